# Optimizing an MI355X kernel written in HIP

```python
import math
import jax, jax.numpy as jnp
from jax import lax
import numpy as np

D_MODEL = 2048
BATCH = 8
SEQ = 2048
DEPTH = 1

CHUNK = 64
Q_BLOCK = 128
EPS = 1e-6
N_HEADS = 16
QK_NOPE_DIM = 128
QK_ROPE_DIM = 64
QK_HEAD_DIM = QK_NOPE_DIM + QK_ROPE_DIM
V_HEAD_DIM = 128
Q_LORA_RANK = 512
KV_LORA_RANK = 256
ROPE_THETA = 10000.0
S5_WIDTH = 1024
S5_GROUP = 16
S5_GROUPS = S5_WIDTH // S5_GROUP
S5_STATE = 64
DT_MIN = 1e-3
DT_MAX = 1e-1
N_EXPERTS = 32
TOP_K = 4
D_FF = 2048
SWIGLU_LIMIT = 7.0
SWIGLU_ALPHA = 1.702
MOE_BLOCK = 128

N_BRANCH = 2
IN_PROJ_DIM = Q_LORA_RANK + KV_LORA_RANK + QK_ROPE_DIM + S5_WIDTH + N_BRANCH * D_MODEL

kernel_name = 'hybrid_mla_s5_gated_moe_block'


def rms_norm(x, g):
    xf = x.astype(jnp.float32)
    y = xf * lax.rsqrt(jnp.mean(xf * xf, axis=-1, keepdims=True) + EPS)
    return y.astype(x.dtype) * g


def rope(x, positions):
    half = QK_ROPE_DIM // 2
    inv_freq = ROPE_THETA ** (-jnp.arange(half, dtype=jnp.float32) / half)
    ang = positions.astype(jnp.float32)[..., None] * inv_freq
    cos = jnp.cos(ang)[:, :, None, :]
    sin = jnp.sin(ang)[:, :, None, :]
    xf = x.astype(jnp.float32)
    x1, x2 = xf[..., :half], xf[..., half:]
    out = jnp.concatenate([x1 * cos - x2 * sin, x2 * cos + x1 * sin], axis=-1)
    return out.astype(x.dtype)


def chunk_causal_attention(q, k, v):
    b, s, h, dh = q.shape
    nqb = s // Q_BLOCK
    scale = 1.0 / math.sqrt(dh)
    qb = q.reshape(b, nqb, Q_BLOCK, h, dh).transpose(1, 0, 2, 3, 4)
    key_chunk = jnp.arange(s) // CHUNK

    def one_block(args):
        q_blk, blk = args
        q_chunk = (blk * Q_BLOCK + jnp.arange(Q_BLOCK)) // CHUNK
        allowed = key_chunk[None, :] <= q_chunk[:, None]
        scores = jnp.einsum('bqhd,bkhd->bhqk', q_blk, k).astype(jnp.float32) * scale
        scores = jnp.where(allowed[None, None], scores, -jnp.inf)
        p = jax.nn.softmax(scores, axis=-1).astype(v.dtype)
        return jnp.einsum('bhqk,bkhd->bqhd', p, v)

    out = lax.map(one_block, (qb, jnp.arange(nqb)))
    return out.transpose(1, 0, 2, 3, 4).reshape(b, s, h, v.shape[-1])


def mla_branch(q_lat, kv_lat, k_rope, positions, q_norm_g, w_uq, kv_norm_g, w_ukv, qk_q_g, qk_k_g, w_o):
    b, s, _ = q_lat.shape
    q = (rms_norm(q_lat, q_norm_g) @ w_uq).reshape(b, s, N_HEADS, QK_HEAD_DIM)
    kv = (rms_norm(kv_lat, kv_norm_g) @ w_ukv).reshape(b, s, N_HEADS, QK_NOPE_DIM + V_HEAD_DIM)
    k_nope, v = kv[..., :QK_NOPE_DIM], kv[..., QK_NOPE_DIM:]
    k_r = jnp.broadcast_to(k_rope[:, :, None, :], (b, s, N_HEADS, QK_ROPE_DIM))
    k = jnp.concatenate([k_nope, k_r], axis=-1)
    q = rms_norm(q, qk_q_g)
    k = rms_norm(k, qk_k_g)
    q = jnp.concatenate([q[..., :QK_NOPE_DIM], rope(q[..., QK_NOPE_DIM:], positions)], axis=-1)
    k = jnp.concatenate([k[..., :QK_NOPE_DIM], rope(k[..., QK_NOPE_DIM:], positions)], axis=-1)
    o = chunk_causal_attention(q, k, v).reshape(b, s, N_HEADS * V_HEAD_DIM)
    return o @ w_o


def s5_branch(u, lam_re, lam_im, log_dt, b_re, b_im, c_re, c_im, d, w_glu, w_o):
    b, s, _ = u.shape
    f32 = jnp.float32
    uf = u.astype(f32)
    ug = uf.reshape(b, s, S5_GROUPS, S5_GROUP)
    dt = jnp.exp(log_dt.astype(f32))[:, None]
    lr, li = lam_re.astype(f32), lam_im.astype(f32)
    mag = jnp.exp(lr * dt)
    ar, ai = mag * jnp.cos(li * dt), mag * jnp.sin(li * dt)
    den = lr * lr + li * li
    zr = ((ar - 1.0) * lr + ai * li) / den
    zi = (ai * lr - (ar - 1.0) * li) / den
    br, bi = b_re.astype(f32), b_im.astype(f32)
    bbr = zr[..., None] * br - zi[..., None] * bi
    bbi = zr[..., None] * bi + zi[..., None] * br
    bu_re = jnp.einsum('bsgc,gpc->bsgp', ug, bbr)
    bu_im = jnp.einsum('bsgc,gpc->bsgp', ug, bbi)
    a_re = jnp.broadcast_to(ar[None, None], (1, s, S5_GROUPS, S5_STATE))
    a_im = jnp.broadcast_to(ai[None, None], (1, s, S5_GROUPS, S5_STATE))

    def combine(left, right):
        a1r, a1i, b1r, b1i = left
        a2r, a2i, b2r, b2i = right
        return (a2r * a1r - a2i * a1i,
                a2r * a1i + a2i * a1r,
                a2r * b1r - a2i * b1i + b2r,
                a2r * b1i + a2i * b1r + b2i)

    _, _, xr, xi = lax.associative_scan(combine, (a_re, a_im, bu_re, bu_im), axis=1)
    y = (jnp.einsum('gcp,bsgp->bsgc', c_re.astype(f32), xr)
         - jnp.einsum('gcp,bsgp->bsgc', c_im.astype(f32), xi))
    y = (y.reshape(b, s, S5_WIDTH) + d.astype(f32) * uf).astype(u.dtype)
    g = jax.nn.gelu(y)
    y = g * jax.nn.sigmoid(g @ w_glu)
    return y @ w_o


def moe(h, w_router, b_router, w_gate, b_gate, w_up, b_up, w_down, b_down):
    bsz, s, d = h.shape
    t = bsz * s
    xf = h.reshape(t, d)
    logits = (xf @ w_router + b_router).astype(jnp.float32)
    top_vals, top_idx = lax.top_k(logits, TOP_K)
    weights = jax.nn.softmax(top_vals, axis=-1)
    n_assign = t * TOP_K
    flat_e = top_idx.reshape(-1)
    flat_tok = jnp.repeat(jnp.arange(t, dtype=jnp.int32), TOP_K)
    flat_w = weights.reshape(-1)
    order = jnp.argsort(flat_e)
    se, stok, sw = flat_e[order], flat_tok[order], flat_w[order]
    counts = jnp.zeros((N_EXPERTS,), jnp.int32).at[flat_e].add(1)
    starts = jnp.cumsum(counts) - counts
    padded = (counts + MOE_BLOCK - 1) // MOE_BLOCK * MOE_BLOCK
    pad_end = jnp.cumsum(padded)
    pad_start = pad_end - padded
    dest = pad_start[se] + jnp.arange(n_assign, dtype=jnp.int32) - starts[se]
    n_blocks = n_assign // MOE_BLOCK + N_EXPERTS
    n_slots = n_blocks * MOE_BLOCK
    slot_tok = jnp.full((n_slots,), t, jnp.int32).at[dest].set(stok)
    slot_w = jnp.zeros((n_slots,), jnp.float32).at[dest].set(sw)
    block_expert = jnp.minimum(
        jnp.searchsorted(pad_end, jnp.arange(n_blocks, dtype=jnp.int32) * MOE_BLOCK, side='right'),
        N_EXPERTS - 1)
    xpad = jnp.concatenate([xf, jnp.zeros((1, d), xf.dtype)], axis=0)
    xb = xpad[slot_tok].reshape(n_blocks, MOE_BLOCK, d)

    def expert_block(args):
        xblk, e = args
        gate = xblk @ w_gate[e] + b_gate[e]
        up = xblk @ w_up[e] + b_up[e]
        gate = jnp.minimum(gate, SWIGLU_LIMIT)
        up = jnp.clip(up, -SWIGLU_LIMIT, SWIGLU_LIMIT)
        glu = gate * jax.nn.sigmoid(SWIGLU_ALPHA * gate)
        return ((up + 1.0) * glu) @ w_down[e] + b_down[e]

    yb = lax.map(expert_block, (xb, block_expert)).reshape(n_slots, d)
    contrib = yb * slot_w[:, None].astype(yb.dtype)
    y = jnp.zeros((t + 1, d), yb.dtype).at[slot_tok].add(contrib)[:t]
    return y.reshape(bsz, s, d)


def setup_inputs(seed: int = 0) -> dict:
    key = jax.random.key(seed)
    ks = jax.random.split(key, 40)
    L = DEPTH
    f32 = jnp.float32

    def nrm(k, shape, scale):
        return jax.random.normal(k, shape, f32) * scale

    def gain(k, shape):
        return 1.0 + 0.01 * jax.random.normal(k, shape, f32)

    x = jax.random.normal(ks[0], (BATCH, SEQ, D_MODEL), f32)
    positions = (jax.random.randint(ks[1], (BATCH, 1), 0, 4096, dtype=jnp.int32)
                 + jnp.arange(SEQ, dtype=jnp.int32)[None, :])
    n_idx = jnp.arange(S5_STATE, dtype=f32)
    lam_re = -0.5 + 1e-3 * jax.random.normal(ks[12], (L, S5_GROUPS, S5_STATE), f32)
    lam_im = math.pi * n_idx[None, None, :] + 1e-3 * jax.random.normal(ks[13], (L, S5_GROUPS, S5_STATE), f32)
    log_dt = jax.random.uniform(ks[14], (L, S5_GROUPS), f32, math.log(DT_MIN), math.log(DT_MAX))
    return {
        'x': x,
        'positions': positions,
        'norm1_g': gain(ks[2], (L, D_MODEL)),
        'w_in': nrm(ks[3], (L, D_MODEL, IN_PROJ_DIM), D_MODEL ** -0.5),
        'b_gates': nrm(ks[4], (L, N_BRANCH * D_MODEL), 0.01),
        'q_norm_g': gain(ks[5], (L, Q_LORA_RANK)),
        'w_uq': nrm(ks[6], (L, Q_LORA_RANK, N_HEADS * QK_HEAD_DIM), Q_LORA_RANK ** -0.5),
        'kv_norm_g': gain(ks[7], (L, KV_LORA_RANK)),
        'w_ukv': nrm(ks[8], (L, KV_LORA_RANK, N_HEADS * (QK_NOPE_DIM + V_HEAD_DIM)), KV_LORA_RANK ** -0.5),
        'qk_norm_q_g': gain(ks[9], (L, QK_HEAD_DIM)),
        'qk_norm_k_g': gain(ks[10], (L, QK_HEAD_DIM)),
        'w_o_mla': nrm(ks[11], (L, N_HEADS * V_HEAD_DIM, D_MODEL), (N_HEADS * V_HEAD_DIM) ** -0.5),
        's5_lambda_re': lam_re,
        's5_lambda_im': lam_im,
        's5_log_dt': log_dt,
        's5_b_re': nrm(ks[15], (L, S5_GROUPS, S5_STATE, S5_GROUP), (2 * S5_GROUP) ** -0.5),
        's5_b_im': nrm(ks[16], (L, S5_GROUPS, S5_STATE, S5_GROUP), (2 * S5_GROUP) ** -0.5),
        's5_c_re': nrm(ks[17], (L, S5_GROUPS, S5_GROUP, S5_STATE), (S5_STATE / 2) ** -0.5),
        's5_c_im': nrm(ks[18], (L, S5_GROUPS, S5_GROUP, S5_STATE), (S5_STATE / 2) ** -0.5),
        's5_d': nrm(ks[19], (L, S5_WIDTH), 1.0),
        'w_glu': nrm(ks[20], (L, S5_WIDTH, S5_WIDTH), S5_WIDTH ** -0.5),
        'w_o_s5': nrm(ks[21], (L, S5_WIDTH, D_MODEL), S5_WIDTH ** -0.5),
        'w_out': nrm(ks[22], (L, D_MODEL, D_MODEL), D_MODEL ** -0.5),
        'norm2_g': gain(ks[23], (L, D_MODEL)),
        'w_router': nrm(ks[24], (L, D_MODEL, N_EXPERTS), D_MODEL ** -0.5),
        'b_router': nrm(ks[25], (L, N_EXPERTS), 0.01),
        'w_gate': nrm(ks[26], (L, N_EXPERTS, D_MODEL, D_FF), D_MODEL ** -0.5),
        'b_gate': nrm(ks[27], (L, N_EXPERTS, D_FF), 0.01),
        'w_up': nrm(ks[28], (L, N_EXPERTS, D_MODEL, D_FF), D_MODEL ** -0.5),
        'b_up': nrm(ks[29], (L, N_EXPERTS, D_FF), 0.01),
        'w_down': nrm(ks[30], (L, N_EXPERTS, D_FF, D_MODEL), D_FF ** -0.5),
        'b_down': nrm(ks[31], (L, N_EXPERTS, D_MODEL), 0.01),
    }


def reference(x, positions, norm1_g, w_in, b_gates, q_norm_g, w_uq, kv_norm_g, w_ukv,
              qk_norm_q_g, qk_norm_k_g, w_o_mla, s5_lambda_re, s5_lambda_im, s5_log_dt,
              s5_b_re, s5_b_im, s5_c_re, s5_c_im, s5_d, w_glu, w_o_s5, w_out, norm2_g,
              w_router, b_router, w_gate, b_gate, w_up, b_up, w_down, b_down):
    o1 = Q_LORA_RANK
    o2 = o1 + KV_LORA_RANK
    o3 = o2 + QK_ROPE_DIM
    o4 = o3 + S5_WIDTH
    for l in range(DEPTH):
        h = rms_norm(x, norm1_g[l])
        proj = h @ w_in[l]
        q_lat, kv_lat, k_rope = proj[..., :o1], proj[..., o1:o2], proj[..., o2:o3]
        u, gate_logits = proj[..., o3:o4], proj[..., o4:]
        y_a = mla_branch(q_lat, kv_lat, k_rope, positions, q_norm_g[l], w_uq[l], kv_norm_g[l],
                         w_ukv[l], qk_norm_q_g[l], qk_norm_k_g[l], w_o_mla[l])
        y_b = s5_branch(u, s5_lambda_re[l], s5_lambda_im[l], s5_log_dt[l], s5_b_re[l], s5_b_im[l],
                        s5_c_re[l], s5_c_im[l], s5_d[l], w_glu[l], w_o_s5[l])
        gates = jax.nn.sigmoid(gate_logits + b_gates[l])
        g_a, g_b = gates[..., :D_MODEL], gates[..., D_MODEL:]
        x = x + (g_a * y_a + g_b * y_b) @ w_out[l]
        h2 = rms_norm(x, norm2_g[l])
        x = x + moe(h2, w_router[l], b_router[l], w_gate[l], b_gate[l], w_up[l], b_up[l],
                    w_down[l], b_down[l])
    return x
```

```cpp
#include <hip/hip_runtime.h>
#include <cstdio>
#include <cstdint>

#ifndef MK_ONE_LAUNCH
#define MK_ONE_LAUNCH 0
#endif
#ifndef MK_FAST_GEMM
#define MK_FAST_GEMM 1
#endif
#ifndef MK_FAST_ATTN
#define MK_FAST_ATTN 1
#endif
#ifndef MK_FAST_S5
#define MK_FAST_S5 1
#endif

#define LAS __attribute__((address_space(3)))
#define GAS __attribute__((address_space(1)))
typedef unsigned short bf16_t;
typedef short bf16x8 __attribute__((ext_vector_type(8)));
typedef short s16x4 __attribute__((ext_vector_type(4)));
typedef float f32x2 __attribute__((ext_vector_type(2)));
typedef float f32x4 __attribute__((ext_vector_type(4)));
typedef float f32x16 __attribute__((ext_vector_type(16)));
typedef unsigned u32x2 __attribute__((ext_vector_type(2)));
typedef unsigned u32x4 __attribute__((ext_vector_type(4)));
typedef unsigned char uchar;

constexpr int NB = 8, SEQ = 2048, TT = NB * SEQ, DM = 2048;
constexpr int NH = 16, DNOPE = 128, DROPE = 64, DQK = 192, DV = 128, QLORA = 512, KVLORA = 256;
constexpr int S5W = 1024, S5G = 64, S5C = 16, S5P = 64, S5L = 16;
constexpr int NE = 32, TOPK = 4, DFF = 2048;
constexpr int IN_PROJ = QLORA + KVLORA + DROPE + S5W + 2 * DM;
constexpr int NPROJ = 6144;
constexpr int C_QLAT = 0, C_KVLAT = 512, C_U = 768, C_GA = 1792, C_GB = 3840, C_KR = 5888;
constexpr float EPS = 1e-6f;
constexpr int MAXSLOT_TILES = (TT * TOPK) / 256 + NE;
constexpr int MAXSLOTS = MAXSLOT_TILES * 256;
constexpr int NCHUNK = TT / S5L;
constexpr int APK = 384;

constexpr size_t MiB = 1u << 20;
constexpr size_t WS_CTL = 0, CTL_ZERO_BYTES = 1 * MiB;
constexpr size_t WS_WIN = 1 * MiB;
constexpr size_t WS_WUQ = WS_WIN + 24 * MiB;
constexpr size_t WS_WUKV = WS_WUQ + 3 * MiB;
constexpr size_t WS_WOMLA = WS_WUKV + 2 * MiB;
constexpr size_t WS_WGLU = WS_WOMLA + 8 * MiB;
constexpr size_t WS_WOS5 = WS_WGLU + 2 * MiB;
constexpr size_t WS_WOUT = WS_WOS5 + 4 * MiB;
constexpr size_t WS_TWC = WS_WOUT + 8 * MiB;
constexpr size_t WS_WS5 = WS_TWC + 12 * MiB;
constexpr size_t WS_ROPE = WS_WS5 + 8 * MiB;
constexpr size_t WS_SMALL = WS_ROPE + 4 * MiB;
constexpr size_t WS_W1 = WS_SMALL + 1 * MiB;
constexpr size_t WS_W2 = WS_W1 + 512 * MiB;
constexpr size_t WS_ACT = WS_W2 + 256 * MiB;
constexpr size_t WS_H = WS_ACT;
constexpr size_t WS_PROJ = WS_H + 64 * MiB;
constexpr size_t WS_APACK = WS_PROJ + 192 * MiB;
constexpr size_t WS_SCH = WS_APACK + 48 * MiB;
constexpr size_t WS_QRAW = WS_SCH + 32 * MiB;
constexpr size_t WS_KVRAW = WS_QRAW + 96 * MiB;
constexpr size_t WS_QN = WS_KVRAW + 128 * MiB;
constexpr size_t WS_KN = WS_QN + 96 * MiB;
constexpr size_t WS_VN = WS_KN + 96 * MiB;
constexpr size_t WS_O = WS_VN + 64 * MiB;
constexpr size_t WS_GACT = WS_O + 64 * MiB;
constexpr size_t WS_Y2 = WS_GACT + 32 * MiB;
constexpr size_t WS_MA = WS_Y2 + 32 * MiB;
constexpr size_t WS_M = WS_MA + 64 * MiB;
constexpr size_t WS_ENDA = WS_M + 64 * MiB;
constexpr size_t WS_H2 = WS_ACT;
constexpr size_t WS_HACT = WS_H2 + 64 * MiB;
constexpr size_t WS_YSLOT = WS_HACT + 288 * MiB;
constexpr size_t WS_TOPI = WS_YSLOT + 288 * MiB;
constexpr size_t WS_TOPW = WS_TOPI + 1 * MiB;
constexpr size_t WS_TPOS = WS_TOPW + 1 * MiB;
constexpr size_t WS_LIST = WS_TPOS + 1 * MiB;
constexpr size_t WS_ENDB = WS_LIST + 2 * MiB;
constexpr size_t WS_END = WS_ENDA > WS_ENDB ? WS_ENDA : WS_ENDB;
constexpr size_t SM_A16 = 0;
constexpr size_t SM_COUNTS = 64 * 1024;
constexpr int CW_BAR = 4096;

constexpr int RING_BYTES = 131072;
constexpr int LDS_BYTES = 163840;
constexpr int LDSCTL_OFF = LDS_BYTES - 2048;
constexpr int MISC_OFF = LDSCTL_OFF;
constexpr int NWAVES = 8, NTHREADS = 512;

#define LDS_WAIT() asm volatile("s_waitcnt lgkmcnt(0)" ::: "memory")
#define VM_WAIT() asm volatile("s_waitcnt vmcnt(0)" ::: "memory")
#define SBAR() __builtin_amdgcn_sched_barrier(0)

__device__ __forceinline__ unsigned f2bf(float f) { unsigned u = __builtin_bit_cast(unsigned, f); return (u + 0x7fffu + ((u >> 16) & 1u)) >> 16; }
__device__ __forceinline__ unsigned pk2(float lo, float hi) { return f2bf(lo) | (f2bf(hi) << 16); }
__device__ __forceinline__ float bf2f(unsigned b) { return __builtin_bit_cast(float, b << 16); }
__device__ __forceinline__ float bflo(unsigned w) { return __builtin_bit_cast(float, w << 16); }
__device__ __forceinline__ float bfhi(unsigned w) { return __builtin_bit_cast(float, w & 0xffff0000u); }
__device__ __forceinline__ unsigned cvt_pk_bf16(float lo, float hi) { unsigned r; asm volatile("v_cvt_pk_bf16_f32 %0, %1, %2" : "=v"(r) : "v"(lo), "v"(hi)); return r; }
__device__ __forceinline__ float sigmoidf_(float x) { return 1.0f / (1.0f + __expf(-x)); }
__device__ __forceinline__ float gelu_tanh(float x) {
    const float u = 0.7978845608028654f * (x + 0.044715f * x * x * x);
    const float e = __expf(2.0f * u);
    const float th = 1.0f - 2.0f / (e + 1.0f);
    return 0.5f * x * (1.0f + th);
}
__device__ __forceinline__ float wave_sum(float v) {
#pragma unroll
    for (int o = 1; o < 64; o <<= 1) v += __shfl_xor(v, o);
    return v;
}

#define XB_TMO      128
#define XB_XCNT(j)  (256  + 64 * (j))
#define XB_XSUB(j)  (1280 + 64 * (j))
#define XB_XGEN(j)  (2304 + 64 * (j))
#define XB_TOP      3328
#define XB_TOPGEN   3392
#define XCD_BAR_WORDS 3456
#define XB_SPIN_CAP (1u << 18)
__device__ __forceinline__ unsigned xb_ld(unsigned* p)              { return __hip_atomic_load(p, __ATOMIC_RELAXED, __HIP_MEMORY_SCOPE_AGENT); }
__device__ __forceinline__ unsigned xb_add(unsigned* p, unsigned v) { return __hip_atomic_fetch_add(p, v, __ATOMIC_RELAXED, __HIP_MEMORY_SCOPE_AGENT); }
__device__ __forceinline__ unsigned xb_xcc_id() { return (unsigned)__builtin_amdgcn_s_getreg((3 << 11) | 20) & 0xFu; }
#define XB_SPIN(cond, bar) do { unsigned _sp = 0; while (cond) { __builtin_amdgcn_s_sleep(1); \
    if ((++_sp & 255u) == 0u) { if (xb_ld(&(bar)[XB_TMO])) break; if (_sp > XB_SPIN_CAP) { atomicAdd(&(bar)[XB_TMO], 1u); break; } } } } while (0)
struct XcdBarrier { unsigned* bar; unsigned x; volatile LAS unsigned* st; };
__device__ __forceinline__ XcdBarrier xcd_barrier_post(unsigned* bar, volatile LAS unsigned* st) {
    XcdBarrier b; b.bar = bar; b.x = xb_xcc_id(); b.st = st;
    if (threadIdx.x == 0) (void)xb_add(&bar[XB_XCNT(b.x)], 1u);
    return b;
}
__device__ __forceinline__ void xcd_barrier_complete(unsigned* bar, unsigned x, unsigned& nloc, unsigned& nx) {
    const unsigned G = gridDim.x * gridDim.y * gridDim.z;
    unsigned sum, cnt, mine, sp = 0u;
    for (;;) {
        sum = 0u; cnt = 0u; mine = 0u;
#pragma unroll
        for (unsigned j = 0; j < 16; ++j) { const unsigned c = xb_ld(&bar[XB_XCNT(j)]); sum += c; cnt += (c > 0u) ? 1u : 0u; mine = (j == x) ? c : mine; }
        if (sum == G) break;
        __builtin_amdgcn_s_sleep(1);
        if ((++sp & 255u) == 0u) { if (xb_ld(&bar[XB_TMO])) break; if (sp > XB_SPIN_CAP) { atomicAdd(&bar[XB_TMO], 1u); break; } }
    }
    nloc = mine > 0u ? mine : 1u; nx = cnt > 0u ? cnt : 1u;
}
__device__ __forceinline__ void xcd_barrier(const XcdBarrier& b) {
    asm volatile("s_waitcnt vmcnt(0)" ::: "memory");
    __syncthreads();
    if (threadIdx.x == 0) {
        unsigned* bar = b.bar;
        __builtin_amdgcn_s_waitcnt(0);
        unsigned nloc = b.st[0], nx = b.st[1];
        if (nloc == 0u) { xcd_barrier_complete(bar, b.x, nloc, nx); b.st[0] = nloc; b.st[1] = nx; }
        const unsigned old = xb_add(&bar[XB_XSUB(b.x)], 1u);
        const unsigned gen = old / nloc;
        if (old + 1u == (gen + 1u) * nloc) {
            __builtin_amdgcn_fence(__ATOMIC_RELEASE, "agent");
            asm volatile("s_waitcnt vmcnt(0)" ::: "memory");
            const unsigned og = xb_add(&bar[XB_TOP], 1u);
            const unsigned tg = og / nx;
            if (og + 1u == (tg + 1u) * nx) xb_add(&bar[XB_TOPGEN], 1u);
            else XB_SPIN(xb_ld(&bar[XB_TOPGEN]) == tg, bar);
            __builtin_amdgcn_fence(__ATOMIC_ACQUIRE, "agent");
            xb_add(&bar[XB_XGEN(b.x)], 1u);
            asm volatile("s_waitcnt vmcnt(0)" ::: "memory");
        } else {
            XB_SPIN(xb_ld(&bar[XB_XGEN(b.x)]) == gen, bar);
            __builtin_amdgcn_fence(__ATOMIC_ACQUIRE, "agent");
            asm volatile("s_waitcnt vmcnt(0)" ::: "memory");
        }
    }
    __syncthreads();
}

namespace gm {
constexpr int BM = 256, BK = 64, HALF = 128, HTB = HALF * BK * 2, STAGE_BYTES = 8 * HTB, NXCD = 8, WGM = 8;
__host__ __device__ __forceinline__ int lds_byte(int r, int c) { const int st = (r >> 4) * 2 + (c >> 5), rr = r & 15, cc = c & 31, ob = rr * 64 + cc * 2; return st * 1024 + (ob ^ (((ob >> 9) & 1) << 5)); }
__host__ __device__ __forceinline__ void stage_rc(int b, int& R, int& C) { const int st = b / 1024, sb = b % 1024, swz = sb ^ (((sb >> 9) & 1) << 5); R = (st >> 1) * 16 + swz / 64; C = (st & 1) * 32 + (swz % 64) / 2; }
__host__ __device__ __forceinline__ int perm32(int rho) { const int n = rho >> 4, i = rho & 15; return 8 * (i >> 2) + 4 * n + (i & 3); }

struct Unit { int pm, pn, g; };


struct ProbDense {
    const bf16_t* A; const bf16_t* B; int lda, ldb, nt; int nM, nN, nwg, G, c;
    __device__ void init(const bf16_t* A_, int lda_, const bf16_t* B_, int ldb_, int K, int M, int N, int G_, int c_) { A = A_; B = B_; lda = lda_; ldb = ldb_; nt = K / BK; nM = M / BM; nN = N / BM; nwg = nM * nN; G = G_; c = c_; }
    __device__ bool next(int i, Unit& u) const {
        const long L = (long)i * G + c; if (L >= nwg) return false;
        int wgid = (int)L; { const int q = nwg / NXCD, r = nwg % NXCD, xcd = wgid % NXCD, off = wgid / NXCD; wgid = (xcd < r ? xcd * (q + 1) : r * (q + 1) + (xcd - r) * q) + off; }
        const int nig = WGM * nN, gid = wgid / nig, fm = gid * WGM, gsz = (nM - fm) < WGM ? (nM - fm) : WGM;
        u.pm = fm + ((wgid % nig) % gsz); u.pn = (wgid % nig) / gsz; u.g = 0; return true;
    }
    __device__ size_t a_off(const Unit& u) const { return (size_t)u.pm * BM * lda; }
    __device__ size_t b_off(const Unit& u) const { return (size_t)u.pn * BM * ldb; }
    __device__ unsigned a_row(const Unit&, int) const { return 0u; }
};

#if MK_FAST_GEMM
template <class Prob, class Epi, bool GATHER>
__device__ __forceinline__ void gemm_phase(LAS uchar* lds, const Prob& S, const Epi& E) {
    const int tid = threadIdx.x, wid = __builtin_amdgcn_readfirstlane(tid >> 6), lane = tid & 63, wr = wid >> 2, wc = wid & 3, fr = lane & 15, fq = lane >> 4;
    const int nt = S.nt;
    int Ra[2], Ca[2]; unsigned voffB[2];
#pragma unroll
    for (int i = 0; i < 2; ++i) { int R, C; stage_rc(tid * 16 + i * 8192, R, C); const int Rb = Epi::PERM ? ((R & ~31) + perm32(R & 31)) : R;
        Ra[i] = R; Ca[i] = C; voffB[i] = (unsigned)(Rb * S.ldb + C) * 2u; }
    const size_t kstep = (size_t)(BK * 2);
    const size_t hstepB = (size_t)HALF * S.ldb * 2;
    const unsigned ldsw = (unsigned)wid * 1024u;
    const int aoff = lds_byte(wr * 64 + fr, fq * 8), boff = lds_byte(wc * 32 + fr, fq * 8);
#define G_SA(b, h) (((b) * 2 + (h)) * HTB)
#define G_SB(b, h) ((4 + (b) * 2 + (h)) * HTB)
#define G_STAGE(bufoff, gbase, voff) do { _Pragma("unroll") for (int _i = 0; _i < 2; ++_i) \
        __builtin_amdgcn_global_load_lds((const unsigned*)((const char*)(gbase) + (voff)[_i]), (LAS unsigned*)(lds + (bufoff) + ldsw + _i * 8192), 16, 0, 0); } while (0)
#define G_LDA(dst, b, h) do { _Pragma("unroll") for (int m = 0; m < 4; ++m) _Pragma("unroll") for (int k = 0; k < 2; ++k) dst[m][k] = *(const LAS bf16x8*)(lds + G_SA(b, h) + aoff + m * 2048 + k * 1024); } while (0)
#define G_LDB(dst, b, h) do { _Pragma("unroll") for (int n = 0; n < 2; ++n) _Pragma("unroll") for (int k = 0; k < 2; ++k) dst[n][k] = *(const LAS bf16x8*)(lds + G_SB(b, h) + boff + n * 2048 + k * 1024); } while (0)
#define G_MMA(ai, bj, At, Bt) do { __builtin_amdgcn_s_setprio(1); _Pragma("unroll") for (int m = 0; m < 4; ++m) _Pragma("unroll") for (int n = 0; n < 2; ++n) _Pragma("unroll") for (int k = 0; k < 2; ++k) \
        acc[ai][bj][m][n] = __builtin_amdgcn_mfma_f32_16x16x32_bf16(Bt[n][k], At[m][k], acc[ai][bj][m][n], 0, 0, 0); __builtin_amdgcn_s_setprio(0); } while (0)
#define G_WAIT_V(n) asm volatile("s_waitcnt vmcnt(" #n ")" ::: "memory")
#define G_WAIT_L(n) asm volatile("s_waitcnt lgkmcnt(" #n ")" ::: "memory")
#define G_BAR __builtin_amdgcn_s_barrier()
#define G_SCHED __builtin_amdgcn_sched_barrier(0)
    Unit cur, nxt; int ui = 0;
    if (!S.next(0, cur)) return;
    f32x4 acc[2][2][4][2];
#pragma unroll
    for (int a = 0; a < 2; ++a)
#pragma unroll
        for (int b = 0; b < 2; ++b)
#pragma unroll
            for (int m = 0; m < 4; ++m)
#pragma unroll
                for (int n = 0; n < 2; ++n) acc[a][b][m][n] = (f32x4){0.f, 0.f, 0.f, 0.f};
    bf16x8 At[4][2], B0[2][2], B1[2][2];
    unsigned vA0[2], vA1[2], nA0[2], nA1[2];
    const char* cA; const char* cB = (const char*)(S.B + S.b_off(cur));
    if constexpr (GATHER) { cA = (const char*)S.A;
#pragma unroll
        for (int i = 0; i < 2; ++i) { vA0[i] = (S.a_row(cur, Ra[i]) + (unsigned)Ca[i]) * 2u; vA1[i] = (S.a_row(cur, HALF + Ra[i]) + (unsigned)Ca[i]) * 2u; }
    } else { cA = (const char*)(S.A + S.a_off(cur));
#pragma unroll
        for (int i = 0; i < 2; ++i) { vA0[i] = (unsigned)(Ra[i] * S.lda + Ca[i]) * 2u; vA1[i] = (unsigned)((HALF + Ra[i]) * S.lda + Ca[i]) * 2u; }
    }
#pragma unroll
    for (int i = 0; i < 2; ++i) { nA0[i] = vA0[i]; nA1[i] = vA1[i]; }
    G_STAGE(G_SB(0, 0), cB, voffB); G_STAGE(G_SA(0, 0), cA, vA0); G_STAGE(G_SB(0, 1), cB + hstepB, voffB); G_STAGE(G_SA(0, 1), cA, vA1);
    if (wr == 1) G_BAR;
    G_WAIT_V(4); G_BAR;
    G_STAGE(G_SB(1, 0), cB + kstep, voffB); G_STAGE(G_SA(1, 0), cA + kstep, vA0); G_STAGE(G_SB(1, 1), cB + hstepB + kstep, voffB);
    G_WAIT_V(6); G_BAR;
    for (;;) {
        const bool has_next = S.next(ui + 1, nxt);
        const char* nA = cA; const char* nB = cB;
        if (has_next) { nB = (const char*)(S.B + S.b_off(nxt));
            if constexpr (GATHER) {
#pragma unroll
                for (int i = 0; i < 2; ++i) { nA0[i] = (S.a_row(nxt, Ra[i]) + (unsigned)Ca[i]) * 2u; nA1[i] = (S.a_row(nxt, HALF + Ra[i]) + (unsigned)Ca[i]) * 2u; }
            } else nA = (const char*)(S.A + S.a_off(nxt));
        }
        for (int t = 0; t < nt; t += 2) {
            const bool last = (t == nt - 2);
            const char* a1 = cA + (size_t)(t + 1) * kstep;
            const char* a2 = last ? nA : cA + (size_t)(t + 2) * kstep; const char* b2 = last ? nB : cB + (size_t)(t + 2) * kstep;
            const char* a3 = a2 + kstep; const char* b3 = b2 + kstep;
            unsigned w0[2], w1[2];
#pragma unroll
            for (int i = 0; i < 2; ++i) { w0[i] = (GATHER && last) ? nA0[i] : vA0[i]; w1[i] = (GATHER && last) ? nA1[i] : vA1[i]; }
            G_LDB(B0, 0, 0); G_SCHED; G_LDA(At, 0, 0); G_STAGE(G_SA(1, 1), a1, vA1);
            G_WAIT_L(8); G_BAR; G_WAIT_L(0); G_MMA(0, 0, At, B0); G_BAR; G_SCHED;
            G_LDB(B1, 0, 1); G_STAGE(G_SB(0, 0), b2, voffB);
            G_BAR; G_WAIT_L(0); G_MMA(0, 1, At, B1); G_BAR;
            G_LDA(At, 0, 1); G_STAGE(G_SA(0, 0), a2, w0);
            G_BAR; G_WAIT_L(0); G_MMA(1, 0, At, B0); G_BAR; G_SCHED;
            G_STAGE(G_SB(0, 1), b2 + hstepB, voffB);
            G_WAIT_V(6); G_BAR; G_MMA(1, 1, At, B1); G_BAR;
            G_LDB(B0, 1, 0); G_SCHED; G_LDA(At, 1, 0); G_STAGE(G_SA(0, 1), a2, w1);
            G_WAIT_L(8); G_BAR; G_WAIT_L(0); G_MMA(0, 0, At, B0); G_BAR; G_SCHED;
            G_LDB(B1, 1, 1); G_STAGE(G_SB(1, 0), b3, voffB);
            G_BAR; G_WAIT_L(0); G_MMA(0, 1, At, B1); G_BAR;
            G_LDA(At, 1, 1); G_STAGE(G_SA(1, 0), a3, w0);
            G_BAR; G_WAIT_L(0); G_MMA(1, 0, At, B0); G_BAR; G_SCHED;
            G_STAGE(G_SB(1, 1), b3 + hstepB, voffB);
            G_WAIT_V(6); G_BAR; G_MMA(1, 1, At, B1); G_BAR;
        }
        E(acc, cur, wr, wc, fr, fq);
        if (!has_next) break;
#pragma unroll
        for (int a = 0; a < 2; ++a)
#pragma unroll
            for (int b = 0; b < 2; ++b)
#pragma unroll
                for (int m = 0; m < 4; ++m)
#pragma unroll
                    for (int n = 0; n < 2; ++n) acc[a][b][m][n] = (f32x4){0.f, 0.f, 0.f, 0.f};
        cur = nxt; cA = nA; cB = nB; ++ui;
        if constexpr (GATHER) {
#pragma unroll
            for (int i = 0; i < 2; ++i) { vA0[i] = nA0[i]; vA1[i] = nA1[i]; }
        }
    }
    G_WAIT_V(0);
    if (wr == 0) G_BAR;
    G_BAR;
#undef G_SA
#undef G_SB
#undef G_STAGE
#undef G_LDA
#undef G_LDB
#undef G_MMA
#undef G_WAIT_V
#undef G_WAIT_L
#undef G_BAR
#undef G_SCHED
}
#else
template <class Prob, class Epi, bool GATHER>
__device__ __forceinline__ void gemm_phase(LAS uchar* lds, const Prob& S, const Epi& E) {
    const int tid = threadIdx.x, wid = tid >> 6, lane = tid & 63, wr = wid >> 2, wc = wid & 3, fr = lane & 15, fq = lane >> 4;
    LAS float* As = (LAS float*)lds; LAS float* Bs = As + 256 * 33;
    Unit u;
    for (int ui = 0; S.next(ui, u); ++ui) {
        float acc[2][2][4][2][4];
#pragma unroll
        for (int a = 0; a < 2; ++a)
#pragma unroll
            for (int b = 0; b < 2; ++b)
#pragma unroll
                for (int m = 0; m < 4; ++m)
#pragma unroll
                    for (int n = 0; n < 2; ++n)
#pragma unroll
                        for (int j = 0; j < 4; ++j) acc[a][b][m][n][j] = 0.f;
        const int lr = tid >> 1, lk = (tid & 1) * 16;
        const bf16_t* ap = GATHER ? (S.A + S.a_row(u, lr)) : (S.A + S.a_off(u) + (size_t)lr * S.lda);
        const bf16_t* bp = S.B + S.b_off(u) + (size_t)lr * S.ldb;
        for (int k0 = 0; k0 < S.nt * 64; k0 += 32) {
            __syncthreads();
            const u32x4 a0 = *(const u32x4*)(ap + k0 + lk), a1 = *(const u32x4*)(ap + k0 + lk + 8);
            const u32x4 b0 = *(const u32x4*)(bp + k0 + lk), b1 = *(const u32x4*)(bp + k0 + lk + 8);
#pragma unroll
            for (int q = 0; q < 4; ++q) {
                As[lr * 33 + lk + 2 * q] = bflo(a0[q]); As[lr * 33 + lk + 2 * q + 1] = bfhi(a0[q]);
                As[lr * 33 + lk + 8 + 2 * q] = bflo(a1[q]); As[lr * 33 + lk + 8 + 2 * q + 1] = bfhi(a1[q]);
                Bs[lr * 33 + lk + 2 * q] = bflo(b0[q]); Bs[lr * 33 + lk + 2 * q + 1] = bfhi(b0[q]);
                Bs[lr * 33 + lk + 8 + 2 * q] = bflo(b1[q]); Bs[lr * 33 + lk + 8 + 2 * q + 1] = bfhi(b1[q]);
            }
            __syncthreads();
            for (int kk = 0; kk < 32; ++kk) {
                float av[2][4], bv[2][2][4];
#pragma unroll
                for (int a = 0; a < 2; ++a)
#pragma unroll
                    for (int m = 0; m < 4; ++m) av[a][m] = As[(128 * a + 64 * wr + 16 * m + fr) * 33 + kk];
#pragma unroll
                for (int b = 0; b < 2; ++b)
#pragma unroll
                    for (int n = 0; n < 2; ++n)
#pragma unroll
                        for (int j = 0; j < 4; ++j) { const int c = 128 * b + 32 * wc + (Epi::PERM ? (8 * fq + 4 * n + j) : (16 * n + 4 * fq + j)); bv[b][n][j] = Bs[c * 33 + kk]; }
#pragma unroll
                for (int a = 0; a < 2; ++a)
#pragma unroll
                    for (int b = 0; b < 2; ++b)
#pragma unroll
                        for (int m = 0; m < 4; ++m)
#pragma unroll
                            for (int n = 0; n < 2; ++n)
#pragma unroll
                                for (int j = 0; j < 4; ++j) acc[a][b][m][n][j] += av[a][m] * bv[b][n][j];
            }
        }
        f32x4 accv[2][2][4][2];
#pragma unroll
        for (int a = 0; a < 2; ++a)
#pragma unroll
            for (int b = 0; b < 2; ++b)
#pragma unroll
                for (int m = 0; m < 4; ++m)
#pragma unroll
                    for (int n = 0; n < 2; ++n) accv[a][b][m][n] = (f32x4){acc[a][b][m][n][0], acc[a][b][m][n][1], acc[a][b][m][n][2], acc[a][b][m][n][3]};
        E(accv, u, wr, wc, fr, fq);
    }
    __syncthreads();
}
#endif
}

struct Args {
    const float* in[32];
    float* out; uchar* ws;
    int ph_lo, ph_hi;
};
struct Frame {
    LAS uchar* lds; uchar* ws; int tid, lane, wave, G, bx;
};
enum { I_X = 0, I_POS, I_N1G, I_WIN, I_BG, I_QNG, I_WUQ, I_KVNG, I_WUKV, I_QKQG, I_QKKG, I_WOMLA, I_LRE, I_LIM, I_LOGDT, I_BRE, I_BIM, I_CRE, I_CIM, I_S5D,
       I_WGLU, I_WOS5, I_WOUT, I_N2G, I_WR, I_BR, I_WG, I_BGATE, I_WU, I_BUP, I_WD, I_BDOWN };

struct ProbS5 {
    const bf16_t* A; const bf16_t* B; int lda, ldb, nt; int G, c;
    __device__ bool next(int i, gm::Unit& u) const { const int L = i * G + c; if (L >= S5G * 4) return false; u.g = L >> 2; u.pm = L & 3; u.pn = 0; return true; }
    __device__ size_t a_off(const gm::Unit& u) const { return ((size_t)u.g * NCHUNK + (size_t)u.pm * 256) * APK; }
    __device__ size_t b_off(const gm::Unit& u) const { return (size_t)u.g * 256 * ldb; }
    __device__ unsigned a_row(const gm::Unit&, int) const { return 0u; }
};
struct ProbMoE {
    const bf16_t* A; const bf16_t* B; int lda, ldb, nt; int npn; size_t estride;
    const int* list;
    const LAS int* tab; int x, rk, nrk;
    __device__ bool next(int i, gm::Unit& u) const {
        int L = i * nrk + rk;
#pragma unroll
        for (int q = 0; q < 4; ++q) { const int e = x + 8 * q; const int nte = tab[32 + e]; const int nu = nte * npn;
            if (L < nu) { u.g = e; u.pn = L / nte; u.pm = L - u.pn * nte; return true; } L -= nu; }
        return false;
    }
    __device__ size_t a_off(const gm::Unit& u) const { return ((size_t)(tab[64 + u.g] + u.pm) * 256) * lda; }
    __device__ size_t b_off(const gm::Unit& u) const { return (size_t)u.g * estride + (size_t)u.pn * 256 * ldb; }
    __device__ unsigned a_row(const gm::Unit& u, int r) const {
        const int cnt = tab[u.g]; int p = u.pm * 256 + r; p = p < cnt ? p : cnt - 1; p = p < 0 ? 0 : p;
        return (unsigned)list[(size_t)u.g * TT + p] * (unsigned)lda;
    }
};

#define EPI_ROW(u_, ai, m) ((u_).pm * 256 + (ai) * 128 + wr * 64 + (m) * 16 + fr)
struct EpiStoreBf16 {
    static constexpr bool PERM = true;
    bf16_t* O; int ld;
    __device__ __forceinline__ void operator()(const f32x4 (&acc)[2][2][4][2], const gm::Unit& u, int wr, int wc, int fr, int fq) const {
#pragma unroll
        for (int ai = 0; ai < 2; ++ai)
#pragma unroll
            for (int m = 0; m < 4; ++m) { bf16_t* rowp = O + (size_t)EPI_ROW(u, ai, m) * ld + u.pn * 256 + wc * 32 + 8 * fq;
#pragma unroll
                for (int bj = 0; bj < 2; ++bj) { const f32x4 v0 = acc[ai][bj][m][0], v1 = acc[ai][bj][m][1];
                    u32x4 w; w.x = cvt_pk_bf16(v0[0], v0[1]); w.y = cvt_pk_bf16(v0[2], v0[3]); w.z = cvt_pk_bf16(v1[0], v1[1]); w.w = cvt_pk_bf16(v1[2], v1[3]);
                    *(u32x4*)(rowp + bj * 128) = w; } }
    }
};
struct EpiInProj {
    static constexpr bool PERM = true;
    bf16_t* proj; bf16_t* apack; const float* bgates;
    __device__ __forceinline__ void operator()(const f32x4 (&acc)[2][2][4][2], const gm::Unit& u, int wr, int wc, int fr, int fq) const {
        const int colt = u.pn * 256 + wc * 32 + 8 * fq;
        const int kind = (u.pn >= 3 && u.pn < 7) ? 1 : ((u.pn >= 7 && u.pn < 23) ? 2 : 0);
#pragma unroll
        for (int bj = 0; bj < 2; ++bj) {
            const int col = colt + bj * 128;
            f32x4 b0 = (f32x4){0.f, 0.f, 0.f, 0.f}, b1 = b0;
            if (kind == 2) { b0 = *(const f32x4*)(bgates + (col - C_GA)); b1 = *(const f32x4*)(bgates + (col - C_GA) + 4); }
#pragma unroll
            for (int ai = 0; ai < 2; ++ai)
#pragma unroll
                for (int m = 0; m < 4; ++m) {
                    const int row = EPI_ROW(u, ai, m);
                    f32x4 v0 = acc[ai][bj][m][0], v1 = acc[ai][bj][m][1];
                    if (kind == 2) {
#pragma unroll
                        for (int j = 0; j < 4; ++j) { v0[j] = sigmoidf_(v0[j] + b0[j]); v1[j] = sigmoidf_(v1[j] + b1[j]); }
                    }
                    u32x4 w; w.x = cvt_pk_bf16(v0[0], v0[1]); w.y = cvt_pk_bf16(v0[2], v0[3]); w.z = cvt_pk_bf16(v1[0], v1[1]); w.w = cvt_pk_bf16(v1[2], v1[3]);
                    if (kind == 1) { const int j = col - C_U, g = j >> 4, cc = j & 15;
                        *(u32x4*)(apack + ((size_t)g * NCHUNK + (row >> 4)) * APK + (row & 15) * 16 + cc) = w; }
                    else *(u32x4*)(proj + (size_t)row * NPROJ + col) = w;
                }
        }
    }
};
struct EpiS5State {
    static constexpr bool PERM = false;
    float* sch;
    __device__ __forceinline__ void operator()(const f32x4 (&acc)[2][2][4][2], const gm::Unit& u, int wr, int wc, int fr, int fq) const {
#pragma unroll
        for (int ai = 0; ai < 2; ++ai)
#pragma unroll
            for (int m = 0; m < 4; ++m) { float* rowp = sch + ((size_t)u.g * NCHUNK + EPI_ROW(u, ai, m)) * 128 + wc * 32 + 4 * fq;
#pragma unroll
                for (int n = 0; n < 2; ++n) *(f32x4*)(rowp + n * 16) = acc[ai][0][m][n]; }
    }
};
struct EpiS5Out {
    static constexpr bool PERM = true;
    bf16_t* gact;
    __device__ __forceinline__ void operator()(const f32x4 (&acc)[2][2][4][2], const gm::Unit& u, int wr, int wc, int fr, int fq) const {
#pragma unroll
        for (int ai = 0; ai < 2; ++ai)
#pragma unroll
            for (int m = 0; m < 4; ++m) { const int r = EPI_ROW(u, ai, m);
#pragma unroll
                for (int bj = 0; bj < 2; ++bj) { const int n0 = bj * 128 + wc * 32 + 8 * fq, t = n0 >> 4, c0 = n0 & 15;
                    f32x4 v0 = acc[ai][bj][m][0], v1 = acc[ai][bj][m][1];
#pragma unroll
                    for (int j = 0; j < 4; ++j) { v0[j] = gelu_tanh(v0[j]); v1[j] = gelu_tanh(v1[j]); }
                    u32x4 w; w.x = cvt_pk_bf16(v0[0], v0[1]); w.y = cvt_pk_bf16(v0[2], v0[3]); w.z = cvt_pk_bf16(v1[0], v1[1]); w.w = cvt_pk_bf16(v1[2], v1[3]);
                    *(u32x4*)(gact + ((size_t)r * 16 + t) * S5W + u.g * 16 + c0) = w; } }
    }
};
template <int MODE> struct EpiSide {
    static constexpr bool PERM = true;
    bf16_t* O; int ldo; const bf16_t* s0; int ld0; const bf16_t* s1; int ld1;
    __device__ __forceinline__ void operator()(const f32x4 (&acc)[2][2][4][2], const gm::Unit& u, int wr, int wc, int fr, int fq) const {
#pragma unroll
        for (int ai = 0; ai < 2; ++ai)
#pragma unroll
            for (int m = 0; m < 4; ++m) { const int row = EPI_ROW(u, ai, m);
#pragma unroll
                for (int bj = 0; bj < 2; ++bj) { const int col = u.pn * 256 + bj * 128 + wc * 32 + 8 * fq;
                    const f32x4 v0 = acc[ai][bj][m][0], v1 = acc[ai][bj][m][1];
                    const u32x4 a = *(const u32x4*)(s0 + (size_t)row * ld0 + col);
                    u32x4 b = (u32x4){0u, 0u, 0u, 0u}; if (MODE == 2) b = *(const u32x4*)(s1 + (size_t)row * ld1 + col);
                    float r[8];
#pragma unroll
                    for (int q = 0; q < 4; ++q) { const float x0 = q < 2 ? v0[2 * q] : v1[2 * q - 4], x1 = q < 2 ? v0[2 * q + 1] : v1[2 * q - 3];
                        const float a0 = bflo(a[q]), a1 = bfhi(a[q]);
                        if (MODE == 0) { r[2 * q] = a0 * sigmoidf_(x0); r[2 * q + 1] = a1 * sigmoidf_(x1); }
                        else if (MODE == 1) { r[2 * q] = a0 * x0; r[2 * q + 1] = a1 * x1; }
                        else { r[2 * q] = bflo(b[q]) + a0 * x0; r[2 * q + 1] = bfhi(b[q]) + a1 * x1; } }
                    u32x4 w; w.x = cvt_pk_bf16(r[0], r[1]); w.y = cvt_pk_bf16(r[2], r[3]); w.z = cvt_pk_bf16(r[4], r[5]); w.w = cvt_pk_bf16(r[6], r[7]);
                    *(u32x4*)(O + (size_t)row * ldo + col) = w; } }
    }
};
struct EpiResidF32 {
    static constexpr bool PERM = false;
    const float* x; float* out;
    __device__ __forceinline__ void operator()(const f32x4 (&acc)[2][2][4][2], const gm::Unit& u, int wr, int wc, int fr, int fq) const {
#pragma unroll
        for (int ai = 0; ai < 2; ++ai)
#pragma unroll
            for (int m = 0; m < 4; ++m) { const size_t off = (size_t)EPI_ROW(u, ai, m) * DM + u.pn * 256 + wc * 32 + 4 * fq;
#pragma unroll
                for (int bj = 0; bj < 2; ++bj)
#pragma unroll
                    for (int n = 0; n < 2; ++n) { const size_t o = off + bj * 128 + n * 16; *(f32x4*)(out + o) = *(const f32x4*)(x + o) + acc[ai][bj][m][n]; } }
    }
};
struct EpiSwiglu {
    static constexpr bool PERM = true;
    bf16_t* hact; const float* bgate; const float* bup; const LAS int* tab;
    __device__ __forceinline__ void operator()(const f32x4 (&acc)[2][2][4][2], const gm::Unit& u, int wr, int wc, int fr, int fq) const {
        const int hc = u.pn * 128 + wc * 32 + 8 * fq;
        const float* bg = bgate + (size_t)u.g * DFF + hc; const float* bu = bup + (size_t)u.g * DFF + hc;
        const f32x4 g0 = *(const f32x4*)bg, g1 = *(const f32x4*)(bg + 4), u0 = *(const f32x4*)bu, u1 = *(const f32x4*)(bu + 4);
        const size_t slot0 = (size_t)(tab[64 + u.g] + u.pm) * 256;
#pragma unroll
        for (int ai = 0; ai < 2; ++ai)
#pragma unroll
            for (int m = 0; m < 4; ++m) { const size_t slot = slot0 + ai * 128 + wr * 64 + m * 16 + fr;
                float r[8];
#pragma unroll
                for (int q = 0; q < 8; ++q) { float gt = (q < 4 ? acc[ai][0][m][0][q] + g0[q] : acc[ai][0][m][1][q - 4] + g1[q - 4]);
                    float up = (q < 4 ? acc[ai][1][m][0][q] + u0[q] : acc[ai][1][m][1][q - 4] + u1[q - 4]);
                    gt = fminf(gt, 7.0f); up = fminf(fmaxf(up, -7.0f), 7.0f);
                    r[q] = (up + 1.0f) * (gt * sigmoidf_(1.702f * gt)); }
                u32x4 w; w.x = cvt_pk_bf16(r[0], r[1]); w.y = cvt_pk_bf16(r[2], r[3]); w.z = cvt_pk_bf16(r[4], r[5]); w.w = cvt_pk_bf16(r[6], r[7]);
                *(u32x4*)(hact + slot * DFF + hc) = w; }
    }
};
struct EpiDown {
    static constexpr bool PERM = true;
    bf16_t* ys; const float* bdown; const LAS int* tab;
    __device__ __forceinline__ void operator()(const f32x4 (&acc)[2][2][4][2], const gm::Unit& u, int wr, int wc, int fr, int fq) const {
        const size_t slot0 = (size_t)(tab[64 + u.g] + u.pm) * 256;
#pragma unroll
        for (int bj = 0; bj < 2; ++bj) { const int col = u.pn * 256 + bj * 128 + wc * 32 + 8 * fq;
            const float* bd = bdown + (size_t)u.g * DM + col; const f32x4 d0 = *(const f32x4*)bd, d1 = *(const f32x4*)(bd + 4);
#pragma unroll
            for (int ai = 0; ai < 2; ++ai)
#pragma unroll
                for (int m = 0; m < 4; ++m) { const size_t slot = slot0 + ai * 128 + wr * 64 + m * 16 + fr;
                    const f32x4 v0 = acc[ai][bj][m][0] + d0, v1 = acc[ai][bj][m][1] + d1;
                    u32x4 w; w.x = cvt_pk_bf16(v0[0], v0[1]); w.y = cvt_pk_bf16(v0[2], v0[3]); w.z = cvt_pk_bf16(v1[0], v1[1]); w.w = cvt_pk_bf16(v1[2], v1[3]);
                    *(u32x4*)(ys + slot * DM + col) = w; } }
    }
};

__device__ __forceinline__ void transpose_item(const float* W, int ldw, int src_col0, int k0, const float* kscale, bf16_t* WT, int ldt, int dst_row0, LAS float* scr, int lane) {
    if (src_col0 >= 0) {
#pragma unroll 8
        for (int i = 0; i < 32; ++i) { const int kk = 2 * i + (lane >> 5); float v = W[(size_t)(k0 + kk) * ldw + src_col0 + (lane & 31)]; if (kscale) v *= kscale[k0 + kk]; scr[kk * 33 + (lane & 31)] = v; }
    } else {
#pragma unroll 8
        for (int i = 0; i < 32; ++i) { const int kk = 2 * i + (lane >> 5); scr[kk * 33 + (lane & 31)] = 0.f; }
    }
    LDS_WAIT(); asm volatile("" ::: "memory");
    const int c = lane & 7;
#pragma unroll
    for (int j = 0; j < 4; ++j) { const int n = (lane >> 3) + 8 * j; const LAS float* s = scr + (8 * c) * 33 + n;
        u32x4 o; o.x = pk2(s[0 * 33], s[1 * 33]); o.y = pk2(s[2 * 33], s[3 * 33]); o.z = pk2(s[4 * 33], s[5 * 33]); o.w = pk2(s[6 * 33], s[7 * 33]);
        *(u32x4*)(WT + (size_t)(dst_row0 + n) * ldt + k0 + 8 * c) = o; }
    LDS_WAIT(); asm volatile("" ::: "memory");
}
__device__ __forceinline__ int win_src_col(int n0) {
    if (n0 < C_KVLAT) return n0;
    if (n0 < C_U) return n0;
    if (n0 < C_GA) return (n0 - C_U) + 832;
    if (n0 < C_KR) return (n0 - C_GA) + 1856;
    if (n0 < C_KR + DROPE) return (n0 - C_KR) + 768;
    return -1;
}
__device__ __forceinline__ void s5_build_group(const Args& a, const Frame& F, int g) {
    LAS float* L = (LAS float*)F.lds;
    LAS float* Apr = L;              LAS float* Api = Apr + 17 * 64;
    LAS float* Zr = Api + 17 * 64;   LAS float* Zi = Zr + 64;
    LAS float* Bbr = Zi + 64;        LAS float* Bbi = Bbr + 1024;
    LAS float* Cr = Bbi + 1024;      LAS float* Ci = Cr + 1024;
    LAS float* Kt = Ci + 1024;
    const int tid = F.tid;
    __syncthreads();
    if (tid < 64) { const int p = tid;
        const float dt = expf(a.in[I_LOGDT][g]); const float lr = a.in[I_LRE][g * 64 + p], li = a.in[I_LIM][g * 64 + p];
        const float mag = expf(lr * dt); const float ar = mag * cosf(li * dt), ai = mag * sinf(li * dt);
        const float den = lr * lr + li * li;
        Zr[p] = ((ar - 1.0f) * lr + ai * li) / den; Zi[p] = (ai * lr - (ar - 1.0f) * li) / den;
        float pr = 1.0f, pi = 0.0f;
        for (int t = 0; t <= 16; ++t) { Apr[t * 64 + p] = pr; Api[t * 64 + p] = pi; const float nr = pr * ar - pi * ai, ni = pr * ai + pi * ar; pr = nr; pi = ni; }
    }
    __syncthreads();
    for (int i = tid; i < 1024; i += NTHREADS) { const int p = i >> 4;
        const float br = a.in[I_BRE][(size_t)g * 1024 + i], bi = a.in[I_BIM][(size_t)g * 1024 + i];
        Bbr[i] = Zr[p] * br - Zi[p] * bi; Bbi[i] = Zr[p] * bi + Zi[p] * br;
        Cr[i] = a.in[I_CRE][(size_t)g * 1024 + i]; Ci[i] = a.in[I_CIM][(size_t)g * 1024 + i]; }
    if (tid < 64) ((float2*)(F.ws + WS_SMALL + SM_A16))[g * 64 + tid] = make_float2(Apr[16 * 64 + tid], Api[16 * 64 + tid]);
    __syncthreads();
    for (int i = tid; i < 4096; i += NTHREADS) { const int tau = i >> 8, c = (i >> 4) & 15, cp = i & 15; float s = 0.f;
        for (int p = 0; p < 64; ++p) { const float cr = Cr[c * 64 + p], ci = Ci[c * 64 + p], ar = Apr[tau * 64 + p], ai = Api[tau * 64 + p];
            const float car = cr * ar - ci * ai, cai = cr * ai + ci * ar; s += car * Bbr[p * 16 + cp] - cai * Bbi[p * 16 + cp]; }
        Kt[i] = s; }
    __syncthreads();
    bf16_t* twc = (bf16_t*)(F.ws + WS_TWC) + (size_t)g * 256 * APK;
    for (int ch = tid; ch < 256 * (APK / 8); ch += NTHREADS) { const int n = ch / (APK / 8), k0 = (ch % (APK / 8)) * 8, t = n >> 4, c = n & 15; float v[8];
#pragma unroll
        for (int j = 0; j < 8; ++j) { const int k = k0 + j;
            if (k < 256) { const int s = k >> 4, cp = k & 15; float x = (s <= t) ? Kt[((t - s) * 16 + c) * 16 + cp] : 0.f; if (s == t && cp == c) x += a.in[I_S5D][g * 16 + c]; v[j] = x; }
            else { const int q = k - 256, p = q & 63; const float cr = Cr[c * 64 + p], ci = Ci[c * 64 + p], ar = Apr[(t + 1) * 64 + p], ai = Api[(t + 1) * 64 + p];
                v[j] = (q < 64) ? (cr * ar - ci * ai) : -(cr * ai + ci * ar); } }
        u32x4 o; o.x = pk2(v[0], v[1]); o.y = pk2(v[2], v[3]); o.z = pk2(v[4], v[5]); o.w = pk2(v[6], v[7]);
        *(u32x4*)(twc + (size_t)n * APK + k0) = o; }
    bf16_t* wsm = (bf16_t*)(F.ws + WS_WS5) + (size_t)g * 256 * 256;
    for (int ch = tid; ch < 256 * 32; ch += NTHREADS) { const int n = ch >> 5, k0 = (ch & 31) * 8; float v[8];
#pragma unroll
        for (int j = 0; j < 8; ++j) { const int k = k0 + j, s = k >> 4, cp = k & 15;
            if (n < 128) { const int p = n & 63; const float ar = Apr[(15 - s) * 64 + p], ai = Api[(15 - s) * 64 + p], br = Bbr[p * 16 + cp], bi = Bbi[p * 16 + cp];
                v[j] = (n < 64) ? (ar * br - ai * bi) : (ar * bi + ai * br); } else v[j] = 0.f; }
        u32x4 o; o.x = pk2(v[0], v[1]); o.y = pk2(v[2], v[3]); o.z = pk2(v[4], v[5]); o.w = pk2(v[6], v[7]);
        *(u32x4*)(wsm + (size_t)n * 256 + k0) = o; }
    __syncthreads();
}
__device__ __forceinline__ void rms_row_to_bf16(const float* xrow, const float* gain, bf16_t* orow, int lane) {
    const f32x4* xr = (const f32x4*)xrow + lane; const f32x4* gr = (const f32x4*)gain + lane;
    f32x4 v[8]; float s = 0.f;
#pragma unroll
    for (int j = 0; j < 8; ++j) { v[j] = xr[64 * j]; s += (v[j].x * v[j].x + v[j].y * v[j].y) + (v[j].z * v[j].z + v[j].w * v[j].w); }
    const float rstd = 1.0f / sqrtf(wave_sum(s) * (1.0f / DM) + EPS);
    unsigned long long* o8 = (unsigned long long*)orow + lane;
#pragma unroll
    for (int j = 0; j < 8; ++j) { const f32x4 gg = gr[64 * j];
        o8[64 * j] = (unsigned long long)pk2(v[j].x * rstd * gg.x, v[j].y * rstd * gg.y) | ((unsigned long long)pk2(v[j].z * rstd * gg.z, v[j].w * rstd * gg.w) << 32); }
}
__device__ __forceinline__ void p0_prologue(const Args& a, const Frame& F) {
    for (int g = F.bx; g < S5G; g += F.G) s5_build_group(a, F, g);
    __syncthreads();
    LAS float* scr = (LAS float*)(F.lds + F.wave * 16384);
    const int gw = F.bx * NWAVES + F.wave, NGW = F.G * NWAVES; const int lane = F.lane;
    for (int m = gw; m < TT; m += NGW) rms_row_to_bf16(a.in[I_X] + (size_t)m * DM, a.in[I_N1G], (bf16_t*)(F.ws + WS_H) + (size_t)m * DM, lane);
    for (int i = gw * 64 + lane; i < TT * 32; i += NGW * 64) { const int t = i >> 5, f = i & 31;
        const double invf = exp(-(double)f * (9.210340371976184 / 32.0)); const double ang = (double)((const int*)a.in[I_POS])[t] * invf;
        ((float2*)(F.ws + WS_ROPE))[i] = make_float2((float)cos(ang), (float)sin(ang)); }
    constexpr int IT_WIN = (DM / 64) * (NPROJ / 32), IT_WUQ = (QLORA / 64) * (3072 / 32), IT_WUKV = (KVLORA / 64) * (4096 / 32), IT_SQ = (DM / 64) * (DM / 32),
                  IT_GLU = (S5W / 64) * (S5W / 32), IT_OS5 = (S5W / 64) * (DM / 32);
    constexpr int IT_MIX = IT_WIN + IT_WUQ + IT_WUKV + IT_SQ + IT_GLU + IT_OS5 + IT_SQ;
    for (int it = gw; it < IT_MIX; it += NGW) { int r = it;
        if (r < IT_WIN) { const int nb = r % (NPROJ / 32), kb = r / (NPROJ / 32); transpose_item(a.in[I_WIN], IN_PROJ, win_src_col(nb * 32), kb * 64, nullptr, (bf16_t*)(F.ws + WS_WIN), DM, nb * 32, scr, lane); continue; } r -= IT_WIN;
        if (r < IT_WUQ) { const int nb = r % 96, kb = r / 96; transpose_item(a.in[I_WUQ], 3072, nb * 32, kb * 64, a.in[I_QNG], (bf16_t*)(F.ws + WS_WUQ), QLORA, nb * 32, scr, lane); continue; } r -= IT_WUQ;
        if (r < IT_WUKV) { const int nb = r % 128, kb = r / 128; transpose_item(a.in[I_WUKV], 4096, nb * 32, kb * 64, a.in[I_KVNG], (bf16_t*)(F.ws + WS_WUKV), KVLORA, nb * 32, scr, lane); continue; } r -= IT_WUKV;
        if (r < IT_SQ) { const int nb = r % 64, kb = r / 64; transpose_item(a.in[I_WOMLA], DM, nb * 32, kb * 64, nullptr, (bf16_t*)(F.ws + WS_WOMLA), DM, nb * 32, scr, lane); continue; } r -= IT_SQ;
        if (r < IT_GLU) { const int nb = r % 32, kb = r / 32; transpose_item(a.in[I_WGLU], S5W, nb * 32, kb * 64, nullptr, (bf16_t*)(F.ws + WS_WGLU), S5W, nb * 32, scr, lane); continue; } r -= IT_GLU;
        if (r < IT_OS5) { const int nb = r % 64, kb = r / 64; transpose_item(a.in[I_WOS5], DM, nb * 32, kb * 64, nullptr, (bf16_t*)(F.ws + WS_WOS5), S5W, nb * 32, scr, lane); continue; } r -= IT_OS5;
        { const int nb = r % 64, kb = r / 64; transpose_item(a.in[I_WOUT], DM, nb * 32, kb * 64, nullptr, (bf16_t*)(F.ws + WS_WOUT), DM, nb * 32, scr, lane); }
    }
    for (int it = gw; it < NE * 2 * 32 * 64; it += NGW) { const int nb = it & 63, kb = (it >> 6) & 31, half = (it >> 11) & 1, e = it >> 12;
        const float* W = a.in[half ? I_WU : I_WG] + (size_t)e * DM * DFF; const int pn = nb >> 2, q = nb & 3;
        transpose_item(W, DFF, nb * 32, kb * 64, nullptr, (bf16_t*)(F.ws + WS_W1) + (size_t)e * 4096 * DM, DM, pn * 256 + half * 128 + q * 32, scr, lane); }
    for (int it = gw; it < NE * 32 * 64; it += NGW) { const int nb = it & 63, kb = (it >> 6) & 31, e = it >> 11;
        transpose_item(a.in[I_WD] + (size_t)e * DFF * DM, DM, nb * 32, kb * 64, nullptr, (bf16_t*)(F.ws + WS_W2) + (size_t)e * DM * DFF, DFF, nb * 32, scr, lane); }
}

constexpr float QSCALE = 0.07216878364870322f * 1.4426950408889634f;
__device__ __forceinline__ float half_sum(float v) {
#pragma unroll
    for (int o = 1; o < 32; o <<= 1) v += __shfl_xor(v, o);
    return v;
}
__device__ __forceinline__ void p3_prep(const Args& a, const Frame& F) {
    const bf16_t* proj = (const bf16_t*)(F.ws + WS_PROJ); const bf16_t* qraw = (const bf16_t*)(F.ws + WS_QRAW); const bf16_t* kvraw = (const bf16_t*)(F.ws + WS_KVRAW);
    bf16_t* Qn = (bf16_t*)(F.ws + WS_QN); bf16_t* Kn = (bf16_t*)(F.ws + WS_KN); bf16_t* Vn = (bf16_t*)(F.ws + WS_VN);
    const float2* rope = (const float2*)(F.ws + WS_ROPE);
    const float* gq = a.in[I_QKQG]; const float* gk = a.in[I_QKKG];
    const int lane = F.lane, half = lane >> 5, j = lane & 31;
    const f32x4 gq4 = *(const f32x4*)(gq + 4 * j), gk4 = *(const f32x4*)(gk + 4 * j);
    const float gq1 = gq[128 + j], gq2 = gq[160 + j], gk1 = gk[128 + j], gk2 = gk[160 + j];
    const int gw = F.bx * NWAVES + F.wave, NGW = F.G * NWAVES;
    for (int it = gw; it < TT * 8; it += NGW) {
        const int t = it >> 3, h = 2 * (it & 7) + half, b = t >> 11, s = t & 2047;
        const bf16_t* prow = proj + (size_t)t * NPROJ;
        float sq = 0.f, skv = 0.f;
        { const u32x4 w = *(const u32x4*)(prow + C_QLAT + 8 * lane);
#pragma unroll
          for (int q = 0; q < 4; ++q) { const float x0 = bflo(w[q]), x1 = bfhi(w[q]); sq += x0 * x0 + x1 * x1; }
          if (lane < 32) { const u32x4 w2 = *(const u32x4*)(prow + C_KVLAT + 8 * lane);
#pragma unroll
              for (int q = 0; q < 4; ++q) { const float x0 = bflo(w2[q]), x1 = bfhi(w2[q]); skv += x0 * x0 + x1 * x1; } } }
        const float rstd_q = 1.0f / sqrtf(wave_sum(sq) * (1.0f / QLORA) + EPS), rstd_kv = 1.0f / sqrtf(wave_sum(skv) * (1.0f / KVLORA) + EPS);
        const float2 cs = rope[t * 32 + j];
        const size_t hs = ((size_t)(b * NH + h) * SEQ + s);
        { const bf16_t* qp = qraw + (size_t)t * 3072 + h * DQK; const u32x2 w = *(const u32x2*)(qp + 4 * j);
          float x0 = bflo(w.x) * rstd_q, x1 = bfhi(w.x) * rstd_q, x2 = bflo(w.y) * rstd_q, x3 = bfhi(w.y) * rstd_q;
          float r1 = bf2f(qp[128 + j]) * rstd_q, r2 = bf2f(qp[160 + j]) * rstd_q;
          const float ms = half_sum(x0 * x0 + x1 * x1 + x2 * x2 + x3 * x3 + r1 * r1 + r2 * r2) * (1.0f / DQK);
          const float rn = QSCALE / sqrtf(ms + EPS);
          x0 *= rn * gq4.x; x1 *= rn * gq4.y; x2 *= rn * gq4.z; x3 *= rn * gq4.w; r1 *= rn * gq1; r2 *= rn * gq2;
          const float o1 = r1 * cs.x - r2 * cs.y, o2 = r2 * cs.x + r1 * cs.y;
          bf16_t* qo = Qn + hs * DQK; u32x2 o; o.x = pk2(x0, x1); o.y = pk2(x2, x3); *(u32x2*)(qo + 4 * j) = o; qo[128 + j] = (bf16_t)f2bf(o1); qo[160 + j] = (bf16_t)f2bf(o2); }
        { const bf16_t* kp = kvraw + (size_t)t * 4096 + h * 256; const u32x2 w = *(const u32x2*)(kp + 4 * j); const u32x2 wv = *(const u32x2*)(kp + 128 + 4 * j);
          float x0 = bflo(w.x) * rstd_kv, x1 = bfhi(w.x) * rstd_kv, x2 = bflo(w.y) * rstd_kv, x3 = bfhi(w.y) * rstd_kv;
          float r1 = bf2f(prow[C_KR + j]), r2 = bf2f(prow[C_KR + 32 + j]);
          const float ms = half_sum(x0 * x0 + x1 * x1 + x2 * x2 + x3 * x3 + r1 * r1 + r2 * r2) * (1.0f / DQK);
          const float rn = 1.0f / sqrtf(ms + EPS);
          x0 *= rn * gk4.x; x1 *= rn * gk4.y; x2 *= rn * gk4.z; x3 *= rn * gk4.w; r1 *= rn * gk1; r2 *= rn * gk2;
          const float o1 = r1 * cs.x - r2 * cs.y, o2 = r2 * cs.x + r1 * cs.y;
          bf16_t* ko = Kn + hs * DQK; u32x2 o; o.x = pk2(x0, x1); o.y = pk2(x2, x3); *(u32x2*)(ko + 4 * j) = o; ko[128 + j] = (bf16_t)f2bf(o1); ko[160 + j] = (bf16_t)f2bf(o2);
          u32x2 ov; ov.x = pk2(bflo(wv.x) * rstd_kv, bfhi(wv.x) * rstd_kv); ov.y = pk2(bflo(wv.y) * rstd_kv, bfhi(wv.y) * rstd_kv);
          *(u32x2*)(Vn + hs * DV + 4 * j) = ov; }
    }
}

__device__ __forceinline__ void p3_scan(const Args& a, const Frame& F) {
    const float* sch = (const float*)(F.ws + WS_SCH); bf16_t* apack = (bf16_t*)(F.ws + WS_APACK); const float2* A16 = (const float2*)(F.ws + WS_SMALL + SM_A16);
    const int gw = F.bx * NWAVES + F.wave, NGW = F.G * NWAVES, p = F.lane;
    for (int it = gw; it < NB * S5G; it += NGW) { const int b = it / S5G, g = it % S5G;
        const float2 am = A16[g * 64 + p]; float xr = 0.f, xi = 0.f;
        const size_t row0 = (size_t)g * NCHUNK + (size_t)b * 128;
        for (int c0 = 0; c0 < 128; c0 += 8) { float sr[8], si[8];
#pragma unroll
            for (int q = 0; q < 8; ++q) { sr[q] = sch[(row0 + c0 + q) * 128 + p]; si[q] = sch[(row0 + c0 + q) * 128 + 64 + p]; }
#pragma unroll
            for (int q = 0; q < 8; ++q) { bf16_t* o = apack + (row0 + c0 + q) * APK + 256; o[p] = (bf16_t)f2bf(xr); o[64 + p] = (bf16_t)f2bf(xi);
                const float nr = am.x * xr - am.y * xi + sr[q], ni = am.x * xi + am.y * xr + si[q]; xr = nr; xi = ni; } }
    }
}

__device__ __forceinline__ void s5_reference(const Args& a, const Frame& F) {
    const bf16_t* apack = (const bf16_t*)(F.ws + WS_APACK); bf16_t* gact = (bf16_t*)(F.ws + WS_GACT);
    const int gw = F.bx * NWAVES + F.wave, NGW = F.G * NWAVES, p = F.lane;
    for (int it = gw; it < NB * S5G; it += NGW) { const int b = it / S5G, g = it % S5G;
        const float dt = expf(a.in[I_LOGDT][g]); const float lr = a.in[I_LRE][g * 64 + p], li = a.in[I_LIM][g * 64 + p];
        const float mag = expf(lr * dt); const float ar = mag * cosf(li * dt), ai = mag * sinf(li * dt); const float den = lr * lr + li * li;
        const float zr = ((ar - 1.0f) * lr + ai * li) / den, zi = (ai * lr - (ar - 1.0f) * li) / den;
        float bbr[16], bbi[16], cr[16], ci[16];
#pragma unroll
        for (int c = 0; c < 16; ++c) { const float br = a.in[I_BRE][((size_t)g * 64 + p) * 16 + c], bi = a.in[I_BIM][((size_t)g * 64 + p) * 16 + c];
            bbr[c] = zr * br - zi * bi; bbi[c] = zr * bi + zi * br; cr[c] = a.in[I_CRE][((size_t)g * 16 + c) * 64 + p]; ci[c] = a.in[I_CIM][((size_t)g * 16 + c) * 64 + p]; }
        const float dl = (p < 16) ? a.in[I_S5D][g * 16 + p] : 0.f;
        float xr = 0.f, xi = 0.f;
        for (int t = 0; t < SEQ; ++t) { const int tok = b * SEQ + t;
            const bf16_t* up = apack + ((size_t)g * NCHUNK + (tok >> 4)) * APK + (tok & 15) * 16;
            const u32x4 w0 = *(const u32x4*)up, w1 = *(const u32x4*)(up + 8); float u[16];
#pragma unroll
            for (int q = 0; q < 4; ++q) { u[2 * q] = bflo(w0[q]); u[2 * q + 1] = bfhi(w0[q]); u[8 + 2 * q] = bflo(w1[q]); u[8 + 2 * q + 1] = bfhi(w1[q]); }
            float br = 0.f, bi = 0.f;
#pragma unroll
            for (int c = 0; c < 16; ++c) { br += bbr[c] * u[c]; bi += bbi[c] * u[c]; }
            const float nr = ar * xr - ai * xi + br, ni = ar * xi + ai * xr + bi; xr = nr; xi = ni;
            float y = 0.f, um = 0.f;
#pragma unroll
            for (int c = 0; c < 16; ++c) { const float yc = wave_sum(cr[c] * xr - ci[c] * xi); if (p == c) { y = yc; um = u[c]; } }
            if (p < 16) gact[(size_t)tok * S5W + g * 16 + p] = (bf16_t)f2bf(gelu_tanh(y + dl * um));
        }
    }
}

__device__ __forceinline__ float attn_bound(const Args& a, int lane) {
    float mq = 0.f, mk = 0.f;
#pragma unroll
    for (int q = 0; q < 3; ++q) { mq = fmaxf(mq, fabsf(a.in[I_QKQG][lane + 64 * q])); mk = fmaxf(mk, fabsf(a.in[I_QKKG][lane + 64 * q])); }
#pragma unroll
    for (int o = 1; o < 64; o <<= 1) { mq = fmaxf(mq, __shfl_xor(mq, o)); mk = fmaxf(mk, __shfl_xor(mk, o)); }
    return mq * mk * 13.856406460551018f * 1.4426950408889634f;
}
__device__ __forceinline__ void attn_reference(const Args& a, const Frame& F) {
    const bf16_t* Qn = (const bf16_t*)(F.ws + WS_QN); const bf16_t* Kn = (const bf16_t*)(F.ws + WS_KN); const bf16_t* Vn = (const bf16_t*)(F.ws + WS_VN);
    bf16_t* O = (bf16_t*)(F.ws + WS_O);
    LAS float* ql = (LAS float*)(F.lds + F.wave * 1024);
    const int lane = F.lane, gw = F.bx * NWAVES + F.wave, NGW = F.G * NWAVES;
    const float Mb = attn_bound(a, lane);
    for (int it = gw; it < NB * NH * SEQ; it += NGW) { const int s = it & 2047, bh = it >> 11, b = bh >> 4, h = bh & 15;
        const bf16_t* qp = Qn + ((size_t)bh * SEQ + s) * DQK;
#pragma unroll
        for (int q = 0; q < 3; ++q) ql[lane + 64 * q] = bf2f(qp[lane + 64 * q]);
        LDS_WAIT();
        const int nk = 64 * ((s >> 6) + 1);
        float o0 = 0.f, o1 = 0.f, l = 0.f;
        for (int k0 = 0; k0 < nk; k0 += 64) {
            const bf16_t* kp = Kn + ((size_t)bh * SEQ + k0 + lane) * DQK; float sc = 0.f;
            for (int d = 0; d < DQK; d += 8) { const u32x4 w = *(const u32x4*)(kp + d);
#pragma unroll
                for (int q = 0; q < 4; ++q) sc += bflo(w[q]) * ql[d + 2 * q] + bfhi(w[q]) * ql[d + 2 * q + 1]; }
            const float pr = __builtin_amdgcn_exp2f(sc - Mb); l += pr;
            for (int kk = 0; kk < 64; ++kk) { const float pk = __shfl(pr, kk); const unsigned w = *(const unsigned*)(Vn + ((size_t)bh * SEQ + k0 + kk) * DV + 2 * lane);
                o0 += pk * bflo(w); o1 += pk * bfhi(w); }
        }
        l = wave_sum(l); const float rl = 1.0f / l;
        *(unsigned*)(O + ((size_t)(b * SEQ + s)) * DM + h * DV + 2 * lane) = pk2(o0 * rl, o1 * rl);
        LDS_WAIT();
    }
}

namespace at {
constexpr int KVB = 64;
constexpr int SHM_V = KVB * DV * 2  , SHM_K = KVB * DQK * 2  ;
constexpr int NQR = 4;
constexpr int OFF_V = 0, OFF_K = 2 * SHM_V, OFF_WS = OFF_K + 2 * SHM_K  , OFF_QL = OFF_WS + NWAVES * 256  , OFF_OST = 0;
constexpr int OPITCH = 272;
static_assert(OFF_QL + NWAVES * (12 - NQR) * 1024 <= LDSCTL_OFF, "attention LDS map");
#define KSWZ(row, colB) ((row) * 384 + ((colB) ^ (((row) & 7) << 4)))
__device__ __forceinline__ int crow(int r, int hi) { return (r & 3) + 8 * (r >> 2) + 4 * hi; }
__device__ __forceinline__ int v_st(int k, int c) { const int kk = (k & ~0xC) | ((k & 4) << 1) | ((k & 8) >> 1); return ((kk >> 3) * 4 + (c >> 5)) * 512 + ((kk & 7) * 32 + (c & 31)) * 2; }
__device__ __forceinline__ int v_rd_base(int lane) { return ((lane & 3) << 3) | (((lane >> 2) & 3) << 6) | (((lane >> 4) & 1) << 5) | (((lane >> 5) & 1) << 8); }
constexpr int v_rd_off(int d0, int ks, int half) { return d0 * 512 + ks * 4096 + half * 2048; }
template <int OFF> __device__ __forceinline__ s16x4 tr_read(int vb) { s16x4 r; asm volatile("ds_read_b64_tr_b16 %0, %1 offset:%2" : "=&v"(r) : "v"(vb), "i"(OFF) : "memory"); return r; }
template <int D0> __device__ __forceinline__ void pv_one(f32x16& od, int vb, bf16x8 pa0, bf16x8 pa1, bf16x8 pa2, bf16x8 pa3) {
    const s16x4 l0 = tr_read<v_rd_off(D0, 0, 0)>(vb), h0 = tr_read<v_rd_off(D0, 0, 1)>(vb), l1 = tr_read<v_rd_off(D0, 1, 0)>(vb), h1 = tr_read<v_rd_off(D0, 1, 1)>(vb);
    const s16x4 l2 = tr_read<v_rd_off(D0, 2, 0)>(vb), h2 = tr_read<v_rd_off(D0, 2, 1)>(vb), l3 = tr_read<v_rd_off(D0, 3, 0)>(vb), h3 = tr_read<v_rd_off(D0, 3, 1)>(vb);
    asm volatile("s_waitcnt lgkmcnt(0)" ::: "memory"); SBAR();
#define PK(L, H) (bf16x8){L[0], L[1], L[2], L[3], H[0], H[1], H[2], H[3]}
    od = __builtin_amdgcn_mfma_f32_32x32x16_bf16(pa0, PK(l0, h0), od, 0, 0, 0);
    od = __builtin_amdgcn_mfma_f32_32x32x16_bf16(pa1, PK(l1, h1), od, 0, 0, 0);
    od = __builtin_amdgcn_mfma_f32_32x32x16_bf16(pa2, PK(l2, h2), od, 0, 0, 0);
    od = __builtin_amdgcn_mfma_f32_32x32x16_bf16(pa3, PK(l3, h3), od, 0, 0, 0);
#undef PK
}
__device__ __forceinline__ void pv_d0(f32x16* o, int vb, bf16x8 pa0, bf16x8 pa1, bf16x8 pa2, bf16x8 pa3) {
    pv_one<0>(o[0], vb, pa0, pa1, pa2, pa3); pv_one<1>(o[1], vb, pa0, pa1, pa2, pa3); pv_one<2>(o[2], vb, pa0, pa1, pa2, pa3); pv_one<3>(o[3], vb, pa0, pa1, pa2, pa3);
}
template <int BUF, int NQR> __device__ __forceinline__ void qkt(f32x16& p0, f32x16& p1, const int (&kb)[4], const bf16x8* qr, int qlb) {
    p0 = f32x16{}; p1 = f32x16{};
#pragma unroll
    for (int a = 0; a < 3; ++a)
#pragma unroll
        for (int b = 0; b < 4; ++b) { const int d0 = 4 * a + b;
            const bf16x8 b0 = *(const LAS bf16x8*)(kb[b] + BUF * SHM_K + a * 128);
            const bf16x8 b1 = *(const LAS bf16x8*)(kb[b] + BUF * SHM_K + a * 128 + 32 * 384);
            bf16x8 q; if (d0 < NQR) q = qr[d0]; else q = *(const LAS bf16x8*)(qlb + (d0 - NQR) * 1024);
            p0 = __builtin_amdgcn_mfma_f32_32x32x16_bf16(b0, q, p0, 0, 0, 0);
            p1 = __builtin_amdgcn_mfma_f32_32x32x16_bf16(b1, q, p1, 0, 0, 0); }
}
__device__ __forceinline__ void partialSM(f32x16& p0, f32x16& p1, float bias) {
#pragma unroll
    for (int r = 0; r < 16; ++r) p0[r] = __builtin_amdgcn_exp2f(p0[r] + bias);
#pragma unroll
    for (int r = 0; r < 16; ++r) p1[r] = p1[r] + bias;
}
__device__ __forceinline__ void finishSM(f32x16& p0, f32x16& p1, float& l_reg, bf16x8& pa0, bf16x8& pa1, bf16x8& pa2, bf16x8& pa3) {
#pragma unroll
    for (int r = 0; r < 16; ++r) p1[r] = __builtin_amdgcn_exp2f(p1[r]);
    float ps = 0;
#pragma unroll
    for (int r = 0; r < 16; ++r) ps += p0[r];
#pragma unroll
    for (int r = 0; r < 16; ++r) ps += p1[r];
    { auto rr = __builtin_amdgcn_permlane32_swap(__float_as_uint(ps), __float_as_uint(ps), false, false); ps = __uint_as_float(rr[0]) + __uint_as_float(rr[1]); }
    l_reg += ps;
#define PK4(P, BASE, OUT) do { unsigned a0 = cvt_pk_bf16(P[BASE + 0], P[BASE + 1]), a1 = cvt_pk_bf16(P[BASE + 2], P[BASE + 3]);   \
    unsigned b0 = cvt_pk_bf16(P[BASE + 4], P[BASE + 5]), b1 = cvt_pk_bf16(P[BASE + 6], P[BASE + 7]);                              \
    auto r0 = __builtin_amdgcn_permlane32_swap(a0, b0, false, false); auto r1 = __builtin_amdgcn_permlane32_swap(a1, b1, false, false); \
    u32x4 w = {r0[0], r1[0], r0[1], r1[1]}; OUT = *reinterpret_cast<bf16x8*>(&w); } while (0)
    PK4(p0, 0, pa0); PK4(p0, 8, pa1); PK4(p1, 0, pa2); PK4(p1, 8, pa3);
#undef PK4
}
__device__ __forceinline__ void attn_qblock(const bf16_t* __restrict__ Qb, const bf16_t* __restrict__ Kh, const bf16_t* __restrict__ Vh, bf16_t* __restrict__ Ob, int qb, float Mb, LAS char* lds) {
    const int tid = threadIdx.x, wid = __builtin_amdgcn_readfirstlane(tid >> 6), lane = tid & 63, r32 = lane & 31, hi = lane >> 5;
    LAS char* V_lds = lds + OFF_V; LAS char* K_lds = lds + OFF_K;
    LAS float* li_l = (LAS float*)(lds + OFF_WS) + wid * 64;
    float l_reg = 0; f32x16 o[4] = {}; bf16x8 qr[NQR];
    const bf16_t* Qw = Qb + (size_t)(wid * 32 + r32) * DQK + hi * 8;
    const int qlb = (int)(uintptr_t)(lds + OFF_QL) + wid * ((12 - NQR) * 1024) + lane * 16;
#pragma unroll
    for (int d0 = 0; d0 < NQR; ++d0) qr[d0] = *(const bf16x8*)(Qw + d0 * 16);
#pragma unroll
    for (int d0 = NQR; d0 < 12; ++d0) *(LAS bf16x8*)(qlb + (d0 - NQR) * 1024) = *(const bf16x8*)(Qw + d0 * 16);
    const int sr = tid >> 4, sc = (tid & 15) * 8, vst0 = v_st(sr, sc), vst1 = v_st(32 + sr, sc);
    int kro[3], kst[3];
#pragma unroll
    for (int i = 0; i < 3; ++i) { const int q = tid + 512 * i, row = q / 24, c8 = q % 24; kro[i] = row * DQK + c8 * 8; kst[i] = KSWZ(row, c8 * 16); }
    const int vb0 = (int)(uintptr_t)V_lds + v_rd_base(lane);
    int kb[4];
#pragma unroll
    for (int b = 0; b < 4; ++b) kb[b] = (int)(uintptr_t)K_lds + r32 * 384 + ((b * 32 + hi * 16) ^ ((r32 & 7) << 4));
    bf16x8 vs0, vs1, ks0, ks1, ks2;
#define SLOAD(k0) do { vs0 = *(const bf16x8*)(Vh + (size_t)((k0) + sr) * DV + sc); vs1 = *(const bf16x8*)(Vh + (size_t)((k0) + 32 + sr) * DV + sc); \
    ks0 = *(const bf16x8*)(Kh + (size_t)(k0) * DQK + kro[0]); ks1 = *(const bf16x8*)(Kh + (size_t)(k0) * DQK + kro[1]); ks2 = *(const bf16x8*)(Kh + (size_t)(k0) * DQK + kro[2]); } while (0)
#define SWRITE(b) do { *(LAS bf16x8*)(V_lds + (b) * SHM_V + vst0) = vs0; *(LAS bf16x8*)(V_lds + (b) * SHM_V + vst1) = vs1; \
    *(LAS bf16x8*)(K_lds + (b) * SHM_K + kst[0]) = ks0; *(LAS bf16x8*)(K_lds + (b) * SHM_K + kst[1]) = ks1; *(LAS bf16x8*)(K_lds + (b) * SHM_K + kst[2]) = ks2; } while (0)
    const int NT = 4 * qb + 4, jmax = 4 * qb + (wid >> 1);
    const float NEG_INF = -__builtin_inff();
#define BIAS(j) (((j) <= jmax) ? -Mb : NEG_INF)
    f32x16 pA0, pA1, pB0, pB1; bf16x8 pa0, pa1, pa2, pa3;
    SLOAD(0); asm volatile("s_waitcnt vmcnt(0)" ::: "memory"); SWRITE(0); __syncthreads();
    qkt<0, NQR>(pA0, pA1, kb, qr, qlb); partialSM(pA0, pA1, BIAS(0));
    SLOAD(KVB); asm volatile("s_waitcnt vmcnt(0)" ::: "memory"); SWRITE(1); __syncthreads();
    for (int j = 1; j + 1 < NT; j += 2) {
        SBAR(); qkt<1, NQR>(pB0, pB1, kb, qr, qlb);
        finishSM(pA0, pA1, l_reg, pa0, pa1, pa2, pa3); SBAR();
        SLOAD((j + 1) * KVB); SBAR();
        pv_d0(o, vb0, pa0, pa1, pa2, pa3); partialSM(pB0, pB1, BIAS(j));
        __syncthreads(); asm volatile("s_waitcnt vmcnt(0)" ::: "memory"); SWRITE(0);
        __syncthreads();
        SBAR(); qkt<0, NQR>(pA0, pA1, kb, qr, qlb);
        finishSM(pB0, pB1, l_reg, pa0, pa1, pa2, pa3); SBAR();
        SLOAD((j + 2) * KVB); SBAR();
        pv_d0(o, vb0 + SHM_V, pa0, pa1, pa2, pa3); partialSM(pA0, pA1, BIAS(j + 1));
        __syncthreads(); asm volatile("s_waitcnt vmcnt(0)" ::: "memory"); SWRITE(1);
        __syncthreads();
    }
    SBAR(); qkt<1, NQR>(pB0, pB1, kb, qr, qlb);
    finishSM(pA0, pA1, l_reg, pa0, pa1, pa2, pa3); SBAR();
    pv_d0(o, vb0, pa0, pa1, pa2, pa3); partialSM(pB0, pB1, BIAS(NT - 1));
    finishSM(pB0, pB1, l_reg, pa0, pa1, pa2, pa3); SBAR();
    pv_d0(o, vb0 + SHM_V, pa0, pa1, pa2, pa3);
    __syncthreads();
    int tz = threadIdx.x; asm volatile("" : "+v"(tz));
    const int lane2 = tz & 63, r32b = lane2 & 31, hib = lane2 >> 5, wid2 = __builtin_amdgcn_readfirstlane(tz >> 6);
    LAS float* li2 = (LAS float*)(lds + OFF_WS) + wid2 * 64;
    if (hib == 0) li2[r32b] = l_reg; LDS_WAIT();
    LAS char* ost = lds + OFF_OST + wid2 * (32 * OPITCH) + hib * (4 * OPITCH) + r32b * 2;
#pragma unroll
    for (int r = 0; r < 16; ++r) { const int orc = (r & 3) + 8 * (r >> 2); const float rl = __builtin_amdgcn_rcpf(li2[orc + 4 * hib]);
#pragma unroll
        for (int d0 = 0; d0 < 4; ++d0) *(LAS bf16_t*)(ost + orc * OPITCH + d0 * 64) = (bf16_t)f2bf(o[d0][r] * rl); }
    LDS_WAIT();
    bf16_t* Ow = Ob + (size_t)(wid2 * 32 + (lane2 >> 4)) * DM + (lane2 & 15) * 8;
    const LAS char* ord = lds + OFF_OST + wid2 * (32 * OPITCH) + (lane2 >> 4) * OPITCH + (lane2 & 15) * 16;
#pragma unroll
    for (int i = 0; i < 8; ++i) { const u32x4 w = *(const LAS u32x4*)(ord + i * 4 * OPITCH); *(u32x4*)(Ow + (size_t)(i * 4) * DM) = w; }
    __syncthreads();
#undef SLOAD
#undef SWRITE
#undef BIAS
}
#undef KSWZ
}
__device__ __forceinline__ void p4_attention(const Args& a, const Frame& F) {
    const bf16_t* Qn = (const bf16_t*)(F.ws + WS_QN); const bf16_t* Kn = (const bf16_t*)(F.ws + WS_KN); const bf16_t* Vn = (const bf16_t*)(F.ws + WS_VN);
    bf16_t* O = (bf16_t*)(F.ws + WS_O);
    const float Mb = attn_bound(a, F.lane);
    for (int id = F.bx; id < NB * NH * 4; id += F.G) { const int x = id & 7, idx = id >> 3, bh = x + 8 * (idx >> 2), pr = idx & 3, b = bh >> 4, h = bh & 15;
        const bf16_t* Kh = Kn + (size_t)bh * SEQ * DQK; const bf16_t* Vh = Vn + (size_t)bh * SEQ * DV;
#pragma unroll 1
        for (int w = 0; w < 2; ++w) { const int qb = w ? pr : 7 - pr;
            at::attn_qblock(Qn + ((size_t)bh * SEQ + qb * 256) * DQK, Kh, Vh, O + ((size_t)(b * SEQ + qb * 256)) * DM + h * DV, qb, Mb, (LAS char*)F.lds); }
    }
}

__device__ __forceinline__ void p8_norm2_router(const Args& a, const Frame& F, const float* x1) {
    bf16_t* H2 = (bf16_t*)(F.ws + WS_H2); int* topi = (int*)(F.ws + WS_TOPI); float* topw = (float*)(F.ws + WS_TOPW);
    const float* wr_ = a.in[I_WR]; const float* g2 = a.in[I_N2G];
    const int lane = F.lane, gw = F.bx * NWAVES + F.wave, NGW = F.G * NWAVES;
    for (int t = gw; t < TT; t += NGW) {
        const f32x4* xr = (const f32x4*)(x1 + (size_t)t * DM) + lane; const f32x4* gr = (const f32x4*)g2 + lane;
        f32x4 v[8]; float s = 0.f;
#pragma unroll
        for (int j = 0; j < 8; ++j) { v[j] = xr[64 * j]; s += (v[j].x * v[j].x + v[j].y * v[j].y) + (v[j].z * v[j].z + v[j].w * v[j].w); }
        const float rstd = 1.0f / sqrtf(wave_sum(s) * (1.0f / DM) + EPS);
        unsigned long long* o8 = (unsigned long long*)(H2 + (size_t)t * DM) + lane;
        float lg[32];
#pragma unroll
        for (int e = 0; e < 32; ++e) lg[e] = 0.f;
#pragma unroll
        for (int j = 0; j < 8; ++j) { const f32x4 gg = gr[64 * j]; f32x4 hv; hv.x = v[j].x * rstd * gg.x; hv.y = v[j].y * rstd * gg.y; hv.z = v[j].z * rstd * gg.z; hv.w = v[j].w * rstd * gg.w;
            o8[64 * j] = (unsigned long long)pk2(hv.x, hv.y) | ((unsigned long long)pk2(hv.z, hv.w) << 32);
            const float* wp = wr_ + (size_t)(256 * j + 4 * lane) * NE;
#pragma unroll
            for (int q = 0; q < 4; ++q) { const float hq = hv[q];
#pragma unroll
                for (int e4 = 0; e4 < 8; ++e4) { const f32x4 w = *(const f32x4*)(wp + q * NE + e4 * 4); lg[e4 * 4] += hq * w.x; lg[e4 * 4 + 1] += hq * w.y; lg[e4 * 4 + 2] += hq * w.z; lg[e4 * 4 + 3] += hq * w.w; } } }
#pragma unroll
        for (int e = 0; e < 32; ++e) lg[e] = wave_sum(lg[e]) + a.in[I_BR][e];
        if (lane == 0) { int bi[4]; float bv[4];
#pragma unroll
            for (int k = 0; k < 4; ++k) { float m = -3.0e38f; int mi = 0;
#pragma unroll
                for (int e = 0; e < 32; ++e) { const bool used = (k > 0 && bi[0] == e) || (k > 1 && bi[1] == e) || (k > 2 && bi[2] == e); if (!used && lg[e] > m) { m = lg[e]; mi = e; } }
                bi[k] = mi; bv[k] = m; }
            const float e0 = 1.0f, e1 = __expf(bv[1] - bv[0]), e2 = __expf(bv[2] - bv[0]), e3 = __expf(bv[3] - bv[0]); const float rs = 1.0f / (e0 + e1 + e2 + e3);
            *(int4*)(topi + 4 * t) = make_int4(bi[0], bi[1], bi[2], bi[3]); *(float4*)(topw + 4 * t) = make_float4(e0 * rs, e1 * rs, e2 * rs, e3 * rs); }
    }
}

__device__ __forceinline__ void p9_routing(const Args& a, const Frame& F) {
    const int* topi = (const int*)(F.ws + WS_TOPI); int* tpos = (int*)(F.ws + WS_TPOS); int* list = (int*)(F.ws + WS_LIST); int* counts = (int*)(F.ws + WS_SMALL + SM_COUNTS);
    LAS int* wtot = (LAS int*)F.lds;
    for (int e = F.bx; e < NE; e += F.G) {
        __syncthreads();
        const int t0 = F.wave * (TT / NWAVES);
        int cnt = 0;
        for (int i = 0; i < TT / NWAVES / 64; ++i) { const int4 ti = *(const int4*)(topi + 4 * (t0 + i * 64 + F.lane));
            const bool hit = (ti.x == e) | (ti.y == e) | (ti.z == e) | (ti.w == e); cnt += __popcll(__ballot(hit)); }
        if (F.lane == 0) wtot[F.wave] = cnt;
        __syncthreads();
        int base = 0, total = 0;
        for (int w = 0; w < NWAVES; ++w) { const int c = wtot[w]; if (w < F.wave) base += c; total += c; }
        for (int i = 0; i < TT / NWAVES / 64; ++i) { const int t = t0 + i * 64 + F.lane; const int4 ti = *(const int4*)(topi + 4 * t);
            const int k = (ti.x == e) ? 0 : (ti.y == e) ? 1 : (ti.z == e) ? 2 : (ti.w == e) ? 3 : -1;
            const unsigned long long bal = __ballot(k >= 0); const int pos = base + __popcll(bal & ((1ull << F.lane) - 1ull));
            if (k >= 0) { list[(size_t)e * TT + pos] = t; tpos[4 * t + k] = pos; }
            base += __popcll(bal); }
        if (F.tid == 0) counts[e] = total;
    }
}
__device__ __forceinline__ void moe_tables(const Frame& F, LAS int* tab) {
    const int* counts = (const int*)(F.ws + WS_SMALL + SM_COUNTS);
    __syncthreads();
    if (F.tid == 0) { int pre = 0; for (int e = 0; e < NE; ++e) { const int c = counts[e]; tab[e] = c; const int nt = (c + 255) >> 8; tab[32 + e] = nt; tab[64 + e] = pre; pre += nt; } tab[96] = pre; }
    __syncthreads();
}

__device__ __forceinline__ void p12_combine(const Args& a, const Frame& F, float* out, const LAS int* tab) {
    const bf16_t* ys = (const bf16_t*)(F.ws + WS_YSLOT); const int* topi = (const int*)(F.ws + WS_TOPI); const float* topw = (const float*)(F.ws + WS_TOPW); const int* tpos = (const int*)(F.ws + WS_TPOS);
    const int lane = F.lane, gw = F.bx * NWAVES + F.wave, NGW = F.G * NWAVES;
    for (int t = gw; t < TT; t += NGW) {
        const int4 ti = *(const int4*)(topi + 4 * t), tp = *(const int4*)(tpos + 4 * t); const float4 tw = *(const float4*)(topw + 4 * t);
        const bf16_t* r0 = ys + ((size_t)tab[64 + ti.x] * 256 + tp.x) * DM; const bf16_t* r1 = ys + ((size_t)tab[64 + ti.y] * 256 + tp.y) * DM;
        const bf16_t* r2 = ys + ((size_t)tab[64 + ti.z] * 256 + tp.z) * DM; const bf16_t* r3 = ys + ((size_t)tab[64 + ti.w] * 256 + tp.w) * DM;
        float* orow = out + (size_t)t * DM;
#pragma unroll
        for (int j = 0; j < 4; ++j) { const int c = j * 512 + lane * 8;
            const u32x4 a0 = *(const u32x4*)(r0 + c), a1 = *(const u32x4*)(r1 + c), a2 = *(const u32x4*)(r2 + c), a3 = *(const u32x4*)(r3 + c);
            f32x4 x0 = *(const f32x4*)(orow + c), x1 = *(const f32x4*)(orow + c + 4);
#pragma unroll
            for (int q = 0; q < 2; ++q) {
                x0[2 * q] += tw.x * bflo(a0[q]) + tw.y * bflo(a1[q]) + tw.z * bflo(a2[q]) + tw.w * bflo(a3[q]);
                x0[2 * q + 1] += tw.x * bfhi(a0[q]) + tw.y * bfhi(a1[q]) + tw.z * bfhi(a2[q]) + tw.w * bfhi(a3[q]);
                x1[2 * q] += tw.x * bflo(a0[2 + q]) + tw.y * bflo(a1[2 + q]) + tw.z * bflo(a2[2 + q]) + tw.w * bflo(a3[2 + q]);
                x1[2 * q + 1] += tw.x * bfhi(a0[2 + q]) + tw.y * bfhi(a1[2 + q]) + tw.z * bfhi(a2[2 + q]) + tw.w * bfhi(a3[2 + q]); }
            *(f32x4*)(orow + c) = x0; *(f32x4*)(orow + c + 4) = x1; }
    }
}

constexpr int NPHASE = 13;
__global__ void __launch_bounds__(NTHREADS, 2) mk_fwd(Args a) {
    extern __shared__ __attribute__((aligned(16))) uchar lds_raw[];
    Frame F; F.lds = (LAS uchar*)lds_raw; F.ws = a.ws; F.tid = threadIdx.x; F.lane = F.tid & 63; F.wave = __builtin_amdgcn_readfirstlane(F.tid >> 6); F.G = gridDim.x; F.bx = blockIdx.x;
    volatile LAS unsigned* MISC = (volatile LAS unsigned*)(F.lds + MISC_OFF);
    LAS int* tab = (LAS int*)(F.lds + LDSCTL_OFF + 512);
    for (int u = F.tid; u < (LDS_BYTES - LDSCTL_OFF) / 4; u += NTHREADS) ((LAS unsigned*)(F.lds + LDSCTL_OFF))[u] = 0u;
    __syncthreads();
    XcdBarrier bar; bar.bar = (unsigned*)(a.ws + WS_CTL) + CW_BAR; bar.x = 0; bar.st = nullptr;
    const int lo = a.ph_lo, hi = a.ph_hi;
    if (hi - lo > 1) bar = xcd_barrier_post((unsigned*)(a.ws + WS_CTL) + CW_BAR, MISC + 8);
#ifndef MK_PHASE_MASK
#define MK_PHASE_MASK 0xffff
#endif
#define IN(k) (((MK_PHASE_MASK >> (k)) & 1) && lo <= (k) && (k) < hi)
#define SEAM(k) do { if (IN(k) && IN((k) + 1)) xcd_barrier(bar); } while (0)
    LAS uchar* ring = F.lds;
    uchar* ws = a.ws;
    const int G = F.G, bx = F.bx;

    if (IN(0)) { p0_prologue(a, F); } SEAM(0);

    if (IN(1)) {
        gm::ProbDense P; P.init((const bf16_t*)(ws + WS_H), DM, (const bf16_t*)(ws + WS_WIN), DM, DM, TT, NPROJ, G, bx);
        EpiInProj E{(bf16_t*)(ws + WS_PROJ), (bf16_t*)(ws + WS_APACK), a.in[I_BG]};
        gm::gemm_phase<gm::ProbDense, EpiInProj, false>(ring, P, E);
    } SEAM(1);

    if (IN(2)) {
        { gm::ProbDense P; P.init((const bf16_t*)(ws + WS_PROJ) + C_QLAT, NPROJ, (const bf16_t*)(ws + WS_WUQ), QLORA, QLORA, TT, NH * DQK, G, bx);
          EpiStoreBf16 E{(bf16_t*)(ws + WS_QRAW), NH * DQK}; gm::gemm_phase<gm::ProbDense, EpiStoreBf16, false>(ring, P, E); }
        { gm::ProbDense P; P.init((const bf16_t*)(ws + WS_PROJ) + C_KVLAT, NPROJ, (const bf16_t*)(ws + WS_WUKV), KVLORA, KVLORA, TT, NH * 256, G, bx);
          EpiStoreBf16 E{(bf16_t*)(ws + WS_KVRAW), NH * 256}; gm::gemm_phase<gm::ProbDense, EpiStoreBf16, false>(ring, P, E); }
#if MK_FAST_S5
        { ProbS5 P{(const bf16_t*)(ws + WS_APACK), (const bf16_t*)(ws + WS_WS5), APK, 256, 4, G, bx};
          EpiS5State E{(float*)(ws + WS_SCH)}; gm::gemm_phase<ProbS5, EpiS5State, false>(ring, P, E); }
#endif
    } SEAM(2);

    if (IN(3)) {
        p3_prep(a, F);
#if MK_FAST_S5
        p3_scan(a, F);
#endif
    } SEAM(3);

    if (IN(4)) {
#if MK_FAST_S5
        { ProbS5 P{(const bf16_t*)(ws + WS_APACK), (const bf16_t*)(ws + WS_TWC), APK, APK, 6, G, bx};
          EpiS5Out E{(bf16_t*)(ws + WS_GACT)}; gm::gemm_phase<ProbS5, EpiS5Out, false>(ring, P, E); }
#else
        s5_reference(a, F);
#endif
#if MK_FAST_ATTN
        p4_attention(a, F);
#else
        attn_reference(a, F);
#endif
    } SEAM(4);

    if (IN(5)) {
        { gm::ProbDense P; P.init((const bf16_t*)(ws + WS_GACT), S5W, (const bf16_t*)(ws + WS_WGLU), S5W, S5W, TT, S5W, G, bx);
          EpiSide<0> E{(bf16_t*)(ws + WS_Y2), S5W, (const bf16_t*)(ws + WS_GACT), S5W, nullptr, 0}; gm::gemm_phase<gm::ProbDense, EpiSide<0>, false>(ring, P, E); }
        { gm::ProbDense P; P.init((const bf16_t*)(ws + WS_O), DM, (const bf16_t*)(ws + WS_WOMLA), DM, DM, TT, DM, G, bx);
          EpiSide<1> E{(bf16_t*)(ws + WS_MA), DM, (const bf16_t*)(ws + WS_PROJ) + C_GA, NPROJ, nullptr, 0}; gm::gemm_phase<gm::ProbDense, EpiSide<1>, false>(ring, P, E); }
    } SEAM(5);

    if (IN(6)) {
        gm::ProbDense P; P.init((const bf16_t*)(ws + WS_Y2), S5W, (const bf16_t*)(ws + WS_WOS5), S5W, S5W, TT, DM, G, bx);
        EpiSide<2> E{(bf16_t*)(ws + WS_M), DM, (const bf16_t*)(ws + WS_PROJ) + C_GB, NPROJ, (const bf16_t*)(ws + WS_MA), DM}; gm::gemm_phase<gm::ProbDense, EpiSide<2>, false>(ring, P, E);
    } SEAM(6);

    if (IN(7)) {
        gm::ProbDense P; P.init((const bf16_t*)(ws + WS_M), DM, (const bf16_t*)(ws + WS_WOUT), DM, DM, TT, DM, G, bx);
        EpiResidF32 E{a.in[I_X], a.out}; gm::gemm_phase<gm::ProbDense, EpiResidF32, false>(ring, P, E);
    } SEAM(7);

    if (IN(8)) { p8_norm2_router(a, F, a.out); } SEAM(8);
    if (IN(9)) { p9_routing(a, F); } SEAM(9);

    if (IN(10) || IN(11) || IN(12)) moe_tables(F, tab);
    const int xl = bx & 7, rk = bx >> 3, nrk = (G - xl + 7) >> 3;
    if (IN(10)) {
        ProbMoE P{(const bf16_t*)(ws + WS_H2), (const bf16_t*)(ws + WS_W1), DM, DM, DM / 64, 16, (size_t)4096 * DM, (const int*)(ws + WS_LIST), tab, xl, rk, nrk};
        EpiSwiglu E{(bf16_t*)(ws + WS_HACT), a.in[I_BGATE], a.in[I_BUP], tab}; gm::gemm_phase<ProbMoE, EpiSwiglu, true>(ring, P, E);
    } SEAM(10);
    if (IN(11)) {
        ProbMoE P{(const bf16_t*)(ws + WS_HACT), (const bf16_t*)(ws + WS_W2), DFF, DFF, DFF / 64, 8, (size_t)DM * DFF, nullptr, tab, xl, rk, nrk};
        EpiDown E{(bf16_t*)(ws + WS_YSLOT), a.in[I_BDOWN], tab}; gm::gemm_phase<ProbMoE, EpiDown, false>(ring, P, E);
    } SEAM(11);
    if (IN(12)) { p12_combine(a, F, a.out, tab); }
#undef IN
#undef SEAM
}

extern "C" void kernel_launch(void* const* d_in, const int* in_sizes, int n_in, void* d_out, int out_size, void* d_ws, size_t ws_size, hipStream_t stream) {
    static int grid = 0;
    if (grid == 0) {
        if (n_in != 32 || in_sizes[0] != TT * DM || out_size != TT * DM || ws_size < WS_END) {
            fprintf(stderr, "kernel_launch: shape mismatch: n_in %d in0 %d out %d ws %zu (need %zu); nothing launched\n", n_in, n_in > 0 ? in_sizes[0] : -1, out_size, ws_size, (size_t)WS_END); grid = -1; return; }
        int dev = 0, cus = 0, per_cu = 0;
        if (hipGetDevice(&dev) != hipSuccess || hipDeviceGetAttribute(&cus, hipDeviceAttributeMultiprocessorCount, dev) != hipSuccess) { fprintf(stderr, "kernel_launch: device query failed\n"); grid = -1; return; }
        if (hipFuncSetAttribute((const void*)mk_fwd, hipFuncAttributeMaxDynamicSharedMemorySize, LDS_BYTES) != hipSuccess) { fprintf(stderr, "kernel_launch: hipFuncSetAttribute failed\n"); grid = -1; return; }
        if (hipOccupancyMaxActiveBlocksPerMultiprocessor(&per_cu, (const void*)mk_fwd, NTHREADS, LDS_BYTES) != hipSuccess || per_cu < 1)
            fprintf(stderr, "kernel_launch: note: occupancy query reports %d workgroups per CU\n", per_cu);
        (void)hipGetLastError();
        grid = cus - (cus % 8);
        if (grid < 8) grid = 8;
    }
    if (grid < 0) return;
    if (hipMemsetAsync((char*)d_ws + WS_CTL, 0, CTL_ZERO_BYTES, stream) != hipSuccess) { fprintf(stderr, "kernel_launch: memset failed\n"); return; }
    Args a{};
    for (int i = 0; i < 32; ++i) a.in[i] = (const float*)d_in[i];
    a.out = (float*)d_out; a.ws = (uchar*)d_ws;
#if MK_ONE_LAUNCH
    a.ph_lo = 0; a.ph_hi = NPHASE;
    hipLaunchKernelGGL(mk_fwd, dim3(grid), dim3(NTHREADS), LDS_BYTES, stream, a);
#else
    for (int p = 0; p < NPHASE; ++p) { a.ph_lo = p; a.ph_hi = p + 1; hipLaunchKernelGGL(mk_fwd, dim3(grid), dim3(NTHREADS), LDS_BYTES, stream, a); }
#endif
    const hipError_t le = hipPeekAtLastError();
    if (le != hipSuccess) fprintf(stderr, "kernel_launch: launch failed: %s\n", hipGetErrorName(le));
}
```

```cpp
#include <hip/hip_runtime.h>
#include <cstdio>
#include <cstdint>

#ifndef MK_ONE_LAUNCH
#define MK_ONE_LAUNCH 1
#endif
#ifndef MK_FAST_GEMM
#define MK_FAST_GEMM 1
#endif
#ifndef MK_FAST_ATTN
#define MK_FAST_ATTN 1
#endif
#ifndef MK_FAST_S5
#define MK_FAST_S5 1
#endif

#ifndef MK_FP8_MOE
#define MK_FP8_MOE 1
#endif
#define LAS __attribute__((address_space(3)))
#define GAS __attribute__((address_space(1)))
typedef unsigned short bf16_t;
typedef short bf16x8 __attribute__((ext_vector_type(8)));
typedef short s16x4 __attribute__((ext_vector_type(4)));
typedef float f32x2 __attribute__((ext_vector_type(2)));
typedef float f32x4 __attribute__((ext_vector_type(4)));
typedef float f32x16 __attribute__((ext_vector_type(16)));
typedef unsigned u32x2 __attribute__((ext_vector_type(2)));
typedef unsigned u32x4 __attribute__((ext_vector_type(4)));
typedef unsigned char uchar;
typedef int v4i __attribute__((ext_vector_type(4)));
typedef int v8i __attribute__((ext_vector_type(8)));
constexpr float FP8_ASCALE = 4.0f, FP8_WSCALE = 64.0f;
__device__ __forceinline__ unsigned pk4_fp8(float a, float b, float c, float d) { int w = __builtin_amdgcn_cvt_pk_fp8_f32(a, b, 0, false); w = __builtin_amdgcn_cvt_pk_fp8_f32(c, d, w, true); return (unsigned)w; }

constexpr int NB = 8, SEQ = 2048, TT = NB * SEQ, DM = 2048;
constexpr int NH = 16, DNOPE = 128, DROPE = 64, DQK = 192, DV = 128, QLORA = 512, KVLORA = 256;
constexpr int S5W = 1024, S5G = 64, S5C = 16, S5P = 64, S5L = 16;
constexpr int NE = 32, TOPK = 4, DFF = 2048;
constexpr int IN_PROJ = QLORA + KVLORA + DROPE + S5W + 2 * DM;
constexpr int NPROJ = 6144;
constexpr int C_QLAT = 0, C_KVLAT = 512, C_U = 768, C_GA = 1792, C_GB = 3840, C_KR = 5888;
constexpr float EPS = 1e-6f;
constexpr int MAXSLOT_TILES = (TT * TOPK) / 256 + NE;
constexpr int MAXSLOTS = MAXSLOT_TILES * 256;
constexpr int NCHUNK = TT / S5L;
constexpr int APK = 384;

constexpr size_t MiB = 1u << 20;
constexpr size_t WS_CTL = 0, CTL_ZERO_BYTES = 1 * MiB;
constexpr size_t WS_WIN = 1 * MiB;
constexpr size_t WS_WUQ = WS_WIN + 24 * MiB;
constexpr size_t WS_WUKV = WS_WUQ + 3 * MiB;
constexpr size_t WS_WOMLA = WS_WUKV + 2 * MiB;
constexpr size_t WS_WGLU = WS_WOMLA + 8 * MiB;
constexpr size_t WS_WOS5 = WS_WGLU + 2 * MiB;
constexpr size_t WS_WOUT = WS_WOS5 + 4 * MiB;
constexpr size_t WS_TWC = WS_WOUT + 8 * MiB;
constexpr size_t WS_WS5 = WS_TWC + 12 * MiB;
constexpr size_t WS_ROPE = WS_WS5 + 8 * MiB;
constexpr size_t WS_SMALL = WS_ROPE + 4 * MiB;
constexpr size_t WS_W1 = WS_SMALL + 1 * MiB;
constexpr size_t WS_W2 = WS_W1 + 512 * MiB;
constexpr size_t WS_ACT = WS_W2 + 256 * MiB;
constexpr size_t WS_H = WS_ACT;
constexpr size_t WS_PROJ = WS_H + 64 * MiB;
constexpr size_t WS_APACK = WS_PROJ + 192 * MiB;
constexpr size_t WS_SCH = WS_APACK + 48 * MiB;
constexpr size_t WS_QRAW = WS_SCH + 32 * MiB;
constexpr size_t WS_KVRAW = WS_QRAW + 96 * MiB;
constexpr size_t WS_QN = WS_KVRAW + 128 * MiB;
constexpr size_t WS_KN = WS_QN + 96 * MiB;
constexpr size_t WS_VN = WS_KN + 96 * MiB;
constexpr size_t WS_O = WS_VN + 64 * MiB;
constexpr size_t WS_GACT = WS_O + 64 * MiB;
constexpr size_t WS_Y2 = WS_GACT + 32 * MiB;
constexpr size_t WS_MA = WS_Y2 + 32 * MiB;
constexpr size_t WS_M = WS_MA + 64 * MiB;
constexpr size_t WS_ENDA = WS_M + 64 * MiB;
constexpr size_t WS_H2 = WS_ACT;
constexpr size_t WS_HACT = WS_H2 + 64 * MiB;
constexpr size_t WS_YSLOT = WS_HACT + 288 * MiB;
constexpr size_t WS_TOPI = WS_YSLOT + 288 * MiB;
constexpr size_t WS_TOPW = WS_TOPI + 1 * MiB;
constexpr size_t WS_TPOS = WS_TOPW + 1 * MiB;
constexpr size_t WS_LIST = WS_TPOS + 1 * MiB;
constexpr size_t WS_XPERM = WS_ACT + 704 * MiB;
constexpr size_t WS_ENDB = WS_XPERM + 288 * MiB;
constexpr size_t WS_END = WS_ENDA > WS_ENDB ? WS_ENDA : WS_ENDB;
constexpr size_t SM_A16 = 0;
constexpr size_t SM_COUNTS = 64 * 1024;
constexpr size_t SM_WRP = 128 * 1024;
constexpr int CW_BAR = 4096;

constexpr int RING_BYTES = 131072;
constexpr int LDS_BYTES = 163840;
constexpr int LDSCTL_OFF = LDS_BYTES - 4096;
constexpr int MISC_OFF = LDSCTL_OFF;
constexpr int GTAB_OFF = LDSCTL_OFF + 2048;
constexpr int NWAVES = 8, NTHREADS = 512;

#define LDS_WAIT() asm volatile("s_waitcnt lgkmcnt(0)" ::: "memory")
#define VM_WAIT() asm volatile("s_waitcnt vmcnt(0)" ::: "memory")
#define SBAR() __builtin_amdgcn_sched_barrier(0)

__device__ __forceinline__ unsigned f2bf(float f) { unsigned u = __builtin_bit_cast(unsigned, f); return (u + 0x7fffu + ((u >> 16) & 1u)) >> 16; }
__device__ __forceinline__ unsigned pk2(float lo, float hi) { return f2bf(lo) | (f2bf(hi) << 16); }
__device__ __forceinline__ float bf2f(unsigned b) { return __builtin_bit_cast(float, b << 16); }
__device__ __forceinline__ float bflo(unsigned w) { return __builtin_bit_cast(float, w << 16); }
__device__ __forceinline__ float bfhi(unsigned w) { return __builtin_bit_cast(float, w & 0xffff0000u); }
__device__ __forceinline__ unsigned cvt_pk_bf16(float lo, float hi) { unsigned r; asm volatile("v_cvt_pk_bf16_f32 %0, %1, %2" : "=v"(r) : "v"(lo), "v"(hi)); return r; }
__device__ __forceinline__ float sigmoidf_(float x) { return 1.0f / (1.0f + __expf(-x)); }
__device__ __forceinline__ float gelu_tanh(float x) {
    const float u = 0.7978845608028654f * (x + 0.044715f * x * x * x);
    const float e = __expf(2.0f * u);
    const float th = 1.0f - 2.0f / (e + 1.0f);
    return 0.5f * x * (1.0f + th);
}
__device__ __forceinline__ int fresh_lane() { int z = 0; asm volatile("" : "+s"(z)); return (int)__builtin_amdgcn_mbcnt_hi(~0u, __builtin_amdgcn_mbcnt_lo(~0u, (unsigned)z)); }
__device__ __forceinline__ float wave_sum(float v) {
#pragma unroll
    for (int o = 1; o < 64; o <<= 1) v += __shfl_xor(v, o);
    return v;
}

#define XB_TMO      128
#define XB_XCNT(j)  (256  + 64 * (j))
#define XB_XSUB(j)  (1280 + 64 * (j))
#define XB_XGEN(j)  (2304 + 64 * (j))
#define XB_TOP      3328
#define XB_TOPGEN   3392
#define XCD_BAR_WORDS 3456
#define XB_SPIN_CAP (1u << 18)
__device__ __forceinline__ unsigned xb_ld(unsigned* p)              { return __hip_atomic_load(p, __ATOMIC_RELAXED, __HIP_MEMORY_SCOPE_AGENT); }
__device__ __forceinline__ unsigned xb_add(unsigned* p, unsigned v) { return __hip_atomic_fetch_add(p, v, __ATOMIC_RELAXED, __HIP_MEMORY_SCOPE_AGENT); }
__device__ __forceinline__ unsigned xb_xcc_id() { return (unsigned)__builtin_amdgcn_s_getreg((3 << 11) | 20) & 0xFu; }
#define XB_SPIN(cond, bar) do { unsigned _sp = 0; while (cond) { __builtin_amdgcn_s_sleep(1); \
    if ((++_sp & 255u) == 0u) { if (xb_ld(&(bar)[XB_TMO])) break; if (_sp > XB_SPIN_CAP) { atomicAdd(&(bar)[XB_TMO], 1u); break; } } } } while (0)
struct XcdBarrier { unsigned* bar; unsigned x; volatile LAS unsigned* st; int wave; };
__device__ __forceinline__ XcdBarrier xcd_barrier_post(unsigned* bar, volatile LAS unsigned* st, int wave) {
    XcdBarrier b; b.bar = bar; b.x = xb_xcc_id(); b.st = st; b.wave = wave;
    if (wave == 0 && fresh_lane() == 0) (void)xb_add(&bar[XB_XCNT(b.x)], 1u);
    return b;
}
__device__ __forceinline__ void xcd_barrier_complete(unsigned* bar, unsigned x, unsigned& nloc, unsigned& nx) {
    const unsigned G = gridDim.x * gridDim.y * gridDim.z;
    unsigned sum, cnt, mine, sp = 0u;
    for (;;) {
        sum = 0u; cnt = 0u; mine = 0u;
#pragma unroll
        for (unsigned j = 0; j < 16; ++j) { const unsigned c = xb_ld(&bar[XB_XCNT(j)]); sum += c; cnt += (c > 0u) ? 1u : 0u; mine = (j == x) ? c : mine; }
        if (sum == G) break;
        __builtin_amdgcn_s_sleep(1);
        if ((++sp & 255u) == 0u) { if (xb_ld(&bar[XB_TMO])) break; if (sp > XB_SPIN_CAP) { atomicAdd(&bar[XB_TMO], 1u); break; } }
    }
    nloc = mine > 0u ? mine : 1u; nx = cnt > 0u ? cnt : 1u;
}
__device__ __forceinline__ void xcd_barrier(const XcdBarrier& b) {
    asm volatile("s_waitcnt vmcnt(0)" ::: "memory");
    __syncthreads();
    if (b.wave == 0 && fresh_lane() == 0) {
        unsigned* bar = b.bar;
        __builtin_amdgcn_s_waitcnt(0);
        unsigned nloc = b.st[0], nx = b.st[1];
        if (nloc == 0u) { xcd_barrier_complete(bar, b.x, nloc, nx); b.st[0] = nloc; b.st[1] = nx; }
        const unsigned old = xb_add(&bar[XB_XSUB(b.x)], 1u);
        const unsigned gen = old / nloc;
        if (old + 1u == (gen + 1u) * nloc) {
            __builtin_amdgcn_fence(__ATOMIC_RELEASE, "agent");
            asm volatile("s_waitcnt vmcnt(0)" ::: "memory");
            const unsigned og = xb_add(&bar[XB_TOP], 1u);
            const unsigned tg = og / nx;
            if (og + 1u == (tg + 1u) * nx) xb_add(&bar[XB_TOPGEN], 1u);
            else XB_SPIN(xb_ld(&bar[XB_TOPGEN]) == tg, bar);
            __builtin_amdgcn_fence(__ATOMIC_ACQUIRE, "agent");
            xb_add(&bar[XB_XGEN(b.x)], 1u);
            asm volatile("s_waitcnt vmcnt(0)" ::: "memory");
        } else {
            XB_SPIN(xb_ld(&bar[XB_XGEN(b.x)]) == gen, bar);
            __builtin_amdgcn_fence(__ATOMIC_ACQUIRE, "agent");
            asm volatile("s_waitcnt vmcnt(0)" ::: "memory");
        }
    }
    __syncthreads();
}

namespace gm {
constexpr int BM = 256, BK = 64, HALF = 128, HTB = HALF * BK * 2, STAGE_BYTES = 8 * HTB, NXCD = 8, WGM = 8;
__host__ __device__ __forceinline__ int lds_byte(int r, int c) { const int st = (r >> 4) * 2 + (c >> 5), rr = r & 15, cc = c & 31, ob = rr * 64 + cc * 2; return st * 1024 + (ob ^ (((ob >> 9) & 1) << 5)); }
__host__ __device__ __forceinline__ void stage_rc(int b, int& R, int& C) { const int st = b / 1024, sb = b % 1024, swz = sb ^ (((sb >> 9) & 1) << 5); R = (st >> 1) * 16 + swz / 64; C = (st & 1) * 32 + (swz % 64) / 2; }
__host__ __device__ __forceinline__ int perm32(int rho) { const int n = rho >> 4, i = rho & 15; return 8 * (i >> 2) + 4 * n + (i & 3); }

struct Unit { int pm, pn, g, st; };


struct ProbDense {
    const bf16_t* A; const bf16_t* B; int lda, ldb, nt; int nM, nN, nwg, G, c; const int* list = nullptr; const LAS int* gtab = nullptr;
    __device__ unsigned list_off(const Unit&) const { return 0u; }
    __device__ void init(const bf16_t* A_, int lda_, const bf16_t* B_, int ldb_, int K, int M, int N, int G_, int c_) { A = A_; B = B_; lda = lda_; ldb = ldb_; nt = K / BK; nM = M / BM; nN = N / BM; nwg = nM * nN; G = G_; c = c_; }
    __device__ bool next(int i, Unit& u) const {
        const long L = (long)i * G + c; if (L >= nwg) return false;
        int wgid = (int)L; { const int q = nwg / NXCD, r = nwg % NXCD, xcd = wgid % NXCD, off = wgid / NXCD; wgid = (xcd < r ? xcd * (q + 1) : r * (q + 1) + (xcd - r) * q) + off; }
        const int nig = WGM * nN, gid = wgid / nig, fm = gid * WGM, gsz = (nM - fm) < WGM ? (nM - fm) : WGM;
        u.pm = fm + ((wgid % nig) % gsz); u.pn = (wgid % nig) / gsz; u.g = 0; u.st = 0; return true;
    }
    __device__ size_t a_off(const Unit& u) const { return (size_t)u.pm * BM * lda; }
    __device__ size_t b_off(const Unit& u) const { return (size_t)u.pn * BM * ldb; }
    __device__ unsigned a_row(const Unit&, int) const { return 0u; }
};

#if MK_FAST_GEMM
template <class Prob, class Epi, bool GATHER, bool FP8 = false>
__device__ __forceinline__ void gemm_phase(LAS uchar* lds, const Prob& S, const Epi& E, const int wid  ) {
    constexpr unsigned ESZ = FP8 ? 1u : 2u;
    const int lane = fresh_lane(), tid = wid * 64 + lane, wr = wid >> 2, wc = wid & 3, fr = lane & 15, fq = lane >> 4;
    const int nt = S.nt;
    int Ra[2], Ca[2]; unsigned voffB[2];
#pragma unroll
    for (int i = 0; i < 2; ++i) { int R, C; stage_rc(tid * 16 + i * 8192, R, C); const int Rb = Epi::PERM ? ((R & ~31) + perm32(R & 31)) : R;
        Ra[i] = R; Ca[i] = C; voffB[i] = (unsigned)(Rb * S.ldb) * ESZ + (unsigned)C * 2u; }
    constexpr unsigned kstep = BK * 2;
    const unsigned hstepB = (unsigned)HALF * (unsigned)S.ldb * ESZ;
    const unsigned ldsw = (unsigned)wid * 1024u;
    const int aoff = lds_byte(wr * 64 + fr, fq * 8), boff = lds_byte(wc * 32 + fr, fq * 8);
    const __amdgpu_buffer_rsrc_t srdA = __builtin_amdgcn_make_buffer_rsrc((void*)S.A, 0, 0xFFFFFFFF, 0x00020000);
    const __amdgpu_buffer_rsrc_t srdB = __builtin_amdgcn_make_buffer_rsrc((void*)S.B, 0, 0xFFFFFFFF, 0x00020000);
#define G_SA(b, h) (((b) * 2 + (h)) * HTB)
#define G_SB(b, h) ((4 + (b) * 2 + (h)) * HTB)
#define G_STAGE(bufoff, srd, soff, voff) do { _Pragma("unroll") for (int _i = 0; _i < 2; ++_i) \
        __builtin_amdgcn_raw_ptr_buffer_load_lds(srd, (LAS void*)(lds + (bufoff) + ldsw + _i * 8192), 16, (int)(voff)[_i], (int)(soff), 0, 0); } while (0)
#define G_LDA(dst, b, h) do { _Pragma("unroll") for (int m = 0; m < 4; ++m) _Pragma("unroll") for (int k = 0; k < 2; ++k) dst[m][k] = *(const LAS bf16x8*)(lds + G_SA(b, h) + aoff + m * 2048 + k * 1024); } while (0)
#define G_LDB(dst, b, h) do { _Pragma("unroll") for (int n = 0; n < 2; ++n) _Pragma("unroll") for (int k = 0; k < 2; ++k) dst[n][k] = *(const LAS bf16x8*)(lds + G_SB(b, h) + boff + n * 2048 + k * 1024); } while (0)
#define G_CAT(x0, x1) __builtin_shufflevector(__builtin_bit_cast(v4i, x0), __builtin_bit_cast(v4i, x1), 0, 1, 2, 3, 4, 5, 6, 7)
#define G_MMA(ai, bj, At, Bt) do { __builtin_amdgcn_s_setprio(1); _Pragma("unroll") for (int m = 0; m < 4; ++m) _Pragma("unroll") for (int n = 0; n < 2; ++n) { \
        if constexpr (FP8) acc[ai][bj][m][n] = __builtin_amdgcn_mfma_scale_f32_16x16x128_f8f6f4(G_CAT(Bt[n][0], Bt[n][1]), G_CAT(At[m][0], At[m][1]), acc[ai][bj][m][n], 0, 0, 0, 0x7f7f7f7f, 0, 0x7f7f7f7f); \
        else { _Pragma("unroll") for (int k = 0; k < 2; ++k) acc[ai][bj][m][n] = __builtin_amdgcn_mfma_f32_16x16x32_bf16(Bt[n][k], At[m][k], acc[ai][bj][m][n], 0, 0, 0); } } \
        __builtin_amdgcn_s_setprio(0); } while (0)
#define G_WAIT_V(n) asm volatile("s_waitcnt vmcnt(" #n ")" ::: "memory")
#define G_WAIT_L(n) asm volatile("s_waitcnt lgkmcnt(" #n ")" ::: "memory")
#define G_BAR __builtin_amdgcn_s_barrier()
#define G_SCHED __builtin_amdgcn_sched_barrier(0)
#define G_UNI(x) ((unsigned)__builtin_amdgcn_readfirstlane((int)(x)))
    Unit cur, nxt; int ui = 0;
    if (!S.next(0, cur)) return;
    unsigned vA0[2], vA1[2];
    unsigned cA = 0u, cB = G_UNI(S.b_off(cur) * ESZ);
    __amdgpu_buffer_rsrc_t srdL = srdA;
    if constexpr (GATHER) srdL = __builtin_amdgcn_make_buffer_rsrc((void*)S.list, 0, 0xFFFFFFFF, 0x00020000);
#define G_IDX(u_) do { if (wid < 4) __builtin_amdgcn_raw_ptr_buffer_load_lds(srdL, (LAS void*)(S.gtab + wid * 64), 4, lane * 4, (int)G_UNI(S.list_off(u_) * 4u) + wid * 256, 0, 0); } while (0)
    const int gR = (int)(uintptr_t)S.gtab + Ra[0] * 4; const unsigned gC = (unsigned)Ca[0] * 2u;
#define G_ROWS(o0, o1) do { const LAS int* _g = (const LAS int*)gR; const unsigned _ls = (unsigned)S.lda * ESZ; \
        o0[0] = (unsigned)_g[0] * _ls + gC; o0[1] = (unsigned)_g[64] * _ls + gC; o1[0] = (unsigned)_g[128] * _ls + gC; o1[1] = (unsigned)_g[192] * _ls + gC; } while (0)
    if constexpr (GATHER) { G_IDX(cur); G_WAIT_V(0); G_BAR; G_ROWS(vA0, vA1); G_WAIT_L(0); G_BAR; }
    else { cA = G_UNI(S.a_off(cur) * ESZ);
#pragma unroll
        for (int i = 0; i < 2; ++i) { vA0[i] = (unsigned)(Ra[i] * S.lda) * ESZ + (unsigned)Ca[i] * 2u; vA1[i] = (unsigned)((HALF + Ra[i]) * S.lda) * ESZ + (unsigned)Ca[i] * 2u; }
    }
    G_STAGE(G_SB(0, 0), srdB, cB, voffB); G_STAGE(G_SA(0, 0), srdA, cA, vA0); G_STAGE(G_SB(0, 1), srdB, cB + hstepB, voffB); G_STAGE(G_SA(0, 1), srdA, cA, vA1);
    if (wr == 1) G_BAR;
    G_WAIT_V(4); G_BAR;
    G_STAGE(G_SB(1, 0), srdB, cB + kstep, voffB); G_STAGE(G_SA(1, 0), srdA, cA + kstep, vA0); G_STAGE(G_SB(1, 1), srdB, cB + hstepB + kstep, voffB);
    G_WAIT_V(6); G_BAR;
    f32x4 acc[2][2][4][2];
#pragma unroll
    for (int a = 0; a < 2; ++a)
#pragma unroll
        for (int b = 0; b < 2; ++b)
#pragma unroll
            for (int m = 0; m < 4; ++m)
#pragma unroll
                for (int n = 0; n < 2; ++n) acc[a][b][m][n] = (f32x4){0.f, 0.f, 0.f, 0.f};
    bf16x8 At[4][2], B0[2][2], B1[2][2];
    for (;;) {
        const bool has_next = S.next(ui + 1, nxt);
        unsigned nA = cA, nB = cB; unsigned x0[2] = {0u, 0u}, x1[2] = {0u, 0u};
        if (has_next) { nB = G_UNI(S.b_off(nxt) * ESZ);
            if constexpr (GATHER) G_IDX(nxt);
            else nA = G_UNI(S.a_off(nxt) * ESZ);
        }
#define G_TRIP(LAST) do { \
            const unsigned a1 = cA + (unsigned)(t + 1) * kstep; \
            const unsigned a2 = (LAST) ? nA : cA + (unsigned)(t + 2) * kstep, b2 = (LAST) ? nB : cB + (unsigned)(t + 2) * kstep; \
            const unsigned a3 = a2 + kstep, b3 = b2 + kstep; \
            unsigned w0[2], w1[2]; \
            _Pragma("unroll") for (int i = 0; i < 2; ++i) { w0[i] = vA0[i]; w1[i] = vA1[i]; } \
            if constexpr (GATHER) { if ((LAST) && has_next) { G_ROWS(w0, w1); _Pragma("unroll") for (int i = 0; i < 2; ++i) { x0[i] = w0[i]; x1[i] = w1[i]; } } } \
              G_LDB(B0, 0, 0); G_SCHED; G_LDA(At, 0, 0); G_STAGE(G_SA(1, 1), srdA, a1, vA1); \
            G_WAIT_L(8); G_BAR; G_WAIT_L(0); G_MMA(0, 0, At, B0); G_BAR; G_SCHED; \
              G_LDB(B1, 0, 1); G_STAGE(G_SB(0, 0), srdB, b2, voffB); \
            G_BAR; G_WAIT_L(0); G_MMA(0, 1, At, B1); G_BAR; \
              G_LDA(At, 0, 1); G_STAGE(G_SA(0, 0), srdA, a2, w0); \
            G_BAR; G_WAIT_L(0); G_MMA(1, 0, At, B0); G_BAR; G_SCHED; \
              G_STAGE(G_SB(0, 1), srdB, b2 + hstepB, voffB); \
            G_WAIT_V(6); G_BAR; G_MMA(1, 1, At, B1); G_BAR; \
              G_LDB(B0, 1, 0); G_SCHED; G_LDA(At, 1, 0); G_STAGE(G_SA(0, 1), srdA, a2, w1); \
            G_WAIT_L(8); G_BAR; G_WAIT_L(0); G_MMA(0, 0, At, B0); G_BAR; G_SCHED; \
              G_LDB(B1, 1, 1); G_STAGE(G_SB(1, 0), srdB, b3, voffB); \
            G_BAR; G_WAIT_L(0); G_MMA(0, 1, At, B1); G_BAR; \
              G_LDA(At, 1, 1); G_STAGE(G_SA(1, 0), srdA, a3, w0); \
            G_BAR; G_WAIT_L(0); G_MMA(1, 0, At, B0); G_BAR; G_SCHED; \
              G_STAGE(G_SB(1, 1), srdB, b3 + hstepB, voffB); \
            G_WAIT_V(6); G_BAR; G_MMA(1, 1, At, B1); G_BAR; } while (0)
        for (int t = 0; t < nt; t += 2) { const bool last = (t == nt - 2); G_TRIP(last); }
        { const int lane2 = fresh_lane();
          E(acc, cur, wid >> 2, wid & 3, lane2 & 15, lane2 >> 4); }
        if (!has_next) break;
#pragma unroll
        for (int a = 0; a < 2; ++a)
#pragma unroll
            for (int b = 0; b < 2; ++b)
#pragma unroll
                for (int m = 0; m < 4; ++m)
#pragma unroll
                    for (int n = 0; n < 2; ++n) acc[a][b][m][n] = (f32x4){0.f, 0.f, 0.f, 0.f};
        cur = nxt; cA = nA; cB = nB; ++ui;
        if constexpr (GATHER) {
#pragma unroll
            for (int i = 0; i < 2; ++i) { vA0[i] = x0[i]; vA1[i] = x1[i]; } }
    }
    G_WAIT_V(0);
    if (wr == 0) G_BAR;
    G_BAR;
#undef G_SA
#undef G_SB
#undef G_STAGE
#undef G_LDA
#undef G_LDB
#undef G_MMA
#undef G_CAT
#undef G_WAIT_V
#undef G_WAIT_L
#undef G_BAR
#undef G_SCHED
#undef G_UNI
#undef G_TRIP
#undef G_IDX
#undef G_ROWS
}
#else
template <class Prob, class Epi, bool GATHER, bool FP8 = false>
__device__ __forceinline__ void gemm_phase(LAS uchar* lds, const Prob& S, const Epi& E, const int wid) {
    const int lane = fresh_lane(), tid = wid * 64 + lane, wr = wid >> 2, wc = wid & 3, fr = lane & 15, fq = lane >> 4;
    LAS float* As = (LAS float*)lds; LAS float* Bs = As + 256 * 33;
    Unit u;
    for (int ui = 0; S.next(ui, u); ++ui) {
        float acc[2][2][4][2][4];
#pragma unroll
        for (int a = 0; a < 2; ++a)
#pragma unroll
            for (int b = 0; b < 2; ++b)
#pragma unroll
                for (int m = 0; m < 4; ++m)
#pragma unroll
                    for (int n = 0; n < 2; ++n)
#pragma unroll
                        for (int j = 0; j < 4; ++j) acc[a][b][m][n][j] = 0.f;
        const int lr = tid >> 1, lk = (tid & 1) * 16;
        const bf16_t* ap = GATHER ? (S.A + S.a_row(u, lr)) : (S.A + S.a_off(u) + (size_t)lr * S.lda);
        const bf16_t* bp = S.B + S.b_off(u) + (size_t)lr * S.ldb;
        for (int k0 = 0; k0 < S.nt * 64; k0 += 32) {
            __syncthreads();
            const u32x4 a0 = *(const u32x4*)(ap + k0 + lk), a1 = *(const u32x4*)(ap + k0 + lk + 8);
            const u32x4 b0 = *(const u32x4*)(bp + k0 + lk), b1 = *(const u32x4*)(bp + k0 + lk + 8);
#pragma unroll
            for (int q = 0; q < 4; ++q) {
                As[lr * 33 + lk + 2 * q] = bflo(a0[q]); As[lr * 33 + lk + 2 * q + 1] = bfhi(a0[q]);
                As[lr * 33 + lk + 8 + 2 * q] = bflo(a1[q]); As[lr * 33 + lk + 8 + 2 * q + 1] = bfhi(a1[q]);
                Bs[lr * 33 + lk + 2 * q] = bflo(b0[q]); Bs[lr * 33 + lk + 2 * q + 1] = bfhi(b0[q]);
                Bs[lr * 33 + lk + 8 + 2 * q] = bflo(b1[q]); Bs[lr * 33 + lk + 8 + 2 * q + 1] = bfhi(b1[q]);
            }
            __syncthreads();
            for (int kk = 0; kk < 32; ++kk) {
                float av[2][4], bv[2][2][4];
#pragma unroll
                for (int a = 0; a < 2; ++a)
#pragma unroll
                    for (int m = 0; m < 4; ++m) av[a][m] = As[(128 * a + 64 * wr + 16 * m + fr) * 33 + kk];
#pragma unroll
                for (int b = 0; b < 2; ++b)
#pragma unroll
                    for (int n = 0; n < 2; ++n)
#pragma unroll
                        for (int j = 0; j < 4; ++j) { const int c = 128 * b + 32 * wc + (Epi::PERM ? (8 * fq + 4 * n + j) : (16 * n + 4 * fq + j)); bv[b][n][j] = Bs[c * 33 + kk]; }
#pragma unroll
                for (int a = 0; a < 2; ++a)
#pragma unroll
                    for (int b = 0; b < 2; ++b)
#pragma unroll
                        for (int m = 0; m < 4; ++m)
#pragma unroll
                            for (int n = 0; n < 2; ++n)
#pragma unroll
                                for (int j = 0; j < 4; ++j) acc[a][b][m][n][j] += av[a][m] * bv[b][n][j];
            }
        }
        f32x4 accv[2][2][4][2];
#pragma unroll
        for (int a = 0; a < 2; ++a)
#pragma unroll
            for (int b = 0; b < 2; ++b)
#pragma unroll
                for (int m = 0; m < 4; ++m)
#pragma unroll
                    for (int n = 0; n < 2; ++n) accv[a][b][m][n] = (f32x4){acc[a][b][m][n][0], acc[a][b][m][n][1], acc[a][b][m][n][2], acc[a][b][m][n][3]};
        E(accv, u, wr, wc, fr, fq);
    }
    __syncthreads();
}
#endif
}

struct Args {
    const float* in[32];
    float* out; uchar* ws;
    int ph_lo, ph_hi;
};
struct Frame {
    LAS uchar* lds; uchar* ws; int wave, G, bx;
};
#define FRAME_IDS(F) const int F_lane = fresh_lane(), F_tid = (F).wave * 64 + F_lane
enum { I_X = 0, I_POS, I_N1G, I_WIN, I_BG, I_QNG, I_WUQ, I_KVNG, I_WUKV, I_QKQG, I_QKKG, I_WOMLA, I_LRE, I_LIM, I_LOGDT, I_BRE, I_BIM, I_CRE, I_CIM, I_S5D,
       I_WGLU, I_WOS5, I_WOUT, I_N2G, I_WR, I_BR, I_WG, I_BGATE, I_WU, I_BUP, I_WD, I_BDOWN };

struct ProbS5 {
    const bf16_t* A; const bf16_t* B; int lda, ldb, nt; int G, c; const int* list = nullptr; const LAS int* gtab = nullptr;
    __device__ unsigned list_off(const gm::Unit&) const { return 0u; }
    __device__ bool next(int i, gm::Unit& u) const { const int L = i * G + c; if (L >= S5G * 4) return false; u.g = L >> 2; u.pm = L & 3; u.pn = 0; u.st = 0; return true; }
    __device__ size_t a_off(const gm::Unit& u) const { return ((size_t)u.g * NCHUNK + (size_t)u.pm * 256) * APK; }
    __device__ size_t b_off(const gm::Unit& u) const { return (size_t)u.g * 256 * ldb; }
    __device__ unsigned a_row(const gm::Unit&, int) const { return 0u; }
};
struct ProbMoE {
    const bf16_t* A; const bf16_t* B; int lda, ldb, nt; int npn; size_t estride;
    int x, rk, nrk; int nte[4], rcp[4], pre[4];
    const int* list = nullptr; const LAS int* gtab = nullptr;
    __device__ void load(const LAS int* tab) {
#pragma unroll
        for (int q = 0; q < 4; ++q) { const int e = x + 8 * q; nte[q] = __builtin_amdgcn_readfirstlane(tab[32 + e]); rcp[q] = __builtin_amdgcn_readfirstlane(tab[128 + e]); pre[q] = __builtin_amdgcn_readfirstlane(tab[64 + e]); }
    }
    __device__ unsigned list_off(const gm::Unit&) const { return 0u; }
    __device__ bool next(int i, gm::Unit& u) const {
        int L = i * nrk + rk;
#pragma unroll
        for (int q = 0; q < 4; ++q) { const int nu = nte[q] * npn;
            if (L < nu) { u.g = x + 8 * q; u.pn = (L * rcp[q]) >> 20; u.pm = L - u.pn * nte[q]; u.st = pre[q] + u.pm; return true; } L -= nu; }
        return false;
    }
    __device__ size_t a_off(const gm::Unit& u) const { return ((size_t)u.st * 256) * lda; }
    __device__ size_t b_off(const gm::Unit& u) const { return (size_t)u.g * estride + (size_t)u.pn * 256 * ldb; }
    __device__ unsigned a_row(const gm::Unit&, int) const { return 0u; }
};

#define EPI_ROW(u_, ai, m) ((u_).pm * 256 + (ai) * 128 + wr * 64 + (m) * 16 + fr)
struct EpiStoreBf16 {
    static constexpr bool PERM = true;
    bf16_t* O; int ld;
    __device__ __forceinline__ void operator()(const f32x4 (&acc)[2][2][4][2], const gm::Unit& u, int wr, int wc, int fr, int fq) const {
#pragma unroll
        for (int ai = 0; ai < 2; ++ai)
#pragma unroll
            for (int m = 0; m < 4; ++m) { bf16_t* rowp = O + (size_t)EPI_ROW(u, ai, m) * ld + u.pn * 256 + wc * 32 + 8 * fq;
#pragma unroll
                for (int bj = 0; bj < 2; ++bj) { const f32x4 v0 = acc[ai][bj][m][0], v1 = acc[ai][bj][m][1];
                    u32x4 w; w.x = cvt_pk_bf16(v0[0], v0[1]); w.y = cvt_pk_bf16(v0[2], v0[3]); w.z = cvt_pk_bf16(v1[0], v1[1]); w.w = cvt_pk_bf16(v1[2], v1[3]);
                    *(u32x4*)(rowp + bj * 128) = w; } }
    }
};
struct EpiInProj {
    static constexpr bool PERM = true;
    bf16_t* proj; bf16_t* apack; const float* bgates;
    __device__ __forceinline__ void operator()(const f32x4 (&acc)[2][2][4][2], const gm::Unit& u, int wr, int wc, int fr, int fq) const {
        const int colt = u.pn * 256 + wc * 32 + 8 * fq;
        const int kind = (u.pn >= 3 && u.pn < 7) ? 1 : ((u.pn >= 7 && u.pn < 23) ? 2 : 0);
#pragma unroll
        for (int bj = 0; bj < 2; ++bj) {
            const int col = colt + bj * 128;
            f32x4 b0 = (f32x4){0.f, 0.f, 0.f, 0.f}, b1 = b0;
            if (kind == 2) { b0 = *(const f32x4*)(bgates + (col - C_GA)); b1 = *(const f32x4*)(bgates + (col - C_GA) + 4); }
#pragma unroll
            for (int ai = 0; ai < 2; ++ai)
#pragma unroll
                for (int m = 0; m < 4; ++m) {
                    const int row = EPI_ROW(u, ai, m);
                    f32x4 v0 = acc[ai][bj][m][0], v1 = acc[ai][bj][m][1];
                    if (kind == 2) {
#pragma unroll
                        for (int j = 0; j < 4; ++j) { v0[j] = sigmoidf_(v0[j] + b0[j]); v1[j] = sigmoidf_(v1[j] + b1[j]); }
                    }
                    u32x4 w; w.x = cvt_pk_bf16(v0[0], v0[1]); w.y = cvt_pk_bf16(v0[2], v0[3]); w.z = cvt_pk_bf16(v1[0], v1[1]); w.w = cvt_pk_bf16(v1[2], v1[3]);
                    if (kind == 1) { const int j = col - C_U, g = j >> 4, cc = j & 15;
                        *(u32x4*)(apack + ((size_t)g * NCHUNK + (row >> 4)) * APK + (row & 15) * 16 + cc) = w; }
                    else *(u32x4*)(proj + (size_t)row * NPROJ + col) = w;
                }
        }
    }
};
struct EpiS5State {
    static constexpr bool PERM = false;
    float* sch;
    __device__ __forceinline__ void operator()(const f32x4 (&acc)[2][2][4][2], const gm::Unit& u, int wr, int wc, int fr, int fq) const {
#pragma unroll
        for (int ai = 0; ai < 2; ++ai)
#pragma unroll
            for (int m = 0; m < 4; ++m) { float* rowp = sch + ((size_t)u.g * NCHUNK + EPI_ROW(u, ai, m)) * 128 + wc * 32 + 4 * fq;
#pragma unroll
                for (int n = 0; n < 2; ++n) *(f32x4*)(rowp + n * 16) = acc[ai][0][m][n]; }
    }
};
struct EpiS5Out {
    static constexpr bool PERM = true;
    bf16_t* gact;
    __device__ __forceinline__ void operator()(const f32x4 (&acc)[2][2][4][2], const gm::Unit& u, int wr, int wc, int fr, int fq) const {
#pragma unroll
        for (int ai = 0; ai < 2; ++ai)
#pragma unroll
            for (int m = 0; m < 4; ++m) { const int r = EPI_ROW(u, ai, m);
#pragma unroll
                for (int bj = 0; bj < 2; ++bj) { const int n0 = bj * 128 + wc * 32 + 8 * fq, t = n0 >> 4, c0 = n0 & 15;
                    f32x4 v0 = acc[ai][bj][m][0], v1 = acc[ai][bj][m][1];
#pragma unroll
                    for (int j = 0; j < 4; ++j) { v0[j] = gelu_tanh(v0[j]); v1[j] = gelu_tanh(v1[j]); }
                    u32x4 w; w.x = cvt_pk_bf16(v0[0], v0[1]); w.y = cvt_pk_bf16(v0[2], v0[3]); w.z = cvt_pk_bf16(v1[0], v1[1]); w.w = cvt_pk_bf16(v1[2], v1[3]);
                    *(u32x4*)(gact + ((size_t)r * 16 + t) * S5W + u.g * 16 + c0) = w; } }
    }
};
template <int MODE> struct EpiSide {
    static constexpr bool PERM = true;
    bf16_t* O; int ldo; const bf16_t* s0; int ld0; const bf16_t* s1; int ld1;
    __device__ __forceinline__ void operator()(const f32x4 (&acc)[2][2][4][2], const gm::Unit& u, int wr, int wc, int fr, int fq) const {
#pragma unroll
        for (int ai = 0; ai < 2; ++ai)
#pragma unroll
            for (int m = 0; m < 4; ++m) { const int row = EPI_ROW(u, ai, m);
#pragma unroll
                for (int bj = 0; bj < 2; ++bj) { const int col = u.pn * 256 + bj * 128 + wc * 32 + 8 * fq;
                    const f32x4 v0 = acc[ai][bj][m][0], v1 = acc[ai][bj][m][1];
                    const u32x4 a = *(const u32x4*)(s0 + (size_t)row * ld0 + col);
                    u32x4 b = (u32x4){0u, 0u, 0u, 0u}; if (MODE == 2) b = *(const u32x4*)(s1 + (size_t)row * ld1 + col);
                    float r[8];
#pragma unroll
                    for (int q = 0; q < 4; ++q) { const float x0 = q < 2 ? v0[2 * q] : v1[2 * q - 4], x1 = q < 2 ? v0[2 * q + 1] : v1[2 * q - 3];
                        const float a0 = bflo(a[q]), a1 = bfhi(a[q]);
                        if (MODE == 0) { r[2 * q] = a0 * sigmoidf_(x0); r[2 * q + 1] = a1 * sigmoidf_(x1); }
                        else if (MODE == 1) { r[2 * q] = a0 * x0; r[2 * q + 1] = a1 * x1; }
                        else { r[2 * q] = bflo(b[q]) + a0 * x0; r[2 * q + 1] = bfhi(b[q]) + a1 * x1; } }
                    u32x4 w; w.x = cvt_pk_bf16(r[0], r[1]); w.y = cvt_pk_bf16(r[2], r[3]); w.z = cvt_pk_bf16(r[4], r[5]); w.w = cvt_pk_bf16(r[6], r[7]);
                    *(u32x4*)(O + (size_t)row * ldo + col) = w; } }
    }
};
struct EpiResidF32 {
    static constexpr bool PERM = false;
    const float* x; float* out;
    __device__ __forceinline__ void operator()(const f32x4 (&acc)[2][2][4][2], const gm::Unit& u, int wr, int wc, int fr, int fq) const {
#pragma unroll
        for (int ai = 0; ai < 2; ++ai)
#pragma unroll
            for (int m = 0; m < 4; ++m) { const size_t off = (size_t)EPI_ROW(u, ai, m) * DM + u.pn * 256 + wc * 32 + 4 * fq;
#pragma unroll
                for (int bj = 0; bj < 2; ++bj)
#pragma unroll
                    for (int n = 0; n < 2; ++n) { const size_t o = off + bj * 128 + n * 16; *(f32x4*)(out + o) = *(const f32x4*)(x + o) + acc[ai][bj][m][n]; } }
    }
};
#if MK_FP8_MOE
constexpr float MOE_DESCALE = 1.0f / (FP8_ASCALE * FP8_WSCALE);
#else
constexpr float MOE_DESCALE = 1.0f;
#endif
struct EpiSwiglu {
    static constexpr bool PERM = true;
    bf16_t* hact; const float* bgate; const float* bup; const LAS int* tab;
    __device__ __forceinline__ void operator()(const f32x4 (&acc)[2][2][4][2], const gm::Unit& u, int wr, int wc, int fr, int fq) const {
        const int hc = u.pn * 128 + wc * 32 + 8 * fq;
        const unsigned slot0 = (unsigned)u.st * 256u + wr * 64 + fr;
#pragma unroll
        for (int n = 0; n < 2; ++n) {
            const f32x4 g0 = *(const f32x4*)(bgate + (unsigned)(u.g * DFF + hc + 4 * n)), u0 = *(const f32x4*)(bup + (unsigned)(u.g * DFF + hc + 4 * n));
#pragma unroll
            for (int ai = 0; ai < 2; ++ai)
#pragma unroll
                for (int m = 0; m < 4; ++m) { const unsigned slot = slot0 + ai * 128 + m * 16;
                    float r[4];
#pragma unroll
                    for (int q = 0; q < 4; ++q) { float gt = acc[ai][0][m][n][q] * MOE_DESCALE + g0[q], up = acc[ai][1][m][n][q] * MOE_DESCALE + u0[q];
                        gt = fminf(gt, 7.0f); up = fminf(fmaxf(up, -7.0f), 7.0f);
                        r[q] = (up + 1.0f) * (gt * sigmoidf_(1.702f * gt)); }
#if MK_FP8_MOE
                    *(unsigned*)((uchar*)hact + slot * DFF + hc + 4 * n) = pk4_fp8(r[0] * FP8_ASCALE, r[1] * FP8_ASCALE, r[2] * FP8_ASCALE, r[3] * FP8_ASCALE);
#else
                    u32x2 w; w.x = cvt_pk_bf16(r[0], r[1]); w.y = cvt_pk_bf16(r[2], r[3]); *(u32x2*)(hact + slot * DFF + hc + 4 * n) = w;
#endif
                }
        }
    }
};
struct EpiDown {
    static constexpr bool PERM = true;
    bf16_t* ys; const float* bdown; const LAS int* tab;
    __device__ __forceinline__ void operator()(const f32x4 (&acc)[2][2][4][2], const gm::Unit& u, int wr, int wc, int fr, int fq) const {
        const size_t slot0 = (size_t)u.st * 256;
#pragma unroll
        for (int bj = 0; bj < 2; ++bj) { const int col = u.pn * 256 + bj * 128 + wc * 32 + 8 * fq;
            const float* bd = bdown + (size_t)u.g * DM + col; const f32x4 d0 = *(const f32x4*)bd, d1 = *(const f32x4*)(bd + 4);
#pragma unroll
            for (int ai = 0; ai < 2; ++ai)
#pragma unroll
                for (int m = 0; m < 4; ++m) { const size_t slot = slot0 + ai * 128 + wr * 64 + m * 16 + fr;
                    const f32x4 v0 = acc[ai][bj][m][0] * MOE_DESCALE + d0, v1 = acc[ai][bj][m][1] * MOE_DESCALE + d1;
                    u32x4 w; w.x = cvt_pk_bf16(v0[0], v0[1]); w.y = cvt_pk_bf16(v0[2], v0[3]); w.z = cvt_pk_bf16(v1[0], v1[1]); w.w = cvt_pk_bf16(v1[2], v1[3]);
                    *(u32x4*)(ys + slot * DM + col) = w; } }
    }
};

template <bool FP8OUT>
__device__ __forceinline__ void transpose_item(const float* W, int ldw, int src_col0, int k0, const float* kscale, void* WT, int ldt, int dst_row0, float oscale, LAS float* scr, int lane) {
    if (src_col0 >= 0) {
        f32x4 v[16]; const float* wp = W + (size_t)(k0 + (lane >> 4)) * ldw + src_col0 + (lane & 15) * 4;
#pragma unroll
        for (int i = 0; i < 16; ++i) v[i] = *(const f32x4*)(wp + (size_t)(4 * i) * ldw);
#pragma unroll
        for (int i = 0; i < 16; ++i) { const int kk = 4 * i + (lane >> 4); const float sc = kscale ? kscale[k0 + kk] * oscale : oscale; LAS float* d = scr + kk * 65 + (lane & 15) * 4;
            d[0] = v[i].x * sc; d[1] = v[i].y * sc; d[2] = v[i].z * sc; d[3] = v[i].w * sc; }
    } else {
#pragma unroll
        for (int i = 0; i < 16; ++i) { LAS float* d = scr + (4 * i + (lane >> 4)) * 65 + (lane & 15) * 4; d[0] = 0.f; d[1] = 0.f; d[2] = 0.f; d[3] = 0.f; }
    }
    LDS_WAIT(); asm volatile("" ::: "memory");
    if constexpr (FP8OUT) { const int c = lane & 3;
#pragma unroll
        for (int j = 0; j < 4; ++j) { const int n = (lane >> 2) + 16 * j; const LAS float* s = scr + (16 * c) * 65 + n; u32x4 o;
            o.x = pk4_fp8(s[0 * 65], s[1 * 65], s[2 * 65], s[3 * 65]); o.y = pk4_fp8(s[4 * 65], s[5 * 65], s[6 * 65], s[7 * 65]);
            o.z = pk4_fp8(s[8 * 65], s[9 * 65], s[10 * 65], s[11 * 65]); o.w = pk4_fp8(s[12 * 65], s[13 * 65], s[14 * 65], s[15 * 65]);
            *(u32x4*)((uchar*)WT + (size_t)(dst_row0 + n) * ldt + k0 + 16 * c) = o; }
    } else { const int c = lane & 7;
#pragma unroll
        for (int j = 0; j < 8; ++j) { const int n = (lane >> 3) + 8 * j; const LAS float* s = scr + (8 * c) * 65 + n;
            u32x4 o; o.x = pk2(s[0 * 65], s[1 * 65]); o.y = pk2(s[2 * 65], s[3 * 65]); o.z = pk2(s[4 * 65], s[5 * 65]); o.w = pk2(s[6 * 65], s[7 * 65]);
            *(u32x4*)((bf16_t*)WT + (size_t)(dst_row0 + n) * ldt + k0 + 8 * c) = o; }
    }
    LDS_WAIT(); asm volatile("" ::: "memory");
}
__device__ __forceinline__ int win_src_col(int n0) {
    if (n0 < C_KVLAT) return n0;
    if (n0 < C_U) return n0;
    if (n0 < C_GA) return (n0 - C_U) + 832;
    if (n0 < C_KR) return (n0 - C_GA) + 1856;
    if (n0 < C_KR + DROPE) return (n0 - C_KR) + 768;
    return -1;
}
__device__ __forceinline__ void s5_build_group(const Args& a, const Frame& F, int g) {
    FRAME_IDS(F);
    LAS float* L = (LAS float*)F.lds;
    LAS float* Apr = L;              LAS float* Api = Apr + 17 * 64;
    LAS float* Zr = Api + 17 * 64;   LAS float* Zi = Zr + 64;
    LAS float* Bbr = Zi + 64;        LAS float* Bbi = Bbr + 1024;
    LAS float* Cr = Bbi + 1024;      LAS float* Ci = Cr + 1024;
    LAS float* Kt = Ci + 1024;
    const int tid = F_tid;
    __syncthreads();
    if (tid < 64) { const int p = tid;
        const float dt = expf(a.in[I_LOGDT][g]); const float lr = a.in[I_LRE][g * 64 + p], li = a.in[I_LIM][g * 64 + p];
        const float mag = expf(lr * dt); const float ar = mag * cosf(li * dt), ai = mag * sinf(li * dt);
        const float den = lr * lr + li * li;
        Zr[p] = ((ar - 1.0f) * lr + ai * li) / den; Zi[p] = (ai * lr - (ar - 1.0f) * li) / den;
        float pr = 1.0f, pi = 0.0f;
        for (int t = 0; t <= 16; ++t) { Apr[t * 64 + p] = pr; Api[t * 64 + p] = pi; const float nr = pr * ar - pi * ai, ni = pr * ai + pi * ar; pr = nr; pi = ni; }
    }
    __syncthreads();
    for (int i = tid; i < 1024; i += NTHREADS) { const int p = i >> 4;
        const float br = a.in[I_BRE][(size_t)g * 1024 + i], bi = a.in[I_BIM][(size_t)g * 1024 + i];
        Bbr[i] = Zr[p] * br - Zi[p] * bi; Bbi[i] = Zr[p] * bi + Zi[p] * br;
        Cr[i] = a.in[I_CRE][(size_t)g * 1024 + i]; Ci[i] = a.in[I_CIM][(size_t)g * 1024 + i]; }
    if (tid < 64) ((float2*)(F.ws + WS_SMALL + SM_A16))[g * 64 + tid] = make_float2(Apr[16 * 64 + tid], Api[16 * 64 + tid]);
    __syncthreads();
    for (int i = tid; i < 4096; i += NTHREADS) { const int tau = i >> 8, c = (i >> 4) & 15, cp = i & 15; float s = 0.f;
        for (int p = 0; p < 64; ++p) { const float cr = Cr[c * 64 + p], ci = Ci[c * 64 + p], ar = Apr[tau * 64 + p], ai = Api[tau * 64 + p];
            const float car = cr * ar - ci * ai, cai = cr * ai + ci * ar; s += car * Bbr[p * 16 + cp] - cai * Bbi[p * 16 + cp]; }
        Kt[i] = s; }
    __syncthreads();
    bf16_t* twc = (bf16_t*)(F.ws + WS_TWC) + (size_t)g * 256 * APK;
    for (int ch = tid; ch < 256 * (APK / 8); ch += NTHREADS) { const int n = ch / (APK / 8), k0 = (ch % (APK / 8)) * 8, t = n >> 4, c = n & 15; float v[8];
#pragma unroll
        for (int j = 0; j < 8; ++j) { const int k = k0 + j;
            if (k < 256) { const int s = k >> 4, cp = k & 15; float x = (s <= t) ? Kt[((t - s) * 16 + c) * 16 + cp] : 0.f; if (s == t && cp == c) x += a.in[I_S5D][g * 16 + c]; v[j] = x; }
            else { const int q = k - 256, p = q & 63; const float cr = Cr[c * 64 + p], ci = Ci[c * 64 + p], ar = Apr[(t + 1) * 64 + p], ai = Api[(t + 1) * 64 + p];
                v[j] = (q < 64) ? (cr * ar - ci * ai) : -(cr * ai + ci * ar); } }
        u32x4 o; o.x = pk2(v[0], v[1]); o.y = pk2(v[2], v[3]); o.z = pk2(v[4], v[5]); o.w = pk2(v[6], v[7]);
        *(u32x4*)(twc + (size_t)n * APK + k0) = o; }
    bf16_t* wsm = (bf16_t*)(F.ws + WS_WS5) + (size_t)g * 256 * 256;
    for (int ch = tid; ch < 256 * 32; ch += NTHREADS) { const int n = ch >> 5, k0 = (ch & 31) * 8; float v[8];
#pragma unroll
        for (int j = 0; j < 8; ++j) { const int k = k0 + j, s = k >> 4, cp = k & 15;
            if (n < 128) { const int p = n & 63; const float ar = Apr[(15 - s) * 64 + p], ai = Api[(15 - s) * 64 + p], br = Bbr[p * 16 + cp], bi = Bbi[p * 16 + cp];
                v[j] = (n < 64) ? (ar * br - ai * bi) : (ar * bi + ai * br); } else v[j] = 0.f; }
        u32x4 o; o.x = pk2(v[0], v[1]); o.y = pk2(v[2], v[3]); o.z = pk2(v[4], v[5]); o.w = pk2(v[6], v[7]);
        *(u32x4*)(wsm + (size_t)n * 256 + k0) = o; }
    __syncthreads();
}
__device__ __forceinline__ void rms_row_to_bf16(const float* xrow, const float* gain, bf16_t* orow, int lane) {
    const f32x4* xr = (const f32x4*)xrow + lane; const f32x4* gr = (const f32x4*)gain + lane;
    f32x4 v[8]; float s = 0.f;
#pragma unroll
    for (int j = 0; j < 8; ++j) { v[j] = xr[64 * j]; s += (v[j].x * v[j].x + v[j].y * v[j].y) + (v[j].z * v[j].z + v[j].w * v[j].w); }
    const float rstd = 1.0f / sqrtf(wave_sum(s) * (1.0f / DM) + EPS);
    unsigned long long* o8 = (unsigned long long*)orow + lane;
#pragma unroll
    for (int j = 0; j < 8; ++j) { const f32x4 gg = gr[64 * j];
        o8[64 * j] = (unsigned long long)pk2(v[j].x * rstd * gg.x, v[j].y * rstd * gg.y) | ((unsigned long long)pk2(v[j].z * rstd * gg.z, v[j].w * rstd * gg.w) << 32); }
}
__device__ __forceinline__ void p0_prologue(const Args& a, const Frame& F) {
    FRAME_IDS(F);
    for (int g = F.bx; g < S5G; g += F.G) s5_build_group(a, F, g);
    __syncthreads();
    const int gw = F.bx * NWAVES + F.wave, NGW = F.G * NWAVES; const int lane = F_lane;
    for (int m = gw; m < TT; m += NGW) rms_row_to_bf16(a.in[I_X] + (size_t)m * DM, a.in[I_N1G], (bf16_t*)(F.ws + WS_H) + (size_t)m * DM, lane);
    for (int i = gw * 64 + lane; i < TT * 32; i += NGW * 64) { const int t = i >> 5, f = i & 31;
        const double invf = exp(-(double)f * (9.210340371976184 / 32.0)); const double ang = (double)((const int*)a.in[I_POS])[t] * invf;
        ((float2*)(F.ws + WS_ROPE))[i] = make_float2((float)cos(ang), (float)sin(ang)); }
    for (int i = gw * 64 + lane; i < DM * NE; i += NGW * 64) ((float*)(F.ws + WS_SMALL + SM_WRP))[i] = a.in[I_WR][i] * a.in[I_N2G][i >> 5];
    LAS float* scr = (LAS float*)(F.lds + F.wave * 16640);
    constexpr int IT_WIN = (DM / 64) * (NPROJ / 64), IT_WUQ = (QLORA / 64) * (3072 / 64), IT_WUKV = (KVLORA / 64) * (4096 / 64), IT_SQ = (DM / 64) * (DM / 64),
                  IT_GLU = (S5W / 64) * (S5W / 64), IT_OS5 = (S5W / 64) * (DM / 64);
    constexpr int IT_MIX = IT_WIN + IT_WUQ + IT_WUKV + IT_SQ + IT_GLU + IT_OS5 + IT_SQ;
    for (int it = gw; it < IT_MIX; it += NGW) { int r = it;
        if (r < IT_WIN) { const int nb = r % (NPROJ / 64), kb = r / (NPROJ / 64); transpose_item<false>(a.in[I_WIN], IN_PROJ, win_src_col(nb * 64), kb * 64, nullptr, F.ws + WS_WIN, DM, nb * 64, 1.f, scr, lane); continue; } r -= IT_WIN;
        if (r < IT_WUQ) { const int nb = r % 48, kb = r / 48; transpose_item<false>(a.in[I_WUQ], 3072, nb * 64, kb * 64, a.in[I_QNG], F.ws + WS_WUQ, QLORA, nb * 64, 1.f, scr, lane); continue; } r -= IT_WUQ;
        if (r < IT_WUKV) { const int nb = r % 64, kb = r / 64; transpose_item<false>(a.in[I_WUKV], 4096, nb * 64, kb * 64, a.in[I_KVNG], F.ws + WS_WUKV, KVLORA, nb * 64, 1.f, scr, lane); continue; } r -= IT_WUKV;
        if (r < IT_SQ) { const int nb = r % 32, kb = r / 32; transpose_item<false>(a.in[I_WOMLA], DM, nb * 64, kb * 64, nullptr, F.ws + WS_WOMLA, DM, nb * 64, 1.f, scr, lane); continue; } r -= IT_SQ;
        if (r < IT_GLU) { const int nb = r % 16, kb = r / 16; transpose_item<false>(a.in[I_WGLU], S5W, nb * 64, kb * 64, nullptr, F.ws + WS_WGLU, S5W, nb * 64, 1.f, scr, lane); continue; } r -= IT_GLU;
        if (r < IT_OS5) { const int nb = r % 32, kb = r / 32; transpose_item<false>(a.in[I_WOS5], DM, nb * 64, kb * 64, nullptr, F.ws + WS_WOS5, S5W, nb * 64, 1.f, scr, lane); continue; } r -= IT_OS5;
        { const int nb = r % 32, kb = r / 32; transpose_item<false>(a.in[I_WOUT], DM, nb * 64, kb * 64, nullptr, F.ws + WS_WOUT, DM, nb * 64, 1.f, scr, lane); }
    }
    constexpr bool W8 = MK_FP8_MOE != 0; constexpr float WSC = W8 ? FP8_WSCALE : 1.0f; constexpr size_t WEB = W8 ? 1 : 2;
    for (int it = gw; it < NE * 2 * 32 * 32; it += NGW) { const int nb = it & 31, kb = (it >> 5) & 31, half = (it >> 10) & 1, e = it >> 11;
        const float* W = a.in[half ? I_WU : I_WG] + (size_t)e * DM * DFF; const int pn = nb >> 1, q = nb & 1;
        transpose_item<W8>(W, DFF, nb * 64, kb * 64, nullptr, F.ws + WS_W1 + (size_t)e * 4096 * DM * WEB, DM, pn * 256 + half * 128 + q * 64, WSC, scr, lane); }
    for (int it = gw; it < NE * 32 * 32; it += NGW) { const int nb = it & 31, kb = (it >> 5) & 31, e = it >> 10;
        transpose_item<W8>(a.in[I_WD] + (size_t)e * DFF * DM, DM, nb * 64, kb * 64, nullptr, F.ws + WS_W2 + (size_t)e * DM * DFF * WEB, DFF, nb * 64, WSC, scr, lane); }
}

constexpr float QSCALE = 0.07216878364870322f * 1.4426950408889634f;
__device__ __forceinline__ float half_sum(float v) {
#pragma unroll
    for (int o = 1; o < 32; o <<= 1) v += __shfl_xor(v, o);
    return v;
}
__device__ __forceinline__ void p3_prep(const Args& a, const Frame& F) {
    FRAME_IDS(F);
    const bf16_t* proj = (const bf16_t*)(F.ws + WS_PROJ); const bf16_t* qraw = (const bf16_t*)(F.ws + WS_QRAW); const bf16_t* kvraw = (const bf16_t*)(F.ws + WS_KVRAW);
    bf16_t* Qn = (bf16_t*)(F.ws + WS_QN); bf16_t* Kn = (bf16_t*)(F.ws + WS_KN); bf16_t* Vn = (bf16_t*)(F.ws + WS_VN);
    const float2* rope = (const float2*)(F.ws + WS_ROPE);
    const float* gq = a.in[I_QKQG]; const float* gk = a.in[I_QKKG];
    const int lane = F_lane, half = lane >> 5, j = lane & 31;
    const f32x4 gq4 = *(const f32x4*)(gq + 4 * j), gk4 = *(const f32x4*)(gk + 4 * j);
    const float gq1 = gq[128 + j], gq2 = gq[160 + j], gk1 = gk[128 + j], gk2 = gk[160 + j];
    const int gw = F.bx * NWAVES + F.wave, NGW = F.G * NWAVES;
    for (int it = gw; it < TT * 8; it += NGW) {
        const int t = it >> 3, h = 2 * (it & 7) + half, b = t >> 11, s = t & 2047;
        const bf16_t* prow = proj + (size_t)t * NPROJ;
        float sq = 0.f, skv = 0.f;
        { const u32x4 w = *(const u32x4*)(prow + C_QLAT + 8 * lane);
#pragma unroll
          for (int q = 0; q < 4; ++q) { const float x0 = bflo(w[q]), x1 = bfhi(w[q]); sq += x0 * x0 + x1 * x1; }
          if (lane < 32) { const u32x4 w2 = *(const u32x4*)(prow + C_KVLAT + 8 * lane);
#pragma unroll
              for (int q = 0; q < 4; ++q) { const float x0 = bflo(w2[q]), x1 = bfhi(w2[q]); skv += x0 * x0 + x1 * x1; } } }
        const float rstd_q = 1.0f / sqrtf(wave_sum(sq) * (1.0f / QLORA) + EPS), rstd_kv = 1.0f / sqrtf(wave_sum(skv) * (1.0f / KVLORA) + EPS);
        const float2 cs = rope[t * 32 + j];
        const size_t hs = ((size_t)(b * NH + h) * SEQ + s);
        { const bf16_t* qp = qraw + (size_t)t * 3072 + h * DQK; const u32x2 w = *(const u32x2*)(qp + 4 * j);
          float x0 = bflo(w.x) * rstd_q, x1 = bfhi(w.x) * rstd_q, x2 = bflo(w.y) * rstd_q, x3 = bfhi(w.y) * rstd_q;
          float r1 = bf2f(qp[128 + j]) * rstd_q, r2 = bf2f(qp[160 + j]) * rstd_q;
          const float ms = half_sum(x0 * x0 + x1 * x1 + x2 * x2 + x3 * x3 + r1 * r1 + r2 * r2) * (1.0f / DQK);
          const float rn = QSCALE / sqrtf(ms + EPS);
          x0 *= rn * gq4.x; x1 *= rn * gq4.y; x2 *= rn * gq4.z; x3 *= rn * gq4.w; r1 *= rn * gq1; r2 *= rn * gq2;
          const float o1 = r1 * cs.x - r2 * cs.y, o2 = r2 * cs.x + r1 * cs.y;
          bf16_t* qo = Qn + hs * DQK; u32x2 o; o.x = pk2(x0, x1); o.y = pk2(x2, x3); *(u32x2*)(qo + 4 * j) = o; qo[128 + j] = (bf16_t)f2bf(o1); qo[160 + j] = (bf16_t)f2bf(o2); }
        { const bf16_t* kp = kvraw + (size_t)t * 4096 + h * 256; const u32x2 w = *(const u32x2*)(kp + 4 * j); const u32x2 wv = *(const u32x2*)(kp + 128 + 4 * j);
          float x0 = bflo(w.x) * rstd_kv, x1 = bfhi(w.x) * rstd_kv, x2 = bflo(w.y) * rstd_kv, x3 = bfhi(w.y) * rstd_kv;
          float r1 = bf2f(prow[C_KR + j]), r2 = bf2f(prow[C_KR + 32 + j]);
          const float ms = half_sum(x0 * x0 + x1 * x1 + x2 * x2 + x3 * x3 + r1 * r1 + r2 * r2) * (1.0f / DQK);
          const float rn = 1.0f / sqrtf(ms + EPS);
          x0 *= rn * gk4.x; x1 *= rn * gk4.y; x2 *= rn * gk4.z; x3 *= rn * gk4.w; r1 *= rn * gk1; r2 *= rn * gk2;
          const float o1 = r1 * cs.x - r2 * cs.y, o2 = r2 * cs.x + r1 * cs.y;
          bf16_t* ko = Kn + hs * DQK; u32x2 o; o.x = pk2(x0, x1); o.y = pk2(x2, x3); *(u32x2*)(ko + 4 * j) = o; ko[128 + j] = (bf16_t)f2bf(o1); ko[160 + j] = (bf16_t)f2bf(o2);
          u32x2 ov; ov.x = pk2(bflo(wv.x) * rstd_kv, bfhi(wv.x) * rstd_kv); ov.y = pk2(bflo(wv.y) * rstd_kv, bfhi(wv.y) * rstd_kv);
          *(u32x2*)(Vn + hs * DV + 4 * j) = ov; }
    }
}

__device__ __forceinline__ void p3_scan(const Args& a, const Frame& F) {
    FRAME_IDS(F);
    const float* sch = (const float*)(F.ws + WS_SCH); bf16_t* apack = (bf16_t*)(F.ws + WS_APACK); const float2* A16 = (const float2*)(F.ws + WS_SMALL + SM_A16);
    const int gw = F.bx * NWAVES + F.wave, NGW = F.G * NWAVES, p = F_lane;
    for (int it = gw; it < NB * S5G; it += NGW) { const int b = it / S5G, g = it % S5G;
        const float2 am = A16[g * 64 + p]; float xr = 0.f, xi = 0.f;
        const size_t row0 = (size_t)g * NCHUNK + (size_t)b * 128;
        for (int c0 = 0; c0 < 128; c0 += 8) { float sr[8], si[8];
#pragma unroll
            for (int q = 0; q < 8; ++q) { sr[q] = sch[(row0 + c0 + q) * 128 + p]; si[q] = sch[(row0 + c0 + q) * 128 + 64 + p]; }
#pragma unroll
            for (int q = 0; q < 8; ++q) { bf16_t* o = apack + (row0 + c0 + q) * APK + 256; o[p] = (bf16_t)f2bf(xr); o[64 + p] = (bf16_t)f2bf(xi);
                const float nr = am.x * xr - am.y * xi + sr[q], ni = am.x * xi + am.y * xr + si[q]; xr = nr; xi = ni; } }
    }
}

__device__ __forceinline__ void s5_reference(const Args& a, const Frame& F) {
    FRAME_IDS(F);
    const bf16_t* apack = (const bf16_t*)(F.ws + WS_APACK); bf16_t* gact = (bf16_t*)(F.ws + WS_GACT);
    const int gw = F.bx * NWAVES + F.wave, NGW = F.G * NWAVES, p = F_lane;
    for (int it = gw; it < NB * S5G; it += NGW) { const int b = it / S5G, g = it % S5G;
        const float dt = expf(a.in[I_LOGDT][g]); const float lr = a.in[I_LRE][g * 64 + p], li = a.in[I_LIM][g * 64 + p];
        const float mag = expf(lr * dt); const float ar = mag * cosf(li * dt), ai = mag * sinf(li * dt); const float den = lr * lr + li * li;
        const float zr = ((ar - 1.0f) * lr + ai * li) / den, zi = (ai * lr - (ar - 1.0f) * li) / den;
        float bbr[16], bbi[16], cr[16], ci[16];
#pragma unroll
        for (int c = 0; c < 16; ++c) { const float br = a.in[I_BRE][((size_t)g * 64 + p) * 16 + c], bi = a.in[I_BIM][((size_t)g * 64 + p) * 16 + c];
            bbr[c] = zr * br - zi * bi; bbi[c] = zr * bi + zi * br; cr[c] = a.in[I_CRE][((size_t)g * 16 + c) * 64 + p]; ci[c] = a.in[I_CIM][((size_t)g * 16 + c) * 64 + p]; }
        const float dl = (p < 16) ? a.in[I_S5D][g * 16 + p] : 0.f;
        float xr = 0.f, xi = 0.f;
        for (int t = 0; t < SEQ; ++t) { const int tok = b * SEQ + t;
            const bf16_t* up = apack + ((size_t)g * NCHUNK + (tok >> 4)) * APK + (tok & 15) * 16;
            const u32x4 w0 = *(const u32x4*)up, w1 = *(const u32x4*)(up + 8); float u[16];
#pragma unroll
            for (int q = 0; q < 4; ++q) { u[2 * q] = bflo(w0[q]); u[2 * q + 1] = bfhi(w0[q]); u[8 + 2 * q] = bflo(w1[q]); u[8 + 2 * q + 1] = bfhi(w1[q]); }
            float br = 0.f, bi = 0.f;
#pragma unroll
            for (int c = 0; c < 16; ++c) { br += bbr[c] * u[c]; bi += bbi[c] * u[c]; }
            const float nr = ar * xr - ai * xi + br, ni = ar * xi + ai * xr + bi; xr = nr; xi = ni;
            float y = 0.f, um = 0.f;
#pragma unroll
            for (int c = 0; c < 16; ++c) { const float yc = wave_sum(cr[c] * xr - ci[c] * xi); if (p == c) { y = yc; um = u[c]; } }
            if (p < 16) gact[(size_t)tok * S5W + g * 16 + p] = (bf16_t)f2bf(gelu_tanh(y + dl * um));
        }
    }
}

__device__ __forceinline__ float attn_bound(const Args& a, int lane) {
    float mq = 0.f, mk = 0.f;
#pragma unroll
    for (int q = 0; q < 3; ++q) { mq = fmaxf(mq, fabsf(a.in[I_QKQG][lane + 64 * q])); mk = fmaxf(mk, fabsf(a.in[I_QKKG][lane + 64 * q])); }
#pragma unroll
    for (int o = 1; o < 64; o <<= 1) { mq = fmaxf(mq, __shfl_xor(mq, o)); mk = fmaxf(mk, __shfl_xor(mk, o)); }
    return mq * mk * 13.856406460551018f * 1.4426950408889634f;
}
__device__ __forceinline__ void attn_reference(const Args& a, const Frame& F) {
    FRAME_IDS(F);
    const bf16_t* Qn = (const bf16_t*)(F.ws + WS_QN); const bf16_t* Kn = (const bf16_t*)(F.ws + WS_KN); const bf16_t* Vn = (const bf16_t*)(F.ws + WS_VN);
    bf16_t* O = (bf16_t*)(F.ws + WS_O);
    LAS float* ql = (LAS float*)(F.lds + F.wave * 1024);
    const int lane = F_lane, gw = F.bx * NWAVES + F.wave, NGW = F.G * NWAVES;
    const float Mb = attn_bound(a, lane);
    for (int it = gw; it < NB * NH * SEQ; it += NGW) { const int s = it & 2047, bh = it >> 11, b = bh >> 4, h = bh & 15;
        const bf16_t* qp = Qn + ((size_t)bh * SEQ + s) * DQK;
#pragma unroll
        for (int q = 0; q < 3; ++q) ql[lane + 64 * q] = bf2f(qp[lane + 64 * q]);
        LDS_WAIT();
        const int nk = 64 * ((s >> 6) + 1);
        float o0 = 0.f, o1 = 0.f, l = 0.f;
        for (int k0 = 0; k0 < nk; k0 += 64) {
            const bf16_t* kp = Kn + ((size_t)bh * SEQ + k0 + lane) * DQK; float sc = 0.f;
            for (int d = 0; d < DQK; d += 8) { const u32x4 w = *(const u32x4*)(kp + d);
#pragma unroll
                for (int q = 0; q < 4; ++q) sc += bflo(w[q]) * ql[d + 2 * q] + bfhi(w[q]) * ql[d + 2 * q + 1]; }
            const float pr = __builtin_amdgcn_exp2f(sc - Mb); l += pr;
            for (int kk = 0; kk < 64; ++kk) { const float pk = __shfl(pr, kk); const unsigned w = *(const unsigned*)(Vn + ((size_t)bh * SEQ + k0 + kk) * DV + 2 * lane);
                o0 += pk * bflo(w); o1 += pk * bfhi(w); }
        }
        l = wave_sum(l); const float rl = 1.0f / l;
        *(unsigned*)(O + ((size_t)(b * SEQ + s)) * DM + h * DV + 2 * lane) = pk2(o0 * rl, o1 * rl);
        LDS_WAIT();
    }
}

namespace at {
constexpr int KVB = 64;
constexpr int SHM_V = KVB * DV * 2  , SHM_K = KVB * DQK * 2  ;
constexpr int NQR = 4;
constexpr int OFF_V = 0, OFF_K = 2 * SHM_V, OFF_WS = OFF_K + 2 * SHM_K  , OFF_QL = OFF_WS + NWAVES * 256  , OFF_OST = 0;
constexpr int OPITCH = 272;
static_assert(OFF_QL + NWAVES * (12 - NQR) * 1024 <= LDSCTL_OFF, "attention LDS map");
#define KSWZ(row, colB) ((row) * 384 + ((colB) ^ (((row) & 7) << 4)))
__device__ __forceinline__ int crow(int r, int hi) { return (r & 3) + 8 * (r >> 2) + 4 * hi; }
__device__ __forceinline__ int v_st(int k, int c) { const int kk = (k & ~0xC) | ((k & 4) << 1) | ((k & 8) >> 1); return ((kk >> 3) * 4 + (c >> 5)) * 512 + ((kk & 7) * 32 + (c & 31)) * 2; }
__device__ __forceinline__ int v_rd_base(int lane) { return ((lane & 3) << 3) | (((lane >> 2) & 3) << 6) | (((lane >> 4) & 1) << 5) | (((lane >> 5) & 1) << 8); }
constexpr int v_rd_off(int d0, int ks, int half) { return d0 * 512 + ks * 4096 + half * 2048; }
template <int OFF> __device__ __forceinline__ s16x4 tr_read(int vb) { s16x4 r; asm volatile("ds_read_b64_tr_b16 %0, %1 offset:%2" : "=&v"(r) : "v"(vb), "i"(OFF) : "memory"); return r; }
template <int D0> __device__ __forceinline__ void pv_one(f32x16& od, int vb, bf16x8 pa0, bf16x8 pa1, bf16x8 pa2, bf16x8 pa3) {
    const s16x4 l0 = tr_read<v_rd_off(D0, 0, 0)>(vb), h0 = tr_read<v_rd_off(D0, 0, 1)>(vb), l1 = tr_read<v_rd_off(D0, 1, 0)>(vb), h1 = tr_read<v_rd_off(D0, 1, 1)>(vb);
    const s16x4 l2 = tr_read<v_rd_off(D0, 2, 0)>(vb), h2 = tr_read<v_rd_off(D0, 2, 1)>(vb), l3 = tr_read<v_rd_off(D0, 3, 0)>(vb), h3 = tr_read<v_rd_off(D0, 3, 1)>(vb);
    asm volatile("s_waitcnt lgkmcnt(0)" ::: "memory"); SBAR();
#define PK(L, H) (bf16x8){L[0], L[1], L[2], L[3], H[0], H[1], H[2], H[3]}
    od = __builtin_amdgcn_mfma_f32_32x32x16_bf16(pa0, PK(l0, h0), od, 0, 0, 0);
    od = __builtin_amdgcn_mfma_f32_32x32x16_bf16(pa1, PK(l1, h1), od, 0, 0, 0);
    od = __builtin_amdgcn_mfma_f32_32x32x16_bf16(pa2, PK(l2, h2), od, 0, 0, 0);
    od = __builtin_amdgcn_mfma_f32_32x32x16_bf16(pa3, PK(l3, h3), od, 0, 0, 0);
#undef PK
}
__device__ __forceinline__ void pv_d0(f32x16* o, int vb, bf16x8 pa0, bf16x8 pa1, bf16x8 pa2, bf16x8 pa3) {
    pv_one<0>(o[0], vb, pa0, pa1, pa2, pa3); pv_one<1>(o[1], vb, pa0, pa1, pa2, pa3); pv_one<2>(o[2], vb, pa0, pa1, pa2, pa3); pv_one<3>(o[3], vb, pa0, pa1, pa2, pa3);
}
template <int BUF, int NQR> __device__ __forceinline__ void qkt(f32x16& p0, f32x16& p1, const int (&kb)[4], const bf16x8* qr, int qlb) {
    p0 = f32x16{}; p1 = f32x16{};
#pragma unroll
    for (int a = 0; a < 3; ++a)
#pragma unroll
        for (int b = 0; b < 4; ++b) { const int d0 = 4 * a + b;
            const bf16x8 b0 = *(const LAS bf16x8*)(kb[b] + BUF * SHM_K + a * 128);
            const bf16x8 b1 = *(const LAS bf16x8*)(kb[b] + BUF * SHM_K + a * 128 + 32 * 384);
            bf16x8 q; if (d0 < NQR) q = qr[d0]; else q = *(const LAS bf16x8*)(qlb + (d0 - NQR) * 1024);
            p0 = __builtin_amdgcn_mfma_f32_32x32x16_bf16(b0, q, p0, 0, 0, 0);
            p1 = __builtin_amdgcn_mfma_f32_32x32x16_bf16(b1, q, p1, 0, 0, 0); }
}
__device__ __forceinline__ void partialSM(f32x16& p0, f32x16& p1, float bias) {
#pragma unroll
    for (int r = 0; r < 16; ++r) p0[r] = __builtin_amdgcn_exp2f(p0[r] + bias);
#pragma unroll
    for (int r = 0; r < 16; ++r) p1[r] = p1[r] + bias;
}
__device__ __forceinline__ void finishSM(f32x16& p0, f32x16& p1, float& l_reg, bf16x8& pa0, bf16x8& pa1, bf16x8& pa2, bf16x8& pa3) {
#pragma unroll
    for (int r = 0; r < 16; ++r) p1[r] = __builtin_amdgcn_exp2f(p1[r]);
    float ps = 0;
#pragma unroll
    for (int r = 0; r < 16; ++r) ps += p0[r];
#pragma unroll
    for (int r = 0; r < 16; ++r) ps += p1[r];
    { auto rr = __builtin_amdgcn_permlane32_swap(__float_as_uint(ps), __float_as_uint(ps), false, false); ps = __uint_as_float(rr[0]) + __uint_as_float(rr[1]); }
    l_reg += ps;
#define PK4(P, BASE, OUT) do { unsigned a0 = cvt_pk_bf16(P[BASE + 0], P[BASE + 1]), a1 = cvt_pk_bf16(P[BASE + 2], P[BASE + 3]);   \
    unsigned b0 = cvt_pk_bf16(P[BASE + 4], P[BASE + 5]), b1 = cvt_pk_bf16(P[BASE + 6], P[BASE + 7]);                              \
    auto r0 = __builtin_amdgcn_permlane32_swap(a0, b0, false, false); auto r1 = __builtin_amdgcn_permlane32_swap(a1, b1, false, false); \
    u32x4 w = {r0[0], r1[0], r0[1], r1[1]}; OUT = *reinterpret_cast<bf16x8*>(&w); } while (0)
    PK4(p0, 0, pa0); PK4(p0, 8, pa1); PK4(p1, 0, pa2); PK4(p1, 8, pa3);
#undef PK4
}
__device__ __forceinline__ void attn_qblock(const bf16_t* __restrict__ Qb, const bf16_t* __restrict__ Kh, const bf16_t* __restrict__ Vh, bf16_t* __restrict__ Ob, int qb, float Mb, LAS char* lds, const int wid) {
    const int lane = fresh_lane(), tid = wid * 64 + lane, r32 = lane & 31, hi = lane >> 5;
    LAS char* V_lds = lds + OFF_V; LAS char* K_lds = lds + OFF_K;
    LAS float* li_l = (LAS float*)(lds + OFF_WS) + wid * 64;
    float l_reg = 0; f32x16 o[4] = {}; bf16x8 qr[NQR];
    const bf16_t* Qw = Qb + (size_t)(wid * 32 + r32) * DQK + hi * 8;
    const int qlb = (int)(uintptr_t)(lds + OFF_QL) + wid * ((12 - NQR) * 1024) + lane * 16;
#pragma unroll
    for (int d0 = 0; d0 < NQR; ++d0) qr[d0] = *(const bf16x8*)(Qw + d0 * 16);
#pragma unroll
    for (int d0 = NQR; d0 < 12; ++d0) *(LAS bf16x8*)(qlb + (d0 - NQR) * 1024) = *(const bf16x8*)(Qw + d0 * 16);
    const int sr = tid >> 4, sc = (tid & 15) * 8, vst0 = v_st(sr, sc), vst1 = v_st(32 + sr, sc);
    int kro[3], kst[3];
#pragma unroll
    for (int i = 0; i < 3; ++i) { const int q = tid + 512 * i, row = q / 24, c8 = q % 24; kro[i] = row * DQK + c8 * 8; kst[i] = KSWZ(row, c8 * 16); }
    const int vb0 = (int)(uintptr_t)V_lds + v_rd_base(lane);
    int kb[4];
#pragma unroll
    for (int b = 0; b < 4; ++b) kb[b] = (int)(uintptr_t)K_lds + r32 * 384 + ((b * 32 + hi * 16) ^ ((r32 & 7) << 4));
    bf16x8 vs0, vs1, ks0, ks1, ks2;
#define SLOAD(k0) do { vs0 = *(const bf16x8*)(Vh + (size_t)((k0) + sr) * DV + sc); vs1 = *(const bf16x8*)(Vh + (size_t)((k0) + 32 + sr) * DV + sc); \
    ks0 = *(const bf16x8*)(Kh + (size_t)(k0) * DQK + kro[0]); ks1 = *(const bf16x8*)(Kh + (size_t)(k0) * DQK + kro[1]); ks2 = *(const bf16x8*)(Kh + (size_t)(k0) * DQK + kro[2]); } while (0)
#define SWRITE(b) do { *(LAS bf16x8*)(V_lds + (b) * SHM_V + vst0) = vs0; *(LAS bf16x8*)(V_lds + (b) * SHM_V + vst1) = vs1; \
    *(LAS bf16x8*)(K_lds + (b) * SHM_K + kst[0]) = ks0; *(LAS bf16x8*)(K_lds + (b) * SHM_K + kst[1]) = ks1; *(LAS bf16x8*)(K_lds + (b) * SHM_K + kst[2]) = ks2; } while (0)
    const int NT = 4 * qb + 4, jmax = 4 * qb + (wid >> 1);
    const float NEG_INF = -__builtin_inff();
#define BIAS(j) (((j) <= jmax) ? -Mb : NEG_INF)
    f32x16 pA0, pA1, pB0, pB1; bf16x8 pa0, pa1, pa2, pa3;
    SLOAD(0); asm volatile("s_waitcnt vmcnt(0)" ::: "memory"); SWRITE(0); __syncthreads();
    qkt<0, NQR>(pA0, pA1, kb, qr, qlb); partialSM(pA0, pA1, BIAS(0));
    SLOAD(KVB); asm volatile("s_waitcnt vmcnt(0)" ::: "memory"); SWRITE(1); __syncthreads();
    for (int j = 1; j + 1 < NT; j += 2) {
        SBAR(); qkt<1, NQR>(pB0, pB1, kb, qr, qlb);
        finishSM(pA0, pA1, l_reg, pa0, pa1, pa2, pa3); SBAR();
        SLOAD((j + 1) * KVB); SBAR();
        pv_d0(o, vb0, pa0, pa1, pa2, pa3); partialSM(pB0, pB1, BIAS(j));
        __syncthreads(); asm volatile("s_waitcnt vmcnt(0)" ::: "memory"); SWRITE(0);
        __syncthreads();
        SBAR(); qkt<0, NQR>(pA0, pA1, kb, qr, qlb);
        finishSM(pB0, pB1, l_reg, pa0, pa1, pa2, pa3); SBAR();
        SLOAD((j + 2) * KVB); SBAR();
        pv_d0(o, vb0 + SHM_V, pa0, pa1, pa2, pa3); partialSM(pA0, pA1, BIAS(j + 1));
        __syncthreads(); asm volatile("s_waitcnt vmcnt(0)" ::: "memory"); SWRITE(1);
        __syncthreads();
    }
    SBAR(); qkt<1, NQR>(pB0, pB1, kb, qr, qlb);
    finishSM(pA0, pA1, l_reg, pa0, pa1, pa2, pa3); SBAR();
    pv_d0(o, vb0, pa0, pa1, pa2, pa3); partialSM(pB0, pB1, BIAS(NT - 1));
    finishSM(pB0, pB1, l_reg, pa0, pa1, pa2, pa3); SBAR();
    pv_d0(o, vb0 + SHM_V, pa0, pa1, pa2, pa3);
    __syncthreads();
    const int lane2 = fresh_lane(), r32b = lane2 & 31, hib = lane2 >> 5, wid2 = wid;
    LAS float* li2 = (LAS float*)(lds + OFF_WS) + wid2 * 64;
    if (hib == 0) li2[r32b] = l_reg; LDS_WAIT();
    LAS char* ost = lds + OFF_OST + wid2 * (32 * OPITCH) + hib * (4 * OPITCH) + r32b * 2;
#pragma unroll
    for (int r = 0; r < 16; ++r) { const int orc = (r & 3) + 8 * (r >> 2); const float rl = __builtin_amdgcn_rcpf(li2[orc + 4 * hib]);
#pragma unroll
        for (int d0 = 0; d0 < 4; ++d0) *(LAS bf16_t*)(ost + orc * OPITCH + d0 * 64) = (bf16_t)f2bf(o[d0][r] * rl); }
    LDS_WAIT();
    bf16_t* Ow = Ob + (size_t)(wid2 * 32 + (lane2 >> 4)) * DM + (lane2 & 15) * 8;
    const LAS char* ord = lds + OFF_OST + wid2 * (32 * OPITCH) + (lane2 >> 4) * OPITCH + (lane2 & 15) * 16;
#pragma unroll
    for (int i = 0; i < 8; ++i) { const u32x4 w = *(const LAS u32x4*)(ord + i * 4 * OPITCH); *(u32x4*)(Ow + (size_t)(i * 4) * DM) = w; }
    __syncthreads();
#undef SLOAD
#undef SWRITE
#undef BIAS
}
#undef KSWZ
}
__device__ __forceinline__ void p4_attention(const Args& a, const Frame& F) {
    FRAME_IDS(F);
    const bf16_t* Qn = (const bf16_t*)(F.ws + WS_QN); const bf16_t* Kn = (const bf16_t*)(F.ws + WS_KN); const bf16_t* Vn = (const bf16_t*)(F.ws + WS_VN);
    bf16_t* O = (bf16_t*)(F.ws + WS_O);
    const float Mb = attn_bound(a, F_lane);
    for (int id = F.bx; id < NB * NH * 4; id += F.G) { const int x = id & 7, idx = id >> 3, bh = x + 8 * (idx >> 2), pr = idx & 3, b = bh >> 4, h = bh & 15;
        const bf16_t* Kh = Kn + (size_t)bh * SEQ * DQK; const bf16_t* Vh = Vn + (size_t)bh * SEQ * DV;
#pragma unroll 1
        for (int w = 0; w < 2; ++w) { const int qb = w ? pr : 7 - pr;
            at::attn_qblock(Qn + ((size_t)bh * SEQ + qb * 256) * DQK, Kh, Vh, O + ((size_t)(b * SEQ + qb * 256)) * DM + h * DV, qb, Mb, (LAS char*)F.lds, F.wave); }
    }
}

__device__ __forceinline__ void p8_norm2_router(const Args& a, const Frame& F, const float* x1) {
    FRAME_IDS(F);
    bf16_t* H2 = (bf16_t*)(F.ws + WS_H2); int* topi = (int*)(F.ws + WS_TOPI); float* topw = (float*)(F.ws + WS_TOPW);
    const float* wrp = (const float*)(F.ws + WS_SMALL + SM_WRP); const float* g2 = a.in[I_N2G];
    const int lane = F_lane, wave = F.wave, tid = F_tid, i = lane & 31, kk = lane >> 5;
    LAS uchar* xs = F.lds + wave * 8704;
    LAS float* part = (LAS float*)(F.lds + 69632);
    LAS float* ssqp = (LAS float*)(F.lds + 69632 + 33792);
    LAS float* logit = ssqp + 256;
    LAS float* rstdl = logit + 32 * 33;
    for (int tile = F.bx; tile < TT / 32; tile += F.G) {
        const int t0 = tile * 32;
        f32x16 acc = {}; float ssq = 0.f;
        for (int ch = 0; ch < 4; ++ch) { const int k0 = wave * 256 + ch * 64;
            f32x4 v[8];
#pragma unroll
            for (int j = 0; j < 8; ++j) v[j] = *(const f32x4*)(x1 + (size_t)(t0 + 4 * j + (lane >> 4)) * DM + k0 + (lane & 15) * 4);
#pragma unroll
            for (int j = 0; j < 8; ++j) *(LAS f32x4*)(xs + (4 * j + (lane >> 4)) * 272 + (lane & 15) * 16) = v[j];
            LDS_WAIT(); asm volatile("" ::: "memory");
            const float* wp = wrp + (size_t)(k0 + kk * 32) * NE + i;
#pragma unroll
            for (int s4 = 0; s4 < 8; ++s4) { const f32x4 xv = *(const LAS f32x4*)(xs + i * 272 + kk * 128 + s4 * 16);
#pragma unroll
                for (int q = 0; q < 4; ++q) { const float b = wp[(s4 * 4 + q) * NE]; acc = __builtin_amdgcn_mfma_f32_32x32x2f32(xv[q], b, acc, 0, 0, 0); ssq += xv[q] * xv[q]; } }
            LDS_WAIT(); asm volatile("" ::: "memory");
        }
#pragma unroll
        for (int r = 0; r < 16; ++r) part[(wave * 32 + (r & 3) + 8 * (r >> 2) + 4 * kk) * 33 + i] = acc[r];
        ssq += __shfl_xor(ssq, 32);
        if (kk == 0) ssqp[wave * 32 + i] = ssq;
        __syncthreads();
        { const int row = tid >> 4, e0 = (tid & 15) * 2; float s0 = 0.f, s1 = 0.f;
#pragma unroll
          for (int w = 0; w < 8; ++w) { s0 += part[(w * 32 + row) * 33 + e0]; s1 += part[(w * 32 + row) * 33 + e0 + 1]; }
          logit[row * 33 + e0] = s0; logit[row * 33 + e0 + 1] = s1;
          if (tid < 32) { float q = 0.f;
#pragma unroll
              for (int w = 0; w < 8; ++w) q += ssqp[w * 32 + tid];
              rstdl[tid] = 1.0f / sqrtf(q * (1.0f / DM) + EPS); } }
        __syncthreads();
        if (tid < 32) { const float rs = rstdl[tid]; float lg[32];
#pragma unroll
            for (int e = 0; e < 32; ++e) lg[e] = logit[tid * 33 + e] * rs + a.in[I_BR][e];
            int bi[4]; float bv[4];
#pragma unroll
            for (int k = 0; k < 4; ++k) { float m = -3.0e38f; int mi = 0;
#pragma unroll
                for (int e = 0; e < 32; ++e) { const bool used = (k > 0 && bi[0] == e) || (k > 1 && bi[1] == e) || (k > 2 && bi[2] == e); if (!used && lg[e] > m) { m = lg[e]; mi = e; } }
                bi[k] = mi; bv[k] = m; }
            const float e1 = __expf(bv[1] - bv[0]), e2 = __expf(bv[2] - bv[0]), e3 = __expf(bv[3] - bv[0]); const float rsum = 1.0f / (1.0f + e1 + e2 + e3);
            const int t = t0 + tid;
            *(int4*)(topi + 4 * t) = make_int4(bi[0], bi[1], bi[2], bi[3]); *(float4*)(topw + 4 * t) = make_float4(rsum, e1 * rsum, e2 * rsum, e3 * rsum); }
#pragma unroll 4
        for (int it = 0; it < 16; ++it) { const int idx = it * NTHREADS + tid, row = idx >> 8, c8 = (idx & 255) * 8; const float rs = rstdl[row];
            const f32x4 x0 = *(const f32x4*)(x1 + (size_t)(t0 + row) * DM + c8), x1v = *(const f32x4*)(x1 + (size_t)(t0 + row) * DM + c8 + 4);
            const f32x4 g0 = *(const f32x4*)(g2 + c8), g1 = *(const f32x4*)(g2 + c8 + 4);
#if MK_FP8_MOE
            const float rs4 = rs * FP8_ASCALE; u32x2 o; o.x = pk4_fp8(x0.x * rs4 * g0.x, x0.y * rs4 * g0.y, x0.z * rs4 * g0.z, x0.w * rs4 * g0.w); o.y = pk4_fp8(x1v.x * rs4 * g1.x, x1v.y * rs4 * g1.y, x1v.z * rs4 * g1.z, x1v.w * rs4 * g1.w);
            *(u32x2*)((uchar*)H2 + (size_t)(t0 + row) * DM + c8) = o; }
#else
            u32x4 o; o.x = pk2(x0.x * rs * g0.x, x0.y * rs * g0.y); o.y = pk2(x0.z * rs * g0.z, x0.w * rs * g0.w); o.z = pk2(x1v.x * rs * g1.x, x1v.y * rs * g1.y); o.w = pk2(x1v.z * rs * g1.z, x1v.w * rs * g1.w);
            *(u32x4*)(H2 + (size_t)(t0 + row) * DM + c8) = o; }
#endif
        __syncthreads();
    }
}

__device__ __forceinline__ void p9_routing(const Args& a, const Frame& F) {
    FRAME_IDS(F);
    const int* topi = (const int*)(F.ws + WS_TOPI); int* tpos = (int*)(F.ws + WS_TPOS); int* list = (int*)(F.ws + WS_LIST); int* counts = (int*)(F.ws + WS_SMALL + SM_COUNTS);
    LAS int* wtot = (LAS int*)F.lds;
    for (int e = F.bx; e < NE; e += F.G) {
        __syncthreads();
        const int t0 = F.wave * (TT / NWAVES);
        int cnt = 0;
        for (int i = 0; i < TT / NWAVES / 64; ++i) { const int4 ti = *(const int4*)(topi + 4 * (t0 + i * 64 + F_lane));
            const bool hit = (ti.x == e) | (ti.y == e) | (ti.z == e) | (ti.w == e); cnt += __popcll(__ballot(hit)); }
        if (F_lane == 0) wtot[F.wave] = cnt;
        __syncthreads();
        int base = 0, total = 0;
        for (int w = 0; w < NWAVES; ++w) { const int c = wtot[w]; if (w < F.wave) base += c; total += c; }
        for (int i = 0; i < TT / NWAVES / 64; ++i) { const int t = t0 + i * 64 + F_lane; const int4 ti = *(const int4*)(topi + 4 * t);
            const int k = (ti.x == e) ? 0 : (ti.y == e) ? 1 : (ti.z == e) ? 2 : (ti.w == e) ? 3 : -1;
            const unsigned long long bal = __ballot(k >= 0); const int pos = base + __popcll(bal & ((1ull << F_lane) - 1ull));
            if (k >= 0) { list[(size_t)e * TT + pos] = t; tpos[4 * t + k] = pos; }
            base += __popcll(bal); }
        for (int q = total + F_tid; q < ((total + 255) & ~255); q += NTHREADS) list[(size_t)e * TT + q] = 0;
        if (F_tid == 0) counts[e] = total;
    }
}
__device__ __forceinline__ void moe_tables(const Frame& F, LAS int* tab) {
    FRAME_IDS(F);
    const int* counts = (const int*)(F.ws + WS_SMALL + SM_COUNTS);
    __syncthreads();
    if (F_tid == 0) { int pre = 0; for (int e = 0; e < NE; ++e) { const int c = counts[e]; tab[e] = c; const int nt = (c + 255) >> 8; tab[32 + e] = nt; tab[64 + e] = pre; tab[128 + e] = nt > 0 ? ((1 << 20) + nt - 1) / nt : 0; pre += nt; } tab[96] = pre; }
    __syncthreads();
}

__device__ __forceinline__ void p10_permute(const Args& a, const Frame& F, const LAS int* tab) {
    FRAME_IDS(F);
    constexpr size_t ROWB = MK_FP8_MOE ? DM : 2 * DM;
    const uchar* H2 = F.ws + WS_H2; uchar* XP = F.ws + WS_XPERM; const int* list = (const int*)(F.ws + WS_LIST);
    const int ntiles = tab[96];
    for (int tile = F.bx; tile < ntiles; tile += F.G) {
        int e = 0;
#pragma unroll 1
        for (int q = 1; q < NE; ++q) if (tab[64 + q] <= tile) e = q;
        const int p0 = (tile - tab[64 + e]) * 256;
        for (int r = F.wave; r < 256; r += NWAVES) { const int tok = list[(size_t)e * TT + p0 + r];
            const uchar* src = H2 + (size_t)tok * ROWB; uchar* dst = XP + ((size_t)tile * 256 + r) * ROWB;
#pragma unroll
            for (int c = 0; c < (int)(ROWB / 1024); ++c) *(u32x4*)(dst + c * 1024 + F_lane * 16) = *(const u32x4*)(src + c * 1024 + F_lane * 16); }
    }
}

__device__ __forceinline__ void p12_combine(const Args& a, const Frame& F, float* out, const LAS int* tab) {
    FRAME_IDS(F);
    const bf16_t* ys = (const bf16_t*)(F.ws + WS_YSLOT); const int* topi = (const int*)(F.ws + WS_TOPI); const float* topw = (const float*)(F.ws + WS_TOPW); const int* tpos = (const int*)(F.ws + WS_TPOS);
    const int lane = F_lane, gw = F.bx * NWAVES + F.wave, NGW = F.G * NWAVES;
    for (int t = gw; t < TT; t += NGW) {
        const int4 ti = *(const int4*)(topi + 4 * t), tp = *(const int4*)(tpos + 4 * t); const float4 tw = *(const float4*)(topw + 4 * t);
        const bf16_t* r0 = ys + ((size_t)tab[64 + ti.x] * 256 + tp.x) * DM; const bf16_t* r1 = ys + ((size_t)tab[64 + ti.y] * 256 + tp.y) * DM;
        const bf16_t* r2 = ys + ((size_t)tab[64 + ti.z] * 256 + tp.z) * DM; const bf16_t* r3 = ys + ((size_t)tab[64 + ti.w] * 256 + tp.w) * DM;
        float* orow = out + (size_t)t * DM;
#pragma unroll
        for (int j = 0; j < 4; ++j) { const int c = j * 512 + lane * 8;
            const u32x4 a0 = *(const u32x4*)(r0 + c), a1 = *(const u32x4*)(r1 + c), a2 = *(const u32x4*)(r2 + c), a3 = *(const u32x4*)(r3 + c);
            f32x4 x0 = *(const f32x4*)(orow + c), x1 = *(const f32x4*)(orow + c + 4);
#pragma unroll
            for (int q = 0; q < 2; ++q) {
                x0[2 * q] += tw.x * bflo(a0[q]) + tw.y * bflo(a1[q]) + tw.z * bflo(a2[q]) + tw.w * bflo(a3[q]);
                x0[2 * q + 1] += tw.x * bfhi(a0[q]) + tw.y * bfhi(a1[q]) + tw.z * bfhi(a2[q]) + tw.w * bfhi(a3[q]);
                x1[2 * q] += tw.x * bflo(a0[2 + q]) + tw.y * bflo(a1[2 + q]) + tw.z * bflo(a2[2 + q]) + tw.w * bflo(a3[2 + q]);
                x1[2 * q + 1] += tw.x * bfhi(a0[2 + q]) + tw.y * bfhi(a1[2 + q]) + tw.z * bfhi(a2[2 + q]) + tw.w * bfhi(a3[2 + q]); }
            *(f32x4*)(orow + c) = x0; *(f32x4*)(orow + c + 4) = x1; }
    }
}

constexpr int NPHASE = 14;
__global__ void __launch_bounds__(NTHREADS, 2) mk_fwd(Args a) {
    extern __shared__ __attribute__((aligned(16))) uchar lds_raw[];
    Frame F; F.lds = (LAS uchar*)lds_raw; F.ws = a.ws; F.wave = __builtin_amdgcn_readfirstlane(threadIdx.x >> 6); F.G = gridDim.x; F.bx = blockIdx.x;
    FRAME_IDS(F);
    volatile LAS unsigned* MISC = (volatile LAS unsigned*)(F.lds + MISC_OFF);
    LAS int* tab = (LAS int*)(F.lds + LDSCTL_OFF + 512);
    for (int u = F_tid; u < (LDS_BYTES - LDSCTL_OFF) / 4; u += NTHREADS) ((LAS unsigned*)(F.lds + LDSCTL_OFF))[u] = 0u;
    __syncthreads();
    XcdBarrier bar; bar.bar = (unsigned*)(a.ws + WS_CTL) + CW_BAR; bar.x = 0; bar.st = nullptr; bar.wave = F.wave;
    const int lo = a.ph_lo, hi = a.ph_hi;
    if (hi - lo > 1) bar = xcd_barrier_post((unsigned*)(a.ws + WS_CTL) + CW_BAR, MISC + 8, F.wave);
#ifndef MK_PHASE_MASK
#define MK_PHASE_MASK 0xffff
#endif
#define IN(k) (((MK_PHASE_MASK >> (k)) & 1) && lo <= (k) && (k) < hi)
#ifdef MK_PROBE_LO
    unsigned long long pr_t0 = 0, pr_t1 = 0;
#define PROBE_AT(k) do { if ((k) == MK_PROBE_LO) pr_t0 = __builtin_amdgcn_s_memrealtime(); if ((k) == MK_PROBE_HI + 1) pr_t1 = __builtin_amdgcn_s_memrealtime(); } while (0)
#else
#define PROBE_AT(k) do { } while (0)
#endif
#define SEAM(k) do { if (IN(k) && IN((k) + 1)) xcd_barrier(bar); } while (0)
    LAS uchar* ring = F.lds;
    uchar* ws = a.ws;
    const int G = F.G, bx = F.bx;

    PROBE_AT(0);
    if (IN(0)) { p0_prologue(a, F); } SEAM(0); PROBE_AT(1);

    if (IN(1)) {
        gm::ProbDense P; P.init((const bf16_t*)(ws + WS_H), DM, (const bf16_t*)(ws + WS_WIN), DM, DM, TT, NPROJ, G, bx);
        EpiInProj E{(bf16_t*)(ws + WS_PROJ), (bf16_t*)(ws + WS_APACK), a.in[I_BG]};
        gm::gemm_phase<gm::ProbDense, EpiInProj, false>(ring, P, E, F.wave);
    } SEAM(1); PROBE_AT(2);

    if (IN(2)) {
        { gm::ProbDense P; P.init((const bf16_t*)(ws + WS_PROJ) + C_QLAT, NPROJ, (const bf16_t*)(ws + WS_WUQ), QLORA, QLORA, TT, NH * DQK, G, bx);
          EpiStoreBf16 E{(bf16_t*)(ws + WS_QRAW), NH * DQK}; gm::gemm_phase<gm::ProbDense, EpiStoreBf16, false>(ring, P, E, F.wave); }
        { gm::ProbDense P; P.init((const bf16_t*)(ws + WS_PROJ) + C_KVLAT, NPROJ, (const bf16_t*)(ws + WS_WUKV), KVLORA, KVLORA, TT, NH * 256, G, bx);
          EpiStoreBf16 E{(bf16_t*)(ws + WS_KVRAW), NH * 256}; gm::gemm_phase<gm::ProbDense, EpiStoreBf16, false>(ring, P, E, F.wave); }
#if MK_FAST_S5
        { ProbS5 P{(const bf16_t*)(ws + WS_APACK), (const bf16_t*)(ws + WS_WS5), APK, 256, 4, G, bx};
          EpiS5State E{(float*)(ws + WS_SCH)}; gm::gemm_phase<ProbS5, EpiS5State, false>(ring, P, E, F.wave); }
#endif
    } SEAM(2); PROBE_AT(3);

    if (IN(3)) {
        p3_prep(a, F);
#if MK_FAST_S5
        p3_scan(a, F);
#endif
    } SEAM(3); PROBE_AT(4);

    if (IN(4)) {
#if MK_FAST_S5
        { ProbS5 P{(const bf16_t*)(ws + WS_APACK), (const bf16_t*)(ws + WS_TWC), APK, APK, 6, G, bx};
          EpiS5Out E{(bf16_t*)(ws + WS_GACT)}; gm::gemm_phase<ProbS5, EpiS5Out, false>(ring, P, E, F.wave); }
#else
        s5_reference(a, F);
#endif
#if MK_FAST_ATTN
        p4_attention(a, F);
#else
        attn_reference(a, F);
#endif
    } SEAM(4); PROBE_AT(5);

    if (IN(5)) {
        { gm::ProbDense P; P.init((const bf16_t*)(ws + WS_GACT), S5W, (const bf16_t*)(ws + WS_WGLU), S5W, S5W, TT, S5W, G, bx);
          EpiSide<0> E{(bf16_t*)(ws + WS_Y2), S5W, (const bf16_t*)(ws + WS_GACT), S5W, nullptr, 0}; gm::gemm_phase<gm::ProbDense, EpiSide<0>, false>(ring, P, E, F.wave); }
        { gm::ProbDense P; P.init((const bf16_t*)(ws + WS_O), DM, (const bf16_t*)(ws + WS_WOMLA), DM, DM, TT, DM, G, bx);
          EpiSide<1> E{(bf16_t*)(ws + WS_MA), DM, (const bf16_t*)(ws + WS_PROJ) + C_GA, NPROJ, nullptr, 0}; gm::gemm_phase<gm::ProbDense, EpiSide<1>, false>(ring, P, E, F.wave); }
    } SEAM(5); PROBE_AT(6);

    if (IN(6)) {
        gm::ProbDense P; P.init((const bf16_t*)(ws + WS_Y2), S5W, (const bf16_t*)(ws + WS_WOS5), S5W, S5W, TT, DM, G, bx);
        EpiSide<2> E{(bf16_t*)(ws + WS_M), DM, (const bf16_t*)(ws + WS_PROJ) + C_GB, NPROJ, (const bf16_t*)(ws + WS_MA), DM}; gm::gemm_phase<gm::ProbDense, EpiSide<2>, false>(ring, P, E, F.wave);
    } SEAM(6); PROBE_AT(7);

    if (IN(7)) {
        gm::ProbDense P; P.init((const bf16_t*)(ws + WS_M), DM, (const bf16_t*)(ws + WS_WOUT), DM, DM, TT, DM, G, bx);
        EpiResidF32 E{a.in[I_X], a.out}; gm::gemm_phase<gm::ProbDense, EpiResidF32, false>(ring, P, E, F.wave);
    } SEAM(7); PROBE_AT(8);

    if (IN(8)) { p8_norm2_router(a, F, a.out); } SEAM(8); PROBE_AT(9);
    if (IN(9)) { p9_routing(a, F); } SEAM(9); PROBE_AT(10);

    if (IN(10) || IN(11) || IN(12) || IN(13)) moe_tables(F, tab);
    const int xl = bx & 7, rk = bx >> 3, nrk = (G - xl + 7) >> 3;
    if (IN(10)) { p10_permute(a, F, tab); } SEAM(10); PROBE_AT(11);
    if (IN(11)) {
        ProbMoE P{(const bf16_t*)(ws + WS_XPERM), (const bf16_t*)(ws + WS_W1), DM, DM, MK_FP8_MOE ? DM / 128 : DM / 64, 16, (size_t)4096 * DM, xl, rk, nrk}; P.load(tab);
        EpiSwiglu E{(bf16_t*)(ws + WS_HACT), a.in[I_BGATE], a.in[I_BUP], tab}; gm::gemm_phase<ProbMoE, EpiSwiglu, false, MK_FP8_MOE != 0>(ring, P, E, F.wave);
    } SEAM(11); PROBE_AT(12);
    if (IN(12)) {
        ProbMoE P{(const bf16_t*)(ws + WS_HACT), (const bf16_t*)(ws + WS_W2), DFF, DFF, MK_FP8_MOE ? DFF / 128 : DFF / 64, 8, (size_t)DM * DFF, xl, rk, nrk}; P.load(tab);
        EpiDown E{(bf16_t*)(ws + WS_YSLOT), a.in[I_BDOWN], tab}; gm::gemm_phase<ProbMoE, EpiDown, false, MK_FP8_MOE != 0>(ring, P, E, F.wave);
    } SEAM(12); PROBE_AT(13);
    if (IN(13)) { p12_combine(a, F, a.out, tab); }
    PROBE_AT(14);
#ifdef MK_PROBE_LO
    if (blockIdx.x == 0 && F_tid == 0) { const unsigned long long dt = (pr_t1 - pr_t0) * MK_PROBE_X, te = __builtin_amdgcn_s_memrealtime();
        while (__builtin_amdgcn_s_memrealtime() - te < dt) __builtin_amdgcn_s_sleep(32); }
#endif
#undef IN
#undef SEAM
}

extern "C" void kernel_launch(void* const* d_in, const int* in_sizes, int n_in, void* d_out, int out_size, void* d_ws, size_t ws_size, hipStream_t stream) {
    static int grid = 0;
    if (grid == 0) {
        if (n_in != 32 || in_sizes[0] != TT * DM || out_size != TT * DM || ws_size < WS_END) {
            fprintf(stderr, "kernel_launch: shape mismatch: n_in %d in0 %d out %d ws %zu (need %zu); nothing launched\n", n_in, n_in > 0 ? in_sizes[0] : -1, out_size, ws_size, (size_t)WS_END); grid = -1; return; }
        int dev = 0, cus = 0, per_cu = 0;
        if (hipGetDevice(&dev) != hipSuccess || hipDeviceGetAttribute(&cus, hipDeviceAttributeMultiprocessorCount, dev) != hipSuccess) { fprintf(stderr, "kernel_launch: device query failed\n"); grid = -1; return; }
        if (hipFuncSetAttribute((const void*)mk_fwd, hipFuncAttributeMaxDynamicSharedMemorySize, LDS_BYTES) != hipSuccess) { fprintf(stderr, "kernel_launch: hipFuncSetAttribute failed\n"); grid = -1; return; }
        if (hipOccupancyMaxActiveBlocksPerMultiprocessor(&per_cu, (const void*)mk_fwd, NTHREADS, LDS_BYTES) != hipSuccess || per_cu < 1)
            fprintf(stderr, "kernel_launch: note: occupancy query reports %d workgroups per CU\n", per_cu);
        (void)hipGetLastError();
        grid = cus - (cus % 8);
        if (grid < 8) grid = 8;
    }
    if (grid < 0) return;
    if (hipMemsetAsync((char*)d_ws + WS_CTL, 0, CTL_ZERO_BYTES, stream) != hipSuccess) { fprintf(stderr, "kernel_launch: memset failed\n"); return; }
    Args a{};
    for (int i = 0; i < 32; ++i) a.in[i] = (const float*)d_in[i];
    a.out = (float*)d_out; a.ws = (uchar*)d_ws;
#if MK_ONE_LAUNCH
    a.ph_lo = 0; a.ph_hi = NPHASE;
    hipLaunchKernelGGL(mk_fwd, dim3(grid), dim3(NTHREADS), LDS_BYTES, stream, a);
#else
    for (int p = 0; p < NPHASE; ++p) { a.ph_lo = p; a.ph_hi = p + 1; hipLaunchKernelGGL(mk_fwd, dim3(grid), dim3(NTHREADS), LDS_BYTES, stream, a); }
#endif
    const hipError_t le = hipPeekAtLastError();
    if (le != hipSuccess) fprintf(stderr, "kernel_launch: launch failed: %s\n", hipGetErrorName(le));
}
```

```cpp
#include <hip/hip_runtime.h>
#include <cstdio>
#include <cstdint>

#ifndef MK_ONE_LAUNCH
#define MK_ONE_LAUNCH 1
#endif
#ifndef MK_FAST_GEMM
#define MK_FAST_GEMM 1
#endif
#ifndef MK_FAST_ATTN
#define MK_FAST_ATTN 1
#endif
#ifndef MK_FAST_S5
#define MK_FAST_S5 1
#endif

#ifndef MK_FP8_MOE
#define MK_FP8_MOE 1
#endif
#define LAS __attribute__((address_space(3)))
#define GAS __attribute__((address_space(1)))
typedef unsigned short bf16_t;
typedef short bf16x8 __attribute__((ext_vector_type(8)));
typedef short s16x4 __attribute__((ext_vector_type(4)));
typedef float f32x2 __attribute__((ext_vector_type(2)));
typedef float f32x4 __attribute__((ext_vector_type(4)));
typedef float f32x16 __attribute__((ext_vector_type(16)));
typedef unsigned u32x2 __attribute__((ext_vector_type(2)));
typedef unsigned u32x4 __attribute__((ext_vector_type(4)));
typedef unsigned char uchar;
typedef int v4i __attribute__((ext_vector_type(4)));
typedef int v8i __attribute__((ext_vector_type(8)));
constexpr float FP8_ASCALE = 4.0f, FP8_WSCALE = 64.0f;
__device__ __forceinline__ unsigned pk4_fp8(float a, float b, float c, float d) { int w = __builtin_amdgcn_cvt_pk_fp8_f32(a, b, 0, false); w = __builtin_amdgcn_cvt_pk_fp8_f32(c, d, w, true); return (unsigned)w; }

constexpr int NB = 8, SEQ = 2048, TT = NB * SEQ, DM = 2048;
constexpr int NH = 16, DNOPE = 128, DROPE = 64, DQK = 192, DV = 128, QLORA = 512, KVLORA = 256;
constexpr int S5W = 1024, S5G = 64, S5C = 16, S5P = 64, S5L = 16;
constexpr int NE = 32, TOPK = 4, DFF = 2048;
constexpr int IN_PROJ = QLORA + KVLORA + DROPE + S5W + 2 * DM;
constexpr int NPROJ = 6144;
constexpr int C_QLAT = 0, C_KVLAT = 512, C_U = 768, C_GA = 1792, C_GB = 3840, C_KR = 5888;
constexpr float EPS = 1e-6f;
constexpr int MAXSLOT_TILES = (TT * TOPK) / 256 + NE;
constexpr int MAXSLOTS = MAXSLOT_TILES * 256;
constexpr int NCHUNK = TT / S5L;
constexpr int APK = 384;

constexpr size_t MiB = 1u << 20;
constexpr size_t WS_CTL = 0, CTL_ZERO_BYTES = 1 * MiB;
constexpr size_t WS_WIN = 1 * MiB;
constexpr size_t WS_WUQ = WS_WIN + 24 * MiB;
constexpr size_t WS_WUKV = WS_WUQ + 3 * MiB;
constexpr size_t WS_WOMLA = WS_WUKV + 2 * MiB;
constexpr size_t WS_WGLU = WS_WOMLA + 8 * MiB;
constexpr size_t WS_WOS5 = WS_WGLU + 2 * MiB;
constexpr size_t WS_WOUT = WS_WOS5 + 4 * MiB;
constexpr size_t WS_TWC = WS_WOUT + 8 * MiB;
constexpr size_t WS_WS5 = WS_TWC + 12 * MiB;
constexpr size_t WS_ROPE = WS_WS5 + 8 * MiB;
constexpr size_t WS_SMALL = WS_ROPE + 4 * MiB;
constexpr size_t WS_W1 = WS_SMALL + 1 * MiB;
constexpr size_t WS_W2 = WS_W1 + 512 * MiB;
constexpr size_t WS_ACT = WS_W2 + 256 * MiB;
constexpr size_t WS_H = WS_ACT;
constexpr size_t WS_PROJ = WS_H + 64 * MiB;
constexpr size_t WS_APACK = WS_PROJ + 192 * MiB;
constexpr size_t WS_SCH = WS_APACK + 48 * MiB;
constexpr size_t WS_QRAW = WS_SCH + 32 * MiB;
constexpr size_t WS_KVRAW = WS_QRAW + 96 * MiB;
constexpr size_t WS_QN = WS_KVRAW + 128 * MiB;
constexpr size_t WS_KN = WS_QN + 96 * MiB;
constexpr size_t WS_VN = WS_KN + 96 * MiB;
constexpr size_t WS_O = WS_VN + 64 * MiB;
constexpr size_t WS_GACT = WS_O + 64 * MiB;
constexpr size_t WS_Y2 = WS_GACT + 32 * MiB;
constexpr size_t WS_MA = WS_Y2 + 32 * MiB;
constexpr size_t WS_M = WS_MA + 64 * MiB;
constexpr size_t WS_ENDA = WS_M + 64 * MiB;
constexpr size_t WS_H2 = WS_ACT;
constexpr size_t WS_HACT = WS_H2 + 64 * MiB;
constexpr size_t WS_YSLOT = WS_HACT + 288 * MiB;
constexpr size_t WS_TOPI = WS_YSLOT + 288 * MiB;
constexpr size_t WS_TOPW = WS_TOPI + 1 * MiB;
constexpr size_t WS_TPOS = WS_TOPW + 1 * MiB;
constexpr size_t WS_LIST = WS_TPOS + 1 * MiB;
constexpr size_t WS_XPERM = WS_ACT + 704 * MiB;
constexpr size_t WS_ENDB = WS_XPERM + 288 * MiB;
constexpr size_t WS_END = WS_ENDA > WS_ENDB ? WS_ENDA : WS_ENDB;
constexpr size_t SM_A16 = 0;
constexpr size_t SM_COUNTS = 64 * 1024;
constexpr size_t SM_WRP = 128 * 1024;
constexpr int CW_BAR = 4096;

constexpr int RING_BYTES = 131072;
constexpr int LDS_BYTES = 163840;
constexpr int LDSCTL_OFF = LDS_BYTES - 4096;
constexpr int MISC_OFF = LDSCTL_OFF;
constexpr int GTAB_OFF = LDSCTL_OFF + 2048;
constexpr int NWAVES = 8, NTHREADS = 512;

#define LDS_WAIT() asm volatile("s_waitcnt lgkmcnt(0)" ::: "memory")
#define VM_WAIT() asm volatile("s_waitcnt vmcnt(0)" ::: "memory")
#define SBAR() __builtin_amdgcn_sched_barrier(0)

__device__ __forceinline__ unsigned f2bf(float f) { unsigned u = __builtin_bit_cast(unsigned, f); return (u + 0x7fffu + ((u >> 16) & 1u)) >> 16; }
__device__ __forceinline__ unsigned pk2(float lo, float hi) { return f2bf(lo) | (f2bf(hi) << 16); }
__device__ __forceinline__ float bf2f(unsigned b) { return __builtin_bit_cast(float, b << 16); }
__device__ __forceinline__ float bflo(unsigned w) { return __builtin_bit_cast(float, w << 16); }
__device__ __forceinline__ float bfhi(unsigned w) { return __builtin_bit_cast(float, w & 0xffff0000u); }
__device__ __forceinline__ unsigned cvt_pk_bf16(float lo, float hi) { unsigned r; asm volatile("v_cvt_pk_bf16_f32 %0, %1, %2" : "=v"(r) : "v"(lo), "v"(hi)); return r; }
__device__ __forceinline__ float sigmoidf_(float x) { return 1.0f / (1.0f + __expf(-x)); }
__device__ __forceinline__ float gelu_tanh(float x) {
    const float u = 0.7978845608028654f * (x + 0.044715f * x * x * x);
    const float e = __expf(2.0f * u);
    const float th = 1.0f - 2.0f / (e + 1.0f);
    return 0.5f * x * (1.0f + th);
}
__device__ __forceinline__ int fresh_lane() { int z = 0; asm volatile("" : "+s"(z)); return (int)__builtin_amdgcn_mbcnt_hi(~0u, __builtin_amdgcn_mbcnt_lo(~0u, (unsigned)z)); }
__device__ __forceinline__ float wave_sum(float v) {
#pragma unroll
    for (int o = 1; o < 64; o <<= 1) v += __shfl_xor(v, o);
    return v;
}

#define XB_TMO      128
#define XB_XCNT(j)  (256  + 64 * (j))
#define XB_XSUB(j)  (1280 + 64 * (j))
#define XB_XGEN(j)  (2304 + 64 * (j))
#define XB_TOP      3328
#define XB_TOPGEN   3392
#define XCD_BAR_WORDS 3456
#define XB_SPIN_CAP (1u << 18)
__device__ __forceinline__ unsigned xb_ld(unsigned* p)              { return __hip_atomic_load(p, __ATOMIC_RELAXED, __HIP_MEMORY_SCOPE_AGENT); }
__device__ __forceinline__ unsigned xb_add(unsigned* p, unsigned v) { return __hip_atomic_fetch_add(p, v, __ATOMIC_RELAXED, __HIP_MEMORY_SCOPE_AGENT); }
__device__ __forceinline__ unsigned xb_xcc_id() { return (unsigned)__builtin_amdgcn_s_getreg((3 << 11) | 20) & 0xFu; }
#define XB_SPIN(cond, bar) do { unsigned _sp = 0; while (cond) { __builtin_amdgcn_s_sleep(1); \
    if ((++_sp & 255u) == 0u) { if (xb_ld(&(bar)[XB_TMO])) break; if (_sp > XB_SPIN_CAP) { atomicAdd(&(bar)[XB_TMO], 1u); break; } } } } while (0)
struct XcdBarrier { unsigned* bar; unsigned x; volatile LAS unsigned* st; int wave; };
__device__ __forceinline__ XcdBarrier xcd_barrier_post(unsigned* bar, volatile LAS unsigned* st, int wave) {
    XcdBarrier b; b.bar = bar; b.x = xb_xcc_id(); b.st = st; b.wave = wave;
    if (wave == 0 && fresh_lane() == 0) (void)xb_add(&bar[XB_XCNT(b.x)], 1u);
    return b;
}
__device__ __forceinline__ void xcd_barrier_complete(unsigned* bar, unsigned x, unsigned& nloc, unsigned& nx) {
    const unsigned G = gridDim.x * gridDim.y * gridDim.z;
    unsigned sum, cnt, mine, sp = 0u;
    for (;;) {
        sum = 0u; cnt = 0u; mine = 0u;
#pragma unroll
        for (unsigned j = 0; j < 16; ++j) { const unsigned c = xb_ld(&bar[XB_XCNT(j)]); sum += c; cnt += (c > 0u) ? 1u : 0u; mine = (j == x) ? c : mine; }
        if (sum == G) break;
        __builtin_amdgcn_s_sleep(1);
        if ((++sp & 255u) == 0u) { if (xb_ld(&bar[XB_TMO])) break; if (sp > XB_SPIN_CAP) { atomicAdd(&bar[XB_TMO], 1u); break; } }
    }
    nloc = mine > 0u ? mine : 1u; nx = cnt > 0u ? cnt : 1u;
}
__device__ __forceinline__ void xcd_barrier(const XcdBarrier& b) {
    asm volatile("s_waitcnt vmcnt(0)" ::: "memory");
    __syncthreads();
    if (b.wave == 0 && fresh_lane() == 0) {
        unsigned* bar = b.bar;
        __builtin_amdgcn_s_waitcnt(0);
        unsigned nloc = b.st[0], nx = b.st[1];
        if (nloc == 0u) { xcd_barrier_complete(bar, b.x, nloc, nx); b.st[0] = nloc; b.st[1] = nx; }
        const unsigned old = xb_add(&bar[XB_XSUB(b.x)], 1u);
        const unsigned gen = old / nloc;
        if (old + 1u == (gen + 1u) * nloc) {
            __builtin_amdgcn_fence(__ATOMIC_RELEASE, "agent");
            asm volatile("s_waitcnt vmcnt(0)" ::: "memory");
            const unsigned og = xb_add(&bar[XB_TOP], 1u);
            const unsigned tg = og / nx;
            if (og + 1u == (tg + 1u) * nx) xb_add(&bar[XB_TOPGEN], 1u);
            else XB_SPIN(xb_ld(&bar[XB_TOPGEN]) == tg, bar);
            __builtin_amdgcn_fence(__ATOMIC_ACQUIRE, "agent");
            xb_add(&bar[XB_XGEN(b.x)], 1u);
            asm volatile("s_waitcnt vmcnt(0)" ::: "memory");
        } else {
            XB_SPIN(xb_ld(&bar[XB_XGEN(b.x)]) == gen, bar);
            __builtin_amdgcn_fence(__ATOMIC_ACQUIRE, "agent");
            asm volatile("s_waitcnt vmcnt(0)" ::: "memory");
        }
    }
    __syncthreads();
}

namespace gm {
constexpr int BM = 256, BK = 64, HALF = 128, HTB = HALF * BK * 2, STAGE_BYTES = 8 * HTB, NXCD = 8, WGM = 8;
__host__ __device__ __forceinline__ int lds_byte(int r, int c) { const int st = (r >> 4) * 2 + (c >> 5), rr = r & 15, cc = c & 31, ob = rr * 64 + cc * 2; return st * 1024 + (ob ^ (((ob >> 9) & 1) << 5)); }
__host__ __device__ __forceinline__ void stage_rc(int b, int& R, int& C) { const int st = b / 1024, sb = b % 1024, swz = sb ^ (((sb >> 9) & 1) << 5); R = (st >> 1) * 16 + swz / 64; C = (st & 1) * 32 + (swz % 64) / 2; }
__host__ __device__ __forceinline__ int perm32(int rho) { const int n = rho >> 4, i = rho & 15; return 8 * (i >> 2) + 4 * n + (i & 3); }

struct Unit { int pm, pn, g, st; };


struct ProbDense {
    const bf16_t* A; const bf16_t* B; int lda, ldb, nt; int nM, nN, nwg, G, c; const int* list = nullptr; const LAS int* gtab = nullptr;
    __device__ unsigned list_off(const Unit&) const { return 0u; }
    __device__ void init(const bf16_t* A_, int lda_, const bf16_t* B_, int ldb_, int K, int M, int N, int G_, int c_) { A = A_; B = B_; lda = lda_; ldb = ldb_; nt = K / BK; nM = M / BM; nN = N / BM; nwg = nM * nN; G = G_; c = c_; }
    __device__ bool next(int i, Unit& u) const {
        const long L = (long)i * G + c; if (L >= nwg) return false;
        int wgid = (int)L; { const int q = nwg / NXCD, r = nwg % NXCD, xcd = wgid % NXCD, off = wgid / NXCD; wgid = (xcd < r ? xcd * (q + 1) : r * (q + 1) + (xcd - r) * q) + off; }
        const int nig = WGM * nN, gid = wgid / nig, fm = gid * WGM, gsz = (nM - fm) < WGM ? (nM - fm) : WGM;
        u.pm = fm + ((wgid % nig) % gsz); u.pn = (wgid % nig) / gsz; u.g = 0; u.st = 0; return true;
    }
    __device__ size_t a_off(const Unit& u) const { return (size_t)u.pm * BM * lda; }
    __device__ size_t b_off(const Unit& u) const { return (size_t)u.pn * BM * ldb; }
    __device__ unsigned a_row(const Unit&, int) const { return 0u; }
};

#if MK_FAST_GEMM
template <class Prob, class Epi, bool GATHER, bool FP8 = false>
__device__ __forceinline__ void gemm_phase(LAS uchar* lds, const Prob& S, const Epi& E, const int wid  ) {
    constexpr unsigned ESZ = FP8 ? 1u : 2u;
    const int lane = fresh_lane(), tid = wid * 64 + lane, wr = wid >> 2, wc = wid & 3, fr = lane & 15, fq = lane >> 4;
    const int nt = S.nt;
    int Ra[2], Ca[2]; unsigned voffB[2];
#pragma unroll
    for (int i = 0; i < 2; ++i) { int R, C; stage_rc(tid * 16 + i * 8192, R, C); const int Rb = Epi::PERM ? ((R & ~31) + perm32(R & 31)) : R;
        Ra[i] = R; Ca[i] = C; voffB[i] = (unsigned)(Rb * S.ldb) * ESZ + (unsigned)C * 2u; }
    constexpr unsigned kstep = BK * 2;
    const unsigned hstepB = (unsigned)HALF * (unsigned)S.ldb * ESZ;
    const unsigned ldsw = (unsigned)wid * 1024u;
    const int aoff = lds_byte(wr * 64 + fr, fq * 8), boff = lds_byte(wc * 32 + fr, fq * 8);
    const __amdgpu_buffer_rsrc_t srdA = __builtin_amdgcn_make_buffer_rsrc((void*)S.A, 0, 0xFFFFFFFF, 0x00020000);
    const __amdgpu_buffer_rsrc_t srdB = __builtin_amdgcn_make_buffer_rsrc((void*)S.B, 0, 0xFFFFFFFF, 0x00020000);
#define G_SA(b, h) (((b) * 2 + (h)) * HTB)
#define G_SB(b, h) ((4 + (b) * 2 + (h)) * HTB)
#define G_STAGE(bufoff, srd, soff, voff) do { _Pragma("unroll") for (int _i = 0; _i < 2; ++_i) \
        __builtin_amdgcn_raw_ptr_buffer_load_lds(srd, (LAS void*)(lds + (bufoff) + ldsw + _i * 8192), 16, (int)(voff)[_i], (int)(soff), 0, 0); } while (0)
#define G_LDA(dst, b, h) do { _Pragma("unroll") for (int m = 0; m < 4; ++m) _Pragma("unroll") for (int k = 0; k < 2; ++k) dst[m][k] = *(const LAS bf16x8*)(lds + G_SA(b, h) + aoff + m * 2048 + k * 1024); } while (0)
#define G_LDB(dst, b, h) do { _Pragma("unroll") for (int n = 0; n < 2; ++n) _Pragma("unroll") for (int k = 0; k < 2; ++k) dst[n][k] = *(const LAS bf16x8*)(lds + G_SB(b, h) + boff + n * 2048 + k * 1024); } while (0)
#define G_CAT(x0, x1) __builtin_shufflevector(__builtin_bit_cast(v4i, x0), __builtin_bit_cast(v4i, x1), 0, 1, 2, 3, 4, 5, 6, 7)
#define G_MMA(ai, bj, At, Bt) do { __builtin_amdgcn_s_setprio(1); _Pragma("unroll") for (int m = 0; m < 4; ++m) _Pragma("unroll") for (int n = 0; n < 2; ++n) { \
        if constexpr (FP8) acc[ai][bj][m][n] = __builtin_amdgcn_mfma_scale_f32_16x16x128_f8f6f4(G_CAT(Bt[n][0], Bt[n][1]), G_CAT(At[m][0], At[m][1]), acc[ai][bj][m][n], 0, 0, 0, 0x7f7f7f7f, 0, 0x7f7f7f7f); \
        else { _Pragma("unroll") for (int k = 0; k < 2; ++k) acc[ai][bj][m][n] = __builtin_amdgcn_mfma_f32_16x16x32_bf16(Bt[n][k], At[m][k], acc[ai][bj][m][n], 0, 0, 0); } } \
        __builtin_amdgcn_s_setprio(0); } while (0)
#define G_WAIT_V(n) asm volatile("s_waitcnt vmcnt(" #n ")" ::: "memory")
#define G_WAIT_L(n) asm volatile("s_waitcnt lgkmcnt(" #n ")" ::: "memory")
#define G_BAR __builtin_amdgcn_s_barrier()
#define G_SCHED __builtin_amdgcn_sched_barrier(0)
#define G_UNI(x) ((unsigned)__builtin_amdgcn_readfirstlane((int)(x)))
    Unit cur, nxt; int ui = 0;
    if (!S.next(0, cur)) return;
    unsigned vA0[2], vA1[2];
    unsigned cA = 0u, cB = G_UNI(S.b_off(cur) * ESZ);
    __amdgpu_buffer_rsrc_t srdL = srdA;
    if constexpr (GATHER) srdL = __builtin_amdgcn_make_buffer_rsrc((void*)S.list, 0, 0xFFFFFFFF, 0x00020000);
#define G_IDX(u_) do { if (wid < 4) __builtin_amdgcn_raw_ptr_buffer_load_lds(srdL, (LAS void*)(S.gtab + wid * 64), 4, lane * 4, (int)G_UNI(S.list_off(u_) * 4u) + wid * 256, 0, 0); } while (0)
    const int gR = (int)(uintptr_t)S.gtab + Ra[0] * 4; const unsigned gC = (unsigned)Ca[0] * 2u;
#define G_ROWS(o0, o1) do { const LAS int* _g = (const LAS int*)gR; const unsigned _ls = (unsigned)S.lda * ESZ; \
        o0[0] = (unsigned)_g[0] * _ls + gC; o0[1] = (unsigned)_g[64] * _ls + gC; o1[0] = (unsigned)_g[128] * _ls + gC; o1[1] = (unsigned)_g[192] * _ls + gC; } while (0)
    if constexpr (GATHER) { G_IDX(cur); G_WAIT_V(0); G_BAR; G_ROWS(vA0, vA1); G_WAIT_L(0); G_BAR; }
    else { cA = G_UNI(S.a_off(cur) * ESZ);
#pragma unroll
        for (int i = 0; i < 2; ++i) { vA0[i] = (unsigned)(Ra[i] * S.lda) * ESZ + (unsigned)Ca[i] * 2u; vA1[i] = (unsigned)((HALF + Ra[i]) * S.lda) * ESZ + (unsigned)Ca[i] * 2u; }
    }
    G_STAGE(G_SB(0, 0), srdB, cB, voffB); G_STAGE(G_SA(0, 0), srdA, cA, vA0); G_STAGE(G_SB(0, 1), srdB, cB + hstepB, voffB); G_STAGE(G_SA(0, 1), srdA, cA, vA1);
    if (wr == 1) G_BAR;
    G_WAIT_V(4); G_BAR;
    G_STAGE(G_SB(1, 0), srdB, cB + kstep, voffB); G_STAGE(G_SA(1, 0), srdA, cA + kstep, vA0); G_STAGE(G_SB(1, 1), srdB, cB + hstepB + kstep, voffB);
    G_WAIT_V(6); G_BAR;
    f32x4 acc[2][2][4][2];
#pragma unroll
    for (int a = 0; a < 2; ++a)
#pragma unroll
        for (int b = 0; b < 2; ++b)
#pragma unroll
            for (int m = 0; m < 4; ++m)
#pragma unroll
                for (int n = 0; n < 2; ++n) acc[a][b][m][n] = (f32x4){0.f, 0.f, 0.f, 0.f};
    bf16x8 At[4][2], B0[2][2], B1[2][2];
    for (;;) {
        const bool has_next = S.next(ui + 1, nxt);
        unsigned nA = cA, nB = cB; unsigned x0[2] = {0u, 0u}, x1[2] = {0u, 0u};
        if (has_next) { nB = G_UNI(S.b_off(nxt) * ESZ);
            if constexpr (GATHER) G_IDX(nxt);
            else nA = G_UNI(S.a_off(nxt) * ESZ);
        }
#define G_TRIP(LAST) do { \
            const unsigned a1 = cA + (unsigned)(t + 1) * kstep; \
            const unsigned a2 = (LAST) ? nA : cA + (unsigned)(t + 2) * kstep, b2 = (LAST) ? nB : cB + (unsigned)(t + 2) * kstep; \
            const unsigned a3 = a2 + kstep, b3 = b2 + kstep; \
            unsigned w0[2], w1[2]; \
            _Pragma("unroll") for (int i = 0; i < 2; ++i) { w0[i] = vA0[i]; w1[i] = vA1[i]; } \
            if constexpr (GATHER) { if ((LAST) && has_next) { G_ROWS(w0, w1); _Pragma("unroll") for (int i = 0; i < 2; ++i) { x0[i] = w0[i]; x1[i] = w1[i]; } } } \
              G_LDB(B0, 0, 0); G_SCHED; G_LDA(At, 0, 0); G_STAGE(G_SA(1, 1), srdA, a1, vA1); \
            G_WAIT_L(8); G_BAR; G_WAIT_L(0); G_MMA(0, 0, At, B0); G_BAR; G_SCHED; \
              G_LDB(B1, 0, 1); G_STAGE(G_SB(0, 0), srdB, b2, voffB); \
            G_BAR; G_WAIT_L(0); G_MMA(0, 1, At, B1); G_BAR; \
              G_LDA(At, 0, 1); G_STAGE(G_SA(0, 0), srdA, a2, w0); \
            G_BAR; G_WAIT_L(0); G_MMA(1, 0, At, B0); G_BAR; G_SCHED; \
              G_STAGE(G_SB(0, 1), srdB, b2 + hstepB, voffB); \
            G_WAIT_V(6); G_BAR; G_MMA(1, 1, At, B1); G_BAR; \
              G_LDB(B0, 1, 0); G_SCHED; G_LDA(At, 1, 0); G_STAGE(G_SA(0, 1), srdA, a2, w1); \
            G_WAIT_L(8); G_BAR; G_WAIT_L(0); G_MMA(0, 0, At, B0); G_BAR; G_SCHED; \
              G_LDB(B1, 1, 1); G_STAGE(G_SB(1, 0), srdB, b3, voffB); \
            G_BAR; G_WAIT_L(0); G_MMA(0, 1, At, B1); G_BAR; \
              G_LDA(At, 1, 1); G_STAGE(G_SA(1, 0), srdA, a3, w0); \
            G_BAR; G_WAIT_L(0); G_MMA(1, 0, At, B0); G_BAR; G_SCHED; \
              G_STAGE(G_SB(1, 1), srdB, b3 + hstepB, voffB); \
            G_WAIT_V(6); G_BAR; G_MMA(1, 1, At, B1); G_BAR; } while (0)
        for (int t = 0; t < nt; t += 2) { const bool last = (t == nt - 2); G_TRIP(last); }
        { const int lane2 = fresh_lane();
          E(acc, cur, wid >> 2, wid & 3, lane2 & 15, lane2 >> 4); }
        if (!has_next) break;
#pragma unroll
        for (int a = 0; a < 2; ++a)
#pragma unroll
            for (int b = 0; b < 2; ++b)
#pragma unroll
                for (int m = 0; m < 4; ++m)
#pragma unroll
                    for (int n = 0; n < 2; ++n) acc[a][b][m][n] = (f32x4){0.f, 0.f, 0.f, 0.f};
        cur = nxt; cA = nA; cB = nB; ++ui;
        if constexpr (GATHER) {
#pragma unroll
            for (int i = 0; i < 2; ++i) { vA0[i] = x0[i]; vA1[i] = x1[i]; } }
    }
    G_WAIT_V(0);
    if (wr == 0) G_BAR;
    G_BAR;
#undef G_SA
#undef G_SB
#undef G_STAGE
#undef G_LDA
#undef G_LDB
#undef G_MMA
#undef G_CAT
#undef G_WAIT_V
#undef G_WAIT_L
#undef G_BAR
#undef G_SCHED
#undef G_UNI
#undef G_TRIP
#undef G_IDX
#undef G_ROWS
}
#else
template <class Prob, class Epi, bool GATHER, bool FP8 = false>
__device__ __forceinline__ void gemm_phase(LAS uchar* lds, const Prob& S, const Epi& E, const int wid) {
    const int lane = fresh_lane(), tid = wid * 64 + lane, wr = wid >> 2, wc = wid & 3, fr = lane & 15, fq = lane >> 4;
    LAS float* As = (LAS float*)lds; LAS float* Bs = As + 256 * 33;
    Unit u;
    for (int ui = 0; S.next(ui, u); ++ui) {
        float acc[2][2][4][2][4];
#pragma unroll
        for (int a = 0; a < 2; ++a)
#pragma unroll
            for (int b = 0; b < 2; ++b)
#pragma unroll
                for (int m = 0; m < 4; ++m)
#pragma unroll
                    for (int n = 0; n < 2; ++n)
#pragma unroll
                        for (int j = 0; j < 4; ++j) acc[a][b][m][n][j] = 0.f;
        const int lr = tid >> 1, lk = (tid & 1) * 16;
        const bf16_t* ap = GATHER ? (S.A + S.a_row(u, lr)) : (S.A + S.a_off(u) + (size_t)lr * S.lda);
        const bf16_t* bp = S.B + S.b_off(u) + (size_t)lr * S.ldb;
        for (int k0 = 0; k0 < S.nt * 64; k0 += 32) {
            __syncthreads();
            const u32x4 a0 = *(const u32x4*)(ap + k0 + lk), a1 = *(const u32x4*)(ap + k0 + lk + 8);
            const u32x4 b0 = *(const u32x4*)(bp + k0 + lk), b1 = *(const u32x4*)(bp + k0 + lk + 8);
#pragma unroll
            for (int q = 0; q < 4; ++q) {
                As[lr * 33 + lk + 2 * q] = bflo(a0[q]); As[lr * 33 + lk + 2 * q + 1] = bfhi(a0[q]);
                As[lr * 33 + lk + 8 + 2 * q] = bflo(a1[q]); As[lr * 33 + lk + 8 + 2 * q + 1] = bfhi(a1[q]);
                Bs[lr * 33 + lk + 2 * q] = bflo(b0[q]); Bs[lr * 33 + lk + 2 * q + 1] = bfhi(b0[q]);
                Bs[lr * 33 + lk + 8 + 2 * q] = bflo(b1[q]); Bs[lr * 33 + lk + 8 + 2 * q + 1] = bfhi(b1[q]);
            }
            __syncthreads();
            for (int kk = 0; kk < 32; ++kk) {
                float av[2][4], bv[2][2][4];
#pragma unroll
                for (int a = 0; a < 2; ++a)
#pragma unroll
                    for (int m = 0; m < 4; ++m) av[a][m] = As[(128 * a + 64 * wr + 16 * m + fr) * 33 + kk];
#pragma unroll
                for (int b = 0; b < 2; ++b)
#pragma unroll
                    for (int n = 0; n < 2; ++n)
#pragma unroll
                        for (int j = 0; j < 4; ++j) { const int c = 128 * b + 32 * wc + (Epi::PERM ? (8 * fq + 4 * n + j) : (16 * n + 4 * fq + j)); bv[b][n][j] = Bs[c * 33 + kk]; }
#pragma unroll
                for (int a = 0; a < 2; ++a)
#pragma unroll
                    for (int b = 0; b < 2; ++b)
#pragma unroll
                        for (int m = 0; m < 4; ++m)
#pragma unroll
                            for (int n = 0; n < 2; ++n)
#pragma unroll
                                for (int j = 0; j < 4; ++j) acc[a][b][m][n][j] += av[a][m] * bv[b][n][j];
            }
        }
        f32x4 accv[2][2][4][2];
#pragma unroll
        for (int a = 0; a < 2; ++a)
#pragma unroll
            for (int b = 0; b < 2; ++b)
#pragma unroll
                for (int m = 0; m < 4; ++m)
#pragma unroll
                    for (int n = 0; n < 2; ++n) accv[a][b][m][n] = (f32x4){acc[a][b][m][n][0], acc[a][b][m][n][1], acc[a][b][m][n][2], acc[a][b][m][n][3]};
        E(accv, u, wr, wc, fr, fq);
    }
    __syncthreads();
}
#endif
}

struct Args {
    const float* in[32];
    float* out; uchar* ws;
    int ph_lo, ph_hi;
};
struct Frame {
    LAS uchar* lds; uchar* ws; int wave, G, bx;
};
#define FRAME_IDS(F) const int F_lane = fresh_lane(), F_tid = (F).wave * 64 + F_lane
enum { I_X = 0, I_POS, I_N1G, I_WIN, I_BG, I_QNG, I_WUQ, I_KVNG, I_WUKV, I_QKQG, I_QKKG, I_WOMLA, I_LRE, I_LIM, I_LOGDT, I_BRE, I_BIM, I_CRE, I_CIM, I_S5D,
       I_WGLU, I_WOS5, I_WOUT, I_N2G, I_WR, I_BR, I_WG, I_BGATE, I_WU, I_BUP, I_WD, I_BDOWN };

struct ProbS5 {
    const bf16_t* A; const bf16_t* B; int lda, ldb, nt; int G, c; const int* list = nullptr; const LAS int* gtab = nullptr;
    __device__ unsigned list_off(const gm::Unit&) const { return 0u; }
    __device__ bool next(int i, gm::Unit& u) const { const int L = i * G + c; if (L >= S5G * 4) return false; u.g = L >> 2; u.pm = L & 3; u.pn = 0; u.st = 0; return true; }
    __device__ size_t a_off(const gm::Unit& u) const { return ((size_t)u.g * NCHUNK + (size_t)u.pm * 256) * APK; }
    __device__ size_t b_off(const gm::Unit& u) const { return (size_t)u.g * 256 * ldb; }
    __device__ unsigned a_row(const gm::Unit&, int) const { return 0u; }
};
struct ProbMoE {
    const bf16_t* A; const bf16_t* B; int lda, ldb, nt; int npn; size_t estride;
    int x, rk, nrk; int nte[4], rcp[4], pre[4];
    const int* list = nullptr; const LAS int* gtab = nullptr;
    __device__ void load(const LAS int* tab) {
#pragma unroll
        for (int q = 0; q < 4; ++q) { const int e = x + 8 * q; nte[q] = __builtin_amdgcn_readfirstlane(tab[32 + e]); rcp[q] = __builtin_amdgcn_readfirstlane(tab[128 + e]); pre[q] = __builtin_amdgcn_readfirstlane(tab[64 + e]); }
    }
    __device__ unsigned list_off(const gm::Unit&) const { return 0u; }
    __device__ bool next(int i, gm::Unit& u) const {
        int L = i * nrk + rk;
#pragma unroll
        for (int q = 0; q < 4; ++q) { const int nu = nte[q] * npn;
            if (L < nu) { u.g = x + 8 * q; u.pn = (L * rcp[q]) >> 20; u.pm = L - u.pn * nte[q]; u.st = pre[q] + u.pm; return true; } L -= nu; }
        return false;
    }
    __device__ size_t a_off(const gm::Unit& u) const { return ((size_t)u.st * 256) * lda; }
    __device__ size_t b_off(const gm::Unit& u) const { return (size_t)u.g * estride + (size_t)u.pn * 256 * ldb; }
    __device__ unsigned a_row(const gm::Unit&, int) const { return 0u; }
};

#define EPI_ROW(u_, ai, m) ((u_).pm * 256 + (ai) * 128 + wr * 64 + (m) * 16 + fr)
struct EpiStoreBf16 {
    static constexpr bool PERM = true;
    bf16_t* O; int ld;
    __device__ __forceinline__ void operator()(const f32x4 (&acc)[2][2][4][2], const gm::Unit& u, int wr, int wc, int fr, int fq) const {
#pragma unroll
        for (int ai = 0; ai < 2; ++ai)
#pragma unroll
            for (int m = 0; m < 4; ++m) { bf16_t* rowp = O + (size_t)EPI_ROW(u, ai, m) * ld + u.pn * 256 + wc * 32 + 8 * fq;
#pragma unroll
                for (int bj = 0; bj < 2; ++bj) { const f32x4 v0 = acc[ai][bj][m][0], v1 = acc[ai][bj][m][1];
                    u32x4 w; w.x = cvt_pk_bf16(v0[0], v0[1]); w.y = cvt_pk_bf16(v0[2], v0[3]); w.z = cvt_pk_bf16(v1[0], v1[1]); w.w = cvt_pk_bf16(v1[2], v1[3]);
                    *(u32x4*)(rowp + bj * 128) = w; } }
    }
};
struct EpiInProj {
    static constexpr bool PERM = true;
    bf16_t* proj; bf16_t* apack; const float* bgates;
    __device__ __forceinline__ void operator()(const f32x4 (&acc)[2][2][4][2], const gm::Unit& u, int wr, int wc, int fr, int fq) const {
        const int colt = u.pn * 256 + wc * 32 + 8 * fq;
        const int kind = (u.pn >= 3 && u.pn < 7) ? 1 : ((u.pn >= 7 && u.pn < 23) ? 2 : 0);
#pragma unroll
        for (int bj = 0; bj < 2; ++bj) {
            const int col = colt + bj * 128;
            f32x4 b0 = (f32x4){0.f, 0.f, 0.f, 0.f}, b1 = b0;
            if (kind == 2) { b0 = *(const f32x4*)(bgates + (col - C_GA)); b1 = *(const f32x4*)(bgates + (col - C_GA) + 4); }
#pragma unroll
            for (int ai = 0; ai < 2; ++ai)
#pragma unroll
                for (int m = 0; m < 4; ++m) {
                    const int row = EPI_ROW(u, ai, m);
                    f32x4 v0 = acc[ai][bj][m][0], v1 = acc[ai][bj][m][1];
                    if (kind == 2) {
#pragma unroll
                        for (int j = 0; j < 4; ++j) { v0[j] = sigmoidf_(v0[j] + b0[j]); v1[j] = sigmoidf_(v1[j] + b1[j]); }
                    }
                    u32x4 w; w.x = cvt_pk_bf16(v0[0], v0[1]); w.y = cvt_pk_bf16(v0[2], v0[3]); w.z = cvt_pk_bf16(v1[0], v1[1]); w.w = cvt_pk_bf16(v1[2], v1[3]);
                    if (kind == 1) { const int j = col - C_U, g = j >> 4, cc = j & 15;
                        *(u32x4*)(apack + ((size_t)g * NCHUNK + (row >> 4)) * APK + (row & 15) * 16 + cc) = w; }
                    else *(u32x4*)(proj + (size_t)row * NPROJ + col) = w;
                }
        }
    }
};
struct EpiS5State {
    static constexpr bool PERM = false;
    float* sch;
    __device__ __forceinline__ void operator()(const f32x4 (&acc)[2][2][4][2], const gm::Unit& u, int wr, int wc, int fr, int fq) const {
#pragma unroll
        for (int ai = 0; ai < 2; ++ai)
#pragma unroll
            for (int m = 0; m < 4; ++m) { float* rowp = sch + ((size_t)u.g * NCHUNK + EPI_ROW(u, ai, m)) * 128 + wc * 32 + 4 * fq;
#pragma unroll
                for (int n = 0; n < 2; ++n) *(f32x4*)(rowp + n * 16) = acc[ai][0][m][n]; }
    }
};
struct EpiS5Out {
    static constexpr bool PERM = true;
    bf16_t* gact;
    __device__ __forceinline__ void operator()(const f32x4 (&acc)[2][2][4][2], const gm::Unit& u, int wr, int wc, int fr, int fq) const {
#pragma unroll
        for (int ai = 0; ai < 2; ++ai)
#pragma unroll
            for (int m = 0; m < 4; ++m) { const int r = EPI_ROW(u, ai, m);
#pragma unroll
                for (int bj = 0; bj < 2; ++bj) { const int n0 = bj * 128 + wc * 32 + 8 * fq, t = n0 >> 4, c0 = n0 & 15;
                    f32x4 v0 = acc[ai][bj][m][0], v1 = acc[ai][bj][m][1];
#pragma unroll
                    for (int j = 0; j < 4; ++j) { v0[j] = gelu_tanh(v0[j]); v1[j] = gelu_tanh(v1[j]); }
                    u32x4 w; w.x = cvt_pk_bf16(v0[0], v0[1]); w.y = cvt_pk_bf16(v0[2], v0[3]); w.z = cvt_pk_bf16(v1[0], v1[1]); w.w = cvt_pk_bf16(v1[2], v1[3]);
                    *(u32x4*)(gact + ((size_t)r * 16 + t) * S5W + u.g * 16 + c0) = w; } }
    }
};
template <int MODE> struct EpiSide {
    static constexpr bool PERM = true;
    bf16_t* O; int ldo; const bf16_t* s0; int ld0; const bf16_t* s1; int ld1;
    __device__ __forceinline__ void operator()(const f32x4 (&acc)[2][2][4][2], const gm::Unit& u, int wr, int wc, int fr, int fq) const {
        const int col0 = u.pn * 256 + wc * 32 + 8 * fq;
#pragma unroll
        for (int ai = 0; ai < 2; ++ai) {
            u32x4 sa[4][2], sb[4][2];
#pragma unroll
            for (int m = 0; m < 4; ++m)
#pragma unroll
                for (int bj = 0; bj < 2; ++bj) { const int row = EPI_ROW(u, ai, m);
                    sa[m][bj] = *(const u32x4*)(s0 + (size_t)row * ld0 + col0 + bj * 128);
                    if (MODE == 2) sb[m][bj] = *(const u32x4*)(s1 + (size_t)row * ld1 + col0 + bj * 128); else sb[m][bj] = (u32x4){0u, 0u, 0u, 0u}; }
#pragma unroll
            for (int m = 0; m < 4; ++m)
#pragma unroll
                for (int bj = 0; bj < 2; ++bj) { const int row = EPI_ROW(u, ai, m);
                    const f32x4 v0 = acc[ai][bj][m][0], v1 = acc[ai][bj][m][1]; const u32x4 a = sa[m][bj], b = sb[m][bj];
                    float r[8];
#pragma unroll
                    for (int q = 0; q < 4; ++q) { const float x0 = q < 2 ? v0[2 * q] : v1[2 * q - 4], x1 = q < 2 ? v0[2 * q + 1] : v1[2 * q - 3];
                        const float a0 = bflo(a[q]), a1 = bfhi(a[q]);
                        if (MODE == 0) { r[2 * q] = a0 * sigmoidf_(x0); r[2 * q + 1] = a1 * sigmoidf_(x1); }
                        else if (MODE == 1) { r[2 * q] = a0 * x0; r[2 * q + 1] = a1 * x1; }
                        else { r[2 * q] = bflo(b[q]) + a0 * x0; r[2 * q + 1] = bfhi(b[q]) + a1 * x1; } }
                    u32x4 w; w.x = cvt_pk_bf16(r[0], r[1]); w.y = cvt_pk_bf16(r[2], r[3]); w.z = cvt_pk_bf16(r[4], r[5]); w.w = cvt_pk_bf16(r[6], r[7]);
                    *(u32x4*)(O + (size_t)row * ldo + col0 + bj * 128) = w; }
        }
    }
};
struct EpiResidF32 {
    static constexpr bool PERM = false;
    const float* x; float* out;
    __device__ __forceinline__ void operator()(const f32x4 (&acc)[2][2][4][2], const gm::Unit& u, int wr, int wc, int fr, int fq) const {
#pragma unroll
        for (int ai = 0; ai < 2; ++ai)
#pragma unroll
            for (int mh = 0; mh < 2; ++mh) { f32x4 xv[2][2][2];
#pragma unroll
                for (int mm = 0; mm < 2; ++mm) { const size_t off = (size_t)EPI_ROW(u, ai, 2 * mh + mm) * DM + u.pn * 256 + wc * 32 + 4 * fq;
#pragma unroll
                    for (int bj = 0; bj < 2; ++bj)
#pragma unroll
                        for (int n = 0; n < 2; ++n) xv[mm][bj][n] = *(const f32x4*)(x + off + bj * 128 + n * 16); }
#pragma unroll
                for (int mm = 0; mm < 2; ++mm) { const size_t off = (size_t)EPI_ROW(u, ai, 2 * mh + mm) * DM + u.pn * 256 + wc * 32 + 4 * fq;
#pragma unroll
                    for (int bj = 0; bj < 2; ++bj)
#pragma unroll
                        for (int n = 0; n < 2; ++n) *(f32x4*)(out + off + bj * 128 + n * 16) = xv[mm][bj][n] + acc[ai][bj][2 * mh + mm][n]; } }
    }
};
#if MK_FP8_MOE
constexpr float MOE_DESCALE = 1.0f / (FP8_ASCALE * FP8_WSCALE);
#else
constexpr float MOE_DESCALE = 1.0f;
#endif
struct EpiSwiglu {
    static constexpr bool PERM = true;
    bf16_t* hact; const float* bgate; const float* bup; const LAS int* tab;
    __device__ __forceinline__ void operator()(const f32x4 (&acc)[2][2][4][2], const gm::Unit& u, int wr, int wc, int fr, int fq) const {
        const int hc = u.pn * 128 + wc * 32 + 8 * fq;
        const unsigned slot0 = (unsigned)u.st * 256u + wr * 64 + fr;
#pragma unroll
        for (int n = 0; n < 2; ++n) {
            const f32x4 g0 = *(const f32x4*)(bgate + (unsigned)(u.g * DFF + hc + 4 * n)), u0 = *(const f32x4*)(bup + (unsigned)(u.g * DFF + hc + 4 * n));
#pragma unroll
            for (int ai = 0; ai < 2; ++ai)
#pragma unroll
                for (int m = 0; m < 4; ++m) { const unsigned slot = slot0 + ai * 128 + m * 16;
                    float r[4];
#pragma unroll
                    for (int q = 0; q < 4; ++q) { float gt = acc[ai][0][m][n][q] * MOE_DESCALE + g0[q], up = acc[ai][1][m][n][q] * MOE_DESCALE + u0[q];
                        gt = fminf(gt, 7.0f); up = fminf(fmaxf(up, -7.0f), 7.0f);
                        r[q] = (up + 1.0f) * (gt * sigmoidf_(1.702f * gt)); }
#if MK_FP8_MOE
                    *(unsigned*)((uchar*)hact + slot * DFF + hc + 4 * n) = pk4_fp8(r[0] * FP8_ASCALE, r[1] * FP8_ASCALE, r[2] * FP8_ASCALE, r[3] * FP8_ASCALE);
#else
                    u32x2 w; w.x = cvt_pk_bf16(r[0], r[1]); w.y = cvt_pk_bf16(r[2], r[3]); *(u32x2*)(hact + slot * DFF + hc + 4 * n) = w;
#endif
                }
        }
    }
};
struct EpiDown {
    static constexpr bool PERM = true;
    bf16_t* ys; const float* bdown; const LAS int* tab;
    __device__ __forceinline__ void operator()(const f32x4 (&acc)[2][2][4][2], const gm::Unit& u, int wr, int wc, int fr, int fq) const {
        const size_t slot0 = (size_t)u.st * 256;
#pragma unroll
        for (int bj = 0; bj < 2; ++bj) { const int col = u.pn * 256 + bj * 128 + wc * 32 + 8 * fq;
            const float* bd = bdown + (size_t)u.g * DM + col; const f32x4 d0 = *(const f32x4*)bd, d1 = *(const f32x4*)(bd + 4);
#pragma unroll
            for (int ai = 0; ai < 2; ++ai)
#pragma unroll
                for (int m = 0; m < 4; ++m) { const size_t slot = slot0 + ai * 128 + wr * 64 + m * 16 + fr;
                    const f32x4 v0 = acc[ai][bj][m][0] * MOE_DESCALE + d0, v1 = acc[ai][bj][m][1] * MOE_DESCALE + d1;
                    u32x4 w; w.x = cvt_pk_bf16(v0[0], v0[1]); w.y = cvt_pk_bf16(v0[2], v0[3]); w.z = cvt_pk_bf16(v1[0], v1[1]); w.w = cvt_pk_bf16(v1[2], v1[3]);
                    *(u32x4*)(ys + slot * DM + col) = w; } }
    }
};

template <bool FP8OUT>
__device__ __forceinline__ void transpose_item(const float* W, int ldw, int src_col0, int k0, const float* kscale, void* WT, int ldt, int dst_row0, float oscale, LAS float* scr, int lane) {
    if (src_col0 >= 0) {
        f32x4 v[16]; const float* wp = W + (size_t)(k0 + (lane >> 4)) * ldw + src_col0 + (lane & 15) * 4;
#pragma unroll
        for (int i = 0; i < 16; ++i) v[i] = *(const f32x4*)(wp + (size_t)(4 * i) * ldw);
#pragma unroll
        for (int i = 0; i < 16; ++i) { const int kk = 4 * i + (lane >> 4); const float sc = kscale ? kscale[k0 + kk] * oscale : oscale; LAS float* d = scr + kk * 65 + (lane & 15) * 4;
            d[0] = v[i].x * sc; d[1] = v[i].y * sc; d[2] = v[i].z * sc; d[3] = v[i].w * sc; }
    } else {
#pragma unroll
        for (int i = 0; i < 16; ++i) { LAS float* d = scr + (4 * i + (lane >> 4)) * 65 + (lane & 15) * 4; d[0] = 0.f; d[1] = 0.f; d[2] = 0.f; d[3] = 0.f; }
    }
    LDS_WAIT(); asm volatile("" ::: "memory");
    if constexpr (FP8OUT) { const int c = lane & 3;
#pragma unroll
        for (int j = 0; j < 4; ++j) { const int n = (lane >> 2) + 16 * j; const LAS float* s = scr + (16 * c) * 65 + n; u32x4 o;
            o.x = pk4_fp8(s[0 * 65], s[1 * 65], s[2 * 65], s[3 * 65]); o.y = pk4_fp8(s[4 * 65], s[5 * 65], s[6 * 65], s[7 * 65]);
            o.z = pk4_fp8(s[8 * 65], s[9 * 65], s[10 * 65], s[11 * 65]); o.w = pk4_fp8(s[12 * 65], s[13 * 65], s[14 * 65], s[15 * 65]);
            *(u32x4*)((uchar*)WT + (size_t)(dst_row0 + n) * ldt + k0 + 16 * c) = o; }
    } else { const int c = lane & 7;
#pragma unroll
        for (int j = 0; j < 8; ++j) { const int n = (lane >> 3) + 8 * j; const LAS float* s = scr + (8 * c) * 65 + n;
            u32x4 o; o.x = pk2(s[0 * 65], s[1 * 65]); o.y = pk2(s[2 * 65], s[3 * 65]); o.z = pk2(s[4 * 65], s[5 * 65]); o.w = pk2(s[6 * 65], s[7 * 65]);
            *(u32x4*)((bf16_t*)WT + (size_t)(dst_row0 + n) * ldt + k0 + 8 * c) = o; }
    }
    LDS_WAIT(); asm volatile("" ::: "memory");
}
struct TItem { const float* src; uchar* dst; };
__device__ __forceinline__ void ti_load(const TItem& t, f32x4 (&v)[16], int lane) {
    const float* wp = t.src + (size_t)(lane >> 4) * DM + (lane & 15) * 4;
#pragma unroll
    for (int i = 0; i < 16; ++i) v[i] = *(const f32x4*)(wp + (size_t)(4 * i) * DM);
}
template <bool FP8OUT>
__device__ __forceinline__ void ti_store(const TItem& t, const f32x4 (&v)[16], float oscale, LAS float* scr, int lane) {
#pragma unroll
    for (int i = 0; i < 16; ++i) { LAS float* d = scr + (4 * i + (lane >> 4)) * 65 + (lane & 15) * 4; d[0] = v[i].x * oscale; d[1] = v[i].y * oscale; d[2] = v[i].z * oscale; d[3] = v[i].w * oscale; }
    LDS_WAIT(); asm volatile("" ::: "memory");
    if constexpr (FP8OUT) { const int c = lane & 3;
#pragma unroll
        for (int j = 0; j < 4; ++j) { const int n = (lane >> 2) + 16 * j; const LAS float* s = scr + (16 * c) * 65 + n; u32x4 o;
            o.x = pk4_fp8(s[0 * 65], s[1 * 65], s[2 * 65], s[3 * 65]); o.y = pk4_fp8(s[4 * 65], s[5 * 65], s[6 * 65], s[7 * 65]);
            o.z = pk4_fp8(s[8 * 65], s[9 * 65], s[10 * 65], s[11 * 65]); o.w = pk4_fp8(s[12 * 65], s[13 * 65], s[14 * 65], s[15 * 65]);
            *(u32x4*)(t.dst + (size_t)n * DM + 16 * c) = o; }
    } else { const int c = lane & 7;
#pragma unroll
        for (int j = 0; j < 8; ++j) { const int n = (lane >> 3) + 8 * j; const LAS float* s = scr + (8 * c) * 65 + n;
            u32x4 o; o.x = pk2(s[0 * 65], s[1 * 65]); o.y = pk2(s[2 * 65], s[3 * 65]); o.z = pk2(s[4 * 65], s[5 * 65]); o.w = pk2(s[6 * 65], s[7 * 65]);
            *(u32x4*)(t.dst + ((size_t)n * DM + 8 * c) * 2) = o; }
    }
    LDS_WAIT(); asm volatile("" ::: "memory");
}
template <bool W8>
__device__ __forceinline__ TItem moe_item(const Args& a, uchar* ws, int it) {
    constexpr size_t WEB = W8 ? 1 : 2; TItem t;
    if (it < NE * 2 * 32 * 32) { const int nb = it & 31, kb = (it >> 5) & 31, half = (it >> 10) & 1, e = it >> 11, pn = nb >> 1, q = nb & 1;
        t.src = a.in[half ? I_WU : I_WG] + (size_t)e * DM * DFF + (size_t)(kb * 64) * DFF + nb * 64;
        t.dst = ws + WS_W1 + ((size_t)e * 4096 * DM + (size_t)(pn * 256 + half * 128 + q * 64) * DM + kb * 64) * WEB;
    } else { const int r = it - NE * 2 * 32 * 32, nb = r & 31, kb = (r >> 5) & 31, e = r >> 10;
        t.src = a.in[I_WD] + (size_t)e * DFF * DM + (size_t)(kb * 64) * DM + nb * 64;
        t.dst = ws + WS_W2 + ((size_t)e * DM * DFF + (size_t)(nb * 64) * DFF + kb * 64) * WEB; }
    return t;
}
__device__ __forceinline__ int win_src_col(int n0) {
    if (n0 < C_KVLAT) return n0;
    if (n0 < C_U) return n0;
    if (n0 < C_GA) return (n0 - C_U) + 832;
    if (n0 < C_KR) return (n0 - C_GA) + 1856;
    if (n0 < C_KR + DROPE) return (n0 - C_KR) + 768;
    return -1;
}
__device__ __forceinline__ void s5_build_group(const Args& a, const Frame& F, int g) {
    FRAME_IDS(F);
    LAS float* L = (LAS float*)F.lds;
    LAS float* Apr = L;              LAS float* Api = Apr + 17 * 64;
    LAS float* Zr = Api + 17 * 64;   LAS float* Zi = Zr + 64;
    LAS float* Bbr = Zi + 64;        LAS float* Bbi = Bbr + 1024;
    LAS float* Cr = Bbi + 1024;      LAS float* Ci = Cr + 1024;
    LAS float* Kt = Ci + 1024;
    const int tid = F_tid;
    __syncthreads();
    if (tid < 64) { const int p = tid;
        const float dt = expf(a.in[I_LOGDT][g]); const float lr = a.in[I_LRE][g * 64 + p], li = a.in[I_LIM][g * 64 + p];
        const float mag = expf(lr * dt); const float ar = mag * cosf(li * dt), ai = mag * sinf(li * dt);
        const float den = lr * lr + li * li;
        Zr[p] = ((ar - 1.0f) * lr + ai * li) / den; Zi[p] = (ai * lr - (ar - 1.0f) * li) / den;
        float pr = 1.0f, pi = 0.0f;
        for (int t = 0; t <= 16; ++t) { Apr[t * 64 + p] = pr; Api[t * 64 + p] = pi; const float nr = pr * ar - pi * ai, ni = pr * ai + pi * ar; pr = nr; pi = ni; }
    }
    __syncthreads();
    for (int i = tid; i < 1024; i += NTHREADS) { const int p = i >> 4;
        const float br = a.in[I_BRE][(size_t)g * 1024 + i], bi = a.in[I_BIM][(size_t)g * 1024 + i];
        Bbr[i] = Zr[p] * br - Zi[p] * bi; Bbi[i] = Zr[p] * bi + Zi[p] * br;
        Cr[i] = a.in[I_CRE][(size_t)g * 1024 + i]; Ci[i] = a.in[I_CIM][(size_t)g * 1024 + i]; }
    if (tid < 64) ((float2*)(F.ws + WS_SMALL + SM_A16))[g * 64 + tid] = make_float2(Apr[16 * 64 + tid], Api[16 * 64 + tid]);
    __syncthreads();
    { const int tau = tid >> 5, c = (tid >> 1) & 15, h8 = (tid & 1) * 8; float acc8[8];
#pragma unroll
      for (int j = 0; j < 8; ++j) acc8[j] = 0.f;
      for (int p = 0; p < 64; ++p) { const float cr = Cr[c * 64 + p], ci = Ci[c * 64 + p], ar = Apr[tau * 64 + p], ai = Api[tau * 64 + p];
          const float car = cr * ar - ci * ai, cai = cr * ai + ci * ar;
          const f32x4 b0 = *(const LAS f32x4*)(Bbr + p * 16 + h8), b1 = *(const LAS f32x4*)(Bbr + p * 16 + h8 + 4), d0 = *(const LAS f32x4*)(Bbi + p * 16 + h8), d1 = *(const LAS f32x4*)(Bbi + p * 16 + h8 + 4);
#pragma unroll
          for (int j = 0; j < 4; ++j) { acc8[j] += car * b0[j] - cai * d0[j]; acc8[4 + j] += car * b1[j] - cai * d1[j]; } }
#pragma unroll
      for (int j = 0; j < 8; ++j) Kt[(tau * 16 + c) * 16 + h8 + j] = acc8[j]; }
    __syncthreads();
    bf16_t* twc = (bf16_t*)(F.ws + WS_TWC) + (size_t)g * 256 * APK;
    for (int ch = tid; ch < 256 * (APK / 8); ch += NTHREADS) { const int n = ch / (APK / 8), k0 = (ch % (APK / 8)) * 8, t = n >> 4, c = n & 15; float v[8];
#pragma unroll
        for (int j = 0; j < 8; ++j) { const int k = k0 + j;
            if (k < 256) { const int s = k >> 4, cp = k & 15; float x = (s <= t) ? Kt[((t - s) * 16 + c) * 16 + cp] : 0.f; if (s == t && cp == c) x += a.in[I_S5D][g * 16 + c]; v[j] = x; }
            else { const int q = k - 256, p = q & 63; const float cr = Cr[c * 64 + p], ci = Ci[c * 64 + p], ar = Apr[(t + 1) * 64 + p], ai = Api[(t + 1) * 64 + p];
                v[j] = (q < 64) ? (cr * ar - ci * ai) : -(cr * ai + ci * ar); } }
        u32x4 o; o.x = pk2(v[0], v[1]); o.y = pk2(v[2], v[3]); o.z = pk2(v[4], v[5]); o.w = pk2(v[6], v[7]);
        *(u32x4*)(twc + (size_t)n * APK + k0) = o; }
    bf16_t* wsm = (bf16_t*)(F.ws + WS_WS5) + (size_t)g * 256 * 256;
    for (int ch = tid; ch < 256 * 32; ch += NTHREADS) { const int n = ch >> 5, k0 = (ch & 31) * 8; float v[8];
#pragma unroll
        for (int j = 0; j < 8; ++j) { const int k = k0 + j, s = k >> 4, cp = k & 15;
            if (n < 128) { const int p = n & 63; const float ar = Apr[(15 - s) * 64 + p], ai = Api[(15 - s) * 64 + p], br = Bbr[p * 16 + cp], bi = Bbi[p * 16 + cp];
                v[j] = (n < 64) ? (ar * br - ai * bi) : (ar * bi + ai * br); } else v[j] = 0.f; }
        u32x4 o; o.x = pk2(v[0], v[1]); o.y = pk2(v[2], v[3]); o.z = pk2(v[4], v[5]); o.w = pk2(v[6], v[7]);
        *(u32x4*)(wsm + (size_t)n * 256 + k0) = o; }
    __syncthreads();
}
__device__ __forceinline__ void rms_row_to_bf16(const float* xrow, const float* gain, bf16_t* orow, int lane) {
    const f32x4* xr = (const f32x4*)xrow + lane; const f32x4* gr = (const f32x4*)gain + lane;
    f32x4 v[8]; float s = 0.f;
#pragma unroll
    for (int j = 0; j < 8; ++j) { v[j] = xr[64 * j]; s += (v[j].x * v[j].x + v[j].y * v[j].y) + (v[j].z * v[j].z + v[j].w * v[j].w); }
    const float rstd = 1.0f / sqrtf(wave_sum(s) * (1.0f / DM) + EPS);
    unsigned long long* o8 = (unsigned long long*)orow + lane;
#pragma unroll
    for (int j = 0; j < 8; ++j) { const f32x4 gg = gr[64 * j];
        o8[64 * j] = (unsigned long long)pk2(v[j].x * rstd * gg.x, v[j].y * rstd * gg.y) | ((unsigned long long)pk2(v[j].z * rstd * gg.z, v[j].w * rstd * gg.w) << 32); }
}
__device__ __forceinline__ void p0_prologue(const Args& a, const Frame& F) {
    FRAME_IDS(F);
    for (int g = F.bx; g < S5G; g += F.G) s5_build_group(a, F, g);
    __syncthreads();
    const int gw = F.bx * NWAVES + F.wave, NGW = F.G * NWAVES; const int lane = F_lane;
    for (int m = gw; m < TT; m += NGW) rms_row_to_bf16(a.in[I_X] + (size_t)m * DM, a.in[I_N1G], (bf16_t*)(F.ws + WS_H) + (size_t)m * DM, lane);
    for (int i = gw * 64 + lane; i < TT * 32; i += NGW * 64) { const int t = i >> 5, f = i & 31;
        const double invf = exp(-(double)f * (9.210340371976184 / 32.0)); const double ang = (double)((const int*)a.in[I_POS])[t] * invf;
        ((float2*)(F.ws + WS_ROPE))[i] = make_float2((float)cos(ang), (float)sin(ang)); }
    for (int i = gw * 64 + lane; i < DM * NE; i += NGW * 64) ((float*)(F.ws + WS_SMALL + SM_WRP))[i] = a.in[I_WR][i] * a.in[I_N2G][i >> 5];
    LAS float* scr = (LAS float*)(F.lds + F.wave * 16640);
    constexpr int IT_WIN = (DM / 64) * (NPROJ / 64), IT_WUQ = (QLORA / 64) * (3072 / 64), IT_WUKV = (KVLORA / 64) * (4096 / 64), IT_SQ = (DM / 64) * (DM / 64),
                  IT_GLU = (S5W / 64) * (S5W / 64), IT_OS5 = (S5W / 64) * (DM / 64);
    constexpr int IT_MIX = IT_WIN + IT_WUQ + IT_WUKV + IT_SQ + IT_GLU + IT_OS5 + IT_SQ;
    for (int it = gw; it < IT_MIX; it += NGW) { int r = it;
        if (r < IT_WIN) { const int nb = r % (NPROJ / 64), kb = r / (NPROJ / 64); transpose_item<false>(a.in[I_WIN], IN_PROJ, win_src_col(nb * 64), kb * 64, nullptr, F.ws + WS_WIN, DM, nb * 64, 1.f, scr, lane); continue; } r -= IT_WIN;
        if (r < IT_WUQ) { const int nb = r % 48, kb = r / 48; transpose_item<false>(a.in[I_WUQ], 3072, nb * 64, kb * 64, a.in[I_QNG], F.ws + WS_WUQ, QLORA, nb * 64, 1.f, scr, lane); continue; } r -= IT_WUQ;
        if (r < IT_WUKV) { const int nb = r % 64, kb = r / 64; transpose_item<false>(a.in[I_WUKV], 4096, nb * 64, kb * 64, a.in[I_KVNG], F.ws + WS_WUKV, KVLORA, nb * 64, 1.f, scr, lane); continue; } r -= IT_WUKV;
        if (r < IT_SQ) { const int nb = r % 32, kb = r / 32; transpose_item<false>(a.in[I_WOMLA], DM, nb * 64, kb * 64, nullptr, F.ws + WS_WOMLA, DM, nb * 64, 1.f, scr, lane); continue; } r -= IT_SQ;
        if (r < IT_GLU) { const int nb = r % 16, kb = r / 16; transpose_item<false>(a.in[I_WGLU], S5W, nb * 64, kb * 64, nullptr, F.ws + WS_WGLU, S5W, nb * 64, 1.f, scr, lane); continue; } r -= IT_GLU;
        if (r < IT_OS5) { const int nb = r % 32, kb = r / 32; transpose_item<false>(a.in[I_WOS5], DM, nb * 64, kb * 64, nullptr, F.ws + WS_WOS5, S5W, nb * 64, 1.f, scr, lane); continue; } r -= IT_OS5;
        { const int nb = r % 32, kb = r / 32; transpose_item<false>(a.in[I_WOUT], DM, nb * 64, kb * 64, nullptr, F.ws + WS_WOUT, DM, nb * 64, 1.f, scr, lane); }
    }
    constexpr bool W8 = MK_FP8_MOE != 0; constexpr float WSC = W8 ? FP8_WSCALE : 1.0f; constexpr int NIT = NE * 3 * 32 * 32;
    if (gw < NIT) { TItem cur = moe_item<W8>(a, F.ws, gw); f32x4 v[16]; ti_load(cur, v, lane);
        for (int it = gw; it < NIT; it += NGW) { const bool hn = it + NGW < NIT; TItem nx = cur; f32x4 w[16];
            if (hn) { nx = moe_item<W8>(a, F.ws, it + NGW); ti_load(nx, w, lane); }
            ti_store<W8>(cur, v, WSC, scr, lane);
            if (hn) { cur = nx;
#pragma unroll
                for (int i = 0; i < 16; ++i) v[i] = w[i]; } } }
}

constexpr float QSCALE = 0.07216878364870322f * 1.4426950408889634f;
__device__ __forceinline__ float half_sum(float v) {
#pragma unroll
    for (int o = 1; o < 32; o <<= 1) v += __shfl_xor(v, o);
    return v;
}
__device__ __forceinline__ void p3_prep(const Args& a, const Frame& F) {
    FRAME_IDS(F);
    const bf16_t* proj = (const bf16_t*)(F.ws + WS_PROJ); const bf16_t* qraw = (const bf16_t*)(F.ws + WS_QRAW); const bf16_t* kvraw = (const bf16_t*)(F.ws + WS_KVRAW);
    bf16_t* Qn = (bf16_t*)(F.ws + WS_QN); bf16_t* Kn = (bf16_t*)(F.ws + WS_KN); bf16_t* Vn = (bf16_t*)(F.ws + WS_VN);
    const float2* rope = (const float2*)(F.ws + WS_ROPE);
    const int lane = F_lane;
    const bool isq = lane < 24, isk = lane >= 24 && lane < 48, isv = lane >= 48;
    const int ch = isq ? lane : (isk ? lane - 24 : lane - 48);
    const bool isrope = (isq || isk) && ch >= 16; const bool x2half = isrope && ch >= 20;
    const int ri = isrope ? ((ch - 16) & 3) * 8 : 0;
    float g[8];
#pragma unroll
    for (int j = 0; j < 8; ++j) g[j] = isq ? a.in[I_QKQG][ch * 8 + j] * QSCALE : (isk ? a.in[I_QKKG][ch * 8 + j] : 1.0f);
    const int gw = F.bx * NWAVES + F.wave, NGW = F.G * NWAVES;
    for (int t = gw; t < TT; t += NGW) {
        const int b = t >> 11, s = t & 2047; const bf16_t* prow = proj + (size_t)t * NPROJ;
        float sq = 0.f, skv = 0.f;
        { const u32x4 w = *(const u32x4*)(prow + C_QLAT + 8 * lane);
#pragma unroll
          for (int q = 0; q < 4; ++q) { const float x0 = bflo(w[q]), x1 = bfhi(w[q]); sq += x0 * x0 + x1 * x1; }
          if (lane < 32) { const u32x4 w2 = *(const u32x4*)(prow + C_KVLAT + 8 * lane);
#pragma unroll
              for (int q = 0; q < 4; ++q) { const float x0 = bflo(w2[q]), x1 = bfhi(w2[q]); skv += x0 * x0 + x1 * x1; } } }
        const float rstd_q = 1.0f / sqrtf(wave_sum(sq) * (1.0f / QLORA) + EPS), rstd_kv = 1.0f / sqrtf(wave_sum(skv) * (1.0f / KVLORA) + EPS);
        float cs[8], sn[8];
        if (isrope) {
#pragma unroll
            for (int j = 0; j < 8; j += 2) { const f32x4 c2 = *(const f32x4*)(rope + (size_t)t * 32 + ri + j); cs[j] = c2.x; sn[j] = c2.y; cs[j + 1] = c2.z; sn[j + 1] = c2.w; } }
        else {
#pragma unroll
            for (int j = 0; j < 8; ++j) { cs[j] = 1.f; sn[j] = 0.f; } }
        const float lat = isq ? rstd_q : rstd_kv;
        u32x4 kr = (u32x4){0u, 0u, 0u, 0u};
        if (isk && ch >= 16) kr = *(const u32x4*)(prow + C_KR + (ch - 16) * 8);
        u32x4 wl[NH];
        { const bf16_t* src0 = isq ? (qraw + (size_t)t * 3072 + ch * 8) : (isk ? (kvraw + (size_t)t * 4096 + ch * 8) : (kvraw + (size_t)t * 4096 + 128 + ch * 8)); const int hstr = isq ? DQK : 256;
#pragma unroll
          for (int h = 0; h < NH; ++h) wl[h] = (isk && ch >= 16) ? kr : *(const u32x4*)(src0 + h * hstr); }
#pragma unroll
        for (int h = 0; h < NH; ++h) {
            const u32x4 w = wl[h];
            float x[8];
#pragma unroll
            for (int q = 0; q < 4; ++q) { x[2 * q] = bflo(w[q]); x[2 * q + 1] = bfhi(w[q]); }
            const float sc0 = (isk && ch >= 16) ? 1.0f : lat;
            float ss = 0.f;
#pragma unroll
            for (int j = 0; j < 8; ++j) { x[j] *= sc0; ss += x[j] * x[j]; }
            const float ssq_ = wave_sum(isq ? ss : 0.f), ssk_ = wave_sum(isk ? ss : 0.f);
            const float rn = isq ? 1.0f / sqrtf(ssq_ * (1.0f / DQK) + EPS) : (isk ? 1.0f / sqrtf(ssk_ * (1.0f / DQK) + EPS) : 1.0f);
            float y[8];
#pragma unroll
            for (int j = 0; j < 8; ++j) y[j] = x[j] * rn * g[j];
#pragma unroll
            for (int j = 0; j < 8; ++j) { const float partner = __shfl_xor(y[j], 4);
                y[j] = x2half ? (y[j] * cs[j] + partner * sn[j]) : (y[j] * cs[j] - partner * sn[j]); }
            u32x4 o; o.x = pk2(y[0], y[1]); o.y = pk2(y[2], y[3]); o.z = pk2(y[4], y[5]); o.w = pk2(y[6], y[7]);
            const size_t hs = ((size_t)(b * NH + h) * SEQ + s);
            bf16_t* dst = isq ? (Qn + hs * DQK + ch * 8) : (isk ? (Kn + hs * DQK + ch * 8) : (Vn + hs * DV + ch * 8));
            *(u32x4*)dst = o;
        }
    }
}

__device__ __forceinline__ void p3_scan(const Args& a, const Frame& F) {
    FRAME_IDS(F);
    const float* sch = (const float*)(F.ws + WS_SCH); bf16_t* apack = (bf16_t*)(F.ws + WS_APACK); const float2* A16 = (const float2*)(F.ws + WS_SMALL + SM_A16);
    const int gw = F.bx * NWAVES + F.wave, NGW = F.G * NWAVES, p = F_lane;
    for (int it = gw; it < NB * S5G; it += NGW) { const int b = it / S5G, g = it % S5G;
        const float2 am = A16[g * 64 + p]; float xr = 0.f, xi = 0.f;
        const size_t row0 = (size_t)g * NCHUNK + (size_t)b * 128;
        for (int c0 = 0; c0 < 128; c0 += 32) { float sr[32], si[32];
#pragma unroll
            for (int q = 0; q < 32; ++q) { sr[q] = sch[(row0 + c0 + q) * 128 + p]; si[q] = sch[(row0 + c0 + q) * 128 + 64 + p]; }
#pragma unroll
            for (int q = 0; q < 32; ++q) { bf16_t* o = apack + (row0 + c0 + q) * APK + 256; o[p] = (bf16_t)f2bf(xr); o[64 + p] = (bf16_t)f2bf(xi);
                const float nr = am.x * xr - am.y * xi + sr[q], ni = am.x * xi + am.y * xr + si[q]; xr = nr; xi = ni; } }
    }
}

__device__ __forceinline__ void s5_reference(const Args& a, const Frame& F) {
    FRAME_IDS(F);
    const bf16_t* apack = (const bf16_t*)(F.ws + WS_APACK); bf16_t* gact = (bf16_t*)(F.ws + WS_GACT);
    const int gw = F.bx * NWAVES + F.wave, NGW = F.G * NWAVES, p = F_lane;
    for (int it = gw; it < NB * S5G; it += NGW) { const int b = it / S5G, g = it % S5G;
        const float dt = expf(a.in[I_LOGDT][g]); const float lr = a.in[I_LRE][g * 64 + p], li = a.in[I_LIM][g * 64 + p];
        const float mag = expf(lr * dt); const float ar = mag * cosf(li * dt), ai = mag * sinf(li * dt); const float den = lr * lr + li * li;
        const float zr = ((ar - 1.0f) * lr + ai * li) / den, zi = (ai * lr - (ar - 1.0f) * li) / den;
        float bbr[16], bbi[16], cr[16], ci[16];
#pragma unroll
        for (int c = 0; c < 16; ++c) { const float br = a.in[I_BRE][((size_t)g * 64 + p) * 16 + c], bi = a.in[I_BIM][((size_t)g * 64 + p) * 16 + c];
            bbr[c] = zr * br - zi * bi; bbi[c] = zr * bi + zi * br; cr[c] = a.in[I_CRE][((size_t)g * 16 + c) * 64 + p]; ci[c] = a.in[I_CIM][((size_t)g * 16 + c) * 64 + p]; }
        const float dl = (p < 16) ? a.in[I_S5D][g * 16 + p] : 0.f;
        float xr = 0.f, xi = 0.f;
        for (int t = 0; t < SEQ; ++t) { const int tok = b * SEQ + t;
            const bf16_t* up = apack + ((size_t)g * NCHUNK + (tok >> 4)) * APK + (tok & 15) * 16;
            const u32x4 w0 = *(const u32x4*)up, w1 = *(const u32x4*)(up + 8); float u[16];
#pragma unroll
            for (int q = 0; q < 4; ++q) { u[2 * q] = bflo(w0[q]); u[2 * q + 1] = bfhi(w0[q]); u[8 + 2 * q] = bflo(w1[q]); u[8 + 2 * q + 1] = bfhi(w1[q]); }
            float br = 0.f, bi = 0.f;
#pragma unroll
            for (int c = 0; c < 16; ++c) { br += bbr[c] * u[c]; bi += bbi[c] * u[c]; }
            const float nr = ar * xr - ai * xi + br, ni = ar * xi + ai * xr + bi; xr = nr; xi = ni;
            float y = 0.f, um = 0.f;
#pragma unroll
            for (int c = 0; c < 16; ++c) { const float yc = wave_sum(cr[c] * xr - ci[c] * xi); if (p == c) { y = yc; um = u[c]; } }
            if (p < 16) gact[(size_t)tok * S5W + g * 16 + p] = (bf16_t)f2bf(gelu_tanh(y + dl * um));
        }
    }
}

__device__ __forceinline__ float attn_bound(const Args& a, int lane) {
    float mq = 0.f, mk = 0.f;
#pragma unroll
    for (int q = 0; q < 3; ++q) { mq = fmaxf(mq, fabsf(a.in[I_QKQG][lane + 64 * q])); mk = fmaxf(mk, fabsf(a.in[I_QKKG][lane + 64 * q])); }
#pragma unroll
    for (int o = 1; o < 64; o <<= 1) { mq = fmaxf(mq, __shfl_xor(mq, o)); mk = fmaxf(mk, __shfl_xor(mk, o)); }
    return mq * mk * 13.856406460551018f * 1.4426950408889634f;
}
__device__ __forceinline__ void attn_reference(const Args& a, const Frame& F) {
    FRAME_IDS(F);
    const bf16_t* Qn = (const bf16_t*)(F.ws + WS_QN); const bf16_t* Kn = (const bf16_t*)(F.ws + WS_KN); const bf16_t* Vn = (const bf16_t*)(F.ws + WS_VN);
    bf16_t* O = (bf16_t*)(F.ws + WS_O);
    LAS float* ql = (LAS float*)(F.lds + F.wave * 1024);
    const int lane = F_lane, gw = F.bx * NWAVES + F.wave, NGW = F.G * NWAVES;
    const float Mb = attn_bound(a, lane);
    for (int it = gw; it < NB * NH * SEQ; it += NGW) { const int s = it & 2047, bh = it >> 11, b = bh >> 4, h = bh & 15;
        const bf16_t* qp = Qn + ((size_t)bh * SEQ + s) * DQK;
#pragma unroll
        for (int q = 0; q < 3; ++q) ql[lane + 64 * q] = bf2f(qp[lane + 64 * q]);
        LDS_WAIT();
        const int nk = 64 * ((s >> 6) + 1);
        float o0 = 0.f, o1 = 0.f, l = 0.f;
        for (int k0 = 0; k0 < nk; k0 += 64) {
            const bf16_t* kp = Kn + ((size_t)bh * SEQ + k0 + lane) * DQK; float sc = 0.f;
            for (int d = 0; d < DQK; d += 8) { const u32x4 w = *(const u32x4*)(kp + d);
#pragma unroll
                for (int q = 0; q < 4; ++q) sc += bflo(w[q]) * ql[d + 2 * q] + bfhi(w[q]) * ql[d + 2 * q + 1]; }
            const float pr = __builtin_amdgcn_exp2f(sc - Mb); l += pr;
            for (int kk = 0; kk < 64; ++kk) { const float pk = __shfl(pr, kk); const unsigned w = *(const unsigned*)(Vn + ((size_t)bh * SEQ + k0 + kk) * DV + 2 * lane);
                o0 += pk * bflo(w); o1 += pk * bfhi(w); }
        }
        l = wave_sum(l); const float rl = 1.0f / l;
        *(unsigned*)(O + ((size_t)(b * SEQ + s)) * DM + h * DV + 2 * lane) = pk2(o0 * rl, o1 * rl);
        LDS_WAIT();
    }
}

namespace at {
constexpr int KVB = 64;
constexpr int SHM_V = KVB * DV * 2  , SHM_K = KVB * DQK * 2  ;
constexpr int NQR = 4;
constexpr int OFF_V = 0, OFF_K = 2 * SHM_V, OFF_WS = OFF_K + 2 * SHM_K  , OFF_QL = OFF_WS + NWAVES * 256  , OFF_OST = 0;
constexpr int OPITCH = 272;
static_assert(OFF_QL + NWAVES * (12 - NQR) * 1024 <= LDSCTL_OFF, "attention LDS map");
#define KSWZ(row, colB) ((row) * 384 + ((colB) ^ (((row) & 7) << 4)))
__device__ __forceinline__ int crow(int r, int hi) { return (r & 3) + 8 * (r >> 2) + 4 * hi; }
__device__ __forceinline__ int v_st(int k, int c) { const int kk = (k & ~0xC) | ((k & 4) << 1) | ((k & 8) >> 1); return ((kk >> 3) * 4 + (c >> 5)) * 512 + ((kk & 7) * 32 + (c & 31)) * 2; }
__device__ __forceinline__ int v_rd_base(int lane) { return ((lane & 3) << 3) | (((lane >> 2) & 3) << 6) | (((lane >> 4) & 1) << 5) | (((lane >> 5) & 1) << 8); }
constexpr int v_rd_off(int d0, int ks, int half) { return d0 * 512 + ks * 4096 + half * 2048; }
template <int OFF> __device__ __forceinline__ s16x4 tr_read(int vb) { s16x4 r; asm volatile("ds_read_b64_tr_b16 %0, %1 offset:%2" : "=&v"(r) : "v"(vb), "i"(OFF) : "memory"); return r; }
template <int D0> __device__ __forceinline__ void pv_one(f32x16& od, int vb, bf16x8 pa0, bf16x8 pa1, bf16x8 pa2, bf16x8 pa3) {
    const s16x4 l0 = tr_read<v_rd_off(D0, 0, 0)>(vb), h0 = tr_read<v_rd_off(D0, 0, 1)>(vb), l1 = tr_read<v_rd_off(D0, 1, 0)>(vb), h1 = tr_read<v_rd_off(D0, 1, 1)>(vb);
    const s16x4 l2 = tr_read<v_rd_off(D0, 2, 0)>(vb), h2 = tr_read<v_rd_off(D0, 2, 1)>(vb), l3 = tr_read<v_rd_off(D0, 3, 0)>(vb), h3 = tr_read<v_rd_off(D0, 3, 1)>(vb);
    asm volatile("s_waitcnt lgkmcnt(0)" ::: "memory"); SBAR();
#define PK(L, H) (bf16x8){L[0], L[1], L[2], L[3], H[0], H[1], H[2], H[3]}
    od = __builtin_amdgcn_mfma_f32_32x32x16_bf16(pa0, PK(l0, h0), od, 0, 0, 0);
    od = __builtin_amdgcn_mfma_f32_32x32x16_bf16(pa1, PK(l1, h1), od, 0, 0, 0);
    od = __builtin_amdgcn_mfma_f32_32x32x16_bf16(pa2, PK(l2, h2), od, 0, 0, 0);
    od = __builtin_amdgcn_mfma_f32_32x32x16_bf16(pa3, PK(l3, h3), od, 0, 0, 0);
#undef PK
}
__device__ __forceinline__ void pv_d0(f32x16* o, int vb, bf16x8 pa0, bf16x8 pa1, bf16x8 pa2, bf16x8 pa3) {
    pv_one<0>(o[0], vb, pa0, pa1, pa2, pa3); pv_one<1>(o[1], vb, pa0, pa1, pa2, pa3); pv_one<2>(o[2], vb, pa0, pa1, pa2, pa3); pv_one<3>(o[3], vb, pa0, pa1, pa2, pa3);
}
template <int BUF, int NQR> __device__ __forceinline__ void qkt(f32x16& p0, f32x16& p1, const int (&kb)[4], const bf16x8* qr, int qlb) {
    p0 = f32x16{}; p1 = f32x16{};
#pragma unroll
    for (int a = 0; a < 3; ++a)
#pragma unroll
        for (int b = 0; b < 4; ++b) { const int d0 = 4 * a + b;
            const bf16x8 b0 = *(const LAS bf16x8*)(kb[b] + BUF * SHM_K + a * 128);
            const bf16x8 b1 = *(const LAS bf16x8*)(kb[b] + BUF * SHM_K + a * 128 + 32 * 384);
            bf16x8 q; if (d0 < NQR) q = qr[d0]; else q = *(const LAS bf16x8*)(qlb + (d0 - NQR) * 1024);
            p0 = __builtin_amdgcn_mfma_f32_32x32x16_bf16(b0, q, p0, 0, 0, 0);
            p1 = __builtin_amdgcn_mfma_f32_32x32x16_bf16(b1, q, p1, 0, 0, 0); }
}
__device__ __forceinline__ void partialSM(f32x16& p0, f32x16& p1, float bias) {
#pragma unroll
    for (int r = 0; r < 16; ++r) p0[r] = __builtin_amdgcn_exp2f(p0[r] + bias);
#pragma unroll
    for (int r = 0; r < 16; ++r) p1[r] = p1[r] + bias;
}
__device__ __forceinline__ void finishSM(f32x16& p0, f32x16& p1, float& l_reg, bf16x8& pa0, bf16x8& pa1, bf16x8& pa2, bf16x8& pa3) {
#pragma unroll
    for (int r = 0; r < 16; ++r) p1[r] = __builtin_amdgcn_exp2f(p1[r]);
    float ps = 0;
#pragma unroll
    for (int r = 0; r < 16; ++r) ps += p0[r];
#pragma unroll
    for (int r = 0; r < 16; ++r) ps += p1[r];
    { auto rr = __builtin_amdgcn_permlane32_swap(__float_as_uint(ps), __float_as_uint(ps), false, false); ps = __uint_as_float(rr[0]) + __uint_as_float(rr[1]); }
    l_reg += ps;
#define PK4(P, BASE, OUT) do { unsigned a0 = cvt_pk_bf16(P[BASE + 0], P[BASE + 1]), a1 = cvt_pk_bf16(P[BASE + 2], P[BASE + 3]);   \
    unsigned b0 = cvt_pk_bf16(P[BASE + 4], P[BASE + 5]), b1 = cvt_pk_bf16(P[BASE + 6], P[BASE + 7]);                              \
    auto r0 = __builtin_amdgcn_permlane32_swap(a0, b0, false, false); auto r1 = __builtin_amdgcn_permlane32_swap(a1, b1, false, false); \
    u32x4 w = {r0[0], r1[0], r0[1], r1[1]}; OUT = *reinterpret_cast<bf16x8*>(&w); } while (0)
    PK4(p0, 0, pa0); PK4(p0, 8, pa1); PK4(p1, 0, pa2); PK4(p1, 8, pa3);
#undef PK4
}
__device__ __forceinline__ void attn_qblock(const bf16_t* __restrict__ Qb, const bf16_t* __restrict__ Kh, const bf16_t* __restrict__ Vh, bf16_t* __restrict__ Ob, int qb, float Mb, LAS char* lds, const int wid) {
    const int lane = fresh_lane(), tid = wid * 64 + lane, r32 = lane & 31, hi = lane >> 5;
    LAS char* V_lds = lds + OFF_V; LAS char* K_lds = lds + OFF_K;
    LAS float* li_l = (LAS float*)(lds + OFF_WS) + wid * 64;
    float l_reg = 0; f32x16 o[4] = {}; bf16x8 qr[NQR];
    const bf16_t* Qw = Qb + (size_t)(wid * 32 + r32) * DQK + hi * 8;
    const int qlb = (int)(uintptr_t)(lds + OFF_QL) + wid * ((12 - NQR) * 1024) + lane * 16;
#pragma unroll
    for (int d0 = 0; d0 < NQR; ++d0) qr[d0] = *(const bf16x8*)(Qw + d0 * 16);
#pragma unroll
    for (int d0 = NQR; d0 < 12; ++d0) *(LAS bf16x8*)(qlb + (d0 - NQR) * 1024) = *(const bf16x8*)(Qw + d0 * 16);
    const int sr = tid >> 4, sc = (tid & 15) * 8, vst0 = v_st(sr, sc), vst1 = v_st(32 + sr, sc);
    int kro[3], kst[3];
#pragma unroll
    for (int i = 0; i < 3; ++i) { const int q = tid + 512 * i, row = q / 24, c8 = q % 24; kro[i] = row * DQK + c8 * 8; kst[i] = KSWZ(row, c8 * 16); }
    const int vb0 = (int)(uintptr_t)V_lds + v_rd_base(lane);
    int kb[4];
#pragma unroll
    for (int b = 0; b < 4; ++b) kb[b] = (int)(uintptr_t)K_lds + r32 * 384 + ((b * 32 + hi * 16) ^ ((r32 & 7) << 4));
    bf16x8 vs0, vs1, ks0, ks1, ks2;
#define SLOAD(k0) do { vs0 = *(const bf16x8*)(Vh + (size_t)((k0) + sr) * DV + sc); vs1 = *(const bf16x8*)(Vh + (size_t)((k0) + 32 + sr) * DV + sc); \
    ks0 = *(const bf16x8*)(Kh + (size_t)(k0) * DQK + kro[0]); ks1 = *(const bf16x8*)(Kh + (size_t)(k0) * DQK + kro[1]); ks2 = *(const bf16x8*)(Kh + (size_t)(k0) * DQK + kro[2]); } while (0)
#define SWRITE(b) do { *(LAS bf16x8*)(V_lds + (b) * SHM_V + vst0) = vs0; *(LAS bf16x8*)(V_lds + (b) * SHM_V + vst1) = vs1; \
    *(LAS bf16x8*)(K_lds + (b) * SHM_K + kst[0]) = ks0; *(LAS bf16x8*)(K_lds + (b) * SHM_K + kst[1]) = ks1; *(LAS bf16x8*)(K_lds + (b) * SHM_K + kst[2]) = ks2; } while (0)
    const int NT = 4 * qb + 4, jmax = 4 * qb + (wid >> 1);
    const float NEG_INF = -__builtin_inff();
#define BIAS(j) (((j) <= jmax) ? -Mb : NEG_INF)
    f32x16 pA0, pA1, pB0, pB1; bf16x8 pa0, pa1, pa2, pa3;
    SLOAD(0); asm volatile("s_waitcnt vmcnt(0)" ::: "memory"); SWRITE(0); __syncthreads();
    qkt<0, NQR>(pA0, pA1, kb, qr, qlb); partialSM(pA0, pA1, BIAS(0));
    SLOAD(KVB); asm volatile("s_waitcnt vmcnt(0)" ::: "memory"); SWRITE(1); __syncthreads();
    for (int j = 1; j + 1 < NT; j += 2) {
        SBAR(); qkt<1, NQR>(pB0, pB1, kb, qr, qlb);
        finishSM(pA0, pA1, l_reg, pa0, pa1, pa2, pa3); SBAR();
        SLOAD((j + 1) * KVB); SBAR();
        pv_d0(o, vb0, pa0, pa1, pa2, pa3); partialSM(pB0, pB1, BIAS(j));
        __syncthreads(); asm volatile("s_waitcnt vmcnt(0)" ::: "memory"); SWRITE(0);
        __syncthreads();
        SBAR(); qkt<0, NQR>(pA0, pA1, kb, qr, qlb);
        finishSM(pB0, pB1, l_reg, pa0, pa1, pa2, pa3); SBAR();
        SLOAD((j + 2) * KVB); SBAR();
        pv_d0(o, vb0 + SHM_V, pa0, pa1, pa2, pa3); partialSM(pA0, pA1, BIAS(j + 1));
        __syncthreads(); asm volatile("s_waitcnt vmcnt(0)" ::: "memory"); SWRITE(1);
        __syncthreads();
    }
    SBAR(); qkt<1, NQR>(pB0, pB1, kb, qr, qlb);
    finishSM(pA0, pA1, l_reg, pa0, pa1, pa2, pa3); SBAR();
    pv_d0(o, vb0, pa0, pa1, pa2, pa3); partialSM(pB0, pB1, BIAS(NT - 1));
    finishSM(pB0, pB1, l_reg, pa0, pa1, pa2, pa3); SBAR();
    pv_d0(o, vb0 + SHM_V, pa0, pa1, pa2, pa3);
    __syncthreads();
    const int lane2 = fresh_lane(), r32b = lane2 & 31, hib = lane2 >> 5, wid2 = wid;
    LAS float* li2 = (LAS float*)(lds + OFF_WS) + wid2 * 64;
    if (hib == 0) li2[r32b] = l_reg; LDS_WAIT();
    LAS char* ost = lds + OFF_OST + wid2 * (32 * OPITCH) + hib * (4 * OPITCH) + r32b * 2;
#pragma unroll
    for (int r = 0; r < 16; ++r) { const int orc = (r & 3) + 8 * (r >> 2); const float rl = __builtin_amdgcn_rcpf(li2[orc + 4 * hib]);
#pragma unroll
        for (int d0 = 0; d0 < 4; ++d0) *(LAS bf16_t*)(ost + orc * OPITCH + d0 * 64) = (bf16_t)f2bf(o[d0][r] * rl); }
    LDS_WAIT();
    bf16_t* Ow = Ob + (size_t)(wid2 * 32 + (lane2 >> 4)) * DM + (lane2 & 15) * 8;
    const LAS char* ord = lds + OFF_OST + wid2 * (32 * OPITCH) + (lane2 >> 4) * OPITCH + (lane2 & 15) * 16;
#pragma unroll
    for (int i = 0; i < 8; ++i) { const u32x4 w = *(const LAS u32x4*)(ord + i * 4 * OPITCH); *(u32x4*)(Ow + (size_t)(i * 4) * DM) = w; }
    __syncthreads();
#undef SLOAD
#undef SWRITE
#undef BIAS
}
#undef KSWZ
}
__device__ __forceinline__ void p4_attention(const Args& a, const Frame& F) {
    FRAME_IDS(F);
    const bf16_t* Qn = (const bf16_t*)(F.ws + WS_QN); const bf16_t* Kn = (const bf16_t*)(F.ws + WS_KN); const bf16_t* Vn = (const bf16_t*)(F.ws + WS_VN);
    bf16_t* O = (bf16_t*)(F.ws + WS_O);
    const float Mb = attn_bound(a, F_lane);
    for (int id = F.bx; id < NB * NH * 4; id += F.G) { const int x = id & 7, idx = id >> 3, bh = x + 8 * (idx >> 2), pr = idx & 3, b = bh >> 4, h = bh & 15;
        const bf16_t* Kh = Kn + (size_t)bh * SEQ * DQK; const bf16_t* Vh = Vn + (size_t)bh * SEQ * DV;
#pragma unroll 1
        for (int w = 0; w < 2; ++w) { const int qb = w ? pr : 7 - pr;
            at::attn_qblock(Qn + ((size_t)bh * SEQ + qb * 256) * DQK, Kh, Vh, O + ((size_t)(b * SEQ + qb * 256)) * DM + h * DV, qb, Mb, (LAS char*)F.lds, F.wave); }
    }
}

__device__ __forceinline__ void p8_norm2_router(const Args& a, const Frame& F, const float* x1) {
    FRAME_IDS(F);
    bf16_t* H2 = (bf16_t*)(F.ws + WS_H2); int* topi = (int*)(F.ws + WS_TOPI); float* topw = (float*)(F.ws + WS_TOPW);
    const float* wrp = (const float*)(F.ws + WS_SMALL + SM_WRP); const float* g2 = a.in[I_N2G];
    const int lane = F_lane, wave = F.wave, tid = F_tid, i = lane & 31, kk = lane >> 5;
    LAS uchar* xs = F.lds + wave * 8704;
    LAS float* part = (LAS float*)(F.lds + 69632);
    LAS float* ssqp = (LAS float*)(F.lds + 69632 + 33792);
    LAS float* logit = ssqp + 256;
    LAS float* rstdl = logit + 32 * 33;
    for (int tile = F.bx; tile < TT / 32; tile += F.G) {
        const int t0 = tile * 32;
        f32x16 acc = {}; float ssq = 0.f;
        for (int ch = 0; ch < 4; ++ch) { const int k0 = wave * 256 + ch * 64;
            f32x4 v[8];
#pragma unroll
            for (int j = 0; j < 8; ++j) v[j] = *(const f32x4*)(x1 + (size_t)(t0 + 4 * j + (lane >> 4)) * DM + k0 + (lane & 15) * 4);
#pragma unroll
            for (int j = 0; j < 8; ++j) *(LAS f32x4*)(xs + (4 * j + (lane >> 4)) * 272 + (lane & 15) * 16) = v[j];
            LDS_WAIT(); asm volatile("" ::: "memory");
            const float* wp = wrp + (size_t)(k0 + kk * 32) * NE + i;
#pragma unroll
            for (int s4 = 0; s4 < 8; ++s4) { const f32x4 xv = *(const LAS f32x4*)(xs + i * 272 + kk * 128 + s4 * 16);
#pragma unroll
                for (int q = 0; q < 4; ++q) { const float b = wp[(s4 * 4 + q) * NE]; acc = __builtin_amdgcn_mfma_f32_32x32x2f32(xv[q], b, acc, 0, 0, 0); ssq += xv[q] * xv[q]; } }
            LDS_WAIT(); asm volatile("" ::: "memory");
        }
#pragma unroll
        for (int r = 0; r < 16; ++r) part[(wave * 32 + (r & 3) + 8 * (r >> 2) + 4 * kk) * 33 + i] = acc[r];
        ssq += __shfl_xor(ssq, 32);
        if (kk == 0) ssqp[wave * 32 + i] = ssq;
        __syncthreads();
        { const int row = tid >> 4, e0 = (tid & 15) * 2; float s0 = 0.f, s1 = 0.f;
#pragma unroll
          for (int w = 0; w < 8; ++w) { s0 += part[(w * 32 + row) * 33 + e0]; s1 += part[(w * 32 + row) * 33 + e0 + 1]; }
          logit[row * 33 + e0] = s0; logit[row * 33 + e0 + 1] = s1;
          if (tid < 32) { float q = 0.f;
#pragma unroll
              for (int w = 0; w < 8; ++w) q += ssqp[w * 32 + tid];
              rstdl[tid] = 1.0f / sqrtf(q * (1.0f / DM) + EPS); } }
        __syncthreads();
        if (tid < 32) { const float rs = rstdl[tid]; float lg[32];
#pragma unroll
            for (int e = 0; e < 32; ++e) lg[e] = logit[tid * 33 + e] * rs + a.in[I_BR][e];
            int bi[4]; float bv[4];
#pragma unroll
            for (int k = 0; k < 4; ++k) { float m = -3.0e38f; int mi = 0;
#pragma unroll
                for (int e = 0; e < 32; ++e) { const bool used = (k > 0 && bi[0] == e) || (k > 1 && bi[1] == e) || (k > 2 && bi[2] == e); if (!used && lg[e] > m) { m = lg[e]; mi = e; } }
                bi[k] = mi; bv[k] = m; }
            const float e1 = __expf(bv[1] - bv[0]), e2 = __expf(bv[2] - bv[0]), e3 = __expf(bv[3] - bv[0]); const float rsum = 1.0f / (1.0f + e1 + e2 + e3);
            const int t = t0 + tid;
            *(int4*)(topi + 4 * t) = make_int4(bi[0], bi[1], bi[2], bi[3]); *(float4*)(topw + 4 * t) = make_float4(rsum, e1 * rsum, e2 * rsum, e3 * rsum); }
#pragma unroll 4
        for (int it = 0; it < 16; ++it) { const int idx = it * NTHREADS + tid, row = idx >> 8, c8 = (idx & 255) * 8; const float rs = rstdl[row];
            const f32x4 x0 = *(const f32x4*)(x1 + (size_t)(t0 + row) * DM + c8), x1v = *(const f32x4*)(x1 + (size_t)(t0 + row) * DM + c8 + 4);
            const f32x4 g0 = *(const f32x4*)(g2 + c8), g1 = *(const f32x4*)(g2 + c8 + 4);
#if MK_FP8_MOE
            const float rs4 = rs * FP8_ASCALE; u32x2 o; o.x = pk4_fp8(x0.x * rs4 * g0.x, x0.y * rs4 * g0.y, x0.z * rs4 * g0.z, x0.w * rs4 * g0.w); o.y = pk4_fp8(x1v.x * rs4 * g1.x, x1v.y * rs4 * g1.y, x1v.z * rs4 * g1.z, x1v.w * rs4 * g1.w);
            *(u32x2*)((uchar*)H2 + (size_t)(t0 + row) * DM + c8) = o; }
#else
            u32x4 o; o.x = pk2(x0.x * rs * g0.x, x0.y * rs * g0.y); o.y = pk2(x0.z * rs * g0.z, x0.w * rs * g0.w); o.z = pk2(x1v.x * rs * g1.x, x1v.y * rs * g1.y); o.w = pk2(x1v.z * rs * g1.z, x1v.w * rs * g1.w);
            *(u32x4*)(H2 + (size_t)(t0 + row) * DM + c8) = o; }
#endif
        __syncthreads();
    }
}

__device__ __forceinline__ void p9_routing(const Args& a, const Frame& F) {
    FRAME_IDS(F);
    const int* topi = (const int*)(F.ws + WS_TOPI); int* tpos = (int*)(F.ws + WS_TPOS); int* list = (int*)(F.ws + WS_LIST); int* counts = (int*)(F.ws + WS_SMALL + SM_COUNTS);
    LAS int* wtot = (LAS int*)F.lds;
    for (int e = F.bx; e < NE; e += F.G) {
        __syncthreads();
        const int t0 = F.wave * (TT / NWAVES);
        int cnt = 0;
        for (int i = 0; i < TT / NWAVES / 64; ++i) { const int4 ti = *(const int4*)(topi + 4 * (t0 + i * 64 + F_lane));
            const bool hit = (ti.x == e) | (ti.y == e) | (ti.z == e) | (ti.w == e); cnt += __popcll(__ballot(hit)); }
        if (F_lane == 0) wtot[F.wave] = cnt;
        __syncthreads();
        int base = 0, total = 0;
        for (int w = 0; w < NWAVES; ++w) { const int c = wtot[w]; if (w < F.wave) base += c; total += c; }
        for (int i = 0; i < TT / NWAVES / 64; ++i) { const int t = t0 + i * 64 + F_lane; const int4 ti = *(const int4*)(topi + 4 * t);
            const int k = (ti.x == e) ? 0 : (ti.y == e) ? 1 : (ti.z == e) ? 2 : (ti.w == e) ? 3 : -1;
            const unsigned long long bal = __ballot(k >= 0); const int pos = base + __popcll(bal & ((1ull << F_lane) - 1ull));
            if (k >= 0) { list[(size_t)e * TT + pos] = t; tpos[4 * t + k] = pos; }
            base += __popcll(bal); }
        for (int q = total + F_tid; q < ((total + 255) & ~255); q += NTHREADS) list[(size_t)e * TT + q] = 0;
        if (F_tid == 0) counts[e] = total;
    }
}
__device__ __forceinline__ void moe_tables(const Frame& F, LAS int* tab) {
    FRAME_IDS(F);
    const int* counts = (const int*)(F.ws + WS_SMALL + SM_COUNTS);
    __syncthreads();
    if (F_tid == 0) { int pre = 0; for (int e = 0; e < NE; ++e) { const int c = counts[e]; tab[e] = c; const int nt = (c + 255) >> 8; tab[32 + e] = nt; tab[64 + e] = pre; tab[128 + e] = nt > 0 ? ((1 << 20) + nt - 1) / nt : 0; pre += nt; } tab[96] = pre; }
    __syncthreads();
}

__device__ __forceinline__ void p10_permute(const Args& a, const Frame& F, const LAS int* tab) {
    FRAME_IDS(F);
    constexpr size_t ROWB = MK_FP8_MOE ? DM : 2 * DM;
    const uchar* H2 = F.ws + WS_H2; uchar* XP = F.ws + WS_XPERM; const int* list = (const int*)(F.ws + WS_LIST);
    const int ntiles = tab[96];
    for (int tile = F.bx; tile < ntiles; tile += F.G) {
        int e = 0;
#pragma unroll 1
        for (int q = 1; q < NE; ++q) if (tab[64 + q] <= tile) e = q;
        const int p0 = (tile - tab[64 + e]) * 256;
        for (int r0 = F.wave * 32; r0 < F.wave * 32 + 32; r0 += 8) { int tok[8]; u32x4 v[8][ROWB / 1024];
#pragma unroll
            for (int q = 0; q < 8; ++q) tok[q] = list[(size_t)e * TT + p0 + r0 + q];
#pragma unroll
            for (int q = 0; q < 8; ++q)
#pragma unroll
                for (int c = 0; c < (int)(ROWB / 1024); ++c) v[q][c] = *(const u32x4*)(H2 + (size_t)tok[q] * ROWB + c * 1024 + F_lane * 16);
#pragma unroll
            for (int q = 0; q < 8; ++q)
#pragma unroll
                for (int c = 0; c < (int)(ROWB / 1024); ++c) *(u32x4*)(XP + ((size_t)tile * 256 + r0 + q) * ROWB + c * 1024 + F_lane * 16) = v[q][c]; }
    }
}

__device__ __forceinline__ void p12_combine(const Args& a, const Frame& F, float* out, const LAS int* tab) {
    FRAME_IDS(F);
    const bf16_t* ys = (const bf16_t*)(F.ws + WS_YSLOT); const int* topi = (const int*)(F.ws + WS_TOPI); const float* topw = (const float*)(F.ws + WS_TOPW); const int* tpos = (const int*)(F.ws + WS_TPOS);
    const int lane = F_lane, gw = F.bx * NWAVES + F.wave, NGW = F.G * NWAVES;
    for (int t = gw; t < TT; t += NGW) {
        const int4 ti = *(const int4*)(topi + 4 * t), tp = *(const int4*)(tpos + 4 * t); const float4 tw = *(const float4*)(topw + 4 * t);
        const bf16_t* r0 = ys + ((size_t)tab[64 + ti.x] * 256 + tp.x) * DM; const bf16_t* r1 = ys + ((size_t)tab[64 + ti.y] * 256 + tp.y) * DM;
        const bf16_t* r2 = ys + ((size_t)tab[64 + ti.z] * 256 + tp.z) * DM; const bf16_t* r3 = ys + ((size_t)tab[64 + ti.w] * 256 + tp.w) * DM;
        float* orow = out + (size_t)t * DM;
#pragma unroll
        for (int j = 0; j < 4; ++j) { const int c = j * 512 + lane * 8;
            const u32x4 a0 = *(const u32x4*)(r0 + c), a1 = *(const u32x4*)(r1 + c), a2 = *(const u32x4*)(r2 + c), a3 = *(const u32x4*)(r3 + c);
            f32x4 x0 = *(const f32x4*)(orow + c), x1 = *(const f32x4*)(orow + c + 4);
#pragma unroll
            for (int q = 0; q < 2; ++q) {
                x0[2 * q] += tw.x * bflo(a0[q]) + tw.y * bflo(a1[q]) + tw.z * bflo(a2[q]) + tw.w * bflo(a3[q]);
                x0[2 * q + 1] += tw.x * bfhi(a0[q]) + tw.y * bfhi(a1[q]) + tw.z * bfhi(a2[q]) + tw.w * bfhi(a3[q]);
                x1[2 * q] += tw.x * bflo(a0[2 + q]) + tw.y * bflo(a1[2 + q]) + tw.z * bflo(a2[2 + q]) + tw.w * bflo(a3[2 + q]);
                x1[2 * q + 1] += tw.x * bfhi(a0[2 + q]) + tw.y * bfhi(a1[2 + q]) + tw.z * bfhi(a2[2 + q]) + tw.w * bfhi(a3[2 + q]); }
            *(f32x4*)(orow + c) = x0; *(f32x4*)(orow + c + 4) = x1; }
    }
}

constexpr int NPHASE = 14;
__global__ void __launch_bounds__(NTHREADS, 2) mk_fwd(Args a) {
    extern __shared__ __attribute__((aligned(16))) uchar lds_raw[];
    Frame F; F.lds = (LAS uchar*)lds_raw; F.ws = a.ws; F.wave = __builtin_amdgcn_readfirstlane(threadIdx.x >> 6); F.G = gridDim.x; F.bx = blockIdx.x;
    FRAME_IDS(F);
    volatile LAS unsigned* MISC = (volatile LAS unsigned*)(F.lds + MISC_OFF);
    LAS int* tab = (LAS int*)(F.lds + LDSCTL_OFF + 512);
    for (int u = F_tid; u < (LDS_BYTES - LDSCTL_OFF) / 4; u += NTHREADS) ((LAS unsigned*)(F.lds + LDSCTL_OFF))[u] = 0u;
    __syncthreads();
    XcdBarrier bar; bar.bar = (unsigned*)(a.ws + WS_CTL) + CW_BAR; bar.x = 0; bar.st = nullptr; bar.wave = F.wave;
    const int lo = a.ph_lo, hi = a.ph_hi;
    if (hi - lo > 1) bar = xcd_barrier_post((unsigned*)(a.ws + WS_CTL) + CW_BAR, MISC + 8, F.wave);
#ifndef MK_PHASE_MASK
#define MK_PHASE_MASK 0xffff
#endif
#define IN(k) (((MK_PHASE_MASK >> (k)) & 1) && lo <= (k) && (k) < hi)
#ifdef MK_PROBE_LO
    volatile LAS unsigned long long* pr_t = (volatile LAS unsigned long long*)(F.lds + LDSCTL_OFF + 64);
#define PROBE_AT(k) do { if ((k) == MK_PROBE_LO && F.wave == 0 && fresh_lane() == 0) pr_t[0] = __builtin_amdgcn_s_memrealtime(); if ((k) == MK_PROBE_HI + 1 && F.wave == 0 && fresh_lane() == 0) pr_t[1] = __builtin_amdgcn_s_memrealtime(); } while (0)
#else
#define PROBE_AT(k) do { } while (0)
#endif
#define SEAM(k) do { if (IN(k) && IN((k) + 1)) xcd_barrier(bar); } while (0)
    LAS uchar* ring = F.lds;
    uchar* ws = a.ws;
    const int G = F.G, bx = F.bx;

    PROBE_AT(0);
    if (IN(0)) { p0_prologue(a, F); } SEAM(0); PROBE_AT(1);

    if (IN(1)) {
        gm::ProbDense P; P.init((const bf16_t*)(ws + WS_H), DM, (const bf16_t*)(ws + WS_WIN), DM, DM, TT, NPROJ, G, bx);
        EpiInProj E{(bf16_t*)(ws + WS_PROJ), (bf16_t*)(ws + WS_APACK), a.in[I_BG]};
        gm::gemm_phase<gm::ProbDense, EpiInProj, false>(ring, P, E, F.wave);
    } SEAM(1); PROBE_AT(2);

    if (IN(2)) {
        { gm::ProbDense P; P.init((const bf16_t*)(ws + WS_PROJ) + C_QLAT, NPROJ, (const bf16_t*)(ws + WS_WUQ), QLORA, QLORA, TT, NH * DQK, G, bx);
          EpiStoreBf16 E{(bf16_t*)(ws + WS_QRAW), NH * DQK}; gm::gemm_phase<gm::ProbDense, EpiStoreBf16, false>(ring, P, E, F.wave); }
        { gm::ProbDense P; P.init((const bf16_t*)(ws + WS_PROJ) + C_KVLAT, NPROJ, (const bf16_t*)(ws + WS_WUKV), KVLORA, KVLORA, TT, NH * 256, G, bx);
          EpiStoreBf16 E{(bf16_t*)(ws + WS_KVRAW), NH * 256}; gm::gemm_phase<gm::ProbDense, EpiStoreBf16, false>(ring, P, E, F.wave); }
#if MK_FAST_S5
        { ProbS5 P{(const bf16_t*)(ws + WS_APACK), (const bf16_t*)(ws + WS_WS5), APK, 256, 4, G, bx};
          EpiS5State E{(float*)(ws + WS_SCH)}; gm::gemm_phase<ProbS5, EpiS5State, false>(ring, P, E, F.wave); }
#endif
    } SEAM(2); PROBE_AT(3);

    if (IN(3)) {
        p3_prep(a, F);
#if MK_FAST_S5
        p3_scan(a, F);
#endif
    } SEAM(3); PROBE_AT(4);

    if (IN(4)) {
#if MK_FAST_S5
        { ProbS5 P{(const bf16_t*)(ws + WS_APACK), (const bf16_t*)(ws + WS_TWC), APK, APK, 6, G, bx};
          EpiS5Out E{(bf16_t*)(ws + WS_GACT)}; gm::gemm_phase<ProbS5, EpiS5Out, false>(ring, P, E, F.wave); }
#else
        s5_reference(a, F);
#endif
#if MK_FAST_ATTN
        p4_attention(a, F);
#else
        attn_reference(a, F);
#endif
    } SEAM(4); PROBE_AT(5);

    if (IN(5)) {
        { gm::ProbDense P; P.init((const bf16_t*)(ws + WS_GACT), S5W, (const bf16_t*)(ws + WS_WGLU), S5W, S5W, TT, S5W, G, bx);
          EpiSide<0> E{(bf16_t*)(ws + WS_Y2), S5W, (const bf16_t*)(ws + WS_GACT), S5W, nullptr, 0}; gm::gemm_phase<gm::ProbDense, EpiSide<0>, false>(ring, P, E, F.wave); }
        { gm::ProbDense P; P.init((const bf16_t*)(ws + WS_O), DM, (const bf16_t*)(ws + WS_WOMLA), DM, DM, TT, DM, G, bx);
          EpiSide<1> E{(bf16_t*)(ws + WS_MA), DM, (const bf16_t*)(ws + WS_PROJ) + C_GA, NPROJ, nullptr, 0}; gm::gemm_phase<gm::ProbDense, EpiSide<1>, false>(ring, P, E, F.wave); }
    } SEAM(5); PROBE_AT(6);

    if (IN(6)) {
        gm::ProbDense P; P.init((const bf16_t*)(ws + WS_Y2), S5W, (const bf16_t*)(ws + WS_WOS5), S5W, S5W, TT, DM, G, bx);
        EpiSide<2> E{(bf16_t*)(ws + WS_M), DM, (const bf16_t*)(ws + WS_PROJ) + C_GB, NPROJ, (const bf16_t*)(ws + WS_MA), DM}; gm::gemm_phase<gm::ProbDense, EpiSide<2>, false>(ring, P, E, F.wave);
    } SEAM(6); PROBE_AT(7);

    if (IN(7)) {
        gm::ProbDense P; P.init((const bf16_t*)(ws + WS_M), DM, (const bf16_t*)(ws + WS_WOUT), DM, DM, TT, DM, G, bx);
        EpiResidF32 E{a.in[I_X], a.out}; gm::gemm_phase<gm::ProbDense, EpiResidF32, false>(ring, P, E, F.wave);
    } SEAM(7); PROBE_AT(8);

    if (IN(8)) { p8_norm2_router(a, F, a.out); } SEAM(8); PROBE_AT(9);
    if (IN(9)) { p9_routing(a, F); } SEAM(9); PROBE_AT(10);

    if (IN(10) || IN(11) || IN(12) || IN(13)) moe_tables(F, tab);
    const int xl = bx & 7, rk = bx >> 3, nrk = (G - xl + 7) >> 3;
    if (IN(10)) { p10_permute(a, F, tab); } SEAM(10); PROBE_AT(11);
    if (IN(11)) {
        ProbMoE P{(const bf16_t*)(ws + WS_XPERM), (const bf16_t*)(ws + WS_W1), DM, DM, MK_FP8_MOE ? DM / 128 : DM / 64, 16, (size_t)4096 * DM, xl, rk, nrk}; P.load(tab);
        EpiSwiglu E{(bf16_t*)(ws + WS_HACT), a.in[I_BGATE], a.in[I_BUP], tab}; gm::gemm_phase<ProbMoE, EpiSwiglu, false, MK_FP8_MOE != 0>(ring, P, E, F.wave);
    } SEAM(11); PROBE_AT(12);
    if (IN(12)) {
        ProbMoE P{(const bf16_t*)(ws + WS_HACT), (const bf16_t*)(ws + WS_W2), DFF, DFF, MK_FP8_MOE ? DFF / 128 : DFF / 64, 8, (size_t)DM * DFF, xl, rk, nrk}; P.load(tab);
        EpiDown E{(bf16_t*)(ws + WS_YSLOT), a.in[I_BDOWN], tab}; gm::gemm_phase<ProbMoE, EpiDown, false, MK_FP8_MOE != 0>(ring, P, E, F.wave);
    } SEAM(12); PROBE_AT(13);
    if (IN(13)) { p12_combine(a, F, a.out, tab); }
    PROBE_AT(14);
#ifdef MK_PROBE_LO
    if (blockIdx.x == 0 && F.wave == 0 && fresh_lane() == 0) { const unsigned long long dt = (pr_t[1] - pr_t[0]) * MK_PROBE_X, te = __builtin_amdgcn_s_memrealtime();
        while (__builtin_amdgcn_s_memrealtime() - te < dt) __builtin_amdgcn_s_sleep(32); }
#endif
#undef IN
#undef SEAM
}

extern "C" void kernel_launch(void* const* d_in, const int* in_sizes, int n_in, void* d_out, int out_size, void* d_ws, size_t ws_size, hipStream_t stream) {
    static int grid = 0;
    if (grid == 0) {
        if (n_in != 32 || in_sizes[0] != TT * DM || out_size != TT * DM || ws_size < WS_END) {
            fprintf(stderr, "kernel_launch: shape mismatch: n_in %d in0 %d out %d ws %zu (need %zu); nothing launched\n", n_in, n_in > 0 ? in_sizes[0] : -1, out_size, ws_size, (size_t)WS_END); grid = -1; return; }
        int dev = 0, cus = 0, per_cu = 0;
        if (hipGetDevice(&dev) != hipSuccess || hipDeviceGetAttribute(&cus, hipDeviceAttributeMultiprocessorCount, dev) != hipSuccess) { fprintf(stderr, "kernel_launch: device query failed\n"); grid = -1; return; }
        if (hipFuncSetAttribute((const void*)mk_fwd, hipFuncAttributeMaxDynamicSharedMemorySize, LDS_BYTES) != hipSuccess) { fprintf(stderr, "kernel_launch: hipFuncSetAttribute failed\n"); grid = -1; return; }
        if (hipOccupancyMaxActiveBlocksPerMultiprocessor(&per_cu, (const void*)mk_fwd, NTHREADS, LDS_BYTES) != hipSuccess || per_cu < 1)
            fprintf(stderr, "kernel_launch: note: occupancy query reports %d workgroups per CU\n", per_cu);
        (void)hipGetLastError();
        grid = cus - (cus % 8);
        if (grid < 8) grid = 8;
    }
    if (grid < 0) return;
    if (hipMemsetAsync((char*)d_ws + WS_CTL, 0, CTL_ZERO_BYTES, stream) != hipSuccess) { fprintf(stderr, "kernel_launch: memset failed\n"); return; }
    Args a{};
    for (int i = 0; i < 32; ++i) a.in[i] = (const float*)d_in[i];
    a.out = (float*)d_out; a.ws = (uchar*)d_ws;
#if MK_ONE_LAUNCH
    a.ph_lo = 0; a.ph_hi = NPHASE;
    hipLaunchKernelGGL(mk_fwd, dim3(grid), dim3(NTHREADS), LDS_BYTES, stream, a);
#else
    for (int p = 0; p < NPHASE; ++p) { a.ph_lo = p; a.ph_hi = p + 1; hipLaunchKernelGGL(mk_fwd, dim3(grid), dim3(NTHREADS), LDS_BYTES, stream, a); }
#endif
    const hipError_t le = hipPeekAtLastError();
    if (le != hipSuccess) fprintf(stderr, "kernel_launch: launch failed: %s\n", hipGetErrorName(le));
}
```

```cpp
#include <hip/hip_runtime.h>
#include <cstdio>
#include <cstdint>

#ifndef MK_ONE_LAUNCH
#define MK_ONE_LAUNCH 1
#endif
#ifndef MK_FAST_GEMM
#define MK_FAST_GEMM 1
#endif
#ifndef MK_FAST_ATTN
#define MK_FAST_ATTN 1
#endif
#ifndef MK_FAST_S5
#define MK_FAST_S5 1
#endif

#ifndef MK_FP8_MOE
#define MK_FP8_MOE 1
#endif
#define LAS __attribute__((address_space(3)))
#define GAS __attribute__((address_space(1)))
typedef unsigned short bf16_t;
typedef short bf16x8 __attribute__((ext_vector_type(8)));
typedef short s16x4 __attribute__((ext_vector_type(4)));
typedef float f32x2 __attribute__((ext_vector_type(2)));
typedef float f32x4 __attribute__((ext_vector_type(4)));
typedef float f32x16 __attribute__((ext_vector_type(16)));
typedef unsigned u32x2 __attribute__((ext_vector_type(2)));
typedef unsigned u32x4 __attribute__((ext_vector_type(4)));
typedef unsigned char uchar;
typedef int v4i __attribute__((ext_vector_type(4)));
typedef int v8i __attribute__((ext_vector_type(8)));
constexpr float FP8_ASCALE = 4.0f, FP8_WSCALE = 64.0f;
__device__ __forceinline__ unsigned pk4_fp8(float a, float b, float c, float d) { int w = __builtin_amdgcn_cvt_pk_fp8_f32(a, b, 0, false); w = __builtin_amdgcn_cvt_pk_fp8_f32(c, d, w, true); return (unsigned)w; }

constexpr int NB = 8, SEQ = 2048, TT = NB * SEQ, DM = 2048;
constexpr int NH = 16, DNOPE = 128, DROPE = 64, DQK = 192, DV = 128, QLORA = 512, KVLORA = 256;
constexpr int S5W = 1024, S5G = 64, S5C = 16, S5P = 64, S5L = 16;
constexpr int NE = 32, TOPK = 4, DFF = 2048;
constexpr int IN_PROJ = QLORA + KVLORA + DROPE + S5W + 2 * DM;
constexpr int NPROJ = 6144;
constexpr int C_QLAT = 0, C_KVLAT = 512, C_U = 768, C_GA = 1792, C_GB = 3840, C_KR = 5888;
constexpr float EPS = 1e-6f;
constexpr int MAXSLOT_TILES = (TT * TOPK) / 256 + NE;
constexpr int MAXSLOTS = MAXSLOT_TILES * 256;
constexpr int NCHUNK = TT / S5L;
constexpr int APK = 384;

constexpr size_t MiB = 1u << 20;
constexpr size_t WS_CTL = 0, CTL_ZERO_BYTES = 1 * MiB;
constexpr size_t WS_WIN = 1 * MiB;
constexpr size_t WS_WUQ = WS_WIN + 24 * MiB;
constexpr size_t WS_WUKV = WS_WUQ + 3 * MiB;
constexpr size_t WS_WOMLA = WS_WUKV + 2 * MiB;
constexpr size_t WS_WGLU = WS_WOMLA + 8 * MiB;
constexpr size_t WS_WOS5 = WS_WGLU + 2 * MiB;
constexpr size_t WS_WOUT = WS_WOS5 + 4 * MiB;
constexpr size_t WS_TWC = WS_WOUT + 8 * MiB;
constexpr size_t WS_WS5 = WS_TWC + 12 * MiB;
constexpr size_t WS_ROPE = WS_WS5 + 8 * MiB;
constexpr size_t WS_SMALL = WS_ROPE + 4 * MiB;
constexpr size_t WS_W1 = WS_SMALL + 1 * MiB;
constexpr size_t WS_W2 = WS_W1 + 512 * MiB;
constexpr size_t WS_ACT = WS_W2 + 256 * MiB;
constexpr size_t WS_H = WS_ACT;
constexpr size_t WS_PROJ = WS_H + 64 * MiB;
constexpr size_t WS_APACK = WS_PROJ + 192 * MiB;
constexpr size_t WS_SCH = WS_APACK + 48 * MiB;
constexpr size_t WS_QRAW = WS_SCH + 32 * MiB;
constexpr size_t WS_KVRAW = WS_QRAW + 96 * MiB;
constexpr size_t WS_QN = WS_KVRAW + 128 * MiB;
constexpr size_t WS_KN = WS_QN + 96 * MiB;
constexpr size_t WS_VN = WS_KN + 96 * MiB;
constexpr size_t WS_O = WS_VN + 64 * MiB;
constexpr size_t WS_GACT = WS_O + 64 * MiB;
constexpr size_t WS_Y2 = WS_GACT + 32 * MiB;
constexpr size_t WS_MA = WS_Y2 + 32 * MiB;
constexpr size_t WS_M = WS_MA + 64 * MiB;
constexpr size_t WS_SSQP = WS_M + 64 * MiB;
constexpr size_t WS_ENDA = WS_SSQP + 1 * MiB;
constexpr size_t WS_H2 = WS_ACT;
constexpr size_t WS_HACT = WS_H2 + 64 * MiB;
constexpr size_t WS_YSLOT = WS_HACT + 288 * MiB;
constexpr size_t WS_TOPI = WS_YSLOT + 288 * MiB;
constexpr size_t WS_TOPW = WS_TOPI + 1 * MiB;
constexpr size_t WS_TPOS = WS_TOPW + 1 * MiB;
constexpr size_t WS_LIST = WS_TPOS + 1 * MiB;
constexpr size_t WS_XPERM = WS_ACT + 704 * MiB;
constexpr size_t WS_ENDB = WS_XPERM + 288 * MiB;
constexpr size_t WS_END = WS_ENDA > WS_ENDB ? WS_ENDA : WS_ENDB;
constexpr size_t SM_A16 = 0;
constexpr size_t SM_COUNTS = 64 * 1024;
constexpr size_t SM_WRP = 128 * 1024;
constexpr int CW_BAR = 4096;

constexpr int RING_BYTES = 131072;
constexpr int LDS_BYTES = 163840;
constexpr int LDSCTL_OFF = LDS_BYTES - 4096;
constexpr int MISC_OFF = LDSCTL_OFF;
constexpr int GTAB_OFF = LDSCTL_OFF + 2048;
constexpr int NWAVES = 8, NTHREADS = 512;

#define LDS_WAIT() asm volatile("s_waitcnt lgkmcnt(0)" ::: "memory")
#define VM_WAIT() asm volatile("s_waitcnt vmcnt(0)" ::: "memory")
#define SBAR() __builtin_amdgcn_sched_barrier(0)

__device__ __forceinline__ unsigned f2bf(float f) { unsigned u = __builtin_bit_cast(unsigned, f); return (u + 0x7fffu + ((u >> 16) & 1u)) >> 16; }
__device__ __forceinline__ unsigned pk2(float lo, float hi) { return f2bf(lo) | (f2bf(hi) << 16); }
__device__ __forceinline__ float bf2f(unsigned b) { return __builtin_bit_cast(float, b << 16); }
__device__ __forceinline__ float bflo(unsigned w) { return __builtin_bit_cast(float, w << 16); }
__device__ __forceinline__ float bfhi(unsigned w) { return __builtin_bit_cast(float, w & 0xffff0000u); }
__device__ __forceinline__ unsigned cvt_pk_bf16(float lo, float hi) { unsigned r; asm volatile("v_cvt_pk_bf16_f32 %0, %1, %2" : "=v"(r) : "v"(lo), "v"(hi)); return r; }
__device__ __forceinline__ float sigmoidf_(float x) { return __builtin_amdgcn_rcpf(1.0f + __builtin_amdgcn_exp2f(-1.4426950408889634f * x)); }
__device__ __forceinline__ float gelu_tanh(float x) {
    const float u = 0.7978845608028654f * (x + 0.044715f * x * x * x);
    const float e = __builtin_amdgcn_exp2f(2.8853900817779268f * u);
    const float th = 1.0f - 2.0f * __builtin_amdgcn_rcpf(e + 1.0f);
    return 0.5f * x * (1.0f + th);
}
__device__ __forceinline__ int fresh_lane() { int z = 0; asm volatile("" : "+s"(z)); return (int)__builtin_amdgcn_mbcnt_hi(~0u, __builtin_amdgcn_mbcnt_lo(~0u, (unsigned)z)); }
__device__ __forceinline__ float wave_sum(float v) {
#pragma unroll
    for (int o = 1; o < 64; o <<= 1) v += __shfl_xor(v, o);
    return v;
}

#define XB_TMO      128
#define XB_XCNT(j)  (256  + 64 * (j))
#define XB_XSUB(j)  (1280 + 64 * (j))
#define XB_XGEN(j)  (2304 + 64 * (j))
#define XB_TOP      3328
#define XB_TOPGEN   3392
#define XCD_BAR_WORDS 3456
#define XB_SPIN_CAP (1u << 18)
__device__ __forceinline__ unsigned xb_ld(unsigned* p)              { return __hip_atomic_load(p, __ATOMIC_RELAXED, __HIP_MEMORY_SCOPE_AGENT); }
__device__ __forceinline__ unsigned xb_add(unsigned* p, unsigned v) { return __hip_atomic_fetch_add(p, v, __ATOMIC_RELAXED, __HIP_MEMORY_SCOPE_AGENT); }
__device__ __forceinline__ unsigned xb_xcc_id() { return (unsigned)__builtin_amdgcn_s_getreg((3 << 11) | 20) & 0xFu; }
#define XB_SPIN(cond, bar) do { unsigned _sp = 0; while (cond) { __builtin_amdgcn_s_sleep(1); \
    if ((++_sp & 255u) == 0u) { if (xb_ld(&(bar)[XB_TMO])) break; if (_sp > XB_SPIN_CAP) { atomicAdd(&(bar)[XB_TMO], 1u); break; } } } } while (0)
struct XcdBarrier { unsigned* bar; unsigned x; volatile LAS unsigned* st; int wave; };
__device__ __forceinline__ XcdBarrier xcd_barrier_post(unsigned* bar, volatile LAS unsigned* st, int wave) {
    XcdBarrier b; b.bar = bar; b.x = xb_xcc_id(); b.st = st; b.wave = wave;
    if (wave == 0 && fresh_lane() == 0) (void)xb_add(&bar[XB_XCNT(b.x)], 1u);
    return b;
}
__device__ __forceinline__ void xcd_barrier_complete(unsigned* bar, unsigned x, unsigned& nloc, unsigned& nx) {
    const unsigned G = gridDim.x * gridDim.y * gridDim.z;
    unsigned sum, cnt, mine, sp = 0u;
    for (;;) {
        sum = 0u; cnt = 0u; mine = 0u;
#pragma unroll
        for (unsigned j = 0; j < 16; ++j) { const unsigned c = xb_ld(&bar[XB_XCNT(j)]); sum += c; cnt += (c > 0u) ? 1u : 0u; mine = (j == x) ? c : mine; }
        if (sum == G) break;
        __builtin_amdgcn_s_sleep(1);
        if ((++sp & 255u) == 0u) { if (xb_ld(&bar[XB_TMO])) break; if (sp > XB_SPIN_CAP) { atomicAdd(&bar[XB_TMO], 1u); break; } }
    }
    nloc = mine > 0u ? mine : 1u; nx = cnt > 0u ? cnt : 1u;
}
__device__ __forceinline__ void xcd_barrier(const XcdBarrier& b) {
    asm volatile("s_waitcnt vmcnt(0)" ::: "memory");
    __syncthreads();
    if (b.wave == 0 && fresh_lane() == 0) {
        unsigned* bar = b.bar;
        __builtin_amdgcn_s_waitcnt(0);
        unsigned nloc = b.st[0], nx = b.st[1];
        if (nloc == 0u) { xcd_barrier_complete(bar, b.x, nloc, nx); b.st[0] = nloc; b.st[1] = nx; }
        const unsigned old = xb_add(&bar[XB_XSUB(b.x)], 1u);
        const unsigned gen = old / nloc;
        if (old + 1u == (gen + 1u) * nloc) {
            __builtin_amdgcn_fence(__ATOMIC_RELEASE, "agent");
            asm volatile("s_waitcnt vmcnt(0)" ::: "memory");
            const unsigned og = xb_add(&bar[XB_TOP], 1u);
            const unsigned tg = og / nx;
            if (og + 1u == (tg + 1u) * nx) xb_add(&bar[XB_TOPGEN], 1u);
            else XB_SPIN(xb_ld(&bar[XB_TOPGEN]) == tg, bar);
            __builtin_amdgcn_fence(__ATOMIC_ACQUIRE, "agent");
            xb_add(&bar[XB_XGEN(b.x)], 1u);
            asm volatile("s_waitcnt vmcnt(0)" ::: "memory");
        } else {
            XB_SPIN(xb_ld(&bar[XB_XGEN(b.x)]) == gen, bar);
            __builtin_amdgcn_fence(__ATOMIC_ACQUIRE, "agent");
            asm volatile("s_waitcnt vmcnt(0)" ::: "memory");
        }
    }
    __syncthreads();
}

namespace gm {
constexpr int BM = 256, BK = 64, HALF = 128, HTB = HALF * BK * 2, STAGE_BYTES = 8 * HTB, NXCD = 8, WGM = 8;
__host__ __device__ __forceinline__ int lds_byte(int r, int c) { const int st = (r >> 4) * 2 + (c >> 5), rr = r & 15, cc = c & 31, ob = rr * 64 + cc * 2; return st * 1024 + (ob ^ (((ob >> 9) & 1) << 5)); }
__host__ __device__ __forceinline__ void stage_rc(int b, int& R, int& C) { const int st = b / 1024, sb = b % 1024, swz = sb ^ (((sb >> 9) & 1) << 5); R = (st >> 1) * 16 + swz / 64; C = (st & 1) * 32 + (swz % 64) / 2; }
__host__ __device__ __forceinline__ int perm32(int rho) { const int n = rho >> 4, i = rho & 15; return 8 * (i >> 2) + 4 * n + (i & 3); }

struct Unit { int pm, pn, g, st; };


struct ProbDense {
    const bf16_t* A; const bf16_t* B; int lda, ldb, nt; int nM, nN, nwg, G, c; const int* list = nullptr; const LAS int* gtab = nullptr;
    __device__ unsigned list_off(const Unit&) const { return 0u; }
    __device__ void init(const bf16_t* A_, int lda_, const bf16_t* B_, int ldb_, int K, int M, int N, int G_, int c_) { A = A_; B = B_; lda = lda_; ldb = ldb_; nt = K / BK; nM = M / BM; nN = N / BM; nwg = nM * nN; G = G_; c = c_; }
    __device__ bool next(int i, Unit& u) const {
        const long L = (long)i * G + c; if (L >= nwg) return false;
        int wgid = (int)L; { const int q = nwg / NXCD, r = nwg % NXCD, xcd = wgid % NXCD, off = wgid / NXCD; wgid = (xcd < r ? xcd * (q + 1) : r * (q + 1) + (xcd - r) * q) + off; }
        const int nig = WGM * nN, gid = wgid / nig, fm = gid * WGM, gsz = (nM - fm) < WGM ? (nM - fm) : WGM;
        u.pm = fm + ((wgid % nig) % gsz); u.pn = (wgid % nig) / gsz; u.g = 0; u.st = 0; return true;
    }
    __device__ size_t a_off(const Unit& u) const { return (size_t)u.pm * BM * lda; }
    __device__ size_t b_off(const Unit& u) const { return (size_t)u.pn * BM * ldb; }
    __device__ unsigned a_row(const Unit&, int) const { return 0u; }
};

#if MK_FAST_GEMM
template <class Prob, class Epi, bool GATHER, bool FP8 = false>
__device__ __forceinline__ void gemm_phase(LAS uchar* lds, const Prob& S, const Epi& E, const int wid  ) {
    constexpr unsigned ESZ = FP8 ? 1u : 2u;
    const int lane = fresh_lane(), tid = wid * 64 + lane, wr = wid >> 2, wc = wid & 3, fr = lane & 15, fq = lane >> 4;
    const int nt = S.nt;
    int Ra[2], Ca[2]; unsigned vB;
    { int R, C; stage_rc(tid * 16, R, C); const int Rb = Epi::PERM ? ((R & ~31) + perm32(R & 31)) : R; Ra[0] = R; Ca[0] = C; Ra[1] = R + 64; Ca[1] = C;
      vB = (unsigned)(Rb * S.ldb) * ESZ + (unsigned)C * 2u; }
    const unsigned dB64 = 64u * (unsigned)S.ldb * ESZ, dA64 = 64u * (unsigned)S.lda * ESZ, dA128 = 2u * dA64;
    constexpr unsigned kstep = BK * 2;
    const unsigned hstepB = (unsigned)HALF * (unsigned)S.ldb * ESZ;
    const unsigned ldsw = (unsigned)wid * 1024u;
    const int aoff = lds_byte(wr * 64 + fr, fq * 8), boff = lds_byte(wc * 32 + fr, fq * 8);
    const __amdgpu_buffer_rsrc_t srdA = __builtin_amdgcn_make_buffer_rsrc((void*)S.A, 0, 0xFFFFFFFF, 0x00020000);
    const __amdgpu_buffer_rsrc_t srdB = __builtin_amdgcn_make_buffer_rsrc((void*)S.B, 0, 0xFFFFFFFF, 0x00020000);
#define G_SA(b, h) (((b) * 2 + (h)) * HTB)
#define G_SB(b, h) ((4 + (b) * 2 + (h)) * HTB)
#define G_STAGE(bufoff, srd, soff, voff) do { _Pragma("unroll") for (int _i = 0; _i < 2; ++_i) \
        __builtin_amdgcn_raw_ptr_buffer_load_lds(srd, (LAS void*)(lds + (bufoff) + ldsw + _i * 8192), 16, (int)(voff)[_i], (int)(soff), 0, 0); } while (0)
#define G_STAGE1(bufoff, srd, soff, v1, d64) do { _Pragma("unroll") for (int _i = 0; _i < 2; ++_i) \
        __builtin_amdgcn_raw_ptr_buffer_load_lds(srd, (LAS void*)(lds + (bufoff) + ldsw + _i * 8192), 16, (int)(v1), (int)((soff) + _i * (d64)), 0, 0); } while (0)
#define G_STAGE_A(bufoff, soff, half, arr0, arr1) do { if constexpr (GATHER) { if (half) G_STAGE(bufoff, srdA, soff, arr1); else G_STAGE(bufoff, srdA, soff, arr0); } \
        else G_STAGE1(bufoff, srdA, (soff) + (half) * dA128, vA, dA64); } while (0)
#define G_LDA(dst, b, h) do { _Pragma("unroll") for (int m = 0; m < 4; ++m) _Pragma("unroll") for (int k = 0; k < 2; ++k) dst[m][k] = *(const LAS bf16x8*)(lds + G_SA(b, h) + aoff + m * 2048 + k * 1024); } while (0)
#define G_LDB(dst, b, h) do { _Pragma("unroll") for (int n = 0; n < 2; ++n) _Pragma("unroll") for (int k = 0; k < 2; ++k) dst[n][k] = *(const LAS bf16x8*)(lds + G_SB(b, h) + boff + n * 2048 + k * 1024); } while (0)
#define G_CAT(x0, x1) __builtin_shufflevector(__builtin_bit_cast(v4i, x0), __builtin_bit_cast(v4i, x1), 0, 1, 2, 3, 4, 5, 6, 7)
#define G_MMA(ai, bj, At, Bt) do { __builtin_amdgcn_s_setprio(1); _Pragma("unroll") for (int m = 0; m < 4; ++m) _Pragma("unroll") for (int n = 0; n < 2; ++n) { \
        if constexpr (FP8) acc[ai][bj][m][n] = __builtin_amdgcn_mfma_scale_f32_16x16x128_f8f6f4(G_CAT(Bt[n][0], Bt[n][1]), G_CAT(At[m][0], At[m][1]), acc[ai][bj][m][n], 0, 0, 0, 0x7f7f7f7f, 0, 0x7f7f7f7f); \
        else { _Pragma("unroll") for (int k = 0; k < 2; ++k) acc[ai][bj][m][n] = __builtin_amdgcn_mfma_f32_16x16x32_bf16(Bt[n][k], At[m][k], acc[ai][bj][m][n], 0, 0, 0); } } \
        __builtin_amdgcn_s_setprio(0); } while (0)
#define G_WAIT_V(n) asm volatile("s_waitcnt vmcnt(" #n ")" ::: "memory")
#define G_WAIT_L(n) asm volatile("s_waitcnt lgkmcnt(" #n ")" ::: "memory")
#define G_BAR __builtin_amdgcn_s_barrier()
#define G_SCHED __builtin_amdgcn_sched_barrier(0)
#define G_UNI(x) ((unsigned)__builtin_amdgcn_readfirstlane((int)(x)))
    Unit cur, nxt; int ui = 0;
    if (!S.next(0, cur)) return;
    unsigned vA0[2], vA1[2];
    unsigned cA = 0u, cB = G_UNI(S.b_off(cur) * ESZ);
    __amdgpu_buffer_rsrc_t srdL = srdA;
    if constexpr (GATHER) srdL = __builtin_amdgcn_make_buffer_rsrc((void*)S.list, 0, 0xFFFFFFFF, 0x00020000);
#define G_IDX(u_) do { if (wid < 4) __builtin_amdgcn_raw_ptr_buffer_load_lds(srdL, (LAS void*)(S.gtab + wid * 64), 4, lane * 4, (int)G_UNI(S.list_off(u_) * 4u) + wid * 256, 0, 0); } while (0)
    const int gR = (int)(uintptr_t)S.gtab + Ra[0] * 4; const unsigned gC = (unsigned)Ca[0] * 2u;
#define G_ROWS(o0, o1) do { const LAS int* _g = (const LAS int*)gR; const unsigned _ls = (unsigned)S.lda * ESZ; \
        o0[0] = (unsigned)_g[0] * _ls + gC; o0[1] = (unsigned)_g[64] * _ls + gC; o1[0] = (unsigned)_g[128] * _ls + gC; o1[1] = (unsigned)_g[192] * _ls + gC; } while (0)
    if constexpr (GATHER) { G_IDX(cur); G_WAIT_V(0); G_BAR; G_ROWS(vA0, vA1); G_WAIT_L(0); G_BAR; }
    else { cA = G_UNI(S.a_off(cur) * ESZ);
#pragma unroll
        for (int i = 0; i < 2; ++i) { vA0[i] = 0u; vA1[i] = 0u; } }
    const unsigned vA = (unsigned)(Ra[0] * S.lda) * ESZ + (unsigned)Ca[0] * 2u;
    G_STAGE1(G_SB(0, 0), srdB, cB, vB, dB64); G_STAGE_A(G_SA(0, 0), cA, 0, vA0, vA1); G_STAGE1(G_SB(0, 1), srdB, cB + hstepB, vB, dB64); G_STAGE_A(G_SA(0, 1), cA, 1, vA0, vA1);
    if (wr == 1) G_BAR;
    G_WAIT_V(4); G_BAR;
    G_STAGE1(G_SB(1, 0), srdB, cB + kstep, vB, dB64); G_STAGE_A(G_SA(1, 0), cA + kstep, 0, vA0, vA1); G_STAGE1(G_SB(1, 1), srdB, cB + hstepB + kstep, vB, dB64);
    G_WAIT_V(6); G_BAR;
    f32x4 acc[2][2][4][2];
#pragma unroll
    for (int a = 0; a < 2; ++a)
#pragma unroll
        for (int b = 0; b < 2; ++b)
#pragma unroll
            for (int m = 0; m < 4; ++m)
#pragma unroll
                for (int n = 0; n < 2; ++n) acc[a][b][m][n] = (f32x4){0.f, 0.f, 0.f, 0.f};
    bf16x8 At[4][2], B0[2][2], B1[2][2];
    for (;;) {
        const bool has_next = S.next(ui + 1, nxt);
        unsigned nA = cA, nB = cB; unsigned x0[2] = {0u, 0u}, x1[2] = {0u, 0u};
        if (has_next) { nB = G_UNI(S.b_off(nxt) * ESZ);
            if constexpr (GATHER) G_IDX(nxt);
            else nA = G_UNI(S.a_off(nxt) * ESZ);
        }
#define G_TRIP(LAST) do { \
            const unsigned a1 = cA + (unsigned)(t + 1) * kstep; \
            const unsigned a2 = (LAST) ? nA : cA + (unsigned)(t + 2) * kstep, b2 = (LAST) ? nB : cB + (unsigned)(t + 2) * kstep; \
            const unsigned a3 = a2 + kstep, b3 = b2 + kstep; \
            unsigned w0[2], w1[2]; \
            _Pragma("unroll") for (int i = 0; i < 2; ++i) { w0[i] = vA0[i]; w1[i] = vA1[i]; } \
            if constexpr (GATHER) { if ((LAST) && has_next) { G_ROWS(w0, w1); _Pragma("unroll") for (int i = 0; i < 2; ++i) { x0[i] = w0[i]; x1[i] = w1[i]; } } } \
              G_LDB(B0, 0, 0); G_SCHED; G_LDA(At, 0, 0); G_STAGE_A(G_SA(1, 1), a1, 1, vA0, vA1); \
            G_WAIT_L(8); G_BAR; G_WAIT_L(0); G_MMA(0, 0, At, B0); G_BAR; G_SCHED; \
              G_LDB(B1, 0, 1); G_STAGE1(G_SB(0, 0), srdB, b2, vB, dB64); \
            G_BAR; G_WAIT_L(0); G_MMA(0, 1, At, B1); G_BAR; \
              G_LDA(At, 0, 1); G_STAGE_A(G_SA(0, 0), a2, 0, w0, w1); \
            G_BAR; G_WAIT_L(0); G_MMA(1, 0, At, B0); G_BAR; G_SCHED; \
              G_STAGE1(G_SB(0, 1), srdB, b2 + hstepB, vB, dB64); \
            G_WAIT_V(6); G_BAR; G_MMA(1, 1, At, B1); G_BAR; \
              G_LDB(B0, 1, 0); G_SCHED; G_LDA(At, 1, 0); G_STAGE_A(G_SA(0, 1), a2, 1, w0, w1); \
            G_WAIT_L(8); G_BAR; G_WAIT_L(0); G_MMA(0, 0, At, B0); G_BAR; G_SCHED; \
              G_LDB(B1, 1, 1); G_STAGE1(G_SB(1, 0), srdB, b3, vB, dB64); \
            G_BAR; G_WAIT_L(0); G_MMA(0, 1, At, B1); G_BAR; \
              G_LDA(At, 1, 1); G_STAGE_A(G_SA(1, 0), a3, 0, w0, w1); \
            G_BAR; G_WAIT_L(0); G_MMA(1, 0, At, B0); G_BAR; G_SCHED; \
              G_STAGE1(G_SB(1, 1), srdB, b3 + hstepB, vB, dB64); \
            G_WAIT_V(6); G_BAR; G_MMA(1, 1, At, B1); G_BAR; } while (0)
        for (int t = 0; t < nt; t += 2) { const bool last = (t == nt - 2); G_TRIP(last); }
        if (wr == 0) G_BAR;
        { const int lane2 = fresh_lane();
          E(acc, cur, wid >> 2, wid & 3, lane2 & 15, lane2 >> 4); }
        if (!has_next) break;
#pragma unroll
        for (int a = 0; a < 2; ++a)
#pragma unroll
            for (int b = 0; b < 2; ++b)
#pragma unroll
                for (int m = 0; m < 4; ++m)
#pragma unroll
                    for (int n = 0; n < 2; ++n) acc[a][b][m][n] = (f32x4){0.f, 0.f, 0.f, 0.f};
        cur = nxt; cA = nA; cB = nB; ++ui;
        if (wr == 1) G_BAR;
        if constexpr (GATHER) {
#pragma unroll
            for (int i = 0; i < 2; ++i) { vA0[i] = x0[i]; vA1[i] = x1[i]; } }
    }
    G_WAIT_V(0);
    G_BAR;
#undef G_SA
#undef G_SB
#undef G_STAGE
#undef G_STAGE1
#undef G_STAGE_A
#undef G_LDA
#undef G_LDB
#undef G_MMA
#undef G_CAT
#undef G_WAIT_V
#undef G_WAIT_L
#undef G_BAR
#undef G_SCHED
#undef G_UNI
#undef G_TRIP
#undef G_IDX
#undef G_ROWS
}
#else
template <class Prob, class Epi, bool GATHER, bool FP8 = false>
__device__ __forceinline__ void gemm_phase(LAS uchar* lds, const Prob& S, const Epi& E, const int wid) {
    const int lane = fresh_lane(), tid = wid * 64 + lane, wr = wid >> 2, wc = wid & 3, fr = lane & 15, fq = lane >> 4;
    LAS float* As = (LAS float*)lds; LAS float* Bs = As + 256 * 33;
    Unit u;
    for (int ui = 0; S.next(ui, u); ++ui) {
        float acc[2][2][4][2][4];
#pragma unroll
        for (int a = 0; a < 2; ++a)
#pragma unroll
            for (int b = 0; b < 2; ++b)
#pragma unroll
                for (int m = 0; m < 4; ++m)
#pragma unroll
                    for (int n = 0; n < 2; ++n)
#pragma unroll
                        for (int j = 0; j < 4; ++j) acc[a][b][m][n][j] = 0.f;
        const int lr = tid >> 1, lk = (tid & 1) * 16;
        const bf16_t* ap = GATHER ? (S.A + S.a_row(u, lr)) : (S.A + S.a_off(u) + (size_t)lr * S.lda);
        const bf16_t* bp = S.B + S.b_off(u) + (size_t)lr * S.ldb;
        for (int k0 = 0; k0 < S.nt * 64; k0 += 32) {
            __syncthreads();
            const u32x4 a0 = *(const u32x4*)(ap + k0 + lk), a1 = *(const u32x4*)(ap + k0 + lk + 8);
            const u32x4 b0 = *(const u32x4*)(bp + k0 + lk), b1 = *(const u32x4*)(bp + k0 + lk + 8);
#pragma unroll
            for (int q = 0; q < 4; ++q) {
                As[lr * 33 + lk + 2 * q] = bflo(a0[q]); As[lr * 33 + lk + 2 * q + 1] = bfhi(a0[q]);
                As[lr * 33 + lk + 8 + 2 * q] = bflo(a1[q]); As[lr * 33 + lk + 8 + 2 * q + 1] = bfhi(a1[q]);
                Bs[lr * 33 + lk + 2 * q] = bflo(b0[q]); Bs[lr * 33 + lk + 2 * q + 1] = bfhi(b0[q]);
                Bs[lr * 33 + lk + 8 + 2 * q] = bflo(b1[q]); Bs[lr * 33 + lk + 8 + 2 * q + 1] = bfhi(b1[q]);
            }
            __syncthreads();
            for (int kk = 0; kk < 32; ++kk) {
                float av[2][4], bv[2][2][4];
#pragma unroll
                for (int a = 0; a < 2; ++a)
#pragma unroll
                    for (int m = 0; m < 4; ++m) av[a][m] = As[(128 * a + 64 * wr + 16 * m + fr) * 33 + kk];
#pragma unroll
                for (int b = 0; b < 2; ++b)
#pragma unroll
                    for (int n = 0; n < 2; ++n)
#pragma unroll
                        for (int j = 0; j < 4; ++j) { const int c = 128 * b + 32 * wc + (Epi::PERM ? (8 * fq + 4 * n + j) : (16 * n + 4 * fq + j)); bv[b][n][j] = Bs[c * 33 + kk]; }
#pragma unroll
                for (int a = 0; a < 2; ++a)
#pragma unroll
                    for (int b = 0; b < 2; ++b)
#pragma unroll
                        for (int m = 0; m < 4; ++m)
#pragma unroll
                            for (int n = 0; n < 2; ++n)
#pragma unroll
                                for (int j = 0; j < 4; ++j) acc[a][b][m][n][j] += av[a][m] * bv[b][n][j];
            }
        }
        f32x4 accv[2][2][4][2];
#pragma unroll
        for (int a = 0; a < 2; ++a)
#pragma unroll
            for (int b = 0; b < 2; ++b)
#pragma unroll
                for (int m = 0; m < 4; ++m)
#pragma unroll
                    for (int n = 0; n < 2; ++n) accv[a][b][m][n] = (f32x4){acc[a][b][m][n][0], acc[a][b][m][n][1], acc[a][b][m][n][2], acc[a][b][m][n][3]};
        E(accv, u, wr, wc, fr, fq);
    }
    __syncthreads();
}
#endif
}

struct Args {
    const float* in[32];
    float* out; uchar* ws;
    int ph_lo, ph_hi;
};
struct Frame {
    LAS uchar* lds; uchar* ws; int wave, G, bx;
};
#define FRAME_IDS(F) const int F_lane = fresh_lane(), F_tid = (F).wave * 64 + F_lane
enum { I_X = 0, I_POS, I_N1G, I_WIN, I_BG, I_QNG, I_WUQ, I_KVNG, I_WUKV, I_QKQG, I_QKKG, I_WOMLA, I_LRE, I_LIM, I_LOGDT, I_BRE, I_BIM, I_CRE, I_CIM, I_S5D,
       I_WGLU, I_WOS5, I_WOUT, I_N2G, I_WR, I_BR, I_WG, I_BGATE, I_WU, I_BUP, I_WD, I_BDOWN };

struct ProbS5 {
    const bf16_t* A; const bf16_t* B; int lda, ldb, nt; int G, c; const int* list = nullptr; const LAS int* gtab = nullptr;
    __device__ unsigned list_off(const gm::Unit&) const { return 0u; }
    __device__ bool next(int i, gm::Unit& u) const { const int L = i * G + c; if (L >= S5G * 4) return false; u.g = L >> 2; u.pm = L & 3; u.pn = 0; u.st = 0; return true; }
    __device__ size_t a_off(const gm::Unit& u) const { return ((size_t)u.g * NCHUNK + (size_t)u.pm * 256) * APK; }
    __device__ size_t b_off(const gm::Unit& u) const { return (size_t)u.g * 256 * ldb; }
    __device__ unsigned a_row(const gm::Unit&, int) const { return 0u; }
};
struct ProbMoE {
    const bf16_t* A; const bf16_t* B; int lda, ldb, nt; int npn; size_t estride;
    int x, rk, nrk; int nte[4], rcp[4], pre[4], eid[4];
    const int* list = nullptr; const LAS int* gtab = nullptr;
    __device__ void load(const LAS int* tab) {
#pragma unroll
        for (int q = 0; q < 4; ++q) { const int e = __builtin_amdgcn_readfirstlane(tab[160 + x * 4 + q]); eid[q] = e; nte[q] = __builtin_amdgcn_readfirstlane(tab[32 + e]); rcp[q] = __builtin_amdgcn_readfirstlane(tab[128 + e]); pre[q] = __builtin_amdgcn_readfirstlane(tab[64 + e]); }
    }
    __device__ unsigned list_off(const gm::Unit&) const { return 0u; }
    __device__ bool next(int i, gm::Unit& u) const {
        int L = i * nrk + rk;
#pragma unroll
        for (int q = 0; q < 4; ++q) { const int nu = nte[q] * npn;
            if (L < nu) { u.g = eid[q]; u.pn = (L * rcp[q]) >> 20; u.pm = L - u.pn * nte[q]; u.st = pre[q] + u.pm; return true; } L -= nu; }
        return false;
    }
    __device__ size_t a_off(const gm::Unit& u) const { return ((size_t)u.st * 256) * lda; }
    __device__ size_t b_off(const gm::Unit& u) const { return (size_t)u.g * estride + (size_t)u.pn * 256 * ldb; }
    __device__ unsigned a_row(const gm::Unit&, int) const { return 0u; }
};

#define EPI_ROW(u_, ai, m) ((u_).pm * 256 + (ai) * 128 + wr * 64 + (m) * 16 + fr)
struct EpiStoreBf16 {
    static constexpr bool PERM = true;
    bf16_t* O; int ld;
    __device__ __forceinline__ void operator()(const f32x4 (&acc)[2][2][4][2], const gm::Unit& u, int wr, int wc, int fr, int fq) const {
#pragma unroll
        for (int ai = 0; ai < 2; ++ai)
#pragma unroll
            for (int m = 0; m < 4; ++m) { bf16_t* rowp = O + (size_t)EPI_ROW(u, ai, m) * ld + u.pn * 256 + wc * 32 + 8 * fq;
#pragma unroll
                for (int bj = 0; bj < 2; ++bj) { const f32x4 v0 = acc[ai][bj][m][0], v1 = acc[ai][bj][m][1];
                    u32x4 w; w.x = cvt_pk_bf16(v0[0], v0[1]); w.y = cvt_pk_bf16(v0[2], v0[3]); w.z = cvt_pk_bf16(v1[0], v1[1]); w.w = cvt_pk_bf16(v1[2], v1[3]);
                    *(u32x4*)(rowp + bj * 128) = w; } }
    }
};
template <int S0, int NS, int LEN> struct EpiStoreScaled {
    static constexpr bool PERM = true;
    bf16_t* O; int ld; const float* ssqp;
    __device__ __forceinline__ void operator()(const f32x4 (&acc)[2][2][4][2], const gm::Unit& u, int wr, int wc, int fr, int fq) const {
#pragma unroll
        for (int ai = 0; ai < 2; ++ai) { float rs[4];
#pragma unroll
            for (int m = 0; m < 4; ++m) { const float* sp = ssqp + (size_t)EPI_ROW(u, ai, m) * 12 + S0; float t = 0.f;
#pragma unroll
                for (int q = 0; q < NS; q += 4) { const f32x4 v = *(const f32x4*)(sp + q); t += (v[0] + v[1]) + (v[2] + v[3]); }
                rs[m] = 1.0f / sqrtf(t * (1.0f / LEN) + EPS); }
#pragma unroll
            for (int m = 0; m < 4; ++m) { bf16_t* rowp = O + (size_t)EPI_ROW(u, ai, m) * ld + u.pn * 256 + wc * 32 + 8 * fq;
#pragma unroll
                for (int bj = 0; bj < 2; ++bj) { const f32x4 v0 = acc[ai][bj][m][0] * rs[m], v1 = acc[ai][bj][m][1] * rs[m];
                    u32x4 w; w.x = cvt_pk_bf16(v0[0], v0[1]); w.y = cvt_pk_bf16(v0[2], v0[3]); w.z = cvt_pk_bf16(v1[0], v1[1]); w.w = cvt_pk_bf16(v1[2], v1[3]);
                    *(u32x4*)(rowp + bj * 128) = w; } } }
    }
};
struct EpiKV {
    static constexpr bool PERM = true;
    bf16_t* kraw; bf16_t* vn; const float* ssqp;
    __device__ __forceinline__ void operator()(const f32x4 (&acc)[2][2][4][2], const gm::Unit& u, int wr, int wc, int fr, int fq) const {
#pragma unroll
        for (int ai = 0; ai < 2; ++ai) { float rs[4];
#pragma unroll
            for (int m = 0; m < 4; ++m) { const f32x4 v = *(const f32x4*)(ssqp + (size_t)EPI_ROW(u, ai, m) * 12 + 8); rs[m] = 1.0f / sqrtf(((v[0] + v[1]) + (v[2] + v[3])) * (1.0f / KVLORA) + EPS); }
#pragma unroll
            for (int m = 0; m < 4; ++m) { const int t = EPI_ROW(u, ai, m); const size_t ro = ((size_t)((t >> 11) * NH + u.pn) * SEQ + (t & 2047)) * 128 + wc * 32 + 8 * fq;
#pragma unroll
                for (int bj = 0; bj < 2; ++bj) { const f32x4 v0 = acc[ai][bj][m][0] * rs[m], v1 = acc[ai][bj][m][1] * rs[m];
                    u32x4 w; w.x = cvt_pk_bf16(v0[0], v0[1]); w.y = cvt_pk_bf16(v0[2], v0[3]); w.z = cvt_pk_bf16(v1[0], v1[1]); w.w = cvt_pk_bf16(v1[2], v1[3]);
                    *(u32x4*)((bj ? vn : kraw) + ro) = w; } } }
    }
};
struct EpiInProj {
    static constexpr bool PERM = true;
    bf16_t* proj; bf16_t* apack; const float* bgates; float* ssqp;
    __device__ __forceinline__ void operator()(const f32x4 (&acc)[2][2][4][2], const gm::Unit& u, int wr, int wc, int fr, int fq) const {
        const int colt = u.pn * 256 + wc * 32 + 8 * fq;
        if (u.pn < 3) {
#pragma unroll
            for (int ai = 0; ai < 2; ++ai)
#pragma unroll
                for (int m = 0; m < 4; ++m) { float sq = 0.f;
#pragma unroll
                    for (int bj = 0; bj < 2; ++bj)
#pragma unroll
                        for (int n = 0; n < 2; ++n) { const f32x4 v = acc[ai][bj][m][n]; sq += (v[0] * v[0] + v[1] * v[1]) + (v[2] * v[2] + v[3] * v[3]); }
                    sq += __shfl_xor(sq, 16); sq += __shfl_xor(sq, 32);
                    if (fq == 0) ssqp[(size_t)EPI_ROW(u, ai, m) * 12 + u.pn * 4 + wc] = sq; } }
        const int kind = (u.pn >= 3 && u.pn < 7) ? 1 : ((u.pn >= 7 && u.pn < 23) ? 2 : 0);
#pragma unroll
        for (int bj = 0; bj < 2; ++bj) {
            const int col = colt + bj * 128;
            f32x4 b0 = (f32x4){0.f, 0.f, 0.f, 0.f}, b1 = b0;
            if (kind == 2) { b0 = *(const f32x4*)(bgates + (col - C_GA)); b1 = *(const f32x4*)(bgates + (col - C_GA) + 4); }
#pragma unroll
            for (int ai = 0; ai < 2; ++ai)
#pragma unroll
                for (int m = 0; m < 4; ++m) {
                    const int row = EPI_ROW(u, ai, m);
                    f32x4 v0 = acc[ai][bj][m][0], v1 = acc[ai][bj][m][1];
                    if (kind == 2) {
#pragma unroll
                        for (int j = 0; j < 4; ++j) { v0[j] = sigmoidf_(v0[j] + b0[j]); v1[j] = sigmoidf_(v1[j] + b1[j]); }
                    }
                    u32x4 w; w.x = cvt_pk_bf16(v0[0], v0[1]); w.y = cvt_pk_bf16(v0[2], v0[3]); w.z = cvt_pk_bf16(v1[0], v1[1]); w.w = cvt_pk_bf16(v1[2], v1[3]);
                    if (kind == 1) { const int j = col - C_U, g = j >> 4, cc = j & 15;
                        *(u32x4*)(apack + ((size_t)g * NCHUNK + (row >> 4)) * APK + (row & 15) * 16 + cc) = w; }
                    else { *(u32x4*)(proj + (size_t)row * NPROJ + col) = w;
                    }
                }
        }
    }
};
struct EpiS5State {
    static constexpr bool PERM = false;
    float* sch;
    __device__ __forceinline__ void operator()(const f32x4 (&acc)[2][2][4][2], const gm::Unit& u, int wr, int wc, int fr, int fq) const {
#pragma unroll
        for (int ai = 0; ai < 2; ++ai)
#pragma unroll
            for (int m = 0; m < 4; ++m) { float* rowp = sch + ((size_t)u.g * NCHUNK + EPI_ROW(u, ai, m)) * 128 + wc * 32 + 4 * fq;
#pragma unroll
                for (int n = 0; n < 2; ++n) *(f32x4*)(rowp + n * 16) = acc[ai][0][m][n]; }
    }
};
struct EpiS5Out {
    static constexpr bool PERM = true;
    bf16_t* gact;
    __device__ __forceinline__ void operator()(const f32x4 (&acc)[2][2][4][2], const gm::Unit& u, int wr, int wc, int fr, int fq) const {
#pragma unroll
        for (int ai = 0; ai < 2; ++ai)
#pragma unroll
            for (int m = 0; m < 4; ++m) { const int r = EPI_ROW(u, ai, m);
#pragma unroll
                for (int bj = 0; bj < 2; ++bj) { const int n0 = bj * 128 + wc * 32 + 8 * fq, t = n0 >> 4, c0 = n0 & 15;
                    f32x4 v0 = acc[ai][bj][m][0], v1 = acc[ai][bj][m][1];
#pragma unroll
                    for (int j = 0; j < 4; ++j) { v0[j] = gelu_tanh(v0[j]); v1[j] = gelu_tanh(v1[j]); }
                    u32x4 w; w.x = cvt_pk_bf16(v0[0], v0[1]); w.y = cvt_pk_bf16(v0[2], v0[3]); w.z = cvt_pk_bf16(v1[0], v1[1]); w.w = cvt_pk_bf16(v1[2], v1[3]);
                    *(u32x4*)(gact + ((size_t)r * 16 + t) * S5W + u.g * 16 + c0) = w; } }
    }
};
template <int MODE> struct EpiSide {
    static constexpr bool PERM = true;
    bf16_t* O; int ldo; const bf16_t* s0; int ld0; const bf16_t* s1; int ld1;
    __device__ __forceinline__ void operator()(const f32x4 (&acc)[2][2][4][2], const gm::Unit& u, int wr, int wc, int fr, int fq) const {
        const int col0 = u.pn * 256 + wc * 32 + 8 * fq;
#pragma unroll
        for (int ai = 0; ai < 2; ++ai) {
            u32x4 sa[4][2], sb[4][2];
#pragma unroll
            for (int m = 0; m < 4; ++m)
#pragma unroll
                for (int bj = 0; bj < 2; ++bj) { const int row = EPI_ROW(u, ai, m);
                    sa[m][bj] = *(const u32x4*)(s0 + (size_t)row * ld0 + col0 + bj * 128);
                    if (MODE == 2) sb[m][bj] = *(const u32x4*)(s1 + (size_t)row * ld1 + col0 + bj * 128); else sb[m][bj] = (u32x4){0u, 0u, 0u, 0u}; }
#pragma unroll
            for (int m = 0; m < 4; ++m)
#pragma unroll
                for (int bj = 0; bj < 2; ++bj) { const int row = EPI_ROW(u, ai, m);
                    const f32x4 v0 = acc[ai][bj][m][0], v1 = acc[ai][bj][m][1]; const u32x4 a = sa[m][bj], b = sb[m][bj];
                    float r[8];
#pragma unroll
                    for (int q = 0; q < 4; ++q) { const float x0 = q < 2 ? v0[2 * q] : v1[2 * q - 4], x1 = q < 2 ? v0[2 * q + 1] : v1[2 * q - 3];
                        const float a0 = bflo(a[q]), a1 = bfhi(a[q]);
                        if (MODE == 0) { r[2 * q] = a0 * sigmoidf_(x0); r[2 * q + 1] = a1 * sigmoidf_(x1); }
                        else if (MODE == 1) { r[2 * q] = a0 * x0; r[2 * q + 1] = a1 * x1; }
                        else { r[2 * q] = bflo(b[q]) + a0 * x0; r[2 * q + 1] = bfhi(b[q]) + a1 * x1; } }
                    u32x4 w; w.x = cvt_pk_bf16(r[0], r[1]); w.y = cvt_pk_bf16(r[2], r[3]); w.z = cvt_pk_bf16(r[4], r[5]); w.w = cvt_pk_bf16(r[6], r[7]);
                    *(u32x4*)(O + (size_t)row * ldo + col0 + bj * 128) = w; }
        }
    }
};
struct EpiResidF32 {
    static constexpr bool PERM = false;
    const float* x; float* out;
    __device__ __forceinline__ void operator()(const f32x4 (&acc)[2][2][4][2], const gm::Unit& u, int wr, int wc, int fr, int fq) const {
#pragma unroll
        for (int ai = 0; ai < 2; ++ai)
#pragma unroll
            for (int mh = 0; mh < 2; ++mh) { f32x4 xv[2][2][2];
#pragma unroll
                for (int mm = 0; mm < 2; ++mm) { const size_t off = (size_t)EPI_ROW(u, ai, 2 * mh + mm) * DM + u.pn * 256 + wc * 32 + 4 * fq;
#pragma unroll
                    for (int bj = 0; bj < 2; ++bj)
#pragma unroll
                        for (int n = 0; n < 2; ++n) xv[mm][bj][n] = *(const f32x4*)(x + off + bj * 128 + n * 16); }
#pragma unroll
                for (int mm = 0; mm < 2; ++mm) { const size_t off = (size_t)EPI_ROW(u, ai, 2 * mh + mm) * DM + u.pn * 256 + wc * 32 + 4 * fq;
#pragma unroll
                    for (int bj = 0; bj < 2; ++bj)
#pragma unroll
                        for (int n = 0; n < 2; ++n) *(f32x4*)(out + off + bj * 128 + n * 16) = xv[mm][bj][n] + acc[ai][bj][2 * mh + mm][n]; } }
    }
};
#if MK_FP8_MOE
constexpr float MOE_DESCALE = 1.0f / (FP8_ASCALE * FP8_WSCALE);
#else
constexpr float MOE_DESCALE = 1.0f;
#endif
struct EpiSwiglu {
    static constexpr bool PERM = true;
    bf16_t* hact; const float* bgate; const float* bup; const LAS int* tab;
    __device__ __forceinline__ void operator()(const f32x4 (&acc)[2][2][4][2], const gm::Unit& u, int wr, int wc, int fr, int fq) const {
        const int hc = u.pn * 128 + wc * 32 + 8 * fq;
        const unsigned slot0 = (unsigned)u.st * 256u + wr * 64 + fr;
#pragma unroll
        for (int n = 0; n < 2; ++n) {
            const f32x4 g0 = *(const f32x4*)(bgate + (unsigned)(u.g * DFF + hc + 4 * n)), u0 = *(const f32x4*)(bup + (unsigned)(u.g * DFF + hc + 4 * n));
#pragma unroll
            for (int ai = 0; ai < 2; ++ai)
#pragma unroll
                for (int m = 0; m < 4; ++m) { const unsigned slot = slot0 + ai * 128 + m * 16;
                    float r[4];
#pragma unroll
                    for (int q = 0; q < 4; ++q) { float gt = acc[ai][0][m][n][q] * MOE_DESCALE + g0[q], up = acc[ai][1][m][n][q] * MOE_DESCALE + u0[q];
                        gt = fminf(gt, 7.0f); up = fminf(fmaxf(up, -7.0f), 7.0f);
                        r[q] = (up + 1.0f) * (gt * sigmoidf_(1.702f * gt)); }
#if MK_FP8_MOE
                    *(unsigned*)((uchar*)hact + slot * DFF + hc + 4 * n) = pk4_fp8(r[0] * FP8_ASCALE, r[1] * FP8_ASCALE, r[2] * FP8_ASCALE, r[3] * FP8_ASCALE);
#else
                    u32x2 w; w.x = cvt_pk_bf16(r[0], r[1]); w.y = cvt_pk_bf16(r[2], r[3]); *(u32x2*)(hact + slot * DFF + hc + 4 * n) = w;
#endif
                }
        }
    }
};
struct EpiDown {
    static constexpr bool PERM = true;
    bf16_t* ys; const float* bdown; const LAS int* tab;
    __device__ __forceinline__ void operator()(const f32x4 (&acc)[2][2][4][2], const gm::Unit& u, int wr, int wc, int fr, int fq) const {
        const size_t slot0 = (size_t)u.st * 256;
#pragma unroll
        for (int bj = 0; bj < 2; ++bj) { const int col = u.pn * 256 + bj * 128 + wc * 32 + 8 * fq;
            const float* bd = bdown + (size_t)u.g * DM + col; const f32x4 d0 = *(const f32x4*)bd, d1 = *(const f32x4*)(bd + 4);
#pragma unroll
            for (int ai = 0; ai < 2; ++ai)
#pragma unroll
                for (int m = 0; m < 4; ++m) { const size_t slot = slot0 + ai * 128 + wr * 64 + m * 16 + fr;
                    const f32x4 v0 = acc[ai][bj][m][0] * MOE_DESCALE + d0, v1 = acc[ai][bj][m][1] * MOE_DESCALE + d1;
                    u32x4 w; w.x = cvt_pk_bf16(v0[0], v0[1]); w.y = cvt_pk_bf16(v0[2], v0[3]); w.z = cvt_pk_bf16(v1[0], v1[1]); w.w = cvt_pk_bf16(v1[2], v1[3]);
                    *(u32x4*)(ys + slot * DM + col) = w; } }
    }
};

template <bool FP8OUT>
__device__ __forceinline__ void transpose_item(const float* W, int ldw, int src_col0, int k0, const float* kscale, void* WT, int ldt, int dst_row0, float oscale, LAS float* scr, int lane) {
    if (src_col0 >= 0) {
        f32x4 v[16]; const float* wp = W + (size_t)(k0 + (lane >> 4)) * ldw + src_col0 + (lane & 15) * 4;
#pragma unroll
        for (int i = 0; i < 16; ++i) v[i] = *(const f32x4*)(wp + (size_t)(4 * i) * ldw);
#pragma unroll
        for (int i = 0; i < 16; ++i) { const int kk = 4 * i + (lane >> 4); const float sc = kscale ? kscale[k0 + kk] * oscale : oscale; LAS float* d = scr + kk * 65 + (lane & 15) * 4;
            d[0] = v[i].x * sc; d[1] = v[i].y * sc; d[2] = v[i].z * sc; d[3] = v[i].w * sc; }
    } else {
#pragma unroll
        for (int i = 0; i < 16; ++i) { LAS float* d = scr + (4 * i + (lane >> 4)) * 65 + (lane & 15) * 4; d[0] = 0.f; d[1] = 0.f; d[2] = 0.f; d[3] = 0.f; }
    }
    LDS_WAIT(); asm volatile("" ::: "memory");
    if constexpr (FP8OUT) { const int c = lane & 3;
#pragma unroll
        for (int j = 0; j < 4; ++j) { const int n = (lane >> 2) + 16 * j; const LAS float* s = scr + (16 * c) * 65 + n; u32x4 o;
            o.x = pk4_fp8(s[0 * 65], s[1 * 65], s[2 * 65], s[3 * 65]); o.y = pk4_fp8(s[4 * 65], s[5 * 65], s[6 * 65], s[7 * 65]);
            o.z = pk4_fp8(s[8 * 65], s[9 * 65], s[10 * 65], s[11 * 65]); o.w = pk4_fp8(s[12 * 65], s[13 * 65], s[14 * 65], s[15 * 65]);
            *(u32x4*)((uchar*)WT + (size_t)(dst_row0 + n) * ldt + k0 + 16 * c) = o; }
    } else { const int c = lane & 7;
#pragma unroll
        for (int j = 0; j < 8; ++j) { const int n = (lane >> 3) + 8 * j; const LAS float* s = scr + (8 * c) * 65 + n;
            u32x4 o; o.x = pk2(s[0 * 65], s[1 * 65]); o.y = pk2(s[2 * 65], s[3 * 65]); o.z = pk2(s[4 * 65], s[5 * 65]); o.w = pk2(s[6 * 65], s[7 * 65]);
            *(u32x4*)((bf16_t*)WT + (size_t)(dst_row0 + n) * ldt + k0 + 8 * c) = o; }
    }
    LDS_WAIT(); asm volatile("" ::: "memory");
}
struct TItem { const float* src; uchar* dst; };
__device__ __forceinline__ void ti_load(const TItem& t, f32x4 (&v)[16], int lane) {
    const float* wp = t.src + (size_t)(lane >> 4) * DM + (lane & 15) * 4;
#pragma unroll
    for (int i = 0; i < 16; ++i) v[i] = *(const f32x4*)(wp + (size_t)(4 * i) * DM);
}
template <bool FP8OUT>
__device__ __forceinline__ void ti_store(const TItem& t, const f32x4 (&v)[16], float oscale, LAS float* scr, int lane) {
#pragma unroll
    for (int i = 0; i < 16; ++i) { LAS float* d = scr + (4 * i + (lane >> 4)) * 65 + (lane & 15) * 4; d[0] = v[i].x * oscale; d[1] = v[i].y * oscale; d[2] = v[i].z * oscale; d[3] = v[i].w * oscale; }
    LDS_WAIT(); asm volatile("" ::: "memory");
    if constexpr (FP8OUT) { const int c = lane & 3;
#pragma unroll
        for (int j = 0; j < 4; ++j) { const int n = (lane >> 2) + 16 * j; const LAS float* s = scr + (16 * c) * 65 + n; u32x4 o;
            o.x = pk4_fp8(s[0 * 65], s[1 * 65], s[2 * 65], s[3 * 65]); o.y = pk4_fp8(s[4 * 65], s[5 * 65], s[6 * 65], s[7 * 65]);
            o.z = pk4_fp8(s[8 * 65], s[9 * 65], s[10 * 65], s[11 * 65]); o.w = pk4_fp8(s[12 * 65], s[13 * 65], s[14 * 65], s[15 * 65]);
            *(u32x4*)(t.dst + (size_t)n * DM + 16 * c) = o; }
    } else { const int c = lane & 7;
#pragma unroll
        for (int j = 0; j < 8; ++j) { const int n = (lane >> 3) + 8 * j; const LAS float* s = scr + (8 * c) * 65 + n;
            u32x4 o; o.x = pk2(s[0 * 65], s[1 * 65]); o.y = pk2(s[2 * 65], s[3 * 65]); o.z = pk2(s[4 * 65], s[5 * 65]); o.w = pk2(s[6 * 65], s[7 * 65]);
            *(u32x4*)(t.dst + ((size_t)n * DM + 8 * c) * 2) = o; }
    }
    LDS_WAIT(); asm volatile("" ::: "memory");
}
template <bool W8>
__device__ __forceinline__ TItem moe_pair(const Args& a, uchar* ws, int it) {
    constexpr size_t WEB = W8 ? 1 : 2; TItem t;
    const int kb = 2 * ((it & 7) | (((it >> 11) & 1) << 3)), nb = (it >> 3) & 31;
    if (it < NE * 2 * 16 * 32) { const int rest = ((it >> 8) & 7) | ((it >> 12) << 3), half = rest & 1, e = rest >> 1, pn = nb >> 1, q = nb & 1;
        t.src = a.in[half ? I_WU : I_WG] + (size_t)e * DM * DFF + (size_t)(kb * 64) * DFF + nb * 64;
        t.dst = ws + WS_W1 + ((size_t)e * 4096 * DM + (size_t)(pn * 256 + half * 128 + q * 64) * DM + kb * 64) * WEB;
    } else { const int r = it - NE * 2 * 16 * 32, e = ((r >> 8) & 7) | ((r >> 12) << 3);
        t.src = a.in[I_WD] + (size_t)e * DFF * DM + (size_t)(kb * 64) * DM + nb * 64;
        t.dst = ws + WS_W2 + ((size_t)e * DM * DFF + (size_t)(nb * 64) * DFF + kb * 64) * WEB; }
    return t;
}
template <bool FP8OUT, int NO>
__device__ __forceinline__ void ti_block(const f32x4 (&v)[16], float oscale, LAS float* scr, int lane, u32x4 (&o)[NO]) {
#pragma unroll
    for (int i = 0; i < 16; ++i) { LAS float* d = scr + (4 * i + (lane >> 4)) * 65 + (lane & 15) * 4; d[0] = v[i].x * oscale; d[1] = v[i].y * oscale; d[2] = v[i].z * oscale; d[3] = v[i].w * oscale; }
    LDS_WAIT(); asm volatile("" ::: "memory");
    if constexpr (FP8OUT) { const int c = lane & 3;
#pragma unroll
        for (int j = 0; j < 4; ++j) { const int n = (lane >> 2) + 16 * j; const LAS float* s = scr + (16 * c) * 65 + n;
            o[j].x = pk4_fp8(s[0 * 65], s[1 * 65], s[2 * 65], s[3 * 65]); o[j].y = pk4_fp8(s[4 * 65], s[5 * 65], s[6 * 65], s[7 * 65]);
            o[j].z = pk4_fp8(s[8 * 65], s[9 * 65], s[10 * 65], s[11 * 65]); o[j].w = pk4_fp8(s[12 * 65], s[13 * 65], s[14 * 65], s[15 * 65]); }
    } else { const int c = lane & 7;
#pragma unroll
        for (int j = 0; j < 8; ++j) { const int n = (lane >> 3) + 8 * j; const LAS float* s = scr + (8 * c) * 65 + n;
            o[j].x = pk2(s[0 * 65], s[1 * 65]); o[j].y = pk2(s[2 * 65], s[3 * 65]); o[j].z = pk2(s[4 * 65], s[5 * 65]); o[j].w = pk2(s[6 * 65], s[7 * 65]); } }
    LDS_WAIT(); asm volatile("" ::: "memory");
}
__device__ __forceinline__ int win_src_col(int n0) {
    if (n0 < C_KVLAT) return n0;
    if (n0 < C_U) return n0;
    if (n0 < C_GA) return (n0 - C_U) + 832;
    if (n0 < C_KR) return (n0 - C_GA) + 1856;
    if (n0 < C_KR + DROPE) return (n0 - C_KR) + 768;
    return -1;
}
__device__ __forceinline__ void s5_build_group(const Args& a, const Frame& F, int g) {
    FRAME_IDS(F);
    LAS float* L = (LAS float*)F.lds;
    LAS float* Apr = L;              LAS float* Api = Apr + 17 * 64;
    LAS float* Zr = Api + 17 * 64;   LAS float* Zi = Zr + 64;
    LAS float* Bbr = Zi + 64;        LAS float* Bbi = Bbr + 1024;
    LAS float* Cr = Bbi + 1024;      LAS float* Ci = Cr + 1024;
    LAS float* Kt = Ci + 1024;
    const int tid = F_tid;
    __syncthreads();
    if (tid < 64) { const int p = tid;
        const float dt = expf(a.in[I_LOGDT][g]); const float lr = a.in[I_LRE][g * 64 + p], li = a.in[I_LIM][g * 64 + p];
        const float mag = expf(lr * dt); const float ar = mag * cosf(li * dt), ai = mag * sinf(li * dt);
        const float den = lr * lr + li * li;
        Zr[p] = ((ar - 1.0f) * lr + ai * li) / den; Zi[p] = (ai * lr - (ar - 1.0f) * li) / den;
        float pr = 1.0f, pi = 0.0f;
        for (int t = 0; t <= 16; ++t) { Apr[t * 64 + p] = pr; Api[t * 64 + p] = pi; const float nr = pr * ar - pi * ai, ni = pr * ai + pi * ar; pr = nr; pi = ni; }
    }
    __syncthreads();
    for (int i = tid; i < 1024; i += NTHREADS) { const int p = i >> 4;
        const float br = a.in[I_BRE][(size_t)g * 1024 + i], bi = a.in[I_BIM][(size_t)g * 1024 + i];
        Bbr[i] = Zr[p] * br - Zi[p] * bi; Bbi[i] = Zr[p] * bi + Zi[p] * br;
        Cr[i] = a.in[I_CRE][(size_t)g * 1024 + i]; Ci[i] = a.in[I_CIM][(size_t)g * 1024 + i]; }
    if (tid < 64) ((float2*)(F.ws + WS_SMALL + SM_A16))[g * 64 + tid] = make_float2(Apr[16 * 64 + tid], Api[16 * 64 + tid]);
    __syncthreads();
    { const int tau = tid >> 5, c = (tid >> 1) & 15, h8 = (tid & 1) * 8; float acc8[8];
#pragma unroll
      for (int j = 0; j < 8; ++j) acc8[j] = 0.f;
      for (int p = 0; p < 64; ++p) { const float cr = Cr[c * 64 + p], ci = Ci[c * 64 + p], ar = Apr[tau * 64 + p], ai = Api[tau * 64 + p];
          const float car = cr * ar - ci * ai, cai = cr * ai + ci * ar;
          const f32x4 b0 = *(const LAS f32x4*)(Bbr + p * 16 + h8), b1 = *(const LAS f32x4*)(Bbr + p * 16 + h8 + 4), d0 = *(const LAS f32x4*)(Bbi + p * 16 + h8), d1 = *(const LAS f32x4*)(Bbi + p * 16 + h8 + 4);
#pragma unroll
          for (int j = 0; j < 4; ++j) { acc8[j] += car * b0[j] - cai * d0[j]; acc8[4 + j] += car * b1[j] - cai * d1[j]; } }
#pragma unroll
      for (int j = 0; j < 8; ++j) Kt[(tau * 16 + c) * 16 + h8 + j] = acc8[j]; }
    __syncthreads();
    bf16_t* twc = (bf16_t*)(F.ws + WS_TWC) + (size_t)g * 256 * APK;
    for (int ch = tid; ch < 256 * (APK / 8); ch += NTHREADS) { const int n = ch / (APK / 8), k0 = (ch % (APK / 8)) * 8, t = n >> 4, c = n & 15; float v[8];
#pragma unroll
        for (int j = 0; j < 8; ++j) { const int k = k0 + j;
            if (k < 256) { const int s = k >> 4, cp = k & 15; float x = (s <= t) ? Kt[((t - s) * 16 + c) * 16 + cp] : 0.f; if (s == t && cp == c) x += a.in[I_S5D][g * 16 + c]; v[j] = x; }
            else { const int q = k - 256, p = q & 63; const float cr = Cr[c * 64 + p], ci = Ci[c * 64 + p], ar = Apr[(t + 1) * 64 + p], ai = Api[(t + 1) * 64 + p];
                v[j] = (q < 64) ? (cr * ar - ci * ai) : -(cr * ai + ci * ar); } }
        u32x4 o; o.x = pk2(v[0], v[1]); o.y = pk2(v[2], v[3]); o.z = pk2(v[4], v[5]); o.w = pk2(v[6], v[7]);
        *(u32x4*)(twc + (size_t)n * APK + k0) = o; }
    bf16_t* wsm = (bf16_t*)(F.ws + WS_WS5) + (size_t)g * 256 * 256;
    for (int ch = tid; ch < 256 * 32; ch += NTHREADS) { const int n = ch >> 5, k0 = (ch & 31) * 8; float v[8];
#pragma unroll
        for (int j = 0; j < 8; ++j) { const int k = k0 + j, s = k >> 4, cp = k & 15;
            if (n < 128) { const int p = n & 63; const float ar = Apr[(15 - s) * 64 + p], ai = Api[(15 - s) * 64 + p], br = Bbr[p * 16 + cp], bi = Bbi[p * 16 + cp];
                v[j] = (n < 64) ? (ar * br - ai * bi) : (ar * bi + ai * br); } else v[j] = 0.f; }
        u32x4 o; o.x = pk2(v[0], v[1]); o.y = pk2(v[2], v[3]); o.z = pk2(v[4], v[5]); o.w = pk2(v[6], v[7]);
        *(u32x4*)(wsm + (size_t)n * 256 + k0) = o; }
    __syncthreads();
}
__device__ __forceinline__ void rms_row_to_bf16(const float* xrow, const float* gain, bf16_t* orow, int lane) {
    const f32x4* xr = (const f32x4*)xrow + lane; const f32x4* gr = (const f32x4*)gain + lane;
    f32x4 v[8]; float s = 0.f;
#pragma unroll
    for (int j = 0; j < 8; ++j) { v[j] = xr[64 * j]; s += (v[j].x * v[j].x + v[j].y * v[j].y) + (v[j].z * v[j].z + v[j].w * v[j].w); }
    const float rstd = 1.0f / sqrtf(wave_sum(s) * (1.0f / DM) + EPS);
    unsigned long long* o8 = (unsigned long long*)orow + lane;
#pragma unroll
    for (int j = 0; j < 8; ++j) { const f32x4 gg = gr[64 * j];
        o8[64 * j] = (unsigned long long)pk2(v[j].x * rstd * gg.x, v[j].y * rstd * gg.y) | ((unsigned long long)pk2(v[j].z * rstd * gg.z, v[j].w * rstd * gg.w) << 32); }
}
__device__ __forceinline__ void p0_prologue(const Args& a, const Frame& F) {
    FRAME_IDS(F);
    for (int g = F.bx; g < S5G; g += F.G) s5_build_group(a, F, g);
    __syncthreads();
    const int gw = F.bx * NWAVES + F.wave, NGW = F.G * NWAVES; const int lane = F_lane;
    for (int m = gw; m < TT; m += NGW) rms_row_to_bf16(a.in[I_X] + (size_t)m * DM, a.in[I_N1G], (bf16_t*)(F.ws + WS_H) + (size_t)m * DM, lane);
    for (int i = gw * 64 + lane; i < TT * 32; i += NGW * 64) { const int t = i >> 5, f = i & 31;
        const double invf = exp(-(double)f * (9.210340371976184 / 32.0)); const double ang = (double)((const int*)a.in[I_POS])[t] * invf;
        ((float2*)(F.ws + WS_ROPE))[i] = make_float2((float)cos(ang), (float)sin(ang)); }
    for (int i = gw * 64 + lane; i < DM * NE; i += NGW * 64) ((float*)(F.ws + WS_SMALL + SM_WRP))[i] = a.in[I_WR][i] * a.in[I_N2G][i >> 5];
    LAS float* scr = (LAS float*)(F.lds + F.wave * 16640);
    constexpr int IT_WIN = (DM / 64) * (NPROJ / 64), IT_WUQ = (QLORA / 64) * (3072 / 64), IT_WUKV = (KVLORA / 64) * (4096 / 64), IT_SQ = (DM / 64) * (DM / 64),
                  IT_GLU = (S5W / 64) * (S5W / 64), IT_OS5 = (S5W / 64) * (DM / 64);
    constexpr int IT_MIX = IT_WIN + IT_WUQ + IT_WUKV + IT_SQ + IT_GLU + IT_OS5 + IT_SQ;
    for (int it = gw; it < IT_MIX; it += NGW) { int r = it;
        if (r < IT_WIN) { const int nb = r % (NPROJ / 64), kb = r / (NPROJ / 64); transpose_item<false>(a.in[I_WIN], IN_PROJ, win_src_col(nb * 64), kb * 64, nullptr, F.ws + WS_WIN, DM, nb * 64, 1.f, scr, lane); continue; } r -= IT_WIN;
        if (r < IT_WUQ) { const int nb = r % 48, kb = r / 48; transpose_item<false>(a.in[I_WUQ], 3072, nb * 64, kb * 64, a.in[I_QNG], F.ws + WS_WUQ, QLORA, nb * 64, 1.f, scr, lane); continue; } r -= IT_WUQ;
        if (r < IT_WUKV) { const int nb = r % 64, kb = r / 64; transpose_item<false>(a.in[I_WUKV], 4096, nb * 64, kb * 64, a.in[I_KVNG], F.ws + WS_WUKV, KVLORA, nb * 64, 1.f, scr, lane); continue; } r -= IT_WUKV;
        if (r < IT_SQ) { const int nb = r % 32, kb = r / 32; transpose_item<false>(a.in[I_WOMLA], DM, nb * 64, kb * 64, nullptr, F.ws + WS_WOMLA, DM, nb * 64, 1.f, scr, lane); continue; } r -= IT_SQ;
        if (r < IT_GLU) { const int nb = r % 16, kb = r / 16; transpose_item<false>(a.in[I_WGLU], S5W, nb * 64, kb * 64, nullptr, F.ws + WS_WGLU, S5W, nb * 64, 1.f, scr, lane); continue; } r -= IT_GLU;
        if (r < IT_OS5) { const int nb = r % 32, kb = r / 32; transpose_item<false>(a.in[I_WOS5], DM, nb * 64, kb * 64, nullptr, F.ws + WS_WOS5, S5W, nb * 64, 1.f, scr, lane); continue; } r -= IT_OS5;
        { const int nb = r % 32, kb = r / 32; transpose_item<false>(a.in[I_WOUT], DM, nb * 64, kb * 64, nullptr, F.ws + WS_WOUT, DM, nb * 64, 1.f, scr, lane); }
    }
    constexpr bool W8 = MK_FP8_MOE != 0; constexpr float WSC = W8 ? FP8_WSCALE : 1.0f; constexpr int NPAIR = NE * 3 * 16 * 32; constexpr int NO = W8 ? 4 : 8;
    for (int it = gw; it < NPAIR; it += NGW) { const TItem t = moe_pair<W8>(a, F.ws, it); f32x4 v0[16], v1[16];
        ti_load(t, v0, lane); { TItem t1 = t; t1.src += (size_t)64 * DM; ti_load(t1, v1, lane); }
        u32x4 o0[NO], o1[NO];
        ti_block<W8, NO>(v0, WSC, scr, lane, o0); ti_block<W8, NO>(v1, WSC, scr, lane, o1);
        if constexpr (W8) { const int c = lane & 3;
#pragma unroll
            for (int j = 0; j < 4; ++j) { uchar* d = t.dst + (size_t)((lane >> 2) + 16 * j) * DM + 16 * c; *(u32x4*)d = o0[j]; *(u32x4*)(d + 64) = o1[j]; }
        } else { const int c = lane & 7;
#pragma unroll
            for (int j = 0; j < 8; ++j) { uchar* d = t.dst + ((size_t)((lane >> 3) + 8 * j) * DM + 8 * c) * 2; *(u32x4*)d = o0[j]; *(u32x4*)(d + 128) = o1[j]; } }
    }
}

constexpr float QSCALE = 0.07216878364870322f * 1.4426950408889634f;
__device__ __forceinline__ float half_sum(float v) {
#pragma unroll
    for (int o = 1; o < 32; o <<= 1) v += __shfl_xor(v, o);
    return v;
}
__device__ __forceinline__ void p3_prep(const Args& a, const Frame& F) {
    FRAME_IDS(F);
    const bf16_t* proj = (const bf16_t*)(F.ws + WS_PROJ); const bf16_t* kvraw = (const bf16_t*)(F.ws + WS_KVRAW); bf16_t* Kn = (bf16_t*)(F.ws + WS_KN);
    const float2* rope = (const float2*)(F.ws + WS_ROPE);
    const int lane = F_lane, grp = lane / 24, ch = lane - grp * 24; const bool act = grp < 2;
    const bool isrope = act && ch >= 16, x2half = isrope && ch >= 20; const int ri = isrope ? ((ch - 16) & 3) * 8 : 0;
    float g[8];
#pragma unroll
    for (int j = 0; j < 8; ++j) g[j] = act ? a.in[I_QKKG][ch * 8 + j] : 0.f;
    const bool even = (TT == 64 * F.G);
    const int tk0 = even ? F.bx * 64 + (F.wave < 2 ? 5 * F.wave : 10 + 9 * (F.wave - 2)) : F.bx * NWAVES + F.wave, tkn = even ? (F.wave < 2 ? 5 : 9) : (TT + F.G * NWAVES - 1) / (F.G * NWAVES), tks = even ? 1 : F.G * NWAVES;
    for (int ti = 0; ti < tkn; ++ti) { const int t = tk0 + ti * tks; if (t >= TT) break;
        const int b = t >> 11, s = t & 2047; const bf16_t* prow = proj + (size_t)t * NPROJ;
        float cs[8], sn[8];
        if (isrope) {
#pragma unroll
            for (int j = 0; j < 8; j += 2) { const f32x4 c2 = *(const f32x4*)(rope + (size_t)t * 32 + ri + j); cs[j] = c2.x; sn[j] = c2.y; cs[j + 1] = c2.z; sn[j + 1] = c2.w; } }
        else {
#pragma unroll
            for (int j = 0; j < 8; ++j) { cs[j] = 1.f; sn[j] = 0.f; } }
        u32x4 kr = (u32x4){0u, 0u, 0u, 0u};
        if (isrope) kr = *(const u32x4*)(prow + C_KR + (ch - 16) * 8);
        u32x4 wl[8];
        { const bf16_t* src0 = kvraw + ((size_t)(b * NH + grp) * SEQ + s) * 128 + (ch & 15) * 8;
#pragma unroll
          for (int i = 0; i < 8; ++i) wl[i] = (!act) ? (u32x4){0u, 0u, 0u, 0u} : (isrope ? kr : *(const u32x4*)(src0 + (size_t)i * 2 * SEQ * 128)); }
#pragma unroll
        for (int i = 0; i < 8; ++i) { const int h = 2 * i + grp; const u32x4 w = wl[i];
            float x[8], ss = 0.f;
#pragma unroll
            for (int q = 0; q < 4; ++q) { x[2 * q] = bflo(w[q]); x[2 * q + 1] = bfhi(w[q]); }
#pragma unroll
            for (int j = 0; j < 8; ++j) ss += x[j] * x[j];
            const float s0 = wave_sum(grp == 0 ? ss : 0.f), s1 = wave_sum(grp == 1 ? ss : 0.f);
            const float rn = 1.0f / sqrtf((grp == 0 ? s0 : s1) * (1.0f / DQK) + EPS);
            float y[8];
#pragma unroll
            for (int j = 0; j < 8; ++j) y[j] = x[j] * rn * g[j];
#pragma unroll
            for (int j = 0; j < 8; ++j) { const float partner = __shfl_xor(y[j], 4); y[j] = x2half ? (y[j] * cs[j] + partner * sn[j]) : (y[j] * cs[j] - partner * sn[j]); }
            if (act) { u32x4 o; o.x = pk2(y[0], y[1]); o.y = pk2(y[2], y[3]); o.z = pk2(y[4], y[5]); o.w = pk2(y[6], y[7]);
                *(u32x4*)(Kn + ((size_t)(b * NH + h) * SEQ + s) * DQK + ch * 8) = o; }
        }
    }
}

__device__ __forceinline__ void p3_scan(const Args& a, const Frame& F) {
    FRAME_IDS(F);
    const float* sch = (const float*)(F.ws + WS_SCH); bf16_t* apack = (bf16_t*)(F.ws + WS_APACK); const float2* A16 = (const float2*)(F.ws + WS_SMALL + SM_A16);
    const int p = F_lane;
    for (int it = F.wave * F.G + F.bx; it < NB * S5G; it += F.G * NWAVES) { const int b = it / S5G, g = it % S5G;
        const float2 am = A16[g * 64 + p]; float xr = 0.f, xi = 0.f;
        const size_t row0 = (size_t)g * NCHUNK + (size_t)b * 128;
        for (int c0 = 0; c0 < 128; c0 += 32) { float sr[32], si[32];
#pragma unroll
            for (int q = 0; q < 32; ++q) { sr[q] = sch[(row0 + c0 + q) * 128 + p]; si[q] = sch[(row0 + c0 + q) * 128 + 64 + p]; }
#pragma unroll
            for (int q = 0; q < 32; ++q) { bf16_t* o = apack + (row0 + c0 + q) * APK + 256; o[p] = (bf16_t)f2bf(xr); o[64 + p] = (bf16_t)f2bf(xi);
                const float nr = am.x * xr - am.y * xi + sr[q], ni = am.x * xi + am.y * xr + si[q]; xr = nr; xi = ni; } }
    }
}

__device__ __forceinline__ void s5_reference(const Args& a, const Frame& F) {
    FRAME_IDS(F);
    const bf16_t* apack = (const bf16_t*)(F.ws + WS_APACK); bf16_t* gact = (bf16_t*)(F.ws + WS_GACT);
    const int gw = F.bx * NWAVES + F.wave, NGW = F.G * NWAVES, p = F_lane;
    for (int it = gw; it < NB * S5G; it += NGW) { const int b = it / S5G, g = it % S5G;
        const float dt = expf(a.in[I_LOGDT][g]); const float lr = a.in[I_LRE][g * 64 + p], li = a.in[I_LIM][g * 64 + p];
        const float mag = expf(lr * dt); const float ar = mag * cosf(li * dt), ai = mag * sinf(li * dt); const float den = lr * lr + li * li;
        const float zr = ((ar - 1.0f) * lr + ai * li) / den, zi = (ai * lr - (ar - 1.0f) * li) / den;
        float bbr[16], bbi[16], cr[16], ci[16];
#pragma unroll
        for (int c = 0; c < 16; ++c) { const float br = a.in[I_BRE][((size_t)g * 64 + p) * 16 + c], bi = a.in[I_BIM][((size_t)g * 64 + p) * 16 + c];
            bbr[c] = zr * br - zi * bi; bbi[c] = zr * bi + zi * br; cr[c] = a.in[I_CRE][((size_t)g * 16 + c) * 64 + p]; ci[c] = a.in[I_CIM][((size_t)g * 16 + c) * 64 + p]; }
        const float dl = (p < 16) ? a.in[I_S5D][g * 16 + p] : 0.f;
        float xr = 0.f, xi = 0.f;
        for (int t = 0; t < SEQ; ++t) { const int tok = b * SEQ + t;
            const bf16_t* up = apack + ((size_t)g * NCHUNK + (tok >> 4)) * APK + (tok & 15) * 16;
            const u32x4 w0 = *(const u32x4*)up, w1 = *(const u32x4*)(up + 8); float u[16];
#pragma unroll
            for (int q = 0; q < 4; ++q) { u[2 * q] = bflo(w0[q]); u[2 * q + 1] = bfhi(w0[q]); u[8 + 2 * q] = bflo(w1[q]); u[8 + 2 * q + 1] = bfhi(w1[q]); }
            float br = 0.f, bi = 0.f;
#pragma unroll
            for (int c = 0; c < 16; ++c) { br += bbr[c] * u[c]; bi += bbi[c] * u[c]; }
            const float nr = ar * xr - ai * xi + br, ni = ar * xi + ai * xr + bi; xr = nr; xi = ni;
            float y = 0.f, um = 0.f;
#pragma unroll
            for (int c = 0; c < 16; ++c) { const float yc = wave_sum(cr[c] * xr - ci[c] * xi); if (p == c) { y = yc; um = u[c]; } }
            if (p < 16) gact[(size_t)tok * S5W + g * 16 + p] = (bf16_t)f2bf(gelu_tanh(y + dl * um));
        }
    }
}

__device__ __forceinline__ float attn_bound(const Args& a, int lane) {
    float mq = 0.f, mk = 0.f;
#pragma unroll
    for (int q = 0; q < 3; ++q) { mq = fmaxf(mq, fabsf(a.in[I_QKQG][lane + 64 * q])); mk = fmaxf(mk, fabsf(a.in[I_QKKG][lane + 64 * q])); }
#pragma unroll
    for (int o = 1; o < 64; o <<= 1) { mq = fmaxf(mq, __shfl_xor(mq, o)); mk = fmaxf(mk, __shfl_xor(mk, o)); }
    return mq * mk * 13.856406460551018f * 1.4426950408889634f;
}
__device__ __forceinline__ void attn_reference(const Args& a, const Frame& F) {
    FRAME_IDS(F);
    const bf16_t* Qn = (const bf16_t*)(F.ws + WS_QN); const bf16_t* Kn = (const bf16_t*)(F.ws + WS_KN); const bf16_t* Vn = (const bf16_t*)(F.ws + WS_VN);
    bf16_t* O = (bf16_t*)(F.ws + WS_O);
    LAS float* ql = (LAS float*)(F.lds + F.wave * 1024);
    const int lane = F_lane, gw = F.bx * NWAVES + F.wave, NGW = F.G * NWAVES;
    const float Mb = attn_bound(a, lane);
    for (int it = gw; it < NB * NH * SEQ; it += NGW) { const int s = it & 2047, bh = it >> 11, b = bh >> 4, h = bh & 15;
        const bf16_t* qp = Qn + ((size_t)bh * SEQ + s) * DQK;
#pragma unroll
        for (int q = 0; q < 3; ++q) ql[lane + 64 * q] = bf2f(qp[lane + 64 * q]);
        LDS_WAIT();
        const int nk = 64 * ((s >> 6) + 1);
        float o0 = 0.f, o1 = 0.f, l = 0.f;
        for (int k0 = 0; k0 < nk; k0 += 64) {
            const bf16_t* kp = Kn + ((size_t)bh * SEQ + k0 + lane) * DQK; float sc = 0.f;
            for (int d = 0; d < DQK; d += 8) { const u32x4 w = *(const u32x4*)(kp + d);
#pragma unroll
                for (int q = 0; q < 4; ++q) sc += bflo(w[q]) * ql[d + 2 * q] + bfhi(w[q]) * ql[d + 2 * q + 1]; }
            const float pr = __builtin_amdgcn_exp2f(sc - Mb); l += pr;
            for (int kk = 0; kk < 64; ++kk) { const float pk = __shfl(pr, kk); const unsigned w = *(const unsigned*)(Vn + ((size_t)bh * SEQ + k0 + kk) * DV + 2 * lane);
                o0 += pk * bflo(w); o1 += pk * bfhi(w); }
        }
        l = wave_sum(l); const float rl = 1.0f / l;
        *(unsigned*)(O + ((size_t)(b * SEQ + s)) * DM + h * DV + 2 * lane) = pk2(o0 * rl, o1 * rl);
        LDS_WAIT();
    }
}

namespace at {
constexpr int KVB = 64;
constexpr int SHM_V = KVB * DV * 2  , SHM_K = KVB * DQK * 2  ;
constexpr int NQR = 4;
constexpr int OFF_V = 0, OFF_K = 2 * SHM_V, OFF_WS = OFF_K + 2 * SHM_K  , OFF_QL = OFF_WS + NWAVES * 256  , OFF_OST = 0;
constexpr int OPITCH = 272;
static_assert(OFF_QL + NWAVES * (12 - NQR) * 1024 <= LDSCTL_OFF, "attention LDS map");
#define KSWZ(row, colB) ((row) * 384 + ((colB) ^ ((((row) >> 1) & 7) << 4)))
__device__ __forceinline__ int crow(int r, int hi) { return (r & 3) + 8 * (r >> 2) + 4 * hi; }
__device__ __forceinline__ int v_st(int k, int c) { const int kk = (k & ~0xC) | ((k & 4) << 1) | ((k & 8) >> 1); return ((kk >> 3) * 4 + (c >> 5)) * 512 + ((kk & 7) * 32 + (c & 31)) * 2; }
__device__ __forceinline__ int v_rd_base(int lane) { return ((lane & 3) << 3) | (((lane >> 2) & 3) << 6) | (((lane >> 4) & 1) << 5) | (((lane >> 5) & 1) << 8); }
constexpr int v_rd_off(int d0, int ks, int half) { return d0 * 512 + ks * 4096 + half * 2048; }
template <int OFF> __device__ __forceinline__ s16x4 tr_read(int vb) { s16x4 r; asm volatile("ds_read_b64_tr_b16 %0, %1 offset:%2" : "=&v"(r) : "v"(vb), "i"(OFF) : "memory"); return r; }
template <int D0> __device__ __forceinline__ void pv_one(f32x16& od, int vb, bf16x8 pa0, bf16x8 pa1, bf16x8 pa2, bf16x8 pa3) {
    const s16x4 l0 = tr_read<v_rd_off(D0, 0, 0)>(vb), h0 = tr_read<v_rd_off(D0, 0, 1)>(vb), l1 = tr_read<v_rd_off(D0, 1, 0)>(vb), h1 = tr_read<v_rd_off(D0, 1, 1)>(vb);
    const s16x4 l2 = tr_read<v_rd_off(D0, 2, 0)>(vb), h2 = tr_read<v_rd_off(D0, 2, 1)>(vb), l3 = tr_read<v_rd_off(D0, 3, 0)>(vb), h3 = tr_read<v_rd_off(D0, 3, 1)>(vb);
    asm volatile("s_waitcnt lgkmcnt(0)" ::: "memory"); SBAR();
#define PK(L, H) (bf16x8){L[0], L[1], L[2], L[3], H[0], H[1], H[2], H[3]}
    od = __builtin_amdgcn_mfma_f32_32x32x16_bf16(pa0, PK(l0, h0), od, 0, 0, 0);
    od = __builtin_amdgcn_mfma_f32_32x32x16_bf16(pa1, PK(l1, h1), od, 0, 0, 0);
    od = __builtin_amdgcn_mfma_f32_32x32x16_bf16(pa2, PK(l2, h2), od, 0, 0, 0);
    od = __builtin_amdgcn_mfma_f32_32x32x16_bf16(pa3, PK(l3, h3), od, 0, 0, 0);
#undef PK
}
__device__ __forceinline__ void pv_d0(f32x16* o, int vb, bf16x8 pa0, bf16x8 pa1, bf16x8 pa2, bf16x8 pa3) {
    pv_one<0>(o[0], vb, pa0, pa1, pa2, pa3); pv_one<1>(o[1], vb, pa0, pa1, pa2, pa3); pv_one<2>(o[2], vb, pa0, pa1, pa2, pa3); pv_one<3>(o[3], vb, pa0, pa1, pa2, pa3);
}
template <int BUF, int NQR> __device__ __forceinline__ void qkt(f32x16& p0, f32x16& p1, const int (&kb)[4], const bf16x8* qr, int qlb) {
    p0 = f32x16{}; p1 = f32x16{};
#pragma unroll
    for (int a = 0; a < 3; ++a)
#pragma unroll
        for (int b = 0; b < 4; ++b) { const int d0 = 4 * a + b;
            const bf16x8 b0 = *(const LAS bf16x8*)(kb[b] + BUF * SHM_K + a * 128);
            const bf16x8 b1 = *(const LAS bf16x8*)(kb[b] + BUF * SHM_K + a * 128 + 32 * 384);
            bf16x8 q; if (d0 < NQR) q = qr[d0]; else q = *(const LAS bf16x8*)(qlb + (d0 - NQR) * 1024);
            p0 = __builtin_amdgcn_mfma_f32_32x32x16_bf16(b0, q, p0, 0, 0, 0);
            p1 = __builtin_amdgcn_mfma_f32_32x32x16_bf16(b1, q, p1, 0, 0, 0); }
}
__device__ __forceinline__ void partialSM(f32x16& p0, f32x16& p1, float bias) {
#pragma unroll
    for (int r = 0; r < 16; ++r) p0[r] = __builtin_amdgcn_exp2f(p0[r] + bias);
#pragma unroll
    for (int r = 0; r < 16; ++r) p1[r] = p1[r] + bias;
}
__device__ __forceinline__ void finishSM(f32x16& p0, f32x16& p1, float& l_reg, bf16x8& pa0, bf16x8& pa1, bf16x8& pa2, bf16x8& pa3) {
#pragma unroll
    for (int r = 0; r < 16; ++r) p1[r] = __builtin_amdgcn_exp2f(p1[r]);
    float ps = 0;
#pragma unroll
    for (int r = 0; r < 16; ++r) ps += p0[r];
#pragma unroll
    for (int r = 0; r < 16; ++r) ps += p1[r];
    { auto rr = __builtin_amdgcn_permlane32_swap(__float_as_uint(ps), __float_as_uint(ps), false, false); ps = __uint_as_float(rr[0]) + __uint_as_float(rr[1]); }
    l_reg += ps;
#define PK4(P, BASE, OUT) do { unsigned a0 = cvt_pk_bf16(P[BASE + 0], P[BASE + 1]), a1 = cvt_pk_bf16(P[BASE + 2], P[BASE + 3]);   \
    unsigned b0 = cvt_pk_bf16(P[BASE + 4], P[BASE + 5]), b1 = cvt_pk_bf16(P[BASE + 6], P[BASE + 7]);                              \
    auto r0 = __builtin_amdgcn_permlane32_swap(a0, b0, false, false); auto r1 = __builtin_amdgcn_permlane32_swap(a1, b1, false, false); \
    u32x4 w = {r0[0], r1[0], r0[1], r1[1]}; OUT = *reinterpret_cast<bf16x8*>(&w); } while (0)
    PK4(p0, 0, pa0); PK4(p0, 8, pa1); PK4(p1, 0, pa2); PK4(p1, 8, pa3);
#undef PK4
}
__device__ __forceinline__ void attn_qblock(const bf16_t* __restrict__ Qb, const bf16_t* __restrict__ Kh, const bf16_t* __restrict__ Vh, bf16_t* __restrict__ Ob, int qb, float Mb, LAS char* lds, const int wid,
                                            const float2* __restrict__ ropeb, const float* __restrict__ gq) {
    const int lane = fresh_lane(), tid = wid * 64 + lane, r32 = lane & 31, hi = lane >> 5;
    LAS char* V_lds = lds + OFF_V; LAS char* K_lds = lds + OFF_K;
    LAS float* li_l = (LAS float*)(lds + OFF_WS) + wid * 64;
    float l_reg = 0; f32x16 o[4] = {}; bf16x8 qr[NQR];
    const int qlb = (int)(uintptr_t)(lds + OFF_QL) + wid * ((12 - NQR) * 1024) + lane * 16;
    {
        const bf16_t* Qw = Qb + (size_t)(wid * 32 + r32) * (NH * DQK) + hi * 8;
        bf16x8 qf[12];
#pragma unroll
        for (int d0 = 0; d0 < 12; ++d0) qf[d0] = *(const bf16x8*)(Qw + d0 * 16);
        float ssq = 0.f;
#pragma unroll
        for (int d0 = 0; d0 < 12; ++d0)
#pragma unroll
            for (int j = 0; j < 8; ++j) { const float v = bf2f((unsigned short)qf[d0][j]); ssq += v * v; }
        ssq += __shfl_xor(ssq, 32);
        const float rn = QSCALE / sqrtf(ssq * (1.0f / DQK) + EPS);
        const float2* rp = ropeb + (size_t)(wid * 32 + r32) * 32 + hi * 8;
#pragma unroll
        for (int d0 = 0; d0 < 12; ++d0) { bf16x8 qn;
            if (d0 < 8) { const f32x4 g0 = *(const f32x4*)(gq + d0 * 16 + hi * 8), g1 = *(const f32x4*)(gq + d0 * 16 + hi * 8 + 4);
#pragma unroll
                for (int j = 0; j < 8; ++j) qn[j] = (short)f2bf(bf2f((unsigned short)qf[d0][j]) * rn * (j < 4 ? g0[j] : g1[j - 4])); }
            else { const int pp = (d0 - 8) & 1, da = 8 + pp, db = 10 + pp; const bool second = d0 >= 10;
#pragma unroll
                for (int j = 0; j < 8; ++j) { const float2 c = rp[pp * 16 + j];
                    const float y1 = bf2f((unsigned short)qf[da][j]) * rn * gq[128 + pp * 16 + hi * 8 + j], y2 = bf2f((unsigned short)qf[db][j]) * rn * gq[160 + pp * 16 + hi * 8 + j];
                    qn[j] = (short)f2bf(second ? (y2 * c.x + y1 * c.y) : (y1 * c.x - y2 * c.y)); } }
            if (d0 < NQR) qr[d0] = qn; else *(LAS bf16x8*)(qlb + (d0 - NQR) * 1024) = qn; }
    }
    const int sr = tid >> 4, sc = (tid & 15) * 8, vst0 = v_st(sr, sc), vst1 = v_st(32 + sr, sc);
    int kro[3], kst[3];
#pragma unroll
    for (int i = 0; i < 3; ++i) { const int q = tid + 512 * i, row = q / 24, c8 = q % 24; kro[i] = row * DQK + c8 * 8; kst[i] = KSWZ(row, c8 * 16); }
    const int vb0 = (int)(uintptr_t)V_lds + v_rd_base(lane);
    int kb[4];
#pragma unroll
    for (int b = 0; b < 4; ++b) kb[b] = (int)(uintptr_t)K_lds + r32 * 384 + ((b * 32 + hi * 16) ^ (((r32 >> 1) & 7) << 4));
    bf16x8 vs0, vs1, ks0, ks1, ks2;
#define SLOAD(k0) do { vs0 = *(const bf16x8*)(Vh + (size_t)((k0) + sr) * DV + sc); vs1 = *(const bf16x8*)(Vh + (size_t)((k0) + 32 + sr) * DV + sc); \
    ks0 = *(const bf16x8*)(Kh + (size_t)(k0) * DQK + kro[0]); ks1 = *(const bf16x8*)(Kh + (size_t)(k0) * DQK + kro[1]); ks2 = *(const bf16x8*)(Kh + (size_t)(k0) * DQK + kro[2]); } while (0)
#define SWRITE(b) do { *(LAS bf16x8*)(V_lds + (b) * SHM_V + vst0) = vs0; *(LAS bf16x8*)(V_lds + (b) * SHM_V + vst1) = vs1; \
    *(LAS bf16x8*)(K_lds + (b) * SHM_K + kst[0]) = ks0; *(LAS bf16x8*)(K_lds + (b) * SHM_K + kst[1]) = ks1; *(LAS bf16x8*)(K_lds + (b) * SHM_K + kst[2]) = ks2; } while (0)
    const int NT = 4 * qb + 4, jmax = 4 * qb + (wid >> 1);
    f32x16 pA0, pA1, pB0, pB1; bf16x8 pa0, pa1, pa2, pa3;
    SLOAD(0); asm volatile("s_waitcnt vmcnt(0)" ::: "memory"); SWRITE(0); __syncthreads();
    qkt<0, NQR>(pA0, pA1, kb, qr, qlb); partialSM(pA0, pA1, -Mb);
    SLOAD(KVB); asm volatile("s_waitcnt vmcnt(0)" ::: "memory"); SWRITE(1); __syncthreads();
    for (int j = 1; j + 1 < NT; j += 2) {
        SBAR(); if (j <= jmax) qkt<1, NQR>(pB0, pB1, kb, qr, qlb);
        if (j - 1 <= jmax) finishSM(pA0, pA1, l_reg, pa0, pa1, pa2, pa3); SBAR();
        SLOAD((j + 1) * KVB); SBAR();
        if (j - 1 <= jmax) pv_d0(o, vb0, pa0, pa1, pa2, pa3); if (j <= jmax) partialSM(pB0, pB1, -Mb);
        __syncthreads(); asm volatile("s_waitcnt vmcnt(0)" ::: "memory"); SWRITE(0);
        __syncthreads();
        SBAR(); if (j + 1 <= jmax) qkt<0, NQR>(pA0, pA1, kb, qr, qlb);
        if (j <= jmax) finishSM(pB0, pB1, l_reg, pa0, pa1, pa2, pa3); SBAR();
        SLOAD((j + 2) * KVB); SBAR();
        if (j <= jmax) pv_d0(o, vb0 + SHM_V, pa0, pa1, pa2, pa3); if (j + 1 <= jmax) partialSM(pA0, pA1, -Mb);
        __syncthreads(); asm volatile("s_waitcnt vmcnt(0)" ::: "memory"); SWRITE(1);
        __syncthreads();
    }
    SBAR(); if (NT - 1 <= jmax) qkt<1, NQR>(pB0, pB1, kb, qr, qlb);
    if (NT - 2 <= jmax) { finishSM(pA0, pA1, l_reg, pa0, pa1, pa2, pa3); SBAR(); pv_d0(o, vb0, pa0, pa1, pa2, pa3); }
    if (NT - 1 <= jmax) { partialSM(pB0, pB1, -Mb); finishSM(pB0, pB1, l_reg, pa0, pa1, pa2, pa3); SBAR(); pv_d0(o, vb0 + SHM_V, pa0, pa1, pa2, pa3); }
    __syncthreads();
    const int lane2 = fresh_lane(), r32b = lane2 & 31, hib = lane2 >> 5, wid2 = wid;
    LAS float* li2 = (LAS float*)(lds + OFF_WS) + wid2 * 64;
    if (hib == 0) li2[r32b] = l_reg; LDS_WAIT();
    LAS char* ost = lds + OFF_OST + wid2 * (32 * OPITCH) + hib * (4 * OPITCH) + r32b * 2;
#pragma unroll
    for (int r = 0; r < 16; ++r) { const int orc = (r & 3) + 8 * (r >> 2); const float rl = __builtin_amdgcn_rcpf(li2[orc + 4 * hib]);
#pragma unroll
        for (int d0 = 0; d0 < 4; ++d0) *(LAS bf16_t*)(ost + orc * OPITCH + d0 * 64) = (bf16_t)f2bf(o[d0][r] * rl); }
    LDS_WAIT();
    bf16_t* Ow = Ob + (size_t)(wid2 * 32 + (lane2 >> 4)) * DM + (lane2 & 15) * 8;
    const LAS char* ord = lds + OFF_OST + wid2 * (32 * OPITCH) + (lane2 >> 4) * OPITCH + (lane2 & 15) * 16;
#pragma unroll
    for (int i = 0; i < 8; ++i) { const u32x4 w = *(const LAS u32x4*)(ord + i * 4 * OPITCH); *(u32x4*)(Ow + (size_t)(i * 4) * DM) = w; }
    __syncthreads();
#undef SLOAD
#undef SWRITE
}
#undef KSWZ
}
__device__ __forceinline__ void p4_attention(const Args& a, const Frame& F) {
    FRAME_IDS(F);
    const bf16_t* qraw = (const bf16_t*)(F.ws + WS_QRAW); const bf16_t* Kn = (const bf16_t*)(F.ws + WS_KN); const bf16_t* Vn = (const bf16_t*)(F.ws + WS_VN);
    bf16_t* O = (bf16_t*)(F.ws + WS_O); const float2* rope = (const float2*)(F.ws + WS_ROPE);
    const float Mb = attn_bound(a, F_lane);
    for (int id = F.bx; id < NB * NH * 4; id += F.G) { const int x = id & 7, idx = id >> 3, bh = x + 8 * (idx >> 2), pr = idx & 3, b = bh >> 4, h = bh & 15;
        const bf16_t* Kh = Kn + (size_t)bh * SEQ * DQK; const bf16_t* Vh = Vn + (size_t)bh * SEQ * DV;
#pragma unroll 1
        for (int w = 0; w < 2; ++w) { const int qb = w ? pr : 7 - pr; const size_t tok0 = (size_t)b * SEQ + qb * 256;
            at::attn_qblock(qraw + tok0 * (NH * DQK) + h * DQK, Kh, Vh, O + tok0 * DM + h * DV, qb, Mb, (LAS char*)F.lds, F.wave, rope + tok0 * 32, a.in[I_QKQG]); }
    }
}

__device__ __forceinline__ void p8_norm2_router(const Args& a, const Frame& F, const float* x1) {
    FRAME_IDS(F);
    bf16_t* H2 = (bf16_t*)(F.ws + WS_H2); int* topi = (int*)(F.ws + WS_TOPI); float* topw = (float*)(F.ws + WS_TOPW);
    const float* wrp = (const float*)(F.ws + WS_SMALL + SM_WRP); const float* g2 = a.in[I_N2G];
    const int lane = F_lane, wave = F.wave, tid = F_tid, i = lane & 31, kk = lane >> 5;
    LAS uchar* xs = F.lds + wave * 8704;
    LAS float* part = (LAS float*)(F.lds + 69632);
    LAS float* ssqp = (LAS float*)(F.lds + 69632 + 33792);
    LAS float* logit = ssqp + 256;
    LAS float* rstdl = logit + 32 * 33;
    for (int tile = F.bx; tile < TT / 32; tile += F.G) {
        const int t0 = tile * 32;
        f32x16 acc = {}; float ssq = 0.f;
        for (int ch = 0; ch < 4; ++ch) { const int k0 = wave * 256 + ch * 64;
            f32x4 v[8];
#pragma unroll
            for (int j = 0; j < 8; ++j) v[j] = *(const f32x4*)(x1 + (size_t)(t0 + 4 * j + (lane >> 4)) * DM + k0 + (lane & 15) * 4);
#pragma unroll
            for (int j = 0; j < 8; ++j) *(LAS f32x4*)(xs + (4 * j + (lane >> 4)) * 272 + (lane & 15) * 16) = v[j];
            LDS_WAIT(); asm volatile("" ::: "memory");
            const float* wp = wrp + (size_t)(k0 + kk * 32) * NE + i;
#pragma unroll
            for (int s4 = 0; s4 < 8; ++s4) { const f32x4 xv = *(const LAS f32x4*)(xs + i * 272 + kk * 128 + s4 * 16);
#pragma unroll
                for (int q = 0; q < 4; ++q) { const float b = wp[(s4 * 4 + q) * NE]; acc = __builtin_amdgcn_mfma_f32_32x32x2f32(xv[q], b, acc, 0, 0, 0); ssq += xv[q] * xv[q]; } }
            LDS_WAIT(); asm volatile("" ::: "memory");
        }
#pragma unroll
        for (int r = 0; r < 16; ++r) part[(wave * 32 + (r & 3) + 8 * (r >> 2) + 4 * kk) * 33 + i] = acc[r];
        ssq += __shfl_xor(ssq, 32);
        if (kk == 0) ssqp[wave * 32 + i] = ssq;
        __syncthreads();
        { const int row = tid >> 4, e0 = (tid & 15) * 2; float s0 = 0.f, s1 = 0.f;
#pragma unroll
          for (int w = 0; w < 8; ++w) { s0 += part[(w * 32 + row) * 33 + e0]; s1 += part[(w * 32 + row) * 33 + e0 + 1]; }
          logit[row * 33 + e0] = s0; logit[row * 33 + e0 + 1] = s1;
          if (tid < 32) { float q = 0.f;
#pragma unroll
              for (int w = 0; w < 8; ++w) q += ssqp[w * 32 + tid];
              rstdl[tid] = 1.0f / sqrtf(q * (1.0f / DM) + EPS); } }
        __syncthreads();
        if (tid < 32) { const float rs = rstdl[tid]; float lg[32];
#pragma unroll
            for (int e = 0; e < 32; ++e) lg[e] = logit[tid * 33 + e] * rs + a.in[I_BR][e];
            int bi[4]; float bv[4];
#pragma unroll
            for (int k = 0; k < 4; ++k) { float m = -3.0e38f; int mi = 0;
#pragma unroll
                for (int e = 0; e < 32; ++e) { const bool used = (k > 0 && bi[0] == e) || (k > 1 && bi[1] == e) || (k > 2 && bi[2] == e); if (!used && lg[e] > m) { m = lg[e]; mi = e; } }
                bi[k] = mi; bv[k] = m; }
            const float e1 = __expf(bv[1] - bv[0]), e2 = __expf(bv[2] - bv[0]), e3 = __expf(bv[3] - bv[0]); const float rsum = 1.0f / (1.0f + e1 + e2 + e3);
            const int t = t0 + tid;
            *(int4*)(topi + 4 * t) = make_int4(bi[0], bi[1], bi[2], bi[3]); *(float4*)(topw + 4 * t) = make_float4(rsum, e1 * rsum, e2 * rsum, e3 * rsum); }
#pragma unroll 4
        for (int it = 0; it < 16; ++it) { const int idx = it * NTHREADS + tid, row = idx >> 8, c8 = (idx & 255) * 8; const float rs = rstdl[row];
            const f32x4 x0 = *(const f32x4*)(x1 + (size_t)(t0 + row) * DM + c8), x1v = *(const f32x4*)(x1 + (size_t)(t0 + row) * DM + c8 + 4);
            const f32x4 g0 = *(const f32x4*)(g2 + c8), g1 = *(const f32x4*)(g2 + c8 + 4);
#if MK_FP8_MOE
            const float rs4 = rs * FP8_ASCALE; u32x2 o; o.x = pk4_fp8(x0.x * rs4 * g0.x, x0.y * rs4 * g0.y, x0.z * rs4 * g0.z, x0.w * rs4 * g0.w); o.y = pk4_fp8(x1v.x * rs4 * g1.x, x1v.y * rs4 * g1.y, x1v.z * rs4 * g1.z, x1v.w * rs4 * g1.w);
            *(u32x2*)((uchar*)H2 + (size_t)(t0 + row) * DM + c8) = o; }
#else
            u32x4 o; o.x = pk2(x0.x * rs * g0.x, x0.y * rs * g0.y); o.y = pk2(x0.z * rs * g0.z, x0.w * rs * g0.w); o.z = pk2(x1v.x * rs * g1.x, x1v.y * rs * g1.y); o.w = pk2(x1v.z * rs * g1.z, x1v.w * rs * g1.w);
            *(u32x4*)(H2 + (size_t)(t0 + row) * DM + c8) = o; }
#endif
        __syncthreads();
    }
}

__device__ __forceinline__ void p9_routing(const Args& a, const Frame& F) {
    FRAME_IDS(F);
    const int* topi = (const int*)(F.ws + WS_TOPI); int* tpos = (int*)(F.ws + WS_TPOS); int* list = (int*)(F.ws + WS_LIST); int* counts = (int*)(F.ws + WS_SMALL + SM_COUNTS);
    LAS int* wtot = (LAS int*)F.lds;
    for (int e = F.bx; e < NE; e += F.G) {
        __syncthreads();
        const int t0 = F.wave * (TT / NWAVES);
        int cnt = 0;
        for (int i = 0; i < TT / NWAVES / 64; ++i) { const int4 ti = *(const int4*)(topi + 4 * (t0 + i * 64 + F_lane));
            const bool hit = (ti.x == e) | (ti.y == e) | (ti.z == e) | (ti.w == e); cnt += __popcll(__ballot(hit)); }
        if (F_lane == 0) wtot[F.wave] = cnt;
        __syncthreads();
        int base = 0, total = 0;
        for (int w = 0; w < NWAVES; ++w) { const int c = wtot[w]; if (w < F.wave) base += c; total += c; }
        for (int i = 0; i < TT / NWAVES / 64; ++i) { const int t = t0 + i * 64 + F_lane; const int4 ti = *(const int4*)(topi + 4 * t);
            const int k = (ti.x == e) ? 0 : (ti.y == e) ? 1 : (ti.z == e) ? 2 : (ti.w == e) ? 3 : -1;
            const unsigned long long bal = __ballot(k >= 0); const int pos = base + __popcll(bal & ((1ull << F_lane) - 1ull));
            if (k >= 0) { list[(size_t)e * TT + pos] = t; tpos[4 * t + k] = pos; }
            base += __popcll(bal); }
        for (int q = total + F_tid; q < ((total + 255) & ~255); q += NTHREADS) list[(size_t)e * TT + q] = 0;
        if (F_tid == 0) counts[e] = total;
    }
}
__device__ __forceinline__ void moe_tables(const Frame& F, LAS int* tab) {
    FRAME_IDS(F);
    const int* counts = (const int*)(F.ws + WS_SMALL + SM_COUNTS);
    __syncthreads();
    if (F_tid == 0) { int pre = 0; for (int e = 0; e < NE; ++e) { const int c = counts[e]; tab[e] = c; const int nt = (c + 255) >> 8; tab[32 + e] = nt; tab[64 + e] = pre; tab[128 + e] = nt > 0 ? ((1 << 20) + nt - 1) / nt : 0; pre += nt; } tab[96] = pre;
        unsigned used = 0u; for (int r = 0; r < NE; ++r) { int best = -1, bn = -1; for (int e = 0; e < NE; ++e) if (!((used >> e) & 1u) && tab[32 + e] > bn) { bn = tab[32 + e]; best = e; }
            used |= 1u << best; const int q = r >> 3, pos = r & 7, xx = (q & 1) ? 7 - pos : pos; tab[160 + xx * 4 + q] = best; } }
    __syncthreads();
}

__device__ __forceinline__ void p10_permute(const Args& a, const Frame& F, const LAS int* tab) {
    FRAME_IDS(F);
    constexpr size_t ROWB = MK_FP8_MOE ? DM : 2 * DM;
    const uchar* H2 = F.ws + WS_H2; uchar* XP = F.ws + WS_XPERM; const int* list = (const int*)(F.ws + WS_LIST);
    const int ntiles = tab[96];
    for (int tile = F.bx; tile < ntiles; tile += F.G) {
        int e = 0;
#pragma unroll 1
        for (int q = 1; q < NE; ++q) if (tab[64 + q] <= tile) e = q;
        const int p0 = (tile - tab[64 + e]) * 256;
        for (int r0 = F.wave * 32; r0 < F.wave * 32 + 32; r0 += 8) { int tok[8]; u32x4 v[8][ROWB / 1024];
#pragma unroll
            for (int q = 0; q < 8; ++q) tok[q] = list[(size_t)e * TT + p0 + r0 + q];
#pragma unroll
            for (int q = 0; q < 8; ++q)
#pragma unroll
                for (int c = 0; c < (int)(ROWB / 1024); ++c) v[q][c] = *(const u32x4*)(H2 + (size_t)tok[q] * ROWB + c * 1024 + F_lane * 16);
#pragma unroll
            for (int q = 0; q < 8; ++q)
#pragma unroll
                for (int c = 0; c < (int)(ROWB / 1024); ++c) *(u32x4*)(XP + ((size_t)tile * 256 + r0 + q) * ROWB + c * 1024 + F_lane * 16) = v[q][c]; }
    }
}

__device__ __forceinline__ void p12_combine(const Args& a, const Frame& F, float* out, const LAS int* tab) {
    FRAME_IDS(F);
    const bf16_t* ys = (const bf16_t*)(F.ws + WS_YSLOT); const int* topi = (const int*)(F.ws + WS_TOPI); const float* topw = (const float*)(F.ws + WS_TOPW); const int* tpos = (const int*)(F.ws + WS_TPOS);
    const int lane = F_lane, gw = F.bx * NWAVES + F.wave, NGW = F.G * NWAVES;
    for (int t = gw; t < TT; t += NGW) {
        const int4 ti = *(const int4*)(topi + 4 * t), tp = *(const int4*)(tpos + 4 * t); const float4 tw = *(const float4*)(topw + 4 * t);
        const bf16_t* r0 = ys + ((size_t)tab[64 + ti.x] * 256 + tp.x) * DM; const bf16_t* r1 = ys + ((size_t)tab[64 + ti.y] * 256 + tp.y) * DM;
        const bf16_t* r2 = ys + ((size_t)tab[64 + ti.z] * 256 + tp.z) * DM; const bf16_t* r3 = ys + ((size_t)tab[64 + ti.w] * 256 + tp.w) * DM;
        float* orow = out + (size_t)t * DM;
#pragma unroll
        for (int j = 0; j < 4; ++j) { const int c = j * 512 + lane * 8;
            const u32x4 a0 = *(const u32x4*)(r0 + c), a1 = *(const u32x4*)(r1 + c), a2 = *(const u32x4*)(r2 + c), a3 = *(const u32x4*)(r3 + c);
            f32x4 x0 = *(const f32x4*)(orow + c), x1 = *(const f32x4*)(orow + c + 4);
#pragma unroll
            for (int q = 0; q < 2; ++q) {
                x0[2 * q] += tw.x * bflo(a0[q]) + tw.y * bflo(a1[q]) + tw.z * bflo(a2[q]) + tw.w * bflo(a3[q]);
                x0[2 * q + 1] += tw.x * bfhi(a0[q]) + tw.y * bfhi(a1[q]) + tw.z * bfhi(a2[q]) + tw.w * bfhi(a3[q]);
                x1[2 * q] += tw.x * bflo(a0[2 + q]) + tw.y * bflo(a1[2 + q]) + tw.z * bflo(a2[2 + q]) + tw.w * bflo(a3[2 + q]);
                x1[2 * q + 1] += tw.x * bfhi(a0[2 + q]) + tw.y * bfhi(a1[2 + q]) + tw.z * bfhi(a2[2 + q]) + tw.w * bfhi(a3[2 + q]); }
            *(f32x4*)(orow + c) = x0; *(f32x4*)(orow + c + 4) = x1; }
    }
}

constexpr int NPHASE = 14;
__global__ void __launch_bounds__(NTHREADS, 2) mk_fwd(Args a) {
    extern __shared__ __attribute__((aligned(16))) uchar lds_raw[];
    Frame F; F.lds = (LAS uchar*)lds_raw; F.ws = a.ws; F.wave = __builtin_amdgcn_readfirstlane(threadIdx.x >> 6); F.G = gridDim.x; F.bx = blockIdx.x;
    FRAME_IDS(F);
    volatile LAS unsigned* MISC = (volatile LAS unsigned*)(F.lds + MISC_OFF);
    LAS int* tab = (LAS int*)(F.lds + LDSCTL_OFF + 512);
    for (int u = F_tid; u < (LDS_BYTES - LDSCTL_OFF) / 4; u += NTHREADS) ((LAS unsigned*)(F.lds + LDSCTL_OFF))[u] = 0u;
    __syncthreads();
    XcdBarrier bar; bar.bar = (unsigned*)(a.ws + WS_CTL) + CW_BAR; bar.x = 0; bar.st = nullptr; bar.wave = F.wave;
    const int lo = a.ph_lo, hi = a.ph_hi;
    if (hi - lo > 1) bar = xcd_barrier_post((unsigned*)(a.ws + WS_CTL) + CW_BAR, MISC + 8, F.wave);
#ifndef MK_PHASE_MASK
#define MK_PHASE_MASK 0xffff
#endif
#define IN(k) (((MK_PHASE_MASK >> (k)) & 1) && lo <= (k) && (k) < hi)
#ifdef MK_PROBE_LO
    volatile LAS unsigned long long* pr_t = (volatile LAS unsigned long long*)(F.lds + LDSCTL_OFF + 64);
#define PROBE_AT(k) do { if ((k) == MK_PROBE_LO && F.wave == 0 && fresh_lane() == 0) pr_t[0] = __builtin_amdgcn_s_memrealtime(); if ((k) == MK_PROBE_HI + 1 && F.wave == 0 && fresh_lane() == 0) pr_t[1] = __builtin_amdgcn_s_memrealtime(); } while (0)
#else
#define PROBE_AT(k) do { } while (0)
#endif
#define SEAM(k) do { if (IN(k) && IN((k) + 1)) xcd_barrier(bar); } while (0)
    LAS uchar* ring = F.lds;
    uchar* ws = a.ws;
    const int G = F.G, bx = F.bx;

    PROBE_AT(0);
    if (IN(0)) { p0_prologue(a, F); } SEAM(0); PROBE_AT(1);

    if (IN(1)) {
        gm::ProbDense P; P.init((const bf16_t*)(ws + WS_H), DM, (const bf16_t*)(ws + WS_WIN), DM, DM, TT, NPROJ, G, bx);
        EpiInProj E{(bf16_t*)(ws + WS_PROJ), (bf16_t*)(ws + WS_APACK), a.in[I_BG], (float*)(ws + WS_SSQP)};
        gm::gemm_phase<gm::ProbDense, EpiInProj, false>(ring, P, E, F.wave);
    } SEAM(1); PROBE_AT(2);

    if (IN(2)) {
        { gm::ProbDense P; P.init((const bf16_t*)(ws + WS_PROJ) + C_QLAT, NPROJ, (const bf16_t*)(ws + WS_WUQ), QLORA, QLORA, TT, NH * DQK, G, bx);
          EpiStoreScaled<0, 8, QLORA> E{(bf16_t*)(ws + WS_QRAW), NH * DQK, (const float*)(ws + WS_SSQP)}; gm::gemm_phase<gm::ProbDense, EpiStoreScaled<0, 8, QLORA>, false>(ring, P, E, F.wave); }
        { gm::ProbDense P; P.init((const bf16_t*)(ws + WS_PROJ) + C_KVLAT, NPROJ, (const bf16_t*)(ws + WS_WUKV), KVLORA, KVLORA, TT, NH * 256, G, bx);
          EpiKV E{(bf16_t*)(ws + WS_KVRAW), (bf16_t*)(ws + WS_VN), (const float*)(ws + WS_SSQP)}; gm::gemm_phase<gm::ProbDense, EpiKV, false>(ring, P, E, F.wave); }
#if MK_FAST_S5
        { ProbS5 P{(const bf16_t*)(ws + WS_APACK), (const bf16_t*)(ws + WS_WS5), APK, 256, 4, G, bx};
          EpiS5State E{(float*)(ws + WS_SCH)}; gm::gemm_phase<ProbS5, EpiS5State, false>(ring, P, E, F.wave); }
#endif
    } SEAM(2); PROBE_AT(3);

    if (IN(3)) {
#if MK_FAST_S5
        p3_scan(a, F);
#endif
        p3_prep(a, F);
    } SEAM(3); PROBE_AT(4);

    if (IN(4)) {
#if MK_FAST_S5
        { ProbS5 P{(const bf16_t*)(ws + WS_APACK), (const bf16_t*)(ws + WS_TWC), APK, APK, 6, G, bx};
          EpiS5Out E{(bf16_t*)(ws + WS_GACT)}; gm::gemm_phase<ProbS5, EpiS5Out, false>(ring, P, E, F.wave); }
#else
        s5_reference(a, F);
#endif
#if MK_FAST_ATTN
        p4_attention(a, F);
#else
        attn_reference(a, F);
#endif
    } SEAM(4); PROBE_AT(5);

    if (IN(5)) {
        { gm::ProbDense P; P.init((const bf16_t*)(ws + WS_GACT), S5W, (const bf16_t*)(ws + WS_WGLU), S5W, S5W, TT, S5W, G, bx);
          EpiSide<0> E{(bf16_t*)(ws + WS_Y2), S5W, (const bf16_t*)(ws + WS_GACT), S5W, nullptr, 0}; gm::gemm_phase<gm::ProbDense, EpiSide<0>, false>(ring, P, E, F.wave); }
        { gm::ProbDense P; P.init((const bf16_t*)(ws + WS_O), DM, (const bf16_t*)(ws + WS_WOMLA), DM, DM, TT, DM, G, bx);
          EpiSide<1> E{(bf16_t*)(ws + WS_MA), DM, (const bf16_t*)(ws + WS_PROJ) + C_GA, NPROJ, nullptr, 0}; gm::gemm_phase<gm::ProbDense, EpiSide<1>, false>(ring, P, E, F.wave); }
    } SEAM(5); PROBE_AT(6);

    if (IN(6)) {
        gm::ProbDense P; P.init((const bf16_t*)(ws + WS_Y2), S5W, (const bf16_t*)(ws + WS_WOS5), S5W, S5W, TT, DM, G, bx);
        EpiSide<2> E{(bf16_t*)(ws + WS_M), DM, (const bf16_t*)(ws + WS_PROJ) + C_GB, NPROJ, (const bf16_t*)(ws + WS_MA), DM}; gm::gemm_phase<gm::ProbDense, EpiSide<2>, false>(ring, P, E, F.wave);
    } SEAM(6); PROBE_AT(7);

    if (IN(7)) {
        gm::ProbDense P; P.init((const bf16_t*)(ws + WS_M), DM, (const bf16_t*)(ws + WS_WOUT), DM, DM, TT, DM, G, bx);
        EpiResidF32 E{a.in[I_X], a.out}; gm::gemm_phase<gm::ProbDense, EpiResidF32, false>(ring, P, E, F.wave);
    } SEAM(7); PROBE_AT(8);

    if (IN(8)) { p8_norm2_router(a, F, a.out); } SEAM(8); PROBE_AT(9);
    if (IN(9)) { p9_routing(a, F); } SEAM(9); PROBE_AT(10);

    if (IN(10) || IN(11) || IN(12) || IN(13)) moe_tables(F, tab);
    const int xl = bx & 7, rk = bx >> 3, nrk = (G - xl + 7) >> 3;
    if (IN(10)) { p10_permute(a, F, tab); } SEAM(10); PROBE_AT(11);
    if (IN(11)) {
        ProbMoE P{(const bf16_t*)(ws + WS_XPERM), (const bf16_t*)(ws + WS_W1), DM, DM, MK_FP8_MOE ? DM / 128 : DM / 64, 16, (size_t)4096 * DM, xl, rk, nrk}; P.load(tab);
        EpiSwiglu E{(bf16_t*)(ws + WS_HACT), a.in[I_BGATE], a.in[I_BUP], tab}; gm::gemm_phase<ProbMoE, EpiSwiglu, false, MK_FP8_MOE != 0>(ring, P, E, F.wave);
    } SEAM(11); PROBE_AT(12);
    if (IN(12)) {
        ProbMoE P{(const bf16_t*)(ws + WS_HACT), (const bf16_t*)(ws + WS_W2), DFF, DFF, MK_FP8_MOE ? DFF / 128 : DFF / 64, 8, (size_t)DM * DFF, xl, rk, nrk}; P.load(tab);
        EpiDown E{(bf16_t*)(ws + WS_YSLOT), a.in[I_BDOWN], tab}; gm::gemm_phase<ProbMoE, EpiDown, false, MK_FP8_MOE != 0>(ring, P, E, F.wave);
    } SEAM(12); PROBE_AT(13);
    if (IN(13)) { p12_combine(a, F, a.out, tab); }
    PROBE_AT(14);
#ifdef MK_PROBE_LO
    if (blockIdx.x == 0 && F.wave == 0 && fresh_lane() == 0) { const unsigned long long dt = (pr_t[1] - pr_t[0]) * MK_PROBE_X, te = __builtin_amdgcn_s_memrealtime();
        while (__builtin_amdgcn_s_memrealtime() - te < dt) __builtin_amdgcn_s_sleep(32); }
#endif
#undef IN
#undef SEAM
}

extern "C" void kernel_launch(void* const* d_in, const int* in_sizes, int n_in, void* d_out, int out_size, void* d_ws, size_t ws_size, hipStream_t stream) {
    static int grid = 0;
    if (grid == 0) {
        if (n_in != 32 || in_sizes[0] != TT * DM || out_size != TT * DM || ws_size < WS_END) {
            fprintf(stderr, "kernel_launch: shape mismatch: n_in %d in0 %d out %d ws %zu (need %zu); nothing launched\n", n_in, n_in > 0 ? in_sizes[0] : -1, out_size, ws_size, (size_t)WS_END); grid = -1; return; }
        int dev = 0, cus = 0, per_cu = 0;
        if (hipGetDevice(&dev) != hipSuccess || hipDeviceGetAttribute(&cus, hipDeviceAttributeMultiprocessorCount, dev) != hipSuccess) { fprintf(stderr, "kernel_launch: device query failed\n"); grid = -1; return; }
        if (hipFuncSetAttribute((const void*)mk_fwd, hipFuncAttributeMaxDynamicSharedMemorySize, LDS_BYTES) != hipSuccess) { fprintf(stderr, "kernel_launch: hipFuncSetAttribute failed\n"); grid = -1; return; }
        if (hipOccupancyMaxActiveBlocksPerMultiprocessor(&per_cu, (const void*)mk_fwd, NTHREADS, LDS_BYTES) != hipSuccess || per_cu < 1)
            fprintf(stderr, "kernel_launch: note: occupancy query reports %d workgroups per CU\n", per_cu);
        (void)hipGetLastError();
        grid = cus - (cus % 8);
        if (grid < 8) grid = 8;
    }
    if (grid < 0) return;
    if (hipMemsetAsync((char*)d_ws + WS_CTL, 0, CTL_ZERO_BYTES, stream) != hipSuccess) { fprintf(stderr, "kernel_launch: memset failed\n"); return; }
    Args a{};
    for (int i = 0; i < 32; ++i) a.in[i] = (const float*)d_in[i];
    a.out = (float*)d_out; a.ws = (uchar*)d_ws;
#if MK_ONE_LAUNCH
    a.ph_lo = 0; a.ph_hi = NPHASE;
    hipLaunchKernelGGL(mk_fwd, dim3(grid), dim3(NTHREADS), LDS_BYTES, stream, a);
#else
    for (int p = 0; p < NPHASE; ++p) { a.ph_lo = p; a.ph_hi = p + 1; hipLaunchKernelGGL(mk_fwd, dim3(grid), dim3(NTHREADS), LDS_BYTES, stream, a); }
#endif
    const hipError_t le = hipPeekAtLastError();
    if (le != hipSuccess) fprintf(stderr, "kernel_launch: launch failed: %s\n", hipGetErrorName(le));
}
```

```cpp
#include <hip/hip_runtime.h>
#include <cstdio>
#include <cstdint>

#ifndef MK_ONE_LAUNCH
#define MK_ONE_LAUNCH 1
#endif
#ifndef MK_FAST_GEMM
#define MK_FAST_GEMM 1
#endif
#ifndef MK_FAST_ATTN
#define MK_FAST_ATTN 1
#endif
#ifndef MK_FAST_S5
#define MK_FAST_S5 1
#endif

#ifndef MK_FP8_MOE
#define MK_FP8_MOE 1
#endif
#define LAS __attribute__((address_space(3)))
#define GAS __attribute__((address_space(1)))
typedef unsigned short bf16_t;
typedef short bf16x8 __attribute__((ext_vector_type(8)));
typedef short s16x4 __attribute__((ext_vector_type(4)));
typedef float f32x2 __attribute__((ext_vector_type(2)));
typedef float f32x4 __attribute__((ext_vector_type(4)));
typedef float f32x16 __attribute__((ext_vector_type(16)));
typedef unsigned u32x2 __attribute__((ext_vector_type(2)));
typedef unsigned u32x4 __attribute__((ext_vector_type(4)));
typedef unsigned char uchar;
typedef int v4i __attribute__((ext_vector_type(4)));
typedef int v8i __attribute__((ext_vector_type(8)));
constexpr float FP8_ASCALE = 4.0f, FP8_WSCALE = 64.0f;
__device__ __forceinline__ unsigned pk4_fp8(float a, float b, float c, float d) { int w = __builtin_amdgcn_cvt_pk_fp8_f32(a, b, 0, false); w = __builtin_amdgcn_cvt_pk_fp8_f32(c, d, w, true); return (unsigned)w; }

constexpr int NB = 8, SEQ = 2048, TT = NB * SEQ, DM = 2048;
constexpr int NH = 16, DNOPE = 128, DROPE = 64, DQK = 192, DV = 128, QLORA = 512, KVLORA = 256;
constexpr int S5W = 1024, S5G = 64, S5C = 16, S5P = 64, S5L = 16;
constexpr int NE = 32, TOPK = 4, DFF = 2048;
constexpr int IN_PROJ = QLORA + KVLORA + DROPE + S5W + 2 * DM;
constexpr int NPROJ = 6144;
constexpr int C_QLAT = 0, C_KVLAT = 512, C_U = 768, C_GA = 1792, C_GB = 3840, C_KR = 5888;
constexpr float EPS = 1e-6f;
constexpr int MAXSLOT_TILES = (TT * TOPK) / 256 + NE;
constexpr int MAXSLOTS = MAXSLOT_TILES * 256;
constexpr int NCHUNK = TT / S5L;
constexpr int APK = 384;

constexpr size_t MiB = 1u << 20;
constexpr size_t WS_CTL = 0, CTL_ZERO_BYTES = 1 * MiB;
constexpr size_t WS_WIN = 1 * MiB;
constexpr size_t WS_WUQ = WS_WIN + 24 * MiB;
constexpr size_t WS_WUKV = WS_WUQ + 3 * MiB;
constexpr size_t WS_WOMLA = WS_WUKV + 2 * MiB;
constexpr size_t WS_WGLU = WS_WOMLA + 8 * MiB;
constexpr size_t WS_WOS5 = WS_WGLU + 2 * MiB;
constexpr size_t WS_WOUT = WS_WOS5 + 4 * MiB;
constexpr size_t WS_TWC = WS_WOUT + 8 * MiB;
constexpr size_t WS_WS5 = WS_TWC + 12 * MiB;
constexpr size_t WS_ROPE = WS_WS5 + 8 * MiB;
constexpr size_t WS_SMALL = WS_ROPE + 4 * MiB;
constexpr size_t WS_W1 = WS_SMALL + 1 * MiB;
constexpr size_t WS_W2 = WS_W1 + 512 * MiB;
constexpr size_t WS_ACT = WS_W2 + 256 * MiB;
constexpr size_t WS_H = WS_ACT;
constexpr size_t WS_PROJ = WS_H + 64 * MiB;
constexpr size_t WS_APACK = WS_PROJ + 192 * MiB;
constexpr size_t WS_SCH = WS_APACK + 48 * MiB;
constexpr size_t WS_QRAW = WS_SCH + 32 * MiB;
constexpr size_t WS_KVRAW = WS_QRAW + 96 * MiB;
constexpr size_t WS_QN = WS_KVRAW + 128 * MiB;
constexpr size_t WS_KN = WS_QN + 96 * MiB;
constexpr size_t WS_VN = WS_KN + 96 * MiB;
constexpr size_t WS_O = WS_VN + 64 * MiB;
constexpr size_t WS_GACT = WS_O + 64 * MiB;
constexpr size_t WS_Y2 = WS_GACT + 32 * MiB;
constexpr size_t WS_MA = WS_Y2 + 32 * MiB;
constexpr size_t WS_M = WS_MA + 64 * MiB;
constexpr size_t WS_SSQP = WS_M + 64 * MiB;
constexpr size_t WS_ENDA = WS_SSQP + 1 * MiB;
constexpr size_t WS_H2 = WS_ACT;
constexpr size_t WS_HACT = WS_H2 + 64 * MiB;
constexpr size_t WS_YSLOT = WS_HACT + 288 * MiB;
constexpr size_t WS_TOPI = WS_YSLOT + 288 * MiB;
constexpr size_t WS_TOPW = WS_TOPI + 1 * MiB;
constexpr size_t WS_TPOS = WS_TOPW + 1 * MiB;
constexpr size_t WS_LIST = WS_TPOS + 1 * MiB;
constexpr size_t WS_XPERM = WS_ACT + 704 * MiB;
constexpr size_t WS_ENDB = WS_XPERM + 288 * MiB;
constexpr size_t WS_END = WS_ENDA > WS_ENDB ? WS_ENDA : WS_ENDB;
constexpr size_t SM_A16 = 0;
constexpr size_t SM_COUNTS = 64 * 1024;
constexpr size_t SM_WRP = 128 * 1024;
constexpr int CW_BAR = 4096;

constexpr int RING_BYTES = 131072;
constexpr int LDS_BYTES = 163840;
constexpr int LDSCTL_OFF = LDS_BYTES - 4096;
constexpr int MISC_OFF = LDSCTL_OFF;
constexpr int GTAB_OFF = LDSCTL_OFF + 2048;
constexpr int NWAVES = 8, NTHREADS = 512;

#define LDS_WAIT() asm volatile("s_waitcnt lgkmcnt(0)" ::: "memory")
#define VM_WAIT() asm volatile("s_waitcnt vmcnt(0)" ::: "memory")
#define SBAR() __builtin_amdgcn_sched_barrier(0)

__device__ __forceinline__ unsigned f2bf(float f) { unsigned u = __builtin_bit_cast(unsigned, f); return (u + 0x7fffu + ((u >> 16) & 1u)) >> 16; }
__device__ __forceinline__ unsigned pk2(float lo, float hi) { return f2bf(lo) | (f2bf(hi) << 16); }
__device__ __forceinline__ float bf2f(unsigned b) { return __builtin_bit_cast(float, b << 16); }
__device__ __forceinline__ float bflo(unsigned w) { return __builtin_bit_cast(float, w << 16); }
__device__ __forceinline__ float bfhi(unsigned w) { return __builtin_bit_cast(float, w & 0xffff0000u); }
__device__ __forceinline__ unsigned cvt_pk_bf16(float lo, float hi) { unsigned r; asm volatile("v_cvt_pk_bf16_f32 %0, %1, %2" : "=v"(r) : "v"(lo), "v"(hi)); return r; }
__device__ __forceinline__ float sigmoidf_(float x) { return __builtin_amdgcn_rcpf(1.0f + __builtin_amdgcn_exp2f(-1.4426950408889634f * x)); }
__device__ __forceinline__ float gelu_tanh(float x) {
    const float u = 0.7978845608028654f * (x + 0.044715f * x * x * x);
    const float e = __builtin_amdgcn_exp2f(2.8853900817779268f * u);
    const float th = 1.0f - 2.0f * __builtin_amdgcn_rcpf(e + 1.0f);
    return 0.5f * x * (1.0f + th);
}
__device__ __forceinline__ int fresh_lane() { int z = 0; asm volatile("" : "+s"(z)); return (int)__builtin_amdgcn_mbcnt_hi(~0u, __builtin_amdgcn_mbcnt_lo(~0u, (unsigned)z)); }
__device__ __forceinline__ float wave_sum(float v) {
#pragma unroll
    for (int o = 1; o < 64; o <<= 1) v += __shfl_xor(v, o);
    return v;
}

#define XB_TMO      128
#define XB_XCNT(j)  (256  + 64 * (j))
#define XB_XSUB(j)  (1280 + 64 * (j))
#define XB_XGEN(j)  (2304 + 64 * (j))
#define XB_TOP      3328
#define XB_TOPGEN   3392
#define XCD_BAR_WORDS 3456
#define XB_SPIN_CAP (1u << 18)
__device__ __forceinline__ unsigned xb_ld(unsigned* p)              { return __hip_atomic_load(p, __ATOMIC_RELAXED, __HIP_MEMORY_SCOPE_AGENT); }
__device__ __forceinline__ unsigned xb_add(unsigned* p, unsigned v) { return __hip_atomic_fetch_add(p, v, __ATOMIC_RELAXED, __HIP_MEMORY_SCOPE_AGENT); }
__device__ __forceinline__ unsigned xb_xcc_id() { return (unsigned)__builtin_amdgcn_s_getreg((3 << 11) | 20) & 0xFu; }
#define XB_SPIN(cond, bar) do { unsigned _sp = 0; while (cond) { __builtin_amdgcn_s_sleep(1); \
    if ((++_sp & 255u) == 0u) { if (xb_ld(&(bar)[XB_TMO])) break; if (_sp > XB_SPIN_CAP) { atomicAdd(&(bar)[XB_TMO], 1u); break; } } } } while (0)
struct XcdBarrier { unsigned* bar; unsigned x; volatile LAS unsigned* st; int wave; };
__device__ __forceinline__ XcdBarrier xcd_barrier_post(unsigned* bar, volatile LAS unsigned* st, int wave) {
    XcdBarrier b; b.bar = bar; b.x = xb_xcc_id(); b.st = st; b.wave = wave;
    if (wave == 0 && fresh_lane() == 0) (void)xb_add(&bar[XB_XCNT(b.x)], 1u);
    return b;
}
__device__ __forceinline__ void xcd_barrier_complete(unsigned* bar, unsigned x, unsigned& nloc, unsigned& nx) {
    const unsigned G = gridDim.x * gridDim.y * gridDim.z;
    unsigned sum, cnt, mine, sp = 0u;
    for (;;) {
        sum = 0u; cnt = 0u; mine = 0u;
#pragma unroll
        for (unsigned j = 0; j < 16; ++j) { const unsigned c = xb_ld(&bar[XB_XCNT(j)]); sum += c; cnt += (c > 0u) ? 1u : 0u; mine = (j == x) ? c : mine; }
        if (sum == G) break;
        __builtin_amdgcn_s_sleep(1);
        if ((++sp & 255u) == 0u) { if (xb_ld(&bar[XB_TMO])) break; if (sp > XB_SPIN_CAP) { atomicAdd(&bar[XB_TMO], 1u); break; } }
    }
    nloc = mine > 0u ? mine : 1u; nx = cnt > 0u ? cnt : 1u;
}
__device__ __forceinline__ void xcd_barrier(const XcdBarrier& b) {
    asm volatile("s_waitcnt vmcnt(0)" ::: "memory");
    __syncthreads();
    if (b.wave == 0 && fresh_lane() == 0) {
        unsigned* bar = b.bar;
        __builtin_amdgcn_s_waitcnt(0);
        unsigned nloc = b.st[0], nx = b.st[1];
        if (nloc == 0u) { xcd_barrier_complete(bar, b.x, nloc, nx); b.st[0] = nloc; b.st[1] = nx; }
        const unsigned old = xb_add(&bar[XB_XSUB(b.x)], 1u);
        const unsigned gen = old / nloc;
        if (old + 1u == (gen + 1u) * nloc) {
            __builtin_amdgcn_fence(__ATOMIC_RELEASE, "agent");
            asm volatile("s_waitcnt vmcnt(0)" ::: "memory");
            const unsigned og = xb_add(&bar[XB_TOP], 1u);
            const unsigned tg = og / nx;
            if (og + 1u == (tg + 1u) * nx) xb_add(&bar[XB_TOPGEN], 1u);
            else XB_SPIN(xb_ld(&bar[XB_TOPGEN]) == tg, bar);
            __builtin_amdgcn_fence(__ATOMIC_ACQUIRE, "agent");
            xb_add(&bar[XB_XGEN(b.x)], 1u);
            asm volatile("s_waitcnt vmcnt(0)" ::: "memory");
        } else {
            XB_SPIN(xb_ld(&bar[XB_XGEN(b.x)]) == gen, bar);
            __builtin_amdgcn_fence(__ATOMIC_ACQUIRE, "agent");
            asm volatile("s_waitcnt vmcnt(0)" ::: "memory");
        }
    }
    __syncthreads();
}

namespace gm {
constexpr int BM = 256, BK = 64, HALF = 128, HTB = HALF * BK * 2, STAGE_BYTES = 8 * HTB, NXCD = 8, WGM = 8;
__host__ __device__ __forceinline__ int lds_byte(int r, int c) { const int st = (r >> 4) * 2 + (c >> 5), rr = r & 15, cc = c & 31, ob = rr * 64 + cc * 2; return st * 1024 + (ob ^ (((ob >> 9) & 1) << 5)); }
__host__ __device__ __forceinline__ void stage_rc(int b, int& R, int& C) { const int st = b / 1024, sb = b % 1024, swz = sb ^ (((sb >> 9) & 1) << 5); R = (st >> 1) * 16 + swz / 64; C = (st & 1) * 32 + (swz % 64) / 2; }
__host__ __device__ __forceinline__ int perm32(int rho) { const int n = rho >> 4, i = rho & 15; return 8 * (i >> 2) + 4 * n + (i & 3); }

struct Unit { int pm, pn, g, st; };


struct ProbDense {
    const bf16_t* A; const bf16_t* B; int lda, ldb, nt; int nM, nN, nwg, G, c; const int* list = nullptr; const LAS int* gtab = nullptr;
    __device__ unsigned list_off(const Unit&) const { return 0u; }
    __device__ void init(const bf16_t* A_, int lda_, const bf16_t* B_, int ldb_, int K, int M, int N, int G_, int c_) { A = A_; B = B_; lda = lda_; ldb = ldb_; nt = K / BK; nM = M / BM; nN = N / BM; nwg = nM * nN; G = G_; c = c_; }
    __device__ bool next(int i, Unit& u) const {
        const long L = (long)i * G + c; if (L >= nwg) return false;
        int wgid = (int)L; { const int q = nwg / NXCD, r = nwg % NXCD, xcd = wgid % NXCD, off = wgid / NXCD; wgid = (xcd < r ? xcd * (q + 1) : r * (q + 1) + (xcd - r) * q) + off; }
        const int nig = WGM * nN, gid = wgid / nig, fm = gid * WGM, gsz = (nM - fm) < WGM ? (nM - fm) : WGM;
        u.pm = fm + ((wgid % nig) % gsz); u.pn = (wgid % nig) / gsz; u.g = 0; u.st = 0; return true;
    }
    __device__ size_t a_off(const Unit& u) const { return (size_t)u.pm * BM * lda; }
    __device__ size_t b_off(const Unit& u) const { return (size_t)u.pn * BM * ldb; }
    __device__ unsigned a_row(const Unit&, int) const { return 0u; }
};

#if MK_FAST_GEMM
template <class Prob, class Epi, bool GATHER, bool FP8 = false>
__device__ __forceinline__ void gemm_phase(LAS uchar* lds, const Prob& S, const Epi& E, const int wid  ) {
    constexpr unsigned ESZ = FP8 ? 1u : 2u;
    const int lane = fresh_lane(), tid = wid * 64 + lane, wr = wid >> 2, wc = wid & 3, fr = lane & 15, fq = lane >> 4;
    const int nt = S.nt;
    int Ra[2], Ca[2]; unsigned vB;
    { int R, C; stage_rc(tid * 16, R, C); const int Rb = Epi::PERM ? ((R & ~31) + perm32(R & 31)) : R; Ra[0] = R; Ca[0] = C; Ra[1] = R + 64; Ca[1] = C;
      vB = (unsigned)(Rb * S.ldb) * ESZ + (unsigned)C * 2u; }
    const unsigned dB64 = 64u * (unsigned)S.ldb * ESZ, dA64 = 64u * (unsigned)S.lda * ESZ, dA128 = 2u * dA64;
    constexpr unsigned kstep = BK * 2;
    const unsigned hstepB = (unsigned)HALF * (unsigned)S.ldb * ESZ;
    const unsigned ldsw = (unsigned)wid * 1024u;
    const int aoff = lds_byte(wr * 64 + fr, fq * 8), boff = lds_byte(wc * 32 + fr, fq * 8);
    const __amdgpu_buffer_rsrc_t srdA = __builtin_amdgcn_make_buffer_rsrc((void*)S.A, 0, 0xFFFFFFFF, 0x00020000);
    const __amdgpu_buffer_rsrc_t srdB = __builtin_amdgcn_make_buffer_rsrc((void*)S.B, 0, 0xFFFFFFFF, 0x00020000);
#define G_SA(b, h) (((b) * 2 + (h)) * HTB)
#define G_SB(b, h) ((4 + (b) * 2 + (h)) * HTB)
#define G_STAGE(bufoff, srd, soff, voff) do { _Pragma("unroll") for (int _i = 0; _i < 2; ++_i) \
        __builtin_amdgcn_raw_ptr_buffer_load_lds(srd, (LAS void*)(lds + (bufoff) + ldsw + _i * 8192), 16, (int)(voff)[_i], (int)(soff), 0, 0); } while (0)
#define G_STAGE1(bufoff, srd, soff, v1, d64) do { _Pragma("unroll") for (int _i = 0; _i < 2; ++_i) \
        __builtin_amdgcn_raw_ptr_buffer_load_lds(srd, (LAS void*)(lds + (bufoff) + ldsw + _i * 8192), 16, (int)(v1), (int)((soff) + _i * (d64)), 0, 0); } while (0)
#define G_STAGE_A(bufoff, soff, half, arr0, arr1) do { if constexpr (GATHER) { if (half) G_STAGE(bufoff, srdA, soff, arr1); else G_STAGE(bufoff, srdA, soff, arr0); } \
        else G_STAGE1(bufoff, srdA, (soff) + (half) * dA128, vA, dA64); } while (0)
#define G_LDA(dst, b, h) do { _Pragma("unroll") for (int m = 0; m < 4; ++m) _Pragma("unroll") for (int k = 0; k < 2; ++k) dst[m][k] = *(const LAS bf16x8*)(lds + G_SA(b, h) + aoff + m * 2048 + k * 1024); } while (0)
#define G_LDB(dst, b, h) do { _Pragma("unroll") for (int n = 0; n < 2; ++n) _Pragma("unroll") for (int k = 0; k < 2; ++k) dst[n][k] = *(const LAS bf16x8*)(lds + G_SB(b, h) + boff + n * 2048 + k * 1024); } while (0)
#define G_CAT(x0, x1) __builtin_shufflevector(__builtin_bit_cast(v4i, x0), __builtin_bit_cast(v4i, x1), 0, 1, 2, 3, 4, 5, 6, 7)
#define G_MMA(ai, bj, At, Bt) do { __builtin_amdgcn_s_setprio(1); _Pragma("unroll") for (int m = 0; m < 4; ++m) _Pragma("unroll") for (int n = 0; n < 2; ++n) { \
        if constexpr (FP8) acc[ai][bj][m][n] = __builtin_amdgcn_mfma_scale_f32_16x16x128_f8f6f4(G_CAT(Bt[n][0], Bt[n][1]), G_CAT(At[m][0], At[m][1]), acc[ai][bj][m][n], 0, 0, 0, 0x7f7f7f7f, 0, 0x7f7f7f7f); \
        else { _Pragma("unroll") for (int k = 0; k < 2; ++k) acc[ai][bj][m][n] = __builtin_amdgcn_mfma_f32_16x16x32_bf16(Bt[n][k], At[m][k], acc[ai][bj][m][n], 0, 0, 0); } } \
        __builtin_amdgcn_s_setprio(0); } while (0)
#define G_WAIT_V(n) asm volatile("s_waitcnt vmcnt(" #n ")" ::: "memory")
#define G_WAIT_L(n) asm volatile("s_waitcnt lgkmcnt(" #n ")" ::: "memory")
#define G_BAR __builtin_amdgcn_s_barrier()
#define G_SCHED __builtin_amdgcn_sched_barrier(0)
#define G_UNI(x) ((unsigned)__builtin_amdgcn_readfirstlane((int)(x)))
    Unit cur, nxt; int ui = 0;
    if (!S.next(0, cur)) return;
    unsigned vA0[2], vA1[2];
    unsigned cA = 0u, cB = G_UNI(S.b_off(cur) * ESZ);
    __amdgpu_buffer_rsrc_t srdL = srdA;
    if constexpr (GATHER) srdL = __builtin_amdgcn_make_buffer_rsrc((void*)S.list, 0, 0xFFFFFFFF, 0x00020000);
#define G_IDX(u_) do { if (wid < 4) __builtin_amdgcn_raw_ptr_buffer_load_lds(srdL, (LAS void*)(S.gtab + wid * 64), 4, lane * 4, (int)G_UNI(S.list_off(u_) * 4u) + wid * 256, 0, 0); } while (0)
    const int gR = (int)(uintptr_t)S.gtab + Ra[0] * 4; const unsigned gC = (unsigned)Ca[0] * 2u;
#define G_ROWS(o0, o1) do { const LAS int* _g = (const LAS int*)gR; const unsigned _ls = (unsigned)S.lda * ESZ; \
        o0[0] = (unsigned)_g[0] * _ls + gC; o0[1] = (unsigned)_g[64] * _ls + gC; o1[0] = (unsigned)_g[128] * _ls + gC; o1[1] = (unsigned)_g[192] * _ls + gC; } while (0)
    if constexpr (GATHER) { G_IDX(cur); G_WAIT_V(0); G_BAR; G_ROWS(vA0, vA1); G_WAIT_L(0); G_BAR; }
    else { cA = G_UNI(S.a_off(cur) * ESZ);
#pragma unroll
        for (int i = 0; i < 2; ++i) { vA0[i] = 0u; vA1[i] = 0u; } }
    const unsigned vA = (unsigned)(Ra[0] * S.lda) * ESZ + (unsigned)Ca[0] * 2u;
    G_STAGE1(G_SB(0, 0), srdB, cB, vB, dB64); G_STAGE_A(G_SA(0, 0), cA, 0, vA0, vA1); G_STAGE1(G_SB(0, 1), srdB, cB + hstepB, vB, dB64); G_STAGE_A(G_SA(0, 1), cA, 1, vA0, vA1);
    if (wr == 1) G_BAR;
    G_WAIT_V(4); G_BAR;
    G_STAGE1(G_SB(1, 0), srdB, cB + kstep, vB, dB64); G_STAGE_A(G_SA(1, 0), cA + kstep, 0, vA0, vA1); G_STAGE1(G_SB(1, 1), srdB, cB + hstepB + kstep, vB, dB64);
    G_WAIT_V(6); G_BAR;
    f32x4 acc[2][2][4][2];
#pragma unroll
    for (int a = 0; a < 2; ++a)
#pragma unroll
        for (int b = 0; b < 2; ++b)
#pragma unroll
            for (int m = 0; m < 4; ++m)
#pragma unroll
                for (int n = 0; n < 2; ++n) acc[a][b][m][n] = (f32x4){0.f, 0.f, 0.f, 0.f};
    bf16x8 At[4][2], B0[2][2], B1[2][2];
    for (;;) {
        const bool has_next = S.next(ui + 1, nxt);
        unsigned nA = cA, nB = cB; unsigned x0[2] = {0u, 0u}, x1[2] = {0u, 0u};
        if (has_next) { nB = G_UNI(S.b_off(nxt) * ESZ);
            if constexpr (GATHER) G_IDX(nxt);
            else nA = G_UNI(S.a_off(nxt) * ESZ);
        }
#define G_TRIP(LAST) do { \
            const unsigned a1 = cA + (unsigned)(t + 1) * kstep; \
            const unsigned a2 = (LAST) ? nA : cA + (unsigned)(t + 2) * kstep, b2 = (LAST) ? nB : cB + (unsigned)(t + 2) * kstep; \
            const unsigned a3 = a2 + kstep, b3 = b2 + kstep; \
            unsigned w0[2], w1[2]; \
            _Pragma("unroll") for (int i = 0; i < 2; ++i) { w0[i] = vA0[i]; w1[i] = vA1[i]; } \
            if constexpr (GATHER) { if ((LAST) && has_next) { G_ROWS(w0, w1); _Pragma("unroll") for (int i = 0; i < 2; ++i) { x0[i] = w0[i]; x1[i] = w1[i]; } } } \
              G_LDB(B0, 0, 0); G_SCHED; G_LDA(At, 0, 0); G_STAGE_A(G_SA(1, 1), a1, 1, vA0, vA1); \
            G_WAIT_L(8); G_BAR; G_WAIT_L(0); G_MMA(0, 0, At, B0); G_BAR; G_SCHED; \
              G_LDB(B1, 0, 1); G_STAGE1(G_SB(0, 0), srdB, b2, vB, dB64); \
            G_BAR; G_WAIT_L(0); G_MMA(0, 1, At, B1); G_BAR; \
              G_LDA(At, 0, 1); G_STAGE_A(G_SA(0, 0), a2, 0, w0, w1); \
            G_BAR; G_WAIT_L(0); G_MMA(1, 0, At, B0); G_BAR; G_SCHED; \
              G_STAGE1(G_SB(0, 1), srdB, b2 + hstepB, vB, dB64); \
            G_WAIT_V(6); G_BAR; G_MMA(1, 1, At, B1); G_BAR; \
              G_LDB(B0, 1, 0); G_SCHED; G_LDA(At, 1, 0); G_STAGE_A(G_SA(0, 1), a2, 1, w0, w1); \
            G_WAIT_L(8); G_BAR; G_WAIT_L(0); G_MMA(0, 0, At, B0); G_BAR; G_SCHED; \
              G_LDB(B1, 1, 1); G_STAGE1(G_SB(1, 0), srdB, b3, vB, dB64); \
            G_BAR; G_WAIT_L(0); G_MMA(0, 1, At, B1); G_BAR; \
              G_LDA(At, 1, 1); G_STAGE_A(G_SA(1, 0), a3, 0, w0, w1); \
            G_BAR; G_WAIT_L(0); G_MMA(1, 0, At, B0); G_BAR; G_SCHED; \
              G_STAGE1(G_SB(1, 1), srdB, b3 + hstepB, vB, dB64); \
            G_WAIT_V(6); G_BAR; G_MMA(1, 1, At, B1); G_BAR; } while (0)
        for (int t = 0; t < nt; t += 2) { const bool last = (t == nt - 2); G_TRIP(last); }
        if (wr == 0) G_BAR;
        { const int lane2 = fresh_lane();
          E(acc, cur, wid >> 2, wid & 3, lane2 & 15, lane2 >> 4); }
        if (!has_next) break;
#pragma unroll
        for (int a = 0; a < 2; ++a)
#pragma unroll
            for (int b = 0; b < 2; ++b)
#pragma unroll
                for (int m = 0; m < 4; ++m)
#pragma unroll
                    for (int n = 0; n < 2; ++n) acc[a][b][m][n] = (f32x4){0.f, 0.f, 0.f, 0.f};
        cur = nxt; cA = nA; cB = nB; ++ui;
        if (wr == 1) G_BAR;
        if constexpr (GATHER) {
#pragma unroll
            for (int i = 0; i < 2; ++i) { vA0[i] = x0[i]; vA1[i] = x1[i]; } }
    }
    G_WAIT_V(0);
    G_BAR;
#undef G_SA
#undef G_SB
#undef G_STAGE
#undef G_STAGE1
#undef G_STAGE_A
#undef G_LDA
#undef G_LDB
#undef G_MMA
#undef G_CAT
#undef G_WAIT_V
#undef G_WAIT_L
#undef G_BAR
#undef G_SCHED
#undef G_UNI
#undef G_TRIP
#undef G_IDX
#undef G_ROWS
}
#else
template <class Prob, class Epi, bool GATHER, bool FP8 = false>
__device__ __forceinline__ void gemm_phase(LAS uchar* lds, const Prob& S, const Epi& E, const int wid) {
    const int lane = fresh_lane(), tid = wid * 64 + lane, wr = wid >> 2, wc = wid & 3, fr = lane & 15, fq = lane >> 4;
    LAS float* As = (LAS float*)lds; LAS float* Bs = As + 256 * 33;
    Unit u;
    for (int ui = 0; S.next(ui, u); ++ui) {
        float acc[2][2][4][2][4];
#pragma unroll
        for (int a = 0; a < 2; ++a)
#pragma unroll
            for (int b = 0; b < 2; ++b)
#pragma unroll
                for (int m = 0; m < 4; ++m)
#pragma unroll
                    for (int n = 0; n < 2; ++n)
#pragma unroll
                        for (int j = 0; j < 4; ++j) acc[a][b][m][n][j] = 0.f;
        const int lr = tid >> 1, lk = (tid & 1) * 16;
        const bf16_t* ap = GATHER ? (S.A + S.a_row(u, lr)) : (S.A + S.a_off(u) + (size_t)lr * S.lda);
        const bf16_t* bp = S.B + S.b_off(u) + (size_t)lr * S.ldb;
        for (int k0 = 0; k0 < S.nt * 64; k0 += 32) {
            __syncthreads();
            const u32x4 a0 = *(const u32x4*)(ap + k0 + lk), a1 = *(const u32x4*)(ap + k0 + lk + 8);
            const u32x4 b0 = *(const u32x4*)(bp + k0 + lk), b1 = *(const u32x4*)(bp + k0 + lk + 8);
#pragma unroll
            for (int q = 0; q < 4; ++q) {
                As[lr * 33 + lk + 2 * q] = bflo(a0[q]); As[lr * 33 + lk + 2 * q + 1] = bfhi(a0[q]);
                As[lr * 33 + lk + 8 + 2 * q] = bflo(a1[q]); As[lr * 33 + lk + 8 + 2 * q + 1] = bfhi(a1[q]);
                Bs[lr * 33 + lk + 2 * q] = bflo(b0[q]); Bs[lr * 33 + lk + 2 * q + 1] = bfhi(b0[q]);
                Bs[lr * 33 + lk + 8 + 2 * q] = bflo(b1[q]); Bs[lr * 33 + lk + 8 + 2 * q + 1] = bfhi(b1[q]);
            }
            __syncthreads();
            for (int kk = 0; kk < 32; ++kk) {
                float av[2][4], bv[2][2][4];
#pragma unroll
                for (int a = 0; a < 2; ++a)
#pragma unroll
                    for (int m = 0; m < 4; ++m) av[a][m] = As[(128 * a + 64 * wr + 16 * m + fr) * 33 + kk];
#pragma unroll
                for (int b = 0; b < 2; ++b)
#pragma unroll
                    for (int n = 0; n < 2; ++n)
#pragma unroll
                        for (int j = 0; j < 4; ++j) { const int c = 128 * b + 32 * wc + (Epi::PERM ? (8 * fq + 4 * n + j) : (16 * n + 4 * fq + j)); bv[b][n][j] = Bs[c * 33 + kk]; }
#pragma unroll
                for (int a = 0; a < 2; ++a)
#pragma unroll
                    for (int b = 0; b < 2; ++b)
#pragma unroll
                        for (int m = 0; m < 4; ++m)
#pragma unroll
                            for (int n = 0; n < 2; ++n)
#pragma unroll
                                for (int j = 0; j < 4; ++j) acc[a][b][m][n][j] += av[a][m] * bv[b][n][j];
            }
        }
        f32x4 accv[2][2][4][2];
#pragma unroll
        for (int a = 0; a < 2; ++a)
#pragma unroll
            for (int b = 0; b < 2; ++b)
#pragma unroll
                for (int m = 0; m < 4; ++m)
#pragma unroll
                    for (int n = 0; n < 2; ++n) accv[a][b][m][n] = (f32x4){acc[a][b][m][n][0], acc[a][b][m][n][1], acc[a][b][m][n][2], acc[a][b][m][n][3]};
        E(accv, u, wr, wc, fr, fq);
    }
    __syncthreads();
}
#endif
}

struct Args {
    const float* in[32];
    float* out; uchar* ws;
    int ph_lo, ph_hi;
};
struct Frame {
    LAS uchar* lds; uchar* ws; int wave, G, bx;
};
#define FRAME_IDS(F) const int F_lane = fresh_lane(), F_tid = (F).wave * 64 + F_lane
enum { I_X = 0, I_POS, I_N1G, I_WIN, I_BG, I_QNG, I_WUQ, I_KVNG, I_WUKV, I_QKQG, I_QKKG, I_WOMLA, I_LRE, I_LIM, I_LOGDT, I_BRE, I_BIM, I_CRE, I_CIM, I_S5D,
       I_WGLU, I_WOS5, I_WOUT, I_N2G, I_WR, I_BR, I_WG, I_BGATE, I_WU, I_BUP, I_WD, I_BDOWN };

struct ProbS5 {
    const bf16_t* A; const bf16_t* B; int lda, ldb, nt; int G, c; const int* list = nullptr; const LAS int* gtab = nullptr;
    __device__ unsigned list_off(const gm::Unit&) const { return 0u; }
    __device__ bool next(int i, gm::Unit& u) const { const int L = i * G + c; if (L >= S5G * 4) return false; u.g = L >> 2; u.pm = L & 3; u.pn = 0; u.st = 0; return true; }
    __device__ size_t a_off(const gm::Unit& u) const { return ((size_t)u.g * NCHUNK + (size_t)u.pm * 256) * APK; }
    __device__ size_t b_off(const gm::Unit& u) const { return (size_t)u.g * 256 * ldb; }
    __device__ unsigned a_row(const gm::Unit&, int) const { return 0u; }
};
struct ProbMoE {
    const bf16_t* A; const bf16_t* B; int lda, ldb, nt; int npn; size_t estride;
    int x, rk, nrk; int nte[4], rcp[4], pre[4], eid[4];
    const int* list = nullptr; const LAS int* gtab = nullptr;
    __device__ void load(const LAS int* tab) {
#pragma unroll
        for (int q = 0; q < 4; ++q) { const int e = __builtin_amdgcn_readfirstlane(tab[160 + x * 4 + q]); eid[q] = e; nte[q] = __builtin_amdgcn_readfirstlane(tab[32 + e]); rcp[q] = __builtin_amdgcn_readfirstlane(tab[128 + e]); pre[q] = __builtin_amdgcn_readfirstlane(tab[64 + e]); }
    }
    __device__ unsigned list_off(const gm::Unit&) const { return 0u; }
    __device__ bool next(int i, gm::Unit& u) const {
        int L = i * nrk + rk;
#pragma unroll
        for (int q = 0; q < 4; ++q) { const int nu = nte[q] * npn;
            if (L < nu) { u.g = eid[q]; u.pn = (L * rcp[q]) >> 20; u.pm = L - u.pn * nte[q]; u.st = pre[q] + u.pm; return true; } L -= nu; }
        return false;
    }
    __device__ size_t a_off(const gm::Unit& u) const { return ((size_t)u.st * 256) * lda; }
    __device__ size_t b_off(const gm::Unit& u) const { return (size_t)u.g * estride + (size_t)u.pn * 256 * ldb; }
    __device__ unsigned a_row(const gm::Unit&, int) const { return 0u; }
};

#define EPI_ROW(u_, ai, m) ((u_).pm * 256 + (ai) * 128 + wr * 64 + (m) * 16 + fr)
struct EpiStoreBf16 {
    static constexpr bool PERM = true;
    bf16_t* O; int ld;
    __device__ __forceinline__ void operator()(const f32x4 (&acc)[2][2][4][2], const gm::Unit& u, int wr, int wc, int fr, int fq) const {
#pragma unroll
        for (int ai = 0; ai < 2; ++ai)
#pragma unroll
            for (int m = 0; m < 4; ++m) { bf16_t* rowp = O + (size_t)EPI_ROW(u, ai, m) * ld + u.pn * 256 + wc * 32 + 8 * fq;
#pragma unroll
                for (int bj = 0; bj < 2; ++bj) { const f32x4 v0 = acc[ai][bj][m][0], v1 = acc[ai][bj][m][1];
                    u32x4 w; w.x = cvt_pk_bf16(v0[0], v0[1]); w.y = cvt_pk_bf16(v0[2], v0[3]); w.z = cvt_pk_bf16(v1[0], v1[1]); w.w = cvt_pk_bf16(v1[2], v1[3]);
                    *(u32x4*)(rowp + bj * 128) = w; } }
    }
};
template <int S0, int NS, int LEN> struct EpiStoreScaled {
    static constexpr bool PERM = true;
    bf16_t* O; int ld; const float* ssqp;
    __device__ __forceinline__ void operator()(const f32x4 (&acc)[2][2][4][2], const gm::Unit& u, int wr, int wc, int fr, int fq) const {
#pragma unroll
        for (int ai = 0; ai < 2; ++ai) { float rs[4];
#pragma unroll
            for (int m = 0; m < 4; ++m) { const float* sp = ssqp + (size_t)EPI_ROW(u, ai, m) * 12 + S0; float t = 0.f;
#pragma unroll
                for (int q = 0; q < NS; q += 4) { const f32x4 v = *(const f32x4*)(sp + q); t += (v[0] + v[1]) + (v[2] + v[3]); }
                rs[m] = 1.0f / sqrtf(t * (1.0f / LEN) + EPS); }
#pragma unroll
            for (int m = 0; m < 4; ++m) { bf16_t* rowp = O + (size_t)EPI_ROW(u, ai, m) * ld + u.pn * 256 + wc * 32 + 8 * fq;
#pragma unroll
                for (int bj = 0; bj < 2; ++bj) { const f32x4 v0 = acc[ai][bj][m][0] * rs[m], v1 = acc[ai][bj][m][1] * rs[m];
                    u32x4 w; w.x = cvt_pk_bf16(v0[0], v0[1]); w.y = cvt_pk_bf16(v0[2], v0[3]); w.z = cvt_pk_bf16(v1[0], v1[1]); w.w = cvt_pk_bf16(v1[2], v1[3]);
                    *(u32x4*)(rowp + bj * 128) = w; } } }
    }
};
struct EpiKV {
    static constexpr bool PERM = true;
    bf16_t* kraw; bf16_t* vn; const float* ssqp;
    __device__ __forceinline__ void operator()(const f32x4 (&acc)[2][2][4][2], const gm::Unit& u, int wr, int wc, int fr, int fq) const {
#pragma unroll
        for (int ai = 0; ai < 2; ++ai) { float rs[4];
#pragma unroll
            for (int m = 0; m < 4; ++m) { const f32x4 v = *(const f32x4*)(ssqp + (size_t)EPI_ROW(u, ai, m) * 12 + 8); rs[m] = 1.0f / sqrtf(((v[0] + v[1]) + (v[2] + v[3])) * (1.0f / KVLORA) + EPS); }
#pragma unroll
            for (int m = 0; m < 4; ++m) { const int t = EPI_ROW(u, ai, m); const size_t ro = ((size_t)((t >> 11) * NH + u.pn) * SEQ + (t & 2047)) * 128 + wc * 32 + 8 * fq;
#pragma unroll
                for (int bj = 0; bj < 2; ++bj) { const f32x4 v0 = acc[ai][bj][m][0] * rs[m], v1 = acc[ai][bj][m][1] * rs[m];
                    u32x4 w; w.x = cvt_pk_bf16(v0[0], v0[1]); w.y = cvt_pk_bf16(v0[2], v0[3]); w.z = cvt_pk_bf16(v1[0], v1[1]); w.w = cvt_pk_bf16(v1[2], v1[3]);
                    *(u32x4*)((bj ? vn : kraw) + ro) = w; } } }
    }
};
struct EpiInProj {
    static constexpr bool PERM = true;
    bf16_t* proj; bf16_t* apack; const float* bgates; float* ssqp;
    __device__ __forceinline__ void operator()(const f32x4 (&acc)[2][2][4][2], const gm::Unit& u, int wr, int wc, int fr, int fq) const {
        const int colt = u.pn * 256 + wc * 32 + 8 * fq;
        if (u.pn < 3) {
#pragma unroll
            for (int ai = 0; ai < 2; ++ai)
#pragma unroll
                for (int m = 0; m < 4; ++m) { float sq = 0.f;
#pragma unroll
                    for (int bj = 0; bj < 2; ++bj)
#pragma unroll
                        for (int n = 0; n < 2; ++n) { const f32x4 v = acc[ai][bj][m][n]; sq += (v[0] * v[0] + v[1] * v[1]) + (v[2] * v[2] + v[3] * v[3]); }
                    sq += __shfl_xor(sq, 16); sq += __shfl_xor(sq, 32);
                    if (fq == 0) ssqp[(size_t)EPI_ROW(u, ai, m) * 12 + u.pn * 4 + wc] = sq; } }
        const int kind = (u.pn >= 3 && u.pn < 7) ? 1 : ((u.pn >= 7 && u.pn < 23) ? 2 : 0);
#pragma unroll
        for (int bj = 0; bj < 2; ++bj) {
            const int col = colt + bj * 128;
            f32x4 b0 = (f32x4){0.f, 0.f, 0.f, 0.f}, b1 = b0;
            if (kind == 2) { b0 = *(const f32x4*)(bgates + (col - C_GA)); b1 = *(const f32x4*)(bgates + (col - C_GA) + 4); }
#pragma unroll
            for (int ai = 0; ai < 2; ++ai)
#pragma unroll
                for (int m = 0; m < 4; ++m) {
                    const int row = EPI_ROW(u, ai, m);
                    f32x4 v0 = acc[ai][bj][m][0], v1 = acc[ai][bj][m][1];
                    if (kind == 2) {
#pragma unroll
                        for (int j = 0; j < 4; ++j) { v0[j] = sigmoidf_(v0[j] + b0[j]); v1[j] = sigmoidf_(v1[j] + b1[j]); }
                    }
                    u32x4 w; w.x = cvt_pk_bf16(v0[0], v0[1]); w.y = cvt_pk_bf16(v0[2], v0[3]); w.z = cvt_pk_bf16(v1[0], v1[1]); w.w = cvt_pk_bf16(v1[2], v1[3]);
                    if (kind == 1) { const int j = col - C_U, g = j >> 4, cc = j & 15;
                        *(u32x4*)(apack + ((size_t)g * NCHUNK + (row >> 4)) * APK + (row & 15) * 16 + cc) = w; }
                    else { *(u32x4*)(proj + (size_t)row * NPROJ + col) = w;
                    }
                }
        }
    }
};
struct EpiS5State {
    static constexpr bool PERM = false;
    float* sch;
    __device__ __forceinline__ void operator()(const f32x4 (&acc)[2][2][4][2], const gm::Unit& u, int wr, int wc, int fr, int fq) const {
#pragma unroll
        for (int ai = 0; ai < 2; ++ai)
#pragma unroll
            for (int m = 0; m < 4; ++m) { float* rowp = sch + ((size_t)u.g * NCHUNK + EPI_ROW(u, ai, m)) * 128 + wc * 32 + 4 * fq;
#pragma unroll
                for (int n = 0; n < 2; ++n) *(f32x4*)(rowp + n * 16) = acc[ai][0][m][n]; }
    }
};
struct EpiS5Out {
    static constexpr bool PERM = true;
    bf16_t* gact;
    __device__ __forceinline__ void operator()(const f32x4 (&acc)[2][2][4][2], const gm::Unit& u, int wr, int wc, int fr, int fq) const {
#pragma unroll
        for (int ai = 0; ai < 2; ++ai)
#pragma unroll
            for (int m = 0; m < 4; ++m) { const int r = EPI_ROW(u, ai, m);
#pragma unroll
                for (int bj = 0; bj < 2; ++bj) { const int n0 = bj * 128 + wc * 32 + 8 * fq, t = n0 >> 4, c0 = n0 & 15;
                    f32x4 v0 = acc[ai][bj][m][0], v1 = acc[ai][bj][m][1];
#pragma unroll
                    for (int j = 0; j < 4; ++j) { v0[j] = gelu_tanh(v0[j]); v1[j] = gelu_tanh(v1[j]); }
                    u32x4 w; w.x = cvt_pk_bf16(v0[0], v0[1]); w.y = cvt_pk_bf16(v0[2], v0[3]); w.z = cvt_pk_bf16(v1[0], v1[1]); w.w = cvt_pk_bf16(v1[2], v1[3]);
                    *(u32x4*)(gact + ((size_t)r * 16 + t) * S5W + u.g * 16 + c0) = w; } }
    }
};
template <int MODE> struct EpiSide {
    static constexpr bool PERM = true;
    bf16_t* O; int ldo; const bf16_t* s0; int ld0; const bf16_t* s1; int ld1;
    __device__ __forceinline__ void operator()(const f32x4 (&acc)[2][2][4][2], const gm::Unit& u, int wr, int wc, int fr, int fq) const {
        const int col0 = u.pn * 256 + wc * 32 + 8 * fq;
#pragma unroll
        for (int ai = 0; ai < 2; ++ai) {
            u32x4 sa[4][2], sb[4][2];
#pragma unroll
            for (int m = 0; m < 4; ++m)
#pragma unroll
                for (int bj = 0; bj < 2; ++bj) { const int row = EPI_ROW(u, ai, m);
                    sa[m][bj] = *(const u32x4*)(s0 + (size_t)row * ld0 + col0 + bj * 128);
                    if (MODE == 2) sb[m][bj] = *(const u32x4*)(s1 + (size_t)row * ld1 + col0 + bj * 128); else sb[m][bj] = (u32x4){0u, 0u, 0u, 0u}; }
#pragma unroll
            for (int m = 0; m < 4; ++m)
#pragma unroll
                for (int bj = 0; bj < 2; ++bj) { const int row = EPI_ROW(u, ai, m);
                    const f32x4 v0 = acc[ai][bj][m][0], v1 = acc[ai][bj][m][1]; const u32x4 a = sa[m][bj], b = sb[m][bj];
                    float r[8];
#pragma unroll
                    for (int q = 0; q < 4; ++q) { const float x0 = q < 2 ? v0[2 * q] : v1[2 * q - 4], x1 = q < 2 ? v0[2 * q + 1] : v1[2 * q - 3];
                        const float a0 = bflo(a[q]), a1 = bfhi(a[q]);
                        if (MODE == 0) { r[2 * q] = a0 * sigmoidf_(x0); r[2 * q + 1] = a1 * sigmoidf_(x1); }
                        else if (MODE == 1) { r[2 * q] = a0 * x0; r[2 * q + 1] = a1 * x1; }
                        else { r[2 * q] = bflo(b[q]) + a0 * x0; r[2 * q + 1] = bfhi(b[q]) + a1 * x1; } }
                    u32x4 w; w.x = cvt_pk_bf16(r[0], r[1]); w.y = cvt_pk_bf16(r[2], r[3]); w.z = cvt_pk_bf16(r[4], r[5]); w.w = cvt_pk_bf16(r[6], r[7]);
                    *(u32x4*)(O + (size_t)row * ldo + col0 + bj * 128) = w; }
        }
    }
};
struct EpiResidF32 {
    static constexpr bool PERM = false;
    const float* x; float* out;
    __device__ __forceinline__ void operator()(const f32x4 (&acc)[2][2][4][2], const gm::Unit& u, int wr, int wc, int fr, int fq) const {
#pragma unroll
        for (int ai = 0; ai < 2; ++ai)
#pragma unroll
            for (int mh = 0; mh < 2; ++mh) { f32x4 xv[2][2][2];
#pragma unroll
                for (int mm = 0; mm < 2; ++mm) { const size_t off = (size_t)EPI_ROW(u, ai, 2 * mh + mm) * DM + u.pn * 256 + wc * 32 + 4 * fq;
#pragma unroll
                    for (int bj = 0; bj < 2; ++bj)
#pragma unroll
                        for (int n = 0; n < 2; ++n) xv[mm][bj][n] = *(const f32x4*)(x + off + bj * 128 + n * 16); }
#pragma unroll
                for (int mm = 0; mm < 2; ++mm) { const size_t off = (size_t)EPI_ROW(u, ai, 2 * mh + mm) * DM + u.pn * 256 + wc * 32 + 4 * fq;
#pragma unroll
                    for (int bj = 0; bj < 2; ++bj)
#pragma unroll
                        for (int n = 0; n < 2; ++n) *(f32x4*)(out + off + bj * 128 + n * 16) = xv[mm][bj][n] + acc[ai][bj][2 * mh + mm][n]; } }
    }
};
#if MK_FP8_MOE
constexpr float MOE_DESCALE = 1.0f / (FP8_ASCALE * FP8_WSCALE);
#else
constexpr float MOE_DESCALE = 1.0f;
#endif
struct EpiSwiglu {
    static constexpr bool PERM = true;
    bf16_t* hact; const float* bgate; const float* bup; const LAS int* tab;
    __device__ __forceinline__ void operator()(const f32x4 (&acc)[2][2][4][2], const gm::Unit& u, int wr, int wc, int fr, int fq) const {
        const int hc = u.pn * 128 + wc * 32 + 8 * fq;
        const unsigned slot0 = (unsigned)u.st * 256u + wr * 64 + fr;
        unsigned w0[2][4];
#pragma unroll
        for (int n = 0; n < 2; ++n) {
            const f32x4 g0 = *(const f32x4*)(bgate + (unsigned)(u.g * DFF + hc + 4 * n)), u0 = *(const f32x4*)(bup + (unsigned)(u.g * DFF + hc + 4 * n));
#pragma unroll
            for (int ai = 0; ai < 2; ++ai)
#pragma unroll
                for (int m = 0; m < 4; ++m) { const unsigned slot = slot0 + ai * 128 + m * 16;
                    float r[4];
#pragma unroll
                    for (int q = 0; q < 4; ++q) { float gt = acc[ai][0][m][n][q] * MOE_DESCALE + g0[q], up = acc[ai][1][m][n][q] * MOE_DESCALE + u0[q];
                        gt = fminf(gt, 7.0f); up = fminf(fmaxf(up, -7.0f), 7.0f);
                        r[q] = (up + 1.0f) * (gt * sigmoidf_(1.702f * gt)); }
#if MK_FP8_MOE
                    const unsigned pk = pk4_fp8(r[0] * FP8_ASCALE, r[1] * FP8_ASCALE, r[2] * FP8_ASCALE, r[3] * FP8_ASCALE);
                    if (n == 0) w0[ai][m] = pk; else { u32x2 w; w.x = w0[ai][m]; w.y = pk; *(u32x2*)((uchar*)hact + slot * DFF + hc) = w; }
#else
                    u32x2 w; w.x = cvt_pk_bf16(r[0], r[1]); w.y = cvt_pk_bf16(r[2], r[3]); *(u32x2*)(hact + slot * DFF + hc + 4 * n) = w;
#endif
                }
        }
    }
};
struct EpiDown {
    static constexpr bool PERM = true;
    bf16_t* ys; const float* bdown; const LAS int* tab;
    __device__ __forceinline__ void operator()(const f32x4 (&acc)[2][2][4][2], const gm::Unit& u, int wr, int wc, int fr, int fq) const {
        const size_t slot0 = (size_t)u.st * 256;
#pragma unroll
        for (int bj = 0; bj < 2; ++bj) { const int col = u.pn * 256 + bj * 128 + wc * 32 + 8 * fq;
            const float* bd = bdown + (size_t)u.g * DM + col; const f32x4 d0 = *(const f32x4*)bd, d1 = *(const f32x4*)(bd + 4);
#pragma unroll
            for (int ai = 0; ai < 2; ++ai)
#pragma unroll
                for (int m = 0; m < 4; ++m) { const size_t slot = slot0 + ai * 128 + wr * 64 + m * 16 + fr;
                    const f32x4 v0 = acc[ai][bj][m][0] * MOE_DESCALE + d0, v1 = acc[ai][bj][m][1] * MOE_DESCALE + d1;
                    u32x4 w; w.x = cvt_pk_bf16(v0[0], v0[1]); w.y = cvt_pk_bf16(v0[2], v0[3]); w.z = cvt_pk_bf16(v1[0], v1[1]); w.w = cvt_pk_bf16(v1[2], v1[3]);
                    *(u32x4*)(ys + slot * DM + col) = w; } }
    }
};

template <bool FP8OUT>
__device__ __forceinline__ void transpose_item(const float* W, int ldw, int src_col0, int k0, const float* kscale, void* WT, int ldt, int dst_row0, float oscale, LAS float* scr, int lane) {
    if (src_col0 >= 0) {
        f32x4 v[16]; const float* wp = W + (size_t)(k0 + (lane >> 4)) * ldw + src_col0 + (lane & 15) * 4;
#pragma unroll
        for (int i = 0; i < 16; ++i) v[i] = *(const f32x4*)(wp + (size_t)(4 * i) * ldw);
#pragma unroll
        for (int i = 0; i < 16; ++i) { const int kk = 4 * i + (lane >> 4); const float sc = kscale ? kscale[k0 + kk] * oscale : oscale; LAS float* d = scr + kk * 65 + (lane & 15) * 4;
            d[0] = v[i].x * sc; d[1] = v[i].y * sc; d[2] = v[i].z * sc; d[3] = v[i].w * sc; }
    } else {
#pragma unroll
        for (int i = 0; i < 16; ++i) { LAS float* d = scr + (4 * i + (lane >> 4)) * 65 + (lane & 15) * 4; d[0] = 0.f; d[1] = 0.f; d[2] = 0.f; d[3] = 0.f; }
    }
    LDS_WAIT(); asm volatile("" ::: "memory");
    if constexpr (FP8OUT) { const int c = lane & 3;
#pragma unroll
        for (int j = 0; j < 4; ++j) { const int n = (lane >> 2) + 16 * j; const LAS float* s = scr + (16 * c) * 65 + n; u32x4 o;
            o.x = pk4_fp8(s[0 * 65], s[1 * 65], s[2 * 65], s[3 * 65]); o.y = pk4_fp8(s[4 * 65], s[5 * 65], s[6 * 65], s[7 * 65]);
            o.z = pk4_fp8(s[8 * 65], s[9 * 65], s[10 * 65], s[11 * 65]); o.w = pk4_fp8(s[12 * 65], s[13 * 65], s[14 * 65], s[15 * 65]);
            *(u32x4*)((uchar*)WT + (size_t)(dst_row0 + n) * ldt + k0 + 16 * c) = o; }
    } else { const int c = lane & 7;
#pragma unroll
        for (int j = 0; j < 8; ++j) { const int n = (lane >> 3) + 8 * j; const LAS float* s = scr + (8 * c) * 65 + n;
            u32x4 o; o.x = pk2(s[0 * 65], s[1 * 65]); o.y = pk2(s[2 * 65], s[3 * 65]); o.z = pk2(s[4 * 65], s[5 * 65]); o.w = pk2(s[6 * 65], s[7 * 65]);
            *(u32x4*)((bf16_t*)WT + (size_t)(dst_row0 + n) * ldt + k0 + 8 * c) = o; }
    }
    LDS_WAIT(); asm volatile("" ::: "memory");
}
struct TItem { const float* src; uchar* dst; };
__device__ __forceinline__ void ti_load(const TItem& t, f32x4 (&v)[16], int lane) {
    const float* wp = t.src + (size_t)(lane >> 4) * DM + (lane & 15) * 4;
#pragma unroll
    for (int i = 0; i < 16; ++i) v[i] = *(const f32x4*)(wp + (size_t)(4 * i) * DM);
}
template <bool FP8OUT>
__device__ __forceinline__ void ti_store(const TItem& t, const f32x4 (&v)[16], float oscale, LAS float* scr, int lane) {
#pragma unroll
    for (int i = 0; i < 16; ++i) { LAS float* d = scr + (4 * i + (lane >> 4)) * 65 + (lane & 15) * 4; d[0] = v[i].x * oscale; d[1] = v[i].y * oscale; d[2] = v[i].z * oscale; d[3] = v[i].w * oscale; }
    LDS_WAIT(); asm volatile("" ::: "memory");
    if constexpr (FP8OUT) { const int c = lane & 3;
#pragma unroll
        for (int j = 0; j < 4; ++j) { const int n = (lane >> 2) + 16 * j; const LAS float* s = scr + (16 * c) * 65 + n; u32x4 o;
            o.x = pk4_fp8(s[0 * 65], s[1 * 65], s[2 * 65], s[3 * 65]); o.y = pk4_fp8(s[4 * 65], s[5 * 65], s[6 * 65], s[7 * 65]);
            o.z = pk4_fp8(s[8 * 65], s[9 * 65], s[10 * 65], s[11 * 65]); o.w = pk4_fp8(s[12 * 65], s[13 * 65], s[14 * 65], s[15 * 65]);
            *(u32x4*)(t.dst + (size_t)n * DM + 16 * c) = o; }
    } else { const int c = lane & 7;
#pragma unroll
        for (int j = 0; j < 8; ++j) { const int n = (lane >> 3) + 8 * j; const LAS float* s = scr + (8 * c) * 65 + n;
            u32x4 o; o.x = pk2(s[0 * 65], s[1 * 65]); o.y = pk2(s[2 * 65], s[3 * 65]); o.z = pk2(s[4 * 65], s[5 * 65]); o.w = pk2(s[6 * 65], s[7 * 65]);
            *(u32x4*)(t.dst + ((size_t)n * DM + 8 * c) * 2) = o; }
    }
    LDS_WAIT(); asm volatile("" ::: "memory");
}
template <bool W8>
__device__ __forceinline__ TItem moe_pair(const Args& a, uchar* ws, int it) {
    constexpr size_t WEB = W8 ? 1 : 2; TItem t;
    const int kb = 2 * ((it & 7) | (((it >> 11) & 1) << 3)), nb = (it >> 3) & 31;
    if (it < NE * 2 * 16 * 32) { const int rest = ((it >> 8) & 7) | ((it >> 12) << 3), half = rest & 1, e = rest >> 1, pn = nb >> 1, q = nb & 1;
        t.src = a.in[half ? I_WU : I_WG] + (size_t)e * DM * DFF + (size_t)(kb * 64) * DFF + nb * 64;
        t.dst = ws + WS_W1 + ((size_t)e * 4096 * DM + (size_t)(pn * 256 + half * 128 + q * 64) * DM + kb * 64) * WEB;
    } else { const int r = it - NE * 2 * 16 * 32, e = ((r >> 8) & 7) | ((r >> 12) << 3);
        t.src = a.in[I_WD] + (size_t)e * DFF * DM + (size_t)(kb * 64) * DM + nb * 64;
        t.dst = ws + WS_W2 + ((size_t)e * DM * DFF + (size_t)(nb * 64) * DFF + kb * 64) * WEB; }
    return t;
}
template <bool FP8OUT, int NO>
__device__ __forceinline__ void ti_block(const f32x4 (&v)[16], float oscale, LAS float* scr, int lane, u32x4 (&o)[NO]) {
#pragma unroll
    for (int i = 0; i < 16; ++i) { LAS float* d = scr + (4 * i + (lane >> 4)) * 65 + (lane & 15) * 4; d[0] = v[i].x * oscale; d[1] = v[i].y * oscale; d[2] = v[i].z * oscale; d[3] = v[i].w * oscale; }
    LDS_WAIT(); asm volatile("" ::: "memory");
    if constexpr (FP8OUT) { const int c = lane & 3;
#pragma unroll
        for (int j = 0; j < 4; ++j) { const int n = (lane >> 2) + 16 * j; const LAS float* s = scr + (16 * c) * 65 + n;
            o[j].x = pk4_fp8(s[0 * 65], s[1 * 65], s[2 * 65], s[3 * 65]); o[j].y = pk4_fp8(s[4 * 65], s[5 * 65], s[6 * 65], s[7 * 65]);
            o[j].z = pk4_fp8(s[8 * 65], s[9 * 65], s[10 * 65], s[11 * 65]); o[j].w = pk4_fp8(s[12 * 65], s[13 * 65], s[14 * 65], s[15 * 65]); }
    } else { const int c = lane & 7;
#pragma unroll
        for (int j = 0; j < 8; ++j) { const int n = (lane >> 3) + 8 * j; const LAS float* s = scr + (8 * c) * 65 + n;
            o[j].x = pk2(s[0 * 65], s[1 * 65]); o[j].y = pk2(s[2 * 65], s[3 * 65]); o[j].z = pk2(s[4 * 65], s[5 * 65]); o[j].w = pk2(s[6 * 65], s[7 * 65]); } }
    LDS_WAIT(); asm volatile("" ::: "memory");
}
__device__ __forceinline__ int win_src_col(int n0) {
    if (n0 < C_KVLAT) return n0;
    if (n0 < C_U) return n0;
    if (n0 < C_GA) return (n0 - C_U) + 832;
    if (n0 < C_KR) return (n0 - C_GA) + 1856;
    if (n0 < C_KR + DROPE) return (n0 - C_KR) + 768;
    return -1;
}
__device__ __forceinline__ void s5_build_group(const Args& a, const Frame& F, int g) {
    FRAME_IDS(F);
    LAS float* L = (LAS float*)F.lds;
    LAS float* Apr = L;              LAS float* Api = Apr + 17 * 64;
    LAS float* Zr = Api + 17 * 64;   LAS float* Zi = Zr + 64;
    LAS float* Bbr = Zi + 64;        LAS float* Bbi = Bbr + 1024;
    LAS float* Cr = Bbi + 1024;      LAS float* Ci = Cr + 1024;
    LAS float* Kt = Ci + 1024;
    const int tid = F_tid;
    __syncthreads();
    if (tid < 64) { const int p = tid;
        const float dt = expf(a.in[I_LOGDT][g]); const float lr = a.in[I_LRE][g * 64 + p], li = a.in[I_LIM][g * 64 + p];
        const float mag = expf(lr * dt); const float ar = mag * cosf(li * dt), ai = mag * sinf(li * dt);
        const float den = lr * lr + li * li;
        Zr[p] = ((ar - 1.0f) * lr + ai * li) / den; Zi[p] = (ai * lr - (ar - 1.0f) * li) / den;
        float pr = 1.0f, pi = 0.0f;
        for (int t = 0; t <= 16; ++t) { Apr[t * 64 + p] = pr; Api[t * 64 + p] = pi; const float nr = pr * ar - pi * ai, ni = pr * ai + pi * ar; pr = nr; pi = ni; }
    }
    __syncthreads();
    for (int i = tid; i < 1024; i += NTHREADS) { const int p = i >> 4;
        const float br = a.in[I_BRE][(size_t)g * 1024 + i], bi = a.in[I_BIM][(size_t)g * 1024 + i];
        Bbr[i] = Zr[p] * br - Zi[p] * bi; Bbi[i] = Zr[p] * bi + Zi[p] * br;
        Cr[i] = a.in[I_CRE][(size_t)g * 1024 + i]; Ci[i] = a.in[I_CIM][(size_t)g * 1024 + i]; }
    if (tid < 64) ((float2*)(F.ws + WS_SMALL + SM_A16))[g * 64 + tid] = make_float2(Apr[16 * 64 + tid], Api[16 * 64 + tid]);
    __syncthreads();
    { const int tau = tid >> 5, c = (tid >> 1) & 15, h8 = (tid & 1) * 8; float acc8[8];
#pragma unroll
      for (int j = 0; j < 8; ++j) acc8[j] = 0.f;
      for (int p = 0; p < 64; ++p) { const float cr = Cr[c * 64 + p], ci = Ci[c * 64 + p], ar = Apr[tau * 64 + p], ai = Api[tau * 64 + p];
          const float car = cr * ar - ci * ai, cai = cr * ai + ci * ar;
          const f32x4 b0 = *(const LAS f32x4*)(Bbr + p * 16 + h8), b1 = *(const LAS f32x4*)(Bbr + p * 16 + h8 + 4), d0 = *(const LAS f32x4*)(Bbi + p * 16 + h8), d1 = *(const LAS f32x4*)(Bbi + p * 16 + h8 + 4);
#pragma unroll
          for (int j = 0; j < 4; ++j) { acc8[j] += car * b0[j] - cai * d0[j]; acc8[4 + j] += car * b1[j] - cai * d1[j]; } }
#pragma unroll
      for (int j = 0; j < 8; ++j) Kt[(tau * 16 + c) * 16 + h8 + j] = acc8[j]; }
    __syncthreads();
    bf16_t* twc = (bf16_t*)(F.ws + WS_TWC) + (size_t)g * 256 * APK;
    for (int ch = tid; ch < 256 * (APK / 8); ch += NTHREADS) { const int n = ch / (APK / 8), k0 = (ch % (APK / 8)) * 8, t = n >> 4, c = n & 15; float v[8];
#pragma unroll
        for (int j = 0; j < 8; ++j) { const int k = k0 + j;
            if (k < 256) { const int s = k >> 4, cp = k & 15; float x = (s <= t) ? Kt[((t - s) * 16 + c) * 16 + cp] : 0.f; if (s == t && cp == c) x += a.in[I_S5D][g * 16 + c]; v[j] = x; }
            else { const int q = k - 256, p = q & 63; const float cr = Cr[c * 64 + p], ci = Ci[c * 64 + p], ar = Apr[(t + 1) * 64 + p], ai = Api[(t + 1) * 64 + p];
                v[j] = (q < 64) ? (cr * ar - ci * ai) : -(cr * ai + ci * ar); } }
        u32x4 o; o.x = pk2(v[0], v[1]); o.y = pk2(v[2], v[3]); o.z = pk2(v[4], v[5]); o.w = pk2(v[6], v[7]);
        *(u32x4*)(twc + (size_t)n * APK + k0) = o; }
    bf16_t* wsm = (bf16_t*)(F.ws + WS_WS5) + (size_t)g * 256 * 256;
    for (int ch = tid; ch < 256 * 32; ch += NTHREADS) { const int n = ch >> 5, k0 = (ch & 31) * 8; float v[8];
#pragma unroll
        for (int j = 0; j < 8; ++j) { const int k = k0 + j, s = k >> 4, cp = k & 15;
            if (n < 128) { const int p = n & 63; const float ar = Apr[(15 - s) * 64 + p], ai = Api[(15 - s) * 64 + p], br = Bbr[p * 16 + cp], bi = Bbi[p * 16 + cp];
                v[j] = (n < 64) ? (ar * br - ai * bi) : (ar * bi + ai * br); } else v[j] = 0.f; }
        u32x4 o; o.x = pk2(v[0], v[1]); o.y = pk2(v[2], v[3]); o.z = pk2(v[4], v[5]); o.w = pk2(v[6], v[7]);
        *(u32x4*)(wsm + (size_t)n * 256 + k0) = o; }
    __syncthreads();
}
__device__ __forceinline__ void rms_row_to_bf16(const float* xrow, const float* gain, bf16_t* orow, int lane) {
    const f32x4* xr = (const f32x4*)xrow + lane; const f32x4* gr = (const f32x4*)gain + lane;
    f32x4 v[8]; float s = 0.f;
#pragma unroll
    for (int j = 0; j < 8; ++j) { v[j] = xr[64 * j]; s += (v[j].x * v[j].x + v[j].y * v[j].y) + (v[j].z * v[j].z + v[j].w * v[j].w); }
    const float rstd = 1.0f / sqrtf(wave_sum(s) * (1.0f / DM) + EPS);
    unsigned long long* o8 = (unsigned long long*)orow + lane;
#pragma unroll
    for (int j = 0; j < 8; ++j) { const f32x4 gg = gr[64 * j];
        o8[64 * j] = (unsigned long long)pk2(v[j].x * rstd * gg.x, v[j].y * rstd * gg.y) | ((unsigned long long)pk2(v[j].z * rstd * gg.z, v[j].w * rstd * gg.w) << 32); }
}
__device__ __forceinline__ void p0_prologue(const Args& a, const Frame& F) {
    FRAME_IDS(F);
    for (int g = F.bx; g < S5G; g += F.G) s5_build_group(a, F, g);
    __syncthreads();
    const int gw = F.bx * NWAVES + F.wave, NGW = F.G * NWAVES; const int lane = F_lane;
    for (int m = gw; m < TT; m += NGW) rms_row_to_bf16(a.in[I_X] + (size_t)m * DM, a.in[I_N1G], (bf16_t*)(F.ws + WS_H) + (size_t)m * DM, lane);
    for (int i = gw * 64 + lane; i < TT * 32; i += NGW * 64) { const int t = i >> 5, f = i & 31;
        const double invf = exp(-(double)f * (9.210340371976184 / 32.0)); const double ang = (double)((const int*)a.in[I_POS])[t] * invf;
        ((float2*)(F.ws + WS_ROPE))[i] = make_float2((float)cos(ang), (float)sin(ang)); }
    for (int i = gw * 64 + lane; i < DM * NE; i += NGW * 64) ((float*)(F.ws + WS_SMALL + SM_WRP))[i] = a.in[I_WR][i] * a.in[I_N2G][i >> 5];
    LAS float* scr = (LAS float*)(F.lds + F.wave * 16640);
    constexpr int IT_WIN = (DM / 64) * (NPROJ / 64), IT_WUQ = (QLORA / 64) * (3072 / 64), IT_WUKV = (KVLORA / 64) * (4096 / 64), IT_SQ = (DM / 64) * (DM / 64),
                  IT_GLU = (S5W / 64) * (S5W / 64), IT_OS5 = (S5W / 64) * (DM / 64);
    constexpr int IT_MIX = IT_WIN + IT_WUQ + IT_WUKV + IT_SQ + IT_GLU + IT_OS5 + IT_SQ;
    for (int it = gw; it < IT_MIX; it += NGW) { int r = it;
        if (r < IT_WIN) { const int nb = r % (NPROJ / 64), kb = r / (NPROJ / 64); transpose_item<false>(a.in[I_WIN], IN_PROJ, win_src_col(nb * 64), kb * 64, nullptr, F.ws + WS_WIN, DM, nb * 64, 1.f, scr, lane); continue; } r -= IT_WIN;
        if (r < IT_WUQ) { const int nb = r % 48, kb = r / 48; transpose_item<false>(a.in[I_WUQ], 3072, nb * 64, kb * 64, a.in[I_QNG], F.ws + WS_WUQ, QLORA, nb * 64, 1.f, scr, lane); continue; } r -= IT_WUQ;
        if (r < IT_WUKV) { const int nb = r % 64, kb = r / 64; transpose_item<false>(a.in[I_WUKV], 4096, nb * 64, kb * 64, a.in[I_KVNG], F.ws + WS_WUKV, KVLORA, nb * 64, 1.f, scr, lane); continue; } r -= IT_WUKV;
        if (r < IT_SQ) { const int nb = r % 32, kb = r / 32; transpose_item<false>(a.in[I_WOMLA], DM, nb * 64, kb * 64, nullptr, F.ws + WS_WOMLA, DM, nb * 64, 1.f, scr, lane); continue; } r -= IT_SQ;
        if (r < IT_GLU) { const int nb = r % 16, kb = r / 16; transpose_item<false>(a.in[I_WGLU], S5W, nb * 64, kb * 64, nullptr, F.ws + WS_WGLU, S5W, nb * 64, 1.f, scr, lane); continue; } r -= IT_GLU;
        if (r < IT_OS5) { const int nb = r % 32, kb = r / 32; transpose_item<false>(a.in[I_WOS5], DM, nb * 64, kb * 64, nullptr, F.ws + WS_WOS5, S5W, nb * 64, 1.f, scr, lane); continue; } r -= IT_OS5;
        { const int nb = r % 32, kb = r / 32; transpose_item<false>(a.in[I_WOUT], DM, nb * 64, kb * 64, nullptr, F.ws + WS_WOUT, DM, nb * 64, 1.f, scr, lane); }
    }
    constexpr bool W8 = MK_FP8_MOE != 0; constexpr float WSC = W8 ? FP8_WSCALE : 1.0f; constexpr int NPAIR = NE * 3 * 16 * 32; constexpr int NO = W8 ? 4 : 8;
    for (int it = gw; it < NPAIR; it += NGW) { const TItem t = moe_pair<W8>(a, F.ws, it); f32x4 v0[16], v1[16];
        ti_load(t, v0, lane); { TItem t1 = t; t1.src += (size_t)64 * DM; ti_load(t1, v1, lane); }
        u32x4 o0[NO], o1[NO];
        ti_block<W8, NO>(v0, WSC, scr, lane, o0); ti_block<W8, NO>(v1, WSC, scr, lane, o1);
        if constexpr (W8) { const int c = lane & 3;
#pragma unroll
            for (int j = 0; j < 4; ++j) { uchar* d = t.dst + (size_t)((lane >> 2) + 16 * j) * DM + 16 * c; *(u32x4*)d = o0[j]; *(u32x4*)(d + 64) = o1[j]; }
        } else { const int c = lane & 7;
#pragma unroll
            for (int j = 0; j < 8; ++j) { uchar* d = t.dst + ((size_t)((lane >> 3) + 8 * j) * DM + 8 * c) * 2; *(u32x4*)d = o0[j]; *(u32x4*)(d + 128) = o1[j]; } }
    }
}

constexpr float QSCALE = 0.07216878364870322f * 1.4426950408889634f;
__device__ __forceinline__ float half_sum(float v) {
#pragma unroll
    for (int o = 1; o < 32; o <<= 1) v += __shfl_xor(v, o);
    return v;
}
__device__ __forceinline__ void p3_prep(const Args& a, const Frame& F) {
    FRAME_IDS(F);
    const bf16_t* proj = (const bf16_t*)(F.ws + WS_PROJ); const bf16_t* kvraw = (const bf16_t*)(F.ws + WS_KVRAW); bf16_t* Kn = (bf16_t*)(F.ws + WS_KN);
    const float2* rope = (const float2*)(F.ws + WS_ROPE);
    const int lane = F_lane, grp = lane / 24, ch = lane - grp * 24; const bool act = grp < 2;
    const bool isrope = act && ch >= 16, x2half = isrope && ch >= 20; const int ri = isrope ? ((ch - 16) & 3) * 8 : 0;
    float g[8];
#pragma unroll
    for (int j = 0; j < 8; ++j) g[j] = act ? a.in[I_QKKG][ch * 8 + j] : 0.f;
    const bool even = (TT == 64 * F.G);
    const int tk0 = even ? F.bx * 64 + (F.wave < 2 ? 5 * F.wave : 10 + 9 * (F.wave - 2)) : F.bx * NWAVES + F.wave, tkn = even ? (F.wave < 2 ? 5 : 9) : (TT + F.G * NWAVES - 1) / (F.G * NWAVES), tks = even ? 1 : F.G * NWAVES;
    for (int ti = 0; ti < tkn; ++ti) { const int t = tk0 + ti * tks; if (t >= TT) break;
        const int b = t >> 11, s = t & 2047; const bf16_t* prow = proj + (size_t)t * NPROJ;
        float cs[8], sn[8];
        if (isrope) {
#pragma unroll
            for (int j = 0; j < 8; j += 2) { const f32x4 c2 = *(const f32x4*)(rope + (size_t)t * 32 + ri + j); cs[j] = c2.x; sn[j] = c2.y; cs[j + 1] = c2.z; sn[j + 1] = c2.w; } }
        else {
#pragma unroll
            for (int j = 0; j < 8; ++j) { cs[j] = 1.f; sn[j] = 0.f; } }
        u32x4 kr = (u32x4){0u, 0u, 0u, 0u};
        if (isrope) kr = *(const u32x4*)(prow + C_KR + (ch - 16) * 8);
        u32x4 wl[8];
        { const bf16_t* src0 = kvraw + ((size_t)(b * NH + grp) * SEQ + s) * 128 + (ch & 15) * 8;
#pragma unroll
          for (int i = 0; i < 8; ++i) wl[i] = (!act) ? (u32x4){0u, 0u, 0u, 0u} : (isrope ? kr : *(const u32x4*)(src0 + (size_t)i * 2 * SEQ * 128)); }
#pragma unroll
        for (int i = 0; i < 8; ++i) { const int h = 2 * i + grp; const u32x4 w = wl[i];
            float x[8], ss = 0.f;
#pragma unroll
            for (int q = 0; q < 4; ++q) { x[2 * q] = bflo(w[q]); x[2 * q + 1] = bfhi(w[q]); }
#pragma unroll
            for (int j = 0; j < 8; ++j) ss += x[j] * x[j];
            const float s0 = wave_sum(grp == 0 ? ss : 0.f), s1 = wave_sum(grp == 1 ? ss : 0.f);
            const float rn = 1.0f / sqrtf((grp == 0 ? s0 : s1) * (1.0f / DQK) + EPS);
            float y[8];
#pragma unroll
            for (int j = 0; j < 8; ++j) y[j] = x[j] * rn * g[j];
#pragma unroll
            for (int j = 0; j < 8; ++j) { const float partner = __shfl_xor(y[j], 4); y[j] = x2half ? (y[j] * cs[j] + partner * sn[j]) : (y[j] * cs[j] - partner * sn[j]); }
            if (act) { u32x4 o; o.x = pk2(y[0], y[1]); o.y = pk2(y[2], y[3]); o.z = pk2(y[4], y[5]); o.w = pk2(y[6], y[7]);
                *(u32x4*)(Kn + ((size_t)(b * NH + h) * SEQ + s) * DQK + ch * 8) = o; }
        }
    }
}

__device__ __forceinline__ void p3_scan(const Args& a, const Frame& F) {
    FRAME_IDS(F);
    const float* sch = (const float*)(F.ws + WS_SCH); bf16_t* apack = (bf16_t*)(F.ws + WS_APACK); const float2* A16 = (const float2*)(F.ws + WS_SMALL + SM_A16);
    const int p = F_lane;
    for (int it = F.wave * F.G + F.bx; it < NB * S5G; it += F.G * NWAVES) { const int b = it / S5G, g = it % S5G;
        const float2 am = A16[g * 64 + p]; float xr = 0.f, xi = 0.f;
        const size_t row0 = (size_t)g * NCHUNK + (size_t)b * 128;
        for (int c0 = 0; c0 < 128; c0 += 32) { float sr[32], si[32];
#pragma unroll
            for (int q = 0; q < 32; ++q) { sr[q] = sch[(row0 + c0 + q) * 128 + p]; si[q] = sch[(row0 + c0 + q) * 128 + 64 + p]; }
#pragma unroll
            for (int q = 0; q < 32; ++q) { bf16_t* o = apack + (row0 + c0 + q) * APK + 256; o[p] = (bf16_t)f2bf(xr); o[64 + p] = (bf16_t)f2bf(xi);
                const float nr = am.x * xr - am.y * xi + sr[q], ni = am.x * xi + am.y * xr + si[q]; xr = nr; xi = ni; } }
    }
}

__device__ __forceinline__ void s5_reference(const Args& a, const Frame& F) {
    FRAME_IDS(F);
    const bf16_t* apack = (const bf16_t*)(F.ws + WS_APACK); bf16_t* gact = (bf16_t*)(F.ws + WS_GACT);
    const int gw = F.bx * NWAVES + F.wave, NGW = F.G * NWAVES, p = F_lane;
    for (int it = gw; it < NB * S5G; it += NGW) { const int b = it / S5G, g = it % S5G;
        const float dt = expf(a.in[I_LOGDT][g]); const float lr = a.in[I_LRE][g * 64 + p], li = a.in[I_LIM][g * 64 + p];
        const float mag = expf(lr * dt); const float ar = mag * cosf(li * dt), ai = mag * sinf(li * dt); const float den = lr * lr + li * li;
        const float zr = ((ar - 1.0f) * lr + ai * li) / den, zi = (ai * lr - (ar - 1.0f) * li) / den;
        float bbr[16], bbi[16], cr[16], ci[16];
#pragma unroll
        for (int c = 0; c < 16; ++c) { const float br = a.in[I_BRE][((size_t)g * 64 + p) * 16 + c], bi = a.in[I_BIM][((size_t)g * 64 + p) * 16 + c];
            bbr[c] = zr * br - zi * bi; bbi[c] = zr * bi + zi * br; cr[c] = a.in[I_CRE][((size_t)g * 16 + c) * 64 + p]; ci[c] = a.in[I_CIM][((size_t)g * 16 + c) * 64 + p]; }
        const float dl = (p < 16) ? a.in[I_S5D][g * 16 + p] : 0.f;
        float xr = 0.f, xi = 0.f;
        for (int t = 0; t < SEQ; ++t) { const int tok = b * SEQ + t;
            const bf16_t* up = apack + ((size_t)g * NCHUNK + (tok >> 4)) * APK + (tok & 15) * 16;
            const u32x4 w0 = *(const u32x4*)up, w1 = *(const u32x4*)(up + 8); float u[16];
#pragma unroll
            for (int q = 0; q < 4; ++q) { u[2 * q] = bflo(w0[q]); u[2 * q + 1] = bfhi(w0[q]); u[8 + 2 * q] = bflo(w1[q]); u[8 + 2 * q + 1] = bfhi(w1[q]); }
            float br = 0.f, bi = 0.f;
#pragma unroll
            for (int c = 0; c < 16; ++c) { br += bbr[c] * u[c]; bi += bbi[c] * u[c]; }
            const float nr = ar * xr - ai * xi + br, ni = ar * xi + ai * xr + bi; xr = nr; xi = ni;
            float y = 0.f, um = 0.f;
#pragma unroll
            for (int c = 0; c < 16; ++c) { const float yc = wave_sum(cr[c] * xr - ci[c] * xi); if (p == c) { y = yc; um = u[c]; } }
            if (p < 16) gact[(size_t)tok * S5W + g * 16 + p] = (bf16_t)f2bf(gelu_tanh(y + dl * um));
        }
    }
}

__device__ __forceinline__ float attn_bound(const Args& a, int lane) {
    float mq = 0.f, mk = 0.f;
#pragma unroll
    for (int q = 0; q < 3; ++q) { mq = fmaxf(mq, fabsf(a.in[I_QKQG][lane + 64 * q])); mk = fmaxf(mk, fabsf(a.in[I_QKKG][lane + 64 * q])); }
#pragma unroll
    for (int o = 1; o < 64; o <<= 1) { mq = fmaxf(mq, __shfl_xor(mq, o)); mk = fmaxf(mk, __shfl_xor(mk, o)); }
    return mq * mk * 13.856406460551018f * 1.4426950408889634f;
}
__device__ __forceinline__ void attn_reference(const Args& a, const Frame& F) {
    FRAME_IDS(F);
    const bf16_t* Qn = (const bf16_t*)(F.ws + WS_QN); const bf16_t* Kn = (const bf16_t*)(F.ws + WS_KN); const bf16_t* Vn = (const bf16_t*)(F.ws + WS_VN);
    bf16_t* O = (bf16_t*)(F.ws + WS_O);
    LAS float* ql = (LAS float*)(F.lds + F.wave * 1024);
    const int lane = F_lane, gw = F.bx * NWAVES + F.wave, NGW = F.G * NWAVES;
    const float Mb = attn_bound(a, lane);
    for (int it = gw; it < NB * NH * SEQ; it += NGW) { const int s = it & 2047, bh = it >> 11, b = bh >> 4, h = bh & 15;
        const bf16_t* qp = Qn + ((size_t)bh * SEQ + s) * DQK;
#pragma unroll
        for (int q = 0; q < 3; ++q) ql[lane + 64 * q] = bf2f(qp[lane + 64 * q]);
        LDS_WAIT();
        const int nk = 64 * ((s >> 6) + 1);
        float o0 = 0.f, o1 = 0.f, l = 0.f;
        for (int k0 = 0; k0 < nk; k0 += 64) {
            const bf16_t* kp = Kn + ((size_t)bh * SEQ + k0 + lane) * DQK; float sc = 0.f;
            for (int d = 0; d < DQK; d += 8) { const u32x4 w = *(const u32x4*)(kp + d);
#pragma unroll
                for (int q = 0; q < 4; ++q) sc += bflo(w[q]) * ql[d + 2 * q] + bfhi(w[q]) * ql[d + 2 * q + 1]; }
            const float pr = __builtin_amdgcn_exp2f(sc - Mb); l += pr;
            for (int kk = 0; kk < 64; ++kk) { const float pk = __shfl(pr, kk); const unsigned w = *(const unsigned*)(Vn + ((size_t)bh * SEQ + k0 + kk) * DV + 2 * lane);
                o0 += pk * bflo(w); o1 += pk * bfhi(w); }
        }
        l = wave_sum(l); const float rl = 1.0f / l;
        *(unsigned*)(O + ((size_t)(b * SEQ + s)) * DM + h * DV + 2 * lane) = pk2(o0 * rl, o1 * rl);
        LDS_WAIT();
    }
}

namespace at {
constexpr int KVB = 64;
constexpr int SHM_V = KVB * DV * 2  , SHM_K = KVB * DQK * 2  ;
constexpr int NQR = 4;
constexpr int OFF_V = 0, OFF_K = 2 * SHM_V, OFF_WS = OFF_K + 2 * SHM_K  , OFF_QL = OFF_WS + NWAVES * 256  , OFF_OST = 0;
constexpr int OPITCH = 272;
static_assert(OFF_QL + NWAVES * (12 - NQR) * 1024 <= LDSCTL_OFF, "attention LDS map");
#define KSWZ(row, colB) ((row) * 384 + ((colB) ^ ((((row) >> 1) & 7) << 4)))
__device__ __forceinline__ int crow(int r, int hi) { return (r & 3) + 8 * (r >> 2) + 4 * hi; }
__device__ __forceinline__ int v_st(int k, int c) { const int kk = (k & ~0xC) | ((k & 4) << 1) | ((k & 8) >> 1); return ((kk >> 3) * 4 + (c >> 5)) * 512 + ((kk & 7) * 32 + (c & 31)) * 2; }
__device__ __forceinline__ int v_rd_base(int lane) { return ((lane & 3) << 3) | (((lane >> 2) & 3) << 6) | (((lane >> 4) & 1) << 5) | (((lane >> 5) & 1) << 8); }
constexpr int v_rd_off(int d0, int ks, int half) { return d0 * 512 + ks * 4096 + half * 2048; }
template <int OFF> __device__ __forceinline__ s16x4 tr_read(int vb) { s16x4 r; asm volatile("ds_read_b64_tr_b16 %0, %1 offset:%2" : "=&v"(r) : "v"(vb), "i"(OFF) : "memory"); return r; }
template <int D0> __device__ __forceinline__ void pv_one(f32x16& od, int vb, bf16x8 pa0, bf16x8 pa1, bf16x8 pa2, bf16x8 pa3) {
    const s16x4 l0 = tr_read<v_rd_off(D0, 0, 0)>(vb), h0 = tr_read<v_rd_off(D0, 0, 1)>(vb), l1 = tr_read<v_rd_off(D0, 1, 0)>(vb), h1 = tr_read<v_rd_off(D0, 1, 1)>(vb);
    const s16x4 l2 = tr_read<v_rd_off(D0, 2, 0)>(vb), h2 = tr_read<v_rd_off(D0, 2, 1)>(vb), l3 = tr_read<v_rd_off(D0, 3, 0)>(vb), h3 = tr_read<v_rd_off(D0, 3, 1)>(vb);
    asm volatile("s_waitcnt lgkmcnt(0)" ::: "memory"); SBAR();
#define PK(L, H) (bf16x8){L[0], L[1], L[2], L[3], H[0], H[1], H[2], H[3]}
    od = __builtin_amdgcn_mfma_f32_32x32x16_bf16(pa0, PK(l0, h0), od, 0, 0, 0);
    od = __builtin_amdgcn_mfma_f32_32x32x16_bf16(pa1, PK(l1, h1), od, 0, 0, 0);
    od = __builtin_amdgcn_mfma_f32_32x32x16_bf16(pa2, PK(l2, h2), od, 0, 0, 0);
    od = __builtin_amdgcn_mfma_f32_32x32x16_bf16(pa3, PK(l3, h3), od, 0, 0, 0);
#undef PK
}
__device__ __forceinline__ void pv_d0(f32x16* o, int vb, bf16x8 pa0, bf16x8 pa1, bf16x8 pa2, bf16x8 pa3) {
    pv_one<0>(o[0], vb, pa0, pa1, pa2, pa3); pv_one<1>(o[1], vb, pa0, pa1, pa2, pa3); pv_one<2>(o[2], vb, pa0, pa1, pa2, pa3); pv_one<3>(o[3], vb, pa0, pa1, pa2, pa3);
}
template <int BUF, int NQR> __device__ __forceinline__ void qkt(f32x16& p0, f32x16& p1, const int (&kb)[4], const bf16x8* qr, int qlb) {
    p0 = f32x16{}; p1 = f32x16{};
#pragma unroll
    for (int a = 0; a < 3; ++a)
#pragma unroll
        for (int b = 0; b < 4; ++b) { const int d0 = 4 * a + b;
            const bf16x8 b0 = *(const LAS bf16x8*)(kb[b] + BUF * SHM_K + a * 128);
            const bf16x8 b1 = *(const LAS bf16x8*)(kb[b] + BUF * SHM_K + a * 128 + 32 * 384);
            bf16x8 q; if (d0 < NQR) q = qr[d0]; else q = *(const LAS bf16x8*)(qlb + (d0 - NQR) * 1024);
            p0 = __builtin_amdgcn_mfma_f32_32x32x16_bf16(b0, q, p0, 0, 0, 0);
            p1 = __builtin_amdgcn_mfma_f32_32x32x16_bf16(b1, q, p1, 0, 0, 0); }
}
__device__ __forceinline__ void partialSM(f32x16& p0, f32x16& p1, float bias) {
#pragma unroll
    for (int r = 0; r < 16; ++r) p0[r] = __builtin_amdgcn_exp2f(p0[r] + bias);
#pragma unroll
    for (int r = 0; r < 16; ++r) p1[r] = p1[r] + bias;
}
__device__ __forceinline__ void finishSM(f32x16& p0, f32x16& p1, float& l_reg, bf16x8& pa0, bf16x8& pa1, bf16x8& pa2, bf16x8& pa3) {
#pragma unroll
    for (int r = 0; r < 16; ++r) p1[r] = __builtin_amdgcn_exp2f(p1[r]);
    float ps = 0;
#pragma unroll
    for (int r = 0; r < 16; ++r) ps += p0[r];
#pragma unroll
    for (int r = 0; r < 16; ++r) ps += p1[r];
    { auto rr = __builtin_amdgcn_permlane32_swap(__float_as_uint(ps), __float_as_uint(ps), false, false); ps = __uint_as_float(rr[0]) + __uint_as_float(rr[1]); }
    l_reg += ps;
#define PK4(P, BASE, OUT) do { unsigned a0 = cvt_pk_bf16(P[BASE + 0], P[BASE + 1]), a1 = cvt_pk_bf16(P[BASE + 2], P[BASE + 3]);   \
    unsigned b0 = cvt_pk_bf16(P[BASE + 4], P[BASE + 5]), b1 = cvt_pk_bf16(P[BASE + 6], P[BASE + 7]);                              \
    auto r0 = __builtin_amdgcn_permlane32_swap(a0, b0, false, false); auto r1 = __builtin_amdgcn_permlane32_swap(a1, b1, false, false); \
    u32x4 w = {r0[0], r1[0], r0[1], r1[1]}; OUT = *reinterpret_cast<bf16x8*>(&w); } while (0)
    PK4(p0, 0, pa0); PK4(p0, 8, pa1); PK4(p1, 0, pa2); PK4(p1, 8, pa3);
#undef PK4
}
__device__ __forceinline__ void attn_qblock(const bf16_t* __restrict__ Qb, const bf16_t* __restrict__ Kh, const bf16_t* __restrict__ Vh, bf16_t* __restrict__ Ob, int qb, float Mb, LAS char* lds, const int wid,
                                            const float2* __restrict__ ropeb, const float* __restrict__ gq) {
    const int lane = fresh_lane(), tid = wid * 64 + lane, r32 = lane & 31, hi = lane >> 5;
    LAS char* V_lds = lds + OFF_V; LAS char* K_lds = lds + OFF_K;
    LAS float* li_l = (LAS float*)(lds + OFF_WS) + wid * 64;
    float l_reg = 0; f32x16 o[4] = {}; bf16x8 qr[NQR];
    const int qlb = (int)(uintptr_t)(lds + OFF_QL) + wid * ((12 - NQR) * 1024) + lane * 16;
    {
        const bf16_t* Qw = Qb + (size_t)(wid * 32 + r32) * (NH * DQK) + hi * 8;
        bf16x8 qf[12];
#pragma unroll
        for (int d0 = 0; d0 < 12; ++d0) qf[d0] = *(const bf16x8*)(Qw + d0 * 16);
        float ssq = 0.f;
#pragma unroll
        for (int d0 = 0; d0 < 12; ++d0)
#pragma unroll
            for (int j = 0; j < 8; ++j) { const float v = bf2f((unsigned short)qf[d0][j]); ssq += v * v; }
        ssq += __shfl_xor(ssq, 32);
        const float rn = QSCALE / sqrtf(ssq * (1.0f / DQK) + EPS);
        const float2* rp = ropeb + (size_t)(wid * 32 + r32) * 32 + hi * 8;
#pragma unroll
        for (int d0 = 0; d0 < 12; ++d0) { bf16x8 qn;
            if (d0 < 8) { const f32x4 g0 = *(const f32x4*)(gq + d0 * 16 + hi * 8), g1 = *(const f32x4*)(gq + d0 * 16 + hi * 8 + 4);
#pragma unroll
                for (int j = 0; j < 8; ++j) qn[j] = (short)f2bf(bf2f((unsigned short)qf[d0][j]) * rn * (j < 4 ? g0[j] : g1[j - 4])); }
            else { const int pp = (d0 - 8) & 1, da = 8 + pp, db = 10 + pp; const bool second = d0 >= 10;
#pragma unroll
                for (int j = 0; j < 8; ++j) { const float2 c = rp[pp * 16 + j];
                    const float y1 = bf2f((unsigned short)qf[da][j]) * rn * gq[128 + pp * 16 + hi * 8 + j], y2 = bf2f((unsigned short)qf[db][j]) * rn * gq[160 + pp * 16 + hi * 8 + j];
                    qn[j] = (short)f2bf(second ? (y2 * c.x + y1 * c.y) : (y1 * c.x - y2 * c.y)); } }
            if (d0 < NQR) qr[d0] = qn; else *(LAS bf16x8*)(qlb + (d0 - NQR) * 1024) = qn; }
    }
    const int sr = tid >> 4, sc = (tid & 15) * 8, vst0 = v_st(sr, sc), vst1 = v_st(32 + sr, sc);
    int kro[3], kst[3];
#pragma unroll
    for (int i = 0; i < 3; ++i) { const int q = tid + 512 * i, row = q / 24, c8 = q % 24; kro[i] = row * DQK + c8 * 8; kst[i] = KSWZ(row, c8 * 16); }
    const int vb0 = (int)(uintptr_t)V_lds + v_rd_base(lane);
    int kb[4];
#pragma unroll
    for (int b = 0; b < 4; ++b) kb[b] = (int)(uintptr_t)K_lds + r32 * 384 + ((b * 32 + hi * 16) ^ (((r32 >> 1) & 7) << 4));
    bf16x8 vs0, vs1, ks0, ks1, ks2;
#define SLOAD(k0) do { vs0 = *(const bf16x8*)(Vh + (size_t)((k0) + sr) * DV + sc); vs1 = *(const bf16x8*)(Vh + (size_t)((k0) + 32 + sr) * DV + sc); \
    ks0 = *(const bf16x8*)(Kh + (size_t)(k0) * DQK + kro[0]); ks1 = *(const bf16x8*)(Kh + (size_t)(k0) * DQK + kro[1]); ks2 = *(const bf16x8*)(Kh + (size_t)(k0) * DQK + kro[2]); } while (0)
#define SWRITE(b) do { *(LAS bf16x8*)(V_lds + (b) * SHM_V + vst0) = vs0; *(LAS bf16x8*)(V_lds + (b) * SHM_V + vst1) = vs1; \
    *(LAS bf16x8*)(K_lds + (b) * SHM_K + kst[0]) = ks0; *(LAS bf16x8*)(K_lds + (b) * SHM_K + kst[1]) = ks1; *(LAS bf16x8*)(K_lds + (b) * SHM_K + kst[2]) = ks2; } while (0)
    const int NT = 4 * qb + 4, jmax = 4 * qb + (wid >> 1);
    f32x16 pA0, pA1, pB0, pB1; bf16x8 pa0, pa1, pa2, pa3;
    SLOAD(0); asm volatile("s_waitcnt vmcnt(0)" ::: "memory"); SWRITE(0); __syncthreads();
    qkt<0, NQR>(pA0, pA1, kb, qr, qlb); partialSM(pA0, pA1, -Mb);
    SLOAD(KVB); asm volatile("s_waitcnt vmcnt(0)" ::: "memory"); SWRITE(1); __syncthreads();
    for (int j = 1; j + 1 < NT; j += 2) {
        SBAR(); if (j <= jmax) qkt<1, NQR>(pB0, pB1, kb, qr, qlb);
        if (j - 1 <= jmax) finishSM(pA0, pA1, l_reg, pa0, pa1, pa2, pa3); SBAR();
        SLOAD((j + 1) * KVB); SBAR();
        if (j - 1 <= jmax) pv_d0(o, vb0, pa0, pa1, pa2, pa3); if (j <= jmax) partialSM(pB0, pB1, -Mb);
        __syncthreads(); asm volatile("s_waitcnt vmcnt(0)" ::: "memory"); SWRITE(0);
        __syncthreads();
        SBAR(); if (j + 1 <= jmax) qkt<0, NQR>(pA0, pA1, kb, qr, qlb);
        if (j <= jmax) finishSM(pB0, pB1, l_reg, pa0, pa1, pa2, pa3); SBAR();
        SLOAD((j + 2) * KVB); SBAR();
        if (j <= jmax) pv_d0(o, vb0 + SHM_V, pa0, pa1, pa2, pa3); if (j + 1 <= jmax) partialSM(pA0, pA1, -Mb);
        __syncthreads(); asm volatile("s_waitcnt vmcnt(0)" ::: "memory"); SWRITE(1);
        __syncthreads();
    }
    SBAR(); if (NT - 1 <= jmax) qkt<1, NQR>(pB0, pB1, kb, qr, qlb);
    if (NT - 2 <= jmax) { finishSM(pA0, pA1, l_reg, pa0, pa1, pa2, pa3); SBAR(); pv_d0(o, vb0, pa0, pa1, pa2, pa3); }
    if (NT - 1 <= jmax) { partialSM(pB0, pB1, -Mb); finishSM(pB0, pB1, l_reg, pa0, pa1, pa2, pa3); SBAR(); pv_d0(o, vb0 + SHM_V, pa0, pa1, pa2, pa3); }
    __syncthreads();
    const int lane2 = fresh_lane(), r32b = lane2 & 31, hib = lane2 >> 5, wid2 = wid;
    LAS float* li2 = (LAS float*)(lds + OFF_WS) + wid2 * 64;
    if (hib == 0) li2[r32b] = l_reg; LDS_WAIT();
    LAS char* ost = lds + OFF_OST + wid2 * (32 * OPITCH) + hib * (4 * OPITCH) + r32b * 2;
#pragma unroll
    for (int r = 0; r < 16; ++r) { const int orc = (r & 3) + 8 * (r >> 2); const float rl = __builtin_amdgcn_rcpf(li2[orc + 4 * hib]);
#pragma unroll
        for (int d0 = 0; d0 < 4; ++d0) *(LAS bf16_t*)(ost + orc * OPITCH + d0 * 64) = (bf16_t)f2bf(o[d0][r] * rl); }
    LDS_WAIT();
    bf16_t* Ow = Ob + (size_t)(wid2 * 32 + (lane2 >> 4)) * DM + (lane2 & 15) * 8;
    const LAS char* ord = lds + OFF_OST + wid2 * (32 * OPITCH) + (lane2 >> 4) * OPITCH + (lane2 & 15) * 16;
#pragma unroll
    for (int i = 0; i < 8; ++i) { const u32x4 w = *(const LAS u32x4*)(ord + i * 4 * OPITCH); *(u32x4*)(Ow + (size_t)(i * 4) * DM) = w; }
    __syncthreads();
#undef SLOAD
#undef SWRITE
}
#undef KSWZ
}
__device__ __forceinline__ void p4_attention(const Args& a, const Frame& F) {
    FRAME_IDS(F);
    const bf16_t* qraw = (const bf16_t*)(F.ws + WS_QRAW); const bf16_t* Kn = (const bf16_t*)(F.ws + WS_KN); const bf16_t* Vn = (const bf16_t*)(F.ws + WS_VN);
    bf16_t* O = (bf16_t*)(F.ws + WS_O); const float2* rope = (const float2*)(F.ws + WS_ROPE);
    const float Mb = attn_bound(a, F_lane);
    for (int id = F.bx; id < NB * NH * 4; id += F.G) { const int x = id & 7, idx = id >> 3, bh = x + 8 * (idx >> 2), pr = idx & 3, b = bh >> 4, h = bh & 15;
        const bf16_t* Kh = Kn + (size_t)bh * SEQ * DQK; const bf16_t* Vh = Vn + (size_t)bh * SEQ * DV;
#pragma unroll 1
        for (int w = 0; w < 2; ++w) { const int qb = w ? pr : 7 - pr; const size_t tok0 = (size_t)b * SEQ + qb * 256;
            at::attn_qblock(qraw + tok0 * (NH * DQK) + h * DQK, Kh, Vh, O + tok0 * DM + h * DV, qb, Mb, (LAS char*)F.lds, F.wave, rope + tok0 * 32, a.in[I_QKQG]); }
    }
}

__device__ __forceinline__ void p8_norm2_router(const Args& a, const Frame& F, const float* x1) {
    FRAME_IDS(F);
    bf16_t* H2 = (bf16_t*)(F.ws + WS_H2); int* topi = (int*)(F.ws + WS_TOPI); float* topw = (float*)(F.ws + WS_TOPW);
    const float* wrp = (const float*)(F.ws + WS_SMALL + SM_WRP); const float* g2 = a.in[I_N2G];
    const int lane = F_lane, wave = F.wave, tid = F_tid, i = lane & 31, kk = lane >> 5;
    LAS uchar* xs = F.lds + wave * 8704;
    LAS float* part = (LAS float*)(F.lds + 69632);
    LAS float* ssqp = (LAS float*)(F.lds + 69632 + 33792);
    LAS float* logit = ssqp + 256;
    LAS float* rstdl = logit + 32 * 33;
    for (int tile = F.bx; tile < TT / 32; tile += F.G) {
        const int t0 = tile * 32;
        f32x16 acc = {}; float ssq = 0.f;
        for (int ch = 0; ch < 4; ++ch) { const int k0 = wave * 256 + ch * 64;
            f32x4 v[8];
#pragma unroll
            for (int j = 0; j < 8; ++j) v[j] = *(const f32x4*)(x1 + (size_t)(t0 + 4 * j + (lane >> 4)) * DM + k0 + (lane & 15) * 4);
#pragma unroll
            for (int j = 0; j < 8; ++j) *(LAS f32x4*)(xs + (4 * j + (lane >> 4)) * 272 + (lane & 15) * 16) = v[j];
            LDS_WAIT(); asm volatile("" ::: "memory");
            const float* wp = wrp + (size_t)(k0 + kk * 32) * NE + i;
#pragma unroll
            for (int s4 = 0; s4 < 8; ++s4) { const f32x4 xv = *(const LAS f32x4*)(xs + i * 272 + kk * 128 + s4 * 16);
#pragma unroll
                for (int q = 0; q < 4; ++q) { const float b = wp[(s4 * 4 + q) * NE]; acc = __builtin_amdgcn_mfma_f32_32x32x2f32(xv[q], b, acc, 0, 0, 0); ssq += xv[q] * xv[q]; } }
            LDS_WAIT(); asm volatile("" ::: "memory");
        }
#pragma unroll
        for (int r = 0; r < 16; ++r) part[(wave * 32 + (r & 3) + 8 * (r >> 2) + 4 * kk) * 33 + i] = acc[r];
        ssq += __shfl_xor(ssq, 32);
        if (kk == 0) ssqp[wave * 32 + i] = ssq;
        __syncthreads();
        { const int row = tid >> 4, e0 = (tid & 15) * 2; float s0 = 0.f, s1 = 0.f;
#pragma unroll
          for (int w = 0; w < 8; ++w) { s0 += part[(w * 32 + row) * 33 + e0]; s1 += part[(w * 32 + row) * 33 + e0 + 1]; }
          logit[row * 33 + e0] = s0; logit[row * 33 + e0 + 1] = s1;
          if (tid < 32) { float q = 0.f;
#pragma unroll
              for (int w = 0; w < 8; ++w) q += ssqp[w * 32 + tid];
              rstdl[tid] = 1.0f / sqrtf(q * (1.0f / DM) + EPS); } }
        __syncthreads();
        if (tid < 32) { const float rs = rstdl[tid]; float lg[32];
#pragma unroll
            for (int e = 0; e < 32; ++e) lg[e] = logit[tid * 33 + e] * rs + a.in[I_BR][e];
            int bi[4]; float bv[4];
#pragma unroll
            for (int k = 0; k < 4; ++k) { float m = -3.0e38f; int mi = 0;
#pragma unroll
                for (int e = 0; e < 32; ++e) { const bool used = (k > 0 && bi[0] == e) || (k > 1 && bi[1] == e) || (k > 2 && bi[2] == e); if (!used && lg[e] > m) { m = lg[e]; mi = e; } }
                bi[k] = mi; bv[k] = m; }
            const float e1 = __expf(bv[1] - bv[0]), e2 = __expf(bv[2] - bv[0]), e3 = __expf(bv[3] - bv[0]); const float rsum = 1.0f / (1.0f + e1 + e2 + e3);
            const int t = t0 + tid;
            *(int4*)(topi + 4 * t) = make_int4(bi[0], bi[1], bi[2], bi[3]); *(float4*)(topw + 4 * t) = make_float4(rsum, e1 * rsum, e2 * rsum, e3 * rsum); }
#pragma unroll 4
        for (int it = 0; it < 16; ++it) { const int idx = it * NTHREADS + tid, row = idx >> 8, c8 = (idx & 255) * 8; const float rs = rstdl[row];
            const f32x4 x0 = *(const f32x4*)(x1 + (size_t)(t0 + row) * DM + c8), x1v = *(const f32x4*)(x1 + (size_t)(t0 + row) * DM + c8 + 4);
            const f32x4 g0 = *(const f32x4*)(g2 + c8), g1 = *(const f32x4*)(g2 + c8 + 4);
#if MK_FP8_MOE
            const float rs4 = rs * FP8_ASCALE; u32x2 o; o.x = pk4_fp8(x0.x * rs4 * g0.x, x0.y * rs4 * g0.y, x0.z * rs4 * g0.z, x0.w * rs4 * g0.w); o.y = pk4_fp8(x1v.x * rs4 * g1.x, x1v.y * rs4 * g1.y, x1v.z * rs4 * g1.z, x1v.w * rs4 * g1.w);
            *(u32x2*)((uchar*)H2 + (size_t)(t0 + row) * DM + c8) = o; }
#else
            u32x4 o; o.x = pk2(x0.x * rs * g0.x, x0.y * rs * g0.y); o.y = pk2(x0.z * rs * g0.z, x0.w * rs * g0.w); o.z = pk2(x1v.x * rs * g1.x, x1v.y * rs * g1.y); o.w = pk2(x1v.z * rs * g1.z, x1v.w * rs * g1.w);
            *(u32x4*)(H2 + (size_t)(t0 + row) * DM + c8) = o; }
#endif
        __syncthreads();
    }
}

__device__ __forceinline__ void p9_routing(const Args& a, const Frame& F) {
    FRAME_IDS(F);
    const int* topi = (const int*)(F.ws + WS_TOPI); int* tpos = (int*)(F.ws + WS_TPOS); int* list = (int*)(F.ws + WS_LIST); int* counts = (int*)(F.ws + WS_SMALL + SM_COUNTS);
    LAS int* wtot = (LAS int*)F.lds;
    for (int e = F.bx; e < NE; e += F.G) {
        __syncthreads();
        const int t0 = F.wave * (TT / NWAVES);
        int cnt = 0;
        for (int i = 0; i < TT / NWAVES / 64; ++i) { const int4 ti = *(const int4*)(topi + 4 * (t0 + i * 64 + F_lane));
            const bool hit = (ti.x == e) | (ti.y == e) | (ti.z == e) | (ti.w == e); cnt += __popcll(__ballot(hit)); }
        if (F_lane == 0) wtot[F.wave] = cnt;
        __syncthreads();
        int base = 0, total = 0;
        for (int w = 0; w < NWAVES; ++w) { const int c = wtot[w]; if (w < F.wave) base += c; total += c; }
        for (int i = 0; i < TT / NWAVES / 64; ++i) { const int t = t0 + i * 64 + F_lane; const int4 ti = *(const int4*)(topi + 4 * t);
            const int k = (ti.x == e) ? 0 : (ti.y == e) ? 1 : (ti.z == e) ? 2 : (ti.w == e) ? 3 : -1;
            const unsigned long long bal = __ballot(k >= 0); const int pos = base + __popcll(bal & ((1ull << F_lane) - 1ull));
            if (k >= 0) { list[(size_t)e * TT + pos] = t; tpos[4 * t + k] = pos; }
            base += __popcll(bal); }
        for (int q = total + F_tid; q < ((total + 255) & ~255); q += NTHREADS) list[(size_t)e * TT + q] = 0;
        if (F_tid == 0) counts[e] = total;
    }
}
__device__ __forceinline__ void moe_tables(const Frame& F, LAS int* tab) {
    FRAME_IDS(F);
    const int* counts = (const int*)(F.ws + WS_SMALL + SM_COUNTS);
    __syncthreads();
    if (F_tid == 0) { int pre = 0; for (int e = 0; e < NE; ++e) { const int c = counts[e]; tab[e] = c; const int nt = (c + 255) >> 8; tab[32 + e] = nt; tab[64 + e] = pre; tab[128 + e] = nt > 0 ? ((1 << 20) + nt - 1) / nt : 0; pre += nt; } tab[96] = pre;
        unsigned used = 0u; for (int r = 0; r < NE; ++r) { int best = -1, bn = -1; for (int e = 0; e < NE; ++e) if (!((used >> e) & 1u) && tab[32 + e] > bn) { bn = tab[32 + e]; best = e; }
            used |= 1u << best; const int q = r >> 3, pos = r & 7, xx = (q & 1) ? 7 - pos : pos; tab[160 + xx * 4 + q] = best; } }
    __syncthreads();
}

__device__ __forceinline__ void p10_permute(const Args& a, const Frame& F, const LAS int* tab) {
    FRAME_IDS(F);
    constexpr size_t ROWB = MK_FP8_MOE ? DM : 2 * DM;
    const uchar* H2 = F.ws + WS_H2; uchar* XP = F.ws + WS_XPERM; const int* list = (const int*)(F.ws + WS_LIST);
    const int ntiles = tab[96];
    for (int tile = F.bx; tile < ntiles; tile += F.G) {
        int e = 0;
#pragma unroll 1
        for (int q = 1; q < NE; ++q) if (tab[64 + q] <= tile) e = q;
        const int p0 = (tile - tab[64 + e]) * 256;
        for (int r0 = F.wave * 32; r0 < F.wave * 32 + 32; r0 += 8) { int tok[8]; u32x4 v[8][ROWB / 1024];
#pragma unroll
            for (int q = 0; q < 8; ++q) tok[q] = list[(size_t)e * TT + p0 + r0 + q];
#pragma unroll
            for (int q = 0; q < 8; ++q)
#pragma unroll
                for (int c = 0; c < (int)(ROWB / 1024); ++c) v[q][c] = *(const u32x4*)(H2 + (size_t)tok[q] * ROWB + c * 1024 + F_lane * 16);
#pragma unroll
            for (int q = 0; q < 8; ++q)
#pragma unroll
                for (int c = 0; c < (int)(ROWB / 1024); ++c) *(u32x4*)(XP + ((size_t)tile * 256 + r0 + q) * ROWB + c * 1024 + F_lane * 16) = v[q][c]; }
    }
}

__device__ __forceinline__ void p12_combine(const Args& a, const Frame& F, float* out, const LAS int* tab) {
    FRAME_IDS(F);
    const bf16_t* ys = (const bf16_t*)(F.ws + WS_YSLOT); const int* topi = (const int*)(F.ws + WS_TOPI); const float* topw = (const float*)(F.ws + WS_TOPW); const int* tpos = (const int*)(F.ws + WS_TPOS);
    const int lane = F_lane, gw = F.bx * NWAVES + F.wave, NGW = F.G * NWAVES;
    for (int t = gw; t < TT; t += NGW) {
        const int4 ti = *(const int4*)(topi + 4 * t), tp = *(const int4*)(tpos + 4 * t); const float4 tw = *(const float4*)(topw + 4 * t);
        const bf16_t* r0 = ys + ((size_t)tab[64 + ti.x] * 256 + tp.x) * DM; const bf16_t* r1 = ys + ((size_t)tab[64 + ti.y] * 256 + tp.y) * DM;
        const bf16_t* r2 = ys + ((size_t)tab[64 + ti.z] * 256 + tp.z) * DM; const bf16_t* r3 = ys + ((size_t)tab[64 + ti.w] * 256 + tp.w) * DM;
        float* orow = out + (size_t)t * DM;
#pragma unroll
        for (int j = 0; j < 4; ++j) { const int c = j * 512 + lane * 8;
            const u32x4 a0 = *(const u32x4*)(r0 + c), a1 = *(const u32x4*)(r1 + c), a2 = *(const u32x4*)(r2 + c), a3 = *(const u32x4*)(r3 + c);
            f32x4 x0 = *(const f32x4*)(orow + c), x1 = *(const f32x4*)(orow + c + 4);
#pragma unroll
            for (int q = 0; q < 2; ++q) {
                x0[2 * q] += tw.x * bflo(a0[q]) + tw.y * bflo(a1[q]) + tw.z * bflo(a2[q]) + tw.w * bflo(a3[q]);
                x0[2 * q + 1] += tw.x * bfhi(a0[q]) + tw.y * bfhi(a1[q]) + tw.z * bfhi(a2[q]) + tw.w * bfhi(a3[q]);
                x1[2 * q] += tw.x * bflo(a0[2 + q]) + tw.y * bflo(a1[2 + q]) + tw.z * bflo(a2[2 + q]) + tw.w * bflo(a3[2 + q]);
                x1[2 * q + 1] += tw.x * bfhi(a0[2 + q]) + tw.y * bfhi(a1[2 + q]) + tw.z * bfhi(a2[2 + q]) + tw.w * bfhi(a3[2 + q]); }
            *(f32x4*)(orow + c) = x0; *(f32x4*)(orow + c + 4) = x1; }
    }
}

constexpr int NPHASE = 14;
__global__ void __launch_bounds__(NTHREADS, 2) mk_fwd(Args a) {
    extern __shared__ __attribute__((aligned(16))) uchar lds_raw[];
    Frame F; F.lds = (LAS uchar*)lds_raw; F.ws = a.ws; F.wave = __builtin_amdgcn_readfirstlane(threadIdx.x >> 6); F.G = gridDim.x; F.bx = blockIdx.x;
    FRAME_IDS(F);
    volatile LAS unsigned* MISC = (volatile LAS unsigned*)(F.lds + MISC_OFF);
    LAS int* tab = (LAS int*)(F.lds + LDSCTL_OFF + 512);
    for (int u = F_tid; u < (LDS_BYTES - LDSCTL_OFF) / 4; u += NTHREADS) ((LAS unsigned*)(F.lds + LDSCTL_OFF))[u] = 0u;
    __syncthreads();
    XcdBarrier bar; bar.bar = (unsigned*)(a.ws + WS_CTL) + CW_BAR; bar.x = 0; bar.st = nullptr; bar.wave = F.wave;
    const int lo = a.ph_lo, hi = a.ph_hi;
    if (hi - lo > 1) bar = xcd_barrier_post((unsigned*)(a.ws + WS_CTL) + CW_BAR, MISC + 8, F.wave);
#ifndef MK_PHASE_MASK
#define MK_PHASE_MASK 0xffff
#endif
#define IN(k) (((MK_PHASE_MASK >> (k)) & 1) && lo <= (k) && (k) < hi)
#ifdef MK_PROBE_LO
    volatile LAS unsigned long long* pr_t = (volatile LAS unsigned long long*)(F.lds + LDSCTL_OFF + 64);
#define PROBE_AT(k) do { if ((k) == MK_PROBE_LO && F.wave == 0 && fresh_lane() == 0) pr_t[0] = __builtin_amdgcn_s_memrealtime(); if ((k) == MK_PROBE_HI + 1 && F.wave == 0 && fresh_lane() == 0) pr_t[1] = __builtin_amdgcn_s_memrealtime(); } while (0)
#else
#define PROBE_AT(k) do { } while (0)
#endif
#define SEAM(k) do { if (IN(k) && IN((k) + 1)) xcd_barrier(bar); } while (0)
    LAS uchar* ring = F.lds;
    uchar* ws = a.ws;
    const int G = F.G, bx = F.bx;

    PROBE_AT(0);
    if (IN(0)) { p0_prologue(a, F); } SEAM(0); PROBE_AT(1);

    if (IN(1)) {
        gm::ProbDense P; P.init((const bf16_t*)(ws + WS_H), DM, (const bf16_t*)(ws + WS_WIN), DM, DM, TT, NPROJ, G, bx);
        EpiInProj E{(bf16_t*)(ws + WS_PROJ), (bf16_t*)(ws + WS_APACK), a.in[I_BG], (float*)(ws + WS_SSQP)};
        gm::gemm_phase<gm::ProbDense, EpiInProj, false>(ring, P, E, F.wave);
    } SEAM(1); PROBE_AT(2);

    if (IN(2)) {
        { gm::ProbDense P; P.init((const bf16_t*)(ws + WS_PROJ) + C_QLAT, NPROJ, (const bf16_t*)(ws + WS_WUQ), QLORA, QLORA, TT, NH * DQK, G, bx);
          EpiStoreScaled<0, 8, QLORA> E{(bf16_t*)(ws + WS_QRAW), NH * DQK, (const float*)(ws + WS_SSQP)}; gm::gemm_phase<gm::ProbDense, EpiStoreScaled<0, 8, QLORA>, false>(ring, P, E, F.wave); }
        { gm::ProbDense P; P.init((const bf16_t*)(ws + WS_PROJ) + C_KVLAT, NPROJ, (const bf16_t*)(ws + WS_WUKV), KVLORA, KVLORA, TT, NH * 256, G, bx);
          EpiKV E{(bf16_t*)(ws + WS_KVRAW), (bf16_t*)(ws + WS_VN), (const float*)(ws + WS_SSQP)}; gm::gemm_phase<gm::ProbDense, EpiKV, false>(ring, P, E, F.wave); }
#if MK_FAST_S5
        { ProbS5 P{(const bf16_t*)(ws + WS_APACK), (const bf16_t*)(ws + WS_WS5), APK, 256, 4, G, bx};
          EpiS5State E{(float*)(ws + WS_SCH)}; gm::gemm_phase<ProbS5, EpiS5State, false>(ring, P, E, F.wave); }
#endif
    } SEAM(2); PROBE_AT(3);

    if (IN(3)) {
#if MK_FAST_S5
        p3_scan(a, F);
#endif
        p3_prep(a, F);
    } SEAM(3); PROBE_AT(4);

    if (IN(4)) {
#if MK_FAST_S5
        { ProbS5 P{(const bf16_t*)(ws + WS_APACK), (const bf16_t*)(ws + WS_TWC), APK, APK, 6, G, bx};
          EpiS5Out E{(bf16_t*)(ws + WS_GACT)}; gm::gemm_phase<ProbS5, EpiS5Out, false>(ring, P, E, F.wave); }
#else
        s5_reference(a, F);
#endif
#if MK_FAST_ATTN
        p4_attention(a, F);
#else
        attn_reference(a, F);
#endif
    } SEAM(4); PROBE_AT(5);

    if (IN(5)) {
        { gm::ProbDense P; P.init((const bf16_t*)(ws + WS_GACT), S5W, (const bf16_t*)(ws + WS_WGLU), S5W, S5W, TT, S5W, G, bx);
          EpiSide<0> E{(bf16_t*)(ws + WS_Y2), S5W, (const bf16_t*)(ws + WS_GACT), S5W, nullptr, 0}; gm::gemm_phase<gm::ProbDense, EpiSide<0>, false>(ring, P, E, F.wave); }
        { gm::ProbDense P; P.init((const bf16_t*)(ws + WS_O), DM, (const bf16_t*)(ws + WS_WOMLA), DM, DM, TT, DM, G, bx);
          EpiSide<1> E{(bf16_t*)(ws + WS_MA), DM, (const bf16_t*)(ws + WS_PROJ) + C_GA, NPROJ, nullptr, 0}; gm::gemm_phase<gm::ProbDense, EpiSide<1>, false>(ring, P, E, F.wave); }
    } SEAM(5); PROBE_AT(6);

    if (IN(6)) {
        gm::ProbDense P; P.init((const bf16_t*)(ws + WS_Y2), S5W, (const bf16_t*)(ws + WS_WOS5), S5W, S5W, TT, DM, G, bx);
        EpiSide<2> E{(bf16_t*)(ws + WS_M), DM, (const bf16_t*)(ws + WS_PROJ) + C_GB, NPROJ, (const bf16_t*)(ws + WS_MA), DM}; gm::gemm_phase<gm::ProbDense, EpiSide<2>, false>(ring, P, E, F.wave);
    } SEAM(6); PROBE_AT(7);

    if (IN(7)) {
        gm::ProbDense P; P.init((const bf16_t*)(ws + WS_M), DM, (const bf16_t*)(ws + WS_WOUT), DM, DM, TT, DM, G, bx);
        EpiResidF32 E{a.in[I_X], a.out}; gm::gemm_phase<gm::ProbDense, EpiResidF32, false>(ring, P, E, F.wave);
    } SEAM(7); PROBE_AT(8);

    if (IN(8)) { p8_norm2_router(a, F, a.out); } SEAM(8); PROBE_AT(9);
    if (IN(9)) { p9_routing(a, F); } SEAM(9); PROBE_AT(10);

    if (IN(10) || IN(11) || IN(12) || IN(13)) moe_tables(F, tab);
    const int xl = bx & 7, rk = bx >> 3, nrk = (G - xl + 7) >> 3;
    if (IN(10)) { p10_permute(a, F, tab); } SEAM(10); PROBE_AT(11);
    if (IN(11)) {
        ProbMoE P{(const bf16_t*)(ws + WS_XPERM), (const bf16_t*)(ws + WS_W1), DM, DM, MK_FP8_MOE ? DM / 128 : DM / 64, 16, (size_t)4096 * DM, xl, rk, nrk}; P.load(tab);
        EpiSwiglu E{(bf16_t*)(ws + WS_HACT), a.in[I_BGATE], a.in[I_BUP], tab}; gm::gemm_phase<ProbMoE, EpiSwiglu, false, MK_FP8_MOE != 0>(ring, P, E, F.wave);
    } SEAM(11); PROBE_AT(12);
    if (IN(12)) {
        ProbMoE P{(const bf16_t*)(ws + WS_HACT), (const bf16_t*)(ws + WS_W2), DFF, DFF, MK_FP8_MOE ? DFF / 128 : DFF / 64, 8, (size_t)DM * DFF, xl, rk, nrk}; P.load(tab);
        EpiDown E{(bf16_t*)(ws + WS_YSLOT), a.in[I_BDOWN], tab}; gm::gemm_phase<ProbMoE, EpiDown, false, MK_FP8_MOE != 0>(ring, P, E, F.wave);
    } SEAM(12); PROBE_AT(13);
    if (IN(13)) { p12_combine(a, F, a.out, tab); }
    PROBE_AT(14);
#ifdef MK_PROBE_LO
    if (blockIdx.x == 0 && F.wave == 0 && fresh_lane() == 0) { const unsigned long long dt = (pr_t[1] - pr_t[0]) * MK_PROBE_X, te = __builtin_amdgcn_s_memrealtime();
        while (__builtin_amdgcn_s_memrealtime() - te < dt) __builtin_amdgcn_s_sleep(32); }
#endif
#undef IN
#undef SEAM
}

extern "C" void kernel_launch(void* const* d_in, const int* in_sizes, int n_in, void* d_out, int out_size, void* d_ws, size_t ws_size, hipStream_t stream) {
    static int grid = 0;
    if (grid == 0) {
        if (n_in != 32 || in_sizes[0] != TT * DM || out_size != TT * DM || ws_size < WS_END) {
            fprintf(stderr, "kernel_launch: shape mismatch: n_in %d in0 %d out %d ws %zu (need %zu); nothing launched\n", n_in, n_in > 0 ? in_sizes[0] : -1, out_size, ws_size, (size_t)WS_END); grid = -1; return; }
        int dev = 0, cus = 0, per_cu = 0;
        if (hipGetDevice(&dev) != hipSuccess || hipDeviceGetAttribute(&cus, hipDeviceAttributeMultiprocessorCount, dev) != hipSuccess) { fprintf(stderr, "kernel_launch: device query failed\n"); grid = -1; return; }
        if (hipFuncSetAttribute((const void*)mk_fwd, hipFuncAttributeMaxDynamicSharedMemorySize, LDS_BYTES) != hipSuccess) { fprintf(stderr, "kernel_launch: hipFuncSetAttribute failed\n"); grid = -1; return; }
        if (hipOccupancyMaxActiveBlocksPerMultiprocessor(&per_cu, (const void*)mk_fwd, NTHREADS, LDS_BYTES) != hipSuccess || per_cu < 1)
            fprintf(stderr, "kernel_launch: note: occupancy query reports %d workgroups per CU\n", per_cu);
        (void)hipGetLastError();
        grid = cus - (cus % 8);
        if (grid < 8) grid = 8;
    }
    if (grid < 0) return;
    if (hipMemsetAsync((char*)d_ws + WS_CTL, 0, CTL_ZERO_BYTES, stream) != hipSuccess) { fprintf(stderr, "kernel_launch: memset failed\n"); return; }
    Args a{};
    for (int i = 0; i < 32; ++i) a.in[i] = (const float*)d_in[i];
    a.out = (float*)d_out; a.ws = (uchar*)d_ws;
#if MK_ONE_LAUNCH
    a.ph_lo = 0; a.ph_hi = NPHASE;
    hipLaunchKernelGGL(mk_fwd, dim3(grid), dim3(NTHREADS), LDS_BYTES, stream, a);
#else
    for (int p = 0; p < NPHASE; ++p) { a.ph_lo = p; a.ph_hi = p + 1; hipLaunchKernelGGL(mk_fwd, dim3(grid), dim3(NTHREADS), LDS_BYTES, stream, a); }
#endif
    const hipError_t le = hipPeekAtLastError();
    if (le != hipSuccess) fprintf(stderr, "kernel_launch: launch failed: %s\n", hipGetErrorName(le));
}
```

```cpp
#include <hip/hip_runtime.h>
#include <cstdio>
#include <cstdint>

#ifndef MK_ONE_LAUNCH
#define MK_ONE_LAUNCH 1
#endif
#ifndef MK_FAST_GEMM
#define MK_FAST_GEMM 1
#endif
#ifndef MK_FAST_ATTN
#define MK_FAST_ATTN 1
#endif
#ifndef MK_FAST_S5
#define MK_FAST_S5 1
#endif

#ifndef MK_FP8_MOE
#define MK_FP8_MOE 1
#endif
#define LAS __attribute__((address_space(3)))
#define GAS __attribute__((address_space(1)))
typedef unsigned short bf16_t;
typedef short bf16x8 __attribute__((ext_vector_type(8)));
typedef short s16x4 __attribute__((ext_vector_type(4)));
typedef float f32x2 __attribute__((ext_vector_type(2)));
typedef float f32x4 __attribute__((ext_vector_type(4)));
typedef float f32x16 __attribute__((ext_vector_type(16)));
typedef unsigned u32x2 __attribute__((ext_vector_type(2)));
typedef unsigned u32x4 __attribute__((ext_vector_type(4)));
typedef unsigned char uchar;
typedef int v4i __attribute__((ext_vector_type(4)));
typedef int v8i __attribute__((ext_vector_type(8)));
constexpr float FP8_YSCALE = 16.0f;
constexpr float FP8_ASCALE = 4.0f, FP8_WSCALE = 64.0f;
__device__ __forceinline__ unsigned pk4_fp8(float a, float b, float c, float d) { int w = __builtin_amdgcn_cvt_pk_fp8_f32(a, b, 0, false); w = __builtin_amdgcn_cvt_pk_fp8_f32(c, d, w, true); return (unsigned)w; }

constexpr int NB = 8, SEQ = 2048, TT = NB * SEQ, DM = 2048;
constexpr int NH = 16, DNOPE = 128, DROPE = 64, DQK = 192, DV = 128, QLORA = 512, KVLORA = 256;
constexpr int S5W = 1024, S5G = 64, S5C = 16, S5P = 64, S5L = 16;
constexpr int NE = 32, TOPK = 4, DFF = 2048;
constexpr int IN_PROJ = QLORA + KVLORA + DROPE + S5W + 2 * DM;
constexpr int NPROJ = 6144;
constexpr int C_QLAT = 0, C_KVLAT = 512, C_U = 768, C_GA = 1792, C_GB = 3840, C_KR = 5888;
constexpr float EPS = 1e-6f;
constexpr int MAXSLOT_TILES = (TT * TOPK) / 256 + NE;
constexpr int MAXSLOTS = MAXSLOT_TILES * 256;
constexpr int NCHUNK = TT / S5L;
constexpr int APK = 384;

constexpr size_t MiB = 1u << 20;
constexpr size_t WS_CTL = 0, CTL_ZERO_BYTES = 1 * MiB;
constexpr size_t WS_WIN = 1 * MiB;
constexpr size_t WS_WUQ = WS_WIN + 24 * MiB;
constexpr size_t WS_WUKV = WS_WUQ + 3 * MiB;
constexpr size_t WS_WOMLA = WS_WUKV + 2 * MiB;
constexpr size_t WS_WGLU = WS_WOMLA + 8 * MiB;
constexpr size_t WS_WOS5 = WS_WGLU + 2 * MiB;
constexpr size_t WS_WOUT = WS_WOS5 + 4 * MiB;
constexpr size_t WS_TWC = WS_WOUT + 8 * MiB;
constexpr size_t WS_WS5 = WS_TWC + 12 * MiB;
constexpr size_t WS_ROPE = WS_WS5 + 8 * MiB;
constexpr size_t WS_SMALL = WS_ROPE + 4 * MiB;
constexpr size_t WS_W1 = WS_SMALL + 1 * MiB;
constexpr size_t WS_W2 = WS_W1 + 512 * MiB;
constexpr size_t WS_ACT = WS_W2 + 256 * MiB;
constexpr size_t WS_H = WS_ACT;
constexpr size_t WS_PROJ = WS_H + 64 * MiB;
constexpr size_t WS_APACK = WS_PROJ + 192 * MiB;
constexpr size_t WS_SCH = WS_APACK + 48 * MiB;
constexpr size_t WS_QRAW = WS_SCH + 32 * MiB;
constexpr size_t WS_KVRAW = WS_QRAW + 96 * MiB;
constexpr size_t WS_QN = WS_KVRAW + 128 * MiB;
constexpr size_t WS_KN = WS_QN + 96 * MiB;
constexpr size_t WS_VN = WS_KN + 96 * MiB;
constexpr size_t WS_O = WS_VN + 64 * MiB;
constexpr size_t WS_GACT = WS_O + 64 * MiB;
constexpr size_t WS_Y2 = WS_GACT + 32 * MiB;
constexpr size_t WS_MA = WS_Y2 + 32 * MiB;
constexpr size_t WS_M = WS_MA + 64 * MiB;
constexpr size_t WS_SSQP = WS_M + 64 * MiB;
constexpr size_t WS_ENDA = WS_SSQP + 1 * MiB;
constexpr size_t WS_H2 = WS_ACT;
constexpr size_t WS_HACT = WS_H2 + 64 * MiB;
constexpr size_t WS_YSLOT = WS_HACT + 288 * MiB;
constexpr size_t WS_TOPI = WS_YSLOT + 288 * MiB;
constexpr size_t WS_TOPW = WS_TOPI + 1 * MiB;
constexpr size_t WS_TPOS = WS_TOPW + 1 * MiB;
constexpr size_t WS_LIST = WS_TPOS + 1 * MiB;
constexpr size_t WS_XPERM = WS_ACT + 704 * MiB;
constexpr size_t WS_ENDB = WS_XPERM + 288 * MiB;
constexpr size_t WS_END = WS_ENDA > WS_ENDB ? WS_ENDA : WS_ENDB;
constexpr size_t SM_A16 = 0;
constexpr size_t SM_COUNTS = 64 * 1024;
constexpr size_t SM_WRP = 128 * 1024;
constexpr int CW_BAR = 4096;

constexpr int RING_BYTES = 131072;
constexpr int LDS_BYTES = 163840;
constexpr int LDSCTL_OFF = LDS_BYTES - 4096;
constexpr int MISC_OFF = LDSCTL_OFF;
constexpr int GTAB_OFF = LDSCTL_OFF + 2048;
constexpr int NWAVES = 8, NTHREADS = 512;

#define LDS_WAIT() asm volatile("s_waitcnt lgkmcnt(0)" ::: "memory")
#define VM_WAIT() asm volatile("s_waitcnt vmcnt(0)" ::: "memory")
#define SBAR() __builtin_amdgcn_sched_barrier(0)

__device__ __forceinline__ unsigned f2bf(float f) { unsigned u = __builtin_bit_cast(unsigned, f); return (u + 0x7fffu + ((u >> 16) & 1u)) >> 16; }
__device__ __forceinline__ unsigned pk2(float lo, float hi) { return f2bf(lo) | (f2bf(hi) << 16); }
__device__ __forceinline__ float bf2f(unsigned b) { return __builtin_bit_cast(float, b << 16); }
__device__ __forceinline__ float bflo(unsigned w) { return __builtin_bit_cast(float, w << 16); }
__device__ __forceinline__ float bfhi(unsigned w) { return __builtin_bit_cast(float, w & 0xffff0000u); }
__device__ __forceinline__ unsigned cvt_pk_bf16(float lo, float hi) { unsigned r; asm volatile("v_cvt_pk_bf16_f32 %0, %1, %2" : "=v"(r) : "v"(lo), "v"(hi)); return r; }
__device__ __forceinline__ float sigmoidf_(float x) { return __builtin_amdgcn_rcpf(1.0f + __builtin_amdgcn_exp2f(-1.4426950408889634f * x)); }
__device__ __forceinline__ float gelu_tanh(float x) {
    const float u = 0.7978845608028654f * (x + 0.044715f * x * x * x);
    const float e = __builtin_amdgcn_exp2f(2.8853900817779268f * u);
    const float th = 1.0f - 2.0f * __builtin_amdgcn_rcpf(e + 1.0f);
    return 0.5f * x * (1.0f + th);
}
__device__ __forceinline__ int fresh_lane() { int z = 0; asm volatile("" : "+s"(z)); return (int)__builtin_amdgcn_mbcnt_hi(~0u, __builtin_amdgcn_mbcnt_lo(~0u, (unsigned)z)); }
__device__ __forceinline__ float wave_sum(float v) {
#pragma unroll
    for (int o = 1; o < 64; o <<= 1) v += __shfl_xor(v, o);
    return v;
}

#define XB_TMO      128
#define XB_XCNT(j)  (256  + 64 * (j))
#define XB_XSUB(j)  (1280 + 64 * (j))
#define XB_XGEN(j)  (2304 + 64 * (j))
#define XB_TOP      3328
#define XB_TOPGEN   3392
#define XCD_BAR_WORDS 3456
#define XB_SPIN_CAP (1u << 18)
__device__ __forceinline__ unsigned xb_ld(unsigned* p)              { return __hip_atomic_load(p, __ATOMIC_RELAXED, __HIP_MEMORY_SCOPE_AGENT); }
__device__ __forceinline__ unsigned xb_add(unsigned* p, unsigned v) { return __hip_atomic_fetch_add(p, v, __ATOMIC_RELAXED, __HIP_MEMORY_SCOPE_AGENT); }
__device__ __forceinline__ unsigned xb_xcc_id() { return (unsigned)__builtin_amdgcn_s_getreg((3 << 11) | 20) & 0xFu; }
#define XB_SPIN(cond, bar) do { unsigned _sp = 0; while (cond) { __builtin_amdgcn_s_sleep(1); \
    if ((++_sp & 255u) == 0u) { if (xb_ld(&(bar)[XB_TMO])) break; if (_sp > XB_SPIN_CAP) { atomicAdd(&(bar)[XB_TMO], 1u); break; } } } } while (0)
struct XcdBarrier { unsigned* bar; unsigned x; volatile LAS unsigned* st; int wave; };
__device__ __forceinline__ XcdBarrier xcd_barrier_post(unsigned* bar, volatile LAS unsigned* st, int wave) {
    XcdBarrier b; b.bar = bar; b.x = xb_xcc_id(); b.st = st; b.wave = wave;
    if (wave == 0 && fresh_lane() == 0) (void)xb_add(&bar[XB_XCNT(b.x)], 1u);
    return b;
}
__device__ __forceinline__ void xcd_barrier_complete(unsigned* bar, unsigned x, unsigned& nloc, unsigned& nx) {
    const unsigned G = gridDim.x * gridDim.y * gridDim.z;
    unsigned sum, cnt, mine, sp = 0u;
    for (;;) {
        sum = 0u; cnt = 0u; mine = 0u;
#pragma unroll
        for (unsigned j = 0; j < 16; ++j) { const unsigned c = xb_ld(&bar[XB_XCNT(j)]); sum += c; cnt += (c > 0u) ? 1u : 0u; mine = (j == x) ? c : mine; }
        if (sum == G) break;
        __builtin_amdgcn_s_sleep(1);
        if ((++sp & 255u) == 0u) { if (xb_ld(&bar[XB_TMO])) break; if (sp > XB_SPIN_CAP) { atomicAdd(&bar[XB_TMO], 1u); break; } }
    }
    nloc = mine > 0u ? mine : 1u; nx = cnt > 0u ? cnt : 1u;
}
__device__ __forceinline__ void xcd_barrier(const XcdBarrier& b) {
    asm volatile("s_waitcnt vmcnt(0)" ::: "memory");
    __syncthreads();
    if (b.wave == 0 && fresh_lane() == 0) {
        unsigned* bar = b.bar;
        __builtin_amdgcn_s_waitcnt(0);
        unsigned nloc = b.st[0], nx = b.st[1];
        if (nloc == 0u) { xcd_barrier_complete(bar, b.x, nloc, nx); b.st[0] = nloc; b.st[1] = nx; }
        const unsigned old = xb_add(&bar[XB_XSUB(b.x)], 1u);
        const unsigned gen = old / nloc;
        if (old + 1u == (gen + 1u) * nloc) {
            __builtin_amdgcn_fence(__ATOMIC_RELEASE, "agent");
            asm volatile("s_waitcnt vmcnt(0)" ::: "memory");
            const unsigned og = xb_add(&bar[XB_TOP], 1u);
            const unsigned tg = og / nx;
            if (og + 1u == (tg + 1u) * nx) xb_add(&bar[XB_TOPGEN], 1u);
            else XB_SPIN(xb_ld(&bar[XB_TOPGEN]) == tg, bar);
            __builtin_amdgcn_fence(__ATOMIC_ACQUIRE, "agent");
            xb_add(&bar[XB_XGEN(b.x)], 1u);
            asm volatile("s_waitcnt vmcnt(0)" ::: "memory");
        } else {
            XB_SPIN(xb_ld(&bar[XB_XGEN(b.x)]) == gen, bar);
            __builtin_amdgcn_fence(__ATOMIC_ACQUIRE, "agent");
            asm volatile("s_waitcnt vmcnt(0)" ::: "memory");
        }
    }
    __syncthreads();
}

namespace gm {
constexpr int BM = 256, BK = 64, HALF = 128, HTB = HALF * BK * 2, STAGE_BYTES = 8 * HTB, NXCD = 8, WGM = 8;
__host__ __device__ __forceinline__ int lds_byte(int r, int c) { const int st = (r >> 4) * 2 + (c >> 5), rr = r & 15, cc = c & 31, ob = rr * 64 + cc * 2; return st * 1024 + (ob ^ (((ob >> 9) & 1) << 5)); }
__host__ __device__ __forceinline__ void stage_rc(int b, int& R, int& C) { const int st = b / 1024, sb = b % 1024, swz = sb ^ (((sb >> 9) & 1) << 5); R = (st >> 1) * 16 + swz / 64; C = (st & 1) * 32 + (swz % 64) / 2; }
__host__ __device__ __forceinline__ int perm32(int rho) { const int n = rho >> 4, i = rho & 15; return 8 * (i >> 2) + 4 * n + (i & 3); }

struct Unit { int pm, pn, g, st; };


struct ProbDense {
    const bf16_t* A; const bf16_t* B; int lda, ldb, nt; int nM, nN, nwg, G, c; const int* list = nullptr; const LAS int* gtab = nullptr;
    __device__ unsigned list_off(const Unit&) const { return 0u; }
    __device__ void init(const bf16_t* A_, int lda_, const bf16_t* B_, int ldb_, int K, int M, int N, int G_, int c_) { A = A_; B = B_; lda = lda_; ldb = ldb_; nt = K / BK; nM = M / BM; nN = N / BM; nwg = nM * nN; G = G_; c = c_; }
    __device__ bool next(int i, Unit& u) const {
        const long L = (long)i * G + c; if (L >= nwg) return false;
        int wgid = (int)L; { const int q = nwg / NXCD, r = nwg % NXCD, xcd = wgid % NXCD, off = wgid / NXCD; wgid = (xcd < r ? xcd * (q + 1) : r * (q + 1) + (xcd - r) * q) + off; }
        const int nig = WGM * nN, gid = wgid / nig, fm = gid * WGM, gsz = (nM - fm) < WGM ? (nM - fm) : WGM;
        u.pm = fm + ((wgid % nig) % gsz); u.pn = (wgid % nig) / gsz; u.g = 0; u.st = 0; return true;
    }
    __device__ size_t a_off(const Unit& u) const { return (size_t)u.pm * BM * lda; }
    __device__ size_t b_off(const Unit& u) const { return (size_t)u.pn * BM * ldb; }
    __device__ unsigned a_row(const Unit&, int) const { return 0u; }
};

#if MK_FAST_GEMM
template <class Prob, class Epi, bool GATHER, bool FP8 = false>
__device__ __forceinline__ void gemm_phase(LAS uchar* lds, const Prob& S, const Epi& E, const int wid  ) {
    constexpr unsigned ESZ = FP8 ? 1u : 2u;
    const int lane = fresh_lane(), tid = wid * 64 + lane, wr = wid >> 2, wc = wid & 3, fr = lane & 15, fq = lane >> 4;
    const int nt = S.nt;
    int Ra[2], Ca[2]; unsigned vB;
    { int R, C; stage_rc(tid * 16, R, C); const int Rb = Epi::PERM ? ((R & ~31) + perm32(R & 31)) : R; Ra[0] = R; Ca[0] = C; Ra[1] = R + 64; Ca[1] = C;
      vB = (unsigned)(Rb * S.ldb) * ESZ + (unsigned)C * 2u; }
    const unsigned dB64 = 64u * (unsigned)S.ldb * ESZ, dA64 = 64u * (unsigned)S.lda * ESZ, dA128 = 2u * dA64;
    constexpr unsigned kstep = BK * 2;
    const unsigned hstepB = (unsigned)HALF * (unsigned)S.ldb * ESZ;
    const unsigned ldsw = (unsigned)wid * 1024u;
    const int aoff = lds_byte(wr * 64 + fr, fq * 8), boff = lds_byte(wc * 32 + fr, fq * 8);
    const __amdgpu_buffer_rsrc_t srdA = __builtin_amdgcn_make_buffer_rsrc((void*)S.A, 0, 0xFFFFFFFF, 0x00020000);
    const __amdgpu_buffer_rsrc_t srdB = __builtin_amdgcn_make_buffer_rsrc((void*)S.B, 0, 0xFFFFFFFF, 0x00020000);
#define G_SA(b, h) (((b) * 2 + (h)) * HTB)
#define G_SB(b, h) ((4 + (b) * 2 + (h)) * HTB)
#define G_STAGE(bufoff, srd, soff, voff) do { _Pragma("unroll") for (int _i = 0; _i < 2; ++_i) \
        __builtin_amdgcn_raw_ptr_buffer_load_lds(srd, (LAS void*)(lds + (bufoff) + ldsw + _i * 8192), 16, (int)(voff)[_i], (int)(soff), 0, 0); } while (0)
#define G_STAGE1(bufoff, srd, soff, v1, d64) do { _Pragma("unroll") for (int _i = 0; _i < 2; ++_i) \
        __builtin_amdgcn_raw_ptr_buffer_load_lds(srd, (LAS void*)(lds + (bufoff) + ldsw + _i * 8192), 16, (int)(v1), (int)((soff) + _i * (d64)), 0, 0); } while (0)
#define G_STAGE_A(bufoff, soff, half, arr0, arr1) do { if constexpr (GATHER) { if (half) G_STAGE(bufoff, srdA, soff, arr1); else G_STAGE(bufoff, srdA, soff, arr0); } \
        else G_STAGE1(bufoff, srdA, (soff) + (half) * dA128, vA, dA64); } while (0)
#define G_LDA(dst, b, h) do { _Pragma("unroll") for (int m = 0; m < 4; ++m) _Pragma("unroll") for (int k = 0; k < 2; ++k) dst[m][k] = *(const LAS bf16x8*)(lds + G_SA(b, h) + aoff + m * 2048 + k * 1024); } while (0)
#define G_LDB(dst, b, h) do { _Pragma("unroll") for (int n = 0; n < 2; ++n) _Pragma("unroll") for (int k = 0; k < 2; ++k) dst[n][k] = *(const LAS bf16x8*)(lds + G_SB(b, h) + boff + n * 2048 + k * 1024); } while (0)
#define G_CAT(x0, x1) __builtin_shufflevector(__builtin_bit_cast(v4i, x0), __builtin_bit_cast(v4i, x1), 0, 1, 2, 3, 4, 5, 6, 7)
#define G_MMA(ai, bj, At, Bt) do { __builtin_amdgcn_s_setprio(1); _Pragma("unroll") for (int m = 0; m < 4; ++m) _Pragma("unroll") for (int n = 0; n < 2; ++n) { \
        if constexpr (FP8) acc[ai][bj][m][n] = __builtin_amdgcn_mfma_scale_f32_16x16x128_f8f6f4(G_CAT(Bt[n][0], Bt[n][1]), G_CAT(At[m][0], At[m][1]), acc[ai][bj][m][n], 0, 0, 0, 0x7f7f7f7f, 0, 0x7f7f7f7f); \
        else { _Pragma("unroll") for (int k = 0; k < 2; ++k) acc[ai][bj][m][n] = __builtin_amdgcn_mfma_f32_16x16x32_bf16(Bt[n][k], At[m][k], acc[ai][bj][m][n], 0, 0, 0); } } \
        __builtin_amdgcn_s_setprio(0); } while (0)
#define G_WAIT_V(n) asm volatile("s_waitcnt vmcnt(" #n ")" ::: "memory")
#define G_WAIT_L(n) asm volatile("s_waitcnt lgkmcnt(" #n ")" ::: "memory")
#define G_BAR __builtin_amdgcn_s_barrier()
#define G_SCHED __builtin_amdgcn_sched_barrier(0)
#define G_UNI(x) ((unsigned)__builtin_amdgcn_readfirstlane((int)(x)))
    Unit cur, nxt; int ui = 0;
    if (!S.next(0, cur)) return;
    unsigned vA0[2], vA1[2];
    unsigned cA = 0u, cB = G_UNI(S.b_off(cur) * ESZ);
    __amdgpu_buffer_rsrc_t srdL = srdA;
    if constexpr (GATHER) srdL = __builtin_amdgcn_make_buffer_rsrc((void*)S.list, 0, 0xFFFFFFFF, 0x00020000);
#define G_IDX(u_) do { if (wid < 4) __builtin_amdgcn_raw_ptr_buffer_load_lds(srdL, (LAS void*)(S.gtab + wid * 64), 4, lane * 4, (int)G_UNI(S.list_off(u_) * 4u) + wid * 256, 0, 0); } while (0)
    const int gR = (int)(uintptr_t)S.gtab + Ra[0] * 4; const unsigned gC = (unsigned)Ca[0] * 2u;
#define G_ROWS(o0, o1) do { const LAS int* _g = (const LAS int*)gR; const unsigned _ls = (unsigned)S.lda * ESZ; \
        o0[0] = (unsigned)_g[0] * _ls + gC; o0[1] = (unsigned)_g[64] * _ls + gC; o1[0] = (unsigned)_g[128] * _ls + gC; o1[1] = (unsigned)_g[192] * _ls + gC; } while (0)
    if constexpr (GATHER) { G_IDX(cur); G_WAIT_V(0); G_BAR; G_ROWS(vA0, vA1); G_WAIT_L(0); G_BAR; }
    else { cA = G_UNI(S.a_off(cur) * ESZ);
#pragma unroll
        for (int i = 0; i < 2; ++i) { vA0[i] = 0u; vA1[i] = 0u; } }
    const unsigned vA = (unsigned)(Ra[0] * S.lda) * ESZ + (unsigned)Ca[0] * 2u;
    G_STAGE1(G_SB(0, 0), srdB, cB, vB, dB64); G_STAGE_A(G_SA(0, 0), cA, 0, vA0, vA1); G_STAGE1(G_SB(0, 1), srdB, cB + hstepB, vB, dB64); G_STAGE_A(G_SA(0, 1), cA, 1, vA0, vA1);
    if (wr == 1) G_BAR;
    G_WAIT_V(4); G_BAR;
    G_STAGE1(G_SB(1, 0), srdB, cB + kstep, vB, dB64); G_STAGE_A(G_SA(1, 0), cA + kstep, 0, vA0, vA1); G_STAGE1(G_SB(1, 1), srdB, cB + hstepB + kstep, vB, dB64);
    G_WAIT_V(6); G_BAR;
    f32x4 acc[2][2][4][2];
#pragma unroll
    for (int a = 0; a < 2; ++a)
#pragma unroll
        for (int b = 0; b < 2; ++b)
#pragma unroll
            for (int m = 0; m < 4; ++m)
#pragma unroll
                for (int n = 0; n < 2; ++n) acc[a][b][m][n] = (f32x4){0.f, 0.f, 0.f, 0.f};
    bf16x8 At[4][2], B0[2][2], B1[2][2];
    for (;;) {
        const bool has_next = S.next(ui + 1, nxt);
        unsigned nA = cA, nB = cB; unsigned x0[2] = {0u, 0u}, x1[2] = {0u, 0u};
        if (has_next) { nB = G_UNI(S.b_off(nxt) * ESZ);
            if constexpr (GATHER) G_IDX(nxt);
            else nA = G_UNI(S.a_off(nxt) * ESZ);
        }
#define G_TRIP(LAST) do { \
            const unsigned a1 = cA + (unsigned)(t + 1) * kstep; \
            const unsigned a2 = (LAST) ? nA : cA + (unsigned)(t + 2) * kstep, b2 = (LAST) ? nB : cB + (unsigned)(t + 2) * kstep; \
            const unsigned a3 = a2 + kstep, b3 = b2 + kstep; \
            unsigned w0[2], w1[2]; \
            _Pragma("unroll") for (int i = 0; i < 2; ++i) { w0[i] = vA0[i]; w1[i] = vA1[i]; } \
            if constexpr (GATHER) { if ((LAST) && has_next) { G_ROWS(w0, w1); _Pragma("unroll") for (int i = 0; i < 2; ++i) { x0[i] = w0[i]; x1[i] = w1[i]; } } } \
              G_LDB(B0, 0, 0); G_SCHED; G_LDA(At, 0, 0); G_STAGE_A(G_SA(1, 1), a1, 1, vA0, vA1); \
            G_WAIT_L(8); G_BAR; G_WAIT_L(0); G_MMA(0, 0, At, B0); G_BAR; G_SCHED; \
              G_LDB(B1, 0, 1); G_STAGE1(G_SB(0, 0), srdB, b2, vB, dB64); \
            G_BAR; G_WAIT_L(0); G_MMA(0, 1, At, B1); G_BAR; \
              G_LDA(At, 0, 1); G_STAGE_A(G_SA(0, 0), a2, 0, w0, w1); \
            G_BAR; G_WAIT_L(0); G_MMA(1, 0, At, B0); G_BAR; G_SCHED; \
              G_STAGE1(G_SB(0, 1), srdB, b2 + hstepB, vB, dB64); \
            G_WAIT_V(6); G_BAR; G_MMA(1, 1, At, B1); G_BAR; \
              G_LDB(B0, 1, 0); G_SCHED; G_LDA(At, 1, 0); G_STAGE_A(G_SA(0, 1), a2, 1, w0, w1); \
            G_WAIT_L(8); G_BAR; G_WAIT_L(0); G_MMA(0, 0, At, B0); G_BAR; G_SCHED; \
              G_LDB(B1, 1, 1); G_STAGE1(G_SB(1, 0), srdB, b3, vB, dB64); \
            G_BAR; G_WAIT_L(0); G_MMA(0, 1, At, B1); G_BAR; \
              G_LDA(At, 1, 1); G_STAGE_A(G_SA(1, 0), a3, 0, w0, w1); \
            G_BAR; G_WAIT_L(0); G_MMA(1, 0, At, B0); G_BAR; G_SCHED; \
              G_STAGE1(G_SB(1, 1), srdB, b3 + hstepB, vB, dB64); \
            G_WAIT_V(6); G_BAR; G_MMA(1, 1, At, B1); G_BAR; } while (0)
        for (int t = 0; t < nt; t += 2) { const bool last = (t == nt - 2); G_TRIP(last); }
        if (wr == 0) G_BAR;
        { const int lane2 = fresh_lane();
          E(acc, cur, wid >> 2, wid & 3, lane2 & 15, lane2 >> 4); }
        if (!has_next) break;
#pragma unroll
        for (int a = 0; a < 2; ++a)
#pragma unroll
            for (int b = 0; b < 2; ++b)
#pragma unroll
                for (int m = 0; m < 4; ++m)
#pragma unroll
                    for (int n = 0; n < 2; ++n) acc[a][b][m][n] = (f32x4){0.f, 0.f, 0.f, 0.f};
        cur = nxt; cA = nA; cB = nB; ++ui;
        if (wr == 1) G_BAR;
        if constexpr (GATHER) {
#pragma unroll
            for (int i = 0; i < 2; ++i) { vA0[i] = x0[i]; vA1[i] = x1[i]; } }
    }
    G_WAIT_V(0);
    G_BAR;
#undef G_SA
#undef G_SB
#undef G_STAGE
#undef G_STAGE1
#undef G_STAGE_A
#undef G_LDA
#undef G_LDB
#undef G_MMA
#undef G_CAT
#undef G_WAIT_V
#undef G_WAIT_L
#undef G_BAR
#undef G_SCHED
#undef G_UNI
#undef G_TRIP
#undef G_IDX
#undef G_ROWS
}
#else
template <class Prob, class Epi, bool GATHER, bool FP8 = false>
__device__ __forceinline__ void gemm_phase(LAS uchar* lds, const Prob& S, const Epi& E, const int wid) {
    const int lane = fresh_lane(), tid = wid * 64 + lane, wr = wid >> 2, wc = wid & 3, fr = lane & 15, fq = lane >> 4;
    LAS float* As = (LAS float*)lds; LAS float* Bs = As + 256 * 33;
    Unit u;
    for (int ui = 0; S.next(ui, u); ++ui) {
        float acc[2][2][4][2][4];
#pragma unroll
        for (int a = 0; a < 2; ++a)
#pragma unroll
            for (int b = 0; b < 2; ++b)
#pragma unroll
                for (int m = 0; m < 4; ++m)
#pragma unroll
                    for (int n = 0; n < 2; ++n)
#pragma unroll
                        for (int j = 0; j < 4; ++j) acc[a][b][m][n][j] = 0.f;
        const int lr = tid >> 1, lk = (tid & 1) * 16;
        const bf16_t* ap = GATHER ? (S.A + S.a_row(u, lr)) : (S.A + S.a_off(u) + (size_t)lr * S.lda);
        const bf16_t* bp = S.B + S.b_off(u) + (size_t)lr * S.ldb;
        for (int k0 = 0; k0 < S.nt * 64; k0 += 32) {
            __syncthreads();
            const u32x4 a0 = *(const u32x4*)(ap + k0 + lk), a1 = *(const u32x4*)(ap + k0 + lk + 8);
            const u32x4 b0 = *(const u32x4*)(bp + k0 + lk), b1 = *(const u32x4*)(bp + k0 + lk + 8);
#pragma unroll
            for (int q = 0; q < 4; ++q) {
                As[lr * 33 + lk + 2 * q] = bflo(a0[q]); As[lr * 33 + lk + 2 * q + 1] = bfhi(a0[q]);
                As[lr * 33 + lk + 8 + 2 * q] = bflo(a1[q]); As[lr * 33 + lk + 8 + 2 * q + 1] = bfhi(a1[q]);
                Bs[lr * 33 + lk + 2 * q] = bflo(b0[q]); Bs[lr * 33 + lk + 2 * q + 1] = bfhi(b0[q]);
                Bs[lr * 33 + lk + 8 + 2 * q] = bflo(b1[q]); Bs[lr * 33 + lk + 8 + 2 * q + 1] = bfhi(b1[q]);
            }
            __syncthreads();
            for (int kk = 0; kk < 32; ++kk) {
                float av[2][4], bv[2][2][4];
#pragma unroll
                for (int a = 0; a < 2; ++a)
#pragma unroll
                    for (int m = 0; m < 4; ++m) av[a][m] = As[(128 * a + 64 * wr + 16 * m + fr) * 33 + kk];
#pragma unroll
                for (int b = 0; b < 2; ++b)
#pragma unroll
                    for (int n = 0; n < 2; ++n)
#pragma unroll
                        for (int j = 0; j < 4; ++j) { const int c = 128 * b + 32 * wc + (Epi::PERM ? (8 * fq + 4 * n + j) : (16 * n + 4 * fq + j)); bv[b][n][j] = Bs[c * 33 + kk]; }
#pragma unroll
                for (int a = 0; a < 2; ++a)
#pragma unroll
                    for (int b = 0; b < 2; ++b)
#pragma unroll
                        for (int m = 0; m < 4; ++m)
#pragma unroll
                            for (int n = 0; n < 2; ++n)
#pragma unroll
                                for (int j = 0; j < 4; ++j) acc[a][b][m][n][j] += av[a][m] * bv[b][n][j];
            }
        }
        f32x4 accv[2][2][4][2];
#pragma unroll
        for (int a = 0; a < 2; ++a)
#pragma unroll
            for (int b = 0; b < 2; ++b)
#pragma unroll
                for (int m = 0; m < 4; ++m)
#pragma unroll
                    for (int n = 0; n < 2; ++n) accv[a][b][m][n] = (f32x4){acc[a][b][m][n][0], acc[a][b][m][n][1], acc[a][b][m][n][2], acc[a][b][m][n][3]};
        E(accv, u, wr, wc, fr, fq);
    }
    __syncthreads();
}
#endif
}

struct Args {
    const float* in[32];
    float* out; uchar* ws;
    int ph_lo, ph_hi;
};
struct Frame {
    LAS uchar* lds; uchar* ws; int wave, G, bx;
};
#define FRAME_IDS(F) const int F_lane = fresh_lane(), F_tid = (F).wave * 64 + F_lane
enum { I_X = 0, I_POS, I_N1G, I_WIN, I_BG, I_QNG, I_WUQ, I_KVNG, I_WUKV, I_QKQG, I_QKKG, I_WOMLA, I_LRE, I_LIM, I_LOGDT, I_BRE, I_BIM, I_CRE, I_CIM, I_S5D,
       I_WGLU, I_WOS5, I_WOUT, I_N2G, I_WR, I_BR, I_WG, I_BGATE, I_WU, I_BUP, I_WD, I_BDOWN };

struct ProbS5 {
    const bf16_t* A; const bf16_t* B; int lda, ldb, nt; int G, c; const int* list = nullptr; const LAS int* gtab = nullptr;
    __device__ unsigned list_off(const gm::Unit&) const { return 0u; }
    __device__ bool next(int i, gm::Unit& u) const { const int L = i * G + c; if (L >= S5G * 4) return false; u.g = L >> 2; u.pm = L & 3; u.pn = 0; u.st = 0; return true; }
    __device__ size_t a_off(const gm::Unit& u) const { return ((size_t)u.g * NCHUNK + (size_t)u.pm * 256) * APK; }
    __device__ size_t b_off(const gm::Unit& u) const { return (size_t)u.g * 256 * ldb; }
    __device__ unsigned a_row(const gm::Unit&, int) const { return 0u; }
};
struct ProbMoE {
    const bf16_t* A; const bf16_t* B; int lda, ldb, nt; int npn; size_t estride;
    int x, rk, nrk; int nte[4], rcp[4], pre[4], eid[4];
    const int* list = nullptr; const LAS int* gtab = nullptr;
    __device__ void load(const LAS int* tab) {
#pragma unroll
        for (int q = 0; q < 4; ++q) { const int e = __builtin_amdgcn_readfirstlane(tab[160 + x * 4 + q]); eid[q] = e; nte[q] = __builtin_amdgcn_readfirstlane(tab[32 + e]); rcp[q] = __builtin_amdgcn_readfirstlane(tab[128 + e]); pre[q] = __builtin_amdgcn_readfirstlane(tab[64 + e]); }
    }
    __device__ unsigned list_off(const gm::Unit&) const { return 0u; }
    __device__ bool next(int i, gm::Unit& u) const {
        int L = i * nrk + rk;
#pragma unroll
        for (int q = 0; q < 4; ++q) { const int nu = nte[q] * npn;
            if (L < nu) { u.g = eid[q]; u.pn = (L * rcp[q]) >> 20; u.pm = L - u.pn * nte[q]; u.st = pre[q] + u.pm; return true; } L -= nu; }
        return false;
    }
    __device__ size_t a_off(const gm::Unit& u) const { return ((size_t)u.st * 256) * lda; }
    __device__ size_t b_off(const gm::Unit& u) const { return (size_t)u.g * estride + (size_t)u.pn * 256 * ldb; }
    __device__ unsigned a_row(const gm::Unit&, int) const { return 0u; }
};

#define EPI_ROW(u_, ai, m) ((u_).pm * 256 + (ai) * 128 + wr * 64 + (m) * 16 + fr)
struct EpiStoreBf16 {
    static constexpr bool PERM = true;
    bf16_t* O; int ld;
    __device__ __forceinline__ void operator()(const f32x4 (&acc)[2][2][4][2], const gm::Unit& u, int wr, int wc, int fr, int fq) const {
#pragma unroll
        for (int ai = 0; ai < 2; ++ai)
#pragma unroll
            for (int m = 0; m < 4; ++m) { bf16_t* rowp = O + (size_t)EPI_ROW(u, ai, m) * ld + u.pn * 256 + wc * 32 + 8 * fq;
#pragma unroll
                for (int bj = 0; bj < 2; ++bj) { const f32x4 v0 = acc[ai][bj][m][0], v1 = acc[ai][bj][m][1];
                    u32x4 w; w.x = cvt_pk_bf16(v0[0], v0[1]); w.y = cvt_pk_bf16(v0[2], v0[3]); w.z = cvt_pk_bf16(v1[0], v1[1]); w.w = cvt_pk_bf16(v1[2], v1[3]);
                    *(u32x4*)(rowp + bj * 128) = w; } }
    }
};
template <int S0, int NS, int LEN> struct EpiStoreScaled {
    static constexpr bool PERM = true;
    bf16_t* O; int ld; const float* ssqp;
    __device__ __forceinline__ void operator()(const f32x4 (&acc)[2][2][4][2], const gm::Unit& u, int wr, int wc, int fr, int fq) const {
#pragma unroll
        for (int ai = 0; ai < 2; ++ai) { float rs[4];
#pragma unroll
            for (int m = 0; m < 4; ++m) { const float* sp = ssqp + (size_t)EPI_ROW(u, ai, m) * 12 + S0; float t = 0.f;
#pragma unroll
                for (int q = 0; q < NS; q += 4) { const f32x4 v = *(const f32x4*)(sp + q); t += (v[0] + v[1]) + (v[2] + v[3]); }
                rs[m] = 1.0f / sqrtf(t * (1.0f / LEN) + EPS); }
#pragma unroll
            for (int m = 0; m < 4; ++m) { bf16_t* rowp = O + (size_t)EPI_ROW(u, ai, m) * ld + u.pn * 256 + wc * 32 + 8 * fq;
#pragma unroll
                for (int bj = 0; bj < 2; ++bj) { const f32x4 v0 = acc[ai][bj][m][0] * rs[m], v1 = acc[ai][bj][m][1] * rs[m];
                    u32x4 w; w.x = cvt_pk_bf16(v0[0], v0[1]); w.y = cvt_pk_bf16(v0[2], v0[3]); w.z = cvt_pk_bf16(v1[0], v1[1]); w.w = cvt_pk_bf16(v1[2], v1[3]);
                    *(u32x4*)(rowp + bj * 128) = w; } } }
    }
};
struct EpiKV {
    static constexpr bool PERM = true;
    bf16_t* kraw; bf16_t* vn; const float* ssqp;
    __device__ __forceinline__ void operator()(const f32x4 (&acc)[2][2][4][2], const gm::Unit& u, int wr, int wc, int fr, int fq) const {
#pragma unroll
        for (int ai = 0; ai < 2; ++ai) { float rs[4];
#pragma unroll
            for (int m = 0; m < 4; ++m) { const f32x4 v = *(const f32x4*)(ssqp + (size_t)EPI_ROW(u, ai, m) * 12 + 8); rs[m] = 1.0f / sqrtf(((v[0] + v[1]) + (v[2] + v[3])) * (1.0f / KVLORA) + EPS); }
#pragma unroll
            for (int m = 0; m < 4; ++m) { const int t = EPI_ROW(u, ai, m); const size_t ro = ((size_t)((t >> 11) * NH + u.pn) * SEQ + (t & 2047)) * 128 + wc * 32 + 8 * fq;
#pragma unroll
                for (int bj = 0; bj < 2; ++bj) { const f32x4 v0 = acc[ai][bj][m][0] * rs[m], v1 = acc[ai][bj][m][1] * rs[m];
                    u32x4 w; w.x = cvt_pk_bf16(v0[0], v0[1]); w.y = cvt_pk_bf16(v0[2], v0[3]); w.z = cvt_pk_bf16(v1[0], v1[1]); w.w = cvt_pk_bf16(v1[2], v1[3]);
                    *(u32x4*)((bj ? vn : kraw) + ro) = w; } } }
    }
};
struct EpiInProj {
    static constexpr bool PERM = true;
    bf16_t* proj; bf16_t* apack; const float* bgates; float* ssqp;
    __device__ __forceinline__ void operator()(const f32x4 (&acc)[2][2][4][2], const gm::Unit& u, int wr, int wc, int fr, int fq) const {
        const int colt = u.pn * 256 + wc * 32 + 8 * fq;
        if (u.pn < 3) {
#pragma unroll
            for (int ai = 0; ai < 2; ++ai)
#pragma unroll
                for (int m = 0; m < 4; ++m) { float sq = 0.f;
#pragma unroll
                    for (int bj = 0; bj < 2; ++bj)
#pragma unroll
                        for (int n = 0; n < 2; ++n) { const f32x4 v = acc[ai][bj][m][n]; sq += (v[0] * v[0] + v[1] * v[1]) + (v[2] * v[2] + v[3] * v[3]); }
                    sq += __shfl_xor(sq, 16); sq += __shfl_xor(sq, 32);
                    if (fq == 0) ssqp[(size_t)EPI_ROW(u, ai, m) * 12 + u.pn * 4 + wc] = sq; } }
        const int kind = (u.pn >= 3 && u.pn < 7) ? 1 : ((u.pn >= 7 && u.pn < 23) ? 2 : 0);
#pragma unroll
        for (int bj = 0; bj < 2; ++bj) {
            const int col = colt + bj * 128;
            f32x4 b0 = (f32x4){0.f, 0.f, 0.f, 0.f}, b1 = b0;
            if (kind == 2) { b0 = *(const f32x4*)(bgates + (col - C_GA)); b1 = *(const f32x4*)(bgates + (col - C_GA) + 4); }
#pragma unroll
            for (int ai = 0; ai < 2; ++ai)
#pragma unroll
                for (int m = 0; m < 4; ++m) {
                    const int row = EPI_ROW(u, ai, m);
                    f32x4 v0 = acc[ai][bj][m][0], v1 = acc[ai][bj][m][1];
                    if (kind == 2) {
#pragma unroll
                        for (int j = 0; j < 4; ++j) { v0[j] = sigmoidf_(v0[j] + b0[j]); v1[j] = sigmoidf_(v1[j] + b1[j]); }
                    }
                    u32x4 w; w.x = cvt_pk_bf16(v0[0], v0[1]); w.y = cvt_pk_bf16(v0[2], v0[3]); w.z = cvt_pk_bf16(v1[0], v1[1]); w.w = cvt_pk_bf16(v1[2], v1[3]);
                    if (kind == 1) { const int j = col - C_U, g = j >> 4, cc = j & 15;
                        *(u32x4*)(apack + ((size_t)g * NCHUNK + (row >> 4)) * APK + (row & 15) * 16 + cc) = w; }
                    else { *(u32x4*)(proj + (size_t)row * NPROJ + col) = w;
                    }
                }
        }
    }
};
struct EpiS5State {
    static constexpr bool PERM = false;
    float* sch;
    __device__ __forceinline__ void operator()(const f32x4 (&acc)[2][2][4][2], const gm::Unit& u, int wr, int wc, int fr, int fq) const {
#pragma unroll
        for (int ai = 0; ai < 2; ++ai)
#pragma unroll
            for (int m = 0; m < 4; ++m) { float* rowp = sch + ((size_t)u.g * NCHUNK + EPI_ROW(u, ai, m)) * 128 + wc * 32 + 4 * fq;
#pragma unroll
                for (int n = 0; n < 2; ++n) *(f32x4*)(rowp + n * 16) = acc[ai][0][m][n]; }
    }
};
struct EpiS5Out {
    static constexpr bool PERM = true;
    bf16_t* gact;
    __device__ __forceinline__ void operator()(const f32x4 (&acc)[2][2][4][2], const gm::Unit& u, int wr, int wc, int fr, int fq) const {
#pragma unroll
        for (int ai = 0; ai < 2; ++ai)
#pragma unroll
            for (int m = 0; m < 4; ++m) { const int r = EPI_ROW(u, ai, m);
#pragma unroll
                for (int bj = 0; bj < 2; ++bj) { const int n0 = bj * 128 + wc * 32 + 8 * fq, t = n0 >> 4, c0 = n0 & 15;
                    f32x4 v0 = acc[ai][bj][m][0], v1 = acc[ai][bj][m][1];
#pragma unroll
                    for (int j = 0; j < 4; ++j) { v0[j] = gelu_tanh(v0[j]); v1[j] = gelu_tanh(v1[j]); }
                    u32x4 w; w.x = cvt_pk_bf16(v0[0], v0[1]); w.y = cvt_pk_bf16(v0[2], v0[3]); w.z = cvt_pk_bf16(v1[0], v1[1]); w.w = cvt_pk_bf16(v1[2], v1[3]);
                    *(u32x4*)(gact + ((size_t)r * 16 + t) * S5W + u.g * 16 + c0) = w; } }
    }
};
template <int MODE> struct EpiSide {
    static constexpr bool PERM = true;
    bf16_t* O; int ldo; const bf16_t* s0; int ld0; const bf16_t* s1; int ld1;
    __device__ __forceinline__ void operator()(const f32x4 (&acc)[2][2][4][2], const gm::Unit& u, int wr, int wc, int fr, int fq) const {
        const int col0 = u.pn * 256 + wc * 32 + 8 * fq;
#pragma unroll
        for (int ai = 0; ai < 2; ++ai) {
            u32x4 sa[4][2], sb[4][2];
#pragma unroll
            for (int m = 0; m < 4; ++m)
#pragma unroll
                for (int bj = 0; bj < 2; ++bj) { const int row = EPI_ROW(u, ai, m);
                    sa[m][bj] = *(const u32x4*)(s0 + (size_t)row * ld0 + col0 + bj * 128);
                    if (MODE == 2) sb[m][bj] = *(const u32x4*)(s1 + (size_t)row * ld1 + col0 + bj * 128); else sb[m][bj] = (u32x4){0u, 0u, 0u, 0u}; }
#pragma unroll
            for (int m = 0; m < 4; ++m)
#pragma unroll
                for (int bj = 0; bj < 2; ++bj) { const int row = EPI_ROW(u, ai, m);
                    const f32x4 v0 = acc[ai][bj][m][0], v1 = acc[ai][bj][m][1]; const u32x4 a = sa[m][bj], b = sb[m][bj];
                    float r[8];
#pragma unroll
                    for (int q = 0; q < 4; ++q) { const float x0 = q < 2 ? v0[2 * q] : v1[2 * q - 4], x1 = q < 2 ? v0[2 * q + 1] : v1[2 * q - 3];
                        const float a0 = bflo(a[q]), a1 = bfhi(a[q]);
                        if (MODE == 0) { r[2 * q] = a0 * sigmoidf_(x0); r[2 * q + 1] = a1 * sigmoidf_(x1); }
                        else if (MODE == 1) { r[2 * q] = a0 * x0; r[2 * q + 1] = a1 * x1; }
                        else { r[2 * q] = bflo(b[q]) + a0 * x0; r[2 * q + 1] = bfhi(b[q]) + a1 * x1; } }
                    u32x4 w; w.x = cvt_pk_bf16(r[0], r[1]); w.y = cvt_pk_bf16(r[2], r[3]); w.z = cvt_pk_bf16(r[4], r[5]); w.w = cvt_pk_bf16(r[6], r[7]);
                    *(u32x4*)(O + (size_t)row * ldo + col0 + bj * 128) = w; }
        }
    }
};
struct EpiResidF32 {
    static constexpr bool PERM = false;
    const float* x; float* out;
    __device__ __forceinline__ void operator()(const f32x4 (&acc)[2][2][4][2], const gm::Unit& u, int wr, int wc, int fr, int fq) const {
#pragma unroll
        for (int ai = 0; ai < 2; ++ai)
#pragma unroll
            for (int mh = 0; mh < 2; ++mh) { f32x4 xv[2][2][2];
#pragma unroll
                for (int mm = 0; mm < 2; ++mm) { const size_t off = (size_t)EPI_ROW(u, ai, 2 * mh + mm) * DM + u.pn * 256 + wc * 32 + 4 * fq;
#pragma unroll
                    for (int bj = 0; bj < 2; ++bj)
#pragma unroll
                        for (int n = 0; n < 2; ++n) xv[mm][bj][n] = *(const f32x4*)(x + off + bj * 128 + n * 16); }
#pragma unroll
                for (int mm = 0; mm < 2; ++mm) { const size_t off = (size_t)EPI_ROW(u, ai, 2 * mh + mm) * DM + u.pn * 256 + wc * 32 + 4 * fq;
#pragma unroll
                    for (int bj = 0; bj < 2; ++bj)
#pragma unroll
                        for (int n = 0; n < 2; ++n) *(f32x4*)(out + off + bj * 128 + n * 16) = xv[mm][bj][n] + acc[ai][bj][2 * mh + mm][n]; } }
    }
};
#if MK_FP8_MOE
constexpr float MOE_DESCALE = 1.0f / (FP8_ASCALE * FP8_WSCALE);
#else
constexpr float MOE_DESCALE = 1.0f;
#endif
struct EpiSwiglu {
    static constexpr bool PERM = true;
    bf16_t* hact; const float* bgate; const float* bup; const LAS int* tab;
    __device__ __forceinline__ void operator()(const f32x4 (&acc)[2][2][4][2], const gm::Unit& u, int wr, int wc, int fr, int fq) const {
        const int hc = u.pn * 128 + wc * 32 + 8 * fq;
        const unsigned slot0 = (unsigned)u.st * 256u + wr * 64 + fr;
        unsigned w0[2][4];
#pragma unroll
        for (int n = 0; n < 2; ++n) {
            const f32x4 g0 = *(const f32x4*)(bgate + (unsigned)(u.g * DFF + hc + 4 * n)), u0 = *(const f32x4*)(bup + (unsigned)(u.g * DFF + hc + 4 * n));
#pragma unroll
            for (int ai = 0; ai < 2; ++ai)
#pragma unroll
                for (int m = 0; m < 4; ++m) { const unsigned slot = slot0 + ai * 128 + m * 16;
                    float r[4];
#pragma unroll
                    for (int q = 0; q < 4; ++q) { float gt = acc[ai][0][m][n][q] * MOE_DESCALE + g0[q], up = acc[ai][1][m][n][q] * MOE_DESCALE + u0[q];
                        gt = fminf(gt, 7.0f); up = fminf(fmaxf(up, -7.0f), 7.0f);
                        r[q] = (up + 1.0f) * (gt * sigmoidf_(1.702f * gt)); }
#if MK_FP8_MOE
                    const unsigned pk = pk4_fp8(r[0] * FP8_ASCALE, r[1] * FP8_ASCALE, r[2] * FP8_ASCALE, r[3] * FP8_ASCALE);
                    if (n == 0) w0[ai][m] = pk; else { u32x2 w; w.x = w0[ai][m]; w.y = pk; *(u32x2*)((uchar*)hact + slot * DFF + hc) = w; }
#else
                    u32x2 w; w.x = cvt_pk_bf16(r[0], r[1]); w.y = cvt_pk_bf16(r[2], r[3]); *(u32x2*)(hact + slot * DFF + hc + 4 * n) = w;
#endif
                }
        }
    }
};
struct EpiDown {
    static constexpr bool PERM = true;
    bf16_t* ys; const float* bdown; const LAS int* tab;
    __device__ __forceinline__ void operator()(const f32x4 (&acc)[2][2][4][2], const gm::Unit& u, int wr, int wc, int fr, int fq) const {
        const size_t slot0 = (size_t)u.st * 256;
#pragma unroll
        for (int bj = 0; bj < 2; ++bj) { const int col = u.pn * 256 + bj * 128 + wc * 32 + 8 * fq;
            const float* bd = bdown + (size_t)u.g * DM + col; const f32x4 d0 = *(const f32x4*)bd, d1 = *(const f32x4*)(bd + 4);
#pragma unroll
            for (int ai = 0; ai < 2; ++ai)
#pragma unroll
                for (int m = 0; m < 4; ++m) { const size_t slot = slot0 + ai * 128 + wr * 64 + m * 16 + fr;
                    const f32x4 v0 = acc[ai][bj][m][0] * MOE_DESCALE + d0, v1 = acc[ai][bj][m][1] * MOE_DESCALE + d1;
#if MK_FP8_MOE
                    u32x2 w; w.x = pk4_fp8(v0[0] * FP8_YSCALE, v0[1] * FP8_YSCALE, v0[2] * FP8_YSCALE, v0[3] * FP8_YSCALE); w.y = pk4_fp8(v1[0] * FP8_YSCALE, v1[1] * FP8_YSCALE, v1[2] * FP8_YSCALE, v1[3] * FP8_YSCALE);
                    *(u32x2*)((uchar*)ys + slot * DM + col) = w; } }
#else
                    u32x4 w; w.x = cvt_pk_bf16(v0[0], v0[1]); w.y = cvt_pk_bf16(v0[2], v0[3]); w.z = cvt_pk_bf16(v1[0], v1[1]); w.w = cvt_pk_bf16(v1[2], v1[3]);
                    *(u32x4*)(ys + slot * DM + col) = w; } }
#endif
    }
};

template <bool FP8OUT>
__device__ __forceinline__ void transpose_item(const float* W, int ldw, int src_col0, int k0, const float* kscale, void* WT, int ldt, int dst_row0, float oscale, LAS float* scr, int lane) {
    if (src_col0 >= 0) {
        f32x4 v[16]; const float* wp = W + (size_t)(k0 + (lane >> 4)) * ldw + src_col0 + (lane & 15) * 4;
#pragma unroll
        for (int i = 0; i < 16; ++i) v[i] = *(const f32x4*)(wp + (size_t)(4 * i) * ldw);
#pragma unroll
        for (int i = 0; i < 16; ++i) { const int kk = 4 * i + (lane >> 4); const float sc = kscale ? kscale[k0 + kk] * oscale : oscale; LAS float* d = scr + kk * 65 + (lane & 15) * 4;
            d[0] = v[i].x * sc; d[1] = v[i].y * sc; d[2] = v[i].z * sc; d[3] = v[i].w * sc; }
    } else {
#pragma unroll
        for (int i = 0; i < 16; ++i) { LAS float* d = scr + (4 * i + (lane >> 4)) * 65 + (lane & 15) * 4; d[0] = 0.f; d[1] = 0.f; d[2] = 0.f; d[3] = 0.f; }
    }
    LDS_WAIT(); asm volatile("" ::: "memory");
    if constexpr (FP8OUT) { const int c = lane & 3;
#pragma unroll
        for (int j = 0; j < 4; ++j) { const int n = (lane >> 2) + 16 * j; const LAS float* s = scr + (16 * c) * 65 + n; u32x4 o;
            o.x = pk4_fp8(s[0 * 65], s[1 * 65], s[2 * 65], s[3 * 65]); o.y = pk4_fp8(s[4 * 65], s[5 * 65], s[6 * 65], s[7 * 65]);
            o.z = pk4_fp8(s[8 * 65], s[9 * 65], s[10 * 65], s[11 * 65]); o.w = pk4_fp8(s[12 * 65], s[13 * 65], s[14 * 65], s[15 * 65]);
            *(u32x4*)((uchar*)WT + (size_t)(dst_row0 + n) * ldt + k0 + 16 * c) = o; }
    } else { const int c = lane & 7;
#pragma unroll
        for (int j = 0; j < 8; ++j) { const int n = (lane >> 3) + 8 * j; const LAS float* s = scr + (8 * c) * 65 + n;
            u32x4 o; o.x = pk2(s[0 * 65], s[1 * 65]); o.y = pk2(s[2 * 65], s[3 * 65]); o.z = pk2(s[4 * 65], s[5 * 65]); o.w = pk2(s[6 * 65], s[7 * 65]);
            *(u32x4*)((bf16_t*)WT + (size_t)(dst_row0 + n) * ldt + k0 + 8 * c) = o; }
    }
    LDS_WAIT(); asm volatile("" ::: "memory");
}
struct TItem { const float* src; uchar* dst; };
__device__ __forceinline__ void ti_load(const TItem& t, f32x4 (&v)[16], int lane) {
    const float* wp = t.src + (size_t)(lane >> 4) * DM + (lane & 15) * 4;
#pragma unroll
    for (int i = 0; i < 16; ++i) v[i] = *(const f32x4*)(wp + (size_t)(4 * i) * DM);
}
template <bool FP8OUT>
__device__ __forceinline__ void ti_store(const TItem& t, const f32x4 (&v)[16], float oscale, LAS float* scr, int lane) {
#pragma unroll
    for (int i = 0; i < 16; ++i) { LAS float* d = scr + (4 * i + (lane >> 4)) * 65 + (lane & 15) * 4; d[0] = v[i].x * oscale; d[1] = v[i].y * oscale; d[2] = v[i].z * oscale; d[3] = v[i].w * oscale; }
    LDS_WAIT(); asm volatile("" ::: "memory");
    if constexpr (FP8OUT) { const int c = lane & 3;
#pragma unroll
        for (int j = 0; j < 4; ++j) { const int n = (lane >> 2) + 16 * j; const LAS float* s = scr + (16 * c) * 65 + n; u32x4 o;
            o.x = pk4_fp8(s[0 * 65], s[1 * 65], s[2 * 65], s[3 * 65]); o.y = pk4_fp8(s[4 * 65], s[5 * 65], s[6 * 65], s[7 * 65]);
            o.z = pk4_fp8(s[8 * 65], s[9 * 65], s[10 * 65], s[11 * 65]); o.w = pk4_fp8(s[12 * 65], s[13 * 65], s[14 * 65], s[15 * 65]);
            *(u32x4*)(t.dst + (size_t)n * DM + 16 * c) = o; }
    } else { const int c = lane & 7;
#pragma unroll
        for (int j = 0; j < 8; ++j) { const int n = (lane >> 3) + 8 * j; const LAS float* s = scr + (8 * c) * 65 + n;
            u32x4 o; o.x = pk2(s[0 * 65], s[1 * 65]); o.y = pk2(s[2 * 65], s[3 * 65]); o.z = pk2(s[4 * 65], s[5 * 65]); o.w = pk2(s[6 * 65], s[7 * 65]);
            *(u32x4*)(t.dst + ((size_t)n * DM + 8 * c) * 2) = o; }
    }
    LDS_WAIT(); asm volatile("" ::: "memory");
}
template <bool W8>
__device__ __forceinline__ TItem moe_pair(const Args& a, uchar* ws, int it) {
    constexpr size_t WEB = W8 ? 1 : 2; TItem t;
    const int kb = 2 * ((it & 7) | (((it >> 11) & 1) << 3)), nb = (it >> 3) & 31;
    if (it < NE * 2 * 16 * 32) { const int rest = ((it >> 8) & 7) | ((it >> 12) << 3), half = rest & 1, e = rest >> 1, pn = nb >> 1, q = nb & 1;
        t.src = a.in[half ? I_WU : I_WG] + (size_t)e * DM * DFF + (size_t)(kb * 64) * DFF + nb * 64;
        t.dst = ws + WS_W1 + ((size_t)e * 4096 * DM + (size_t)(pn * 256 + half * 128 + q * 64) * DM + kb * 64) * WEB;
    } else { const int r = it - NE * 2 * 16 * 32, e = ((r >> 8) & 7) | ((r >> 12) << 3);
        t.src = a.in[I_WD] + (size_t)e * DFF * DM + (size_t)(kb * 64) * DM + nb * 64;
        t.dst = ws + WS_W2 + ((size_t)e * DM * DFF + (size_t)(nb * 64) * DFF + kb * 64) * WEB; }
    return t;
}
template <bool FP8OUT, int NO>
__device__ __forceinline__ void ti_block(const f32x4 (&v)[16], float oscale, LAS float* scr, int lane, u32x4 (&o)[NO]) {
#pragma unroll
    for (int i = 0; i < 16; ++i) { LAS float* d = scr + (4 * i + (lane >> 4)) * 65 + (lane & 15) * 4; d[0] = v[i].x * oscale; d[1] = v[i].y * oscale; d[2] = v[i].z * oscale; d[3] = v[i].w * oscale; }
    LDS_WAIT(); asm volatile("" ::: "memory");
    if constexpr (FP8OUT) { const int c = lane & 3;
#pragma unroll
        for (int j = 0; j < 4; ++j) { const int n = (lane >> 2) + 16 * j; const LAS float* s = scr + (16 * c) * 65 + n;
            o[j].x = pk4_fp8(s[0 * 65], s[1 * 65], s[2 * 65], s[3 * 65]); o[j].y = pk4_fp8(s[4 * 65], s[5 * 65], s[6 * 65], s[7 * 65]);
            o[j].z = pk4_fp8(s[8 * 65], s[9 * 65], s[10 * 65], s[11 * 65]); o[j].w = pk4_fp8(s[12 * 65], s[13 * 65], s[14 * 65], s[15 * 65]); }
    } else { const int c = lane & 7;
#pragma unroll
        for (int j = 0; j < 8; ++j) { const int n = (lane >> 3) + 8 * j; const LAS float* s = scr + (8 * c) * 65 + n;
            o[j].x = pk2(s[0 * 65], s[1 * 65]); o[j].y = pk2(s[2 * 65], s[3 * 65]); o[j].z = pk2(s[4 * 65], s[5 * 65]); o[j].w = pk2(s[6 * 65], s[7 * 65]); } }
    LDS_WAIT(); asm volatile("" ::: "memory");
}
__device__ __forceinline__ int win_src_col(int n0) {
    if (n0 < C_KVLAT) return n0;
    if (n0 < C_U) return n0;
    if (n0 < C_GA) return (n0 - C_U) + 832;
    if (n0 < C_KR) return (n0 - C_GA) + 1856;
    if (n0 < C_KR + DROPE) return (n0 - C_KR) + 768;
    return -1;
}
__device__ __forceinline__ void s5_build_group(const Args& a, const Frame& F, int g) {
    FRAME_IDS(F);
    LAS float* L = (LAS float*)F.lds;
    LAS float* Apr = L;              LAS float* Api = Apr + 17 * 64;
    LAS float* Zr = Api + 17 * 64;   LAS float* Zi = Zr + 64;
    LAS float* Bbr = Zi + 64;        LAS float* Bbi = Bbr + 1024;
    LAS float* Cr = Bbi + 1024;      LAS float* Ci = Cr + 1024;
    LAS float* Kt = Ci + 1024;
    const int tid = F_tid;
    __syncthreads();
    if (tid < 64) { const int p = tid;
        const float dt = expf(a.in[I_LOGDT][g]); const float lr = a.in[I_LRE][g * 64 + p], li = a.in[I_LIM][g * 64 + p];
        const float mag = expf(lr * dt); const float ar = mag * cosf(li * dt), ai = mag * sinf(li * dt);
        const float den = lr * lr + li * li;
        Zr[p] = ((ar - 1.0f) * lr + ai * li) / den; Zi[p] = (ai * lr - (ar - 1.0f) * li) / den;
        float pr = 1.0f, pi = 0.0f;
        for (int t = 0; t <= 16; ++t) { Apr[t * 64 + p] = pr; Api[t * 64 + p] = pi; const float nr = pr * ar - pi * ai, ni = pr * ai + pi * ar; pr = nr; pi = ni; }
    }
    __syncthreads();
    for (int i = tid; i < 1024; i += NTHREADS) { const int p = i >> 4;
        const float br = a.in[I_BRE][(size_t)g * 1024 + i], bi = a.in[I_BIM][(size_t)g * 1024 + i];
        Bbr[i] = Zr[p] * br - Zi[p] * bi; Bbi[i] = Zr[p] * bi + Zi[p] * br;
        Cr[i] = a.in[I_CRE][(size_t)g * 1024 + i]; Ci[i] = a.in[I_CIM][(size_t)g * 1024 + i]; }
    if (tid < 64) ((float2*)(F.ws + WS_SMALL + SM_A16))[g * 64 + tid] = make_float2(Apr[16 * 64 + tid], Api[16 * 64 + tid]);
    __syncthreads();
    { const int tau = tid >> 5, c = (tid >> 1) & 15, h8 = (tid & 1) * 8; float acc8[8];
#pragma unroll
      for (int j = 0; j < 8; ++j) acc8[j] = 0.f;
      for (int p = 0; p < 64; ++p) { const float cr = Cr[c * 64 + p], ci = Ci[c * 64 + p], ar = Apr[tau * 64 + p], ai = Api[tau * 64 + p];
          const float car = cr * ar - ci * ai, cai = cr * ai + ci * ar;
          const f32x4 b0 = *(const LAS f32x4*)(Bbr + p * 16 + h8), b1 = *(const LAS f32x4*)(Bbr + p * 16 + h8 + 4), d0 = *(const LAS f32x4*)(Bbi + p * 16 + h8), d1 = *(const LAS f32x4*)(Bbi + p * 16 + h8 + 4);
#pragma unroll
          for (int j = 0; j < 4; ++j) { acc8[j] += car * b0[j] - cai * d0[j]; acc8[4 + j] += car * b1[j] - cai * d1[j]; } }
#pragma unroll
      for (int j = 0; j < 8; ++j) Kt[(tau * 16 + c) * 16 + h8 + j] = acc8[j]; }
    __syncthreads();
    bf16_t* twc = (bf16_t*)(F.ws + WS_TWC) + (size_t)g * 256 * APK;
    for (int ch = tid; ch < 256 * (APK / 8); ch += NTHREADS) { const int n = ch / (APK / 8), k0 = (ch % (APK / 8)) * 8, t = n >> 4, c = n & 15; float v[8];
#pragma unroll
        for (int j = 0; j < 8; ++j) { const int k = k0 + j;
            if (k < 256) { const int s = k >> 4, cp = k & 15; float x = (s <= t) ? Kt[((t - s) * 16 + c) * 16 + cp] : 0.f; if (s == t && cp == c) x += a.in[I_S5D][g * 16 + c]; v[j] = x; }
            else { const int q = k - 256, p = q & 63; const float cr = Cr[c * 64 + p], ci = Ci[c * 64 + p], ar = Apr[(t + 1) * 64 + p], ai = Api[(t + 1) * 64 + p];
                v[j] = (q < 64) ? (cr * ar - ci * ai) : -(cr * ai + ci * ar); } }
        u32x4 o; o.x = pk2(v[0], v[1]); o.y = pk2(v[2], v[3]); o.z = pk2(v[4], v[5]); o.w = pk2(v[6], v[7]);
        *(u32x4*)(twc + (size_t)n * APK + k0) = o; }
    bf16_t* wsm = (bf16_t*)(F.ws + WS_WS5) + (size_t)g * 256 * 256;
    for (int ch = tid; ch < 256 * 32; ch += NTHREADS) { const int n = ch >> 5, k0 = (ch & 31) * 8; float v[8];
#pragma unroll
        for (int j = 0; j < 8; ++j) { const int k = k0 + j, s = k >> 4, cp = k & 15;
            if (n < 128) { const int p = n & 63; const float ar = Apr[(15 - s) * 64 + p], ai = Api[(15 - s) * 64 + p], br = Bbr[p * 16 + cp], bi = Bbi[p * 16 + cp];
                v[j] = (n < 64) ? (ar * br - ai * bi) : (ar * bi + ai * br); } else v[j] = 0.f; }
        u32x4 o; o.x = pk2(v[0], v[1]); o.y = pk2(v[2], v[3]); o.z = pk2(v[4], v[5]); o.w = pk2(v[6], v[7]);
        *(u32x4*)(wsm + (size_t)n * 256 + k0) = o; }
    __syncthreads();
}
__device__ __forceinline__ void rms_row_to_bf16(const float* xrow, const float* gain, bf16_t* orow, int lane) {
    const f32x4* xr = (const f32x4*)xrow + lane; const f32x4* gr = (const f32x4*)gain + lane;
    f32x4 v[8]; float s = 0.f;
#pragma unroll
    for (int j = 0; j < 8; ++j) { v[j] = xr[64 * j]; s += (v[j].x * v[j].x + v[j].y * v[j].y) + (v[j].z * v[j].z + v[j].w * v[j].w); }
    const float rstd = 1.0f / sqrtf(wave_sum(s) * (1.0f / DM) + EPS);
    unsigned long long* o8 = (unsigned long long*)orow + lane;
#pragma unroll
    for (int j = 0; j < 8; ++j) { const f32x4 gg = gr[64 * j];
        o8[64 * j] = (unsigned long long)pk2(v[j].x * rstd * gg.x, v[j].y * rstd * gg.y) | ((unsigned long long)pk2(v[j].z * rstd * gg.z, v[j].w * rstd * gg.w) << 32); }
}
__device__ __forceinline__ void p0_prologue(const Args& a, const Frame& F) {
    FRAME_IDS(F);
    for (int g = F.bx; g < S5G; g += F.G) s5_build_group(a, F, g);
    __syncthreads();
    const int gw = F.bx * NWAVES + F.wave, NGW = F.G * NWAVES; const int lane = F_lane;
    for (int m = gw; m < TT; m += NGW) rms_row_to_bf16(a.in[I_X] + (size_t)m * DM, a.in[I_N1G], (bf16_t*)(F.ws + WS_H) + (size_t)m * DM, lane);
    for (int i = gw * 64 + lane; i < TT * 32; i += NGW * 64) { const int t = i >> 5, f = i & 31;
        const double invf = exp(-(double)f * (9.210340371976184 / 32.0)); const double ang = (double)((const int*)a.in[I_POS])[t] * invf;
        ((float2*)(F.ws + WS_ROPE))[i] = make_float2((float)cos(ang), (float)sin(ang)); }
    for (int i = gw * 64 + lane; i < DM * NE; i += NGW * 64) ((float*)(F.ws + WS_SMALL + SM_WRP))[i] = a.in[I_WR][i] * a.in[I_N2G][i >> 5];
    LAS float* scr = (LAS float*)(F.lds + F.wave * 16640);
    constexpr int IT_WIN = (DM / 64) * (NPROJ / 64), IT_WUQ = (QLORA / 64) * (3072 / 64), IT_WUKV = (KVLORA / 64) * (4096 / 64), IT_SQ = (DM / 64) * (DM / 64),
                  IT_GLU = (S5W / 64) * (S5W / 64), IT_OS5 = (S5W / 64) * (DM / 64);
    constexpr int IT_MIX = IT_WIN + IT_WUQ + IT_WUKV + IT_SQ + IT_GLU + IT_OS5 + IT_SQ;
    for (int it = gw; it < IT_MIX; it += NGW) { int r = it;
        if (r < IT_WIN) { const int nb = r % (NPROJ / 64), kb = r / (NPROJ / 64); transpose_item<false>(a.in[I_WIN], IN_PROJ, win_src_col(nb * 64), kb * 64, nullptr, F.ws + WS_WIN, DM, nb * 64, 1.f, scr, lane); continue; } r -= IT_WIN;
        if (r < IT_WUQ) { const int nb = r % 48, kb = r / 48; transpose_item<false>(a.in[I_WUQ], 3072, nb * 64, kb * 64, a.in[I_QNG], F.ws + WS_WUQ, QLORA, nb * 64, 1.f, scr, lane); continue; } r -= IT_WUQ;
        if (r < IT_WUKV) { const int nb = r % 64, kb = r / 64; transpose_item<false>(a.in[I_WUKV], 4096, nb * 64, kb * 64, a.in[I_KVNG], F.ws + WS_WUKV, KVLORA, nb * 64, 1.f, scr, lane); continue; } r -= IT_WUKV;
        if (r < IT_SQ) { const int nb = r % 32, kb = r / 32; transpose_item<false>(a.in[I_WOMLA], DM, nb * 64, kb * 64, nullptr, F.ws + WS_WOMLA, DM, nb * 64, 1.f, scr, lane); continue; } r -= IT_SQ;
        if (r < IT_GLU) { const int nb = r % 16, kb = r / 16; transpose_item<false>(a.in[I_WGLU], S5W, nb * 64, kb * 64, nullptr, F.ws + WS_WGLU, S5W, nb * 64, 1.f, scr, lane); continue; } r -= IT_GLU;
        if (r < IT_OS5) { const int nb = r % 32, kb = r / 32; transpose_item<false>(a.in[I_WOS5], DM, nb * 64, kb * 64, nullptr, F.ws + WS_WOS5, S5W, nb * 64, 1.f, scr, lane); continue; } r -= IT_OS5;
        { const int nb = r % 32, kb = r / 32; transpose_item<false>(a.in[I_WOUT], DM, nb * 64, kb * 64, nullptr, F.ws + WS_WOUT, DM, nb * 64, 1.f, scr, lane); }
    }
    constexpr bool W8 = MK_FP8_MOE != 0; constexpr float WSC = W8 ? FP8_WSCALE : 1.0f; constexpr int NPAIR = NE * 3 * 16 * 32; constexpr int NO = W8 ? 4 : 8;
    for (int it = gw; it < NPAIR; it += NGW) { const TItem t = moe_pair<W8>(a, F.ws, it); f32x4 v0[16], v1[16];
        ti_load(t, v0, lane); { TItem t1 = t; t1.src += (size_t)64 * DM; ti_load(t1, v1, lane); }
        u32x4 o0[NO], o1[NO];
        ti_block<W8, NO>(v0, WSC, scr, lane, o0); ti_block<W8, NO>(v1, WSC, scr, lane, o1);
        if constexpr (W8) { const int c = lane & 3;
#pragma unroll
            for (int j = 0; j < 4; ++j) { uchar* d = t.dst + (size_t)((lane >> 2) + 16 * j) * DM + 16 * c; *(u32x4*)d = o0[j]; *(u32x4*)(d + 64) = o1[j]; }
        } else { const int c = lane & 7;
#pragma unroll
            for (int j = 0; j < 8; ++j) { uchar* d = t.dst + ((size_t)((lane >> 3) + 8 * j) * DM + 8 * c) * 2; *(u32x4*)d = o0[j]; *(u32x4*)(d + 128) = o1[j]; } }
    }
}

constexpr float QSCALE = 0.07216878364870322f * 1.4426950408889634f;
__device__ __forceinline__ float half_sum(float v) {
#pragma unroll
    for (int o = 1; o < 32; o <<= 1) v += __shfl_xor(v, o);
    return v;
}
__device__ __forceinline__ void p3_prep(const Args& a, const Frame& F) {
    FRAME_IDS(F);
    const bf16_t* proj = (const bf16_t*)(F.ws + WS_PROJ); const bf16_t* kvraw = (const bf16_t*)(F.ws + WS_KVRAW); bf16_t* Kn = (bf16_t*)(F.ws + WS_KN);
    const float2* rope = (const float2*)(F.ws + WS_ROPE);
    const int lane = F_lane, grp = lane / 24, ch = lane - grp * 24; const bool act = grp < 2;
    const bool isrope = act && ch >= 16, x2half = isrope && ch >= 20; const int ri = isrope ? ((ch - 16) & 3) * 8 : 0;
    float g[8];
#pragma unroll
    for (int j = 0; j < 8; ++j) g[j] = act ? a.in[I_QKKG][ch * 8 + j] : 0.f;
    const bool even = (TT == 64 * F.G);
    const int tk0 = even ? F.bx * 64 + (F.wave < 2 ? 5 * F.wave : 10 + 9 * (F.wave - 2)) : F.bx * NWAVES + F.wave, tkn = even ? (F.wave < 2 ? 5 : 9) : (TT + F.G * NWAVES - 1) / (F.G * NWAVES), tks = even ? 1 : F.G * NWAVES;
    for (int ti = 0; ti < tkn; ++ti) { const int t = tk0 + ti * tks; if (t >= TT) break;
        const int b = t >> 11, s = t & 2047; const bf16_t* prow = proj + (size_t)t * NPROJ;
        float cs[8], sn[8];
        if (isrope) {
#pragma unroll
            for (int j = 0; j < 8; j += 2) { const f32x4 c2 = *(const f32x4*)(rope + (size_t)t * 32 + ri + j); cs[j] = c2.x; sn[j] = c2.y; cs[j + 1] = c2.z; sn[j + 1] = c2.w; } }
        else {
#pragma unroll
            for (int j = 0; j < 8; ++j) { cs[j] = 1.f; sn[j] = 0.f; } }
        u32x4 kr = (u32x4){0u, 0u, 0u, 0u};
        if (isrope) kr = *(const u32x4*)(prow + C_KR + (ch - 16) * 8);
        u32x4 wl[8];
        { const bf16_t* src0 = kvraw + ((size_t)(b * NH + grp) * SEQ + s) * 128 + (ch & 15) * 8;
#pragma unroll
          for (int i = 0; i < 8; ++i) wl[i] = (!act) ? (u32x4){0u, 0u, 0u, 0u} : (isrope ? kr : *(const u32x4*)(src0 + (size_t)i * 2 * SEQ * 128)); }
#pragma unroll
        for (int i = 0; i < 8; ++i) { const int h = 2 * i + grp; const u32x4 w = wl[i];
            float x[8], ss = 0.f;
#pragma unroll
            for (int q = 0; q < 4; ++q) { x[2 * q] = bflo(w[q]); x[2 * q + 1] = bfhi(w[q]); }
#pragma unroll
            for (int j = 0; j < 8; ++j) ss += x[j] * x[j];
            const float s0 = wave_sum(grp == 0 ? ss : 0.f), s1 = wave_sum(grp == 1 ? ss : 0.f);
            const float rn = 1.0f / sqrtf((grp == 0 ? s0 : s1) * (1.0f / DQK) + EPS);
            float y[8];
#pragma unroll
            for (int j = 0; j < 8; ++j) y[j] = x[j] * rn * g[j];
#pragma unroll
            for (int j = 0; j < 8; ++j) { const float partner = __shfl_xor(y[j], 4); y[j] = x2half ? (y[j] * cs[j] + partner * sn[j]) : (y[j] * cs[j] - partner * sn[j]); }
            if (act) { u32x4 o; o.x = pk2(y[0], y[1]); o.y = pk2(y[2], y[3]); o.z = pk2(y[4], y[5]); o.w = pk2(y[6], y[7]);
                *(u32x4*)(Kn + ((size_t)(b * NH + h) * SEQ + s) * DQK + ch * 8) = o; }
        }
    }
}

__device__ __forceinline__ void p3_scan(const Args& a, const Frame& F) {
    FRAME_IDS(F);
    const float* sch = (const float*)(F.ws + WS_SCH); bf16_t* apack = (bf16_t*)(F.ws + WS_APACK); const float2* A16 = (const float2*)(F.ws + WS_SMALL + SM_A16);
    const int p = F_lane;
    for (int it = F.wave * F.G + F.bx; it < NB * S5G; it += F.G * NWAVES) { const int b = it / S5G, g = it % S5G;
        const float2 am = A16[g * 64 + p]; float xr = 0.f, xi = 0.f;
        const size_t row0 = (size_t)g * NCHUNK + (size_t)b * 128;
        for (int c0 = 0; c0 < 128; c0 += 32) { float sr[32], si[32];
#pragma unroll
            for (int q = 0; q < 32; ++q) { sr[q] = sch[(row0 + c0 + q) * 128 + p]; si[q] = sch[(row0 + c0 + q) * 128 + 64 + p]; }
#pragma unroll
            for (int q = 0; q < 32; ++q) { bf16_t* o = apack + (row0 + c0 + q) * APK + 256; o[p] = (bf16_t)f2bf(xr); o[64 + p] = (bf16_t)f2bf(xi);
                const float nr = am.x * xr - am.y * xi + sr[q], ni = am.x * xi + am.y * xr + si[q]; xr = nr; xi = ni; } }
    }
}

__device__ __forceinline__ void s5_reference(const Args& a, const Frame& F) {
    FRAME_IDS(F);
    const bf16_t* apack = (const bf16_t*)(F.ws + WS_APACK); bf16_t* gact = (bf16_t*)(F.ws + WS_GACT);
    const int gw = F.bx * NWAVES + F.wave, NGW = F.G * NWAVES, p = F_lane;
    for (int it = gw; it < NB * S5G; it += NGW) { const int b = it / S5G, g = it % S5G;
        const float dt = expf(a.in[I_LOGDT][g]); const float lr = a.in[I_LRE][g * 64 + p], li = a.in[I_LIM][g * 64 + p];
        const float mag = expf(lr * dt); const float ar = mag * cosf(li * dt), ai = mag * sinf(li * dt); const float den = lr * lr + li * li;
        const float zr = ((ar - 1.0f) * lr + ai * li) / den, zi = (ai * lr - (ar - 1.0f) * li) / den;
        float bbr[16], bbi[16], cr[16], ci[16];
#pragma unroll
        for (int c = 0; c < 16; ++c) { const float br = a.in[I_BRE][((size_t)g * 64 + p) * 16 + c], bi = a.in[I_BIM][((size_t)g * 64 + p) * 16 + c];
            bbr[c] = zr * br - zi * bi; bbi[c] = zr * bi + zi * br; cr[c] = a.in[I_CRE][((size_t)g * 16 + c) * 64 + p]; ci[c] = a.in[I_CIM][((size_t)g * 16 + c) * 64 + p]; }
        const float dl = (p < 16) ? a.in[I_S5D][g * 16 + p] : 0.f;
        float xr = 0.f, xi = 0.f;
        for (int t = 0; t < SEQ; ++t) { const int tok = b * SEQ + t;
            const bf16_t* up = apack + ((size_t)g * NCHUNK + (tok >> 4)) * APK + (tok & 15) * 16;
            const u32x4 w0 = *(const u32x4*)up, w1 = *(const u32x4*)(up + 8); float u[16];
#pragma unroll
            for (int q = 0; q < 4; ++q) { u[2 * q] = bflo(w0[q]); u[2 * q + 1] = bfhi(w0[q]); u[8 + 2 * q] = bflo(w1[q]); u[8 + 2 * q + 1] = bfhi(w1[q]); }
            float br = 0.f, bi = 0.f;
#pragma unroll
            for (int c = 0; c < 16; ++c) { br += bbr[c] * u[c]; bi += bbi[c] * u[c]; }
            const float nr = ar * xr - ai * xi + br, ni = ar * xi + ai * xr + bi; xr = nr; xi = ni;
            float y = 0.f, um = 0.f;
#pragma unroll
            for (int c = 0; c < 16; ++c) { const float yc = wave_sum(cr[c] * xr - ci[c] * xi); if (p == c) { y = yc; um = u[c]; } }
            if (p < 16) gact[(size_t)tok * S5W + g * 16 + p] = (bf16_t)f2bf(gelu_tanh(y + dl * um));
        }
    }
}

__device__ __forceinline__ float attn_bound(const Args& a, int lane) {
    float mq = 0.f, mk = 0.f;
#pragma unroll
    for (int q = 0; q < 3; ++q) { mq = fmaxf(mq, fabsf(a.in[I_QKQG][lane + 64 * q])); mk = fmaxf(mk, fabsf(a.in[I_QKKG][lane + 64 * q])); }
#pragma unroll
    for (int o = 1; o < 64; o <<= 1) { mq = fmaxf(mq, __shfl_xor(mq, o)); mk = fmaxf(mk, __shfl_xor(mk, o)); }
    return mq * mk * 13.856406460551018f * 1.4426950408889634f;
}
__device__ __forceinline__ void attn_reference(const Args& a, const Frame& F) {
    FRAME_IDS(F);
    const bf16_t* Qn = (const bf16_t*)(F.ws + WS_QN); const bf16_t* Kn = (const bf16_t*)(F.ws + WS_KN); const bf16_t* Vn = (const bf16_t*)(F.ws + WS_VN);
    bf16_t* O = (bf16_t*)(F.ws + WS_O);
    LAS float* ql = (LAS float*)(F.lds + F.wave * 1024);
    const int lane = F_lane, gw = F.bx * NWAVES + F.wave, NGW = F.G * NWAVES;
    const float Mb = attn_bound(a, lane);
    for (int it = gw; it < NB * NH * SEQ; it += NGW) { const int s = it & 2047, bh = it >> 11, b = bh >> 4, h = bh & 15;
        const bf16_t* qp = Qn + ((size_t)bh * SEQ + s) * DQK;
#pragma unroll
        for (int q = 0; q < 3; ++q) ql[lane + 64 * q] = bf2f(qp[lane + 64 * q]);
        LDS_WAIT();
        const int nk = 64 * ((s >> 6) + 1);
        float o0 = 0.f, o1 = 0.f, l = 0.f;
        for (int k0 = 0; k0 < nk; k0 += 64) {
            const bf16_t* kp = Kn + ((size_t)bh * SEQ + k0 + lane) * DQK; float sc = 0.f;
            for (int d = 0; d < DQK; d += 8) { const u32x4 w = *(const u32x4*)(kp + d);
#pragma unroll
                for (int q = 0; q < 4; ++q) sc += bflo(w[q]) * ql[d + 2 * q] + bfhi(w[q]) * ql[d + 2 * q + 1]; }
            const float pr = __builtin_amdgcn_exp2f(sc - Mb); l += pr;
            for (int kk = 0; kk < 64; ++kk) { const float pk = __shfl(pr, kk); const unsigned w = *(const unsigned*)(Vn + ((size_t)bh * SEQ + k0 + kk) * DV + 2 * lane);
                o0 += pk * bflo(w); o1 += pk * bfhi(w); }
        }
        l = wave_sum(l); const float rl = 1.0f / l;
        *(unsigned*)(O + ((size_t)(b * SEQ + s)) * DM + h * DV + 2 * lane) = pk2(o0 * rl, o1 * rl);
        LDS_WAIT();
    }
}

namespace at {
constexpr int KVB = 64;
constexpr int SHM_V = KVB * DV * 2  , SHM_K = KVB * DQK * 2  ;
constexpr int NQR = 4;
constexpr int OFF_V = 0, OFF_K = 2 * SHM_V, OFF_WS = OFF_K + 2 * SHM_K  , OFF_QL = OFF_WS + NWAVES * 256  , OFF_OST = 0;
constexpr int OPITCH = 272;
static_assert(OFF_QL + NWAVES * (12 - NQR) * 1024 <= LDSCTL_OFF, "attention LDS map");
#define KSWZ(row, colB) ((row) * 384 + ((colB) ^ ((((row) >> 1) & 7) << 4)))
__device__ __forceinline__ int crow(int r, int hi) { return (r & 3) + 8 * (r >> 2) + 4 * hi; }
__device__ __forceinline__ int v_st(int k, int c) { const int kk = (k & ~0xC) | ((k & 4) << 1) | ((k & 8) >> 1); return ((kk >> 3) * 4 + (c >> 5)) * 512 + ((kk & 7) * 32 + (c & 31)) * 2; }
__device__ __forceinline__ int v_rd_base(int lane) { return ((lane & 3) << 3) | (((lane >> 2) & 3) << 6) | (((lane >> 4) & 1) << 5) | (((lane >> 5) & 1) << 8); }
constexpr int v_rd_off(int d0, int ks, int half) { return d0 * 512 + ks * 4096 + half * 2048; }
template <int OFF> __device__ __forceinline__ s16x4 tr_read(int vb) { s16x4 r; asm volatile("ds_read_b64_tr_b16 %0, %1 offset:%2" : "=&v"(r) : "v"(vb), "i"(OFF) : "memory"); return r; }
template <int D0> __device__ __forceinline__ void pv_one(f32x16& od, int vb, bf16x8 pa0, bf16x8 pa1, bf16x8 pa2, bf16x8 pa3) {
    const s16x4 l0 = tr_read<v_rd_off(D0, 0, 0)>(vb), h0 = tr_read<v_rd_off(D0, 0, 1)>(vb), l1 = tr_read<v_rd_off(D0, 1, 0)>(vb), h1 = tr_read<v_rd_off(D0, 1, 1)>(vb);
    const s16x4 l2 = tr_read<v_rd_off(D0, 2, 0)>(vb), h2 = tr_read<v_rd_off(D0, 2, 1)>(vb), l3 = tr_read<v_rd_off(D0, 3, 0)>(vb), h3 = tr_read<v_rd_off(D0, 3, 1)>(vb);
    asm volatile("s_waitcnt lgkmcnt(0)" ::: "memory"); SBAR();
#define PK(L, H) (bf16x8){L[0], L[1], L[2], L[3], H[0], H[1], H[2], H[3]}
    od = __builtin_amdgcn_mfma_f32_32x32x16_bf16(pa0, PK(l0, h0), od, 0, 0, 0);
    od = __builtin_amdgcn_mfma_f32_32x32x16_bf16(pa1, PK(l1, h1), od, 0, 0, 0);
    od = __builtin_amdgcn_mfma_f32_32x32x16_bf16(pa2, PK(l2, h2), od, 0, 0, 0);
    od = __builtin_amdgcn_mfma_f32_32x32x16_bf16(pa3, PK(l3, h3), od, 0, 0, 0);
#undef PK
}
__device__ __forceinline__ void pv_d0(f32x16* o, int vb, bf16x8 pa0, bf16x8 pa1, bf16x8 pa2, bf16x8 pa3) {
    pv_one<0>(o[0], vb, pa0, pa1, pa2, pa3); pv_one<1>(o[1], vb, pa0, pa1, pa2, pa3); pv_one<2>(o[2], vb, pa0, pa1, pa2, pa3); pv_one<3>(o[3], vb, pa0, pa1, pa2, pa3);
}
template <int BUF, int NQR> __device__ __forceinline__ void qkt(f32x16& p0, f32x16& p1, const int (&kb)[4], const bf16x8* qr, int qlb) {
    p0 = f32x16{}; p1 = f32x16{};
#pragma unroll
    for (int a = 0; a < 3; ++a)
#pragma unroll
        for (int b = 0; b < 4; ++b) { const int d0 = 4 * a + b;
            const bf16x8 b0 = *(const LAS bf16x8*)(kb[b] + BUF * SHM_K + a * 128);
            const bf16x8 b1 = *(const LAS bf16x8*)(kb[b] + BUF * SHM_K + a * 128 + 32 * 384);
            bf16x8 q; if (d0 < NQR) q = qr[d0]; else q = *(const LAS bf16x8*)(qlb + (d0 - NQR) * 1024);
            p0 = __builtin_amdgcn_mfma_f32_32x32x16_bf16(b0, q, p0, 0, 0, 0);
            p1 = __builtin_amdgcn_mfma_f32_32x32x16_bf16(b1, q, p1, 0, 0, 0); }
}
__device__ __forceinline__ void partialSM(f32x16& p0, f32x16& p1, float bias) {
#pragma unroll
    for (int r = 0; r < 16; ++r) p0[r] = __builtin_amdgcn_exp2f(p0[r] + bias);
#pragma unroll
    for (int r = 0; r < 16; ++r) p1[r] = p1[r] + bias;
}
__device__ __forceinline__ void finishSM(f32x16& p0, f32x16& p1, float& l_reg, bf16x8& pa0, bf16x8& pa1, bf16x8& pa2, bf16x8& pa3) {
#pragma unroll
    for (int r = 0; r < 16; ++r) p1[r] = __builtin_amdgcn_exp2f(p1[r]);
    float ps = 0;
#pragma unroll
    for (int r = 0; r < 16; ++r) ps += p0[r];
#pragma unroll
    for (int r = 0; r < 16; ++r) ps += p1[r];
    { auto rr = __builtin_amdgcn_permlane32_swap(__float_as_uint(ps), __float_as_uint(ps), false, false); ps = __uint_as_float(rr[0]) + __uint_as_float(rr[1]); }
    l_reg += ps;
#define PK4(P, BASE, OUT) do { unsigned a0 = cvt_pk_bf16(P[BASE + 0], P[BASE + 1]), a1 = cvt_pk_bf16(P[BASE + 2], P[BASE + 3]);   \
    unsigned b0 = cvt_pk_bf16(P[BASE + 4], P[BASE + 5]), b1 = cvt_pk_bf16(P[BASE + 6], P[BASE + 7]);                              \
    auto r0 = __builtin_amdgcn_permlane32_swap(a0, b0, false, false); auto r1 = __builtin_amdgcn_permlane32_swap(a1, b1, false, false); \
    u32x4 w = {r0[0], r1[0], r0[1], r1[1]}; OUT = *reinterpret_cast<bf16x8*>(&w); } while (0)
    PK4(p0, 0, pa0); PK4(p0, 8, pa1); PK4(p1, 0, pa2); PK4(p1, 8, pa3);
#undef PK4
}
__device__ __forceinline__ void attn_qblock(const bf16_t* __restrict__ Qb, const bf16_t* __restrict__ Kh, const bf16_t* __restrict__ Vh, bf16_t* __restrict__ Ob, int qb, float Mb, LAS char* lds, const int wid,
                                            const float2* __restrict__ ropeb, const float* __restrict__ gq) {
    const int lane = fresh_lane(), tid = wid * 64 + lane, r32 = lane & 31, hi = lane >> 5;
    LAS char* V_lds = lds + OFF_V; LAS char* K_lds = lds + OFF_K;
    LAS float* li_l = (LAS float*)(lds + OFF_WS) + wid * 64;
    float l_reg = 0; f32x16 o[4] = {}; bf16x8 qr[NQR];
    const int qlb = (int)(uintptr_t)(lds + OFF_QL) + wid * ((12 - NQR) * 1024) + lane * 16;
    {
        const bf16_t* Qw = Qb + (size_t)(wid * 32 + r32) * (NH * DQK) + hi * 8;
        bf16x8 qf[12];
#pragma unroll
        for (int d0 = 0; d0 < 12; ++d0) qf[d0] = *(const bf16x8*)(Qw + d0 * 16);
        float ssq = 0.f;
#pragma unroll
        for (int d0 = 0; d0 < 12; ++d0)
#pragma unroll
            for (int j = 0; j < 8; ++j) { const float v = bf2f((unsigned short)qf[d0][j]); ssq += v * v; }
        ssq += __shfl_xor(ssq, 32);
        const float rn = QSCALE / sqrtf(ssq * (1.0f / DQK) + EPS);
        const float2* rp = ropeb + (size_t)(wid * 32 + r32) * 32 + hi * 8;
#pragma unroll
        for (int d0 = 0; d0 < 12; ++d0) { bf16x8 qn;
            if (d0 < 8) { const f32x4 g0 = *(const f32x4*)(gq + d0 * 16 + hi * 8), g1 = *(const f32x4*)(gq + d0 * 16 + hi * 8 + 4);
#pragma unroll
                for (int j = 0; j < 8; ++j) qn[j] = (short)f2bf(bf2f((unsigned short)qf[d0][j]) * rn * (j < 4 ? g0[j] : g1[j - 4])); }
            else { const int pp = (d0 - 8) & 1, da = 8 + pp, db = 10 + pp; const bool second = d0 >= 10;
#pragma unroll
                for (int j = 0; j < 8; ++j) { const float2 c = rp[pp * 16 + j];
                    const float y1 = bf2f((unsigned short)qf[da][j]) * rn * gq[128 + pp * 16 + hi * 8 + j], y2 = bf2f((unsigned short)qf[db][j]) * rn * gq[160 + pp * 16 + hi * 8 + j];
                    qn[j] = (short)f2bf(second ? (y2 * c.x + y1 * c.y) : (y1 * c.x - y2 * c.y)); } }
            if (d0 < NQR) qr[d0] = qn; else *(LAS bf16x8*)(qlb + (d0 - NQR) * 1024) = qn; }
    }
    const int sr = tid >> 4, sc = (tid & 15) * 8, vst0 = v_st(sr, sc), vst1 = v_st(32 + sr, sc);
    int kro[3], kst[3];
#pragma unroll
    for (int i = 0; i < 3; ++i) { const int q = tid + 512 * i, row = q / 24, c8 = q % 24; kro[i] = row * DQK + c8 * 8; kst[i] = KSWZ(row, c8 * 16); }
    const int vb0 = (int)(uintptr_t)V_lds + v_rd_base(lane);
    int kb[4];
#pragma unroll
    for (int b = 0; b < 4; ++b) kb[b] = (int)(uintptr_t)K_lds + r32 * 384 + ((b * 32 + hi * 16) ^ (((r32 >> 1) & 7) << 4));
    bf16x8 vs0, vs1, ks0, ks1, ks2;
#define SLOAD(k0) do { vs0 = *(const bf16x8*)(Vh + (size_t)((k0) + sr) * DV + sc); vs1 = *(const bf16x8*)(Vh + (size_t)((k0) + 32 + sr) * DV + sc); \
    ks0 = *(const bf16x8*)(Kh + (size_t)(k0) * DQK + kro[0]); ks1 = *(const bf16x8*)(Kh + (size_t)(k0) * DQK + kro[1]); ks2 = *(const bf16x8*)(Kh + (size_t)(k0) * DQK + kro[2]); } while (0)
#define SWRITE(b) do { *(LAS bf16x8*)(V_lds + (b) * SHM_V + vst0) = vs0; *(LAS bf16x8*)(V_lds + (b) * SHM_V + vst1) = vs1; \
    *(LAS bf16x8*)(K_lds + (b) * SHM_K + kst[0]) = ks0; *(LAS bf16x8*)(K_lds + (b) * SHM_K + kst[1]) = ks1; *(LAS bf16x8*)(K_lds + (b) * SHM_K + kst[2]) = ks2; } while (0)
    const int NT = 4 * qb + 4, jmax = 4 * qb + (wid >> 1);
    f32x16 pA0, pA1, pB0, pB1; bf16x8 pa0, pa1, pa2, pa3;
    SLOAD(0); asm volatile("s_waitcnt vmcnt(0)" ::: "memory"); SWRITE(0); __syncthreads();
    qkt<0, NQR>(pA0, pA1, kb, qr, qlb); partialSM(pA0, pA1, -Mb);
    SLOAD(KVB); asm volatile("s_waitcnt vmcnt(0)" ::: "memory"); SWRITE(1); __syncthreads();
    for (int j = 1; j + 1 < NT; j += 2) {
        SBAR(); if (j <= jmax) qkt<1, NQR>(pB0, pB1, kb, qr, qlb);
        if (j - 1 <= jmax) finishSM(pA0, pA1, l_reg, pa0, pa1, pa2, pa3); SBAR();
        SLOAD((j + 1) * KVB); SBAR();
        if (j - 1 <= jmax) pv_d0(o, vb0, pa0, pa1, pa2, pa3); if (j <= jmax) partialSM(pB0, pB1, -Mb);
        __syncthreads(); asm volatile("s_waitcnt vmcnt(0)" ::: "memory"); SWRITE(0);
        __syncthreads();
        SBAR(); if (j + 1 <= jmax) qkt<0, NQR>(pA0, pA1, kb, qr, qlb);
        if (j <= jmax) finishSM(pB0, pB1, l_reg, pa0, pa1, pa2, pa3); SBAR();
        SLOAD((j + 2) * KVB); SBAR();
        if (j <= jmax) pv_d0(o, vb0 + SHM_V, pa0, pa1, pa2, pa3); if (j + 1 <= jmax) partialSM(pA0, pA1, -Mb);
        __syncthreads(); asm volatile("s_waitcnt vmcnt(0)" ::: "memory"); SWRITE(1);
        __syncthreads();
    }
    SBAR(); if (NT - 1 <= jmax) qkt<1, NQR>(pB0, pB1, kb, qr, qlb);
    if (NT - 2 <= jmax) { finishSM(pA0, pA1, l_reg, pa0, pa1, pa2, pa3); SBAR(); pv_d0(o, vb0, pa0, pa1, pa2, pa3); }
    if (NT - 1 <= jmax) { partialSM(pB0, pB1, -Mb); finishSM(pB0, pB1, l_reg, pa0, pa1, pa2, pa3); SBAR(); pv_d0(o, vb0 + SHM_V, pa0, pa1, pa2, pa3); }
    __syncthreads();
    const int lane2 = fresh_lane(), r32b = lane2 & 31, hib = lane2 >> 5, wid2 = wid;
    LAS float* li2 = (LAS float*)(lds + OFF_WS) + wid2 * 64;
    if (hib == 0) li2[r32b] = l_reg; LDS_WAIT();
    LAS char* ost = lds + OFF_OST + wid2 * (32 * OPITCH) + hib * (4 * OPITCH) + r32b * 2;
#pragma unroll
    for (int r = 0; r < 16; ++r) { const int orc = (r & 3) + 8 * (r >> 2); const float rl = __builtin_amdgcn_rcpf(li2[orc + 4 * hib]);
#pragma unroll
        for (int d0 = 0; d0 < 4; ++d0) *(LAS bf16_t*)(ost + orc * OPITCH + d0 * 64) = (bf16_t)f2bf(o[d0][r] * rl); }
    LDS_WAIT();
    bf16_t* Ow = Ob + (size_t)(wid2 * 32 + (lane2 >> 4)) * DM + (lane2 & 15) * 8;
    const LAS char* ord = lds + OFF_OST + wid2 * (32 * OPITCH) + (lane2 >> 4) * OPITCH + (lane2 & 15) * 16;
#pragma unroll
    for (int i = 0; i < 8; ++i) { const u32x4 w = *(const LAS u32x4*)(ord + i * 4 * OPITCH); *(u32x4*)(Ow + (size_t)(i * 4) * DM) = w; }
    __syncthreads();
#undef SLOAD
#undef SWRITE
}
#undef KSWZ
}
__device__ __forceinline__ void p4_attention(const Args& a, const Frame& F) {
    FRAME_IDS(F);
    const bf16_t* qraw = (const bf16_t*)(F.ws + WS_QRAW); const bf16_t* Kn = (const bf16_t*)(F.ws + WS_KN); const bf16_t* Vn = (const bf16_t*)(F.ws + WS_VN);
    bf16_t* O = (bf16_t*)(F.ws + WS_O); const float2* rope = (const float2*)(F.ws + WS_ROPE);
    const float Mb = attn_bound(a, F_lane);
    for (int id = F.bx; id < NB * NH * 4; id += F.G) { const int x = id & 7, idx = id >> 3, bh = x + 8 * (idx >> 2), pr = idx & 3, b = bh >> 4, h = bh & 15;
        const bf16_t* Kh = Kn + (size_t)bh * SEQ * DQK; const bf16_t* Vh = Vn + (size_t)bh * SEQ * DV;
#pragma unroll 1
        for (int w = 0; w < 2; ++w) { const int qb = w ? pr : 7 - pr; const size_t tok0 = (size_t)b * SEQ + qb * 256;
            at::attn_qblock(qraw + tok0 * (NH * DQK) + h * DQK, Kh, Vh, O + tok0 * DM + h * DV, qb, Mb, (LAS char*)F.lds, F.wave, rope + tok0 * 32, a.in[I_QKQG]); }
    }
}

__device__ __forceinline__ void p8_norm2_router(const Args& a, const Frame& F, const float* x1) {
    FRAME_IDS(F);
    bf16_t* H2 = (bf16_t*)(F.ws + WS_H2); int* topi = (int*)(F.ws + WS_TOPI); float* topw = (float*)(F.ws + WS_TOPW);
    const float* wrp = (const float*)(F.ws + WS_SMALL + SM_WRP); const float* g2 = a.in[I_N2G];
    const int lane = F_lane, wave = F.wave, tid = F_tid, i = lane & 31, kk = lane >> 5;
    LAS uchar* xs = F.lds + wave * 8704;
    LAS float* part = (LAS float*)(F.lds + 69632);
    LAS float* ssqp = (LAS float*)(F.lds + 69632 + 33792);
    LAS float* logit = ssqp + 256;
    LAS float* rstdl = logit + 32 * 33;
    for (int tile = F.bx; tile < TT / 32; tile += F.G) {
        const int t0 = tile * 32;
        f32x16 acc = {}; float ssq = 0.f;
        for (int ch = 0; ch < 4; ++ch) { const int k0 = wave * 256 + ch * 64;
            f32x4 v[8];
#pragma unroll
            for (int j = 0; j < 8; ++j) v[j] = *(const f32x4*)(x1 + (size_t)(t0 + 4 * j + (lane >> 4)) * DM + k0 + (lane & 15) * 4);
#pragma unroll
            for (int j = 0; j < 8; ++j) *(LAS f32x4*)(xs + (4 * j + (lane >> 4)) * 272 + (lane & 15) * 16) = v[j];
            LDS_WAIT(); asm volatile("" ::: "memory");
            const float* wp = wrp + (size_t)(k0 + kk * 32) * NE + i;
#pragma unroll
            for (int s4 = 0; s4 < 8; ++s4) { const f32x4 xv = *(const LAS f32x4*)(xs + i * 272 + kk * 128 + s4 * 16);
#pragma unroll
                for (int q = 0; q < 4; ++q) { const float b = wp[(s4 * 4 + q) * NE]; acc = __builtin_amdgcn_mfma_f32_32x32x2f32(xv[q], b, acc, 0, 0, 0); ssq += xv[q] * xv[q]; } }
            LDS_WAIT(); asm volatile("" ::: "memory");
        }
#pragma unroll
        for (int r = 0; r < 16; ++r) part[(wave * 32 + (r & 3) + 8 * (r >> 2) + 4 * kk) * 33 + i] = acc[r];
        ssq += __shfl_xor(ssq, 32);
        if (kk == 0) ssqp[wave * 32 + i] = ssq;
        __syncthreads();
        { const int row = tid >> 4, e0 = (tid & 15) * 2; float s0 = 0.f, s1 = 0.f;
#pragma unroll
          for (int w = 0; w < 8; ++w) { s0 += part[(w * 32 + row) * 33 + e0]; s1 += part[(w * 32 + row) * 33 + e0 + 1]; }
          logit[row * 33 + e0] = s0; logit[row * 33 + e0 + 1] = s1;
          if (tid < 32) { float q = 0.f;
#pragma unroll
              for (int w = 0; w < 8; ++w) q += ssqp[w * 32 + tid];
              rstdl[tid] = 1.0f / sqrtf(q * (1.0f / DM) + EPS); } }
        __syncthreads();
        if (tid < 32) { const float rs = rstdl[tid]; float lg[32];
#pragma unroll
            for (int e = 0; e < 32; ++e) lg[e] = logit[tid * 33 + e] * rs + a.in[I_BR][e];
            int bi[4]; float bv[4];
#pragma unroll
            for (int k = 0; k < 4; ++k) { float m = -3.0e38f; int mi = 0;
#pragma unroll
                for (int e = 0; e < 32; ++e) { const bool used = (k > 0 && bi[0] == e) || (k > 1 && bi[1] == e) || (k > 2 && bi[2] == e); if (!used && lg[e] > m) { m = lg[e]; mi = e; } }
                bi[k] = mi; bv[k] = m; }
            const float e1 = __expf(bv[1] - bv[0]), e2 = __expf(bv[2] - bv[0]), e3 = __expf(bv[3] - bv[0]); const float rsum = 1.0f / (1.0f + e1 + e2 + e3);
            const int t = t0 + tid;
            *(int4*)(topi + 4 * t) = make_int4(bi[0], bi[1], bi[2], bi[3]); *(float4*)(topw + 4 * t) = make_float4(rsum, e1 * rsum, e2 * rsum, e3 * rsum); }
#pragma unroll 4
        for (int it = 0; it < 16; ++it) { const int idx = it * NTHREADS + tid, row = idx >> 8, c8 = (idx & 255) * 8; const float rs = rstdl[row];
            const f32x4 x0 = *(const f32x4*)(x1 + (size_t)(t0 + row) * DM + c8), x1v = *(const f32x4*)(x1 + (size_t)(t0 + row) * DM + c8 + 4);
            const f32x4 g0 = *(const f32x4*)(g2 + c8), g1 = *(const f32x4*)(g2 + c8 + 4);
#if MK_FP8_MOE
            const float rs4 = rs * FP8_ASCALE; u32x2 o; o.x = pk4_fp8(x0.x * rs4 * g0.x, x0.y * rs4 * g0.y, x0.z * rs4 * g0.z, x0.w * rs4 * g0.w); o.y = pk4_fp8(x1v.x * rs4 * g1.x, x1v.y * rs4 * g1.y, x1v.z * rs4 * g1.z, x1v.w * rs4 * g1.w);
            *(u32x2*)((uchar*)H2 + (size_t)(t0 + row) * DM + c8) = o; }
#else
            u32x4 o; o.x = pk2(x0.x * rs * g0.x, x0.y * rs * g0.y); o.y = pk2(x0.z * rs * g0.z, x0.w * rs * g0.w); o.z = pk2(x1v.x * rs * g1.x, x1v.y * rs * g1.y); o.w = pk2(x1v.z * rs * g1.z, x1v.w * rs * g1.w);
            *(u32x4*)(H2 + (size_t)(t0 + row) * DM + c8) = o; }
#endif
        __syncthreads();
    }
}

__device__ __forceinline__ void p9_routing(const Args& a, const Frame& F) {
    FRAME_IDS(F);
    const int* topi = (const int*)(F.ws + WS_TOPI); int* tpos = (int*)(F.ws + WS_TPOS); int* list = (int*)(F.ws + WS_LIST); int* counts = (int*)(F.ws + WS_SMALL + SM_COUNTS);
    LAS int* wtot = (LAS int*)F.lds;
    for (int e = F.bx; e < NE; e += F.G) {
        __syncthreads();
        const int t0 = F.wave * (TT / NWAVES);
        int cnt = 0;
        for (int i = 0; i < TT / NWAVES / 64; ++i) { const int4 ti = *(const int4*)(topi + 4 * (t0 + i * 64 + F_lane));
            const bool hit = (ti.x == e) | (ti.y == e) | (ti.z == e) | (ti.w == e); cnt += __popcll(__ballot(hit)); }
        if (F_lane == 0) wtot[F.wave] = cnt;
        __syncthreads();
        int base = 0, total = 0;
        for (int w = 0; w < NWAVES; ++w) { const int c = wtot[w]; if (w < F.wave) base += c; total += c; }
        for (int i = 0; i < TT / NWAVES / 64; ++i) { const int t = t0 + i * 64 + F_lane; const int4 ti = *(const int4*)(topi + 4 * t);
            const int k = (ti.x == e) ? 0 : (ti.y == e) ? 1 : (ti.z == e) ? 2 : (ti.w == e) ? 3 : -1;
            const unsigned long long bal = __ballot(k >= 0); const int pos = base + __popcll(bal & ((1ull << F_lane) - 1ull));
            if (k >= 0) { list[(size_t)e * TT + pos] = t; tpos[4 * t + k] = pos; }
            base += __popcll(bal); }
        for (int q = total + F_tid; q < ((total + 255) & ~255); q += NTHREADS) list[(size_t)e * TT + q] = 0;
        if (F_tid == 0) counts[e] = total;
    }
}
__device__ __forceinline__ void moe_tables(const Frame& F, LAS int* tab) {
    FRAME_IDS(F);
    const int* counts = (const int*)(F.ws + WS_SMALL + SM_COUNTS);
    __syncthreads();
    if (F_tid == 0) { int pre = 0; for (int e = 0; e < NE; ++e) { const int c = counts[e]; tab[e] = c; const int nt = (c + 255) >> 8; tab[32 + e] = nt; tab[64 + e] = pre; tab[128 + e] = nt > 0 ? ((1 << 20) + nt - 1) / nt : 0; pre += nt; } tab[96] = pre;
        unsigned used = 0u; for (int r = 0; r < NE; ++r) { int best = -1, bn = -1; for (int e = 0; e < NE; ++e) if (!((used >> e) & 1u) && tab[32 + e] > bn) { bn = tab[32 + e]; best = e; }
            used |= 1u << best; const int q = r >> 3, pos = r & 7, xx = (q & 1) ? 7 - pos : pos; tab[160 + xx * 4 + q] = best; } }
    __syncthreads();
}

__device__ __forceinline__ void p10_permute(const Args& a, const Frame& F, const LAS int* tab) {
    FRAME_IDS(F);
    constexpr size_t ROWB = MK_FP8_MOE ? DM : 2 * DM;
    const uchar* H2 = F.ws + WS_H2; uchar* XP = F.ws + WS_XPERM; const int* list = (const int*)(F.ws + WS_LIST);
    const int ntiles = tab[96];
    for (int tile = F.bx; tile < ntiles; tile += F.G) {
        int e = 0;
#pragma unroll 1
        for (int q = 1; q < NE; ++q) if (tab[64 + q] <= tile) e = q;
        const int p0 = (tile - tab[64 + e]) * 256;
        for (int r0 = F.wave * 32; r0 < F.wave * 32 + 32; r0 += 8) { int tok[8]; u32x4 v[8][ROWB / 1024];
#pragma unroll
            for (int q = 0; q < 8; ++q) tok[q] = list[(size_t)e * TT + p0 + r0 + q];
#pragma unroll
            for (int q = 0; q < 8; ++q)
#pragma unroll
                for (int c = 0; c < (int)(ROWB / 1024); ++c) v[q][c] = *(const u32x4*)(H2 + (size_t)tok[q] * ROWB + c * 1024 + F_lane * 16);
#pragma unroll
            for (int q = 0; q < 8; ++q)
#pragma unroll
                for (int c = 0; c < (int)(ROWB / 1024); ++c) *(u32x4*)(XP + ((size_t)tile * 256 + r0 + q) * ROWB + c * 1024 + F_lane * 16) = v[q][c]; }
    }
}

__device__ __forceinline__ void p12_combine(const Args& a, const Frame& F, float* out, const LAS int* tab) {
    FRAME_IDS(F);
    const int* topi = (const int*)(F.ws + WS_TOPI); const float* topw = (const float*)(F.ws + WS_TOPW); const int* tpos = (const int*)(F.ws + WS_TPOS);
    const int lane = F_lane, gw = F.bx * NWAVES + F.wave, NGW = F.G * NWAVES;
#if MK_FP8_MOE
    const uchar* ys = F.ws + WS_YSLOT;
    for (int t = gw; t < TT; t += NGW) {
        const int4 ti = *(const int4*)(topi + 4 * t), tp = *(const int4*)(tpos + 4 * t); float4 tw = *(const float4*)(topw + 4 * t);
        tw.x *= 1.0f / FP8_YSCALE; tw.y *= 1.0f / FP8_YSCALE; tw.z *= 1.0f / FP8_YSCALE; tw.w *= 1.0f / FP8_YSCALE;
        const uchar* r0 = ys + ((size_t)tab[64 + ti.x] * 256 + tp.x) * DM; const uchar* r1 = ys + ((size_t)tab[64 + ti.y] * 256 + tp.y) * DM;
        const uchar* r2 = ys + ((size_t)tab[64 + ti.z] * 256 + tp.z) * DM; const uchar* r3 = ys + ((size_t)tab[64 + ti.w] * 256 + tp.w) * DM;
        float* orow = out + (size_t)t * DM;
        u32x2 y0[4], y1[4], y2[4], y3[4]; f32x4 xa[4], xb[4];
#pragma unroll
        for (int j = 0; j < 4; ++j) { const int c = j * 512 + lane * 8; y0[j] = *(const u32x2*)(r0 + c); y1[j] = *(const u32x2*)(r1 + c); y2[j] = *(const u32x2*)(r2 + c); y3[j] = *(const u32x2*)(r3 + c);
            xa[j] = *(const f32x4*)(orow + c); xb[j] = *(const f32x4*)(orow + c + 4); }
#pragma unroll
        for (int j = 0; j < 4; ++j) { const int c = j * 512 + lane * 8; f32x4 x0 = xa[j], x1 = xb[j];
#define ACC4(X, Y, W) do { const f32x2 lo = __builtin_amdgcn_cvt_pk_f32_fp8((int)(Y), false), hi2 = __builtin_amdgcn_cvt_pk_f32_fp8((int)(Y), true); X[0] += (W) * lo.x; X[1] += (W) * lo.y; X[2] += (W) * hi2.x; X[3] += (W) * hi2.y; } while (0)
            ACC4(x0, y0[j].x, tw.x); ACC4(x1, y0[j].y, tw.x); ACC4(x0, y1[j].x, tw.y); ACC4(x1, y1[j].y, tw.y);
            ACC4(x0, y2[j].x, tw.z); ACC4(x1, y2[j].y, tw.z); ACC4(x0, y3[j].x, tw.w); ACC4(x1, y3[j].y, tw.w);
#undef ACC4
            *(f32x4*)(orow + c) = x0; *(f32x4*)(orow + c + 4) = x1; }
    }
#else
    const bf16_t* ys = (const bf16_t*)(F.ws + WS_YSLOT);
    for (int t = gw; t < TT; t += NGW) {
        const int4 ti = *(const int4*)(topi + 4 * t), tp = *(const int4*)(tpos + 4 * t); const float4 tw = *(const float4*)(topw + 4 * t);
        const bf16_t* r0 = ys + ((size_t)tab[64 + ti.x] * 256 + tp.x) * DM; const bf16_t* r1 = ys + ((size_t)tab[64 + ti.y] * 256 + tp.y) * DM;
        const bf16_t* r2 = ys + ((size_t)tab[64 + ti.z] * 256 + tp.z) * DM; const bf16_t* r3 = ys + ((size_t)tab[64 + ti.w] * 256 + tp.w) * DM;
        float* orow = out + (size_t)t * DM;
#pragma unroll
        for (int j = 0; j < 4; ++j) { const int c = j * 512 + lane * 8;
            const u32x4 a0 = *(const u32x4*)(r0 + c), a1 = *(const u32x4*)(r1 + c), a2 = *(const u32x4*)(r2 + c), a3 = *(const u32x4*)(r3 + c);
            f32x4 x0 = *(const f32x4*)(orow + c), x1 = *(const f32x4*)(orow + c + 4);
#pragma unroll
            for (int q = 0; q < 2; ++q) {
                x0[2 * q] += tw.x * bflo(a0[q]) + tw.y * bflo(a1[q]) + tw.z * bflo(a2[q]) + tw.w * bflo(a3[q]);
                x0[2 * q + 1] += tw.x * bfhi(a0[q]) + tw.y * bfhi(a1[q]) + tw.z * bfhi(a2[q]) + tw.w * bfhi(a3[q]);
                x1[2 * q] += tw.x * bflo(a0[2 + q]) + tw.y * bflo(a1[2 + q]) + tw.z * bflo(a2[2 + q]) + tw.w * bflo(a3[2 + q]);
                x1[2 * q + 1] += tw.x * bfhi(a0[2 + q]) + tw.y * bfhi(a1[2 + q]) + tw.z * bfhi(a2[2 + q]) + tw.w * bfhi(a3[2 + q]); }
            *(f32x4*)(orow + c) = x0; *(f32x4*)(orow + c + 4) = x1; }
    }
#endif
}

constexpr int NPHASE = 14;
__global__ void __launch_bounds__(NTHREADS, 2) mk_fwd(Args a) {
    extern __shared__ __attribute__((aligned(16))) uchar lds_raw[];
    Frame F; F.lds = (LAS uchar*)lds_raw; F.ws = a.ws; F.wave = __builtin_amdgcn_readfirstlane(threadIdx.x >> 6); F.G = gridDim.x; F.bx = blockIdx.x;
    FRAME_IDS(F);
    volatile LAS unsigned* MISC = (volatile LAS unsigned*)(F.lds + MISC_OFF);
    LAS int* tab = (LAS int*)(F.lds + LDSCTL_OFF + 512);
    for (int u = F_tid; u < (LDS_BYTES - LDSCTL_OFF) / 4; u += NTHREADS) ((LAS unsigned*)(F.lds + LDSCTL_OFF))[u] = 0u;
    __syncthreads();
    XcdBarrier bar; bar.bar = (unsigned*)(a.ws + WS_CTL) + CW_BAR; bar.x = 0; bar.st = nullptr; bar.wave = F.wave;
    const int lo = a.ph_lo, hi = a.ph_hi;
    if (hi - lo > 1) bar = xcd_barrier_post((unsigned*)(a.ws + WS_CTL) + CW_BAR, MISC + 8, F.wave);
#ifndef MK_PHASE_MASK
#define MK_PHASE_MASK 0xffff
#endif
#define IN(k) (((MK_PHASE_MASK >> (k)) & 1) && lo <= (k) && (k) < hi)
#ifdef MK_PROBE_LO
    volatile LAS unsigned long long* pr_t = (volatile LAS unsigned long long*)(F.lds + LDSCTL_OFF + 64);
#define PROBE_AT(k) do { if ((k) == MK_PROBE_LO && F.wave == 0 && fresh_lane() == 0) pr_t[0] = __builtin_amdgcn_s_memrealtime(); if ((k) == MK_PROBE_HI + 1 && F.wave == 0 && fresh_lane() == 0) pr_t[1] = __builtin_amdgcn_s_memrealtime(); } while (0)
#else
#define PROBE_AT(k) do { } while (0)
#endif
#define SEAM(k) do { if (IN(k) && IN((k) + 1)) xcd_barrier(bar); } while (0)
    LAS uchar* ring = F.lds;
    uchar* ws = a.ws;
    const int G = F.G, bx = F.bx;

    PROBE_AT(0);
    if (IN(0)) { p0_prologue(a, F); } SEAM(0); PROBE_AT(1);

    if (IN(1)) {
        gm::ProbDense P; P.init((const bf16_t*)(ws + WS_H), DM, (const bf16_t*)(ws + WS_WIN), DM, DM, TT, NPROJ, G, bx);
        EpiInProj E{(bf16_t*)(ws + WS_PROJ), (bf16_t*)(ws + WS_APACK), a.in[I_BG], (float*)(ws + WS_SSQP)};
        gm::gemm_phase<gm::ProbDense, EpiInProj, false>(ring, P, E, F.wave);
    } SEAM(1); PROBE_AT(2);

    if (IN(2)) {
        { gm::ProbDense P; P.init((const bf16_t*)(ws + WS_PROJ) + C_QLAT, NPROJ, (const bf16_t*)(ws + WS_WUQ), QLORA, QLORA, TT, NH * DQK, G, bx);
          EpiStoreScaled<0, 8, QLORA> E{(bf16_t*)(ws + WS_QRAW), NH * DQK, (const float*)(ws + WS_SSQP)}; gm::gemm_phase<gm::ProbDense, EpiStoreScaled<0, 8, QLORA>, false>(ring, P, E, F.wave); }
        { gm::ProbDense P; P.init((const bf16_t*)(ws + WS_PROJ) + C_KVLAT, NPROJ, (const bf16_t*)(ws + WS_WUKV), KVLORA, KVLORA, TT, NH * 256, G, bx);
          EpiKV E{(bf16_t*)(ws + WS_KVRAW), (bf16_t*)(ws + WS_VN), (const float*)(ws + WS_SSQP)}; gm::gemm_phase<gm::ProbDense, EpiKV, false>(ring, P, E, F.wave); }
#if MK_FAST_S5
        { ProbS5 P{(const bf16_t*)(ws + WS_APACK), (const bf16_t*)(ws + WS_WS5), APK, 256, 4, G, bx};
          EpiS5State E{(float*)(ws + WS_SCH)}; gm::gemm_phase<ProbS5, EpiS5State, false>(ring, P, E, F.wave); }
#endif
    } SEAM(2); PROBE_AT(3);

    if (IN(3)) {
#if MK_FAST_S5
        p3_scan(a, F);
#endif
        p3_prep(a, F);
    } SEAM(3); PROBE_AT(4);

    if (IN(4)) {
#if MK_FAST_S5
        { ProbS5 P{(const bf16_t*)(ws + WS_APACK), (const bf16_t*)(ws + WS_TWC), APK, APK, 6, G, bx};
          EpiS5Out E{(bf16_t*)(ws + WS_GACT)}; gm::gemm_phase<ProbS5, EpiS5Out, false>(ring, P, E, F.wave); }
#else
        s5_reference(a, F);
#endif
#if MK_FAST_ATTN
        p4_attention(a, F);
#else
        attn_reference(a, F);
#endif
    } SEAM(4); PROBE_AT(5);

    if (IN(5)) {
        { gm::ProbDense P; P.init((const bf16_t*)(ws + WS_GACT), S5W, (const bf16_t*)(ws + WS_WGLU), S5W, S5W, TT, S5W, G, bx);
          EpiSide<0> E{(bf16_t*)(ws + WS_Y2), S5W, (const bf16_t*)(ws + WS_GACT), S5W, nullptr, 0}; gm::gemm_phase<gm::ProbDense, EpiSide<0>, false>(ring, P, E, F.wave); }
        { gm::ProbDense P; P.init((const bf16_t*)(ws + WS_O), DM, (const bf16_t*)(ws + WS_WOMLA), DM, DM, TT, DM, G, bx);
          EpiSide<1> E{(bf16_t*)(ws + WS_MA), DM, (const bf16_t*)(ws + WS_PROJ) + C_GA, NPROJ, nullptr, 0}; gm::gemm_phase<gm::ProbDense, EpiSide<1>, false>(ring, P, E, F.wave); }
    } SEAM(5); PROBE_AT(6);

    if (IN(6)) {
        gm::ProbDense P; P.init((const bf16_t*)(ws + WS_Y2), S5W, (const bf16_t*)(ws + WS_WOS5), S5W, S5W, TT, DM, G, bx);
        EpiSide<2> E{(bf16_t*)(ws + WS_M), DM, (const bf16_t*)(ws + WS_PROJ) + C_GB, NPROJ, (const bf16_t*)(ws + WS_MA), DM}; gm::gemm_phase<gm::ProbDense, EpiSide<2>, false>(ring, P, E, F.wave);
    } SEAM(6); PROBE_AT(7);

    if (IN(7)) {
        gm::ProbDense P; P.init((const bf16_t*)(ws + WS_M), DM, (const bf16_t*)(ws + WS_WOUT), DM, DM, TT, DM, G, bx);
        EpiResidF32 E{a.in[I_X], a.out}; gm::gemm_phase<gm::ProbDense, EpiResidF32, false>(ring, P, E, F.wave);
    } SEAM(7); PROBE_AT(8);

    if (IN(8)) { p8_norm2_router(a, F, a.out); } SEAM(8); PROBE_AT(9);
    if (IN(9)) { p9_routing(a, F); } SEAM(9); PROBE_AT(10);

    if (IN(10) || IN(11) || IN(12) || IN(13)) moe_tables(F, tab);
    const int xl = bx & 7, rk = bx >> 3, nrk = (G - xl + 7) >> 3;
    if (IN(10)) { p10_permute(a, F, tab); } SEAM(10); PROBE_AT(11);
    if (IN(11)) {
        ProbMoE P{(const bf16_t*)(ws + WS_XPERM), (const bf16_t*)(ws + WS_W1), DM, DM, MK_FP8_MOE ? DM / 128 : DM / 64, 16, (size_t)4096 * DM, xl, rk, nrk}; P.load(tab);
        EpiSwiglu E{(bf16_t*)(ws + WS_HACT), a.in[I_BGATE], a.in[I_BUP], tab}; gm::gemm_phase<ProbMoE, EpiSwiglu, false, MK_FP8_MOE != 0>(ring, P, E, F.wave);
    } SEAM(11); PROBE_AT(12);
    if (IN(12)) {
        ProbMoE P{(const bf16_t*)(ws + WS_HACT), (const bf16_t*)(ws + WS_W2), DFF, DFF, MK_FP8_MOE ? DFF / 128 : DFF / 64, 8, (size_t)DM * DFF, xl, rk, nrk}; P.load(tab);
        EpiDown E{(bf16_t*)(ws + WS_YSLOT), a.in[I_BDOWN], tab}; gm::gemm_phase<ProbMoE, EpiDown, false, MK_FP8_MOE != 0>(ring, P, E, F.wave);
    } SEAM(12); PROBE_AT(13);
    if (IN(13)) { p12_combine(a, F, a.out, tab); }
    PROBE_AT(14);
#ifdef MK_PROBE_LO
    if (blockIdx.x == 0 && F.wave == 0 && fresh_lane() == 0) { const unsigned long long dt = (pr_t[1] - pr_t[0]) * MK_PROBE_X, te = __builtin_amdgcn_s_memrealtime();
        while (__builtin_amdgcn_s_memrealtime() - te < dt) __builtin_amdgcn_s_sleep(32); }
#endif
#undef IN
#undef SEAM
}

extern "C" void kernel_launch(void* const* d_in, const int* in_sizes, int n_in, void* d_out, int out_size, void* d_ws, size_t ws_size, hipStream_t stream) {
    static int grid = 0;
    if (grid == 0) {
        if (n_in != 32 || in_sizes[0] != TT * DM || out_size != TT * DM || ws_size < WS_END) {
            fprintf(stderr, "kernel_launch: shape mismatch: n_in %d in0 %d out %d ws %zu (need %zu); nothing launched\n", n_in, n_in > 0 ? in_sizes[0] : -1, out_size, ws_size, (size_t)WS_END); grid = -1; return; }
        int dev = 0, cus = 0, per_cu = 0;
        if (hipGetDevice(&dev) != hipSuccess || hipDeviceGetAttribute(&cus, hipDeviceAttributeMultiprocessorCount, dev) != hipSuccess) { fprintf(stderr, "kernel_launch: device query failed\n"); grid = -1; return; }
        if (hipFuncSetAttribute((const void*)mk_fwd, hipFuncAttributeMaxDynamicSharedMemorySize, LDS_BYTES) != hipSuccess) { fprintf(stderr, "kernel_launch: hipFuncSetAttribute failed\n"); grid = -1; return; }
        if (hipOccupancyMaxActiveBlocksPerMultiprocessor(&per_cu, (const void*)mk_fwd, NTHREADS, LDS_BYTES) != hipSuccess || per_cu < 1)
            fprintf(stderr, "kernel_launch: note: occupancy query reports %d workgroups per CU\n", per_cu);
        (void)hipGetLastError();
        grid = cus - (cus % 8);
        if (grid < 8) grid = 8;
    }
    if (grid < 0) return;
    if (hipMemsetAsync((char*)d_ws + WS_CTL, 0, CTL_ZERO_BYTES, stream) != hipSuccess) { fprintf(stderr, "kernel_launch: memset failed\n"); return; }
    Args a{};
    for (int i = 0; i < 32; ++i) a.in[i] = (const float*)d_in[i];
    a.out = (float*)d_out; a.ws = (uchar*)d_ws;
#if MK_ONE_LAUNCH
    a.ph_lo = 0; a.ph_hi = NPHASE;
    hipLaunchKernelGGL(mk_fwd, dim3(grid), dim3(NTHREADS), LDS_BYTES, stream, a);
#else
    for (int p = 0; p < NPHASE; ++p) { a.ph_lo = p; a.ph_hi = p + 1; hipLaunchKernelGGL(mk_fwd, dim3(grid), dim3(NTHREADS), LDS_BYTES, stream, a); }
#endif
    const hipError_t le = hipPeekAtLastError();
    if (le != hipSuccess) fprintf(stderr, "kernel_launch: launch failed: %s\n", hipGetErrorName(le));
}
```

```cpp
#include <hip/hip_runtime.h>
#include <cstdio>
#include <cstdint>

#ifndef MK_ONE_LAUNCH
#define MK_ONE_LAUNCH 1
#endif
#ifndef MK_FAST_GEMM
#define MK_FAST_GEMM 1
#endif
#ifndef MK_FAST_ATTN
#define MK_FAST_ATTN 1
#endif
#ifndef MK_FAST_S5
#define MK_FAST_S5 1
#endif

#ifndef MK_FP8_MOE
#define MK_FP8_MOE 1
#endif
#define LAS __attribute__((address_space(3)))
#define GAS __attribute__((address_space(1)))
typedef unsigned short bf16_t;
typedef short bf16x8 __attribute__((ext_vector_type(8)));
typedef short s16x4 __attribute__((ext_vector_type(4)));
typedef float f32x2 __attribute__((ext_vector_type(2)));
typedef float f32x4 __attribute__((ext_vector_type(4)));
typedef float f32x16 __attribute__((ext_vector_type(16)));
typedef unsigned u32x2 __attribute__((ext_vector_type(2)));
typedef unsigned u32x4 __attribute__((ext_vector_type(4)));
typedef unsigned char uchar;
typedef int v4i __attribute__((ext_vector_type(4)));
typedef int v8i __attribute__((ext_vector_type(8)));
constexpr float FP8_YSCALE = 16.0f;
constexpr float FP8_ASCALE = 4.0f, FP8_WSCALE = 64.0f;
__device__ __forceinline__ unsigned pk4_fp8(float a, float b, float c, float d) { int w = __builtin_amdgcn_cvt_pk_fp8_f32(a, b, 0, false); w = __builtin_amdgcn_cvt_pk_fp8_f32(c, d, w, true); return (unsigned)w; }

constexpr int NB = 8, SEQ = 2048, TT = NB * SEQ, DM = 2048;
constexpr int NH = 16, DNOPE = 128, DROPE = 64, DQK = 192, DV = 128, QLORA = 512, KVLORA = 256;
constexpr int S5W = 1024, S5G = 64, S5C = 16, S5P = 64, S5L = 16;
constexpr int NE = 32, TOPK = 4, DFF = 2048;
constexpr int IN_PROJ = QLORA + KVLORA + DROPE + S5W + 2 * DM;
constexpr int NPROJ = 6144;
constexpr int C_QLAT = 0, C_KVLAT = 512, C_U = 768, C_GA = 1792, C_GB = 3840, C_KR = 5888;
constexpr float EPS = 1e-6f;
constexpr int MAXSLOT_TILES = (TT * TOPK) / 256 + NE;
constexpr int MAXSLOTS = MAXSLOT_TILES * 256;
constexpr int NCHUNK = TT / S5L;
constexpr int APK = 384;

constexpr size_t MiB = 1u << 20;
constexpr size_t WS_CTL = 0, CTL_ZERO_BYTES = 1 * MiB;
constexpr size_t WS_WIN = 1 * MiB;
constexpr size_t WS_WUQ = WS_WIN + 24 * MiB;
constexpr size_t WS_WUKV = WS_WUQ + 3 * MiB;
constexpr size_t WS_WOMLA = WS_WUKV + 2 * MiB;
constexpr size_t WS_WGLU = WS_WOMLA + 8 * MiB;
constexpr size_t WS_WOS5 = WS_WGLU + 2 * MiB;
constexpr size_t WS_WOUT = WS_WOS5 + 4 * MiB;
constexpr size_t WS_TWC = WS_WOUT + 8 * MiB;
constexpr size_t WS_WS5 = WS_TWC + 12 * MiB;
constexpr size_t WS_ROPE = WS_WS5 + 8 * MiB;
constexpr size_t WS_SMALL = WS_ROPE + 4 * MiB;
constexpr size_t WS_W1 = WS_SMALL + 1 * MiB;
constexpr size_t WS_W2 = WS_W1 + 512 * MiB;
constexpr size_t WS_ACT = WS_W2 + 256 * MiB;
constexpr size_t WS_H = WS_ACT;
constexpr size_t WS_PROJ = WS_H + 64 * MiB;
constexpr size_t WS_APACK = WS_PROJ + 192 * MiB;
constexpr size_t WS_SCH = WS_APACK + 48 * MiB;
constexpr size_t WS_QRAW = WS_SCH + 32 * MiB;
constexpr size_t WS_KVRAW = WS_QRAW + 96 * MiB;
constexpr size_t WS_QN = WS_KVRAW + 128 * MiB;
constexpr size_t WS_KN = WS_QN + 96 * MiB;
constexpr size_t WS_VN = WS_KN + 96 * MiB;
constexpr size_t WS_O = WS_VN + 64 * MiB;
constexpr size_t WS_GACT = WS_O + 64 * MiB;
constexpr size_t WS_Y2 = WS_GACT + 32 * MiB;
constexpr size_t WS_MA = WS_Y2 + 32 * MiB;
constexpr size_t WS_M = WS_MA + 64 * MiB;
constexpr size_t WS_SSQP = WS_M + 64 * MiB;
constexpr size_t WS_ENDA = WS_SSQP + 1 * MiB;
constexpr size_t WS_H2 = WS_ACT;
constexpr size_t WS_HACT = WS_H2 + 64 * MiB;
constexpr size_t WS_YSLOT = WS_HACT + 288 * MiB;
constexpr size_t WS_TOPI = WS_YSLOT + 288 * MiB;
constexpr size_t WS_TOPW = WS_TOPI + 1 * MiB;
constexpr size_t WS_TPOS = WS_TOPW + 1 * MiB;
constexpr size_t WS_LIST = WS_TPOS + 1 * MiB;
constexpr size_t WS_XPERM = WS_ACT + 704 * MiB;
constexpr size_t WS_ENDB = WS_XPERM + 288 * MiB;
constexpr size_t WS_END = WS_ENDA > WS_ENDB ? WS_ENDA : WS_ENDB;
constexpr size_t SM_A16 = 0;
constexpr size_t SM_COUNTS = 64 * 1024;
constexpr size_t SM_WRP = 128 * 1024;
constexpr int CW_BAR = 4096;

constexpr int RING_BYTES = 131072;
constexpr int LDS_BYTES = 163840;
constexpr int LDSCTL_OFF = LDS_BYTES - 4096;
constexpr int MISC_OFF = LDSCTL_OFF;
constexpr int GTAB_OFF = LDSCTL_OFF + 2048;
constexpr int NWAVES = 8, NTHREADS = 512;

#define LDS_WAIT() asm volatile("s_waitcnt lgkmcnt(0)" ::: "memory")
#define VM_WAIT() asm volatile("s_waitcnt vmcnt(0)" ::: "memory")
#define SBAR() __builtin_amdgcn_sched_barrier(0)

__device__ __forceinline__ unsigned f2bf(float f) { unsigned u = __builtin_bit_cast(unsigned, f); return (u + 0x7fffu + ((u >> 16) & 1u)) >> 16; }
__device__ __forceinline__ unsigned pk2(float lo, float hi) { return f2bf(lo) | (f2bf(hi) << 16); }
__device__ __forceinline__ float bf2f(unsigned b) { return __builtin_bit_cast(float, b << 16); }
__device__ __forceinline__ float bflo(unsigned w) { return __builtin_bit_cast(float, w << 16); }
__device__ __forceinline__ float bfhi(unsigned w) { return __builtin_bit_cast(float, w & 0xffff0000u); }
__device__ __forceinline__ unsigned cvt_pk_bf16(float lo, float hi) { unsigned r; asm volatile("v_cvt_pk_bf16_f32 %0, %1, %2" : "=v"(r) : "v"(lo), "v"(hi)); return r; }
__device__ __forceinline__ float sigmoidf_(float x) { return __builtin_amdgcn_rcpf(1.0f + __builtin_amdgcn_exp2f(-1.4426950408889634f * x)); }
__device__ __forceinline__ float gelu_tanh(float x) {
    const float u = 0.7978845608028654f * (x + 0.044715f * x * x * x);
    const float e = __builtin_amdgcn_exp2f(2.8853900817779268f * u);
    const float th = 1.0f - 2.0f * __builtin_amdgcn_rcpf(e + 1.0f);
    return 0.5f * x * (1.0f + th);
}
__device__ __forceinline__ int fresh_lane() { int z = 0; asm volatile("" : "+s"(z)); return (int)__builtin_amdgcn_mbcnt_hi(~0u, __builtin_amdgcn_mbcnt_lo(~0u, (unsigned)z)); }
__device__ __forceinline__ float wave_sum(float v) {
#pragma unroll
    for (int o = 1; o < 64; o <<= 1) v += __shfl_xor(v, o);
    return v;
}

#define XB_TMO      128
#define XB_XCNT(j)  (256  + 64 * (j))
#define XB_XSUB(j)  (1280 + 64 * (j))
#define XB_XGEN(j)  (2304 + 64 * (j))
#define XB_TOP      3328
#define XB_TOPGEN   3392
#define XCD_BAR_WORDS 3456
#define XB_SPIN_CAP (1u << 18)
__device__ __forceinline__ unsigned xb_ld(unsigned* p)              { return __hip_atomic_load(p, __ATOMIC_RELAXED, __HIP_MEMORY_SCOPE_AGENT); }
__device__ __forceinline__ unsigned xb_add(unsigned* p, unsigned v) { return __hip_atomic_fetch_add(p, v, __ATOMIC_RELAXED, __HIP_MEMORY_SCOPE_AGENT); }
__device__ __forceinline__ unsigned xb_xcc_id() { return (unsigned)__builtin_amdgcn_s_getreg((3 << 11) | 20) & 0xFu; }
#define XB_SPIN(cond, bar) do { unsigned _sp = 0; while (cond) { __builtin_amdgcn_s_sleep(1); \
    if ((++_sp & 255u) == 0u) { if (xb_ld(&(bar)[XB_TMO])) break; if (_sp > XB_SPIN_CAP) { atomicAdd(&(bar)[XB_TMO], 1u); break; } } } } while (0)
struct XcdBarrier { unsigned* bar; unsigned x; volatile LAS unsigned* st; int wave; };
__device__ __forceinline__ XcdBarrier xcd_barrier_post(unsigned* bar, volatile LAS unsigned* st, int wave) {
    XcdBarrier b; b.bar = bar; b.x = xb_xcc_id(); b.st = st; b.wave = wave;
    if (wave == 0 && fresh_lane() == 0) (void)xb_add(&bar[XB_XCNT(b.x)], 1u);
    return b;
}
__device__ __forceinline__ void xcd_barrier_complete(unsigned* bar, unsigned x, unsigned& nloc, unsigned& nx) {
    const unsigned G = gridDim.x * gridDim.y * gridDim.z;
    unsigned sum, cnt, mine, sp = 0u;
    for (;;) {
        sum = 0u; cnt = 0u; mine = 0u;
#pragma unroll
        for (unsigned j = 0; j < 16; ++j) { const unsigned c = xb_ld(&bar[XB_XCNT(j)]); sum += c; cnt += (c > 0u) ? 1u : 0u; mine = (j == x) ? c : mine; }
        if (sum == G) break;
        __builtin_amdgcn_s_sleep(1);
        if ((++sp & 255u) == 0u) { if (xb_ld(&bar[XB_TMO])) break; if (sp > XB_SPIN_CAP) { atomicAdd(&bar[XB_TMO], 1u); break; } }
    }
    nloc = mine > 0u ? mine : 1u; nx = cnt > 0u ? cnt : 1u;
}
__device__ __forceinline__ void xcd_barrier(const XcdBarrier& b) {
    asm volatile("s_waitcnt vmcnt(0)" ::: "memory");
    __syncthreads();
    if (b.wave == 0 && fresh_lane() == 0) {
        unsigned* bar = b.bar;
        __builtin_amdgcn_s_waitcnt(0);
        unsigned nloc = b.st[0], nx = b.st[1];
        if (nloc == 0u) { xcd_barrier_complete(bar, b.x, nloc, nx); b.st[0] = nloc; b.st[1] = nx; }
        const unsigned old = xb_add(&bar[XB_XSUB(b.x)], 1u);
        const unsigned gen = old / nloc;
        if (old + 1u == (gen + 1u) * nloc) {
            __builtin_amdgcn_fence(__ATOMIC_RELEASE, "agent");
            asm volatile("s_waitcnt vmcnt(0)" ::: "memory");
            const unsigned og = xb_add(&bar[XB_TOP], 1u);
            const unsigned tg = og / nx;
            if (og + 1u == (tg + 1u) * nx) xb_add(&bar[XB_TOPGEN], 1u);
            else XB_SPIN(xb_ld(&bar[XB_TOPGEN]) == tg, bar);
            __builtin_amdgcn_fence(__ATOMIC_ACQUIRE, "agent");
            xb_add(&bar[XB_XGEN(b.x)], 1u);
            asm volatile("s_waitcnt vmcnt(0)" ::: "memory");
        } else {
            XB_SPIN(xb_ld(&bar[XB_XGEN(b.x)]) == gen, bar);
            __builtin_amdgcn_fence(__ATOMIC_ACQUIRE, "agent");
            asm volatile("s_waitcnt vmcnt(0)" ::: "memory");
        }
    }
    __syncthreads();
}

namespace gm {
constexpr int BM = 256, BK = 64, HALF = 128, HTB = HALF * BK * 2, STAGE_BYTES = 8 * HTB, NXCD = 8, WGM = 8;
__host__ __device__ __forceinline__ int lds_byte(int r, int c) { const int st = (r >> 4) * 2 + (c >> 5), rr = r & 15, cc = c & 31, ob = rr * 64 + cc * 2; return st * 1024 + (ob ^ (((ob >> 9) & 1) << 5)); }
__host__ __device__ __forceinline__ void stage_rc(int b, int& R, int& C) { const int st = b / 1024, sb = b % 1024, swz = sb ^ (((sb >> 9) & 1) << 5); R = (st >> 1) * 16 + swz / 64; C = (st & 1) * 32 + (swz % 64) / 2; }
__host__ __device__ __forceinline__ int perm32(int rho) { const int n = rho >> 4, i = rho & 15; return 8 * (i >> 2) + 4 * n + (i & 3); }

struct Unit { int pm, pn, g, st; };


struct ProbDense {
    const bf16_t* A; const bf16_t* B; int lda, ldb, nt; int nM, nN, nwg, G, c; const int* list = nullptr; const LAS int* gtab = nullptr;
    __device__ unsigned list_off(const Unit&) const { return 0u; }
    __device__ void init(const bf16_t* A_, int lda_, const bf16_t* B_, int ldb_, int K, int M, int N, int G_, int c_) { A = A_; B = B_; lda = lda_; ldb = ldb_; nt = K / BK; nM = M / BM; nN = N / BM; nwg = nM * nN; G = G_; c = c_; }
    __device__ bool next(int i, Unit& u) const {
        const long L = (long)i * G + c; if (L >= nwg) return false;
        int wgid = (int)L; { const int q = nwg / NXCD, r = nwg % NXCD, xcd = wgid % NXCD, off = wgid / NXCD; wgid = (xcd < r ? xcd * (q + 1) : r * (q + 1) + (xcd - r) * q) + off; }
        const int nig = WGM * nN, gid = wgid / nig, fm = gid * WGM, gsz = (nM - fm) < WGM ? (nM - fm) : WGM;
        u.pm = fm + ((wgid % nig) % gsz); u.pn = (wgid % nig) / gsz; u.g = 0; u.st = 0; return true;
    }
    __device__ size_t a_off(const Unit& u) const { return (size_t)u.pm * BM * lda; }
    __device__ size_t b_off(const Unit& u) const { return (size_t)u.pn * BM * ldb; }
    __device__ unsigned a_row(const Unit&, int) const { return 0u; }
};

#if MK_FAST_GEMM
template <class Prob, class Epi, bool GATHER, bool FP8 = false>
__device__ __forceinline__ void gemm_phase(LAS uchar* lds, const Prob& S, const Epi& E, const int wid  ) {
    constexpr unsigned ESZ = FP8 ? 1u : 2u;
    const int lane = fresh_lane(), tid = wid * 64 + lane, wr = wid >> 2, wc = wid & 3, fr = lane & 15, fq = lane >> 4;
    const int nt = S.nt;
    int Ra[2], Ca[2]; unsigned vB;
    { int R, C; stage_rc(tid * 16, R, C); const int Rb = Epi::PERM ? ((R & ~31) + perm32(R & 31)) : R; Ra[0] = R; Ca[0] = C; Ra[1] = R + 64; Ca[1] = C;
      vB = (unsigned)(Rb * S.ldb) * ESZ + (unsigned)C * 2u; }
    const unsigned dB64 = 64u * (unsigned)S.ldb * ESZ, dA64 = 64u * (unsigned)S.lda * ESZ, dA128 = 2u * dA64;
    constexpr unsigned kstep = BK * 2;
    const unsigned hstepB = (unsigned)HALF * (unsigned)S.ldb * ESZ;
    const unsigned ldsw = (unsigned)wid * 1024u;
    const int aoff = lds_byte(wr * 64 + fr, fq * 8), boff = lds_byte(wc * 32 + fr, fq * 8);
    const __amdgpu_buffer_rsrc_t srdA = __builtin_amdgcn_make_buffer_rsrc((void*)S.A, 0, 0xFFFFFFFF, 0x00020000);
    const __amdgpu_buffer_rsrc_t srdB = __builtin_amdgcn_make_buffer_rsrc((void*)S.B, 0, 0xFFFFFFFF, 0x00020000);
#define G_SA(b, h) (((b) * 2 + (h)) * HTB)
#define G_SB(b, h) ((4 + (b) * 2 + (h)) * HTB)
#define G_STAGE(bufoff, srd, soff, voff) do { _Pragma("unroll") for (int _i = 0; _i < 2; ++_i) \
        __builtin_amdgcn_raw_ptr_buffer_load_lds(srd, (LAS void*)(lds + (bufoff) + ldsw + _i * 8192), 16, (int)(voff)[_i], (int)(soff), 0, 0); } while (0)
#define G_STAGE1(bufoff, srd, soff, v1, d64) do { _Pragma("unroll") for (int _i = 0; _i < 2; ++_i) \
        __builtin_amdgcn_raw_ptr_buffer_load_lds(srd, (LAS void*)(lds + (bufoff) + ldsw + _i * 8192), 16, (int)(v1), (int)((soff) + _i * (d64)), 0, 0); } while (0)
#define G_STAGE_A(bufoff, soff, half, arr0, arr1) do { if constexpr (GATHER) { if (half) G_STAGE(bufoff, srdA, soff, arr1); else G_STAGE(bufoff, srdA, soff, arr0); } \
        else G_STAGE1(bufoff, srdA, (soff) + (half) * dA128, vA, dA64); } while (0)
#define G_LDA(dst, b, h) do { _Pragma("unroll") for (int m = 0; m < 4; ++m) _Pragma("unroll") for (int k = 0; k < 2; ++k) dst[m][k] = *(const LAS bf16x8*)(lds + G_SA(b, h) + aoff + m * 2048 + k * 1024); } while (0)
#define G_LDB(dst, b, h) do { _Pragma("unroll") for (int n = 0; n < 2; ++n) _Pragma("unroll") for (int k = 0; k < 2; ++k) dst[n][k] = *(const LAS bf16x8*)(lds + G_SB(b, h) + boff + n * 2048 + k * 1024); } while (0)
#define G_CAT(x0, x1) __builtin_shufflevector(__builtin_bit_cast(v4i, x0), __builtin_bit_cast(v4i, x1), 0, 1, 2, 3, 4, 5, 6, 7)
#define G_MMA(ai, bj, At, Bt) do { __builtin_amdgcn_s_setprio(1); _Pragma("unroll") for (int m = 0; m < 4; ++m) _Pragma("unroll") for (int n = 0; n < 2; ++n) { \
        if constexpr (FP8) acc[ai][bj][m][n] = __builtin_amdgcn_mfma_scale_f32_16x16x128_f8f6f4(G_CAT(Bt[n][0], Bt[n][1]), G_CAT(At[m][0], At[m][1]), acc[ai][bj][m][n], 0, 0, 0, 0x7f7f7f7f, 0, 0x7f7f7f7f); \
        else { _Pragma("unroll") for (int k = 0; k < 2; ++k) acc[ai][bj][m][n] = __builtin_amdgcn_mfma_f32_16x16x32_bf16(Bt[n][k], At[m][k], acc[ai][bj][m][n], 0, 0, 0); } } \
        __builtin_amdgcn_s_setprio(0); } while (0)
#define G_WAIT_V(n) asm volatile("s_waitcnt vmcnt(" #n ")" ::: "memory")
#define G_WAIT_L(n) asm volatile("s_waitcnt lgkmcnt(" #n ")" ::: "memory")
#define G_BAR __builtin_amdgcn_s_barrier()
#define G_SCHED __builtin_amdgcn_sched_barrier(0)
#define G_UNI(x) ((unsigned)__builtin_amdgcn_readfirstlane((int)(x)))
    Unit cur, nxt; int ui = 0;
    if (!S.next(0, cur)) return;
    unsigned vA0[2], vA1[2];
    unsigned cA = 0u, cB = G_UNI(S.b_off(cur) * ESZ);
    __amdgpu_buffer_rsrc_t srdL = srdA;
    if constexpr (GATHER) srdL = __builtin_amdgcn_make_buffer_rsrc((void*)S.list, 0, 0xFFFFFFFF, 0x00020000);
#define G_IDX(u_) do { if (wid < 4) __builtin_amdgcn_raw_ptr_buffer_load_lds(srdL, (LAS void*)(S.gtab + wid * 64), 4, lane * 4, (int)G_UNI(S.list_off(u_) * 4u) + wid * 256, 0, 0); } while (0)
    const int gR = (int)(uintptr_t)S.gtab + Ra[0] * 4; const unsigned gC = (unsigned)Ca[0] * 2u;
#define G_ROWS(o0, o1) do { const LAS int* _g = (const LAS int*)gR; const unsigned _ls = (unsigned)S.lda * ESZ; \
        o0[0] = (unsigned)_g[0] * _ls + gC; o0[1] = (unsigned)_g[64] * _ls + gC; o1[0] = (unsigned)_g[128] * _ls + gC; o1[1] = (unsigned)_g[192] * _ls + gC; } while (0)
    if constexpr (GATHER) { G_IDX(cur); G_WAIT_V(0); G_BAR; G_ROWS(vA0, vA1); G_WAIT_L(0); G_BAR; }
    else { cA = G_UNI(S.a_off(cur) * ESZ);
#pragma unroll
        for (int i = 0; i < 2; ++i) { vA0[i] = 0u; vA1[i] = 0u; } }
    const unsigned vA = (unsigned)(Ra[0] * S.lda) * ESZ + (unsigned)Ca[0] * 2u;
    G_STAGE1(G_SB(0, 0), srdB, cB, vB, dB64); G_STAGE_A(G_SA(0, 0), cA, 0, vA0, vA1); G_STAGE1(G_SB(0, 1), srdB, cB + hstepB, vB, dB64); G_STAGE_A(G_SA(0, 1), cA, 1, vA0, vA1);
    if (wr == 1) G_BAR;
    G_WAIT_V(4); G_BAR;
    G_STAGE1(G_SB(1, 0), srdB, cB + kstep, vB, dB64); G_STAGE_A(G_SA(1, 0), cA + kstep, 0, vA0, vA1); G_STAGE1(G_SB(1, 1), srdB, cB + hstepB + kstep, vB, dB64);
    G_WAIT_V(6); G_BAR;
    f32x4 acc[2][2][4][2];
#pragma unroll
    for (int a = 0; a < 2; ++a)
#pragma unroll
        for (int b = 0; b < 2; ++b)
#pragma unroll
            for (int m = 0; m < 4; ++m)
#pragma unroll
                for (int n = 0; n < 2; ++n) acc[a][b][m][n] = (f32x4){0.f, 0.f, 0.f, 0.f};
    bf16x8 At[4][2], B0[2][2], B1[2][2];
    for (;;) {
        const bool has_next = S.next(ui + 1, nxt);
        unsigned nA = cA, nB = cB; unsigned x0[2] = {0u, 0u}, x1[2] = {0u, 0u};
        if (has_next) { nB = G_UNI(S.b_off(nxt) * ESZ);
            if constexpr (GATHER) G_IDX(nxt);
            else nA = G_UNI(S.a_off(nxt) * ESZ);
        }
#define G_TRIP(LAST) do { \
            const unsigned a1 = cA + (unsigned)(t + 1) * kstep; \
            const unsigned a2 = (LAST) ? nA : cA + (unsigned)(t + 2) * kstep, b2 = (LAST) ? nB : cB + (unsigned)(t + 2) * kstep; \
            const unsigned a3 = a2 + kstep, b3 = b2 + kstep; \
            unsigned w0[2], w1[2]; \
            _Pragma("unroll") for (int i = 0; i < 2; ++i) { w0[i] = vA0[i]; w1[i] = vA1[i]; } \
            if constexpr (GATHER) { if ((LAST) && has_next) { G_ROWS(w0, w1); _Pragma("unroll") for (int i = 0; i < 2; ++i) { x0[i] = w0[i]; x1[i] = w1[i]; } } } \
              G_LDB(B0, 0, 0); G_SCHED; G_LDA(At, 0, 0); G_STAGE_A(G_SA(1, 1), a1, 1, vA0, vA1); \
            G_WAIT_L(8); G_BAR; G_WAIT_L(0); G_MMA(0, 0, At, B0); G_BAR; G_SCHED; \
              G_LDB(B1, 0, 1); G_STAGE1(G_SB(0, 0), srdB, b2, vB, dB64); \
            G_BAR; G_WAIT_L(0); G_MMA(0, 1, At, B1); G_BAR; \
              G_LDA(At, 0, 1); G_STAGE_A(G_SA(0, 0), a2, 0, w0, w1); \
            G_BAR; G_WAIT_L(0); G_MMA(1, 0, At, B0); G_BAR; G_SCHED; \
              G_STAGE1(G_SB(0, 1), srdB, b2 + hstepB, vB, dB64); \
            G_WAIT_V(6); G_BAR; G_MMA(1, 1, At, B1); G_BAR; \
              G_LDB(B0, 1, 0); G_SCHED; G_LDA(At, 1, 0); G_STAGE_A(G_SA(0, 1), a2, 1, w0, w1); \
            G_WAIT_L(8); G_BAR; G_WAIT_L(0); G_MMA(0, 0, At, B0); G_BAR; G_SCHED; \
              G_LDB(B1, 1, 1); G_STAGE1(G_SB(1, 0), srdB, b3, vB, dB64); \
            G_BAR; G_WAIT_L(0); G_MMA(0, 1, At, B1); G_BAR; \
              G_LDA(At, 1, 1); G_STAGE_A(G_SA(1, 0), a3, 0, w0, w1); \
            G_BAR; G_WAIT_L(0); G_MMA(1, 0, At, B0); G_BAR; G_SCHED; \
              G_STAGE1(G_SB(1, 1), srdB, b3 + hstepB, vB, dB64); \
            G_WAIT_V(6); G_BAR; G_MMA(1, 1, At, B1); G_BAR; } while (0)
        for (int t = 0; t < nt; t += 2) { const bool last = (t == nt - 2); G_TRIP(last); }
        if (wr == 0) G_BAR;
        { const int lane2 = fresh_lane();
          E(acc, cur, wid >> 2, wid & 3, lane2 & 15, lane2 >> 4); }
        if (!has_next) break;
#pragma unroll
        for (int a = 0; a < 2; ++a)
#pragma unroll
            for (int b = 0; b < 2; ++b)
#pragma unroll
                for (int m = 0; m < 4; ++m)
#pragma unroll
                    for (int n = 0; n < 2; ++n) acc[a][b][m][n] = (f32x4){0.f, 0.f, 0.f, 0.f};
        cur = nxt; cA = nA; cB = nB; ++ui;
        if (wr == 1) G_BAR;
        if constexpr (GATHER) {
#pragma unroll
            for (int i = 0; i < 2; ++i) { vA0[i] = x0[i]; vA1[i] = x1[i]; } }
    }
    G_WAIT_V(0);
    G_BAR;
#undef G_SA
#undef G_SB
#undef G_STAGE
#undef G_STAGE1
#undef G_STAGE_A
#undef G_LDA
#undef G_LDB
#undef G_MMA
#undef G_CAT
#undef G_WAIT_V
#undef G_WAIT_L
#undef G_BAR
#undef G_SCHED
#undef G_UNI
#undef G_TRIP
#undef G_IDX
#undef G_ROWS
}
#else
template <class Prob, class Epi, bool GATHER, bool FP8 = false>
__device__ __forceinline__ void gemm_phase(LAS uchar* lds, const Prob& S, const Epi& E, const int wid) {
    const int lane = fresh_lane(), tid = wid * 64 + lane, wr = wid >> 2, wc = wid & 3, fr = lane & 15, fq = lane >> 4;
    LAS float* As = (LAS float*)lds; LAS float* Bs = As + 256 * 33;
    Unit u;
    for (int ui = 0; S.next(ui, u); ++ui) {
        float acc[2][2][4][2][4];
#pragma unroll
        for (int a = 0; a < 2; ++a)
#pragma unroll
            for (int b = 0; b < 2; ++b)
#pragma unroll
                for (int m = 0; m < 4; ++m)
#pragma unroll
                    for (int n = 0; n < 2; ++n)
#pragma unroll
                        for (int j = 0; j < 4; ++j) acc[a][b][m][n][j] = 0.f;
        const int lr = tid >> 1, lk = (tid & 1) * 16;
        const bf16_t* ap = GATHER ? (S.A + S.a_row(u, lr)) : (S.A + S.a_off(u) + (size_t)lr * S.lda);
        const bf16_t* bp = S.B + S.b_off(u) + (size_t)lr * S.ldb;
        for (int k0 = 0; k0 < S.nt * 64; k0 += 32) {
            __syncthreads();
            const u32x4 a0 = *(const u32x4*)(ap + k0 + lk), a1 = *(const u32x4*)(ap + k0 + lk + 8);
            const u32x4 b0 = *(const u32x4*)(bp + k0 + lk), b1 = *(const u32x4*)(bp + k0 + lk + 8);
#pragma unroll
            for (int q = 0; q < 4; ++q) {
                As[lr * 33 + lk + 2 * q] = bflo(a0[q]); As[lr * 33 + lk + 2 * q + 1] = bfhi(a0[q]);
                As[lr * 33 + lk + 8 + 2 * q] = bflo(a1[q]); As[lr * 33 + lk + 8 + 2 * q + 1] = bfhi(a1[q]);
                Bs[lr * 33 + lk + 2 * q] = bflo(b0[q]); Bs[lr * 33 + lk + 2 * q + 1] = bfhi(b0[q]);
                Bs[lr * 33 + lk + 8 + 2 * q] = bflo(b1[q]); Bs[lr * 33 + lk + 8 + 2 * q + 1] = bfhi(b1[q]);
            }
            __syncthreads();
            for (int kk = 0; kk < 32; ++kk) {
                float av[2][4], bv[2][2][4];
#pragma unroll
                for (int a = 0; a < 2; ++a)
#pragma unroll
                    for (int m = 0; m < 4; ++m) av[a][m] = As[(128 * a + 64 * wr + 16 * m + fr) * 33 + kk];
#pragma unroll
                for (int b = 0; b < 2; ++b)
#pragma unroll
                    for (int n = 0; n < 2; ++n)
#pragma unroll
                        for (int j = 0; j < 4; ++j) { const int c = 128 * b + 32 * wc + (Epi::PERM ? (8 * fq + 4 * n + j) : (16 * n + 4 * fq + j)); bv[b][n][j] = Bs[c * 33 + kk]; }
#pragma unroll
                for (int a = 0; a < 2; ++a)
#pragma unroll
                    for (int b = 0; b < 2; ++b)
#pragma unroll
                        for (int m = 0; m < 4; ++m)
#pragma unroll
                            for (int n = 0; n < 2; ++n)
#pragma unroll
                                for (int j = 0; j < 4; ++j) acc[a][b][m][n][j] += av[a][m] * bv[b][n][j];
            }
        }
        f32x4 accv[2][2][4][2];
#pragma unroll
        for (int a = 0; a < 2; ++a)
#pragma unroll
            for (int b = 0; b < 2; ++b)
#pragma unroll
                for (int m = 0; m < 4; ++m)
#pragma unroll
                    for (int n = 0; n < 2; ++n) accv[a][b][m][n] = (f32x4){acc[a][b][m][n][0], acc[a][b][m][n][1], acc[a][b][m][n][2], acc[a][b][m][n][3]};
        E(accv, u, wr, wc, fr, fq);
    }
    __syncthreads();
}
#endif
}

struct Args {
    const float* in[32];
    float* out; uchar* ws;
    int ph_lo, ph_hi;
};
struct Frame {
    LAS uchar* lds; uchar* ws; int wave, G, bx;
};
#define FRAME_IDS(F) const int F_lane = fresh_lane(), F_tid = (F).wave * 64 + F_lane
enum { I_X = 0, I_POS, I_N1G, I_WIN, I_BG, I_QNG, I_WUQ, I_KVNG, I_WUKV, I_QKQG, I_QKKG, I_WOMLA, I_LRE, I_LIM, I_LOGDT, I_BRE, I_BIM, I_CRE, I_CIM, I_S5D,
       I_WGLU, I_WOS5, I_WOUT, I_N2G, I_WR, I_BR, I_WG, I_BGATE, I_WU, I_BUP, I_WD, I_BDOWN };

struct ProbS5 {
    const bf16_t* A; const bf16_t* B; int lda, ldb, nt; int G, c; const int* list = nullptr; const LAS int* gtab = nullptr;
    __device__ unsigned list_off(const gm::Unit&) const { return 0u; }
    __device__ bool next(int i, gm::Unit& u) const { const int L = i * G + c; if (L >= S5G * 4) return false; u.g = L >> 2; u.pm = L & 3; u.pn = 0; u.st = 0; return true; }
    __device__ size_t a_off(const gm::Unit& u) const { return ((size_t)u.g * NCHUNK + (size_t)u.pm * 256) * APK; }
    __device__ size_t b_off(const gm::Unit& u) const { return (size_t)u.g * 256 * ldb; }
    __device__ unsigned a_row(const gm::Unit&, int) const { return 0u; }
};
struct ProbMoE {
    const bf16_t* A; const bf16_t* B; int lda, ldb, nt; int npn; size_t estride;
    int x, rk, nrk; int nte[4], rcp[4], pre[4], eid[4];
    const int* list = nullptr; const LAS int* gtab = nullptr;
    __device__ void load(const LAS int* tab) {
#pragma unroll
        for (int q = 0; q < 4; ++q) { const int e = __builtin_amdgcn_readfirstlane(tab[160 + x * 4 + q]); eid[q] = e; nte[q] = __builtin_amdgcn_readfirstlane(tab[32 + e]); rcp[q] = __builtin_amdgcn_readfirstlane(tab[128 + e]); pre[q] = __builtin_amdgcn_readfirstlane(tab[64 + e]); }
    }
    __device__ unsigned list_off(const gm::Unit&) const { return 0u; }
    __device__ bool next(int i, gm::Unit& u) const {
        int L = i * nrk + rk;
#pragma unroll
        for (int q = 0; q < 4; ++q) { const int nu = nte[q] * npn;
            if (L < nu) { u.g = eid[q]; u.pn = (L * rcp[q]) >> 20; u.pm = L - u.pn * nte[q]; u.st = pre[q] + u.pm; return true; } L -= nu; }
        return false;
    }
    __device__ size_t a_off(const gm::Unit& u) const { return ((size_t)u.st * 256) * lda; }
    __device__ size_t b_off(const gm::Unit& u) const { return (size_t)u.g * estride + (size_t)u.pn * 256 * ldb; }
    __device__ unsigned a_row(const gm::Unit&, int) const { return 0u; }
};

#define EPI_ROW(u_, ai, m) ((u_).pm * 256 + (ai) * 128 + wr * 64 + (m) * 16 + fr)
struct EpiStoreBf16 {
    static constexpr bool PERM = true;
    bf16_t* O; int ld;
    __device__ __forceinline__ void operator()(const f32x4 (&acc)[2][2][4][2], const gm::Unit& u, int wr, int wc, int fr, int fq) const {
#pragma unroll
        for (int ai = 0; ai < 2; ++ai)
#pragma unroll
            for (int m = 0; m < 4; ++m) { bf16_t* rowp = O + (size_t)EPI_ROW(u, ai, m) * ld + u.pn * 256 + wc * 32 + 8 * fq;
#pragma unroll
                for (int bj = 0; bj < 2; ++bj) { const f32x4 v0 = acc[ai][bj][m][0], v1 = acc[ai][bj][m][1];
                    u32x4 w; w.x = cvt_pk_bf16(v0[0], v0[1]); w.y = cvt_pk_bf16(v0[2], v0[3]); w.z = cvt_pk_bf16(v1[0], v1[1]); w.w = cvt_pk_bf16(v1[2], v1[3]);
                    *(u32x4*)(rowp + bj * 128) = w; } }
    }
};
template <int S0, int NS, int LEN> struct EpiStoreScaled {
    static constexpr bool PERM = true;
    bf16_t* O; int ld; const float* ssqp;
    __device__ __forceinline__ void operator()(const f32x4 (&acc)[2][2][4][2], const gm::Unit& u, int wr, int wc, int fr, int fq) const {
#pragma unroll
        for (int ai = 0; ai < 2; ++ai) { float rs[4];
#pragma unroll
            for (int m = 0; m < 4; ++m) { const float* sp = ssqp + (size_t)EPI_ROW(u, ai, m) * 12 + S0; float t = 0.f;
#pragma unroll
                for (int q = 0; q < NS; q += 4) { const f32x4 v = *(const f32x4*)(sp + q); t += (v[0] + v[1]) + (v[2] + v[3]); }
                rs[m] = 1.0f / sqrtf(t * (1.0f / LEN) + EPS); }
#pragma unroll
            for (int m = 0; m < 4; ++m) { bf16_t* rowp = O + (size_t)EPI_ROW(u, ai, m) * ld + u.pn * 256 + wc * 32 + 8 * fq;
#pragma unroll
                for (int bj = 0; bj < 2; ++bj) { const f32x4 v0 = acc[ai][bj][m][0] * rs[m], v1 = acc[ai][bj][m][1] * rs[m];
                    u32x4 w; w.x = cvt_pk_bf16(v0[0], v0[1]); w.y = cvt_pk_bf16(v0[2], v0[3]); w.z = cvt_pk_bf16(v1[0], v1[1]); w.w = cvt_pk_bf16(v1[2], v1[3]);
                    *(u32x4*)(rowp + bj * 128) = w; } } }
    }
};
struct EpiKV {
    static constexpr bool PERM = true;
    bf16_t* kraw; bf16_t* vn; const float* ssqp;
    __device__ __forceinline__ void operator()(const f32x4 (&acc)[2][2][4][2], const gm::Unit& u, int wr, int wc, int fr, int fq) const {
#pragma unroll
        for (int ai = 0; ai < 2; ++ai) { float rs[4];
#pragma unroll
            for (int m = 0; m < 4; ++m) { const f32x4 v = *(const f32x4*)(ssqp + (size_t)EPI_ROW(u, ai, m) * 12 + 8); rs[m] = 1.0f / sqrtf(((v[0] + v[1]) + (v[2] + v[3])) * (1.0f / KVLORA) + EPS); }
#pragma unroll
            for (int m = 0; m < 4; ++m) { const int t = EPI_ROW(u, ai, m); const size_t ro = ((size_t)((t >> 11) * NH + u.pn) * SEQ + (t & 2047)) * 128 + wc * 32 + 8 * fq;
#pragma unroll
                for (int bj = 0; bj < 2; ++bj) { const f32x4 v0 = acc[ai][bj][m][0] * rs[m], v1 = acc[ai][bj][m][1] * rs[m];
                    u32x4 w; w.x = cvt_pk_bf16(v0[0], v0[1]); w.y = cvt_pk_bf16(v0[2], v0[3]); w.z = cvt_pk_bf16(v1[0], v1[1]); w.w = cvt_pk_bf16(v1[2], v1[3]);
                    *(u32x4*)((bj ? vn : kraw) + ro) = w; } } }
    }
};
struct EpiInProj {
    static constexpr bool PERM = true;
    bf16_t* proj; bf16_t* apack; const float* bgates; float* ssqp;
    __device__ __forceinline__ void operator()(const f32x4 (&acc)[2][2][4][2], const gm::Unit& u, int wr, int wc, int fr, int fq) const {
        const int colt = u.pn * 256 + wc * 32 + 8 * fq;
        if (u.pn < 3) {
#pragma unroll
            for (int ai = 0; ai < 2; ++ai)
#pragma unroll
                for (int m = 0; m < 4; ++m) { float sq = 0.f;
#pragma unroll
                    for (int bj = 0; bj < 2; ++bj)
#pragma unroll
                        for (int n = 0; n < 2; ++n) { const f32x4 v = acc[ai][bj][m][n]; sq += (v[0] * v[0] + v[1] * v[1]) + (v[2] * v[2] + v[3] * v[3]); }
                    sq += __shfl_xor(sq, 16); sq += __shfl_xor(sq, 32);
                    if (fq == 0) ssqp[(size_t)EPI_ROW(u, ai, m) * 12 + u.pn * 4 + wc] = sq; } }
        const int kind = (u.pn >= 3 && u.pn < 7) ? 1 : ((u.pn >= 7 && u.pn < 23) ? 2 : 0);
#pragma unroll
        for (int bj = 0; bj < 2; ++bj) {
            const int col = colt + bj * 128;
            f32x4 b0 = (f32x4){0.f, 0.f, 0.f, 0.f}, b1 = b0;
            if (kind == 2) { b0 = *(const f32x4*)(bgates + (col - C_GA)); b1 = *(const f32x4*)(bgates + (col - C_GA) + 4); }
#pragma unroll
            for (int ai = 0; ai < 2; ++ai)
#pragma unroll
                for (int m = 0; m < 4; ++m) {
                    const int row = EPI_ROW(u, ai, m);
                    f32x4 v0 = acc[ai][bj][m][0], v1 = acc[ai][bj][m][1];
                    if (kind == 2) {
#pragma unroll
                        for (int j = 0; j < 4; ++j) { v0[j] = sigmoidf_(v0[j] + b0[j]); v1[j] = sigmoidf_(v1[j] + b1[j]); }
                    }
                    u32x4 w; w.x = cvt_pk_bf16(v0[0], v0[1]); w.y = cvt_pk_bf16(v0[2], v0[3]); w.z = cvt_pk_bf16(v1[0], v1[1]); w.w = cvt_pk_bf16(v1[2], v1[3]);
                    if (kind == 1) { const int j = col - C_U, g = j >> 4, cc = j & 15;
                        *(u32x4*)(apack + ((size_t)g * NCHUNK + (row >> 4)) * APK + (row & 15) * 16 + cc) = w; }
                    else { *(u32x4*)(proj + (size_t)row * NPROJ + col) = w;
                    }
                }
        }
    }
};
struct EpiS5State {
    static constexpr bool PERM = false;
    float* sch;
    __device__ __forceinline__ void operator()(const f32x4 (&acc)[2][2][4][2], const gm::Unit& u, int wr, int wc, int fr, int fq) const {
#pragma unroll
        for (int ai = 0; ai < 2; ++ai)
#pragma unroll
            for (int m = 0; m < 4; ++m) { float* rowp = sch + ((size_t)u.g * NCHUNK + EPI_ROW(u, ai, m)) * 128 + wc * 32 + 4 * fq;
#pragma unroll
                for (int n = 0; n < 2; ++n) *(f32x4*)(rowp + n * 16) = acc[ai][0][m][n]; }
    }
};
struct EpiS5Out {
    static constexpr bool PERM = true;
    bf16_t* gact;
    __device__ __forceinline__ void operator()(const f32x4 (&acc)[2][2][4][2], const gm::Unit& u, int wr, int wc, int fr, int fq) const {
#pragma unroll
        for (int ai = 0; ai < 2; ++ai)
#pragma unroll
            for (int m = 0; m < 4; ++m) { const int r = EPI_ROW(u, ai, m);
#pragma unroll
                for (int bj = 0; bj < 2; ++bj) { const int n0 = bj * 128 + wc * 32 + 8 * fq, t = n0 >> 4, c0 = n0 & 15;
                    f32x4 v0 = acc[ai][bj][m][0], v1 = acc[ai][bj][m][1];
#pragma unroll
                    for (int j = 0; j < 4; ++j) { v0[j] = gelu_tanh(v0[j]); v1[j] = gelu_tanh(v1[j]); }
                    u32x4 w; w.x = cvt_pk_bf16(v0[0], v0[1]); w.y = cvt_pk_bf16(v0[2], v0[3]); w.z = cvt_pk_bf16(v1[0], v1[1]); w.w = cvt_pk_bf16(v1[2], v1[3]);
                    *(u32x4*)(gact + ((size_t)r * 16 + t) * S5W + u.g * 16 + c0) = w; } }
    }
};
template <int MODE> struct EpiSide {
    static constexpr bool PERM = true;
    bf16_t* O; int ldo; const bf16_t* s0; int ld0; const bf16_t* s1; int ld1;
    __device__ __forceinline__ void operator()(const f32x4 (&acc)[2][2][4][2], const gm::Unit& u, int wr, int wc, int fr, int fq) const {
        const int col0 = u.pn * 256 + wc * 32 + 8 * fq;
#pragma unroll
        for (int ai = 0; ai < 2; ++ai) {
            u32x4 sa[4][2], sb[4][2];
#pragma unroll
            for (int m = 0; m < 4; ++m)
#pragma unroll
                for (int bj = 0; bj < 2; ++bj) { const int row = EPI_ROW(u, ai, m);
                    sa[m][bj] = *(const u32x4*)(s0 + (size_t)row * ld0 + col0 + bj * 128);
                    if (MODE == 2) sb[m][bj] = *(const u32x4*)(s1 + (size_t)row * ld1 + col0 + bj * 128); else sb[m][bj] = (u32x4){0u, 0u, 0u, 0u}; }
#pragma unroll
            for (int m = 0; m < 4; ++m)
#pragma unroll
                for (int bj = 0; bj < 2; ++bj) { const int row = EPI_ROW(u, ai, m);
                    const f32x4 v0 = acc[ai][bj][m][0], v1 = acc[ai][bj][m][1]; const u32x4 a = sa[m][bj], b = sb[m][bj];
                    float r[8];
#pragma unroll
                    for (int q = 0; q < 4; ++q) { const float x0 = q < 2 ? v0[2 * q] : v1[2 * q - 4], x1 = q < 2 ? v0[2 * q + 1] : v1[2 * q - 3];
                        const float a0 = bflo(a[q]), a1 = bfhi(a[q]);
                        if (MODE == 0) { r[2 * q] = a0 * sigmoidf_(x0); r[2 * q + 1] = a1 * sigmoidf_(x1); }
                        else if (MODE == 1) { r[2 * q] = a0 * x0; r[2 * q + 1] = a1 * x1; }
                        else { r[2 * q] = bflo(b[q]) + a0 * x0; r[2 * q + 1] = bfhi(b[q]) + a1 * x1; } }
                    u32x4 w; w.x = cvt_pk_bf16(r[0], r[1]); w.y = cvt_pk_bf16(r[2], r[3]); w.z = cvt_pk_bf16(r[4], r[5]); w.w = cvt_pk_bf16(r[6], r[7]);
                    *(u32x4*)(O + (size_t)row * ldo + col0 + bj * 128) = w; }
        }
    }
};
struct EpiResidF32 {
    static constexpr bool PERM = false;
    const float* x; float* out;
    __device__ __forceinline__ void operator()(const f32x4 (&acc)[2][2][4][2], const gm::Unit& u, int wr, int wc, int fr, int fq) const {
#pragma unroll
        for (int ai = 0; ai < 2; ++ai)
#pragma unroll
            for (int mh = 0; mh < 2; ++mh) { f32x4 xv[2][2][2];
#pragma unroll
                for (int mm = 0; mm < 2; ++mm) { const size_t off = (size_t)EPI_ROW(u, ai, 2 * mh + mm) * DM + u.pn * 256 + wc * 32 + 4 * fq;
#pragma unroll
                    for (int bj = 0; bj < 2; ++bj)
#pragma unroll
                        for (int n = 0; n < 2; ++n) xv[mm][bj][n] = *(const f32x4*)(x + off + bj * 128 + n * 16); }
#pragma unroll
                for (int mm = 0; mm < 2; ++mm) { const size_t off = (size_t)EPI_ROW(u, ai, 2 * mh + mm) * DM + u.pn * 256 + wc * 32 + 4 * fq;
#pragma unroll
                    for (int bj = 0; bj < 2; ++bj)
#pragma unroll
                        for (int n = 0; n < 2; ++n) *(f32x4*)(out + off + bj * 128 + n * 16) = xv[mm][bj][n] + acc[ai][bj][2 * mh + mm][n]; } }
    }
};
#if MK_FP8_MOE
constexpr float MOE_DESCALE = 1.0f / (FP8_ASCALE * FP8_WSCALE);
#else
constexpr float MOE_DESCALE = 1.0f;
#endif
struct EpiSwiglu {
    static constexpr bool PERM = true;
    bf16_t* hact; const float* bgate; const float* bup; const LAS int* tab;
    __device__ __forceinline__ void operator()(const f32x4 (&acc)[2][2][4][2], const gm::Unit& u, int wr, int wc, int fr, int fq) const {
        const int hc = u.pn * 128 + wc * 32 + 8 * fq;
        const unsigned slot0 = (unsigned)u.st * 256u + wr * 64 + fr;
        unsigned w0[2][4];
#pragma unroll
        for (int n = 0; n < 2; ++n) {
            const f32x4 g0 = *(const f32x4*)(bgate + (unsigned)(u.g * DFF + hc + 4 * n)), u0 = *(const f32x4*)(bup + (unsigned)(u.g * DFF + hc + 4 * n));
#pragma unroll
            for (int ai = 0; ai < 2; ++ai)
#pragma unroll
                for (int m = 0; m < 4; ++m) { const unsigned slot = slot0 + ai * 128 + m * 16;
                    float r[4];
#pragma unroll
                    for (int q = 0; q < 4; ++q) { float gt = acc[ai][0][m][n][q] * MOE_DESCALE + g0[q], up = acc[ai][1][m][n][q] * MOE_DESCALE + u0[q];
                        gt = fminf(gt, 7.0f); up = fminf(fmaxf(up, -7.0f), 7.0f);
                        r[q] = (up + 1.0f) * (gt * sigmoidf_(1.702f * gt)); }
#if MK_FP8_MOE
                    const unsigned pk = pk4_fp8(r[0] * FP8_ASCALE, r[1] * FP8_ASCALE, r[2] * FP8_ASCALE, r[3] * FP8_ASCALE);
                    if (n == 0) w0[ai][m] = pk; else { u32x2 w; w.x = w0[ai][m]; w.y = pk; *(u32x2*)((uchar*)hact + slot * DFF + hc) = w; }
#else
                    u32x2 w; w.x = cvt_pk_bf16(r[0], r[1]); w.y = cvt_pk_bf16(r[2], r[3]); *(u32x2*)(hact + slot * DFF + hc + 4 * n) = w;
#endif
                }
        }
    }
};
struct EpiDown {
    static constexpr bool PERM = true;
    bf16_t* ys; const float* bdown; const LAS int* tab;
    __device__ __forceinline__ void operator()(const f32x4 (&acc)[2][2][4][2], const gm::Unit& u, int wr, int wc, int fr, int fq) const {
        const size_t slot0 = (size_t)u.st * 256;
#pragma unroll
        for (int bj = 0; bj < 2; ++bj) { const int col = u.pn * 256 + bj * 128 + wc * 32 + 8 * fq;
            const float* bd = bdown + (size_t)u.g * DM + col; const f32x4 d0 = *(const f32x4*)bd, d1 = *(const f32x4*)(bd + 4);
#pragma unroll
            for (int ai = 0; ai < 2; ++ai)
#pragma unroll
                for (int m = 0; m < 4; ++m) { const size_t slot = slot0 + ai * 128 + wr * 64 + m * 16 + fr;
                    const f32x4 v0 = acc[ai][bj][m][0] * MOE_DESCALE + d0, v1 = acc[ai][bj][m][1] * MOE_DESCALE + d1;
#if MK_FP8_MOE
                    u32x2 w; w.x = pk4_fp8(v0[0] * FP8_YSCALE, v0[1] * FP8_YSCALE, v0[2] * FP8_YSCALE, v0[3] * FP8_YSCALE); w.y = pk4_fp8(v1[0] * FP8_YSCALE, v1[1] * FP8_YSCALE, v1[2] * FP8_YSCALE, v1[3] * FP8_YSCALE);
                    *(u32x2*)((uchar*)ys + slot * DM + col) = w; } }
#else
                    u32x4 w; w.x = cvt_pk_bf16(v0[0], v0[1]); w.y = cvt_pk_bf16(v0[2], v0[3]); w.z = cvt_pk_bf16(v1[0], v1[1]); w.w = cvt_pk_bf16(v1[2], v1[3]);
                    *(u32x4*)(ys + slot * DM + col) = w; } }
#endif
    }
};

template <bool FP8OUT>
__device__ __forceinline__ void transpose_item(const float* W, int ldw, int src_col0, int k0, const float* kscale, void* WT, int ldt, int dst_row0, float oscale, LAS float* scr, int lane) {
    if (src_col0 >= 0) {
        f32x4 v[16]; const float* wp = W + (size_t)(k0 + (lane >> 4)) * ldw + src_col0 + (lane & 15) * 4;
#pragma unroll
        for (int i = 0; i < 16; ++i) v[i] = *(const f32x4*)(wp + (size_t)(4 * i) * ldw);
#pragma unroll
        for (int i = 0; i < 16; ++i) { const int kk = 4 * i + (lane >> 4); const float sc = kscale ? kscale[k0 + kk] * oscale : oscale; LAS float* d = scr + kk * 65 + (lane & 15) * 4;
            d[0] = v[i].x * sc; d[1] = v[i].y * sc; d[2] = v[i].z * sc; d[3] = v[i].w * sc; }
    } else {
#pragma unroll
        for (int i = 0; i < 16; ++i) { LAS float* d = scr + (4 * i + (lane >> 4)) * 65 + (lane & 15) * 4; d[0] = 0.f; d[1] = 0.f; d[2] = 0.f; d[3] = 0.f; }
    }
    LDS_WAIT(); asm volatile("" ::: "memory");
    if constexpr (FP8OUT) { const int c = lane & 3;
#pragma unroll
        for (int j = 0; j < 4; ++j) { const int n = (lane >> 2) + 16 * j; const LAS float* s = scr + (16 * c) * 65 + n; u32x4 o;
            o.x = pk4_fp8(s[0 * 65], s[1 * 65], s[2 * 65], s[3 * 65]); o.y = pk4_fp8(s[4 * 65], s[5 * 65], s[6 * 65], s[7 * 65]);
            o.z = pk4_fp8(s[8 * 65], s[9 * 65], s[10 * 65], s[11 * 65]); o.w = pk4_fp8(s[12 * 65], s[13 * 65], s[14 * 65], s[15 * 65]);
            *(u32x4*)((uchar*)WT + (size_t)(dst_row0 + n) * ldt + k0 + 16 * c) = o; }
    } else { const int c = lane & 7;
#pragma unroll
        for (int j = 0; j < 8; ++j) { const int n = (lane >> 3) + 8 * j; const LAS float* s = scr + (8 * c) * 65 + n;
            u32x4 o; o.x = pk2(s[0 * 65], s[1 * 65]); o.y = pk2(s[2 * 65], s[3 * 65]); o.z = pk2(s[4 * 65], s[5 * 65]); o.w = pk2(s[6 * 65], s[7 * 65]);
            *(u32x4*)((bf16_t*)WT + (size_t)(dst_row0 + n) * ldt + k0 + 8 * c) = o; }
    }
    LDS_WAIT(); asm volatile("" ::: "memory");
}
struct TItem { const float* src; uchar* dst; };
__device__ __forceinline__ void ti_load(const TItem& t, f32x4 (&v)[16], int lane) {
    const float* wp = t.src + (size_t)(lane >> 4) * DM + (lane & 15) * 4;
#pragma unroll
    for (int i = 0; i < 16; ++i) v[i] = *(const f32x4*)(wp + (size_t)(4 * i) * DM);
}
template <bool FP8OUT>
__device__ __forceinline__ void ti_store(const TItem& t, const f32x4 (&v)[16], float oscale, LAS float* scr, int lane) {
#pragma unroll
    for (int i = 0; i < 16; ++i) { LAS float* d = scr + (4 * i + (lane >> 4)) * 65 + (lane & 15) * 4; d[0] = v[i].x * oscale; d[1] = v[i].y * oscale; d[2] = v[i].z * oscale; d[3] = v[i].w * oscale; }
    LDS_WAIT(); asm volatile("" ::: "memory");
    if constexpr (FP8OUT) { const int c = lane & 3;
#pragma unroll
        for (int j = 0; j < 4; ++j) { const int n = (lane >> 2) + 16 * j; const LAS float* s = scr + (16 * c) * 65 + n; u32x4 o;
            o.x = pk4_fp8(s[0 * 65], s[1 * 65], s[2 * 65], s[3 * 65]); o.y = pk4_fp8(s[4 * 65], s[5 * 65], s[6 * 65], s[7 * 65]);
            o.z = pk4_fp8(s[8 * 65], s[9 * 65], s[10 * 65], s[11 * 65]); o.w = pk4_fp8(s[12 * 65], s[13 * 65], s[14 * 65], s[15 * 65]);
            *(u32x4*)(t.dst + (size_t)n * DM + 16 * c) = o; }
    } else { const int c = lane & 7;
#pragma unroll
        for (int j = 0; j < 8; ++j) { const int n = (lane >> 3) + 8 * j; const LAS float* s = scr + (8 * c) * 65 + n;
            u32x4 o; o.x = pk2(s[0 * 65], s[1 * 65]); o.y = pk2(s[2 * 65], s[3 * 65]); o.z = pk2(s[4 * 65], s[5 * 65]); o.w = pk2(s[6 * 65], s[7 * 65]);
            *(u32x4*)(t.dst + ((size_t)n * DM + 8 * c) * 2) = o; }
    }
    LDS_WAIT(); asm volatile("" ::: "memory");
}
template <bool W8>
__device__ __forceinline__ TItem moe_pair(const Args& a, uchar* ws, int it) {
    constexpr size_t WEB = W8 ? 1 : 2; TItem t;
    const int kb = 2 * ((it & 7) | (((it >> 11) & 1) << 3)), nb = (it >> 3) & 31;
    if (it < NE * 2 * 16 * 32) { const int rest = ((it >> 8) & 7) | ((it >> 12) << 3), half = rest & 1, e = rest >> 1, pn = nb >> 1, q = nb & 1;
        t.src = a.in[half ? I_WU : I_WG] + (size_t)e * DM * DFF + (size_t)(kb * 64) * DFF + nb * 64;
        t.dst = ws + WS_W1 + ((size_t)e * 4096 * DM + (size_t)(pn * 256 + half * 128 + q * 64) * DM + kb * 64) * WEB;
    } else { const int r = it - NE * 2 * 16 * 32, e = ((r >> 8) & 7) | ((r >> 12) << 3);
        t.src = a.in[I_WD] + (size_t)e * DFF * DM + (size_t)(kb * 64) * DM + nb * 64;
        t.dst = ws + WS_W2 + ((size_t)e * DM * DFF + (size_t)(nb * 64) * DFF + kb * 64) * WEB; }
    return t;
}
template <bool FP8OUT, int NO>
__device__ __forceinline__ void ti_block(const f32x4 (&v)[16], float oscale, LAS float* scr, int lane, u32x4 (&o)[NO]) {
#pragma unroll
    for (int i = 0; i < 16; ++i) { LAS float* d = scr + (4 * i + (lane >> 4)) * 65 + (lane & 15) * 4; d[0] = v[i].x * oscale; d[1] = v[i].y * oscale; d[2] = v[i].z * oscale; d[3] = v[i].w * oscale; }
    LDS_WAIT(); asm volatile("" ::: "memory");
    if constexpr (FP8OUT) { const int c = lane & 3;
#pragma unroll
        for (int j = 0; j < 4; ++j) { const int n = (lane >> 2) + 16 * j; const LAS float* s = scr + (16 * c) * 65 + n;
            o[j].x = pk4_fp8(s[0 * 65], s[1 * 65], s[2 * 65], s[3 * 65]); o[j].y = pk4_fp8(s[4 * 65], s[5 * 65], s[6 * 65], s[7 * 65]);
            o[j].z = pk4_fp8(s[8 * 65], s[9 * 65], s[10 * 65], s[11 * 65]); o[j].w = pk4_fp8(s[12 * 65], s[13 * 65], s[14 * 65], s[15 * 65]); }
    } else { const int c = lane & 7;
#pragma unroll
        for (int j = 0; j < 8; ++j) { const int n = (lane >> 3) + 8 * j; const LAS float* s = scr + (8 * c) * 65 + n;
            o[j].x = pk2(s[0 * 65], s[1 * 65]); o[j].y = pk2(s[2 * 65], s[3 * 65]); o[j].z = pk2(s[4 * 65], s[5 * 65]); o[j].w = pk2(s[6 * 65], s[7 * 65]); } }
    LDS_WAIT(); asm volatile("" ::: "memory");
}
__device__ __forceinline__ int win_src_col(int n0) {
    if (n0 < C_KVLAT) return n0;
    if (n0 < C_U) return n0;
    if (n0 < C_GA) return (n0 - C_U) + 832;
    if (n0 < C_KR) return (n0 - C_GA) + 1856;
    if (n0 < C_KR + DROPE) return (n0 - C_KR) + 768;
    return -1;
}
__device__ __forceinline__ void s5_build_group(const Args& a, const Frame& F, int g) {
    FRAME_IDS(F);
    LAS float* L = (LAS float*)F.lds;
    LAS float* Apr = L;              LAS float* Api = Apr + 17 * 64;
    LAS float* Zr = Api + 17 * 64;   LAS float* Zi = Zr + 64;
    LAS float* Bbr = Zi + 64;        LAS float* Bbi = Bbr + 1024;
    LAS float* Cr = Bbi + 1024;      LAS float* Ci = Cr + 1024;
    LAS float* Kt = Ci + 1024;
    const int tid = F_tid;
    __syncthreads();
    if (tid < 64) { const int p = tid;
        const float dt = expf(a.in[I_LOGDT][g]); const float lr = a.in[I_LRE][g * 64 + p], li = a.in[I_LIM][g * 64 + p];
        const float mag = expf(lr * dt); const float ar = mag * cosf(li * dt), ai = mag * sinf(li * dt);
        const float den = lr * lr + li * li;
        Zr[p] = ((ar - 1.0f) * lr + ai * li) / den; Zi[p] = (ai * lr - (ar - 1.0f) * li) / den;
        float pr = 1.0f, pi = 0.0f;
        for (int t = 0; t <= 16; ++t) { Apr[t * 64 + p] = pr; Api[t * 64 + p] = pi; const float nr = pr * ar - pi * ai, ni = pr * ai + pi * ar; pr = nr; pi = ni; }
    }
    __syncthreads();
    for (int i = tid; i < 1024; i += NTHREADS) { const int p = i >> 4;
        const float br = a.in[I_BRE][(size_t)g * 1024 + i], bi = a.in[I_BIM][(size_t)g * 1024 + i];
        Bbr[i] = Zr[p] * br - Zi[p] * bi; Bbi[i] = Zr[p] * bi + Zi[p] * br;
        Cr[i] = a.in[I_CRE][(size_t)g * 1024 + i]; Ci[i] = a.in[I_CIM][(size_t)g * 1024 + i]; }
    if (tid < 64) ((float2*)(F.ws + WS_SMALL + SM_A16))[g * 64 + tid] = make_float2(Apr[16 * 64 + tid], Api[16 * 64 + tid]);
    __syncthreads();
    { const int tau = tid >> 5, c = (tid >> 1) & 15, h8 = (tid & 1) * 8; float acc8[8];
#pragma unroll
      for (int j = 0; j < 8; ++j) acc8[j] = 0.f;
      for (int p = 0; p < 64; ++p) { const float cr = Cr[c * 64 + p], ci = Ci[c * 64 + p], ar = Apr[tau * 64 + p], ai = Api[tau * 64 + p];
          const float car = cr * ar - ci * ai, cai = cr * ai + ci * ar;
          const f32x4 b0 = *(const LAS f32x4*)(Bbr + p * 16 + h8), b1 = *(const LAS f32x4*)(Bbr + p * 16 + h8 + 4), d0 = *(const LAS f32x4*)(Bbi + p * 16 + h8), d1 = *(const LAS f32x4*)(Bbi + p * 16 + h8 + 4);
#pragma unroll
          for (int j = 0; j < 4; ++j) { acc8[j] += car * b0[j] - cai * d0[j]; acc8[4 + j] += car * b1[j] - cai * d1[j]; } }
#pragma unroll
      for (int j = 0; j < 8; ++j) Kt[(tau * 16 + c) * 16 + h8 + j] = acc8[j]; }
    __syncthreads();
    bf16_t* twc = (bf16_t*)(F.ws + WS_TWC) + (size_t)g * 256 * APK;
    for (int ch = tid; ch < 256 * (APK / 8); ch += NTHREADS) { const int n = ch / (APK / 8), k0 = (ch % (APK / 8)) * 8, t = n >> 4, c = n & 15; float v[8];
#pragma unroll
        for (int j = 0; j < 8; ++j) { const int k = k0 + j;
            if (k < 256) { const int s = k >> 4, cp = k & 15; float x = (s <= t) ? Kt[((t - s) * 16 + c) * 16 + cp] : 0.f; if (s == t && cp == c) x += a.in[I_S5D][g * 16 + c]; v[j] = x; }
            else { const int q = k - 256, p = q & 63; const float cr = Cr[c * 64 + p], ci = Ci[c * 64 + p], ar = Apr[(t + 1) * 64 + p], ai = Api[(t + 1) * 64 + p];
                v[j] = (q < 64) ? (cr * ar - ci * ai) : -(cr * ai + ci * ar); } }
        u32x4 o; o.x = pk2(v[0], v[1]); o.y = pk2(v[2], v[3]); o.z = pk2(v[4], v[5]); o.w = pk2(v[6], v[7]);
        *(u32x4*)(twc + (size_t)n * APK + k0) = o; }
    bf16_t* wsm = (bf16_t*)(F.ws + WS_WS5) + (size_t)g * 256 * 256;
    for (int ch = tid; ch < 256 * 32; ch += NTHREADS) { const int n = ch >> 5, k0 = (ch & 31) * 8; float v[8];
#pragma unroll
        for (int j = 0; j < 8; ++j) { const int k = k0 + j, s = k >> 4, cp = k & 15;
            if (n < 128) { const int p = n & 63; const float ar = Apr[(15 - s) * 64 + p], ai = Api[(15 - s) * 64 + p], br = Bbr[p * 16 + cp], bi = Bbi[p * 16 + cp];
                v[j] = (n < 64) ? (ar * br - ai * bi) : (ar * bi + ai * br); } else v[j] = 0.f; }
        u32x4 o; o.x = pk2(v[0], v[1]); o.y = pk2(v[2], v[3]); o.z = pk2(v[4], v[5]); o.w = pk2(v[6], v[7]);
        *(u32x4*)(wsm + (size_t)n * 256 + k0) = o; }
    __syncthreads();
}
__device__ __forceinline__ void rms_row_to_bf16(const float* xrow, const float* gain, bf16_t* orow, int lane) {
    const f32x4* xr = (const f32x4*)xrow + lane; const f32x4* gr = (const f32x4*)gain + lane;
    f32x4 v[8]; float s = 0.f;
#pragma unroll
    for (int j = 0; j < 8; ++j) { v[j] = xr[64 * j]; s += (v[j].x * v[j].x + v[j].y * v[j].y) + (v[j].z * v[j].z + v[j].w * v[j].w); }
    const float rstd = 1.0f / sqrtf(wave_sum(s) * (1.0f / DM) + EPS);
    unsigned long long* o8 = (unsigned long long*)orow + lane;
#pragma unroll
    for (int j = 0; j < 8; ++j) { const f32x4 gg = gr[64 * j];
        o8[64 * j] = (unsigned long long)pk2(v[j].x * rstd * gg.x, v[j].y * rstd * gg.y) | ((unsigned long long)pk2(v[j].z * rstd * gg.z, v[j].w * rstd * gg.w) << 32); }
}
__device__ __forceinline__ void p0_prologue(const Args& a, const Frame& F) {
    FRAME_IDS(F);
    for (int g = F.bx; g < S5G; g += F.G) s5_build_group(a, F, g);
    __syncthreads();
    const int gw = F.bx * NWAVES + F.wave, NGW = F.G * NWAVES; const int lane = F_lane;
    for (int m = gw; m < TT; m += NGW) rms_row_to_bf16(a.in[I_X] + (size_t)m * DM, a.in[I_N1G], (bf16_t*)(F.ws + WS_H) + (size_t)m * DM, lane);
    for (int i = gw * 64 + lane; i < TT * 32; i += NGW * 64) { const int t = i >> 5, f = i & 31;
        const double invf = exp(-(double)f * (9.210340371976184 / 32.0)); const double ang = (double)((const int*)a.in[I_POS])[t] * invf;
        ((float2*)(F.ws + WS_ROPE))[i] = make_float2((float)cos(ang), (float)sin(ang)); }
    for (int i = gw * 64 + lane; i < DM * NE; i += NGW * 64) ((float*)(F.ws + WS_SMALL + SM_WRP))[i] = a.in[I_WR][i] * a.in[I_N2G][i >> 5];
    LAS float* scr = (LAS float*)(F.lds + F.wave * 16640);
    constexpr int IT_WIN = (DM / 64) * (NPROJ / 64), IT_WUQ = (QLORA / 64) * (3072 / 64), IT_WUKV = (KVLORA / 64) * (4096 / 64), IT_SQ = (DM / 64) * (DM / 64),
                  IT_GLU = (S5W / 64) * (S5W / 64), IT_OS5 = (S5W / 64) * (DM / 64);
    constexpr int IT_MIX = IT_WIN + IT_WUQ + IT_WUKV + IT_SQ + IT_GLU + IT_OS5 + IT_SQ;
    for (int it = gw; it < IT_MIX; it += NGW) { int r = it;
        if (r < IT_WIN) { const int nb = r % (NPROJ / 64), kb = r / (NPROJ / 64); transpose_item<false>(a.in[I_WIN], IN_PROJ, win_src_col(nb * 64), kb * 64, nullptr, F.ws + WS_WIN, DM, nb * 64, 1.f, scr, lane); continue; } r -= IT_WIN;
        if (r < IT_WUQ) { const int nb = r % 48, kb = r / 48; transpose_item<false>(a.in[I_WUQ], 3072, nb * 64, kb * 64, a.in[I_QNG], F.ws + WS_WUQ, QLORA, nb * 64, 1.f, scr, lane); continue; } r -= IT_WUQ;
        if (r < IT_WUKV) { const int nb = r % 64, kb = r / 64; transpose_item<false>(a.in[I_WUKV], 4096, nb * 64, kb * 64, a.in[I_KVNG], F.ws + WS_WUKV, KVLORA, nb * 64, 1.f, scr, lane); continue; } r -= IT_WUKV;
        if (r < IT_SQ) { const int nb = r % 32, kb = r / 32; transpose_item<false>(a.in[I_WOMLA], DM, nb * 64, kb * 64, nullptr, F.ws + WS_WOMLA, DM, nb * 64, 1.f, scr, lane); continue; } r -= IT_SQ;
        if (r < IT_GLU) { const int nb = r % 16, kb = r / 16; transpose_item<false>(a.in[I_WGLU], S5W, nb * 64, kb * 64, nullptr, F.ws + WS_WGLU, S5W, nb * 64, 1.f, scr, lane); continue; } r -= IT_GLU;
        if (r < IT_OS5) { const int nb = r % 32, kb = r / 32; transpose_item<false>(a.in[I_WOS5], DM, nb * 64, kb * 64, nullptr, F.ws + WS_WOS5, S5W, nb * 64, 1.f, scr, lane); continue; } r -= IT_OS5;
        { const int nb = r % 32, kb = r / 32; transpose_item<false>(a.in[I_WOUT], DM, nb * 64, kb * 64, nullptr, F.ws + WS_WOUT, DM, nb * 64, 1.f, scr, lane); }
    }
    constexpr bool W8 = MK_FP8_MOE != 0; constexpr float WSC = W8 ? FP8_WSCALE : 1.0f; constexpr int NPAIR = NE * 3 * 16 * 32; constexpr int NO = W8 ? 4 : 8;
    for (int it = gw; it < NPAIR; it += NGW) { const TItem t = moe_pair<W8>(a, F.ws, it); f32x4 v0[16], v1[16];
        ti_load(t, v0, lane); { TItem t1 = t; t1.src += (size_t)64 * DM; ti_load(t1, v1, lane); }
        u32x4 o0[NO], o1[NO];
        ti_block<W8, NO>(v0, WSC, scr, lane, o0); ti_block<W8, NO>(v1, WSC, scr, lane, o1);
        if constexpr (W8) { const int c = lane & 3;
#pragma unroll
            for (int j = 0; j < 4; ++j) { uchar* d = t.dst + (size_t)((lane >> 2) + 16 * j) * DM + 16 * c; *(u32x4*)d = o0[j]; *(u32x4*)(d + 64) = o1[j]; }
        } else { const int c = lane & 7;
#pragma unroll
            for (int j = 0; j < 8; ++j) { uchar* d = t.dst + ((size_t)((lane >> 3) + 8 * j) * DM + 8 * c) * 2; *(u32x4*)d = o0[j]; *(u32x4*)(d + 128) = o1[j]; } }
    }
}

constexpr float QSCALE = 0.07216878364870322f * 1.4426950408889634f;
__device__ __forceinline__ float half_sum(float v) {
#pragma unroll
    for (int o = 1; o < 32; o <<= 1) v += __shfl_xor(v, o);
    return v;
}
__device__ __forceinline__ void p3_prep(const Args& a, const Frame& F) {
    FRAME_IDS(F);
    const bf16_t* proj = (const bf16_t*)(F.ws + WS_PROJ); const bf16_t* kvraw = (const bf16_t*)(F.ws + WS_KVRAW); bf16_t* Kn = (bf16_t*)(F.ws + WS_KN);
    const float2* rope = (const float2*)(F.ws + WS_ROPE);
    const int lane = F_lane, grp = lane / 24, ch = lane - grp * 24; const bool act = grp < 2;
    const bool isrope = act && ch >= 16, x2half = isrope && ch >= 20; const int ri = isrope ? ((ch - 16) & 3) * 8 : 0;
    float g[8];
#pragma unroll
    for (int j = 0; j < 8; ++j) g[j] = act ? a.in[I_QKKG][ch * 8 + j] : 0.f;
    const bool even = (TT == 64 * F.G);
    const int tk0 = even ? F.bx * 64 + (F.wave < 2 ? 5 * F.wave : 10 + 9 * (F.wave - 2)) : F.bx * NWAVES + F.wave, tkn = even ? (F.wave < 2 ? 5 : 9) : (TT + F.G * NWAVES - 1) / (F.G * NWAVES), tks = even ? 1 : F.G * NWAVES;
    for (int ti = 0; ti < tkn; ++ti) { const int t = tk0 + ti * tks; if (t >= TT) break;
        const int b = t >> 11, s = t & 2047; const bf16_t* prow = proj + (size_t)t * NPROJ;
        float cs[8], sn[8];
        if (isrope) {
#pragma unroll
            for (int j = 0; j < 8; j += 2) { const f32x4 c2 = *(const f32x4*)(rope + (size_t)t * 32 + ri + j); cs[j] = c2.x; sn[j] = c2.y; cs[j + 1] = c2.z; sn[j + 1] = c2.w; } }
        else {
#pragma unroll
            for (int j = 0; j < 8; ++j) { cs[j] = 1.f; sn[j] = 0.f; } }
        u32x4 kr = (u32x4){0u, 0u, 0u, 0u};
        if (isrope) kr = *(const u32x4*)(prow + C_KR + (ch - 16) * 8);
        u32x4 wl[8];
        { const bf16_t* src0 = kvraw + ((size_t)(b * NH + grp) * SEQ + s) * 128 + (ch & 15) * 8;
#pragma unroll
          for (int i = 0; i < 8; ++i) wl[i] = (!act) ? (u32x4){0u, 0u, 0u, 0u} : (isrope ? kr : *(const u32x4*)(src0 + (size_t)i * 2 * SEQ * 128)); }
#pragma unroll
        for (int i = 0; i < 8; ++i) { const int h = 2 * i + grp; const u32x4 w = wl[i];
            float x[8], ss = 0.f;
#pragma unroll
            for (int q = 0; q < 4; ++q) { x[2 * q] = bflo(w[q]); x[2 * q + 1] = bfhi(w[q]); }
#pragma unroll
            for (int j = 0; j < 8; ++j) ss += x[j] * x[j];
            const float s0 = wave_sum(grp == 0 ? ss : 0.f), s1 = wave_sum(grp == 1 ? ss : 0.f);
            const float rn = 1.0f / sqrtf((grp == 0 ? s0 : s1) * (1.0f / DQK) + EPS);
            float y[8];
#pragma unroll
            for (int j = 0; j < 8; ++j) y[j] = x[j] * rn * g[j];
#pragma unroll
            for (int j = 0; j < 8; ++j) { const float partner = __shfl_xor(y[j], 4); y[j] = x2half ? (y[j] * cs[j] + partner * sn[j]) : (y[j] * cs[j] - partner * sn[j]); }
            if (act) { u32x4 o; o.x = pk2(y[0], y[1]); o.y = pk2(y[2], y[3]); o.z = pk2(y[4], y[5]); o.w = pk2(y[6], y[7]);
                *(u32x4*)(Kn + ((size_t)(b * NH + h) * SEQ + s) * DQK + ch * 8) = o; }
        }
    }
}

__device__ __forceinline__ void p3_scan(const Args& a, const Frame& F) {
    FRAME_IDS(F);
    const float* sch = (const float*)(F.ws + WS_SCH); bf16_t* apack = (bf16_t*)(F.ws + WS_APACK); const float2* A16 = (const float2*)(F.ws + WS_SMALL + SM_A16);
    const int p = F_lane;
    for (int it = F.wave * F.G + F.bx; it < NB * S5G; it += F.G * NWAVES) { const int b = it / S5G, g = it % S5G;
        const float2 am = A16[g * 64 + p]; float xr = 0.f, xi = 0.f;
        const size_t row0 = (size_t)g * NCHUNK + (size_t)b * 128;
        for (int c0 = 0; c0 < 128; c0 += 32) { float sr[32], si[32];
#pragma unroll
            for (int q = 0; q < 32; ++q) { sr[q] = sch[(row0 + c0 + q) * 128 + p]; si[q] = sch[(row0 + c0 + q) * 128 + 64 + p]; }
#pragma unroll
            for (int q = 0; q < 32; ++q) { bf16_t* o = apack + (row0 + c0 + q) * APK + 256; o[p] = (bf16_t)f2bf(xr); o[64 + p] = (bf16_t)f2bf(xi);
                const float nr = am.x * xr - am.y * xi + sr[q], ni = am.x * xi + am.y * xr + si[q]; xr = nr; xi = ni; } }
    }
}

__device__ __forceinline__ void s5_reference(const Args& a, const Frame& F) {
    FRAME_IDS(F);
    const bf16_t* apack = (const bf16_t*)(F.ws + WS_APACK); bf16_t* gact = (bf16_t*)(F.ws + WS_GACT);
    const int gw = F.bx * NWAVES + F.wave, NGW = F.G * NWAVES, p = F_lane;
    for (int it = gw; it < NB * S5G; it += NGW) { const int b = it / S5G, g = it % S5G;
        const float dt = expf(a.in[I_LOGDT][g]); const float lr = a.in[I_LRE][g * 64 + p], li = a.in[I_LIM][g * 64 + p];
        const float mag = expf(lr * dt); const float ar = mag * cosf(li * dt), ai = mag * sinf(li * dt); const float den = lr * lr + li * li;
        const float zr = ((ar - 1.0f) * lr + ai * li) / den, zi = (ai * lr - (ar - 1.0f) * li) / den;
        float bbr[16], bbi[16], cr[16], ci[16];
#pragma unroll
        for (int c = 0; c < 16; ++c) { const float br = a.in[I_BRE][((size_t)g * 64 + p) * 16 + c], bi = a.in[I_BIM][((size_t)g * 64 + p) * 16 + c];
            bbr[c] = zr * br - zi * bi; bbi[c] = zr * bi + zi * br; cr[c] = a.in[I_CRE][((size_t)g * 16 + c) * 64 + p]; ci[c] = a.in[I_CIM][((size_t)g * 16 + c) * 64 + p]; }
        const float dl = (p < 16) ? a.in[I_S5D][g * 16 + p] : 0.f;
        float xr = 0.f, xi = 0.f;
        for (int t = 0; t < SEQ; ++t) { const int tok = b * SEQ + t;
            const bf16_t* up = apack + ((size_t)g * NCHUNK + (tok >> 4)) * APK + (tok & 15) * 16;
            const u32x4 w0 = *(const u32x4*)up, w1 = *(const u32x4*)(up + 8); float u[16];
#pragma unroll
            for (int q = 0; q < 4; ++q) { u[2 * q] = bflo(w0[q]); u[2 * q + 1] = bfhi(w0[q]); u[8 + 2 * q] = bflo(w1[q]); u[8 + 2 * q + 1] = bfhi(w1[q]); }
            float br = 0.f, bi = 0.f;
#pragma unroll
            for (int c = 0; c < 16; ++c) { br += bbr[c] * u[c]; bi += bbi[c] * u[c]; }
            const float nr = ar * xr - ai * xi + br, ni = ar * xi + ai * xr + bi; xr = nr; xi = ni;
            float y = 0.f, um = 0.f;
#pragma unroll
            for (int c = 0; c < 16; ++c) { const float yc = wave_sum(cr[c] * xr - ci[c] * xi); if (p == c) { y = yc; um = u[c]; } }
            if (p < 16) gact[(size_t)tok * S5W + g * 16 + p] = (bf16_t)f2bf(gelu_tanh(y + dl * um));
        }
    }
}

__device__ __forceinline__ float attn_bound(const Args& a, int lane) {
    float mq = 0.f, mk = 0.f;
#pragma unroll
    for (int q = 0; q < 3; ++q) { mq = fmaxf(mq, fabsf(a.in[I_QKQG][lane + 64 * q])); mk = fmaxf(mk, fabsf(a.in[I_QKKG][lane + 64 * q])); }
#pragma unroll
    for (int o = 1; o < 64; o <<= 1) { mq = fmaxf(mq, __shfl_xor(mq, o)); mk = fmaxf(mk, __shfl_xor(mk, o)); }
    return mq * mk * 13.856406460551018f * 1.4426950408889634f;
}
__device__ __forceinline__ void attn_reference(const Args& a, const Frame& F) {
    FRAME_IDS(F);
    const bf16_t* Qn = (const bf16_t*)(F.ws + WS_QN); const bf16_t* Kn = (const bf16_t*)(F.ws + WS_KN); const bf16_t* Vn = (const bf16_t*)(F.ws + WS_VN);
    bf16_t* O = (bf16_t*)(F.ws + WS_O);
    LAS float* ql = (LAS float*)(F.lds + F.wave * 1024);
    const int lane = F_lane, gw = F.bx * NWAVES + F.wave, NGW = F.G * NWAVES;
    const float Mb = attn_bound(a, lane);
    for (int it = gw; it < NB * NH * SEQ; it += NGW) { const int s = it & 2047, bh = it >> 11, b = bh >> 4, h = bh & 15;
        const bf16_t* qp = Qn + ((size_t)bh * SEQ + s) * DQK;
#pragma unroll
        for (int q = 0; q < 3; ++q) ql[lane + 64 * q] = bf2f(qp[lane + 64 * q]);
        LDS_WAIT();
        const int nk = 64 * ((s >> 6) + 1);
        float o0 = 0.f, o1 = 0.f, l = 0.f;
        for (int k0 = 0; k0 < nk; k0 += 64) {
            const bf16_t* kp = Kn + ((size_t)bh * SEQ + k0 + lane) * DQK; float sc = 0.f;
            for (int d = 0; d < DQK; d += 8) { const u32x4 w = *(const u32x4*)(kp + d);
#pragma unroll
                for (int q = 0; q < 4; ++q) sc += bflo(w[q]) * ql[d + 2 * q] + bfhi(w[q]) * ql[d + 2 * q + 1]; }
            const float pr = __builtin_amdgcn_exp2f(sc - Mb); l += pr;
            for (int kk = 0; kk < 64; ++kk) { const float pk = __shfl(pr, kk); const unsigned w = *(const unsigned*)(Vn + ((size_t)bh * SEQ + k0 + kk) * DV + 2 * lane);
                o0 += pk * bflo(w); o1 += pk * bfhi(w); }
        }
        l = wave_sum(l); const float rl = 1.0f / l;
        *(unsigned*)(O + ((size_t)(b * SEQ + s)) * DM + h * DV + 2 * lane) = pk2(o0 * rl, o1 * rl);
        LDS_WAIT();
    }
}

namespace at {
constexpr int KVB = 64;
constexpr int SHM_V = KVB * DV * 2  , SHM_K = KVB * DQK * 2  ;
constexpr int NQR = 4;
constexpr int OFF_V = 0, OFF_K = 2 * SHM_V, OFF_WS = OFF_K + 2 * SHM_K  , OFF_QL = OFF_WS + NWAVES * 256  , OFF_OST = 0;
constexpr int OPITCH = 272;
static_assert(OFF_QL + NWAVES * (12 - NQR) * 1024 <= LDSCTL_OFF, "attention LDS map");
#define KSWZ(row, colB) ((row) * 384 + ((colB) ^ ((((row) >> 1) & 7) << 4)))
__device__ __forceinline__ int crow(int r, int hi) { return (r & 3) + 8 * (r >> 2) + 4 * hi; }
__device__ __forceinline__ int v_st(int k, int c) { const int kk = (k & ~0xC) | ((k & 4) << 1) | ((k & 8) >> 1); return ((kk >> 3) * 4 + (c >> 5)) * 512 + ((kk & 7) * 32 + (c & 31)) * 2; }
__device__ __forceinline__ int v_rd_base(int lane) { return ((lane & 3) << 3) | (((lane >> 2) & 3) << 6) | (((lane >> 4) & 1) << 5) | (((lane >> 5) & 1) << 8); }
constexpr int v_rd_off(int d0, int ks, int half) { return d0 * 512 + ks * 4096 + half * 2048; }
template <int OFF> __device__ __forceinline__ s16x4 tr_read(int vb) { s16x4 r; asm volatile("ds_read_b64_tr_b16 %0, %1 offset:%2" : "=&v"(r) : "v"(vb), "i"(OFF) : "memory"); return r; }
template <int D0> __device__ __forceinline__ void pv_one(f32x16& od, int vb, bf16x8 pa0, bf16x8 pa1, bf16x8 pa2, bf16x8 pa3) {
    const s16x4 l0 = tr_read<v_rd_off(D0, 0, 0)>(vb), h0 = tr_read<v_rd_off(D0, 0, 1)>(vb), l1 = tr_read<v_rd_off(D0, 1, 0)>(vb), h1 = tr_read<v_rd_off(D0, 1, 1)>(vb);
    const s16x4 l2 = tr_read<v_rd_off(D0, 2, 0)>(vb), h2 = tr_read<v_rd_off(D0, 2, 1)>(vb), l3 = tr_read<v_rd_off(D0, 3, 0)>(vb), h3 = tr_read<v_rd_off(D0, 3, 1)>(vb);
    asm volatile("s_waitcnt lgkmcnt(0)" ::: "memory"); SBAR();
#define PK(L, H) (bf16x8){L[0], L[1], L[2], L[3], H[0], H[1], H[2], H[3]}
    od = __builtin_amdgcn_mfma_f32_32x32x16_bf16(pa0, PK(l0, h0), od, 0, 0, 0);
    od = __builtin_amdgcn_mfma_f32_32x32x16_bf16(pa1, PK(l1, h1), od, 0, 0, 0);
    od = __builtin_amdgcn_mfma_f32_32x32x16_bf16(pa2, PK(l2, h2), od, 0, 0, 0);
    od = __builtin_amdgcn_mfma_f32_32x32x16_bf16(pa3, PK(l3, h3), od, 0, 0, 0);
#undef PK
}
__device__ __forceinline__ void pv_d0(f32x16* o, int vb, bf16x8 pa0, bf16x8 pa1, bf16x8 pa2, bf16x8 pa3) {
    pv_one<0>(o[0], vb, pa0, pa1, pa2, pa3); pv_one<1>(o[1], vb, pa0, pa1, pa2, pa3); pv_one<2>(o[2], vb, pa0, pa1, pa2, pa3); pv_one<3>(o[3], vb, pa0, pa1, pa2, pa3);
}
template <int BUF, int NQR> __device__ __forceinline__ void qkt(f32x16& p0, f32x16& p1, const int (&kb)[4], const bf16x8* qr, int qlb, float bias) {
#pragma unroll
    for (int r = 0; r < 16; ++r) { p0[r] = bias; p1[r] = bias; }
#pragma unroll
    for (int a = 0; a < 3; ++a)
#pragma unroll
        for (int b = 0; b < 4; ++b) { const int d0 = 4 * a + b;
            const bf16x8 b0 = *(const LAS bf16x8*)(kb[b] + BUF * SHM_K + a * 128);
            const bf16x8 b1 = *(const LAS bf16x8*)(kb[b] + BUF * SHM_K + a * 128 + 32 * 384);
            bf16x8 q; if (d0 < NQR) q = qr[d0]; else q = *(const LAS bf16x8*)(qlb + (d0 - NQR) * 1024);
            p0 = __builtin_amdgcn_mfma_f32_32x32x16_bf16(b0, q, p0, 0, 0, 0);
            p1 = __builtin_amdgcn_mfma_f32_32x32x16_bf16(b1, q, p1, 0, 0, 0); }
}
__device__ __forceinline__ void partialSM(f32x16& p0, f32x16& p1) {
#pragma unroll
    for (int r = 0; r < 16; ++r) p0[r] = __builtin_amdgcn_exp2f(p0[r]);
}
__device__ __forceinline__ void finishSM(f32x16& p0, f32x16& p1, float& l_reg, bf16x8& pa0, bf16x8& pa1, bf16x8& pa2, bf16x8& pa3) {
#pragma unroll
    for (int r = 0; r < 16; ++r) p1[r] = __builtin_amdgcn_exp2f(p1[r]);
    float ps = 0;
#pragma unroll
    for (int r = 0; r < 16; ++r) ps += p0[r];
#pragma unroll
    for (int r = 0; r < 16; ++r) ps += p1[r];
    { auto rr = __builtin_amdgcn_permlane32_swap(__float_as_uint(ps), __float_as_uint(ps), false, false); ps = __uint_as_float(rr[0]) + __uint_as_float(rr[1]); }
    l_reg += ps;
#define PK4(P, BASE, OUT) do { unsigned a0 = cvt_pk_bf16(P[BASE + 0], P[BASE + 1]), a1 = cvt_pk_bf16(P[BASE + 2], P[BASE + 3]);   \
    unsigned b0 = cvt_pk_bf16(P[BASE + 4], P[BASE + 5]), b1 = cvt_pk_bf16(P[BASE + 6], P[BASE + 7]);                              \
    auto r0 = __builtin_amdgcn_permlane32_swap(a0, b0, false, false); auto r1 = __builtin_amdgcn_permlane32_swap(a1, b1, false, false); \
    u32x4 w = {r0[0], r1[0], r0[1], r1[1]}; OUT = *reinterpret_cast<bf16x8*>(&w); } while (0)
    PK4(p0, 0, pa0); PK4(p0, 8, pa1); PK4(p1, 0, pa2); PK4(p1, 8, pa3);
#undef PK4
}
__device__ __forceinline__ void attn_qblock(const bf16_t* __restrict__ Qb, const bf16_t* __restrict__ Kh, const bf16_t* __restrict__ Vh, bf16_t* __restrict__ Ob, int qb, float Mb, LAS char* lds, const int wid,
                                            const float2* __restrict__ ropeb, const float* __restrict__ gq) {
    const int lane = fresh_lane(), tid = wid * 64 + lane, r32 = lane & 31, hi = lane >> 5;
    LAS char* V_lds = lds + OFF_V; LAS char* K_lds = lds + OFF_K;
    LAS float* li_l = (LAS float*)(lds + OFF_WS) + wid * 64;
    float l_reg = 0; f32x16 o[4] = {}; bf16x8 qr[NQR];
    const int qlb = (int)(uintptr_t)(lds + OFF_QL) + wid * ((12 - NQR) * 1024) + lane * 16;
    {
        const bf16_t* Qw = Qb + (size_t)(wid * 32 + r32) * (NH * DQK) + hi * 8;
        bf16x8 qf[12];
#pragma unroll
        for (int d0 = 0; d0 < 12; ++d0) qf[d0] = *(const bf16x8*)(Qw + d0 * 16);
        float ssq = 0.f;
#pragma unroll
        for (int d0 = 0; d0 < 12; ++d0)
#pragma unroll
            for (int j = 0; j < 8; ++j) { const float v = bf2f((unsigned short)qf[d0][j]); ssq += v * v; }
        ssq += __shfl_xor(ssq, 32);
        const float rn = QSCALE / sqrtf(ssq * (1.0f / DQK) + EPS);
        const float2* rp = ropeb + (size_t)(wid * 32 + r32) * 32 + hi * 8;
#pragma unroll
        for (int d0 = 0; d0 < 12; ++d0) { bf16x8 qn;
            if (d0 < 8) { const f32x4 g0 = *(const f32x4*)(gq + d0 * 16 + hi * 8), g1 = *(const f32x4*)(gq + d0 * 16 + hi * 8 + 4);
#pragma unroll
                for (int j = 0; j < 8; ++j) qn[j] = (short)f2bf(bf2f((unsigned short)qf[d0][j]) * rn * (j < 4 ? g0[j] : g1[j - 4])); }
            else { const int pp = (d0 - 8) & 1, da = 8 + pp, db = 10 + pp; const bool second = d0 >= 10;
#pragma unroll
                for (int j = 0; j < 8; ++j) { const float2 c = rp[pp * 16 + j];
                    const float y1 = bf2f((unsigned short)qf[da][j]) * rn * gq[128 + pp * 16 + hi * 8 + j], y2 = bf2f((unsigned short)qf[db][j]) * rn * gq[160 + pp * 16 + hi * 8 + j];
                    qn[j] = (short)f2bf(second ? (y2 * c.x + y1 * c.y) : (y1 * c.x - y2 * c.y)); } }
            if (d0 < NQR) qr[d0] = qn; else *(LAS bf16x8*)(qlb + (d0 - NQR) * 1024) = qn; }
    }
    const int sr = tid >> 4, sc = (tid & 15) * 8, vst0 = v_st(sr, sc), vst1 = v_st(32 + sr, sc);
    int kro[3], kst[3];
#pragma unroll
    for (int i = 0; i < 3; ++i) { const int q = tid + 512 * i, row = q / 24, c8 = q % 24; kro[i] = row * DQK + c8 * 8; kst[i] = KSWZ(row, c8 * 16); }
    const int vb0 = (int)(uintptr_t)V_lds + v_rd_base(lane);
    int kb[4];
#pragma unroll
    for (int b = 0; b < 4; ++b) kb[b] = (int)(uintptr_t)K_lds + r32 * 384 + ((b * 32 + hi * 16) ^ (((r32 >> 1) & 7) << 4));
    bf16x8 vs0, vs1, ks0, ks1, ks2;
#define SLOAD(k0) do { vs0 = *(const bf16x8*)(Vh + (size_t)((k0) + sr) * DV + sc); vs1 = *(const bf16x8*)(Vh + (size_t)((k0) + 32 + sr) * DV + sc); \
    ks0 = *(const bf16x8*)(Kh + (size_t)(k0) * DQK + kro[0]); ks1 = *(const bf16x8*)(Kh + (size_t)(k0) * DQK + kro[1]); ks2 = *(const bf16x8*)(Kh + (size_t)(k0) * DQK + kro[2]); } while (0)
#define SWRITE(b) do { *(LAS bf16x8*)(V_lds + (b) * SHM_V + vst0) = vs0; *(LAS bf16x8*)(V_lds + (b) * SHM_V + vst1) = vs1; \
    *(LAS bf16x8*)(K_lds + (b) * SHM_K + kst[0]) = ks0; *(LAS bf16x8*)(K_lds + (b) * SHM_K + kst[1]) = ks1; *(LAS bf16x8*)(K_lds + (b) * SHM_K + kst[2]) = ks2; } while (0)
    const int NT = 4 * qb + 4, jmax = 4 * qb + (wid >> 1);
    f32x16 pA0, pA1, pB0, pB1; bf16x8 pa0, pa1, pa2, pa3;
    SLOAD(0); asm volatile("s_waitcnt vmcnt(0)" ::: "memory"); SWRITE(0); __syncthreads();
    qkt<0, NQR>(pA0, pA1, kb, qr, qlb, -Mb); partialSM(pA0, pA1);
    SLOAD(KVB); asm volatile("s_waitcnt vmcnt(0)" ::: "memory"); SWRITE(1); __syncthreads();
    for (int j = 1; j + 1 < NT; j += 2) {
        SBAR(); if (j <= jmax) qkt<1, NQR>(pB0, pB1, kb, qr, qlb, -Mb);
        if (j - 1 <= jmax) finishSM(pA0, pA1, l_reg, pa0, pa1, pa2, pa3); SBAR();
        SLOAD((j + 1) * KVB); SBAR();
        if (j - 1 <= jmax) pv_d0(o, vb0, pa0, pa1, pa2, pa3); if (j <= jmax) partialSM(pB0, pB1);
        __syncthreads(); asm volatile("s_waitcnt vmcnt(0)" ::: "memory"); SWRITE(0);
        __syncthreads();
        SBAR(); if (j + 1 <= jmax) qkt<0, NQR>(pA0, pA1, kb, qr, qlb, -Mb);
        if (j <= jmax) finishSM(pB0, pB1, l_reg, pa0, pa1, pa2, pa3); SBAR();
        SLOAD((j + 2) * KVB); SBAR();
        if (j <= jmax) pv_d0(o, vb0 + SHM_V, pa0, pa1, pa2, pa3); if (j + 1 <= jmax) partialSM(pA0, pA1);
        __syncthreads(); asm volatile("s_waitcnt vmcnt(0)" ::: "memory"); SWRITE(1);
        __syncthreads();
    }
    SBAR(); if (NT - 1 <= jmax) qkt<1, NQR>(pB0, pB1, kb, qr, qlb, -Mb);
    if (NT - 2 <= jmax) { finishSM(pA0, pA1, l_reg, pa0, pa1, pa2, pa3); SBAR(); pv_d0(o, vb0, pa0, pa1, pa2, pa3); }
    if (NT - 1 <= jmax) { partialSM(pB0, pB1); finishSM(pB0, pB1, l_reg, pa0, pa1, pa2, pa3); SBAR(); pv_d0(o, vb0 + SHM_V, pa0, pa1, pa2, pa3); }
    __syncthreads();
    const int lane2 = fresh_lane(), r32b = lane2 & 31, hib = lane2 >> 5, wid2 = wid;
    LAS float* li2 = (LAS float*)(lds + OFF_WS) + wid2 * 64;
    if (hib == 0) li2[r32b] = l_reg; LDS_WAIT();
    LAS char* ost = lds + OFF_OST + wid2 * (32 * OPITCH) + hib * (4 * OPITCH) + r32b * 2;
#pragma unroll
    for (int r = 0; r < 16; ++r) { const int orc = (r & 3) + 8 * (r >> 2); const float rl = __builtin_amdgcn_rcpf(li2[orc + 4 * hib]);
#pragma unroll
        for (int d0 = 0; d0 < 4; ++d0) *(LAS bf16_t*)(ost + orc * OPITCH + d0 * 64) = (bf16_t)f2bf(o[d0][r] * rl); }
    LDS_WAIT();
    bf16_t* Ow = Ob + (size_t)(wid2 * 32 + (lane2 >> 4)) * DM + (lane2 & 15) * 8;
    const LAS char* ord = lds + OFF_OST + wid2 * (32 * OPITCH) + (lane2 >> 4) * OPITCH + (lane2 & 15) * 16;
#pragma unroll
    for (int i = 0; i < 8; ++i) { const u32x4 w = *(const LAS u32x4*)(ord + i * 4 * OPITCH); *(u32x4*)(Ow + (size_t)(i * 4) * DM) = w; }
    __syncthreads();
#undef SLOAD
#undef SWRITE
}
#undef KSWZ
}
__device__ __forceinline__ void p4_attention(const Args& a, const Frame& F) {
    FRAME_IDS(F);
    const bf16_t* qraw = (const bf16_t*)(F.ws + WS_QRAW); const bf16_t* Kn = (const bf16_t*)(F.ws + WS_KN); const bf16_t* Vn = (const bf16_t*)(F.ws + WS_VN);
    bf16_t* O = (bf16_t*)(F.ws + WS_O); const float2* rope = (const float2*)(F.ws + WS_ROPE);
    const float Mb = attn_bound(a, F_lane);
    for (int id = F.bx; id < NB * NH * 4; id += F.G) { const int x = id & 7, idx = id >> 3, bh = x + 8 * (idx >> 2), pr = idx & 3, b = bh >> 4, h = bh & 15;
        const bf16_t* Kh = Kn + (size_t)bh * SEQ * DQK; const bf16_t* Vh = Vn + (size_t)bh * SEQ * DV;
#pragma unroll 1
        for (int w = 0; w < 2; ++w) { const int qb = w ? pr : 7 - pr; const size_t tok0 = (size_t)b * SEQ + qb * 256;
            at::attn_qblock(qraw + tok0 * (NH * DQK) + h * DQK, Kh, Vh, O + tok0 * DM + h * DV, qb, Mb, (LAS char*)F.lds, F.wave, rope + tok0 * 32, a.in[I_QKQG]); }
    }
}

__device__ __forceinline__ void p8_norm2_router(const Args& a, const Frame& F, const float* x1) {
    FRAME_IDS(F);
    bf16_t* H2 = (bf16_t*)(F.ws + WS_H2); int* topi = (int*)(F.ws + WS_TOPI); float* topw = (float*)(F.ws + WS_TOPW);
    const float* wrp = (const float*)(F.ws + WS_SMALL + SM_WRP); const float* g2 = a.in[I_N2G];
    const int lane = F_lane, wave = F.wave, tid = F_tid, i = lane & 31, kk = lane >> 5;
    LAS uchar* xs = F.lds + wave * 8704;
    LAS float* part = (LAS float*)(F.lds + 69632);
    LAS float* ssqp = (LAS float*)(F.lds + 69632 + 33792);
    LAS float* logit = ssqp + 256;
    LAS float* rstdl = logit + 32 * 33;
    for (int tile = F.bx; tile < TT / 32; tile += F.G) {
        const int t0 = tile * 32;
        f32x16 acc = {}; float ssq = 0.f;
        for (int ch = 0; ch < 4; ++ch) { const int k0 = wave * 256 + ch * 64;
            f32x4 v[8];
#pragma unroll
            for (int j = 0; j < 8; ++j) v[j] = *(const f32x4*)(x1 + (size_t)(t0 + 4 * j + (lane >> 4)) * DM + k0 + (lane & 15) * 4);
#pragma unroll
            for (int j = 0; j < 8; ++j) *(LAS f32x4*)(xs + (4 * j + (lane >> 4)) * 272 + (lane & 15) * 16) = v[j];
            LDS_WAIT(); asm volatile("" ::: "memory");
            const float* wp = wrp + (size_t)(k0 + kk * 32) * NE + i;
#pragma unroll
            for (int s4 = 0; s4 < 8; ++s4) { const f32x4 xv = *(const LAS f32x4*)(xs + i * 272 + kk * 128 + s4 * 16);
#pragma unroll
                for (int q = 0; q < 4; ++q) { const float b = wp[(s4 * 4 + q) * NE]; acc = __builtin_amdgcn_mfma_f32_32x32x2f32(xv[q], b, acc, 0, 0, 0); ssq += xv[q] * xv[q]; } }
            LDS_WAIT(); asm volatile("" ::: "memory");
        }
#pragma unroll
        for (int r = 0; r < 16; ++r) part[(wave * 32 + (r & 3) + 8 * (r >> 2) + 4 * kk) * 33 + i] = acc[r];
        ssq += __shfl_xor(ssq, 32);
        if (kk == 0) ssqp[wave * 32 + i] = ssq;
        __syncthreads();
        { const int row = tid >> 4, e0 = (tid & 15) * 2; float s0 = 0.f, s1 = 0.f;
#pragma unroll
          for (int w = 0; w < 8; ++w) { s0 += part[(w * 32 + row) * 33 + e0]; s1 += part[(w * 32 + row) * 33 + e0 + 1]; }
          logit[row * 33 + e0] = s0; logit[row * 33 + e0 + 1] = s1;
          if (tid < 32) { float q = 0.f;
#pragma unroll
              for (int w = 0; w < 8; ++w) q += ssqp[w * 32 + tid];
              rstdl[tid] = 1.0f / sqrtf(q * (1.0f / DM) + EPS); } }
        __syncthreads();
        if (tid < 32) { const float rs = rstdl[tid]; float lg[32];
#pragma unroll
            for (int e = 0; e < 32; ++e) lg[e] = logit[tid * 33 + e] * rs + a.in[I_BR][e];
            int bi[4]; float bv[4];
#pragma unroll
            for (int k = 0; k < 4; ++k) { float m = -3.0e38f; int mi = 0;
#pragma unroll
                for (int e = 0; e < 32; ++e) { const bool used = (k > 0 && bi[0] == e) || (k > 1 && bi[1] == e) || (k > 2 && bi[2] == e); if (!used && lg[e] > m) { m = lg[e]; mi = e; } }
                bi[k] = mi; bv[k] = m; }
            const float e1 = __expf(bv[1] - bv[0]), e2 = __expf(bv[2] - bv[0]), e3 = __expf(bv[3] - bv[0]); const float rsum = 1.0f / (1.0f + e1 + e2 + e3);
            const int t = t0 + tid;
            *(int4*)(topi + 4 * t) = make_int4(bi[0], bi[1], bi[2], bi[3]); *(float4*)(topw + 4 * t) = make_float4(rsum, e1 * rsum, e2 * rsum, e3 * rsum); }
#pragma unroll 4
        for (int it = 0; it < 16; ++it) { const int idx = it * NTHREADS + tid, row = idx >> 8, c8 = (idx & 255) * 8; const float rs = rstdl[row];
            const f32x4 x0 = *(const f32x4*)(x1 + (size_t)(t0 + row) * DM + c8), x1v = *(const f32x4*)(x1 + (size_t)(t0 + row) * DM + c8 + 4);
            const f32x4 g0 = *(const f32x4*)(g2 + c8), g1 = *(const f32x4*)(g2 + c8 + 4);
#if MK_FP8_MOE
            const float rs4 = rs * FP8_ASCALE; u32x2 o; o.x = pk4_fp8(x0.x * rs4 * g0.x, x0.y * rs4 * g0.y, x0.z * rs4 * g0.z, x0.w * rs4 * g0.w); o.y = pk4_fp8(x1v.x * rs4 * g1.x, x1v.y * rs4 * g1.y, x1v.z * rs4 * g1.z, x1v.w * rs4 * g1.w);
            *(u32x2*)((uchar*)H2 + (size_t)(t0 + row) * DM + c8) = o; }
#else
            u32x4 o; o.x = pk2(x0.x * rs * g0.x, x0.y * rs * g0.y); o.y = pk2(x0.z * rs * g0.z, x0.w * rs * g0.w); o.z = pk2(x1v.x * rs * g1.x, x1v.y * rs * g1.y); o.w = pk2(x1v.z * rs * g1.z, x1v.w * rs * g1.w);
            *(u32x4*)(H2 + (size_t)(t0 + row) * DM + c8) = o; }
#endif
        __syncthreads();
    }
}

__device__ __forceinline__ void p9_routing(const Args& a, const Frame& F) {
    FRAME_IDS(F);
    const int* topi = (const int*)(F.ws + WS_TOPI); int* tpos = (int*)(F.ws + WS_TPOS); int* list = (int*)(F.ws + WS_LIST); int* counts = (int*)(F.ws + WS_SMALL + SM_COUNTS);
    LAS int* wtot = (LAS int*)F.lds;
    constexpr int NIT = TT / NWAVES / 64;
    for (int e = F.bx; e < NE; e += F.G) {
        __syncthreads();
        const int t0 = F.wave * (TT / NWAVES);
        int kk[NIT];
#pragma unroll
        for (int i = 0; i < NIT; ++i) { const int4 ti = *(const int4*)(topi + 4 * (t0 + i * 64 + F_lane)); kk[i] = (ti.x == e) ? 0 : (ti.y == e) ? 1 : (ti.z == e) ? 2 : (ti.w == e) ? 3 : -1; }
        int cnt = 0;
#pragma unroll
        for (int i = 0; i < NIT; ++i) cnt += __popcll(__ballot(kk[i] >= 0));
        if (F_lane == 0) wtot[F.wave] = cnt;
        __syncthreads();
        int base = 0, total = 0;
        for (int w = 0; w < NWAVES; ++w) { const int c = wtot[w]; if (w < F.wave) base += c; total += c; }
#pragma unroll
        for (int i = 0; i < NIT; ++i) { const int t = t0 + i * 64 + F_lane; const int k = kk[i];
            const unsigned long long bal = __ballot(k >= 0); const int pos = base + __popcll(bal & ((1ull << F_lane) - 1ull));
            if (k >= 0) { list[(size_t)e * TT + pos] = t; tpos[4 * t + k] = pos; }
            base += __popcll(bal); }
        for (int q = total + F_tid; q < ((total + 255) & ~255); q += NTHREADS) list[(size_t)e * TT + q] = 0;
        if (F_tid == 0) counts[e] = total;
    }
}
__device__ __forceinline__ void moe_tables(const Frame& F, LAS int* tab) {
    FRAME_IDS(F);
    const int* counts = (const int*)(F.ws + WS_SMALL + SM_COUNTS);
    __syncthreads();
    if (F_tid < NE) { const int c = counts[F_tid]; tab[F_tid] = c; const int nt = (c + 255) >> 8; tab[32 + F_tid] = nt; tab[128 + F_tid] = nt > 0 ? ((1 << 20) + nt - 1) / nt : 0; }
    __syncthreads();
    if (F_tid < NE) { const int e = F_tid, me = tab[32 + e]; int pre = 0, rank = 0;
        for (int q = 0; q < NE; ++q) { const int v = tab[32 + q]; pre += (q < e) ? v : 0; rank += (v > me || (v == me && q < e)) ? 1 : 0; }
        tab[64 + e] = pre; if (e == NE - 1) tab[96] = pre + me;
        const int q4 = rank >> 3, pos = rank & 7, xx = (q4 & 1) ? 7 - pos : pos; tab[160 + xx * 4 + q4] = e; }
    __syncthreads();
}

__device__ __forceinline__ void p10_permute(const Args& a, const Frame& F, const LAS int* tab) {
    FRAME_IDS(F);
    constexpr size_t ROWB = MK_FP8_MOE ? DM : 2 * DM;
    const uchar* H2 = F.ws + WS_H2; uchar* XP = F.ws + WS_XPERM; const int* list = (const int*)(F.ws + WS_LIST);
    const int ntiles = tab[96];
    for (int tile = F.bx; tile < ntiles; tile += F.G) {
        int e = 0;
#pragma unroll 1
        for (int q = 1; q < NE; ++q) if (tab[64 + q] <= tile) e = q;
        const int p0 = (tile - tab[64 + e]) * 256;
        for (int r0 = F.wave * 32; r0 < F.wave * 32 + 32; r0 += 8) { int tok[8]; u32x4 v[8][ROWB / 1024];
#pragma unroll
            for (int q = 0; q < 8; ++q) tok[q] = list[(size_t)e * TT + p0 + r0 + q];
#pragma unroll
            for (int q = 0; q < 8; ++q)
#pragma unroll
                for (int c = 0; c < (int)(ROWB / 1024); ++c) v[q][c] = *(const u32x4*)(H2 + (size_t)tok[q] * ROWB + c * 1024 + F_lane * 16);
#pragma unroll
            for (int q = 0; q < 8; ++q)
#pragma unroll
                for (int c = 0; c < (int)(ROWB / 1024); ++c) *(u32x4*)(XP + ((size_t)tile * 256 + r0 + q) * ROWB + c * 1024 + F_lane * 16) = v[q][c]; }
    }
}

__device__ __forceinline__ void p12_combine(const Args& a, const Frame& F, float* out, const LAS int* tab) {
    FRAME_IDS(F);
    const int* topi = (const int*)(F.ws + WS_TOPI); const float* topw = (const float*)(F.ws + WS_TOPW); const int* tpos = (const int*)(F.ws + WS_TPOS);
    const int lane = F_lane, gw = F.bx * NWAVES + F.wave, NGW = F.G * NWAVES;
#if MK_FP8_MOE
    const uchar* ys = F.ws + WS_YSLOT;
    for (int t = gw; t < TT; t += NGW) {
        const int4 ti = *(const int4*)(topi + 4 * t), tp = *(const int4*)(tpos + 4 * t); float4 tw = *(const float4*)(topw + 4 * t);
        tw.x *= 1.0f / FP8_YSCALE; tw.y *= 1.0f / FP8_YSCALE; tw.z *= 1.0f / FP8_YSCALE; tw.w *= 1.0f / FP8_YSCALE;
        const uchar* r0 = ys + ((size_t)tab[64 + ti.x] * 256 + tp.x) * DM; const uchar* r1 = ys + ((size_t)tab[64 + ti.y] * 256 + tp.y) * DM;
        const uchar* r2 = ys + ((size_t)tab[64 + ti.z] * 256 + tp.z) * DM; const uchar* r3 = ys + ((size_t)tab[64 + ti.w] * 256 + tp.w) * DM;
        float* orow = out + (size_t)t * DM;
        u32x2 y0[4], y1[4], y2[4], y3[4]; f32x4 xa[4], xb[4];
#pragma unroll
        for (int j = 0; j < 4; ++j) { const int c = j * 512 + lane * 8; y0[j] = *(const u32x2*)(r0 + c); y1[j] = *(const u32x2*)(r1 + c); y2[j] = *(const u32x2*)(r2 + c); y3[j] = *(const u32x2*)(r3 + c);
            xa[j] = *(const f32x4*)(orow + c); xb[j] = *(const f32x4*)(orow + c + 4); }
#pragma unroll
        for (int j = 0; j < 4; ++j) { const int c = j * 512 + lane * 8; f32x4 x0 = xa[j], x1 = xb[j];
#define ACC4(X, Y, W) do { const f32x2 lo = __builtin_amdgcn_cvt_pk_f32_fp8((int)(Y), false), hi2 = __builtin_amdgcn_cvt_pk_f32_fp8((int)(Y), true); X[0] += (W) * lo.x; X[1] += (W) * lo.y; X[2] += (W) * hi2.x; X[3] += (W) * hi2.y; } while (0)
            ACC4(x0, y0[j].x, tw.x); ACC4(x1, y0[j].y, tw.x); ACC4(x0, y1[j].x, tw.y); ACC4(x1, y1[j].y, tw.y);
            ACC4(x0, y2[j].x, tw.z); ACC4(x1, y2[j].y, tw.z); ACC4(x0, y3[j].x, tw.w); ACC4(x1, y3[j].y, tw.w);
#undef ACC4
            *(f32x4*)(orow + c) = x0; *(f32x4*)(orow + c + 4) = x1; }
    }
#else
    const bf16_t* ys = (const bf16_t*)(F.ws + WS_YSLOT);
    for (int t = gw; t < TT; t += NGW) {
        const int4 ti = *(const int4*)(topi + 4 * t), tp = *(const int4*)(tpos + 4 * t); const float4 tw = *(const float4*)(topw + 4 * t);
        const bf16_t* r0 = ys + ((size_t)tab[64 + ti.x] * 256 + tp.x) * DM; const bf16_t* r1 = ys + ((size_t)tab[64 + ti.y] * 256 + tp.y) * DM;
        const bf16_t* r2 = ys + ((size_t)tab[64 + ti.z] * 256 + tp.z) * DM; const bf16_t* r3 = ys + ((size_t)tab[64 + ti.w] * 256 + tp.w) * DM;
        float* orow = out + (size_t)t * DM;
#pragma unroll
        for (int j = 0; j < 4; ++j) { const int c = j * 512 + lane * 8;
            const u32x4 a0 = *(const u32x4*)(r0 + c), a1 = *(const u32x4*)(r1 + c), a2 = *(const u32x4*)(r2 + c), a3 = *(const u32x4*)(r3 + c);
            f32x4 x0 = *(const f32x4*)(orow + c), x1 = *(const f32x4*)(orow + c + 4);
#pragma unroll
            for (int q = 0; q < 2; ++q) {
                x0[2 * q] += tw.x * bflo(a0[q]) + tw.y * bflo(a1[q]) + tw.z * bflo(a2[q]) + tw.w * bflo(a3[q]);
                x0[2 * q + 1] += tw.x * bfhi(a0[q]) + tw.y * bfhi(a1[q]) + tw.z * bfhi(a2[q]) + tw.w * bfhi(a3[q]);
                x1[2 * q] += tw.x * bflo(a0[2 + q]) + tw.y * bflo(a1[2 + q]) + tw.z * bflo(a2[2 + q]) + tw.w * bflo(a3[2 + q]);
                x1[2 * q + 1] += tw.x * bfhi(a0[2 + q]) + tw.y * bfhi(a1[2 + q]) + tw.z * bfhi(a2[2 + q]) + tw.w * bfhi(a3[2 + q]); }
            *(f32x4*)(orow + c) = x0; *(f32x4*)(orow + c + 4) = x1; }
    }
#endif
}

constexpr int NPHASE = 14;
__global__ void __launch_bounds__(NTHREADS, 2) mk_fwd(Args a) {
    extern __shared__ __attribute__((aligned(16))) uchar lds_raw[];
    Frame F; F.lds = (LAS uchar*)lds_raw; F.ws = a.ws; F.wave = __builtin_amdgcn_readfirstlane(threadIdx.x >> 6); F.G = gridDim.x; F.bx = blockIdx.x;
    FRAME_IDS(F);
    volatile LAS unsigned* MISC = (volatile LAS unsigned*)(F.lds + MISC_OFF);
    LAS int* tab = (LAS int*)(F.lds + LDSCTL_OFF + 512);
    for (int u = F_tid; u < (LDS_BYTES - LDSCTL_OFF) / 4; u += NTHREADS) ((LAS unsigned*)(F.lds + LDSCTL_OFF))[u] = 0u;
    __syncthreads();
    XcdBarrier bar; bar.bar = (unsigned*)(a.ws + WS_CTL) + CW_BAR; bar.x = 0; bar.st = nullptr; bar.wave = F.wave;
    const int lo = a.ph_lo, hi = a.ph_hi;
    if (hi - lo > 1) bar = xcd_barrier_post((unsigned*)(a.ws + WS_CTL) + CW_BAR, MISC + 8, F.wave);
#ifndef MK_PHASE_MASK
#define MK_PHASE_MASK 0xffff
#endif
#define IN(k) (((MK_PHASE_MASK >> (k)) & 1) && lo <= (k) && (k) < hi)
#ifdef MK_PROBE_LO
    volatile LAS unsigned long long* pr_t = (volatile LAS unsigned long long*)(F.lds + LDSCTL_OFF + 64);
#define PROBE_AT(k) do { if ((k) == MK_PROBE_LO && F.wave == 0 && fresh_lane() == 0) pr_t[0] = __builtin_amdgcn_s_memrealtime(); if ((k) == MK_PROBE_HI + 1 && F.wave == 0 && fresh_lane() == 0) pr_t[1] = __builtin_amdgcn_s_memrealtime(); } while (0)
#else
#define PROBE_AT(k) do { } while (0)
#endif
#define SEAM(k) do { if (IN(k) && IN((k) + 1)) xcd_barrier(bar); } while (0)
    LAS uchar* ring = F.lds;
    uchar* ws = a.ws;
    const int G = F.G, bx = F.bx;

    PROBE_AT(0);
    if (IN(0)) { p0_prologue(a, F); } SEAM(0); PROBE_AT(1);

    if (IN(1)) {
        gm::ProbDense P; P.init((const bf16_t*)(ws + WS_H), DM, (const bf16_t*)(ws + WS_WIN), DM, DM, TT, NPROJ, G, bx);
        EpiInProj E{(bf16_t*)(ws + WS_PROJ), (bf16_t*)(ws + WS_APACK), a.in[I_BG], (float*)(ws + WS_SSQP)};
        gm::gemm_phase<gm::ProbDense, EpiInProj, false>(ring, P, E, F.wave);
    } SEAM(1); PROBE_AT(2);

    if (IN(2)) {
        { gm::ProbDense P; P.init((const bf16_t*)(ws + WS_PROJ) + C_QLAT, NPROJ, (const bf16_t*)(ws + WS_WUQ), QLORA, QLORA, TT, NH * DQK, G, bx);
          EpiStoreScaled<0, 8, QLORA> E{(bf16_t*)(ws + WS_QRAW), NH * DQK, (const float*)(ws + WS_SSQP)}; gm::gemm_phase<gm::ProbDense, EpiStoreScaled<0, 8, QLORA>, false>(ring, P, E, F.wave); }
        { gm::ProbDense P; P.init((const bf16_t*)(ws + WS_PROJ) + C_KVLAT, NPROJ, (const bf16_t*)(ws + WS_WUKV), KVLORA, KVLORA, TT, NH * 256, G, bx);
          EpiKV E{(bf16_t*)(ws + WS_KVRAW), (bf16_t*)(ws + WS_VN), (const float*)(ws + WS_SSQP)}; gm::gemm_phase<gm::ProbDense, EpiKV, false>(ring, P, E, F.wave); }
#if MK_FAST_S5
        { ProbS5 P{(const bf16_t*)(ws + WS_APACK), (const bf16_t*)(ws + WS_WS5), APK, 256, 4, G, bx};
          EpiS5State E{(float*)(ws + WS_SCH)}; gm::gemm_phase<ProbS5, EpiS5State, false>(ring, P, E, F.wave); }
#endif
    } SEAM(2); PROBE_AT(3);

    if (IN(3)) {
#if MK_FAST_S5
        p3_scan(a, F);
#endif
        p3_prep(a, F);
    } SEAM(3); PROBE_AT(4);

    if (IN(4)) {
#if MK_FAST_S5
        { ProbS5 P{(const bf16_t*)(ws + WS_APACK), (const bf16_t*)(ws + WS_TWC), APK, APK, 6, G, bx};
          EpiS5Out E{(bf16_t*)(ws + WS_GACT)}; gm::gemm_phase<ProbS5, EpiS5Out, false>(ring, P, E, F.wave); }
#else
        s5_reference(a, F);
#endif
#if MK_FAST_ATTN
        p4_attention(a, F);
#else
        attn_reference(a, F);
#endif
    } SEAM(4); PROBE_AT(5);

    if (IN(5)) {
        { gm::ProbDense P; P.init((const bf16_t*)(ws + WS_GACT), S5W, (const bf16_t*)(ws + WS_WGLU), S5W, S5W, TT, S5W, G, bx);
          EpiSide<0> E{(bf16_t*)(ws + WS_Y2), S5W, (const bf16_t*)(ws + WS_GACT), S5W, nullptr, 0}; gm::gemm_phase<gm::ProbDense, EpiSide<0>, false>(ring, P, E, F.wave); }
        { gm::ProbDense P; P.init((const bf16_t*)(ws + WS_O), DM, (const bf16_t*)(ws + WS_WOMLA), DM, DM, TT, DM, G, bx);
          EpiSide<1> E{(bf16_t*)(ws + WS_MA), DM, (const bf16_t*)(ws + WS_PROJ) + C_GA, NPROJ, nullptr, 0}; gm::gemm_phase<gm::ProbDense, EpiSide<1>, false>(ring, P, E, F.wave); }
    } SEAM(5); PROBE_AT(6);

    if (IN(6)) {
        gm::ProbDense P; P.init((const bf16_t*)(ws + WS_Y2), S5W, (const bf16_t*)(ws + WS_WOS5), S5W, S5W, TT, DM, G, bx);
        EpiSide<2> E{(bf16_t*)(ws + WS_M), DM, (const bf16_t*)(ws + WS_PROJ) + C_GB, NPROJ, (const bf16_t*)(ws + WS_MA), DM}; gm::gemm_phase<gm::ProbDense, EpiSide<2>, false>(ring, P, E, F.wave);
    } SEAM(6); PROBE_AT(7);

    if (IN(7)) {
        gm::ProbDense P; P.init((const bf16_t*)(ws + WS_M), DM, (const bf16_t*)(ws + WS_WOUT), DM, DM, TT, DM, G, bx);
        EpiResidF32 E{a.in[I_X], a.out}; gm::gemm_phase<gm::ProbDense, EpiResidF32, false>(ring, P, E, F.wave);
    } SEAM(7); PROBE_AT(8);

    if (IN(8)) { p8_norm2_router(a, F, a.out); } SEAM(8); PROBE_AT(9);
    if (IN(9)) { p9_routing(a, F); } SEAM(9); PROBE_AT(10);

    if (IN(10) || IN(11) || IN(12) || IN(13)) moe_tables(F, tab);
    const int xl = bx & 7, rk = bx >> 3, nrk = (G - xl + 7) >> 3;
    if (IN(10)) { p10_permute(a, F, tab); } SEAM(10); PROBE_AT(11);
    if (IN(11)) {
        ProbMoE P{(const bf16_t*)(ws + WS_XPERM), (const bf16_t*)(ws + WS_W1), DM, DM, MK_FP8_MOE ? DM / 128 : DM / 64, 16, (size_t)4096 * DM, xl, rk, nrk}; P.load(tab);
        EpiSwiglu E{(bf16_t*)(ws + WS_HACT), a.in[I_BGATE], a.in[I_BUP], tab}; gm::gemm_phase<ProbMoE, EpiSwiglu, false, MK_FP8_MOE != 0>(ring, P, E, F.wave);
    } SEAM(11); PROBE_AT(12);
    if (IN(12)) {
        ProbMoE P{(const bf16_t*)(ws + WS_HACT), (const bf16_t*)(ws + WS_W2), DFF, DFF, MK_FP8_MOE ? DFF / 128 : DFF / 64, 8, (size_t)DM * DFF, xl, rk, nrk}; P.load(tab);
        EpiDown E{(bf16_t*)(ws + WS_YSLOT), a.in[I_BDOWN], tab}; gm::gemm_phase<ProbMoE, EpiDown, false, MK_FP8_MOE != 0>(ring, P, E, F.wave);
    } SEAM(12); PROBE_AT(13);
    if (IN(13)) { p12_combine(a, F, a.out, tab); }
    PROBE_AT(14);
#ifdef MK_PROBE_LO
    if (blockIdx.x == 0 && F.wave == 0 && fresh_lane() == 0) { const unsigned long long dt = (pr_t[1] - pr_t[0]) * MK_PROBE_X, te = __builtin_amdgcn_s_memrealtime();
        while (__builtin_amdgcn_s_memrealtime() - te < dt) __builtin_amdgcn_s_sleep(32); }
#endif
#undef IN
#undef SEAM
}

extern "C" void kernel_launch(void* const* d_in, const int* in_sizes, int n_in, void* d_out, int out_size, void* d_ws, size_t ws_size, hipStream_t stream) {
    static int grid = 0;
    if (grid == 0) {
        if (n_in != 32 || in_sizes[0] != TT * DM || out_size != TT * DM || ws_size < WS_END) {
            fprintf(stderr, "kernel_launch: shape mismatch: n_in %d in0 %d out %d ws %zu (need %zu); nothing launched\n", n_in, n_in > 0 ? in_sizes[0] : -1, out_size, ws_size, (size_t)WS_END); grid = -1; return; }
        int dev = 0, cus = 0, per_cu = 0;
        if (hipGetDevice(&dev) != hipSuccess || hipDeviceGetAttribute(&cus, hipDeviceAttributeMultiprocessorCount, dev) != hipSuccess) { fprintf(stderr, "kernel_launch: device query failed\n"); grid = -1; return; }
        if (hipFuncSetAttribute((const void*)mk_fwd, hipFuncAttributeMaxDynamicSharedMemorySize, LDS_BYTES) != hipSuccess) { fprintf(stderr, "kernel_launch: hipFuncSetAttribute failed\n"); grid = -1; return; }
        if (hipOccupancyMaxActiveBlocksPerMultiprocessor(&per_cu, (const void*)mk_fwd, NTHREADS, LDS_BYTES) != hipSuccess || per_cu < 1)
            fprintf(stderr, "kernel_launch: note: occupancy query reports %d workgroups per CU\n", per_cu);
        (void)hipGetLastError();
        grid = cus - (cus % 8);
        if (grid < 8) grid = 8;
    }
    if (grid < 0) return;
    if (hipMemsetAsync((char*)d_ws + WS_CTL, 0, CTL_ZERO_BYTES, stream) != hipSuccess) { fprintf(stderr, "kernel_launch: memset failed\n"); return; }
    Args a{};
    for (int i = 0; i < 32; ++i) a.in[i] = (const float*)d_in[i];
    a.out = (float*)d_out; a.ws = (uchar*)d_ws;
#if MK_ONE_LAUNCH
    a.ph_lo = 0; a.ph_hi = NPHASE;
    hipLaunchKernelGGL(mk_fwd, dim3(grid), dim3(NTHREADS), LDS_BYTES, stream, a);
#else
    for (int p = 0; p < NPHASE; ++p) { a.ph_lo = p; a.ph_hi = p + 1; hipLaunchKernelGGL(mk_fwd, dim3(grid), dim3(NTHREADS), LDS_BYTES, stream, a); }
#endif
    const hipError_t le = hipPeekAtLastError();
    if (le != hipSuccess) fprintf(stderr, "kernel_launch: launch failed: %s\n", hipGetErrorName(le));
}
```

```cpp
#include <hip/hip_runtime.h>
#include <cstdio>
#include <cstdint>

#ifndef MK_ONE_LAUNCH
#define MK_ONE_LAUNCH 1
#endif
#ifndef MK_FAST_GEMM
#define MK_FAST_GEMM 1
#endif
#ifndef MK_FAST_ATTN
#define MK_FAST_ATTN 1
#endif
#ifndef MK_FAST_S5
#define MK_FAST_S5 1
#endif

#ifndef MK_FP8_MOE
#define MK_FP8_MOE 1
#endif
#define LAS __attribute__((address_space(3)))
#define GAS __attribute__((address_space(1)))
typedef unsigned short bf16_t;
typedef short bf16x8 __attribute__((ext_vector_type(8)));
typedef short s16x4 __attribute__((ext_vector_type(4)));
typedef float f32x2 __attribute__((ext_vector_type(2)));
typedef float f32x4 __attribute__((ext_vector_type(4)));
typedef float f32x16 __attribute__((ext_vector_type(16)));
typedef unsigned u32x2 __attribute__((ext_vector_type(2)));
typedef unsigned u32x4 __attribute__((ext_vector_type(4)));
typedef unsigned char uchar;
typedef int v4i __attribute__((ext_vector_type(4)));
typedef int v8i __attribute__((ext_vector_type(8)));
constexpr float FP8_YSCALE = 16.0f;
constexpr float FP8_ASCALE = 4.0f, FP8_WSCALE = 64.0f;
__device__ __forceinline__ unsigned pk4_fp8(float a, float b, float c, float d) { int w = __builtin_amdgcn_cvt_pk_fp8_f32(a, b, 0, false); w = __builtin_amdgcn_cvt_pk_fp8_f32(c, d, w, true); return (unsigned)w; }

constexpr int NB = 8, SEQ = 2048, TT = NB * SEQ, DM = 2048;
constexpr int NH = 16, DNOPE = 128, DROPE = 64, DQK = 192, DV = 128, QLORA = 512, KVLORA = 256;
constexpr int S5W = 1024, S5G = 64, S5C = 16, S5P = 64, S5L = 16;
constexpr int NE = 32, TOPK = 4, DFF = 2048;
constexpr int IN_PROJ = QLORA + KVLORA + DROPE + S5W + 2 * DM;
constexpr int NPROJ = 6144;
constexpr int C_QLAT = 0, C_KVLAT = 512, C_U = 768, C_GA = 1792, C_GB = 3840, C_KR = 5888;
constexpr float EPS = 1e-6f;
constexpr int MAXSLOT_TILES = (TT * TOPK) / 256 + NE;
constexpr int MAXSLOTS = MAXSLOT_TILES * 256;
constexpr int NCHUNK = TT / S5L;
constexpr int APK = 384;

constexpr size_t MiB = 1u << 20;
constexpr size_t WS_CTL = 0, CTL_ZERO_BYTES = 1 * MiB;
constexpr size_t WS_WIN = 1 * MiB;
constexpr size_t WS_WUQ = WS_WIN + 24 * MiB;
constexpr size_t WS_WUKV = WS_WUQ + 3 * MiB;
constexpr size_t WS_WOMLA = WS_WUKV + 2 * MiB;
constexpr size_t WS_WGLU = WS_WOMLA + 8 * MiB;
constexpr size_t WS_WOS5 = WS_WGLU + 2 * MiB;
constexpr size_t WS_WOUT = WS_WOS5 + 4 * MiB;
constexpr size_t WS_TWC = WS_WOUT + 8 * MiB;
constexpr size_t WS_WS5 = WS_TWC + 12 * MiB;
constexpr size_t WS_ROPE = WS_WS5 + 8 * MiB;
constexpr size_t WS_SMALL = WS_ROPE + 4 * MiB;
constexpr size_t WS_W1 = WS_SMALL + 1 * MiB;
constexpr size_t WS_W2 = WS_W1 + 512 * MiB;
constexpr size_t WS_ACT = WS_W2 + 256 * MiB;
constexpr size_t WS_H = WS_ACT;
constexpr size_t WS_PROJ = WS_H + 64 * MiB;
constexpr size_t WS_APACK = WS_PROJ + 192 * MiB;
constexpr size_t WS_SCH = WS_APACK + 48 * MiB;
constexpr size_t WS_QRAW = WS_SCH + 32 * MiB;
constexpr size_t WS_KVRAW = WS_QRAW + 96 * MiB;
constexpr size_t WS_QN = WS_KVRAW + 128 * MiB;
constexpr size_t WS_KN = WS_QN + 96 * MiB;
constexpr size_t WS_VN = WS_KN + 96 * MiB;
constexpr size_t WS_O = WS_VN + 64 * MiB;
constexpr size_t WS_GACT = WS_O + 64 * MiB;
constexpr size_t WS_Y2 = WS_GACT + 32 * MiB;
constexpr size_t WS_MA = WS_Y2 + 32 * MiB;
constexpr size_t WS_M = WS_MA + 64 * MiB;
constexpr size_t WS_SSQP = WS_M + 64 * MiB;
constexpr size_t WS_ENDA = WS_SSQP + 1 * MiB;
constexpr size_t WS_H2 = WS_ACT;
constexpr size_t WS_HACT = WS_H2 + 64 * MiB;
constexpr size_t WS_YSLOT = WS_HACT + 288 * MiB;
constexpr size_t WS_TOPI = WS_YSLOT + 288 * MiB;
constexpr size_t WS_TOPW = WS_TOPI + 1 * MiB;
constexpr size_t WS_TPOS = WS_TOPW + 1 * MiB;
constexpr size_t WS_LIST = WS_TPOS + 1 * MiB;
constexpr size_t WS_XPERM = WS_ACT + 704 * MiB;
constexpr size_t WS_ENDB = WS_XPERM + 288 * MiB;
constexpr size_t WS_END = WS_ENDA > WS_ENDB ? WS_ENDA : WS_ENDB;
constexpr size_t SM_A16 = 0;
constexpr size_t SM_COUNTS = 64 * 1024;
constexpr size_t SM_WRP = 128 * 1024;
constexpr int CW_BAR = 4096;

constexpr int RING_BYTES = 131072;
constexpr int LDS_BYTES = 163840;
constexpr int LDSCTL_OFF = LDS_BYTES - 4096;
constexpr int MISC_OFF = LDSCTL_OFF;
constexpr int GTAB_OFF = LDSCTL_OFF + 2048;
constexpr int NWAVES = 8, NTHREADS = 512;

#define LDS_WAIT() asm volatile("s_waitcnt lgkmcnt(0)" ::: "memory")
#define VM_WAIT() asm volatile("s_waitcnt vmcnt(0)" ::: "memory")
#define SBAR() __builtin_amdgcn_sched_barrier(0)

__device__ __forceinline__ unsigned f2bf(float f) { unsigned u = __builtin_bit_cast(unsigned, f); return (u + 0x7fffu + ((u >> 16) & 1u)) >> 16; }
__device__ __forceinline__ unsigned pk2(float lo, float hi) { return f2bf(lo) | (f2bf(hi) << 16); }
__device__ __forceinline__ float bf2f(unsigned b) { return __builtin_bit_cast(float, b << 16); }
__device__ __forceinline__ float bflo(unsigned w) { return __builtin_bit_cast(float, w << 16); }
__device__ __forceinline__ float bfhi(unsigned w) { return __builtin_bit_cast(float, w & 0xffff0000u); }
__device__ __forceinline__ unsigned cvt_pk_bf16(float lo, float hi) { unsigned r; asm volatile("v_cvt_pk_bf16_f32 %0, %1, %2" : "=v"(r) : "v"(lo), "v"(hi)); return r; }
__device__ __forceinline__ float sigmoidf_(float x) { return __builtin_amdgcn_rcpf(1.0f + __builtin_amdgcn_exp2f(-1.4426950408889634f * x)); }
__device__ __forceinline__ f32x2 sig2_t(f32x2 t) { f32x2 d; d.x = __builtin_amdgcn_exp2f(t.x); d.y = __builtin_amdgcn_exp2f(t.y); d = d + 1.0f; f32x2 r; r.x = __builtin_amdgcn_rcpf(d.x); r.y = __builtin_amdgcn_rcpf(d.y); return r; }
__device__ __forceinline__ f32x2 gelu_tanh2(f32x2 x) { constexpr float C = -2.0f * 0.7978845608028654f * 1.4426950408889634f; const f32x2 p = (x * x) * (C * 0.044715f) + C; return x * sig2_t(x * p); }
__device__ __forceinline__ float gelu_tanh(float x) {
    const float u = 0.7978845608028654f * (x + 0.044715f * x * x * x);
    const float e = __builtin_amdgcn_exp2f(2.8853900817779268f * u);
    const float th = 1.0f - 2.0f * __builtin_amdgcn_rcpf(e + 1.0f);
    return 0.5f * x * (1.0f + th);
}
__device__ __forceinline__ int fresh_lane() { int z = 0; asm volatile("" : "+s"(z)); return (int)__builtin_amdgcn_mbcnt_hi(~0u, __builtin_amdgcn_mbcnt_lo(~0u, (unsigned)z)); }
__device__ __forceinline__ float wave_sum(float v) {
#pragma unroll
    for (int o = 1; o < 64; o <<= 1) v += __shfl_xor(v, o);
    return v;
}

#define XB_TMO      128
#define XB_XCNT(j)  (256  + 64 * (j))
#define XB_XSUB(j)  (1280 + 64 * (j))
#define XB_XGEN(j)  (2304 + 64 * (j))
#define XB_TOP      3328
#define XB_TOPGEN   3392
#define XCD_BAR_WORDS 3456
#define XB_SPIN_CAP (1u << 18)
__device__ __forceinline__ unsigned xb_ld(unsigned* p)              { return __hip_atomic_load(p, __ATOMIC_RELAXED, __HIP_MEMORY_SCOPE_AGENT); }
__device__ __forceinline__ unsigned xb_add(unsigned* p, unsigned v) { return __hip_atomic_fetch_add(p, v, __ATOMIC_RELAXED, __HIP_MEMORY_SCOPE_AGENT); }
__device__ __forceinline__ unsigned xb_xcc_id() { return (unsigned)__builtin_amdgcn_s_getreg((3 << 11) | 20) & 0xFu; }
#define XB_SPIN(cond, bar) do { unsigned _sp = 0; while (cond) { __builtin_amdgcn_s_sleep(1); \
    if ((++_sp & 255u) == 0u) { if (xb_ld(&(bar)[XB_TMO])) break; if (_sp > XB_SPIN_CAP) { atomicAdd(&(bar)[XB_TMO], 1u); break; } } } } while (0)
struct XcdBarrier { unsigned* bar; unsigned x; volatile LAS unsigned* st; int wave; };
__device__ __forceinline__ XcdBarrier xcd_barrier_post(unsigned* bar, volatile LAS unsigned* st, int wave) {
    XcdBarrier b; b.bar = bar; b.x = xb_xcc_id(); b.st = st; b.wave = wave;
    if (wave == 0 && fresh_lane() == 0) (void)xb_add(&bar[XB_XCNT(b.x)], 1u);
    return b;
}
__device__ __forceinline__ void xcd_barrier_complete(unsigned* bar, unsigned x, unsigned& nloc, unsigned& nx) {
    const unsigned G = gridDim.x * gridDim.y * gridDim.z;
    unsigned sum, cnt, mine, sp = 0u;
    for (;;) {
        sum = 0u; cnt = 0u; mine = 0u;
#pragma unroll
        for (unsigned j = 0; j < 16; ++j) { const unsigned c = xb_ld(&bar[XB_XCNT(j)]); sum += c; cnt += (c > 0u) ? 1u : 0u; mine = (j == x) ? c : mine; }
        if (sum == G) break;
        __builtin_amdgcn_s_sleep(1);
        if ((++sp & 255u) == 0u) { if (xb_ld(&bar[XB_TMO])) break; if (sp > XB_SPIN_CAP) { atomicAdd(&bar[XB_TMO], 1u); break; } }
    }
    nloc = mine > 0u ? mine : 1u; nx = cnt > 0u ? cnt : 1u;
}
__device__ __forceinline__ void xcd_barrier(const XcdBarrier& b) {
    asm volatile("s_waitcnt vmcnt(0)" ::: "memory");
    __syncthreads();
    if (b.wave == 0 && fresh_lane() == 0) {
        unsigned* bar = b.bar;
        __builtin_amdgcn_s_waitcnt(0);
        unsigned nloc = b.st[0], nx = b.st[1];
        if (nloc == 0u) { xcd_barrier_complete(bar, b.x, nloc, nx); b.st[0] = nloc; b.st[1] = nx; }
        const unsigned old = xb_add(&bar[XB_XSUB(b.x)], 1u);
        const unsigned gen = old / nloc;
        if (old + 1u == (gen + 1u) * nloc) {
            __builtin_amdgcn_fence(__ATOMIC_RELEASE, "agent");
            asm volatile("s_waitcnt vmcnt(0)" ::: "memory");
            const unsigned og = xb_add(&bar[XB_TOP], 1u);
            const unsigned tg = og / nx;
            if (og + 1u == (tg + 1u) * nx) xb_add(&bar[XB_TOPGEN], 1u);
            else XB_SPIN(xb_ld(&bar[XB_TOPGEN]) == tg, bar);
            __builtin_amdgcn_fence(__ATOMIC_ACQUIRE, "agent");
            xb_add(&bar[XB_XGEN(b.x)], 1u);
            asm volatile("s_waitcnt vmcnt(0)" ::: "memory");
        } else {
            XB_SPIN(xb_ld(&bar[XB_XGEN(b.x)]) == gen, bar);
            __builtin_amdgcn_fence(__ATOMIC_ACQUIRE, "agent");
            asm volatile("s_waitcnt vmcnt(0)" ::: "memory");
        }
    }
    __syncthreads();
}

namespace gm {
constexpr int BM = 256, BK = 64, HALF = 128, HTB = HALF * BK * 2, STAGE_BYTES = 8 * HTB, NXCD = 8, WGM = 8;
__host__ __device__ __forceinline__ int lds_byte(int r, int c) { const int st = (r >> 4) * 2 + (c >> 5), rr = r & 15, cc = c & 31, ob = rr * 64 + cc * 2; return st * 1024 + (ob ^ (((ob >> 9) & 1) << 5)); }
__host__ __device__ __forceinline__ void stage_rc(int b, int& R, int& C) { const int st = b / 1024, sb = b % 1024, swz = sb ^ (((sb >> 9) & 1) << 5); R = (st >> 1) * 16 + swz / 64; C = (st & 1) * 32 + (swz % 64) / 2; }
__host__ __device__ __forceinline__ int perm32(int rho) { const int n = rho >> 4, i = rho & 15; return 8 * (i >> 2) + 4 * n + (i & 3); }

struct Unit { int pm, pn, g, st; };


struct ProbDense {
    const bf16_t* A; const bf16_t* B; int lda, ldb, nt; int nM, nN, nwg, G, c; const int* list = nullptr; const LAS int* gtab = nullptr;
    __device__ unsigned list_off(const Unit&) const { return 0u; }
    __device__ void init(const bf16_t* A_, int lda_, const bf16_t* B_, int ldb_, int K, int M, int N, int G_, int c_) { A = A_; B = B_; lda = lda_; ldb = ldb_; nt = K / BK; nM = M / BM; nN = N / BM; nwg = nM * nN; G = G_; c = c_; }
    __device__ bool next(int i, Unit& u) const {
        const long L = (long)i * G + c; if (L >= nwg) return false;
        int wgid = (int)L; { const int q = nwg / NXCD, r = nwg % NXCD, xcd = wgid % NXCD, off = wgid / NXCD; wgid = (xcd < r ? xcd * (q + 1) : r * (q + 1) + (xcd - r) * q) + off; }
        const int nig = WGM * nN, gid = wgid / nig, fm = gid * WGM, gsz = (nM - fm) < WGM ? (nM - fm) : WGM;
        u.pm = fm + ((wgid % nig) % gsz); u.pn = (wgid % nig) / gsz; u.g = 0; u.st = 0; return true;
    }
    __device__ size_t a_off(const Unit& u) const { return (size_t)u.pm * BM * lda; }
    __device__ size_t b_off(const Unit& u) const { return (size_t)u.pn * BM * ldb; }
    __device__ unsigned a_row(const Unit&, int) const { return 0u; }
};

#if MK_FAST_GEMM
template <class Prob, class Epi, bool GATHER, bool FP8 = false>
__device__ __forceinline__ void gemm_phase(LAS uchar* lds, const Prob& S, const Epi& E, const int wid  ) {
    constexpr unsigned ESZ = FP8 ? 1u : 2u;
    const int lane = fresh_lane(), tid = wid * 64 + lane, wr = wid >> 2, wc = wid & 3, fr = lane & 15, fq = lane >> 4;
    const int nt = S.nt;
    int Ra[2], Ca[2]; unsigned vB;
    { int R, C; stage_rc(tid * 16, R, C); const int Rb = Epi::PERM ? ((R & ~31) + perm32(R & 31)) : R; Ra[0] = R; Ca[0] = C; Ra[1] = R + 64; Ca[1] = C;
      vB = (unsigned)(Rb * S.ldb) * ESZ + (unsigned)C * 2u; }
    const unsigned dB64 = 64u * (unsigned)S.ldb * ESZ, dA64 = 64u * (unsigned)S.lda * ESZ, dA128 = 2u * dA64;
    constexpr unsigned kstep = BK * 2;
    const unsigned hstepB = (unsigned)HALF * (unsigned)S.ldb * ESZ;
    const unsigned ldsw = (unsigned)wid * 1024u;
    const int aoff = lds_byte(wr * 64 + fr, fq * 8), boff = lds_byte(wc * 32 + fr, fq * 8);
    const __amdgpu_buffer_rsrc_t srdA = __builtin_amdgcn_make_buffer_rsrc((void*)S.A, 0, 0xFFFFFFFF, 0x00020000);
    const __amdgpu_buffer_rsrc_t srdB = __builtin_amdgcn_make_buffer_rsrc((void*)S.B, 0, 0xFFFFFFFF, 0x00020000);
#define G_SA(b, h) (((b) * 2 + (h)) * HTB)
#define G_SB(b, h) ((4 + (b) * 2 + (h)) * HTB)
#define G_STAGE(bufoff, srd, soff, voff) do { _Pragma("unroll") for (int _i = 0; _i < 2; ++_i) \
        __builtin_amdgcn_raw_ptr_buffer_load_lds(srd, (LAS void*)(lds + (bufoff) + ldsw + _i * 8192), 16, (int)(voff)[_i], (int)(soff), 0, 0); } while (0)
#define G_STAGE1(bufoff, srd, soff, v1, d64) do { _Pragma("unroll") for (int _i = 0; _i < 2; ++_i) \
        __builtin_amdgcn_raw_ptr_buffer_load_lds(srd, (LAS void*)(lds + (bufoff) + ldsw + _i * 8192), 16, (int)(v1), (int)((soff) + _i * (d64)), 0, 0); } while (0)
#define G_STAGE_A(bufoff, soff, half, arr0, arr1) do { if constexpr (GATHER) { if (half) G_STAGE(bufoff, srdA, soff, arr1); else G_STAGE(bufoff, srdA, soff, arr0); } \
        else G_STAGE1(bufoff, srdA, (soff) + (half) * dA128, vA, dA64); } while (0)
#define G_LDA(dst, b, h) do { _Pragma("unroll") for (int m = 0; m < 4; ++m) _Pragma("unroll") for (int k = 0; k < 2; ++k) dst[m][k] = *(const LAS bf16x8*)(lds + G_SA(b, h) + aoff + m * 2048 + k * 1024); } while (0)
#define G_LDB(dst, b, h) do { _Pragma("unroll") for (int n = 0; n < 2; ++n) _Pragma("unroll") for (int k = 0; k < 2; ++k) dst[n][k] = *(const LAS bf16x8*)(lds + G_SB(b, h) + boff + n * 2048 + k * 1024); } while (0)
#define G_CAT(x0, x1) __builtin_shufflevector(__builtin_bit_cast(v4i, x0), __builtin_bit_cast(v4i, x1), 0, 1, 2, 3, 4, 5, 6, 7)
#define G_MMA(ai, bj, At, Bt) do { __builtin_amdgcn_s_setprio(1); _Pragma("unroll") for (int m = 0; m < 4; ++m) _Pragma("unroll") for (int n = 0; n < 2; ++n) { \
        if constexpr (FP8) acc[ai][bj][m][n] = __builtin_amdgcn_mfma_scale_f32_16x16x128_f8f6f4(G_CAT(Bt[n][0], Bt[n][1]), G_CAT(At[m][0], At[m][1]), acc[ai][bj][m][n], 0, 0, 0, 0x7f7f7f7f, 0, 0x7f7f7f7f); \
        else { _Pragma("unroll") for (int k = 0; k < 2; ++k) acc[ai][bj][m][n] = __builtin_amdgcn_mfma_f32_16x16x32_bf16(Bt[n][k], At[m][k], acc[ai][bj][m][n], 0, 0, 0); } } \
        __builtin_amdgcn_s_setprio(0); } while (0)
#define G_WAIT_V(n) asm volatile("s_waitcnt vmcnt(" #n ")" ::: "memory")
#define G_WAIT_L(n) asm volatile("s_waitcnt lgkmcnt(" #n ")" ::: "memory")
#define G_BAR __builtin_amdgcn_s_barrier()
#define G_SCHED __builtin_amdgcn_sched_barrier(0)
#define G_UNI(x) ((unsigned)__builtin_amdgcn_readfirstlane((int)(x)))
    Unit cur, nxt; int ui = 0;
    if (!S.next(0, cur)) return;
    unsigned vA0[2], vA1[2];
    unsigned cA = 0u, cB = G_UNI(S.b_off(cur) * ESZ);
    __amdgpu_buffer_rsrc_t srdL = srdA;
    if constexpr (GATHER) srdL = __builtin_amdgcn_make_buffer_rsrc((void*)S.list, 0, 0xFFFFFFFF, 0x00020000);
#define G_IDX(u_) do { if (wid < 4) __builtin_amdgcn_raw_ptr_buffer_load_lds(srdL, (LAS void*)(S.gtab + wid * 64), 4, lane * 4, (int)G_UNI(S.list_off(u_) * 4u) + wid * 256, 0, 0); } while (0)
    const int gR = (int)(uintptr_t)S.gtab + Ra[0] * 4; const unsigned gC = (unsigned)Ca[0] * 2u;
#define G_ROWS(o0, o1) do { const LAS int* _g = (const LAS int*)gR; const unsigned _ls = (unsigned)S.lda * ESZ; \
        o0[0] = (unsigned)_g[0] * _ls + gC; o0[1] = (unsigned)_g[64] * _ls + gC; o1[0] = (unsigned)_g[128] * _ls + gC; o1[1] = (unsigned)_g[192] * _ls + gC; } while (0)
    if constexpr (GATHER) { G_IDX(cur); G_WAIT_V(0); G_BAR; G_ROWS(vA0, vA1); G_WAIT_L(0); G_BAR; }
    else { cA = G_UNI(S.a_off(cur) * ESZ);
#pragma unroll
        for (int i = 0; i < 2; ++i) { vA0[i] = 0u; vA1[i] = 0u; } }
    const unsigned vA = (unsigned)(Ra[0] * S.lda) * ESZ + (unsigned)Ca[0] * 2u;
    G_STAGE1(G_SB(0, 0), srdB, cB, vB, dB64); G_STAGE_A(G_SA(0, 0), cA, 0, vA0, vA1); G_STAGE1(G_SB(0, 1), srdB, cB + hstepB, vB, dB64); G_STAGE_A(G_SA(0, 1), cA, 1, vA0, vA1);
    if (wr == 1) G_BAR;
    G_WAIT_V(4); G_BAR;
    G_STAGE1(G_SB(1, 0), srdB, cB + kstep, vB, dB64); G_STAGE_A(G_SA(1, 0), cA + kstep, 0, vA0, vA1); G_STAGE1(G_SB(1, 1), srdB, cB + hstepB + kstep, vB, dB64);
    G_WAIT_V(6); G_BAR;
    f32x4 acc[2][2][4][2];
#pragma unroll
    for (int a = 0; a < 2; ++a)
#pragma unroll
        for (int b = 0; b < 2; ++b)
#pragma unroll
            for (int m = 0; m < 4; ++m)
#pragma unroll
                for (int n = 0; n < 2; ++n) acc[a][b][m][n] = (f32x4){0.f, 0.f, 0.f, 0.f};
    bf16x8 At[4][2], B0[2][2], B1[2][2];
    for (;;) {
        const bool has_next = S.next(ui + 1, nxt);
        unsigned nA = cA, nB = cB; unsigned x0[2] = {0u, 0u}, x1[2] = {0u, 0u};
        if (has_next) { nB = G_UNI(S.b_off(nxt) * ESZ);
            if constexpr (GATHER) G_IDX(nxt);
            else nA = G_UNI(S.a_off(nxt) * ESZ);
        }
#define G_TRIP(LAST) do { \
            const unsigned a1 = cA + (unsigned)(t + 1) * kstep; \
            const unsigned a2 = (LAST) ? nA : cA + (unsigned)(t + 2) * kstep, b2 = (LAST) ? nB : cB + (unsigned)(t + 2) * kstep; \
            const unsigned a3 = a2 + kstep, b3 = b2 + kstep; \
            unsigned w0[2], w1[2]; \
            _Pragma("unroll") for (int i = 0; i < 2; ++i) { w0[i] = vA0[i]; w1[i] = vA1[i]; } \
            if constexpr (GATHER) { if ((LAST) && has_next) { G_ROWS(w0, w1); _Pragma("unroll") for (int i = 0; i < 2; ++i) { x0[i] = w0[i]; x1[i] = w1[i]; } } } \
              G_LDB(B0, 0, 0); G_SCHED; G_LDA(At, 0, 0); G_STAGE_A(G_SA(1, 1), a1, 1, vA0, vA1); \
            G_WAIT_L(8); G_BAR; G_WAIT_L(0); G_MMA(0, 0, At, B0); G_BAR; G_SCHED; \
              G_LDB(B1, 0, 1); G_STAGE1(G_SB(0, 0), srdB, b2, vB, dB64); \
            G_BAR; G_WAIT_L(0); G_MMA(0, 1, At, B1); G_BAR; \
              G_LDA(At, 0, 1); G_STAGE_A(G_SA(0, 0), a2, 0, w0, w1); \
            G_BAR; G_WAIT_L(0); G_MMA(1, 0, At, B0); G_BAR; G_SCHED; \
              G_STAGE1(G_SB(0, 1), srdB, b2 + hstepB, vB, dB64); \
            G_WAIT_V(6); G_BAR; G_MMA(1, 1, At, B1); G_BAR; \
              G_LDB(B0, 1, 0); G_SCHED; G_LDA(At, 1, 0); G_STAGE_A(G_SA(0, 1), a2, 1, w0, w1); \
            G_WAIT_L(8); G_BAR; G_WAIT_L(0); G_MMA(0, 0, At, B0); G_BAR; G_SCHED; \
              G_LDB(B1, 1, 1); G_STAGE1(G_SB(1, 0), srdB, b3, vB, dB64); \
            G_BAR; G_WAIT_L(0); G_MMA(0, 1, At, B1); G_BAR; \
              G_LDA(At, 1, 1); G_STAGE_A(G_SA(1, 0), a3, 0, w0, w1); \
            G_BAR; G_WAIT_L(0); G_MMA(1, 0, At, B0); G_BAR; G_SCHED; \
              G_STAGE1(G_SB(1, 1), srdB, b3 + hstepB, vB, dB64); \
            G_WAIT_V(6); G_BAR; G_MMA(1, 1, At, B1); G_BAR; } while (0)
        for (int t = 0; t < nt; t += 2) { const bool last = (t == nt - 2); G_TRIP(last); }
        if (wr == 0) G_BAR;
        { const int lane2 = fresh_lane();
          E(acc, cur, wid >> 2, wid & 3, lane2 & 15, lane2 >> 4); }
        if (!has_next) break;
#pragma unroll
        for (int a = 0; a < 2; ++a)
#pragma unroll
            for (int b = 0; b < 2; ++b)
#pragma unroll
                for (int m = 0; m < 4; ++m)
#pragma unroll
                    for (int n = 0; n < 2; ++n) acc[a][b][m][n] = (f32x4){0.f, 0.f, 0.f, 0.f};
        cur = nxt; cA = nA; cB = nB; ++ui;
        if (wr == 1) G_BAR;
        if constexpr (GATHER) {
#pragma unroll
            for (int i = 0; i < 2; ++i) { vA0[i] = x0[i]; vA1[i] = x1[i]; } }
    }
    G_WAIT_V(0);
    G_BAR;
#undef G_SA
#undef G_SB
#undef G_STAGE
#undef G_STAGE1
#undef G_STAGE_A
#undef G_LDA
#undef G_LDB
#undef G_MMA
#undef G_CAT
#undef G_WAIT_V
#undef G_WAIT_L
#undef G_BAR
#undef G_SCHED
#undef G_UNI
#undef G_TRIP
#undef G_IDX
#undef G_ROWS
}
#else
template <class Prob, class Epi, bool GATHER, bool FP8 = false>
__device__ __forceinline__ void gemm_phase(LAS uchar* lds, const Prob& S, const Epi& E, const int wid) {
    const int lane = fresh_lane(), tid = wid * 64 + lane, wr = wid >> 2, wc = wid & 3, fr = lane & 15, fq = lane >> 4;
    LAS float* As = (LAS float*)lds; LAS float* Bs = As + 256 * 33;
    Unit u;
    for (int ui = 0; S.next(ui, u); ++ui) {
        float acc[2][2][4][2][4];
#pragma unroll
        for (int a = 0; a < 2; ++a)
#pragma unroll
            for (int b = 0; b < 2; ++b)
#pragma unroll
                for (int m = 0; m < 4; ++m)
#pragma unroll
                    for (int n = 0; n < 2; ++n)
#pragma unroll
                        for (int j = 0; j < 4; ++j) acc[a][b][m][n][j] = 0.f;
        const int lr = tid >> 1, lk = (tid & 1) * 16;
        const bf16_t* ap = GATHER ? (S.A + S.a_row(u, lr)) : (S.A + S.a_off(u) + (size_t)lr * S.lda);
        const bf16_t* bp = S.B + S.b_off(u) + (size_t)lr * S.ldb;
        for (int k0 = 0; k0 < S.nt * 64; k0 += 32) {
            __syncthreads();
            const u32x4 a0 = *(const u32x4*)(ap + k0 + lk), a1 = *(const u32x4*)(ap + k0 + lk + 8);
            const u32x4 b0 = *(const u32x4*)(bp + k0 + lk), b1 = *(const u32x4*)(bp + k0 + lk + 8);
#pragma unroll
            for (int q = 0; q < 4; ++q) {
                As[lr * 33 + lk + 2 * q] = bflo(a0[q]); As[lr * 33 + lk + 2 * q + 1] = bfhi(a0[q]);
                As[lr * 33 + lk + 8 + 2 * q] = bflo(a1[q]); As[lr * 33 + lk + 8 + 2 * q + 1] = bfhi(a1[q]);
                Bs[lr * 33 + lk + 2 * q] = bflo(b0[q]); Bs[lr * 33 + lk + 2 * q + 1] = bfhi(b0[q]);
                Bs[lr * 33 + lk + 8 + 2 * q] = bflo(b1[q]); Bs[lr * 33 + lk + 8 + 2 * q + 1] = bfhi(b1[q]);
            }
            __syncthreads();
            for (int kk = 0; kk < 32; ++kk) {
                float av[2][4], bv[2][2][4];
#pragma unroll
                for (int a = 0; a < 2; ++a)
#pragma unroll
                    for (int m = 0; m < 4; ++m) av[a][m] = As[(128 * a + 64 * wr + 16 * m + fr) * 33 + kk];
#pragma unroll
                for (int b = 0; b < 2; ++b)
#pragma unroll
                    for (int n = 0; n < 2; ++n)
#pragma unroll
                        for (int j = 0; j < 4; ++j) { const int c = 128 * b + 32 * wc + (Epi::PERM ? (8 * fq + 4 * n + j) : (16 * n + 4 * fq + j)); bv[b][n][j] = Bs[c * 33 + kk]; }
#pragma unroll
                for (int a = 0; a < 2; ++a)
#pragma unroll
                    for (int b = 0; b < 2; ++b)
#pragma unroll
                        for (int m = 0; m < 4; ++m)
#pragma unroll
                            for (int n = 0; n < 2; ++n)
#pragma unroll
                                for (int j = 0; j < 4; ++j) acc[a][b][m][n][j] += av[a][m] * bv[b][n][j];
            }
        }
        f32x4 accv[2][2][4][2];
#pragma unroll
        for (int a = 0; a < 2; ++a)
#pragma unroll
            for (int b = 0; b < 2; ++b)
#pragma unroll
                for (int m = 0; m < 4; ++m)
#pragma unroll
                    for (int n = 0; n < 2; ++n) accv[a][b][m][n] = (f32x4){acc[a][b][m][n][0], acc[a][b][m][n][1], acc[a][b][m][n][2], acc[a][b][m][n][3]};
        E(accv, u, wr, wc, fr, fq);
    }
    __syncthreads();
}
#endif
}

struct Args {
    const float* in[32];
    float* out; uchar* ws;
    int ph_lo, ph_hi;
};
struct Frame {
    LAS uchar* lds; uchar* ws; int wave, G, bx;
};
#define FRAME_IDS(F) const int F_lane = fresh_lane(), F_tid = (F).wave * 64 + F_lane
enum { I_X = 0, I_POS, I_N1G, I_WIN, I_BG, I_QNG, I_WUQ, I_KVNG, I_WUKV, I_QKQG, I_QKKG, I_WOMLA, I_LRE, I_LIM, I_LOGDT, I_BRE, I_BIM, I_CRE, I_CIM, I_S5D,
       I_WGLU, I_WOS5, I_WOUT, I_N2G, I_WR, I_BR, I_WG, I_BGATE, I_WU, I_BUP, I_WD, I_BDOWN };

struct ProbS5 {
    const bf16_t* A; const bf16_t* B; int lda, ldb, nt; int G, c; const int* list = nullptr; const LAS int* gtab = nullptr;
    __device__ unsigned list_off(const gm::Unit&) const { return 0u; }
    __device__ bool next(int i, gm::Unit& u) const { const int L = i * G + c; if (L >= S5G * 4) return false; u.g = L >> 2; u.pm = L & 3; u.pn = 0; u.st = 0; return true; }
    __device__ size_t a_off(const gm::Unit& u) const { return ((size_t)u.g * NCHUNK + (size_t)u.pm * 256) * APK; }
    __device__ size_t b_off(const gm::Unit& u) const { return (size_t)u.g * 256 * ldb; }
    __device__ unsigned a_row(const gm::Unit&, int) const { return 0u; }
};
struct ProbMoE {
    const bf16_t* A; const bf16_t* B; int lda, ldb, nt; int npn; size_t estride;
    int x, rk, nrk; int nte[4], rcp[4], pre[4], eid[4];
    const int* list = nullptr; const LAS int* gtab = nullptr;
    __device__ void load(const LAS int* tab) {
#pragma unroll
        for (int q = 0; q < 4; ++q) { const int e = __builtin_amdgcn_readfirstlane(tab[160 + x * 4 + q]); eid[q] = e; nte[q] = __builtin_amdgcn_readfirstlane(tab[32 + e]); rcp[q] = __builtin_amdgcn_readfirstlane(tab[128 + e]); pre[q] = __builtin_amdgcn_readfirstlane(tab[64 + e]); }
    }
    __device__ unsigned list_off(const gm::Unit&) const { return 0u; }
    __device__ bool next(int i, gm::Unit& u) const {
        int L = i * nrk + rk;
#pragma unroll
        for (int q = 0; q < 4; ++q) { const int nu = nte[q] * npn;
            if (L < nu) { u.g = eid[q]; u.pn = (L * rcp[q]) >> 20; u.pm = L - u.pn * nte[q]; u.st = pre[q] + u.pm; return true; } L -= nu; }
        return false;
    }
    __device__ size_t a_off(const gm::Unit& u) const { return ((size_t)u.st * 256) * lda; }
    __device__ size_t b_off(const gm::Unit& u) const { return (size_t)u.g * estride + (size_t)u.pn * 256 * ldb; }
    __device__ unsigned a_row(const gm::Unit&, int) const { return 0u; }
};

#define EPI_ROW(u_, ai, m) ((u_).pm * 256 + (ai) * 128 + wr * 64 + (m) * 16 + fr)
struct EpiStoreBf16 {
    static constexpr bool PERM = true;
    bf16_t* O; int ld;
    __device__ __forceinline__ void operator()(const f32x4 (&acc)[2][2][4][2], const gm::Unit& u, int wr, int wc, int fr, int fq) const {
#pragma unroll
        for (int ai = 0; ai < 2; ++ai)
#pragma unroll
            for (int m = 0; m < 4; ++m) { bf16_t* rowp = O + (size_t)EPI_ROW(u, ai, m) * ld + u.pn * 256 + wc * 32 + 8 * fq;
#pragma unroll
                for (int bj = 0; bj < 2; ++bj) { const f32x4 v0 = acc[ai][bj][m][0], v1 = acc[ai][bj][m][1];
                    u32x4 w; w.x = cvt_pk_bf16(v0[0], v0[1]); w.y = cvt_pk_bf16(v0[2], v0[3]); w.z = cvt_pk_bf16(v1[0], v1[1]); w.w = cvt_pk_bf16(v1[2], v1[3]);
                    *(u32x4*)(rowp + bj * 128) = w; } }
    }
};
template <int S0, int NS, int LEN> struct EpiStoreScaled {
    static constexpr bool PERM = true;
    bf16_t* O; int ld; const float* ssqp;
    __device__ __forceinline__ void operator()(const f32x4 (&acc)[2][2][4][2], const gm::Unit& u, int wr, int wc, int fr, int fq) const {
#pragma unroll
        for (int ai = 0; ai < 2; ++ai) { float rs[4];
#pragma unroll
            for (int m = 0; m < 4; ++m) { const float* sp = ssqp + (size_t)EPI_ROW(u, ai, m) * 12 + S0; float t = 0.f;
#pragma unroll
                for (int q = 0; q < NS; q += 4) { const f32x4 v = *(const f32x4*)(sp + q); t += (v[0] + v[1]) + (v[2] + v[3]); }
                rs[m] = 1.0f / sqrtf(t * (1.0f / LEN) + EPS); }
#pragma unroll
            for (int m = 0; m < 4; ++m) { bf16_t* rowp = O + (size_t)EPI_ROW(u, ai, m) * ld + u.pn * 256 + wc * 32 + 8 * fq;
#pragma unroll
                for (int bj = 0; bj < 2; ++bj) { const f32x4 v0 = acc[ai][bj][m][0] * rs[m], v1 = acc[ai][bj][m][1] * rs[m];
                    u32x4 w; w.x = cvt_pk_bf16(v0[0], v0[1]); w.y = cvt_pk_bf16(v0[2], v0[3]); w.z = cvt_pk_bf16(v1[0], v1[1]); w.w = cvt_pk_bf16(v1[2], v1[3]);
                    *(u32x4*)(rowp + bj * 128) = w; } } }
    }
};
struct EpiKV {
    static constexpr bool PERM = true;
    bf16_t* kraw; bf16_t* vn; const float* ssqp;
    __device__ __forceinline__ void operator()(const f32x4 (&acc)[2][2][4][2], const gm::Unit& u, int wr, int wc, int fr, int fq) const {
#pragma unroll
        for (int ai = 0; ai < 2; ++ai) { float rs[4];
#pragma unroll
            for (int m = 0; m < 4; ++m) { const f32x4 v = *(const f32x4*)(ssqp + (size_t)EPI_ROW(u, ai, m) * 12 + 8); rs[m] = 1.0f / sqrtf(((v[0] + v[1]) + (v[2] + v[3])) * (1.0f / KVLORA) + EPS); }
#pragma unroll
            for (int m = 0; m < 4; ++m) { const int t = EPI_ROW(u, ai, m); const size_t ro = ((size_t)((t >> 11) * NH + u.pn) * SEQ + (t & 2047)) * 128 + wc * 32 + 8 * fq;
#pragma unroll
                for (int bj = 0; bj < 2; ++bj) { const f32x4 v0 = acc[ai][bj][m][0] * rs[m], v1 = acc[ai][bj][m][1] * rs[m];
                    u32x4 w; w.x = cvt_pk_bf16(v0[0], v0[1]); w.y = cvt_pk_bf16(v0[2], v0[3]); w.z = cvt_pk_bf16(v1[0], v1[1]); w.w = cvt_pk_bf16(v1[2], v1[3]);
                    *(u32x4*)((bj ? vn : kraw) + ro) = w; } } }
    }
};
struct EpiInProj {
    static constexpr bool PERM = true;
    bf16_t* proj; bf16_t* apack; const float* bgates; float* ssqp;
    __device__ __forceinline__ void operator()(const f32x4 (&acc)[2][2][4][2], const gm::Unit& u, int wr, int wc, int fr, int fq) const {
        const int colt = u.pn * 256 + wc * 32 + 8 * fq;
        if (u.pn < 3) {
#pragma unroll
            for (int ai = 0; ai < 2; ++ai)
#pragma unroll
                for (int m = 0; m < 4; ++m) { float sq = 0.f;
#pragma unroll
                    for (int bj = 0; bj < 2; ++bj)
#pragma unroll
                        for (int n = 0; n < 2; ++n) { const f32x4 v = acc[ai][bj][m][n]; sq += (v[0] * v[0] + v[1] * v[1]) + (v[2] * v[2] + v[3] * v[3]); }
                    sq += __shfl_xor(sq, 16); sq += __shfl_xor(sq, 32);
                    if (fq == 0) ssqp[(size_t)EPI_ROW(u, ai, m) * 12 + u.pn * 4 + wc] = sq; } }
        const int kind = (u.pn >= 3 && u.pn < 7) ? 1 : ((u.pn >= 7 && u.pn < 23) ? 2 : 0);
#pragma unroll
        for (int bj = 0; bj < 2; ++bj) {
            const int col = colt + bj * 128;
            f32x4 b0 = (f32x4){0.f, 0.f, 0.f, 0.f}, b1 = b0;
            constexpr float NL2E = -1.4426950408889634f;
            if (kind == 2) { b0 = *(const f32x4*)(bgates + (col - C_GA)) * NL2E; b1 = *(const f32x4*)(bgates + (col - C_GA) + 4) * NL2E; }
#pragma unroll
            for (int ai = 0; ai < 2; ++ai)
#pragma unroll
                for (int m = 0; m < 4; ++m) {
                    const int row = EPI_ROW(u, ai, m);
                    f32x4 v0 = acc[ai][bj][m][0], v1 = acc[ai][bj][m][1];
                    if (kind == 2) {
#pragma unroll
                        for (int h = 0; h < 2; ++h) { const f32x2 s0 = sig2_t((f32x2){v0[2 * h], v0[2 * h + 1]} * NL2E + (f32x2){b0[2 * h], b0[2 * h + 1]}), s1 = sig2_t((f32x2){v1[2 * h], v1[2 * h + 1]} * NL2E + (f32x2){b1[2 * h], b1[2 * h + 1]});
                            v0[2 * h] = s0.x; v0[2 * h + 1] = s0.y; v1[2 * h] = s1.x; v1[2 * h + 1] = s1.y; }
                    }
                    u32x4 w; w.x = cvt_pk_bf16(v0[0], v0[1]); w.y = cvt_pk_bf16(v0[2], v0[3]); w.z = cvt_pk_bf16(v1[0], v1[1]); w.w = cvt_pk_bf16(v1[2], v1[3]);
                    if (kind == 1) { const int j = col - C_U, g = j >> 4, cc = j & 15;
                        *(u32x4*)(apack + ((size_t)g * NCHUNK + (row >> 4)) * APK + (row & 15) * 16 + cc) = w; }
                    else { *(u32x4*)(proj + (size_t)row * NPROJ + col) = w;
                    }
                }
        }
    }
};
struct EpiS5State {
    static constexpr bool PERM = false;
    float* sch;
    __device__ __forceinline__ void operator()(const f32x4 (&acc)[2][2][4][2], const gm::Unit& u, int wr, int wc, int fr, int fq) const {
#pragma unroll
        for (int ai = 0; ai < 2; ++ai)
#pragma unroll
            for (int m = 0; m < 4; ++m) { float* rowp = sch + ((size_t)u.g * NCHUNK + EPI_ROW(u, ai, m)) * 128 + wc * 32 + 4 * fq;
#pragma unroll
                for (int n = 0; n < 2; ++n) *(f32x4*)(rowp + n * 16) = acc[ai][0][m][n]; }
    }
};
struct EpiS5Out {
    static constexpr bool PERM = true;
    bf16_t* gact;
    __device__ __forceinline__ void operator()(const f32x4 (&acc)[2][2][4][2], const gm::Unit& u, int wr, int wc, int fr, int fq) const {
#pragma unroll
        for (int ai = 0; ai < 2; ++ai)
#pragma unroll
            for (int m = 0; m < 4; ++m) { const int r = EPI_ROW(u, ai, m);
#pragma unroll
                for (int bj = 0; bj < 2; ++bj) { const int n0 = bj * 128 + wc * 32 + 8 * fq, t = n0 >> 4, c0 = n0 & 15;
                    f32x4 v0 = acc[ai][bj][m][0], v1 = acc[ai][bj][m][1];
#pragma unroll
                    for (int h = 0; h < 2; ++h) { const f32x2 g0 = gelu_tanh2((f32x2){v0[2 * h], v0[2 * h + 1]}), g1 = gelu_tanh2((f32x2){v1[2 * h], v1[2 * h + 1]});
                        v0[2 * h] = g0.x; v0[2 * h + 1] = g0.y; v1[2 * h] = g1.x; v1[2 * h + 1] = g1.y; }
                    u32x4 w; w.x = cvt_pk_bf16(v0[0], v0[1]); w.y = cvt_pk_bf16(v0[2], v0[3]); w.z = cvt_pk_bf16(v1[0], v1[1]); w.w = cvt_pk_bf16(v1[2], v1[3]);
                    *(u32x4*)(gact + ((size_t)r * 16 + t) * S5W + u.g * 16 + c0) = w; } }
    }
};
template <int MODE> struct EpiSide {
    static constexpr bool PERM = true;
    bf16_t* O; int ldo; const bf16_t* s0; int ld0; const bf16_t* s1; int ld1;
    __device__ __forceinline__ void operator()(const f32x4 (&acc)[2][2][4][2], const gm::Unit& u, int wr, int wc, int fr, int fq) const {
        const int col0 = u.pn * 256 + wc * 32 + 8 * fq;
#pragma unroll
        for (int ai = 0; ai < 2; ++ai) {
            u32x4 sa[4][2], sb[4][2];
#pragma unroll
            for (int m = 0; m < 4; ++m)
#pragma unroll
                for (int bj = 0; bj < 2; ++bj) { const int row = EPI_ROW(u, ai, m);
                    sa[m][bj] = *(const u32x4*)(s0 + (size_t)row * ld0 + col0 + bj * 128);
                    if (MODE == 2) sb[m][bj] = *(const u32x4*)(s1 + (size_t)row * ld1 + col0 + bj * 128); else sb[m][bj] = (u32x4){0u, 0u, 0u, 0u}; }
#pragma unroll
            for (int m = 0; m < 4; ++m)
#pragma unroll
                for (int bj = 0; bj < 2; ++bj) { const int row = EPI_ROW(u, ai, m);
                    const f32x4 v0 = acc[ai][bj][m][0], v1 = acc[ai][bj][m][1]; const u32x4 a = sa[m][bj], b = sb[m][bj];
                    float r[8];
#pragma unroll
                    for (int q = 0; q < 4; ++q) { const float x0 = q < 2 ? v0[2 * q] : v1[2 * q - 4], x1 = q < 2 ? v0[2 * q + 1] : v1[2 * q - 3];
                        const float a0 = bflo(a[q]), a1 = bfhi(a[q]);
                        if (MODE == 0) { const f32x2 sg = sig2_t((f32x2){x0, x1} * -1.4426950408889634f) * (f32x2){a0, a1}; r[2 * q] = sg.x; r[2 * q + 1] = sg.y; }
                        else if (MODE == 1) { r[2 * q] = a0 * x0; r[2 * q + 1] = a1 * x1; }
                        else { r[2 * q] = bflo(b[q]) + a0 * x0; r[2 * q + 1] = bfhi(b[q]) + a1 * x1; } }
                    u32x4 w; w.x = cvt_pk_bf16(r[0], r[1]); w.y = cvt_pk_bf16(r[2], r[3]); w.z = cvt_pk_bf16(r[4], r[5]); w.w = cvt_pk_bf16(r[6], r[7]);
                    *(u32x4*)(O + (size_t)row * ldo + col0 + bj * 128) = w; }
        }
    }
};
struct EpiResidF32 {
    static constexpr bool PERM = false;
    const float* x; float* out;
    __device__ __forceinline__ void operator()(const f32x4 (&acc)[2][2][4][2], const gm::Unit& u, int wr, int wc, int fr, int fq) const {
#pragma unroll
        for (int ai = 0; ai < 2; ++ai)
#pragma unroll
            for (int mh = 0; mh < 2; ++mh) { f32x4 xv[2][2][2];
#pragma unroll
                for (int mm = 0; mm < 2; ++mm) { const size_t off = (size_t)EPI_ROW(u, ai, 2 * mh + mm) * DM + u.pn * 256 + wc * 32 + 4 * fq;
#pragma unroll
                    for (int bj = 0; bj < 2; ++bj)
#pragma unroll
                        for (int n = 0; n < 2; ++n) xv[mm][bj][n] = *(const f32x4*)(x + off + bj * 128 + n * 16); }
#pragma unroll
                for (int mm = 0; mm < 2; ++mm) { const size_t off = (size_t)EPI_ROW(u, ai, 2 * mh + mm) * DM + u.pn * 256 + wc * 32 + 4 * fq;
#pragma unroll
                    for (int bj = 0; bj < 2; ++bj)
#pragma unroll
                        for (int n = 0; n < 2; ++n) *(f32x4*)(out + off + bj * 128 + n * 16) = xv[mm][bj][n] + acc[ai][bj][2 * mh + mm][n]; } }
    }
};
#if MK_FP8_MOE
constexpr float MOE_DESCALE = 1.0f / (FP8_ASCALE * FP8_WSCALE);
#else
constexpr float MOE_DESCALE = 1.0f;
#endif
struct EpiSwiglu {
    static constexpr bool PERM = true;
    static constexpr float EPS_AS = MK_FP8_MOE ? FP8_ASCALE : 1.0f;
    bf16_t* hact; const float* bgate; const float* bup; const LAS int* tab;
    __device__ __forceinline__ void operator()(const f32x4 (&acc)[2][2][4][2], const gm::Unit& u, int wr, int wc, int fr, int fq) const {
        const int hc = u.pn * 128 + wc * 32 + 8 * fq;
        const unsigned slot0 = (unsigned)u.st * 256u + wr * 64 + fr;
        unsigned w0[2][4];
#pragma unroll
        for (int n = 0; n < 2; ++n) {
            const f32x4 g0 = *(const f32x4*)(bgate + (unsigned)(u.g * DFF + hc + 4 * n)), u0 = *(const f32x4*)(bup + (unsigned)(u.g * DFF + hc + 4 * n));
            const f32x2 gbv[2] = {{g0.x, g0.y}, {g0.z, g0.w}}, ubv[2] = {{u0.x * EPS_AS + EPS_AS, u0.y * EPS_AS + EPS_AS}, {u0.z * EPS_AS + EPS_AS, u0.w * EPS_AS + EPS_AS}};
#pragma unroll
            for (int ai = 0; ai < 2; ++ai)
#pragma unroll
                for (int m = 0; m < 4; ++m) { const unsigned slot = slot0 + ai * 128 + m * 16;
                    float r[4];
#pragma unroll
                    for (int h = 0; h < 2; ++h) { const f32x2 ag = {acc[ai][0][m][n][2 * h], acc[ai][0][m][n][2 * h + 1]}, au = {acc[ai][1][m][n][2 * h], acc[ai][1][m][n][2 * h + 1]};
                        f32x2 gt = ag * MOE_DESCALE + gbv[h], up = au * (MOE_DESCALE * EPS_AS) + ubv[h];
                        gt.x = fminf(gt.x, 7.0f); gt.y = fminf(gt.y, 7.0f);
                        up.x = __builtin_amdgcn_fmed3f(up.x, -6.0f * EPS_AS, 8.0f * EPS_AS); up.y = __builtin_amdgcn_fmed3f(up.y, -6.0f * EPS_AS, 8.0f * EPS_AS);
                        const f32x2 t = gt * (-1.702f * 1.4426950408889634f); f32x2 d; d.x = __builtin_amdgcn_exp2f(t.x); d.y = __builtin_amdgcn_exp2f(t.y); d = d + 1.0f;
                        f32x2 sg; sg.x = __builtin_amdgcn_rcpf(d.x); sg.y = __builtin_amdgcn_rcpf(d.y);
                        const f32x2 o = up * (gt * sg); r[2 * h] = o.x; r[2 * h + 1] = o.y; }
#if MK_FP8_MOE
                    const unsigned pk = pk4_fp8(r[0], r[1], r[2], r[3]);
                    if (n == 0) w0[ai][m] = pk; else { u32x2 w; w.x = w0[ai][m]; w.y = pk; *(u32x2*)((uchar*)hact + slot * DFF + hc) = w; }
#else
                    u32x2 w; w.x = cvt_pk_bf16(r[0], r[1]); w.y = cvt_pk_bf16(r[2], r[3]); *(u32x2*)(hact + slot * DFF + hc + 4 * n) = w;
#endif
                }
        }
    }
};
struct EpiDown {
    static constexpr bool PERM = true;
    bf16_t* ys; const float* bdown; const LAS int* tab;
    __device__ __forceinline__ void operator()(const f32x4 (&acc)[2][2][4][2], const gm::Unit& u, int wr, int wc, int fr, int fq) const {
        const size_t slot0 = (size_t)u.st * 256;
#pragma unroll
        for (int bj = 0; bj < 2; ++bj) { const int col = u.pn * 256 + bj * 128 + wc * 32 + 8 * fq;
            const float* bd = bdown + (size_t)u.g * DM + col; const f32x4 d0 = *(const f32x4*)bd, d1 = *(const f32x4*)(bd + 4);
#pragma unroll
            for (int ai = 0; ai < 2; ++ai)
#pragma unroll
                for (int m = 0; m < 4; ++m) { const size_t slot = slot0 + ai * 128 + wr * 64 + m * 16 + fr;
                    const f32x4 v0 = acc[ai][bj][m][0] * MOE_DESCALE + d0, v1 = acc[ai][bj][m][1] * MOE_DESCALE + d1;
#if MK_FP8_MOE
                    u32x2 w; w.x = pk4_fp8(v0[0] * FP8_YSCALE, v0[1] * FP8_YSCALE, v0[2] * FP8_YSCALE, v0[3] * FP8_YSCALE); w.y = pk4_fp8(v1[0] * FP8_YSCALE, v1[1] * FP8_YSCALE, v1[2] * FP8_YSCALE, v1[3] * FP8_YSCALE);
                    *(u32x2*)((uchar*)ys + slot * DM + col) = w; } }
#else
                    u32x4 w; w.x = cvt_pk_bf16(v0[0], v0[1]); w.y = cvt_pk_bf16(v0[2], v0[3]); w.z = cvt_pk_bf16(v1[0], v1[1]); w.w = cvt_pk_bf16(v1[2], v1[3]);
                    *(u32x4*)(ys + slot * DM + col) = w; } }
#endif
    }
};

template <bool FP8OUT>
__device__ __forceinline__ void transpose_item(const float* W, int ldw, int src_col0, int k0, const float* kscale, void* WT, int ldt, int dst_row0, float oscale, LAS float* scr, int lane) {
    if (src_col0 >= 0) {
        f32x4 v[16]; const float* wp = W + (size_t)(k0 + (lane >> 4)) * ldw + src_col0 + (lane & 15) * 4;
#pragma unroll
        for (int i = 0; i < 16; ++i) v[i] = __builtin_nontemporal_load((const f32x4*)(wp + (size_t)(4 * i) * ldw));
#pragma unroll
        for (int i = 0; i < 16; ++i) { const int kk = 4 * i + (lane >> 4); const float sc = kscale ? kscale[k0 + kk] * oscale : oscale; LAS float* d = scr + kk * 65 + (lane & 15) * 4;
            d[0] = v[i].x * sc; d[1] = v[i].y * sc; d[2] = v[i].z * sc; d[3] = v[i].w * sc; }
    } else {
#pragma unroll
        for (int i = 0; i < 16; ++i) { LAS float* d = scr + (4 * i + (lane >> 4)) * 65 + (lane & 15) * 4; d[0] = 0.f; d[1] = 0.f; d[2] = 0.f; d[3] = 0.f; }
    }
    LDS_WAIT(); asm volatile("" ::: "memory");
    if constexpr (FP8OUT) { const int c = lane & 3;
#pragma unroll
        for (int j = 0; j < 4; ++j) { const int n = (lane >> 2) + 16 * j; const LAS float* s = scr + (16 * c) * 65 + n; u32x4 o;
            o.x = pk4_fp8(s[0 * 65], s[1 * 65], s[2 * 65], s[3 * 65]); o.y = pk4_fp8(s[4 * 65], s[5 * 65], s[6 * 65], s[7 * 65]);
            o.z = pk4_fp8(s[8 * 65], s[9 * 65], s[10 * 65], s[11 * 65]); o.w = pk4_fp8(s[12 * 65], s[13 * 65], s[14 * 65], s[15 * 65]);
            *(u32x4*)((uchar*)WT + (size_t)(dst_row0 + n) * ldt + k0 + 16 * c) = o; }
    } else { const int c = lane & 7;
#pragma unroll
        for (int j = 0; j < 8; ++j) { const int n = (lane >> 3) + 8 * j; const LAS float* s = scr + (8 * c) * 65 + n;
            u32x4 o; o.x = pk2(s[0 * 65], s[1 * 65]); o.y = pk2(s[2 * 65], s[3 * 65]); o.z = pk2(s[4 * 65], s[5 * 65]); o.w = pk2(s[6 * 65], s[7 * 65]);
            *(u32x4*)((bf16_t*)WT + (size_t)(dst_row0 + n) * ldt + k0 + 8 * c) = o; }
    }
    LDS_WAIT(); asm volatile("" ::: "memory");
}
struct TItem { const float* src; uchar* dst; };
__device__ __forceinline__ void ti_load(const TItem& t, f32x4 (&v)[16], int lane) {
    const float* wp = t.src + (size_t)(lane >> 4) * DM + (lane & 15) * 4;
#pragma unroll
    for (int i = 0; i < 16; ++i) v[i] = __builtin_nontemporal_load((const f32x4*)(wp + (size_t)(4 * i) * DM));
}
template <bool FP8OUT>
__device__ __forceinline__ void ti_store(const TItem& t, const f32x4 (&v)[16], float oscale, LAS float* scr, int lane) {
#pragma unroll
    for (int i = 0; i < 16; ++i) { LAS float* d = scr + (4 * i + (lane >> 4)) * 65 + (lane & 15) * 4; d[0] = v[i].x * oscale; d[1] = v[i].y * oscale; d[2] = v[i].z * oscale; d[3] = v[i].w * oscale; }
    LDS_WAIT(); asm volatile("" ::: "memory");
    if constexpr (FP8OUT) { const int c = lane & 3;
#pragma unroll
        for (int j = 0; j < 4; ++j) { const int n = (lane >> 2) + 16 * j; const LAS float* s = scr + (16 * c) * 65 + n; u32x4 o;
            o.x = pk4_fp8(s[0 * 65], s[1 * 65], s[2 * 65], s[3 * 65]); o.y = pk4_fp8(s[4 * 65], s[5 * 65], s[6 * 65], s[7 * 65]);
            o.z = pk4_fp8(s[8 * 65], s[9 * 65], s[10 * 65], s[11 * 65]); o.w = pk4_fp8(s[12 * 65], s[13 * 65], s[14 * 65], s[15 * 65]);
            *(u32x4*)(t.dst + (size_t)n * DM + 16 * c) = o; }
    } else { const int c = lane & 7;
#pragma unroll
        for (int j = 0; j < 8; ++j) { const int n = (lane >> 3) + 8 * j; const LAS float* s = scr + (8 * c) * 65 + n;
            u32x4 o; o.x = pk2(s[0 * 65], s[1 * 65]); o.y = pk2(s[2 * 65], s[3 * 65]); o.z = pk2(s[4 * 65], s[5 * 65]); o.w = pk2(s[6 * 65], s[7 * 65]);
            *(u32x4*)(t.dst + ((size_t)n * DM + 8 * c) * 2) = o; }
    }
    LDS_WAIT(); asm volatile("" ::: "memory");
}
template <bool W8>
__device__ __forceinline__ TItem moe_pair(const Args& a, uchar* ws, int it) {
    constexpr size_t WEB = W8 ? 1 : 2; TItem t;
    const int kb = 2 * ((it & 7) | (((it >> 11) & 1) << 3)), nb = (it >> 3) & 31;
    if (it < NE * 2 * 16 * 32) { const int rest = ((it >> 8) & 7) | ((it >> 12) << 3), half = rest & 1, e = rest >> 1, pn = nb >> 1, q = nb & 1;
        t.src = a.in[half ? I_WU : I_WG] + (size_t)e * DM * DFF + (size_t)(kb * 64) * DFF + nb * 64;
        t.dst = ws + WS_W1 + ((size_t)e * 4096 * DM + (size_t)(pn * 256 + half * 128 + q * 64) * DM + kb * 64) * WEB;
    } else { const int r = it - NE * 2 * 16 * 32, e = ((r >> 8) & 7) | ((r >> 12) << 3);
        t.src = a.in[I_WD] + (size_t)e * DFF * DM + (size_t)(kb * 64) * DM + nb * 64;
        t.dst = ws + WS_W2 + ((size_t)e * DM * DFF + (size_t)(nb * 64) * DFF + kb * 64) * WEB; }
    return t;
}
template <bool FP8OUT, int NO>
__device__ __forceinline__ void ti_block(const f32x4 (&v)[16], float oscale, LAS float* scr, int lane, u32x4 (&o)[NO]) {
#pragma unroll
    for (int i = 0; i < 16; ++i) { LAS float* d = scr + (4 * i + (lane >> 4)) * 65 + (lane & 15) * 4; d[0] = v[i].x * oscale; d[1] = v[i].y * oscale; d[2] = v[i].z * oscale; d[3] = v[i].w * oscale; }
    LDS_WAIT(); asm volatile("" ::: "memory");
    if constexpr (FP8OUT) { const int c = lane & 3;
#pragma unroll
        for (int j = 0; j < 4; ++j) { const int n = (lane >> 2) + 16 * j; const LAS float* s = scr + (16 * c) * 65 + n;
            o[j].x = pk4_fp8(s[0 * 65], s[1 * 65], s[2 * 65], s[3 * 65]); o[j].y = pk4_fp8(s[4 * 65], s[5 * 65], s[6 * 65], s[7 * 65]);
            o[j].z = pk4_fp8(s[8 * 65], s[9 * 65], s[10 * 65], s[11 * 65]); o[j].w = pk4_fp8(s[12 * 65], s[13 * 65], s[14 * 65], s[15 * 65]); }
    } else { const int c = lane & 7;
#pragma unroll
        for (int j = 0; j < 8; ++j) { const int n = (lane >> 3) + 8 * j; const LAS float* s = scr + (8 * c) * 65 + n;
            o[j].x = pk2(s[0 * 65], s[1 * 65]); o[j].y = pk2(s[2 * 65], s[3 * 65]); o[j].z = pk2(s[4 * 65], s[5 * 65]); o[j].w = pk2(s[6 * 65], s[7 * 65]); } }
    LDS_WAIT(); asm volatile("" ::: "memory");
}
__device__ __forceinline__ int win_src_col(int n0) {
    if (n0 < C_KVLAT) return n0;
    if (n0 < C_U) return n0;
    if (n0 < C_GA) return (n0 - C_U) + 832;
    if (n0 < C_KR) return (n0 - C_GA) + 1856;
    if (n0 < C_KR + DROPE) return (n0 - C_KR) + 768;
    return -1;
}
__device__ __forceinline__ void s5_build_group(const Args& a, const Frame& F, int g) {
    FRAME_IDS(F);
    LAS float* L = (LAS float*)F.lds;
    LAS float* Apr = L;              LAS float* Api = Apr + 17 * 64;
    LAS float* Zr = Api + 17 * 64;   LAS float* Zi = Zr + 64;
    LAS float* Bbr = Zi + 64;        LAS float* Bbi = Bbr + 1024;
    LAS float* Cr = Bbi + 1024;      LAS float* Ci = Cr + 1024;
    LAS float* Kt = Ci + 1024;
    const int tid = F_tid;
    __syncthreads();
    if (tid < 64) { const int p = tid;
        const float dt = expf(a.in[I_LOGDT][g]); const float lr = a.in[I_LRE][g * 64 + p], li = a.in[I_LIM][g * 64 + p];
        const float mag = expf(lr * dt); const float ar = mag * cosf(li * dt), ai = mag * sinf(li * dt);
        const float den = lr * lr + li * li;
        Zr[p] = ((ar - 1.0f) * lr + ai * li) / den; Zi[p] = (ai * lr - (ar - 1.0f) * li) / den;
        float pr = 1.0f, pi = 0.0f;
        for (int t = 0; t <= 16; ++t) { Apr[t * 64 + p] = pr; Api[t * 64 + p] = pi; const float nr = pr * ar - pi * ai, ni = pr * ai + pi * ar; pr = nr; pi = ni; }
    }
    __syncthreads();
    for (int i = tid; i < 1024; i += NTHREADS) { const int p = i >> 4;
        const float br = a.in[I_BRE][(size_t)g * 1024 + i], bi = a.in[I_BIM][(size_t)g * 1024 + i];
        Bbr[i] = Zr[p] * br - Zi[p] * bi; Bbi[i] = Zr[p] * bi + Zi[p] * br;
        Cr[i] = a.in[I_CRE][(size_t)g * 1024 + i]; Ci[i] = a.in[I_CIM][(size_t)g * 1024 + i]; }
    if (tid < 64) ((float2*)(F.ws + WS_SMALL + SM_A16))[g * 64 + tid] = make_float2(Apr[16 * 64 + tid], Api[16 * 64 + tid]);
    __syncthreads();
    { const int tau = tid >> 5, c = (tid >> 1) & 15, h8 = (tid & 1) * 8; float acc8[8];
#pragma unroll
      for (int j = 0; j < 8; ++j) acc8[j] = 0.f;
      for (int p = 0; p < 64; ++p) { const float cr = Cr[c * 64 + p], ci = Ci[c * 64 + p], ar = Apr[tau * 64 + p], ai = Api[tau * 64 + p];
          const float car = cr * ar - ci * ai, cai = cr * ai + ci * ar;
          const f32x4 b0 = *(const LAS f32x4*)(Bbr + p * 16 + h8), b1 = *(const LAS f32x4*)(Bbr + p * 16 + h8 + 4), d0 = *(const LAS f32x4*)(Bbi + p * 16 + h8), d1 = *(const LAS f32x4*)(Bbi + p * 16 + h8 + 4);
#pragma unroll
          for (int j = 0; j < 4; ++j) { acc8[j] += car * b0[j] - cai * d0[j]; acc8[4 + j] += car * b1[j] - cai * d1[j]; } }
#pragma unroll
      for (int j = 0; j < 8; ++j) Kt[(tau * 16 + c) * 16 + h8 + j] = acc8[j]; }
    __syncthreads();
    bf16_t* twc = (bf16_t*)(F.ws + WS_TWC) + (size_t)g * 256 * APK;
    for (int ch = tid; ch < 256 * (APK / 8); ch += NTHREADS) { const int n = ch / (APK / 8), k0 = (ch % (APK / 8)) * 8, t = n >> 4, c = n & 15; float v[8];
#pragma unroll
        for (int j = 0; j < 8; ++j) { const int k = k0 + j;
            if (k < 256) { const int s = k >> 4, cp = k & 15; float x = (s <= t) ? Kt[((t - s) * 16 + c) * 16 + cp] : 0.f; if (s == t && cp == c) x += a.in[I_S5D][g * 16 + c]; v[j] = x; }
            else { const int q = k - 256, p = q & 63; const float cr = Cr[c * 64 + p], ci = Ci[c * 64 + p], ar = Apr[(t + 1) * 64 + p], ai = Api[(t + 1) * 64 + p];
                v[j] = (q < 64) ? (cr * ar - ci * ai) : -(cr * ai + ci * ar); } }
        u32x4 o; o.x = pk2(v[0], v[1]); o.y = pk2(v[2], v[3]); o.z = pk2(v[4], v[5]); o.w = pk2(v[6], v[7]);
        *(u32x4*)(twc + (size_t)n * APK + k0) = o; }
    bf16_t* wsm = (bf16_t*)(F.ws + WS_WS5) + (size_t)g * 256 * 256;
    for (int ch = tid; ch < 256 * 32; ch += NTHREADS) { const int n = ch >> 5, k0 = (ch & 31) * 8; float v[8];
#pragma unroll
        for (int j = 0; j < 8; ++j) { const int k = k0 + j, s = k >> 4, cp = k & 15;
            if (n < 128) { const int p = n & 63; const float ar = Apr[(15 - s) * 64 + p], ai = Api[(15 - s) * 64 + p], br = Bbr[p * 16 + cp], bi = Bbi[p * 16 + cp];
                v[j] = (n < 64) ? (ar * br - ai * bi) : (ar * bi + ai * br); } else v[j] = 0.f; }
        u32x4 o; o.x = pk2(v[0], v[1]); o.y = pk2(v[2], v[3]); o.z = pk2(v[4], v[5]); o.w = pk2(v[6], v[7]);
        *(u32x4*)(wsm + (size_t)n * 256 + k0) = o; }
    __syncthreads();
}
__device__ __forceinline__ void rms_row_to_bf16(const float* xrow, const float* gain, bf16_t* orow, int lane) {
    const f32x4* xr = (const f32x4*)xrow + lane; const f32x4* gr = (const f32x4*)gain + lane;
    f32x4 v[8]; float s = 0.f;
#pragma unroll
    for (int j = 0; j < 8; ++j) { v[j] = __builtin_nontemporal_load(xr + 64 * j); s += (v[j].x * v[j].x + v[j].y * v[j].y) + (v[j].z * v[j].z + v[j].w * v[j].w); }
    const float rstd = 1.0f / sqrtf(wave_sum(s) * (1.0f / DM) + EPS);
    unsigned long long* o8 = (unsigned long long*)orow + lane;
#pragma unroll
    for (int j = 0; j < 8; ++j) { const f32x4 gg = gr[64 * j];
        o8[64 * j] = (unsigned long long)pk2(v[j].x * rstd * gg.x, v[j].y * rstd * gg.y) | ((unsigned long long)pk2(v[j].z * rstd * gg.z, v[j].w * rstd * gg.w) << 32); }
}
__device__ __forceinline__ void p0_prologue(const Args& a, const Frame& F) {
    FRAME_IDS(F);
    for (int g = F.bx; g < S5G; g += F.G) s5_build_group(a, F, g);
    __syncthreads();
    const int gw = F.bx * NWAVES + F.wave, NGW = F.G * NWAVES; const int lane = F_lane;
    for (int m = gw; m < TT; m += NGW) rms_row_to_bf16(a.in[I_X] + (size_t)m * DM, a.in[I_N1G], (bf16_t*)(F.ws + WS_H) + (size_t)m * DM, lane);
    for (int i = gw * 64 + lane; i < TT * 32; i += NGW * 64) { const int t = i >> 5, f = i & 31;
        const double invf = exp(-(double)f * (9.210340371976184 / 32.0)); const double ang = (double)((const int*)a.in[I_POS])[t] * invf;
        ((float2*)(F.ws + WS_ROPE))[i] = make_float2((float)cos(ang), (float)sin(ang)); }
    for (int i = gw * 64 + lane; i < DM * NE; i += NGW * 64) ((float*)(F.ws + WS_SMALL + SM_WRP))[i] = a.in[I_WR][i] * a.in[I_N2G][i >> 5];
    LAS float* scr = (LAS float*)(F.lds + F.wave * 16640);
    constexpr int IT_WIN = (DM / 64) * (NPROJ / 64), IT_WUQ = (QLORA / 64) * (3072 / 64), IT_WUKV = (KVLORA / 64) * (4096 / 64), IT_SQ = (DM / 64) * (DM / 64),
                  IT_GLU = (S5W / 64) * (S5W / 64), IT_OS5 = (S5W / 64) * (DM / 64);
    constexpr int IT_MIX = IT_WIN + IT_WUQ + IT_WUKV + IT_SQ + IT_GLU + IT_OS5 + IT_SQ;
    for (int it = gw; it < IT_MIX; it += NGW) { int r = it;
        if (r < IT_WIN) { const int nb = r % (NPROJ / 64), kb = r / (NPROJ / 64); transpose_item<false>(a.in[I_WIN], IN_PROJ, win_src_col(nb * 64), kb * 64, nullptr, F.ws + WS_WIN, DM, nb * 64, 1.f, scr, lane); continue; } r -= IT_WIN;
        if (r < IT_WUQ) { const int nb = r % 48, kb = r / 48; transpose_item<false>(a.in[I_WUQ], 3072, nb * 64, kb * 64, a.in[I_QNG], F.ws + WS_WUQ, QLORA, nb * 64, 1.f, scr, lane); continue; } r -= IT_WUQ;
        if (r < IT_WUKV) { const int nb = r % 64, kb = r / 64; transpose_item<false>(a.in[I_WUKV], 4096, nb * 64, kb * 64, a.in[I_KVNG], F.ws + WS_WUKV, KVLORA, nb * 64, 1.f, scr, lane); continue; } r -= IT_WUKV;
        if (r < IT_SQ) { const int nb = r % 32, kb = r / 32; transpose_item<false>(a.in[I_WOMLA], DM, nb * 64, kb * 64, nullptr, F.ws + WS_WOMLA, DM, nb * 64, 1.f, scr, lane); continue; } r -= IT_SQ;
        if (r < IT_GLU) { const int nb = r % 16, kb = r / 16; transpose_item<false>(a.in[I_WGLU], S5W, nb * 64, kb * 64, nullptr, F.ws + WS_WGLU, S5W, nb * 64, 1.f, scr, lane); continue; } r -= IT_GLU;
        if (r < IT_OS5) { const int nb = r % 32, kb = r / 32; transpose_item<false>(a.in[I_WOS5], DM, nb * 64, kb * 64, nullptr, F.ws + WS_WOS5, S5W, nb * 64, 1.f, scr, lane); continue; } r -= IT_OS5;
        { const int nb = r % 32, kb = r / 32; transpose_item<false>(a.in[I_WOUT], DM, nb * 64, kb * 64, nullptr, F.ws + WS_WOUT, DM, nb * 64, 1.f, scr, lane); }
    }
    constexpr bool W8 = MK_FP8_MOE != 0; constexpr float WSC = W8 ? FP8_WSCALE : 1.0f; constexpr int NPAIR = NE * 3 * 16 * 32; constexpr int NO = W8 ? 4 : 8;
    for (int it = gw; it < NPAIR; it += NGW) { const TItem t = moe_pair<W8>(a, F.ws, it); f32x4 v0[16], v1[16];
        ti_load(t, v0, lane); { TItem t1 = t; t1.src += (size_t)64 * DM; ti_load(t1, v1, lane); }
        u32x4 o0[NO], o1[NO];
        ti_block<W8, NO>(v0, WSC, scr, lane, o0); ti_block<W8, NO>(v1, WSC, scr, lane, o1);
        if constexpr (W8) { const int c = lane & 3;
#pragma unroll
            for (int j = 0; j < 4; ++j) { uchar* d = t.dst + (size_t)((lane >> 2) + 16 * j) * DM + 16 * c; *(u32x4*)d = o0[j]; *(u32x4*)(d + 64) = o1[j]; }
        } else { const int c = lane & 7;
#pragma unroll
            for (int j = 0; j < 8; ++j) { uchar* d = t.dst + ((size_t)((lane >> 3) + 8 * j) * DM + 8 * c) * 2; *(u32x4*)d = o0[j]; *(u32x4*)(d + 128) = o1[j]; } }
    }
}

constexpr float QSCALE = 0.07216878364870322f * 1.4426950408889634f;
__device__ __forceinline__ float half_sum(float v) {
#pragma unroll
    for (int o = 1; o < 32; o <<= 1) v += __shfl_xor(v, o);
    return v;
}
__device__ __forceinline__ void p3_prep(const Args& a, const Frame& F) {
    FRAME_IDS(F);
    const bf16_t* proj = (const bf16_t*)(F.ws + WS_PROJ); const bf16_t* kvraw = (const bf16_t*)(F.ws + WS_KVRAW); bf16_t* Kn = (bf16_t*)(F.ws + WS_KN);
    const float2* rope = (const float2*)(F.ws + WS_ROPE);
    const int lane = F_lane, grp = lane / 24, ch = lane - grp * 24; const bool act = grp < 2;
    const bool isrope = act && ch >= 16, x2half = isrope && ch >= 20; const int ri = isrope ? ((ch - 16) & 3) * 8 : 0;
    float g[8];
#pragma unroll
    for (int j = 0; j < 8; ++j) g[j] = act ? a.in[I_QKKG][ch * 8 + j] : 0.f;
    const bool even = (TT == 64 * F.G);
    const int tk0 = even ? F.bx * 64 + (F.wave < 2 ? 5 * F.wave : 10 + 9 * (F.wave - 2)) : F.bx * NWAVES + F.wave, tkn = even ? (F.wave < 2 ? 5 : 9) : (TT + F.G * NWAVES - 1) / (F.G * NWAVES), tks = even ? 1 : F.G * NWAVES;
    for (int ti = 0; ti < tkn; ++ti) { const int t = tk0 + ti * tks; if (t >= TT) break;
        const int b = t >> 11, s = t & 2047; const bf16_t* prow = proj + (size_t)t * NPROJ;
        float cs[8], sn[8];
        if (isrope) {
#pragma unroll
            for (int j = 0; j < 8; j += 2) { const f32x4 c2 = *(const f32x4*)(rope + (size_t)t * 32 + ri + j); cs[j] = c2.x; sn[j] = c2.y; cs[j + 1] = c2.z; sn[j + 1] = c2.w; } }
        else {
#pragma unroll
            for (int j = 0; j < 8; ++j) { cs[j] = 1.f; sn[j] = 0.f; } }
        u32x4 kr = (u32x4){0u, 0u, 0u, 0u};
        if (isrope) kr = *(const u32x4*)(prow + C_KR + (ch - 16) * 8);
        u32x4 wl[8];
        { const bf16_t* src0 = kvraw + ((size_t)(b * NH + grp) * SEQ + s) * 128 + (ch & 15) * 8;
#pragma unroll
          for (int i = 0; i < 8; ++i) wl[i] = (!act) ? (u32x4){0u, 0u, 0u, 0u} : (isrope ? kr : *(const u32x4*)(src0 + (size_t)i * 2 * SEQ * 128)); }
#pragma unroll
        for (int i = 0; i < 8; ++i) { const int h = 2 * i + grp; const u32x4 w = wl[i];
            float x[8], ss = 0.f;
#pragma unroll
            for (int q = 0; q < 4; ++q) { x[2 * q] = bflo(w[q]); x[2 * q + 1] = bfhi(w[q]); }
#pragma unroll
            for (int j = 0; j < 8; ++j) ss += x[j] * x[j];
            const float s0 = wave_sum(grp == 0 ? ss : 0.f), s1 = wave_sum(grp == 1 ? ss : 0.f);
            const float rn = 1.0f / sqrtf((grp == 0 ? s0 : s1) * (1.0f / DQK) + EPS);
            float y[8];
#pragma unroll
            for (int j = 0; j < 8; ++j) y[j] = x[j] * rn * g[j];
#pragma unroll
            for (int j = 0; j < 8; ++j) { const float partner = __shfl_xor(y[j], 4); y[j] = x2half ? (y[j] * cs[j] + partner * sn[j]) : (y[j] * cs[j] - partner * sn[j]); }
            if (act) { u32x4 o; o.x = pk2(y[0], y[1]); o.y = pk2(y[2], y[3]); o.z = pk2(y[4], y[5]); o.w = pk2(y[6], y[7]);
                *(u32x4*)(Kn + ((size_t)(b * NH + h) * SEQ + s) * DQK + ch * 8) = o; }
        }
    }
}

__device__ __forceinline__ void p3_scan(const Args& a, const Frame& F) {
    FRAME_IDS(F);
    const float* sch = (const float*)(F.ws + WS_SCH); bf16_t* apack = (bf16_t*)(F.ws + WS_APACK); const float2* A16 = (const float2*)(F.ws + WS_SMALL + SM_A16);
    const int p = F_lane;
    for (int it = F.wave * F.G + F.bx; it < NB * S5G; it += F.G * NWAVES) { const int b = it / S5G, g = it % S5G;
        const float2 am = A16[g * 64 + p]; float xr = 0.f, xi = 0.f;
        const size_t row0 = (size_t)g * NCHUNK + (size_t)b * 128;
        for (int c0 = 0; c0 < 128; c0 += 32) { float sr[32], si[32];
#pragma unroll
            for (int q = 0; q < 32; ++q) { sr[q] = sch[(row0 + c0 + q) * 128 + p]; si[q] = sch[(row0 + c0 + q) * 128 + 64 + p]; }
#pragma unroll
            for (int q = 0; q < 32; ++q) { bf16_t* o = apack + (row0 + c0 + q) * APK + 256; o[p] = (bf16_t)f2bf(xr); o[64 + p] = (bf16_t)f2bf(xi);
                const float nr = am.x * xr - am.y * xi + sr[q], ni = am.x * xi + am.y * xr + si[q]; xr = nr; xi = ni; } }
    }
}

__device__ __forceinline__ void s5_reference(const Args& a, const Frame& F) {
    FRAME_IDS(F);
    const bf16_t* apack = (const bf16_t*)(F.ws + WS_APACK); bf16_t* gact = (bf16_t*)(F.ws + WS_GACT);
    const int gw = F.bx * NWAVES + F.wave, NGW = F.G * NWAVES, p = F_lane;
    for (int it = gw; it < NB * S5G; it += NGW) { const int b = it / S5G, g = it % S5G;
        const float dt = expf(a.in[I_LOGDT][g]); const float lr = a.in[I_LRE][g * 64 + p], li = a.in[I_LIM][g * 64 + p];
        const float mag = expf(lr * dt); const float ar = mag * cosf(li * dt), ai = mag * sinf(li * dt); const float den = lr * lr + li * li;
        const float zr = ((ar - 1.0f) * lr + ai * li) / den, zi = (ai * lr - (ar - 1.0f) * li) / den;
        float bbr[16], bbi[16], cr[16], ci[16];
#pragma unroll
        for (int c = 0; c < 16; ++c) { const float br = a.in[I_BRE][((size_t)g * 64 + p) * 16 + c], bi = a.in[I_BIM][((size_t)g * 64 + p) * 16 + c];
            bbr[c] = zr * br - zi * bi; bbi[c] = zr * bi + zi * br; cr[c] = a.in[I_CRE][((size_t)g * 16 + c) * 64 + p]; ci[c] = a.in[I_CIM][((size_t)g * 16 + c) * 64 + p]; }
        const float dl = (p < 16) ? a.in[I_S5D][g * 16 + p] : 0.f;
        float xr = 0.f, xi = 0.f;
        for (int t = 0; t < SEQ; ++t) { const int tok = b * SEQ + t;
            const bf16_t* up = apack + ((size_t)g * NCHUNK + (tok >> 4)) * APK + (tok & 15) * 16;
            const u32x4 w0 = *(const u32x4*)up, w1 = *(const u32x4*)(up + 8); float u[16];
#pragma unroll
            for (int q = 0; q < 4; ++q) { u[2 * q] = bflo(w0[q]); u[2 * q + 1] = bfhi(w0[q]); u[8 + 2 * q] = bflo(w1[q]); u[8 + 2 * q + 1] = bfhi(w1[q]); }
            float br = 0.f, bi = 0.f;
#pragma unroll
            for (int c = 0; c < 16; ++c) { br += bbr[c] * u[c]; bi += bbi[c] * u[c]; }
            const float nr = ar * xr - ai * xi + br, ni = ar * xi + ai * xr + bi; xr = nr; xi = ni;
            float y = 0.f, um = 0.f;
#pragma unroll
            for (int c = 0; c < 16; ++c) { const float yc = wave_sum(cr[c] * xr - ci[c] * xi); if (p == c) { y = yc; um = u[c]; } }
            if (p < 16) gact[(size_t)tok * S5W + g * 16 + p] = (bf16_t)f2bf(gelu_tanh(y + dl * um));
        }
    }
}

__device__ __forceinline__ float attn_bound(const Args& a, int lane) {
    float mq = 0.f, mk = 0.f;
#pragma unroll
    for (int q = 0; q < 3; ++q) { mq = fmaxf(mq, fabsf(a.in[I_QKQG][lane + 64 * q])); mk = fmaxf(mk, fabsf(a.in[I_QKKG][lane + 64 * q])); }
#pragma unroll
    for (int o = 1; o < 64; o <<= 1) { mq = fmaxf(mq, __shfl_xor(mq, o)); mk = fmaxf(mk, __shfl_xor(mk, o)); }
    return mq * mk * 13.856406460551018f * 1.4426950408889634f;
}
__device__ __forceinline__ void attn_reference(const Args& a, const Frame& F) {
    FRAME_IDS(F);
    const bf16_t* Qn = (const bf16_t*)(F.ws + WS_QN); const bf16_t* Kn = (const bf16_t*)(F.ws + WS_KN); const bf16_t* Vn = (const bf16_t*)(F.ws + WS_VN);
    bf16_t* O = (bf16_t*)(F.ws + WS_O);
    LAS float* ql = (LAS float*)(F.lds + F.wave * 1024);
    const int lane = F_lane, gw = F.bx * NWAVES + F.wave, NGW = F.G * NWAVES;
    const float Mb = attn_bound(a, lane);
    for (int it = gw; it < NB * NH * SEQ; it += NGW) { const int s = it & 2047, bh = it >> 11, b = bh >> 4, h = bh & 15;
        const bf16_t* qp = Qn + ((size_t)bh * SEQ + s) * DQK;
#pragma unroll
        for (int q = 0; q < 3; ++q) ql[lane + 64 * q] = bf2f(qp[lane + 64 * q]);
        LDS_WAIT();
        const int nk = 64 * ((s >> 6) + 1);
        float o0 = 0.f, o1 = 0.f, l = 0.f;
        for (int k0 = 0; k0 < nk; k0 += 64) {
            const bf16_t* kp = Kn + ((size_t)bh * SEQ + k0 + lane) * DQK; float sc = 0.f;
            for (int d = 0; d < DQK; d += 8) { const u32x4 w = *(const u32x4*)(kp + d);
#pragma unroll
                for (int q = 0; q < 4; ++q) sc += bflo(w[q]) * ql[d + 2 * q] + bfhi(w[q]) * ql[d + 2 * q + 1]; }
            const float pr = __builtin_amdgcn_exp2f(sc - Mb); l += pr;
            for (int kk = 0; kk < 64; ++kk) { const float pk = __shfl(pr, kk); const unsigned w = *(const unsigned*)(Vn + ((size_t)bh * SEQ + k0 + kk) * DV + 2 * lane);
                o0 += pk * bflo(w); o1 += pk * bfhi(w); }
        }
        l = wave_sum(l); const float rl = 1.0f / l;
        *(unsigned*)(O + ((size_t)(b * SEQ + s)) * DM + h * DV + 2 * lane) = pk2(o0 * rl, o1 * rl);
        LDS_WAIT();
    }
}

namespace at {
constexpr int KVB = 64;
constexpr int SHM_V = KVB * DV * 2  , SHM_K = KVB * DQK * 2  ;
constexpr int NQR = 4;
constexpr int OFF_V = 0, OFF_K = 2 * SHM_V, OFF_WS = OFF_K + 2 * SHM_K  , OFF_QL = OFF_WS + NWAVES * 256  , OFF_OST = 0;
constexpr int OPITCH = 272;
static_assert(OFF_QL + NWAVES * (12 - NQR) * 1024 <= LDSCTL_OFF, "attention LDS map");
#define KSWZ(row, colB) ((row) * 384 + ((colB) ^ ((((row) >> 1) & 7) << 4)))
__device__ __forceinline__ int crow(int r, int hi) { return (r & 3) + 8 * (r >> 2) + 4 * hi; }
__device__ __forceinline__ int v_st(int k, int c) { const int kk = (k & ~0xC) | ((k & 4) << 1) | ((k & 8) >> 1); return ((kk >> 3) * 4 + (c >> 5)) * 512 + ((kk & 7) * 32 + (c & 31)) * 2; }
__device__ __forceinline__ int v_rd_base(int lane) { return ((lane & 3) << 3) | (((lane >> 2) & 3) << 6) | (((lane >> 4) & 1) << 5) | (((lane >> 5) & 1) << 8); }
constexpr int v_rd_off(int d0, int ks, int half) { return d0 * 512 + ks * 4096 + half * 2048; }
template <int OFF> __device__ __forceinline__ s16x4 tr_read(int vb) { s16x4 r; asm volatile("ds_read_b64_tr_b16 %0, %1 offset:%2" : "=&v"(r) : "v"(vb), "i"(OFF) : "memory"); return r; }
template <int D0> __device__ __forceinline__ void pv_one(f32x16& od, int vb, bf16x8 pa0, bf16x8 pa1, bf16x8 pa2, bf16x8 pa3) {
    const s16x4 l0 = tr_read<v_rd_off(D0, 0, 0)>(vb), h0 = tr_read<v_rd_off(D0, 0, 1)>(vb), l1 = tr_read<v_rd_off(D0, 1, 0)>(vb), h1 = tr_read<v_rd_off(D0, 1, 1)>(vb);
    const s16x4 l2 = tr_read<v_rd_off(D0, 2, 0)>(vb), h2 = tr_read<v_rd_off(D0, 2, 1)>(vb), l3 = tr_read<v_rd_off(D0, 3, 0)>(vb), h3 = tr_read<v_rd_off(D0, 3, 1)>(vb);
    asm volatile("s_waitcnt lgkmcnt(0)" ::: "memory"); SBAR();
#define PK(L, H) (bf16x8){L[0], L[1], L[2], L[3], H[0], H[1], H[2], H[3]}
    od = __builtin_amdgcn_mfma_f32_32x32x16_bf16(pa0, PK(l0, h0), od, 0, 0, 0);
    od = __builtin_amdgcn_mfma_f32_32x32x16_bf16(pa1, PK(l1, h1), od, 0, 0, 0);
    od = __builtin_amdgcn_mfma_f32_32x32x16_bf16(pa2, PK(l2, h2), od, 0, 0, 0);
    od = __builtin_amdgcn_mfma_f32_32x32x16_bf16(pa3, PK(l3, h3), od, 0, 0, 0);
#undef PK
}
__device__ __forceinline__ void pv_d0(f32x16* o, int vb, bf16x8 pa0, bf16x8 pa1, bf16x8 pa2, bf16x8 pa3) {
    pv_one<0>(o[0], vb, pa0, pa1, pa2, pa3); pv_one<1>(o[1], vb, pa0, pa1, pa2, pa3); pv_one<2>(o[2], vb, pa0, pa1, pa2, pa3); pv_one<3>(o[3], vb, pa0, pa1, pa2, pa3);
}
template <int BUF, int NQR> __device__ __forceinline__ void qkt(f32x16& p0, f32x16& p1, const int (&kb)[4], const bf16x8* qr, int qlb, float bias) {
#pragma unroll
    for (int r = 0; r < 16; ++r) { p0[r] = bias; p1[r] = bias; }
#pragma unroll
    for (int a = 0; a < 3; ++a)
#pragma unroll
        for (int b = 0; b < 4; ++b) { const int d0 = 4 * a + b;
            const bf16x8 b0 = *(const LAS bf16x8*)(kb[b] + BUF * SHM_K + a * 128);
            const bf16x8 b1 = *(const LAS bf16x8*)(kb[b] + BUF * SHM_K + a * 128 + 32 * 384);
            bf16x8 q; if (d0 < NQR) q = qr[d0]; else q = *(const LAS bf16x8*)(qlb + (d0 - NQR) * 1024);
            p0 = __builtin_amdgcn_mfma_f32_32x32x16_bf16(b0, q, p0, 0, 0, 0);
            p1 = __builtin_amdgcn_mfma_f32_32x32x16_bf16(b1, q, p1, 0, 0, 0); }
}
__device__ __forceinline__ void partialSM(f32x16& p0, f32x16& p1) {
#pragma unroll
    for (int r = 0; r < 16; ++r) p0[r] = __builtin_amdgcn_exp2f(p0[r]);
}
__device__ __forceinline__ void finishSM(f32x16& p0, f32x16& p1, float& l_reg, bf16x8& pa0, bf16x8& pa1, bf16x8& pa2, bf16x8& pa3) {
#pragma unroll
    for (int r = 0; r < 16; ++r) p1[r] = __builtin_amdgcn_exp2f(p1[r]);
    float ps = 0;
#pragma unroll
    for (int r = 0; r < 16; ++r) ps += p0[r];
#pragma unroll
    for (int r = 0; r < 16; ++r) ps += p1[r];
    { auto rr = __builtin_amdgcn_permlane32_swap(__float_as_uint(ps), __float_as_uint(ps), false, false); ps = __uint_as_float(rr[0]) + __uint_as_float(rr[1]); }
    l_reg += ps;
#define PK4(P, BASE, OUT) do { unsigned a0 = cvt_pk_bf16(P[BASE + 0], P[BASE + 1]), a1 = cvt_pk_bf16(P[BASE + 2], P[BASE + 3]);   \
    unsigned b0 = cvt_pk_bf16(P[BASE + 4], P[BASE + 5]), b1 = cvt_pk_bf16(P[BASE + 6], P[BASE + 7]);                              \
    auto r0 = __builtin_amdgcn_permlane32_swap(a0, b0, false, false); auto r1 = __builtin_amdgcn_permlane32_swap(a1, b1, false, false); \
    u32x4 w = {r0[0], r1[0], r0[1], r1[1]}; OUT = *reinterpret_cast<bf16x8*>(&w); } while (0)
    PK4(p0, 0, pa0); PK4(p0, 8, pa1); PK4(p1, 0, pa2); PK4(p1, 8, pa3);
#undef PK4
}
__device__ __forceinline__ void attn_qblock(const bf16_t* __restrict__ Qb, const bf16_t* __restrict__ Kh, const bf16_t* __restrict__ Vh, bf16_t* __restrict__ Ob, int qb, float Mb, LAS char* lds, const int wid,
                                            const float2* __restrict__ ropeb, const float* __restrict__ gq) {
    const int lane = fresh_lane(), tid = wid * 64 + lane, r32 = lane & 31, hi = lane >> 5;
    LAS char* V_lds = lds + OFF_V; LAS char* K_lds = lds + OFF_K;
    LAS float* li_l = (LAS float*)(lds + OFF_WS) + wid * 64;
    float l_reg = 0; f32x16 o[4] = {}; bf16x8 qr[NQR];
    const int qlb = (int)(uintptr_t)(lds + OFF_QL) + wid * ((12 - NQR) * 1024) + lane * 16;
    {
        const bf16_t* Qw = Qb + (size_t)(wid * 32 + r32) * (NH * DQK) + hi * 8;
        bf16x8 qf[12];
#pragma unroll
        for (int d0 = 0; d0 < 12; ++d0) qf[d0] = *(const bf16x8*)(Qw + d0 * 16);
        float ssq = 0.f;
#pragma unroll
        for (int d0 = 0; d0 < 12; ++d0)
#pragma unroll
            for (int j = 0; j < 8; ++j) { const float v = bf2f((unsigned short)qf[d0][j]); ssq += v * v; }
        ssq += __shfl_xor(ssq, 32);
        const float rn = QSCALE / sqrtf(ssq * (1.0f / DQK) + EPS);
        const float2* rp = ropeb + (size_t)(wid * 32 + r32) * 32 + hi * 8;
#pragma unroll
        for (int d0 = 0; d0 < 12; ++d0) { bf16x8 qn;
            if (d0 < 8) { const f32x4 g0 = *(const f32x4*)(gq + d0 * 16 + hi * 8), g1 = *(const f32x4*)(gq + d0 * 16 + hi * 8 + 4);
#pragma unroll
                for (int j = 0; j < 8; ++j) qn[j] = (short)f2bf(bf2f((unsigned short)qf[d0][j]) * rn * (j < 4 ? g0[j] : g1[j - 4])); }
            else { const int pp = (d0 - 8) & 1, da = 8 + pp, db = 10 + pp; const bool second = d0 >= 10;
#pragma unroll
                for (int j = 0; j < 8; ++j) { const float2 c = rp[pp * 16 + j];
                    const float y1 = bf2f((unsigned short)qf[da][j]) * rn * gq[128 + pp * 16 + hi * 8 + j], y2 = bf2f((unsigned short)qf[db][j]) * rn * gq[160 + pp * 16 + hi * 8 + j];
                    qn[j] = (short)f2bf(second ? (y2 * c.x + y1 * c.y) : (y1 * c.x - y2 * c.y)); } }
            if (d0 < NQR) qr[d0] = qn; else *(LAS bf16x8*)(qlb + (d0 - NQR) * 1024) = qn; }
    }
    const int sr = tid >> 4, sc = (tid & 15) * 8, vst0 = v_st(sr, sc), vst1 = v_st(32 + sr, sc);
    int kro[3], kst[3];
#pragma unroll
    for (int i = 0; i < 3; ++i) { const int q = tid + 512 * i, row = q / 24, c8 = q % 24; kro[i] = row * DQK + c8 * 8; kst[i] = KSWZ(row, c8 * 16); }
    const int vb0 = (int)(uintptr_t)V_lds + v_rd_base(lane);
    int kb[4];
#pragma unroll
    for (int b = 0; b < 4; ++b) kb[b] = (int)(uintptr_t)K_lds + r32 * 384 + ((b * 32 + hi * 16) ^ (((r32 >> 1) & 7) << 4));
    bf16x8 vs0, vs1, ks0, ks1, ks2;
#define SLOAD(k0) do { vs0 = *(const bf16x8*)(Vh + (size_t)((k0) + sr) * DV + sc); vs1 = *(const bf16x8*)(Vh + (size_t)((k0) + 32 + sr) * DV + sc); \
    ks0 = *(const bf16x8*)(Kh + (size_t)(k0) * DQK + kro[0]); ks1 = *(const bf16x8*)(Kh + (size_t)(k0) * DQK + kro[1]); ks2 = *(const bf16x8*)(Kh + (size_t)(k0) * DQK + kro[2]); } while (0)
#define SWRITE(b) do { *(LAS bf16x8*)(V_lds + (b) * SHM_V + vst0) = vs0; *(LAS bf16x8*)(V_lds + (b) * SHM_V + vst1) = vs1; \
    *(LAS bf16x8*)(K_lds + (b) * SHM_K + kst[0]) = ks0; *(LAS bf16x8*)(K_lds + (b) * SHM_K + kst[1]) = ks1; *(LAS bf16x8*)(K_lds + (b) * SHM_K + kst[2]) = ks2; } while (0)
    const int NT = 4 * qb + 4, jmax = 4 * qb + (wid >> 1);
    f32x16 pA0, pA1, pB0, pB1; bf16x8 pa0, pa1, pa2, pa3;
    SLOAD(0); asm volatile("s_waitcnt vmcnt(0)" ::: "memory"); SWRITE(0); __syncthreads();
    qkt<0, NQR>(pA0, pA1, kb, qr, qlb, -Mb); partialSM(pA0, pA1);
    SLOAD(KVB); asm volatile("s_waitcnt vmcnt(0)" ::: "memory"); SWRITE(1); __syncthreads();
    for (int j = 1; j + 1 < NT; j += 2) {
        SBAR(); if (j <= jmax) qkt<1, NQR>(pB0, pB1, kb, qr, qlb, -Mb);
        if (j - 1 <= jmax) finishSM(pA0, pA1, l_reg, pa0, pa1, pa2, pa3); SBAR();
        SLOAD((j + 1) * KVB); SBAR();
        if (j - 1 <= jmax) pv_d0(o, vb0, pa0, pa1, pa2, pa3); if (j <= jmax) partialSM(pB0, pB1);
        __syncthreads(); asm volatile("s_waitcnt vmcnt(0)" ::: "memory"); SWRITE(0);
        __syncthreads();
        SBAR(); if (j + 1 <= jmax) qkt<0, NQR>(pA0, pA1, kb, qr, qlb, -Mb);
        if (j <= jmax) finishSM(pB0, pB1, l_reg, pa0, pa1, pa2, pa3); SBAR();
        SLOAD((j + 2) * KVB); SBAR();
        if (j <= jmax) pv_d0(o, vb0 + SHM_V, pa0, pa1, pa2, pa3); if (j + 1 <= jmax) partialSM(pA0, pA1);
        __syncthreads(); asm volatile("s_waitcnt vmcnt(0)" ::: "memory"); SWRITE(1);
        __syncthreads();
    }
    SBAR(); if (NT - 1 <= jmax) qkt<1, NQR>(pB0, pB1, kb, qr, qlb, -Mb);
    if (NT - 2 <= jmax) { finishSM(pA0, pA1, l_reg, pa0, pa1, pa2, pa3); SBAR(); pv_d0(o, vb0, pa0, pa1, pa2, pa3); }
    if (NT - 1 <= jmax) { partialSM(pB0, pB1); finishSM(pB0, pB1, l_reg, pa0, pa1, pa2, pa3); SBAR(); pv_d0(o, vb0 + SHM_V, pa0, pa1, pa2, pa3); }
    __syncthreads();
    const int lane2 = fresh_lane(), r32b = lane2 & 31, hib = lane2 >> 5, wid2 = wid;
    LAS float* li2 = (LAS float*)(lds + OFF_WS) + wid2 * 64;
    if (hib == 0) li2[r32b] = l_reg; LDS_WAIT();
    LAS char* ost = lds + OFF_OST + wid2 * (32 * OPITCH) + hib * (4 * OPITCH) + r32b * 2;
#pragma unroll
    for (int r = 0; r < 16; ++r) { const int orc = (r & 3) + 8 * (r >> 2); const float rl = __builtin_amdgcn_rcpf(li2[orc + 4 * hib]);
#pragma unroll
        for (int d0 = 0; d0 < 4; ++d0) *(LAS bf16_t*)(ost + orc * OPITCH + d0 * 64) = (bf16_t)f2bf(o[d0][r] * rl); }
    LDS_WAIT();
    bf16_t* Ow = Ob + (size_t)(wid2 * 32 + (lane2 >> 4)) * DM + (lane2 & 15) * 8;
    const LAS char* ord = lds + OFF_OST + wid2 * (32 * OPITCH) + (lane2 >> 4) * OPITCH + (lane2 & 15) * 16;
#pragma unroll
    for (int i = 0; i < 8; ++i) { const u32x4 w = *(const LAS u32x4*)(ord + i * 4 * OPITCH); *(u32x4*)(Ow + (size_t)(i * 4) * DM) = w; }
    __syncthreads();
#undef SLOAD
#undef SWRITE
}
#undef KSWZ
}
__device__ __forceinline__ void p4_attention(const Args& a, const Frame& F) {
    FRAME_IDS(F);
    const bf16_t* qraw = (const bf16_t*)(F.ws + WS_QRAW); const bf16_t* Kn = (const bf16_t*)(F.ws + WS_KN); const bf16_t* Vn = (const bf16_t*)(F.ws + WS_VN);
    bf16_t* O = (bf16_t*)(F.ws + WS_O); const float2* rope = (const float2*)(F.ws + WS_ROPE);
    const float Mb = attn_bound(a, F_lane);
    for (int id = F.bx; id < NB * NH * 4; id += F.G) { const int x = id & 7, idx = id >> 3, bh = x + 8 * (idx >> 2), pr = idx & 3, b = bh >> 4, h = bh & 15;
        const bf16_t* Kh = Kn + (size_t)bh * SEQ * DQK; const bf16_t* Vh = Vn + (size_t)bh * SEQ * DV;
#pragma unroll 1
        for (int w = 0; w < 2; ++w) { const int qb = w ? pr : 7 - pr; const size_t tok0 = (size_t)b * SEQ + qb * 256;
            at::attn_qblock(qraw + tok0 * (NH * DQK) + h * DQK, Kh, Vh, O + tok0 * DM + h * DV, qb, Mb, (LAS char*)F.lds, F.wave, rope + tok0 * 32, a.in[I_QKQG]); }
    }
}

__device__ __forceinline__ void p8_norm2_router(const Args& a, const Frame& F, const float* x1) {
    FRAME_IDS(F);
    bf16_t* H2 = (bf16_t*)(F.ws + WS_H2); int* topi = (int*)(F.ws + WS_TOPI); float* topw = (float*)(F.ws + WS_TOPW);
    const float* wrp = (const float*)(F.ws + WS_SMALL + SM_WRP); const float* g2 = a.in[I_N2G];
    const int lane = F_lane, wave = F.wave, tid = F_tid, i = lane & 31, kk = lane >> 5;
    LAS uchar* xs = F.lds + wave * 8704;
    LAS float* part = (LAS float*)(F.lds + 69632);
    LAS float* ssqp = (LAS float*)(F.lds + 69632 + 33792);
    LAS float* logit = ssqp + 256;
    LAS float* rstdl = logit + 32 * 33;
    for (int tile = F.bx; tile < TT / 32; tile += F.G) {
        const int t0 = tile * 32;
        f32x16 acc = {}; float ssq = 0.f;
        for (int ch = 0; ch < 4; ++ch) { const int k0 = wave * 256 + ch * 64;
            f32x4 v[8];
#pragma unroll
            for (int j = 0; j < 8; ++j) v[j] = *(const f32x4*)(x1 + (size_t)(t0 + 4 * j + (lane >> 4)) * DM + k0 + (lane & 15) * 4);
#pragma unroll
            for (int j = 0; j < 8; ++j) *(LAS f32x4*)(xs + (4 * j + (lane >> 4)) * 272 + (lane & 15) * 16) = v[j];
            LDS_WAIT(); asm volatile("" ::: "memory");
            const float* wp = wrp + (size_t)(k0 + kk * 32) * NE + i;
#pragma unroll
            for (int s4 = 0; s4 < 8; ++s4) { const f32x4 xv = *(const LAS f32x4*)(xs + i * 272 + kk * 128 + s4 * 16);
#pragma unroll
                for (int q = 0; q < 4; ++q) { const float b = wp[(s4 * 4 + q) * NE]; acc = __builtin_amdgcn_mfma_f32_32x32x2f32(xv[q], b, acc, 0, 0, 0); ssq += xv[q] * xv[q]; } }
            LDS_WAIT(); asm volatile("" ::: "memory");
        }
#pragma unroll
        for (int r = 0; r < 16; ++r) part[(wave * 32 + (r & 3) + 8 * (r >> 2) + 4 * kk) * 33 + i] = acc[r];
        ssq += __shfl_xor(ssq, 32);
        if (kk == 0) ssqp[wave * 32 + i] = ssq;
        __syncthreads();
        { const int row = tid >> 4, e0 = (tid & 15) * 2; float s0 = 0.f, s1 = 0.f;
#pragma unroll
          for (int w = 0; w < 8; ++w) { s0 += part[(w * 32 + row) * 33 + e0]; s1 += part[(w * 32 + row) * 33 + e0 + 1]; }
          logit[row * 33 + e0] = s0; logit[row * 33 + e0 + 1] = s1;
          if (tid < 32) { float q = 0.f;
#pragma unroll
              for (int w = 0; w < 8; ++w) q += ssqp[w * 32 + tid];
              rstdl[tid] = 1.0f / sqrtf(q * (1.0f / DM) + EPS); } }
        __syncthreads();
        if (tid < 32) { const float rs = rstdl[tid]; float lg[32];
#pragma unroll
            for (int e = 0; e < 32; ++e) lg[e] = logit[tid * 33 + e] * rs + a.in[I_BR][e];
            int bi[4]; float bv[4];
#pragma unroll
            for (int k = 0; k < 4; ++k) { float m = -3.0e38f; int mi = 0;
#pragma unroll
                for (int e = 0; e < 32; ++e) { const bool used = (k > 0 && bi[0] == e) || (k > 1 && bi[1] == e) || (k > 2 && bi[2] == e); if (!used && lg[e] > m) { m = lg[e]; mi = e; } }
                bi[k] = mi; bv[k] = m; }
            const float e1 = __expf(bv[1] - bv[0]), e2 = __expf(bv[2] - bv[0]), e3 = __expf(bv[3] - bv[0]); const float rsum = 1.0f / (1.0f + e1 + e2 + e3);
            const int t = t0 + tid;
            *(int4*)(topi + 4 * t) = make_int4(bi[0], bi[1], bi[2], bi[3]); *(float4*)(topw + 4 * t) = make_float4(rsum, e1 * rsum, e2 * rsum, e3 * rsum); }
#pragma unroll 4
        for (int it = 0; it < 16; ++it) { const int idx = it * NTHREADS + tid, row = idx >> 8, c8 = (idx & 255) * 8; const float rs = rstdl[row];
            const f32x4 x0 = *(const f32x4*)(x1 + (size_t)(t0 + row) * DM + c8), x1v = *(const f32x4*)(x1 + (size_t)(t0 + row) * DM + c8 + 4);
            const f32x4 g0 = *(const f32x4*)(g2 + c8), g1 = *(const f32x4*)(g2 + c8 + 4);
#if MK_FP8_MOE
            const float rs4 = rs * FP8_ASCALE; u32x2 o; o.x = pk4_fp8(x0.x * rs4 * g0.x, x0.y * rs4 * g0.y, x0.z * rs4 * g0.z, x0.w * rs4 * g0.w); o.y = pk4_fp8(x1v.x * rs4 * g1.x, x1v.y * rs4 * g1.y, x1v.z * rs4 * g1.z, x1v.w * rs4 * g1.w);
            *(u32x2*)((uchar*)H2 + (size_t)(t0 + row) * DM + c8) = o; }
#else
            u32x4 o; o.x = pk2(x0.x * rs * g0.x, x0.y * rs * g0.y); o.y = pk2(x0.z * rs * g0.z, x0.w * rs * g0.w); o.z = pk2(x1v.x * rs * g1.x, x1v.y * rs * g1.y); o.w = pk2(x1v.z * rs * g1.z, x1v.w * rs * g1.w);
            *(u32x4*)(H2 + (size_t)(t0 + row) * DM + c8) = o; }
#endif
        __syncthreads();
    }
}

__device__ __forceinline__ void p9_routing(const Args& a, const Frame& F) {
    FRAME_IDS(F);
    const int* topi = (const int*)(F.ws + WS_TOPI); int* tpos = (int*)(F.ws + WS_TPOS); int* list = (int*)(F.ws + WS_LIST); int* counts = (int*)(F.ws + WS_SMALL + SM_COUNTS);
    LAS int* wtot = (LAS int*)F.lds;
    constexpr int NIT = TT / NWAVES / 64;
    for (int e = F.bx; e < NE; e += F.G) {
        __syncthreads();
        const int t0 = F.wave * (TT / NWAVES);
        int kk[NIT];
#pragma unroll
        for (int i = 0; i < NIT; ++i) { const int4 ti = *(const int4*)(topi + 4 * (t0 + i * 64 + F_lane)); kk[i] = (ti.x == e) ? 0 : (ti.y == e) ? 1 : (ti.z == e) ? 2 : (ti.w == e) ? 3 : -1; }
        int cnt = 0;
#pragma unroll
        for (int i = 0; i < NIT; ++i) cnt += __popcll(__ballot(kk[i] >= 0));
        if (F_lane == 0) wtot[F.wave] = cnt;
        __syncthreads();
        int base = 0, total = 0;
        for (int w = 0; w < NWAVES; ++w) { const int c = wtot[w]; if (w < F.wave) base += c; total += c; }
#pragma unroll
        for (int i = 0; i < NIT; ++i) { const int t = t0 + i * 64 + F_lane; const int k = kk[i];
            const unsigned long long bal = __ballot(k >= 0); const int pos = base + __popcll(bal & ((1ull << F_lane) - 1ull));
            if (k >= 0) { list[(size_t)e * TT + pos] = t; tpos[4 * t + k] = pos; }
            base += __popcll(bal); }
        for (int q = total + F_tid; q < ((total + 255) & ~255); q += NTHREADS) list[(size_t)e * TT + q] = 0;
        if (F_tid == 0) counts[e] = total;
    }
}
__device__ __forceinline__ void moe_tables(const Frame& F, LAS int* tab) {
    FRAME_IDS(F);
    const int* counts = (const int*)(F.ws + WS_SMALL + SM_COUNTS);
    __syncthreads();
    if (F_tid < NE) { const int c = counts[F_tid]; tab[F_tid] = c; const int nt = (c + 255) >> 8; tab[32 + F_tid] = nt; tab[128 + F_tid] = nt > 0 ? ((1 << 20) + nt - 1) / nt : 0; }
    __syncthreads();
    if (F_tid < NE) { const int e = F_tid, me = tab[32 + e]; int pre = 0, rank = 0;
        for (int q = 0; q < NE; ++q) { const int v = tab[32 + q]; pre += (q < e) ? v : 0; rank += (v > me || (v == me && q < e)) ? 1 : 0; }
        tab[64 + e] = pre; if (e == NE - 1) tab[96] = pre + me;
        const int q4 = rank >> 3, pos = rank & 7, xx = (q4 & 1) ? 7 - pos : pos; tab[160 + xx * 4 + q4] = e; }
    __syncthreads();
}

__device__ __forceinline__ void p10_permute(const Args& a, const Frame& F, const LAS int* tab) {
    FRAME_IDS(F);
    constexpr size_t ROWB = MK_FP8_MOE ? DM : 2 * DM;
    const uchar* H2 = F.ws + WS_H2; uchar* XP = F.ws + WS_XPERM; const int* list = (const int*)(F.ws + WS_LIST);
    const int ntiles = tab[96];
    for (int tile = F.bx; tile < ntiles; tile += F.G) {
        int e = 0;
#pragma unroll 1
        for (int q = 1; q < NE; ++q) if (tab[64 + q] <= tile) e = q;
        const int p0 = (tile - tab[64 + e]) * 256;
        for (int r0 = F.wave * 32; r0 < F.wave * 32 + 32; r0 += 8) { int tok[8]; u32x4 v[8][ROWB / 1024];
#pragma unroll
            for (int q = 0; q < 8; ++q) tok[q] = list[(size_t)e * TT + p0 + r0 + q];
#pragma unroll
            for (int q = 0; q < 8; ++q)
#pragma unroll
                for (int c = 0; c < (int)(ROWB / 1024); ++c) v[q][c] = *(const u32x4*)(H2 + (size_t)tok[q] * ROWB + c * 1024 + F_lane * 16);
#pragma unroll
            for (int q = 0; q < 8; ++q)
#pragma unroll
                for (int c = 0; c < (int)(ROWB / 1024); ++c) *(u32x4*)(XP + ((size_t)tile * 256 + r0 + q) * ROWB + c * 1024 + F_lane * 16) = v[q][c]; }
    }
}

__device__ __forceinline__ void p12_combine(const Args& a, const Frame& F, float* out, const LAS int* tab) {
    FRAME_IDS(F);
    const int* topi = (const int*)(F.ws + WS_TOPI); const float* topw = (const float*)(F.ws + WS_TOPW); const int* tpos = (const int*)(F.ws + WS_TPOS);
    const int lane = F_lane, gw = F.bx * NWAVES + F.wave, NGW = F.G * NWAVES;
#if MK_FP8_MOE
    const uchar* ys = F.ws + WS_YSLOT;
    for (int t = gw; t < TT; t += NGW) {
        const int4 ti = *(const int4*)(topi + 4 * t), tp = *(const int4*)(tpos + 4 * t); float4 tw = *(const float4*)(topw + 4 * t);
        tw.x *= 1.0f / FP8_YSCALE; tw.y *= 1.0f / FP8_YSCALE; tw.z *= 1.0f / FP8_YSCALE; tw.w *= 1.0f / FP8_YSCALE;
        const uchar* r0 = ys + ((size_t)tab[64 + ti.x] * 256 + tp.x) * DM; const uchar* r1 = ys + ((size_t)tab[64 + ti.y] * 256 + tp.y) * DM;
        const uchar* r2 = ys + ((size_t)tab[64 + ti.z] * 256 + tp.z) * DM; const uchar* r3 = ys + ((size_t)tab[64 + ti.w] * 256 + tp.w) * DM;
        float* orow = out + (size_t)t * DM;
        u32x2 y0[4], y1[4], y2[4], y3[4]; f32x4 xa[4], xb[4];
#pragma unroll
        for (int j = 0; j < 4; ++j) { const int c = j * 512 + lane * 8; y0[j] = *(const u32x2*)(r0 + c); y1[j] = *(const u32x2*)(r1 + c); y2[j] = *(const u32x2*)(r2 + c); y3[j] = *(const u32x2*)(r3 + c);
            xa[j] = *(const f32x4*)(orow + c); xb[j] = *(const f32x4*)(orow + c + 4); }
#pragma unroll
        for (int j = 0; j < 4; ++j) { const int c = j * 512 + lane * 8; f32x4 x0 = xa[j], x1 = xb[j];
#define ACC4(X, Y, W) do { const f32x2 lo = __builtin_amdgcn_cvt_pk_f32_fp8((int)(Y), false), hi2 = __builtin_amdgcn_cvt_pk_f32_fp8((int)(Y), true); X[0] += (W) * lo.x; X[1] += (W) * lo.y; X[2] += (W) * hi2.x; X[3] += (W) * hi2.y; } while (0)
            ACC4(x0, y0[j].x, tw.x); ACC4(x1, y0[j].y, tw.x); ACC4(x0, y1[j].x, tw.y); ACC4(x1, y1[j].y, tw.y);
            ACC4(x0, y2[j].x, tw.z); ACC4(x1, y2[j].y, tw.z); ACC4(x0, y3[j].x, tw.w); ACC4(x1, y3[j].y, tw.w);
#undef ACC4
            *(f32x4*)(orow + c) = x0; *(f32x4*)(orow + c + 4) = x1; }
    }
#else
    const bf16_t* ys = (const bf16_t*)(F.ws + WS_YSLOT);
    for (int t = gw; t < TT; t += NGW) {
        const int4 ti = *(const int4*)(topi + 4 * t), tp = *(const int4*)(tpos + 4 * t); const float4 tw = *(const float4*)(topw + 4 * t);
        const bf16_t* r0 = ys + ((size_t)tab[64 + ti.x] * 256 + tp.x) * DM; const bf16_t* r1 = ys + ((size_t)tab[64 + ti.y] * 256 + tp.y) * DM;
        const bf16_t* r2 = ys + ((size_t)tab[64 + ti.z] * 256 + tp.z) * DM; const bf16_t* r3 = ys + ((size_t)tab[64 + ti.w] * 256 + tp.w) * DM;
        float* orow = out + (size_t)t * DM;
#pragma unroll
        for (int j = 0; j < 4; ++j) { const int c = j * 512 + lane * 8;
            const u32x4 a0 = *(const u32x4*)(r0 + c), a1 = *(const u32x4*)(r1 + c), a2 = *(const u32x4*)(r2 + c), a3 = *(const u32x4*)(r3 + c);
            f32x4 x0 = *(const f32x4*)(orow + c), x1 = *(const f32x4*)(orow + c + 4);
#pragma unroll
            for (int q = 0; q < 2; ++q) {
                x0[2 * q] += tw.x * bflo(a0[q]) + tw.y * bflo(a1[q]) + tw.z * bflo(a2[q]) + tw.w * bflo(a3[q]);
                x0[2 * q + 1] += tw.x * bfhi(a0[q]) + tw.y * bfhi(a1[q]) + tw.z * bfhi(a2[q]) + tw.w * bfhi(a3[q]);
                x1[2 * q] += tw.x * bflo(a0[2 + q]) + tw.y * bflo(a1[2 + q]) + tw.z * bflo(a2[2 + q]) + tw.w * bflo(a3[2 + q]);
                x1[2 * q + 1] += tw.x * bfhi(a0[2 + q]) + tw.y * bfhi(a1[2 + q]) + tw.z * bfhi(a2[2 + q]) + tw.w * bfhi(a3[2 + q]); }
            *(f32x4*)(orow + c) = x0; *(f32x4*)(orow + c + 4) = x1; }
    }
#endif
}

constexpr int NPHASE = 14;
__global__ void __launch_bounds__(NTHREADS, 2) mk_fwd(Args a) {
    extern __shared__ __attribute__((aligned(16))) uchar lds_raw[];
    Frame F; F.lds = (LAS uchar*)lds_raw; F.ws = a.ws; F.wave = __builtin_amdgcn_readfirstlane(threadIdx.x >> 6); F.G = gridDim.x; F.bx = blockIdx.x;
    FRAME_IDS(F);
    volatile LAS unsigned* MISC = (volatile LAS unsigned*)(F.lds + MISC_OFF);
    LAS int* tab = (LAS int*)(F.lds + LDSCTL_OFF + 512);
    for (int u = F_tid; u < (LDS_BYTES - LDSCTL_OFF) / 4; u += NTHREADS) ((LAS unsigned*)(F.lds + LDSCTL_OFF))[u] = 0u;
    __syncthreads();
    XcdBarrier bar; bar.bar = (unsigned*)(a.ws + WS_CTL) + CW_BAR; bar.x = 0; bar.st = nullptr; bar.wave = F.wave;
    const int lo = a.ph_lo, hi = a.ph_hi;
    if (hi - lo > 1) bar = xcd_barrier_post((unsigned*)(a.ws + WS_CTL) + CW_BAR, MISC + 8, F.wave);
#ifndef MK_PHASE_MASK
#define MK_PHASE_MASK 0xffff
#endif
#define IN(k) (((MK_PHASE_MASK >> (k)) & 1) && lo <= (k) && (k) < hi)
#ifdef MK_PROBE_LO
    volatile LAS unsigned long long* pr_t = (volatile LAS unsigned long long*)(F.lds + LDSCTL_OFF + 64);
#define PROBE_AT(k) do { if ((k) == MK_PROBE_LO && F.wave == 0 && fresh_lane() == 0) pr_t[0] = __builtin_amdgcn_s_memrealtime(); if ((k) == MK_PROBE_HI + 1 && F.wave == 0 && fresh_lane() == 0) pr_t[1] = __builtin_amdgcn_s_memrealtime(); } while (0)
#else
#define PROBE_AT(k) do { } while (0)
#endif
#define SEAM(k) do { if (IN(k) && IN((k) + 1)) xcd_barrier(bar); } while (0)
    LAS uchar* ring = F.lds;
    uchar* ws = a.ws;
    const int G = F.G, bx = F.bx;

    PROBE_AT(0);
    if (IN(0)) { p0_prologue(a, F); } SEAM(0); PROBE_AT(1);

    if (IN(1)) {
        gm::ProbDense P; P.init((const bf16_t*)(ws + WS_H), DM, (const bf16_t*)(ws + WS_WIN), DM, DM, TT, NPROJ, G, bx);
        EpiInProj E{(bf16_t*)(ws + WS_PROJ), (bf16_t*)(ws + WS_APACK), a.in[I_BG], (float*)(ws + WS_SSQP)};
        gm::gemm_phase<gm::ProbDense, EpiInProj, false>(ring, P, E, F.wave);
    } SEAM(1); PROBE_AT(2);

    if (IN(2)) {
        { gm::ProbDense P; P.init((const bf16_t*)(ws + WS_PROJ) + C_QLAT, NPROJ, (const bf16_t*)(ws + WS_WUQ), QLORA, QLORA, TT, NH * DQK, G, bx);
          EpiStoreScaled<0, 8, QLORA> E{(bf16_t*)(ws + WS_QRAW), NH * DQK, (const float*)(ws + WS_SSQP)}; gm::gemm_phase<gm::ProbDense, EpiStoreScaled<0, 8, QLORA>, false>(ring, P, E, F.wave); }
        { gm::ProbDense P; P.init((const bf16_t*)(ws + WS_PROJ) + C_KVLAT, NPROJ, (const bf16_t*)(ws + WS_WUKV), KVLORA, KVLORA, TT, NH * 256, G, bx);
          EpiKV E{(bf16_t*)(ws + WS_KVRAW), (bf16_t*)(ws + WS_VN), (const float*)(ws + WS_SSQP)}; gm::gemm_phase<gm::ProbDense, EpiKV, false>(ring, P, E, F.wave); }
#if MK_FAST_S5
        { ProbS5 P{(const bf16_t*)(ws + WS_APACK), (const bf16_t*)(ws + WS_WS5), APK, 256, 4, G, bx};
          EpiS5State E{(float*)(ws + WS_SCH)}; gm::gemm_phase<ProbS5, EpiS5State, false>(ring, P, E, F.wave); }
#endif
    } SEAM(2); PROBE_AT(3);

    if (IN(3)) {
#if MK_FAST_S5
        p3_scan(a, F);
#endif
        p3_prep(a, F);
    } SEAM(3); PROBE_AT(4);

    if (IN(4)) {
#if MK_FAST_S5
        { ProbS5 P{(const bf16_t*)(ws + WS_APACK), (const bf16_t*)(ws + WS_TWC), APK, APK, 6, G, bx};
          EpiS5Out E{(bf16_t*)(ws + WS_GACT)}; gm::gemm_phase<ProbS5, EpiS5Out, false>(ring, P, E, F.wave); }
#else
        s5_reference(a, F);
#endif
#if MK_FAST_ATTN
        p4_attention(a, F);
#else
        attn_reference(a, F);
#endif
    } SEAM(4); PROBE_AT(5);

    if (IN(5)) {
        { gm::ProbDense P; P.init((const bf16_t*)(ws + WS_GACT), S5W, (const bf16_t*)(ws + WS_WGLU), S5W, S5W, TT, S5W, G, bx);
          EpiSide<0> E{(bf16_t*)(ws + WS_Y2), S5W, (const bf16_t*)(ws + WS_GACT), S5W, nullptr, 0}; gm::gemm_phase<gm::ProbDense, EpiSide<0>, false>(ring, P, E, F.wave); }
        { gm::ProbDense P; P.init((const bf16_t*)(ws + WS_O), DM, (const bf16_t*)(ws + WS_WOMLA), DM, DM, TT, DM, G, bx);
          EpiSide<1> E{(bf16_t*)(ws + WS_MA), DM, (const bf16_t*)(ws + WS_PROJ) + C_GA, NPROJ, nullptr, 0}; gm::gemm_phase<gm::ProbDense, EpiSide<1>, false>(ring, P, E, F.wave); }
    } SEAM(5); PROBE_AT(6);

    if (IN(6)) {
        gm::ProbDense P; P.init((const bf16_t*)(ws + WS_Y2), S5W, (const bf16_t*)(ws + WS_WOS5), S5W, S5W, TT, DM, G, bx);
        EpiSide<2> E{(bf16_t*)(ws + WS_M), DM, (const bf16_t*)(ws + WS_PROJ) + C_GB, NPROJ, (const bf16_t*)(ws + WS_MA), DM}; gm::gemm_phase<gm::ProbDense, EpiSide<2>, false>(ring, P, E, F.wave);
    } SEAM(6); PROBE_AT(7);

    if (IN(7)) {
        gm::ProbDense P; P.init((const bf16_t*)(ws + WS_M), DM, (const bf16_t*)(ws + WS_WOUT), DM, DM, TT, DM, G, bx);
        EpiResidF32 E{a.in[I_X], a.out}; gm::gemm_phase<gm::ProbDense, EpiResidF32, false>(ring, P, E, F.wave);
    } SEAM(7); PROBE_AT(8);

    if (IN(8)) { p8_norm2_router(a, F, a.out); } SEAM(8); PROBE_AT(9);
    if (IN(9)) { p9_routing(a, F); } SEAM(9); PROBE_AT(10);

    if (IN(10) || IN(11) || IN(12) || IN(13)) moe_tables(F, tab);
    const int xl = bx & 7, rk = bx >> 3, nrk = (G - xl + 7) >> 3;
    if (IN(10)) { p10_permute(a, F, tab); } SEAM(10); PROBE_AT(11);
    if (IN(11)) {
        ProbMoE P{(const bf16_t*)(ws + WS_XPERM), (const bf16_t*)(ws + WS_W1), DM, DM, MK_FP8_MOE ? DM / 128 : DM / 64, 16, (size_t)4096 * DM, xl, rk, nrk}; P.load(tab);
        EpiSwiglu E{(bf16_t*)(ws + WS_HACT), a.in[I_BGATE], a.in[I_BUP], tab}; gm::gemm_phase<ProbMoE, EpiSwiglu, false, MK_FP8_MOE != 0>(ring, P, E, F.wave);
    } SEAM(11); PROBE_AT(12);
    if (IN(12)) {
        ProbMoE P{(const bf16_t*)(ws + WS_HACT), (const bf16_t*)(ws + WS_W2), DFF, DFF, MK_FP8_MOE ? DFF / 128 : DFF / 64, 8, (size_t)DM * DFF, xl, rk, nrk}; P.load(tab);
        EpiDown E{(bf16_t*)(ws + WS_YSLOT), a.in[I_BDOWN], tab}; gm::gemm_phase<ProbMoE, EpiDown, false, MK_FP8_MOE != 0>(ring, P, E, F.wave);
    } SEAM(12); PROBE_AT(13);
    if (IN(13)) { p12_combine(a, F, a.out, tab); }
    PROBE_AT(14);
#ifdef MK_PROBE_LO
    if (blockIdx.x == 0 && F.wave == 0 && fresh_lane() == 0) { const unsigned long long dt = (pr_t[1] - pr_t[0]) * MK_PROBE_X, te = __builtin_amdgcn_s_memrealtime();
        while (__builtin_amdgcn_s_memrealtime() - te < dt) __builtin_amdgcn_s_sleep(32); }
#endif
#undef IN
#undef SEAM
}

extern "C" void kernel_launch(void* const* d_in, const int* in_sizes, int n_in, void* d_out, int out_size, void* d_ws, size_t ws_size, hipStream_t stream) {
    static int grid = 0;
    if (grid == 0) {
        if (n_in != 32 || in_sizes[0] != TT * DM || out_size != TT * DM || ws_size < WS_END) {
            fprintf(stderr, "kernel_launch: shape mismatch: n_in %d in0 %d out %d ws %zu (need %zu); nothing launched\n", n_in, n_in > 0 ? in_sizes[0] : -1, out_size, ws_size, (size_t)WS_END); grid = -1; return; }
        int dev = 0, cus = 0, per_cu = 0;
        if (hipGetDevice(&dev) != hipSuccess || hipDeviceGetAttribute(&cus, hipDeviceAttributeMultiprocessorCount, dev) != hipSuccess) { fprintf(stderr, "kernel_launch: device query failed\n"); grid = -1; return; }
        if (hipFuncSetAttribute((const void*)mk_fwd, hipFuncAttributeMaxDynamicSharedMemorySize, LDS_BYTES) != hipSuccess) { fprintf(stderr, "kernel_launch: hipFuncSetAttribute failed\n"); grid = -1; return; }
        if (hipOccupancyMaxActiveBlocksPerMultiprocessor(&per_cu, (const void*)mk_fwd, NTHREADS, LDS_BYTES) != hipSuccess || per_cu < 1)
            fprintf(stderr, "kernel_launch: note: occupancy query reports %d workgroups per CU\n", per_cu);
        (void)hipGetLastError();
        grid = cus - (cus % 8);
        if (grid < 8) grid = 8;
    }
    if (grid < 0) return;
    if (hipMemsetAsync((char*)d_ws + WS_CTL, 0, CTL_ZERO_BYTES, stream) != hipSuccess) { fprintf(stderr, "kernel_launch: memset failed\n"); return; }
    Args a{};
    for (int i = 0; i < 32; ++i) a.in[i] = (const float*)d_in[i];
    a.out = (float*)d_out; a.ws = (uchar*)d_ws;
#if MK_ONE_LAUNCH
    a.ph_lo = 0; a.ph_hi = NPHASE;
    hipLaunchKernelGGL(mk_fwd, dim3(grid), dim3(NTHREADS), LDS_BYTES, stream, a);
#else
    for (int p = 0; p < NPHASE; ++p) { a.ph_lo = p; a.ph_hi = p + 1; hipLaunchKernelGGL(mk_fwd, dim3(grid), dim3(NTHREADS), LDS_BYTES, stream, a); }
#endif
    const hipError_t le = hipPeekAtLastError();
    if (le != hipSuccess) fprintf(stderr, "kernel_launch: launch failed: %s\n", hipGetErrorName(le));
}
```

```cpp
#include <hip/hip_runtime.h>
#include <cstdio>
#include <cstdint>

#ifndef MK_ONE_LAUNCH
#define MK_ONE_LAUNCH 1
#endif
#ifndef MK_FAST_GEMM
#define MK_FAST_GEMM 1
#endif
#ifndef MK_FAST_ATTN
#define MK_FAST_ATTN 1
#endif
#ifndef MK_FAST_S5
#define MK_FAST_S5 1
#endif

#ifndef MK_FP8_MOE
#define MK_FP8_MOE 1
#endif
#define LAS __attribute__((address_space(3)))
#define GAS __attribute__((address_space(1)))
typedef unsigned short bf16_t;
typedef short bf16x8 __attribute__((ext_vector_type(8)));
typedef short s16x4 __attribute__((ext_vector_type(4)));
typedef float f32x2 __attribute__((ext_vector_type(2)));
typedef float f32x4 __attribute__((ext_vector_type(4)));
typedef float f32x16 __attribute__((ext_vector_type(16)));
typedef unsigned u32x2 __attribute__((ext_vector_type(2)));
typedef unsigned u32x4 __attribute__((ext_vector_type(4)));
typedef unsigned char uchar;
typedef int v4i __attribute__((ext_vector_type(4)));
typedef int v8i __attribute__((ext_vector_type(8)));
constexpr float FP8_YSCALE = 16.0f;
#ifndef MK_FP8_INPROJ
#define MK_FP8_INPROJ 1
#endif
constexpr float FP8_ASCALE = 4.0f, FP8_WSCALE = 64.0f;
__device__ __forceinline__ unsigned pk4_fp8(float a, float b, float c, float d) { int w = __builtin_amdgcn_cvt_pk_fp8_f32(a, b, 0, false); w = __builtin_amdgcn_cvt_pk_fp8_f32(c, d, w, true); return (unsigned)w; }

constexpr int NB = 8, SEQ = 2048, TT = NB * SEQ, DM = 2048;
constexpr int NH = 16, DNOPE = 128, DROPE = 64, DQK = 192, DV = 128, QLORA = 512, KVLORA = 256;
constexpr int S5W = 1024, S5G = 64, S5C = 16, S5P = 64, S5L = 16;
constexpr int NE = 32, TOPK = 4, DFF = 2048;
constexpr int IN_PROJ = QLORA + KVLORA + DROPE + S5W + 2 * DM;
constexpr int NPROJ = 6144;
constexpr int C_QLAT = 0, C_KVLAT = 512, C_U = 768, C_GA = 1792, C_GB = 3840, C_KR = 5888;
constexpr float EPS = 1e-6f;
constexpr int MAXSLOT_TILES = (TT * TOPK) / 256 + NE;
constexpr int MAXSLOTS = MAXSLOT_TILES * 256;
constexpr int NCHUNK = TT / S5L;
constexpr int APK = 384;

constexpr size_t MiB = 1u << 20;
constexpr size_t WS_CTL = 0, CTL_ZERO_BYTES = 1 * MiB;
constexpr size_t WS_WIN = 1 * MiB;
constexpr size_t WS_WUQ = WS_WIN + 24 * MiB;
constexpr size_t WS_WUKV = WS_WUQ + 3 * MiB;
constexpr size_t WS_WOMLA = WS_WUKV + 2 * MiB;
constexpr size_t WS_WGLU = WS_WOMLA + 8 * MiB;
constexpr size_t WS_WOS5 = WS_WGLU + 2 * MiB;
constexpr size_t WS_WOUT = WS_WOS5 + 4 * MiB;
constexpr size_t WS_TWC = WS_WOUT + 8 * MiB;
constexpr size_t WS_WS5 = WS_TWC + 12 * MiB;
constexpr size_t WS_ROPE = WS_WS5 + 8 * MiB;
constexpr size_t WS_SMALL = WS_ROPE + 4 * MiB;
constexpr size_t WS_W1 = WS_SMALL + 1 * MiB;
constexpr size_t WS_W2 = WS_W1 + 512 * MiB;
constexpr size_t WS_ACT = WS_W2 + 256 * MiB;
constexpr size_t WS_H = WS_ACT;
constexpr size_t WS_PROJ = WS_H + 64 * MiB;
constexpr size_t WS_APACK = WS_PROJ + 192 * MiB;
constexpr size_t WS_SCH = WS_APACK + 48 * MiB;
constexpr size_t WS_QRAW = WS_SCH + 32 * MiB;
constexpr size_t WS_KVRAW = WS_QRAW + 96 * MiB;
constexpr size_t WS_QN = WS_KVRAW + 128 * MiB;
constexpr size_t WS_KN = WS_QN + 96 * MiB;
constexpr size_t WS_VN = WS_KN + 96 * MiB;
constexpr size_t WS_O = WS_VN + 64 * MiB;
constexpr size_t WS_GACT = WS_O + 64 * MiB;
constexpr size_t WS_Y2 = WS_GACT + 32 * MiB;
constexpr size_t WS_MA = WS_Y2 + 32 * MiB;
constexpr size_t WS_M = WS_MA + 64 * MiB;
constexpr size_t WS_SSQP = WS_M + 64 * MiB;
constexpr size_t WS_ENDA = WS_SSQP + 1 * MiB;
constexpr size_t WS_H2 = WS_ACT;
constexpr size_t WS_HACT = WS_H2 + 64 * MiB;
constexpr size_t WS_YSLOT = WS_HACT + 288 * MiB;
constexpr size_t WS_TOPI = WS_YSLOT + 288 * MiB;
constexpr size_t WS_TOPW = WS_TOPI + 1 * MiB;
constexpr size_t WS_TPOS = WS_TOPW + 1 * MiB;
constexpr size_t WS_LIST = WS_TPOS + 1 * MiB;
constexpr size_t WS_XPERM = WS_ACT + 704 * MiB;
constexpr size_t WS_ENDB = WS_XPERM + 288 * MiB;
constexpr size_t WS_END = WS_ENDA > WS_ENDB ? WS_ENDA : WS_ENDB;
constexpr size_t SM_A16 = 0;
constexpr size_t SM_COUNTS = 64 * 1024;
constexpr size_t SM_WRP = 128 * 1024;
constexpr int CW_BAR = 4096;

constexpr int RING_BYTES = 131072;
constexpr int LDS_BYTES = 163840;
constexpr int LDSCTL_OFF = LDS_BYTES - 4096;
constexpr int MISC_OFF = LDSCTL_OFF;
constexpr int GTAB_OFF = LDSCTL_OFF + 2048;
constexpr int NWAVES = 8, NTHREADS = 512;

#define LDS_WAIT() asm volatile("s_waitcnt lgkmcnt(0)" ::: "memory")
#define VM_WAIT() asm volatile("s_waitcnt vmcnt(0)" ::: "memory")
#define SBAR() __builtin_amdgcn_sched_barrier(0)

__device__ __forceinline__ unsigned f2bf(float f) { unsigned u = __builtin_bit_cast(unsigned, f); return (u + 0x7fffu + ((u >> 16) & 1u)) >> 16; }
__device__ __forceinline__ unsigned pk2(float lo, float hi) { return f2bf(lo) | (f2bf(hi) << 16); }
__device__ __forceinline__ float bf2f(unsigned b) { return __builtin_bit_cast(float, b << 16); }
__device__ __forceinline__ float bflo(unsigned w) { return __builtin_bit_cast(float, w << 16); }
__device__ __forceinline__ float bfhi(unsigned w) { return __builtin_bit_cast(float, w & 0xffff0000u); }
__device__ __forceinline__ unsigned cvt_pk_bf16(float lo, float hi) { unsigned r; asm volatile("v_cvt_pk_bf16_f32 %0, %1, %2" : "=v"(r) : "v"(lo), "v"(hi)); return r; }
__device__ __forceinline__ float sigmoidf_(float x) { return __builtin_amdgcn_rcpf(1.0f + __builtin_amdgcn_exp2f(-1.4426950408889634f * x)); }
__device__ __forceinline__ f32x2 sig2_t(f32x2 t) { f32x2 d; d.x = __builtin_amdgcn_exp2f(t.x); d.y = __builtin_amdgcn_exp2f(t.y); d = d + 1.0f; f32x2 r; r.x = __builtin_amdgcn_rcpf(d.x); r.y = __builtin_amdgcn_rcpf(d.y); return r; }
__device__ __forceinline__ f32x2 gelu_tanh2(f32x2 x) { constexpr float C = -2.0f * 0.7978845608028654f * 1.4426950408889634f; const f32x2 p = (x * x) * (C * 0.044715f) + C; return x * sig2_t(x * p); }
__device__ __forceinline__ float gelu_tanh(float x) {
    const float u = 0.7978845608028654f * (x + 0.044715f * x * x * x);
    const float e = __builtin_amdgcn_exp2f(2.8853900817779268f * u);
    const float th = 1.0f - 2.0f * __builtin_amdgcn_rcpf(e + 1.0f);
    return 0.5f * x * (1.0f + th);
}
__device__ __forceinline__ int fresh_lane() { int z = 0; asm volatile("" : "+s"(z)); return (int)__builtin_amdgcn_mbcnt_hi(~0u, __builtin_amdgcn_mbcnt_lo(~0u, (unsigned)z)); }
__device__ __forceinline__ float wave_sum(float v) {
#pragma unroll
    for (int o = 1; o < 64; o <<= 1) v += __shfl_xor(v, o);
    return v;
}

#define XB_TMO      128
#define XB_XCNT(j)  (256  + 64 * (j))
#define XB_XSUB(j)  (1280 + 64 * (j))
#define XB_XGEN(j)  (2304 + 64 * (j))
#define XB_TOP      3328
#define XB_TOPGEN   3392
#define XCD_BAR_WORDS 3456
#define XB_SPIN_CAP (1u << 18)
__device__ __forceinline__ unsigned xb_ld(unsigned* p)              { return __hip_atomic_load(p, __ATOMIC_RELAXED, __HIP_MEMORY_SCOPE_AGENT); }
__device__ __forceinline__ unsigned xb_add(unsigned* p, unsigned v) { return __hip_atomic_fetch_add(p, v, __ATOMIC_RELAXED, __HIP_MEMORY_SCOPE_AGENT); }
__device__ __forceinline__ unsigned xb_xcc_id() { return (unsigned)__builtin_amdgcn_s_getreg((3 << 11) | 20) & 0xFu; }
#define XB_SPIN(cond, bar) do { unsigned _sp = 0; while (cond) { __builtin_amdgcn_s_sleep(1); \
    if ((++_sp & 255u) == 0u) { if (xb_ld(&(bar)[XB_TMO])) break; if (_sp > XB_SPIN_CAP) { atomicAdd(&(bar)[XB_TMO], 1u); break; } } } } while (0)
struct XcdBarrier { unsigned* bar; unsigned x; volatile LAS unsigned* st; int wave; };
__device__ __forceinline__ XcdBarrier xcd_barrier_post(unsigned* bar, volatile LAS unsigned* st, int wave) {
    XcdBarrier b; b.bar = bar; b.x = xb_xcc_id(); b.st = st; b.wave = wave;
    if (wave == 0 && fresh_lane() == 0) (void)xb_add(&bar[XB_XCNT(b.x)], 1u);
    return b;
}
__device__ __forceinline__ void xcd_barrier_complete(unsigned* bar, unsigned x, unsigned& nloc, unsigned& nx) {
    const unsigned G = gridDim.x * gridDim.y * gridDim.z;
    unsigned sum, cnt, mine, sp = 0u;
    for (;;) {
        sum = 0u; cnt = 0u; mine = 0u;
#pragma unroll
        for (unsigned j = 0; j < 16; ++j) { const unsigned c = xb_ld(&bar[XB_XCNT(j)]); sum += c; cnt += (c > 0u) ? 1u : 0u; mine = (j == x) ? c : mine; }
        if (sum == G) break;
        __builtin_amdgcn_s_sleep(1);
        if ((++sp & 255u) == 0u) { if (xb_ld(&bar[XB_TMO])) break; if (sp > XB_SPIN_CAP) { atomicAdd(&bar[XB_TMO], 1u); break; } }
    }
    nloc = mine > 0u ? mine : 1u; nx = cnt > 0u ? cnt : 1u;
}
__device__ __forceinline__ void xcd_barrier(const XcdBarrier& b) {
    asm volatile("s_waitcnt vmcnt(0)" ::: "memory");
    __syncthreads();
    if (b.wave == 0 && fresh_lane() == 0) {
        unsigned* bar = b.bar;
        __builtin_amdgcn_s_waitcnt(0);
        unsigned nloc = b.st[0], nx = b.st[1];
        if (nloc == 0u) { xcd_barrier_complete(bar, b.x, nloc, nx); b.st[0] = nloc; b.st[1] = nx; }
        const unsigned old = xb_add(&bar[XB_XSUB(b.x)], 1u);
        const unsigned gen = old / nloc;
        if (old + 1u == (gen + 1u) * nloc) {
            __builtin_amdgcn_fence(__ATOMIC_RELEASE, "agent");
            asm volatile("s_waitcnt vmcnt(0)" ::: "memory");
            const unsigned og = xb_add(&bar[XB_TOP], 1u);
            const unsigned tg = og / nx;
            if (og + 1u == (tg + 1u) * nx) xb_add(&bar[XB_TOPGEN], 1u);
            else XB_SPIN(xb_ld(&bar[XB_TOPGEN]) == tg, bar);
            __builtin_amdgcn_fence(__ATOMIC_ACQUIRE, "agent");
            xb_add(&bar[XB_XGEN(b.x)], 1u);
            asm volatile("s_waitcnt vmcnt(0)" ::: "memory");
        } else {
            XB_SPIN(xb_ld(&bar[XB_XGEN(b.x)]) == gen, bar);
            __builtin_amdgcn_fence(__ATOMIC_ACQUIRE, "agent");
            asm volatile("s_waitcnt vmcnt(0)" ::: "memory");
        }
    }
    __syncthreads();
}

constexpr float INPROJ_DS = MK_FP8_INPROJ ? 1.0f / (FP8_ASCALE * FP8_WSCALE) : 1.0f;
#ifndef MK_DUP
#define MK_DUP 0
#endif
namespace gm {
constexpr int BM = 256, BK = 64, HALF = 128, HTB = HALF * BK * 2, STAGE_BYTES = 8 * HTB, NXCD = 8, WGM = 8;
__host__ __device__ __forceinline__ int lds_byte(int r, int c) { const int st = (r >> 4) * 2 + (c >> 5), rr = r & 15, cc = c & 31, ob = rr * 64 + cc * 2; return st * 1024 + (ob ^ (((ob >> 9) & 1) << 5)); }
__host__ __device__ __forceinline__ void stage_rc(int b, int& R, int& C) { const int st = b / 1024, sb = b % 1024, swz = sb ^ (((sb >> 9) & 1) << 5); R = (st >> 1) * 16 + swz / 64; C = (st & 1) * 32 + (swz % 64) / 2; }
__host__ __device__ __forceinline__ int perm32(int rho) { const int n = rho >> 4, i = rho & 15; return 8 * (i >> 2) + 4 * n + (i & 3); }

struct Unit { int pm, pn, g, st; };


struct ProbDense {
    const bf16_t* A; const bf16_t* B; int lda, ldb, nt; int nM, nN, nwg, G, c; const int* list = nullptr; const LAS int* gtab = nullptr;
    __device__ unsigned list_off(const Unit&) const { return 0u; }
    __device__ void init(const bf16_t* A_, int lda_, const bf16_t* B_, int ldb_, int K, int M, int N, int G_, int c_) { A = A_; B = B_; lda = lda_; ldb = ldb_; nt = K / BK; nM = M / BM; nN = N / BM; nwg = nM * nN; G = G_; c = c_; }
    __device__ bool next(int i, Unit& u) const {
        const long L = (long)i * G + c; if (L >= nwg) return false;
        int wgid = (int)L; { const int q = nwg / NXCD, r = nwg % NXCD, xcd = wgid % NXCD, off = wgid / NXCD; wgid = (xcd < r ? xcd * (q + 1) : r * (q + 1) + (xcd - r) * q) + off; }
        const int nig = WGM * nN, gid = wgid / nig, fm = gid * WGM, gsz = (nM - fm) < WGM ? (nM - fm) : WGM;
        u.pm = fm + ((wgid % nig) % gsz); u.pn = (wgid % nig) / gsz; u.g = 0; u.st = 0; return true;
    }
    __device__ size_t a_off(const Unit& u) const { return (size_t)u.pm * BM * lda; }
    __device__ size_t b_off(const Unit& u) const { return (size_t)u.pn * BM * ldb; }
    __device__ unsigned a_row(const Unit&, int) const { return 0u; }
};

#if MK_FAST_GEMM
template <class Prob, class Epi, bool GATHER, bool FP8 = false>
__device__ __forceinline__ void gemm_phase(LAS uchar* lds, const Prob& S, const Epi& E, const int wid  ) {
    constexpr unsigned ESZ = FP8 ? 1u : 2u;
    const int lane = fresh_lane(), tid = wid * 64 + lane, wr = wid >> 2, wc = wid & 3, fr = lane & 15, fq = lane >> 4;
    const int nt = S.nt;
    int Ra[2], Ca[2]; unsigned vB;
    { int R, C; stage_rc(tid * 16, R, C); const int Rb = Epi::PERM ? ((R & ~31) + perm32(R & 31)) : R; Ra[0] = R; Ca[0] = C; Ra[1] = R + 64; Ca[1] = C;
      vB = (unsigned)(Rb * S.ldb) * ESZ + (unsigned)C * 2u; }
    const unsigned dB64 = 64u * (unsigned)S.ldb * ESZ, dA64 = 64u * (unsigned)S.lda * ESZ, dA128 = 2u * dA64;
    constexpr unsigned kstep = BK * 2;
    const unsigned hstepB = (unsigned)HALF * (unsigned)S.ldb * ESZ;
    const unsigned ldsw = (unsigned)wid * 1024u;
    const int aoff = lds_byte(wr * 64 + fr, fq * 8), boff = lds_byte(wc * 32 + fr, fq * 8);
    const __amdgpu_buffer_rsrc_t srdA = __builtin_amdgcn_make_buffer_rsrc((void*)S.A, 0, 0xFFFFFFFF, 0x00020000);
    const __amdgpu_buffer_rsrc_t srdB = __builtin_amdgcn_make_buffer_rsrc((void*)S.B, 0, 0xFFFFFFFF, 0x00020000);
#define G_SA(b, h) (((b) * 2 + (h)) * HTB)
#define G_SB(b, h) ((4 + (b) * 2 + (h)) * HTB)
#define G_STAGE(bufoff, srd, soff, voff) do { _Pragma("unroll") for (int _i = 0; _i < 2; ++_i) \
        __builtin_amdgcn_raw_ptr_buffer_load_lds(srd, (LAS void*)(lds + (bufoff) + ldsw + _i * 8192), 16, (int)(voff)[_i], (int)(soff), 0, 0); } while (0)
#define G_STAGE1(bufoff, srd, soff, v1, d64) do { _Pragma("unroll") for (int _i = 0; _i < 2; ++_i) \
        __builtin_amdgcn_raw_ptr_buffer_load_lds(srd, (LAS void*)(lds + (bufoff) + ldsw + _i * 8192), 16, (int)(v1), (int)((soff) + _i * (d64)), 0, 0); } while (0)
#define G_STAGE_A(bufoff, soff, half, arr0, arr1) do { if constexpr (GATHER) { if (half) G_STAGE(bufoff, srdA, soff, arr1); else G_STAGE(bufoff, srdA, soff, arr0); } \
        else G_STAGE1(bufoff, srdA, (soff) + (half) * dA128, vA, dA64); } while (0)
#define G_LDA(dst, b, h) do { _Pragma("unroll") for (int m = 0; m < 4; ++m) _Pragma("unroll") for (int k = 0; k < 2; ++k) dst[m][k] = *(const LAS bf16x8*)(lds + G_SA(b, h) + aoff + m * 2048 + k * 1024); } while (0)
#define G_LDB(dst, b, h) do { _Pragma("unroll") for (int n = 0; n < 2; ++n) _Pragma("unroll") for (int k = 0; k < 2; ++k) dst[n][k] = *(const LAS bf16x8*)(lds + G_SB(b, h) + boff + n * 2048 + k * 1024); } while (0)
#define G_CAT(x0, x1) __builtin_shufflevector(__builtin_bit_cast(v4i, x0), __builtin_bit_cast(v4i, x1), 0, 1, 2, 3, 4, 5, 6, 7)
#define G_MMA(ai, bj, At, Bt) do { __builtin_amdgcn_s_setprio(1); _Pragma("unroll") for (int m = 0; m < 4; ++m) _Pragma("unroll") for (int n = 0; n < 2; ++n) { \
        if constexpr (FP8) acc[ai][bj][m][n] = __builtin_amdgcn_mfma_scale_f32_16x16x128_f8f6f4(G_CAT(Bt[n][0], Bt[n][1]), G_CAT(At[m][0], At[m][1]), acc[ai][bj][m][n], 0, 0, 0, 0x7f7f7f7f, 0, 0x7f7f7f7f); \
        else { _Pragma("unroll") for (int k = 0; k < 2; ++k) acc[ai][bj][m][n] = __builtin_amdgcn_mfma_f32_16x16x32_bf16(Bt[n][k], At[m][k], acc[ai][bj][m][n], 0, 0, 0); } } \
        __builtin_amdgcn_s_setprio(0); } while (0)
#define G_WAIT_V(n) asm volatile("s_waitcnt vmcnt(" #n ")" ::: "memory")
#define G_WAIT_L(n) asm volatile("s_waitcnt lgkmcnt(" #n ")" ::: "memory")
#define G_BAR __builtin_amdgcn_s_barrier()
#define G_SCHED __builtin_amdgcn_sched_barrier(0)
#define G_UNI(x) ((unsigned)__builtin_amdgcn_readfirstlane((int)(x)))
    Unit cur, nxt; int ui = 0;
    if (!S.next(0, cur)) return;
    unsigned vA0[2], vA1[2];
    unsigned cA = 0u, cB = G_UNI(S.b_off(cur) * ESZ);
    __amdgpu_buffer_rsrc_t srdL = srdA;
    if constexpr (GATHER) srdL = __builtin_amdgcn_make_buffer_rsrc((void*)S.list, 0, 0xFFFFFFFF, 0x00020000);
#define G_IDX(u_) do { if (wid < 4) __builtin_amdgcn_raw_ptr_buffer_load_lds(srdL, (LAS void*)(S.gtab + wid * 64), 4, lane * 4, (int)G_UNI(S.list_off(u_) * 4u) + wid * 256, 0, 0); } while (0)
    const int gR = (int)(uintptr_t)S.gtab + Ra[0] * 4; const unsigned gC = (unsigned)Ca[0] * 2u;
#define G_ROWS(o0, o1) do { const LAS int* _g = (const LAS int*)gR; const unsigned _ls = (unsigned)S.lda * ESZ; \
        o0[0] = (unsigned)_g[0] * _ls + gC; o0[1] = (unsigned)_g[64] * _ls + gC; o1[0] = (unsigned)_g[128] * _ls + gC; o1[1] = (unsigned)_g[192] * _ls + gC; } while (0)
    if constexpr (GATHER) { G_IDX(cur); G_WAIT_V(0); G_BAR; G_ROWS(vA0, vA1); G_WAIT_L(0); G_BAR; }
    else { cA = G_UNI(S.a_off(cur) * ESZ);
#pragma unroll
        for (int i = 0; i < 2; ++i) { vA0[i] = 0u; vA1[i] = 0u; } }
    const unsigned vA = (unsigned)(Ra[0] * S.lda) * ESZ + (unsigned)Ca[0] * 2u;
    G_STAGE1(G_SB(0, 0), srdB, cB, vB, dB64); G_STAGE_A(G_SA(0, 0), cA, 0, vA0, vA1); G_STAGE1(G_SB(0, 1), srdB, cB + hstepB, vB, dB64); G_STAGE_A(G_SA(0, 1), cA, 1, vA0, vA1);
    if (wr == 1) G_BAR;
    G_WAIT_V(4); G_BAR;
    G_STAGE1(G_SB(1, 0), srdB, cB + kstep, vB, dB64); G_STAGE_A(G_SA(1, 0), cA + kstep, 0, vA0, vA1); G_STAGE1(G_SB(1, 1), srdB, cB + hstepB + kstep, vB, dB64);
    G_WAIT_V(6); G_BAR;
    f32x4 acc[2][2][4][2];
#pragma unroll
    for (int a = 0; a < 2; ++a)
#pragma unroll
        for (int b = 0; b < 2; ++b)
#pragma unroll
            for (int m = 0; m < 4; ++m)
#pragma unroll
                for (int n = 0; n < 2; ++n) acc[a][b][m][n] = (f32x4){0.f, 0.f, 0.f, 0.f};
    bf16x8 At[4][2], B0[2][2], B1[2][2];
    for (;;) {
        const bool has_next = S.next(ui + 1, nxt);
        unsigned nA = cA, nB = cB; unsigned x0[2] = {0u, 0u}, x1[2] = {0u, 0u};
        if (has_next) { nB = G_UNI(S.b_off(nxt) * ESZ);
            if constexpr (GATHER) G_IDX(nxt);
            else nA = G_UNI(S.a_off(nxt) * ESZ);
        }
#define G_TRIP(LAST) do { \
            const unsigned a1 = cA + (unsigned)(t + 1) * kstep; \
            const unsigned a2 = (LAST) ? nA : cA + (unsigned)(t + 2) * kstep, b2 = (LAST) ? nB : cB + (unsigned)(t + 2) * kstep; \
            const unsigned a3 = a2 + kstep, b3 = b2 + kstep; \
            unsigned w0[2], w1[2]; \
            _Pragma("unroll") for (int i = 0; i < 2; ++i) { w0[i] = vA0[i]; w1[i] = vA1[i]; } \
            if constexpr (GATHER) { if ((LAST) && has_next) { G_ROWS(w0, w1); _Pragma("unroll") for (int i = 0; i < 2; ++i) { x0[i] = w0[i]; x1[i] = w1[i]; } } } \
              G_LDB(B0, 0, 0); G_SCHED; G_LDA(At, 0, 0); G_STAGE_A(G_SA(1, 1), a1, 1, vA0, vA1); \
            G_WAIT_L(8); G_BAR; G_WAIT_L(0); G_MMA(0, 0, At, B0); G_BAR; G_SCHED; \
              G_LDB(B1, 0, 1); G_STAGE1(G_SB(0, 0), srdB, b2, vB, dB64); \
            G_BAR; G_WAIT_L(0); G_MMA(0, 1, At, B1); G_BAR; \
              G_LDA(At, 0, 1); G_STAGE_A(G_SA(0, 0), a2, 0, w0, w1); \
            G_BAR; G_WAIT_L(0); G_MMA(1, 0, At, B0); G_BAR; G_SCHED; \
              G_STAGE1(G_SB(0, 1), srdB, b2 + hstepB, vB, dB64); \
            G_WAIT_V(6); G_BAR; G_MMA(1, 1, At, B1); G_BAR; \
              G_LDB(B0, 1, 0); G_SCHED; G_LDA(At, 1, 0); G_STAGE_A(G_SA(0, 1), a2, 1, w0, w1); \
            G_WAIT_L(8); G_BAR; G_WAIT_L(0); G_MMA(0, 0, At, B0); G_BAR; G_SCHED; \
              G_LDB(B1, 1, 1); G_STAGE1(G_SB(1, 0), srdB, b3, vB, dB64); \
            G_BAR; G_WAIT_L(0); G_MMA(0, 1, At, B1); G_BAR; \
              G_LDA(At, 1, 1); G_STAGE_A(G_SA(1, 0), a3, 0, w0, w1); \
            G_BAR; G_WAIT_L(0); G_MMA(1, 0, At, B0); G_BAR; G_SCHED; \
              G_STAGE1(G_SB(1, 1), srdB, b3 + hstepB, vB, dB64); \
            G_WAIT_V(6); G_BAR; G_MMA(1, 1, At, B1); G_BAR; } while (0)
        for (int t = 0; t < nt; t += 2) { const bool last = (t == nt - 2); G_TRIP(last); }
        if (wr == 0) G_BAR;
        { const int lane2 = fresh_lane();
          if (!(FP8 && MK_DUP && (ui & 1) == 0)) E(acc, cur, wid >> 2, wid & 3, lane2 & 15, lane2 >> 4); }
        if (!has_next) break;
#pragma unroll
        for (int a = 0; a < 2; ++a)
#pragma unroll
            for (int b = 0; b < 2; ++b)
#pragma unroll
                for (int m = 0; m < 4; ++m)
#pragma unroll
                    for (int n = 0; n < 2; ++n) acc[a][b][m][n] = (f32x4){0.f, 0.f, 0.f, 0.f};
        cur = nxt; cA = nA; cB = nB; ++ui;
        if (wr == 1) G_BAR;
        if constexpr (GATHER) {
#pragma unroll
            for (int i = 0; i < 2; ++i) { vA0[i] = x0[i]; vA1[i] = x1[i]; } }
    }
    G_WAIT_V(0);
    G_BAR;
#undef G_SA
#undef G_SB
#undef G_STAGE
#undef G_STAGE1
#undef G_STAGE_A
#undef G_LDA
#undef G_LDB
#undef G_MMA
#undef G_CAT
#undef G_WAIT_V
#undef G_WAIT_L
#undef G_BAR
#undef G_SCHED
#undef G_UNI
#undef G_TRIP
#undef G_IDX
#undef G_ROWS
}
#else
template <class Prob, class Epi, bool GATHER, bool FP8 = false>
__device__ __forceinline__ void gemm_phase(LAS uchar* lds, const Prob& S, const Epi& E, const int wid) {
    const int lane = fresh_lane(), tid = wid * 64 + lane, wr = wid >> 2, wc = wid & 3, fr = lane & 15, fq = lane >> 4;
    LAS float* As = (LAS float*)lds; LAS float* Bs = As + 256 * 33;
    Unit u;
    for (int ui = 0; S.next(ui, u); ++ui) {
        float acc[2][2][4][2][4];
#pragma unroll
        for (int a = 0; a < 2; ++a)
#pragma unroll
            for (int b = 0; b < 2; ++b)
#pragma unroll
                for (int m = 0; m < 4; ++m)
#pragma unroll
                    for (int n = 0; n < 2; ++n)
#pragma unroll
                        for (int j = 0; j < 4; ++j) acc[a][b][m][n][j] = 0.f;
        const int lr = tid >> 1, lk = (tid & 1) * 16;
        const bf16_t* ap = GATHER ? (S.A + S.a_row(u, lr)) : (S.A + S.a_off(u) + (size_t)lr * S.lda);
        const bf16_t* bp = S.B + S.b_off(u) + (size_t)lr * S.ldb;
        for (int k0 = 0; k0 < S.nt * 64; k0 += 32) {
            __syncthreads();
            const u32x4 a0 = *(const u32x4*)(ap + k0 + lk), a1 = *(const u32x4*)(ap + k0 + lk + 8);
            const u32x4 b0 = *(const u32x4*)(bp + k0 + lk), b1 = *(const u32x4*)(bp + k0 + lk + 8);
#pragma unroll
            for (int q = 0; q < 4; ++q) {
                As[lr * 33 + lk + 2 * q] = bflo(a0[q]); As[lr * 33 + lk + 2 * q + 1] = bfhi(a0[q]);
                As[lr * 33 + lk + 8 + 2 * q] = bflo(a1[q]); As[lr * 33 + lk + 8 + 2 * q + 1] = bfhi(a1[q]);
                Bs[lr * 33 + lk + 2 * q] = bflo(b0[q]); Bs[lr * 33 + lk + 2 * q + 1] = bfhi(b0[q]);
                Bs[lr * 33 + lk + 8 + 2 * q] = bflo(b1[q]); Bs[lr * 33 + lk + 8 + 2 * q + 1] = bfhi(b1[q]);
            }
            __syncthreads();
            for (int kk = 0; kk < 32; ++kk) {
                float av[2][4], bv[2][2][4];
#pragma unroll
                for (int a = 0; a < 2; ++a)
#pragma unroll
                    for (int m = 0; m < 4; ++m) av[a][m] = As[(128 * a + 64 * wr + 16 * m + fr) * 33 + kk];
#pragma unroll
                for (int b = 0; b < 2; ++b)
#pragma unroll
                    for (int n = 0; n < 2; ++n)
#pragma unroll
                        for (int j = 0; j < 4; ++j) { const int c = 128 * b + 32 * wc + (Epi::PERM ? (8 * fq + 4 * n + j) : (16 * n + 4 * fq + j)); bv[b][n][j] = Bs[c * 33 + kk]; }
#pragma unroll
                for (int a = 0; a < 2; ++a)
#pragma unroll
                    for (int b = 0; b < 2; ++b)
#pragma unroll
                        for (int m = 0; m < 4; ++m)
#pragma unroll
                            for (int n = 0; n < 2; ++n)
#pragma unroll
                                for (int j = 0; j < 4; ++j) acc[a][b][m][n][j] += av[a][m] * bv[b][n][j];
            }
        }
        f32x4 accv[2][2][4][2];
#pragma unroll
        for (int a = 0; a < 2; ++a)
#pragma unroll
            for (int b = 0; b < 2; ++b)
#pragma unroll
                for (int m = 0; m < 4; ++m)
#pragma unroll
                    for (int n = 0; n < 2; ++n) accv[a][b][m][n] = (f32x4){acc[a][b][m][n][0], acc[a][b][m][n][1], acc[a][b][m][n][2], acc[a][b][m][n][3]};
        E(accv, u, wr, wc, fr, fq);
    }
    __syncthreads();
}
#endif
}

struct Args {
    const float* in[32];
    float* out; uchar* ws;
    int ph_lo, ph_hi;
};
struct Frame {
    LAS uchar* lds; uchar* ws; int wave, G, bx;
};
#define FRAME_IDS(F) const int F_lane = fresh_lane(), F_tid = (F).wave * 64 + F_lane
enum { I_X = 0, I_POS, I_N1G, I_WIN, I_BG, I_QNG, I_WUQ, I_KVNG, I_WUKV, I_QKQG, I_QKKG, I_WOMLA, I_LRE, I_LIM, I_LOGDT, I_BRE, I_BIM, I_CRE, I_CIM, I_S5D,
       I_WGLU, I_WOS5, I_WOUT, I_N2G, I_WR, I_BR, I_WG, I_BGATE, I_WU, I_BUP, I_WD, I_BDOWN };

struct ProbS5 {
    const bf16_t* A; const bf16_t* B; int lda, ldb, nt; int G, c; const int* list = nullptr; const LAS int* gtab = nullptr;
    __device__ unsigned list_off(const gm::Unit&) const { return 0u; }
    __device__ bool next(int i, gm::Unit& u) const { const int L = i * G + c; if (L >= S5G * 4) return false; u.g = L >> 2; u.pm = L & 3; u.pn = 0; u.st = 0; return true; }
    __device__ size_t a_off(const gm::Unit& u) const { return ((size_t)u.g * NCHUNK + (size_t)u.pm * 256) * APK; }
    __device__ size_t b_off(const gm::Unit& u) const { return (size_t)u.g * 256 * ldb; }
    __device__ unsigned a_row(const gm::Unit&, int) const { return 0u; }
};
struct ProbMoE {
    const bf16_t* A; const bf16_t* B; int lda, ldb, nt; int npn; size_t estride;
    int x, rk, nrk; int nte[4], rcp[4], pre[4], eid[4];
    const int* list = nullptr; const LAS int* gtab = nullptr;
    __device__ void load(const LAS int* tab) {
#pragma unroll
        for (int q = 0; q < 4; ++q) { const int e = __builtin_amdgcn_readfirstlane(tab[160 + x * 4 + q]); eid[q] = e; nte[q] = __builtin_amdgcn_readfirstlane(tab[32 + e]); rcp[q] = __builtin_amdgcn_readfirstlane(tab[128 + e]); pre[q] = __builtin_amdgcn_readfirstlane(tab[64 + e]); }
    }
    __device__ unsigned list_off(const gm::Unit&) const { return 0u; }
    __device__ bool next(int i, gm::Unit& u) const {
        int L = (i >> MK_DUP) * nrk + rk;
#pragma unroll
        for (int q = 0; q < 4; ++q) { const int nu = nte[q] * npn;
            if (L < nu) { u.g = eid[q]; u.pn = (L * rcp[q]) >> 20; u.pm = L - u.pn * nte[q]; u.st = pre[q] + u.pm; return true; } L -= nu; }
        return false;
    }
    __device__ size_t a_off(const gm::Unit& u) const { return ((size_t)u.st * 256) * lda; }
    __device__ size_t b_off(const gm::Unit& u) const { return (size_t)u.g * estride + (size_t)u.pn * 256 * ldb; }
    __device__ unsigned a_row(const gm::Unit&, int) const { return 0u; }
};

#define EPI_ROW(u_, ai, m) ((u_).pm * 256 + (ai) * 128 + wr * 64 + (m) * 16 + fr)
struct EpiStoreBf16 {
    static constexpr bool PERM = true;
    bf16_t* O; int ld;
    __device__ __forceinline__ void operator()(const f32x4 (&acc)[2][2][4][2], const gm::Unit& u, int wr, int wc, int fr, int fq) const {
#pragma unroll
        for (int ai = 0; ai < 2; ++ai)
#pragma unroll
            for (int m = 0; m < 4; ++m) { bf16_t* rowp = O + (size_t)EPI_ROW(u, ai, m) * ld + u.pn * 256 + wc * 32 + 8 * fq;
#pragma unroll
                for (int bj = 0; bj < 2; ++bj) { const f32x4 v0 = acc[ai][bj][m][0], v1 = acc[ai][bj][m][1];
                    u32x4 w; w.x = cvt_pk_bf16(v0[0], v0[1]); w.y = cvt_pk_bf16(v0[2], v0[3]); w.z = cvt_pk_bf16(v1[0], v1[1]); w.w = cvt_pk_bf16(v1[2], v1[3]);
                    *(u32x4*)(rowp + bj * 128) = w; } }
    }
};
template <int S0, int NS, int LEN> struct EpiStoreScaled {
    static constexpr bool PERM = true;
    bf16_t* O; int ld; const float* ssqp;
    __device__ __forceinline__ void operator()(const f32x4 (&acc)[2][2][4][2], const gm::Unit& u, int wr, int wc, int fr, int fq) const {
#pragma unroll
        for (int ai = 0; ai < 2; ++ai) { float rs[4];
#pragma unroll
            for (int m = 0; m < 4; ++m) { const float* sp = ssqp + (size_t)EPI_ROW(u, ai, m) * 12 + S0; float t = 0.f;
#pragma unroll
                for (int q = 0; q < NS; q += 4) { const f32x4 v = *(const f32x4*)(sp + q); t += (v[0] + v[1]) + (v[2] + v[3]); }
                rs[m] = 1.0f / sqrtf(t * (1.0f / LEN) + EPS); }
#pragma unroll
            for (int m = 0; m < 4; ++m) { bf16_t* rowp = O + (size_t)EPI_ROW(u, ai, m) * ld + u.pn * 256 + wc * 32 + 8 * fq;
#pragma unroll
                for (int bj = 0; bj < 2; ++bj) { const f32x4 v0 = acc[ai][bj][m][0] * rs[m], v1 = acc[ai][bj][m][1] * rs[m];
                    u32x4 w; w.x = cvt_pk_bf16(v0[0], v0[1]); w.y = cvt_pk_bf16(v0[2], v0[3]); w.z = cvt_pk_bf16(v1[0], v1[1]); w.w = cvt_pk_bf16(v1[2], v1[3]);
                    *(u32x4*)(rowp + bj * 128) = w; } } }
    }
};
struct EpiKV {
    static constexpr bool PERM = true;
    bf16_t* kraw; bf16_t* vn; const float* ssqp;
    __device__ __forceinline__ void operator()(const f32x4 (&acc)[2][2][4][2], const gm::Unit& u, int wr, int wc, int fr, int fq) const {
#pragma unroll
        for (int ai = 0; ai < 2; ++ai) { float rs[4];
#pragma unroll
            for (int m = 0; m < 4; ++m) { const f32x4 v = *(const f32x4*)(ssqp + (size_t)EPI_ROW(u, ai, m) * 12 + 8); rs[m] = 1.0f / sqrtf(((v[0] + v[1]) + (v[2] + v[3])) * (1.0f / KVLORA) + EPS); }
#pragma unroll
            for (int m = 0; m < 4; ++m) { const int t = EPI_ROW(u, ai, m); const size_t ro = ((size_t)((t >> 11) * NH + u.pn) * SEQ + (t & 2047)) * 128 + wc * 32 + 8 * fq;
#pragma unroll
                for (int bj = 0; bj < 2; ++bj) { const f32x4 v0 = acc[ai][bj][m][0] * rs[m], v1 = acc[ai][bj][m][1] * rs[m];
                    u32x4 w; w.x = cvt_pk_bf16(v0[0], v0[1]); w.y = cvt_pk_bf16(v0[2], v0[3]); w.z = cvt_pk_bf16(v1[0], v1[1]); w.w = cvt_pk_bf16(v1[2], v1[3]);
                    *(u32x4*)((bj ? vn : kraw) + ro) = w; } } }
    }
};
struct EpiInProj {
    static constexpr bool PERM = true;
    bf16_t* proj; bf16_t* apack; const float* bgates; float* ssqp;
    __device__ __forceinline__ void operator()(const f32x4 (&acc)[2][2][4][2], const gm::Unit& u, int wr, int wc, int fr, int fq) const {
        const int colt = u.pn * 256 + wc * 32 + 8 * fq;
        if (u.pn < 3) {
#pragma unroll
            for (int ai = 0; ai < 2; ++ai)
#pragma unroll
                for (int m = 0; m < 4; ++m) { float sq = 0.f;
#pragma unroll
                    for (int bj = 0; bj < 2; ++bj)
#pragma unroll
                        for (int n = 0; n < 2; ++n) { const f32x4 v = acc[ai][bj][m][n]; sq += (v[0] * v[0] + v[1] * v[1]) + (v[2] * v[2] + v[3] * v[3]); }
                    sq += __shfl_xor(sq, 16); sq += __shfl_xor(sq, 32);
                    if (fq == 0) ssqp[(size_t)EPI_ROW(u, ai, m) * 12 + u.pn * 4 + wc] = sq * (INPROJ_DS * INPROJ_DS); } }
        const int kind = (u.pn >= 3 && u.pn < 7) ? 1 : ((u.pn >= 7 && u.pn < 23) ? 2 : 0);
#pragma unroll
        for (int bj = 0; bj < 2; ++bj) {
            const int col = colt + bj * 128;
            f32x4 b0 = (f32x4){0.f, 0.f, 0.f, 0.f}, b1 = b0;
            constexpr float NL2E = -1.4426950408889634f;
            if (kind == 2) { b0 = *(const f32x4*)(bgates + (col - C_GA)) * NL2E; b1 = *(const f32x4*)(bgates + (col - C_GA) + 4) * NL2E; }
#pragma unroll
            for (int ai = 0; ai < 2; ++ai)
#pragma unroll
                for (int m = 0; m < 4; ++m) {
                    const int row = EPI_ROW(u, ai, m);
                    f32x4 v0 = acc[ai][bj][m][0], v1 = acc[ai][bj][m][1];
                    if (kind == 2) {
#pragma unroll
                        for (int h = 0; h < 2; ++h) { const f32x2 s0 = sig2_t((f32x2){v0[2 * h], v0[2 * h + 1]} * (NL2E * INPROJ_DS) + (f32x2){b0[2 * h], b0[2 * h + 1]}), s1 = sig2_t((f32x2){v1[2 * h], v1[2 * h + 1]} * (NL2E * INPROJ_DS) + (f32x2){b1[2 * h], b1[2 * h + 1]});
                            v0[2 * h] = s0.x; v0[2 * h + 1] = s0.y; v1[2 * h] = s1.x; v1[2 * h + 1] = s1.y; }
                    } else if (MK_FP8_INPROJ) { v0 = v0 * INPROJ_DS; v1 = v1 * INPROJ_DS; }
                    u32x4 w; w.x = cvt_pk_bf16(v0[0], v0[1]); w.y = cvt_pk_bf16(v0[2], v0[3]); w.z = cvt_pk_bf16(v1[0], v1[1]); w.w = cvt_pk_bf16(v1[2], v1[3]);
                    if (kind == 1) { const int j = col - C_U, g = j >> 4, cc = j & 15;
                        *(u32x4*)(apack + ((size_t)g * NCHUNK + (row >> 4)) * APK + (row & 15) * 16 + cc) = w; }
                    else { *(u32x4*)(proj + (size_t)row * NPROJ + col) = w;
                    }
                }
        }
    }
};
struct EpiS5State {
    static constexpr bool PERM = false;
    float* sch;
    __device__ __forceinline__ void operator()(const f32x4 (&acc)[2][2][4][2], const gm::Unit& u, int wr, int wc, int fr, int fq) const {
#pragma unroll
        for (int ai = 0; ai < 2; ++ai)
#pragma unroll
            for (int m = 0; m < 4; ++m) { float* rowp = sch + ((size_t)u.g * NCHUNK + EPI_ROW(u, ai, m)) * 128 + wc * 32 + 4 * fq;
#pragma unroll
                for (int n = 0; n < 2; ++n) *(f32x4*)(rowp + n * 16) = acc[ai][0][m][n]; }
    }
};
struct EpiS5Out {
    static constexpr bool PERM = true;
    bf16_t* gact;
    __device__ __forceinline__ void operator()(const f32x4 (&acc)[2][2][4][2], const gm::Unit& u, int wr, int wc, int fr, int fq) const {
#pragma unroll
        for (int ai = 0; ai < 2; ++ai)
#pragma unroll
            for (int m = 0; m < 4; ++m) { const int r = EPI_ROW(u, ai, m);
#pragma unroll
                for (int bj = 0; bj < 2; ++bj) { const int n0 = bj * 128 + wc * 32 + 8 * fq, t = n0 >> 4, c0 = n0 & 15;
                    f32x4 v0 = acc[ai][bj][m][0], v1 = acc[ai][bj][m][1];
#pragma unroll
                    for (int h = 0; h < 2; ++h) { const f32x2 g0 = gelu_tanh2((f32x2){v0[2 * h], v0[2 * h + 1]}), g1 = gelu_tanh2((f32x2){v1[2 * h], v1[2 * h + 1]});
                        v0[2 * h] = g0.x; v0[2 * h + 1] = g0.y; v1[2 * h] = g1.x; v1[2 * h + 1] = g1.y; }
                    u32x4 w; w.x = cvt_pk_bf16(v0[0], v0[1]); w.y = cvt_pk_bf16(v0[2], v0[3]); w.z = cvt_pk_bf16(v1[0], v1[1]); w.w = cvt_pk_bf16(v1[2], v1[3]);
                    *(u32x4*)(gact + ((size_t)r * 16 + t) * S5W + u.g * 16 + c0) = w; } }
    }
};
template <int MODE> struct EpiSide {
    static constexpr bool PERM = true;
    bf16_t* O; int ldo; const bf16_t* s0; int ld0; const bf16_t* s1; int ld1;
    __device__ __forceinline__ void operator()(const f32x4 (&acc)[2][2][4][2], const gm::Unit& u, int wr, int wc, int fr, int fq) const {
        const int col0 = u.pn * 256 + wc * 32 + 8 * fq;
#pragma unroll
        for (int ai = 0; ai < 2; ++ai) {
            u32x4 sa[4][2], sb[4][2];
#pragma unroll
            for (int m = 0; m < 4; ++m)
#pragma unroll
                for (int bj = 0; bj < 2; ++bj) { const int row = EPI_ROW(u, ai, m);
                    sa[m][bj] = *(const u32x4*)(s0 + (size_t)row * ld0 + col0 + bj * 128);
                    if (MODE == 2) sb[m][bj] = *(const u32x4*)(s1 + (size_t)row * ld1 + col0 + bj * 128); else sb[m][bj] = (u32x4){0u, 0u, 0u, 0u}; }
#pragma unroll
            for (int m = 0; m < 4; ++m)
#pragma unroll
                for (int bj = 0; bj < 2; ++bj) { const int row = EPI_ROW(u, ai, m);
                    const f32x4 v0 = acc[ai][bj][m][0], v1 = acc[ai][bj][m][1]; const u32x4 a = sa[m][bj], b = sb[m][bj];
                    float r[8];
#pragma unroll
                    for (int q = 0; q < 4; ++q) { const float x0 = q < 2 ? v0[2 * q] : v1[2 * q - 4], x1 = q < 2 ? v0[2 * q + 1] : v1[2 * q - 3];
                        const float a0 = bflo(a[q]), a1 = bfhi(a[q]);
                        if (MODE == 0) { const f32x2 sg = sig2_t((f32x2){x0, x1} * -1.4426950408889634f) * (f32x2){a0, a1}; r[2 * q] = sg.x; r[2 * q + 1] = sg.y; }
                        else if (MODE == 1) { r[2 * q] = a0 * x0; r[2 * q + 1] = a1 * x1; }
                        else { r[2 * q] = bflo(b[q]) + a0 * x0; r[2 * q + 1] = bfhi(b[q]) + a1 * x1; } }
                    u32x4 w; w.x = cvt_pk_bf16(r[0], r[1]); w.y = cvt_pk_bf16(r[2], r[3]); w.z = cvt_pk_bf16(r[4], r[5]); w.w = cvt_pk_bf16(r[6], r[7]);
                    *(u32x4*)(O + (size_t)row * ldo + col0 + bj * 128) = w; }
        }
    }
};
struct EpiResidF32 {
    static constexpr bool PERM = false;
    const float* x; float* out;
    __device__ __forceinline__ void operator()(const f32x4 (&acc)[2][2][4][2], const gm::Unit& u, int wr, int wc, int fr, int fq) const {
#pragma unroll
        for (int ai = 0; ai < 2; ++ai)
#pragma unroll
            for (int mh = 0; mh < 2; ++mh) { f32x4 xv[2][2][2];
#pragma unroll
                for (int mm = 0; mm < 2; ++mm) { const size_t off = (size_t)EPI_ROW(u, ai, 2 * mh + mm) * DM + u.pn * 256 + wc * 32 + 4 * fq;
#pragma unroll
                    for (int bj = 0; bj < 2; ++bj)
#pragma unroll
                        for (int n = 0; n < 2; ++n) xv[mm][bj][n] = *(const f32x4*)(x + off + bj * 128 + n * 16); }
#pragma unroll
                for (int mm = 0; mm < 2; ++mm) { const size_t off = (size_t)EPI_ROW(u, ai, 2 * mh + mm) * DM + u.pn * 256 + wc * 32 + 4 * fq;
#pragma unroll
                    for (int bj = 0; bj < 2; ++bj)
#pragma unroll
                        for (int n = 0; n < 2; ++n) *(f32x4*)(out + off + bj * 128 + n * 16) = xv[mm][bj][n] + acc[ai][bj][2 * mh + mm][n]; } }
    }
};
#if MK_FP8_MOE
constexpr float MOE_DESCALE = 1.0f / (FP8_ASCALE * FP8_WSCALE);
#else
constexpr float MOE_DESCALE = 1.0f;
#endif
struct EpiSwiglu {
    static constexpr bool PERM = true;
    static constexpr float EPS_AS = MK_FP8_MOE ? FP8_ASCALE : 1.0f;
    bf16_t* hact; const float* bgate; const float* bup; const LAS int* tab;
    __device__ __forceinline__ void operator()(const f32x4 (&acc)[2][2][4][2], const gm::Unit& u, int wr, int wc, int fr, int fq) const {
        const int hc = u.pn * 128 + wc * 32 + 8 * fq;
        const unsigned slot0 = (unsigned)u.st * 256u + wr * 64 + fr;
        unsigned w0[2][4];
#pragma unroll
        for (int n = 0; n < 2; ++n) {
            const f32x4 g0 = *(const f32x4*)(bgate + (unsigned)(u.g * DFF + hc + 4 * n)), u0 = *(const f32x4*)(bup + (unsigned)(u.g * DFF + hc + 4 * n));
            const f32x2 gbv[2] = {{g0.x, g0.y}, {g0.z, g0.w}}, ubv[2] = {{u0.x * EPS_AS + EPS_AS, u0.y * EPS_AS + EPS_AS}, {u0.z * EPS_AS + EPS_AS, u0.w * EPS_AS + EPS_AS}};
#pragma unroll
            for (int ai = 0; ai < 2; ++ai)
#pragma unroll
                for (int m = 0; m < 4; ++m) { const unsigned slot = slot0 + ai * 128 + m * 16;
                    float r[4];
#pragma unroll
                    for (int h = 0; h < 2; ++h) { const f32x2 ag = {acc[ai][0][m][n][2 * h], acc[ai][0][m][n][2 * h + 1]}, au = {acc[ai][1][m][n][2 * h], acc[ai][1][m][n][2 * h + 1]};
                        f32x2 gt = ag * MOE_DESCALE + gbv[h], up = au * (MOE_DESCALE * EPS_AS) + ubv[h];
                        gt.x = fminf(gt.x, 7.0f); gt.y = fminf(gt.y, 7.0f);
                        up.x = __builtin_amdgcn_fmed3f(up.x, -6.0f * EPS_AS, 8.0f * EPS_AS); up.y = __builtin_amdgcn_fmed3f(up.y, -6.0f * EPS_AS, 8.0f * EPS_AS);
                        const f32x2 t = gt * (-1.702f * 1.4426950408889634f); f32x2 d; d.x = __builtin_amdgcn_exp2f(t.x); d.y = __builtin_amdgcn_exp2f(t.y); d = d + 1.0f;
                        f32x2 sg; sg.x = __builtin_amdgcn_rcpf(d.x); sg.y = __builtin_amdgcn_rcpf(d.y);
                        const f32x2 o = up * (gt * sg); r[2 * h] = o.x; r[2 * h + 1] = o.y; }
#if MK_FP8_MOE
                    const unsigned pk = pk4_fp8(r[0], r[1], r[2], r[3]);
                    if (n == 0) w0[ai][m] = pk; else { u32x2 w; w.x = w0[ai][m]; w.y = pk; *(u32x2*)((uchar*)hact + slot * DFF + hc) = w; }
#else
                    u32x2 w; w.x = cvt_pk_bf16(r[0], r[1]); w.y = cvt_pk_bf16(r[2], r[3]); *(u32x2*)(hact + slot * DFF + hc + 4 * n) = w;
#endif
                }
        }
    }
};
struct EpiDown {
    static constexpr bool PERM = true;
    bf16_t* ys; const float* bdown; const LAS int* tab;
    __device__ __forceinline__ void operator()(const f32x4 (&acc)[2][2][4][2], const gm::Unit& u, int wr, int wc, int fr, int fq) const {
        const size_t slot0 = (size_t)u.st * 256;
#pragma unroll
        for (int bj = 0; bj < 2; ++bj) { const int col = u.pn * 256 + bj * 128 + wc * 32 + 8 * fq;
            const float* bd = bdown + (size_t)u.g * DM + col; const f32x4 d0 = *(const f32x4*)bd, d1 = *(const f32x4*)(bd + 4);
#pragma unroll
            for (int ai = 0; ai < 2; ++ai)
#pragma unroll
                for (int m = 0; m < 4; ++m) { const size_t slot = slot0 + ai * 128 + wr * 64 + m * 16 + fr;
                    const f32x4 v0 = acc[ai][bj][m][0] * MOE_DESCALE + d0, v1 = acc[ai][bj][m][1] * MOE_DESCALE + d1;
#if MK_FP8_MOE
                    u32x2 w; w.x = pk4_fp8(v0[0] * FP8_YSCALE, v0[1] * FP8_YSCALE, v0[2] * FP8_YSCALE, v0[3] * FP8_YSCALE); w.y = pk4_fp8(v1[0] * FP8_YSCALE, v1[1] * FP8_YSCALE, v1[2] * FP8_YSCALE, v1[3] * FP8_YSCALE);
                    *(u32x2*)((uchar*)ys + slot * DM + col) = w; } }
#else
                    u32x4 w; w.x = cvt_pk_bf16(v0[0], v0[1]); w.y = cvt_pk_bf16(v0[2], v0[3]); w.z = cvt_pk_bf16(v1[0], v1[1]); w.w = cvt_pk_bf16(v1[2], v1[3]);
                    *(u32x4*)(ys + slot * DM + col) = w; } }
#endif
    }
};

template <bool FP8OUT>
__device__ __forceinline__ void transpose_item(const float* W, int ldw, int src_col0, int k0, const float* kscale, void* WT, int ldt, int dst_row0, float oscale, LAS float* scr, int lane) {
    if (src_col0 >= 0) {
        f32x4 v[16]; const float* wp = W + (size_t)(k0 + (lane >> 4)) * ldw + src_col0 + (lane & 15) * 4;
#pragma unroll
        for (int i = 0; i < 16; ++i) v[i] = __builtin_nontemporal_load((const f32x4*)(wp + (size_t)(4 * i) * ldw));
#pragma unroll
        for (int i = 0; i < 16; ++i) { const int kk = 4 * i + (lane >> 4); const float sc = kscale ? kscale[k0 + kk] * oscale : oscale; LAS float* d = scr + kk * 65 + (lane & 15) * 4;
            d[0] = v[i].x * sc; d[1] = v[i].y * sc; d[2] = v[i].z * sc; d[3] = v[i].w * sc; }
    } else {
#pragma unroll
        for (int i = 0; i < 16; ++i) { LAS float* d = scr + (4 * i + (lane >> 4)) * 65 + (lane & 15) * 4; d[0] = 0.f; d[1] = 0.f; d[2] = 0.f; d[3] = 0.f; }
    }
    LDS_WAIT(); asm volatile("" ::: "memory");
    if constexpr (FP8OUT) { const int c = lane & 3;
#pragma unroll
        for (int j = 0; j < 4; ++j) { const int n = (lane >> 2) + 16 * j; const LAS float* s = scr + (16 * c) * 65 + n; u32x4 o;
            o.x = pk4_fp8(s[0 * 65], s[1 * 65], s[2 * 65], s[3 * 65]); o.y = pk4_fp8(s[4 * 65], s[5 * 65], s[6 * 65], s[7 * 65]);
            o.z = pk4_fp8(s[8 * 65], s[9 * 65], s[10 * 65], s[11 * 65]); o.w = pk4_fp8(s[12 * 65], s[13 * 65], s[14 * 65], s[15 * 65]);
            *(u32x4*)((uchar*)WT + (size_t)(dst_row0 + n) * ldt + k0 + 16 * c) = o; }
    } else { const int c = lane & 7;
#pragma unroll
        for (int j = 0; j < 8; ++j) { const int n = (lane >> 3) + 8 * j; const LAS float* s = scr + (8 * c) * 65 + n;
            u32x4 o; o.x = pk2(s[0 * 65], s[1 * 65]); o.y = pk2(s[2 * 65], s[3 * 65]); o.z = pk2(s[4 * 65], s[5 * 65]); o.w = pk2(s[6 * 65], s[7 * 65]);
            *(u32x4*)((bf16_t*)WT + (size_t)(dst_row0 + n) * ldt + k0 + 8 * c) = o; }
    }
    LDS_WAIT(); asm volatile("" ::: "memory");
}
struct TItem { const float* src; uchar* dst; };
__device__ __forceinline__ void ti_load(const TItem& t, f32x4 (&v)[16], int lane) {
    const float* wp = t.src + (size_t)(lane >> 4) * DM + (lane & 15) * 4;
#pragma unroll
    for (int i = 0; i < 16; ++i) v[i] = __builtin_nontemporal_load((const f32x4*)(wp + (size_t)(4 * i) * DM));
}
template <bool FP8OUT>
__device__ __forceinline__ void ti_store(const TItem& t, const f32x4 (&v)[16], float oscale, LAS float* scr, int lane) {
#pragma unroll
    for (int i = 0; i < 16; ++i) { LAS float* d = scr + (4 * i + (lane >> 4)) * 65 + (lane & 15) * 4; d[0] = v[i].x * oscale; d[1] = v[i].y * oscale; d[2] = v[i].z * oscale; d[3] = v[i].w * oscale; }
    LDS_WAIT(); asm volatile("" ::: "memory");
    if constexpr (FP8OUT) { const int c = lane & 3;
#pragma unroll
        for (int j = 0; j < 4; ++j) { const int n = (lane >> 2) + 16 * j; const LAS float* s = scr + (16 * c) * 65 + n; u32x4 o;
            o.x = pk4_fp8(s[0 * 65], s[1 * 65], s[2 * 65], s[3 * 65]); o.y = pk4_fp8(s[4 * 65], s[5 * 65], s[6 * 65], s[7 * 65]);
            o.z = pk4_fp8(s[8 * 65], s[9 * 65], s[10 * 65], s[11 * 65]); o.w = pk4_fp8(s[12 * 65], s[13 * 65], s[14 * 65], s[15 * 65]);
            *(u32x4*)(t.dst + (size_t)n * DM + 16 * c) = o; }
    } else { const int c = lane & 7;
#pragma unroll
        for (int j = 0; j < 8; ++j) { const int n = (lane >> 3) + 8 * j; const LAS float* s = scr + (8 * c) * 65 + n;
            u32x4 o; o.x = pk2(s[0 * 65], s[1 * 65]); o.y = pk2(s[2 * 65], s[3 * 65]); o.z = pk2(s[4 * 65], s[5 * 65]); o.w = pk2(s[6 * 65], s[7 * 65]);
            *(u32x4*)(t.dst + ((size_t)n * DM + 8 * c) * 2) = o; }
    }
    LDS_WAIT(); asm volatile("" ::: "memory");
}
template <bool W8>
__device__ __forceinline__ TItem moe_pair(const Args& a, uchar* ws, int it) {
    constexpr size_t WEB = W8 ? 1 : 2; TItem t;
    const int kb = 2 * ((it & 7) | (((it >> 11) & 1) << 3)), nb = (it >> 3) & 31;
    if (it < NE * 2 * 16 * 32) { const int rest = ((it >> 8) & 7) | ((it >> 12) << 3), half = rest & 1, e = rest >> 1, pn = nb >> 1, q = nb & 1;
        t.src = a.in[half ? I_WU : I_WG] + (size_t)e * DM * DFF + (size_t)(kb * 64) * DFF + nb * 64;
        t.dst = ws + WS_W1 + ((size_t)e * 4096 * DM + (size_t)(pn * 256 + half * 128 + q * 64) * DM + kb * 64) * WEB;
    } else { const int r = it - NE * 2 * 16 * 32, e = ((r >> 8) & 7) | ((r >> 12) << 3);
        t.src = a.in[I_WD] + (size_t)e * DFF * DM + (size_t)(kb * 64) * DM + nb * 64;
        t.dst = ws + WS_W2 + ((size_t)e * DM * DFF + (size_t)(nb * 64) * DFF + kb * 64) * WEB; }
    return t;
}
template <bool FP8OUT, int NO>
__device__ __forceinline__ void ti_block(const f32x4 (&v)[16], float oscale, LAS float* scr, int lane, u32x4 (&o)[NO]) {
#pragma unroll
    for (int i = 0; i < 16; ++i) { LAS float* d = scr + (4 * i + (lane >> 4)) * 65 + (lane & 15) * 4; d[0] = v[i].x * oscale; d[1] = v[i].y * oscale; d[2] = v[i].z * oscale; d[3] = v[i].w * oscale; }
    LDS_WAIT(); asm volatile("" ::: "memory");
    if constexpr (FP8OUT) { const int c = lane & 3;
#pragma unroll
        for (int j = 0; j < 4; ++j) { const int n = (lane >> 2) + 16 * j; const LAS float* s = scr + (16 * c) * 65 + n;
            o[j].x = pk4_fp8(s[0 * 65], s[1 * 65], s[2 * 65], s[3 * 65]); o[j].y = pk4_fp8(s[4 * 65], s[5 * 65], s[6 * 65], s[7 * 65]);
            o[j].z = pk4_fp8(s[8 * 65], s[9 * 65], s[10 * 65], s[11 * 65]); o[j].w = pk4_fp8(s[12 * 65], s[13 * 65], s[14 * 65], s[15 * 65]); }
    } else { const int c = lane & 7;
#pragma unroll
        for (int j = 0; j < 8; ++j) { const int n = (lane >> 3) + 8 * j; const LAS float* s = scr + (8 * c) * 65 + n;
            o[j].x = pk2(s[0 * 65], s[1 * 65]); o[j].y = pk2(s[2 * 65], s[3 * 65]); o[j].z = pk2(s[4 * 65], s[5 * 65]); o[j].w = pk2(s[6 * 65], s[7 * 65]); } }
    LDS_WAIT(); asm volatile("" ::: "memory");
}
__device__ __forceinline__ int win_src_col(int n0) {
    if (n0 < C_KVLAT) return n0;
    if (n0 < C_U) return n0;
    if (n0 < C_GA) return (n0 - C_U) + 832;
    if (n0 < C_KR) return (n0 - C_GA) + 1856;
    if (n0 < C_KR + DROPE) return (n0 - C_KR) + 768;
    return -1;
}
__device__ __forceinline__ void s5_build_group(const Args& a, const Frame& F, int g) {
    FRAME_IDS(F);
    LAS float* L = (LAS float*)F.lds;
    LAS float* Apr = L;              LAS float* Api = Apr + 17 * 64;
    LAS float* Zr = Api + 17 * 64;   LAS float* Zi = Zr + 64;
    LAS float* Bbr = Zi + 64;        LAS float* Bbi = Bbr + 1024;
    LAS float* Cr = Bbi + 1024;      LAS float* Ci = Cr + 1024;
    LAS float* Kt = Ci + 1024;
    const int tid = F_tid;
    __syncthreads();
    if (tid < 64) { const int p = tid;
        const float dt = expf(a.in[I_LOGDT][g]); const float lr = a.in[I_LRE][g * 64 + p], li = a.in[I_LIM][g * 64 + p];
        const float mag = expf(lr * dt); const float ar = mag * cosf(li * dt), ai = mag * sinf(li * dt);
        const float den = lr * lr + li * li;
        Zr[p] = ((ar - 1.0f) * lr + ai * li) / den; Zi[p] = (ai * lr - (ar - 1.0f) * li) / den;
        float pr = 1.0f, pi = 0.0f;
        for (int t = 0; t <= 16; ++t) { Apr[t * 64 + p] = pr; Api[t * 64 + p] = pi; const float nr = pr * ar - pi * ai, ni = pr * ai + pi * ar; pr = nr; pi = ni; }
    }
    __syncthreads();
    for (int i = tid; i < 1024; i += NTHREADS) { const int p = i >> 4;
        const float br = a.in[I_BRE][(size_t)g * 1024 + i], bi = a.in[I_BIM][(size_t)g * 1024 + i];
        Bbr[i] = Zr[p] * br - Zi[p] * bi; Bbi[i] = Zr[p] * bi + Zi[p] * br;
        Cr[i] = a.in[I_CRE][(size_t)g * 1024 + i]; Ci[i] = a.in[I_CIM][(size_t)g * 1024 + i]; }
    if (tid < 64) ((float2*)(F.ws + WS_SMALL + SM_A16))[g * 64 + tid] = make_float2(Apr[16 * 64 + tid], Api[16 * 64 + tid]);
    __syncthreads();
    { const int tau = tid >> 5, c = (tid >> 1) & 15, h8 = (tid & 1) * 8; float acc8[8];
#pragma unroll
      for (int j = 0; j < 8; ++j) acc8[j] = 0.f;
      for (int p = 0; p < 64; ++p) { const float cr = Cr[c * 64 + p], ci = Ci[c * 64 + p], ar = Apr[tau * 64 + p], ai = Api[tau * 64 + p];
          const float car = cr * ar - ci * ai, cai = cr * ai + ci * ar;
          const f32x4 b0 = *(const LAS f32x4*)(Bbr + p * 16 + h8), b1 = *(const LAS f32x4*)(Bbr + p * 16 + h8 + 4), d0 = *(const LAS f32x4*)(Bbi + p * 16 + h8), d1 = *(const LAS f32x4*)(Bbi + p * 16 + h8 + 4);
#pragma unroll
          for (int j = 0; j < 4; ++j) { acc8[j] += car * b0[j] - cai * d0[j]; acc8[4 + j] += car * b1[j] - cai * d1[j]; } }
#pragma unroll
      for (int j = 0; j < 8; ++j) Kt[(tau * 16 + c) * 16 + h8 + j] = acc8[j]; }
    __syncthreads();
    bf16_t* twc = (bf16_t*)(F.ws + WS_TWC) + (size_t)g * 256 * APK;
    for (int ch = tid; ch < 256 * (APK / 8); ch += NTHREADS) { const int n = ch / (APK / 8), k0 = (ch % (APK / 8)) * 8, t = n >> 4, c = n & 15; float v[8];
#pragma unroll
        for (int j = 0; j < 8; ++j) { const int k = k0 + j;
            if (k < 256) { const int s = k >> 4, cp = k & 15; float x = (s <= t) ? Kt[((t - s) * 16 + c) * 16 + cp] : 0.f; if (s == t && cp == c) x += a.in[I_S5D][g * 16 + c]; v[j] = x; }
            else { const int q = k - 256, p = q & 63; const float cr = Cr[c * 64 + p], ci = Ci[c * 64 + p], ar = Apr[(t + 1) * 64 + p], ai = Api[(t + 1) * 64 + p];
                v[j] = (q < 64) ? (cr * ar - ci * ai) : -(cr * ai + ci * ar); } }
        u32x4 o; o.x = pk2(v[0], v[1]); o.y = pk2(v[2], v[3]); o.z = pk2(v[4], v[5]); o.w = pk2(v[6], v[7]);
        *(u32x4*)(twc + (size_t)n * APK + k0) = o; }
    bf16_t* wsm = (bf16_t*)(F.ws + WS_WS5) + (size_t)g * 256 * 256;
    for (int ch = tid; ch < 256 * 32; ch += NTHREADS) { const int n = ch >> 5, k0 = (ch & 31) * 8; float v[8];
#pragma unroll
        for (int j = 0; j < 8; ++j) { const int k = k0 + j, s = k >> 4, cp = k & 15;
            if (n < 128) { const int p = n & 63; const float ar = Apr[(15 - s) * 64 + p], ai = Api[(15 - s) * 64 + p], br = Bbr[p * 16 + cp], bi = Bbi[p * 16 + cp];
                v[j] = (n < 64) ? (ar * br - ai * bi) : (ar * bi + ai * br); } else v[j] = 0.f; }
        u32x4 o; o.x = pk2(v[0], v[1]); o.y = pk2(v[2], v[3]); o.z = pk2(v[4], v[5]); o.w = pk2(v[6], v[7]);
        *(u32x4*)(wsm + (size_t)n * 256 + k0) = o; }
    __syncthreads();
}
__device__ __forceinline__ void rms_row_to_bf16(const float* xrow, const float* gain, bf16_t* orow, int lane) {
    const f32x4* xr = (const f32x4*)xrow + lane; const f32x4* gr = (const f32x4*)gain + lane;
    f32x4 v[8]; float s = 0.f;
#pragma unroll
    for (int j = 0; j < 8; ++j) { v[j] = __builtin_nontemporal_load(xr + 64 * j); s += (v[j].x * v[j].x + v[j].y * v[j].y) + (v[j].z * v[j].z + v[j].w * v[j].w); }
    const float rstd = 1.0f / sqrtf(wave_sum(s) * (1.0f / DM) + EPS);
#if MK_FP8_INPROJ
    unsigned* o4 = (unsigned*)orow + lane; const float rs4 = rstd * FP8_ASCALE;
#pragma unroll
    for (int j = 0; j < 8; ++j) { const f32x4 gg = gr[64 * j]; o4[64 * j] = pk4_fp8(v[j].x * rs4 * gg.x, v[j].y * rs4 * gg.y, v[j].z * rs4 * gg.z, v[j].w * rs4 * gg.w); }
#else
    unsigned long long* o8 = (unsigned long long*)orow + lane;
#pragma unroll
    for (int j = 0; j < 8; ++j) { const f32x4 gg = gr[64 * j];
        o8[64 * j] = (unsigned long long)pk2(v[j].x * rstd * gg.x, v[j].y * rstd * gg.y) | ((unsigned long long)pk2(v[j].z * rstd * gg.z, v[j].w * rstd * gg.w) << 32); }
#endif
}
__device__ __forceinline__ void p0_prologue(const Args& a, const Frame& F) {
    FRAME_IDS(F);
    for (int g = F.bx; g < S5G; g += F.G) s5_build_group(a, F, g);
    __syncthreads();
    const int gw = F.bx * NWAVES + F.wave, NGW = F.G * NWAVES; const int lane = F_lane;
    for (int m = gw; m < TT; m += NGW) rms_row_to_bf16(a.in[I_X] + (size_t)m * DM, a.in[I_N1G], (bf16_t*)(F.ws + WS_H + (size_t)m * DM * (MK_FP8_INPROJ ? 1 : 2)), lane);
    for (int i = gw * 64 + lane; i < TT * 32; i += NGW * 64) { const int t = i >> 5, f = i & 31;
        const double invf = exp(-(double)f * (9.210340371976184 / 32.0)); const double ang = (double)((const int*)a.in[I_POS])[t] * invf;
        ((float2*)(F.ws + WS_ROPE))[i] = make_float2((float)cos(ang), (float)sin(ang)); }
    for (int i = gw * 64 + lane; i < DM * NE; i += NGW * 64) ((float*)(F.ws + WS_SMALL + SM_WRP))[i] = a.in[I_WR][i] * a.in[I_N2G][i >> 5];
    LAS float* scr = (LAS float*)(F.lds + F.wave * 16640);
    constexpr int IT_WIN = (DM / 64) * (NPROJ / 64), IT_WUQ = (QLORA / 64) * (3072 / 64), IT_WUKV = (KVLORA / 64) * (4096 / 64), IT_SQ = (DM / 64) * (DM / 64),
                  IT_GLU = (S5W / 64) * (S5W / 64), IT_OS5 = (S5W / 64) * (DM / 64);
    constexpr int IT_MIX = IT_WIN + IT_WUQ + IT_WUKV + IT_SQ + IT_GLU + IT_OS5 + IT_SQ;
    for (int it = gw; it < IT_MIX; it += NGW) { int r = it;
        if (r < IT_WIN) { const int nb = r % (NPROJ / 64), kb = r / (NPROJ / 64); transpose_item<MK_FP8_INPROJ != 0>(a.in[I_WIN], IN_PROJ, win_src_col(nb * 64), kb * 64, nullptr, F.ws + WS_WIN, DM, nb * 64, MK_FP8_INPROJ ? FP8_WSCALE : 1.f, scr, lane); continue; } r -= IT_WIN;
        if (r < IT_WUQ) { const int nb = r % 48, kb = r / 48; transpose_item<false>(a.in[I_WUQ], 3072, nb * 64, kb * 64, a.in[I_QNG], F.ws + WS_WUQ, QLORA, nb * 64, 1.f, scr, lane); continue; } r -= IT_WUQ;
        if (r < IT_WUKV) { const int nb = r % 64, kb = r / 64; transpose_item<false>(a.in[I_WUKV], 4096, nb * 64, kb * 64, a.in[I_KVNG], F.ws + WS_WUKV, KVLORA, nb * 64, 1.f, scr, lane); continue; } r -= IT_WUKV;
        if (r < IT_SQ) { const int nb = r % 32, kb = r / 32; transpose_item<false>(a.in[I_WOMLA], DM, nb * 64, kb * 64, nullptr, F.ws + WS_WOMLA, DM, nb * 64, 1.f, scr, lane); continue; } r -= IT_SQ;
        if (r < IT_GLU) { const int nb = r % 16, kb = r / 16; transpose_item<false>(a.in[I_WGLU], S5W, nb * 64, kb * 64, nullptr, F.ws + WS_WGLU, S5W, nb * 64, 1.f, scr, lane); continue; } r -= IT_GLU;
        if (r < IT_OS5) { const int nb = r % 32, kb = r / 32; transpose_item<false>(a.in[I_WOS5], DM, nb * 64, kb * 64, nullptr, F.ws + WS_WOS5, S5W, nb * 64, 1.f, scr, lane); continue; } r -= IT_OS5;
        { const int nb = r % 32, kb = r / 32; transpose_item<false>(a.in[I_WOUT], DM, nb * 64, kb * 64, nullptr, F.ws + WS_WOUT, DM, nb * 64, 1.f, scr, lane); }
    }
    constexpr bool W8 = MK_FP8_MOE != 0; constexpr float WSC = W8 ? FP8_WSCALE : 1.0f; constexpr int NPAIR = NE * 3 * 16 * 32; constexpr int NO = W8 ? 4 : 8;
    for (int it = gw; it < NPAIR; it += NGW) { const TItem t = moe_pair<W8>(a, F.ws, it); f32x4 v0[16], v1[16];
        ti_load(t, v0, lane); { TItem t1 = t; t1.src += (size_t)64 * DM; ti_load(t1, v1, lane); }
        u32x4 o0[NO], o1[NO];
        ti_block<W8, NO>(v0, WSC, scr, lane, o0); ti_block<W8, NO>(v1, WSC, scr, lane, o1);
        if constexpr (W8) { const int c = lane & 3;
#pragma unroll
            for (int j = 0; j < 4; ++j) { uchar* d = t.dst + (size_t)((lane >> 2) + 16 * j) * DM + 16 * c; *(u32x4*)d = o0[j]; *(u32x4*)(d + 64) = o1[j]; }
        } else { const int c = lane & 7;
#pragma unroll
            for (int j = 0; j < 8; ++j) { uchar* d = t.dst + ((size_t)((lane >> 3) + 8 * j) * DM + 8 * c) * 2; *(u32x4*)d = o0[j]; *(u32x4*)(d + 128) = o1[j]; } }
    }
}

constexpr float QSCALE = 0.07216878364870322f * 1.4426950408889634f;
__device__ __forceinline__ float half_sum(float v) {
#pragma unroll
    for (int o = 1; o < 32; o <<= 1) v += __shfl_xor(v, o);
    return v;
}
__device__ __forceinline__ void p3_prep(const Args& a, const Frame& F) {
    FRAME_IDS(F);
    const bf16_t* proj = (const bf16_t*)(F.ws + WS_PROJ); const bf16_t* kvraw = (const bf16_t*)(F.ws + WS_KVRAW); bf16_t* Kn = (bf16_t*)(F.ws + WS_KN);
    const float2* rope = (const float2*)(F.ws + WS_ROPE);
    const int lane = F_lane, grp = lane / 24, ch = lane - grp * 24; const bool act = grp < 2;
    const bool isrope = act && ch >= 16, x2half = isrope && ch >= 20; const int ri = isrope ? ((ch - 16) & 3) * 8 : 0;
    float g[8];
#pragma unroll
    for (int j = 0; j < 8; ++j) g[j] = act ? a.in[I_QKKG][ch * 8 + j] : 0.f;
    const bool even = (TT == 64 * F.G);
    const int tk0 = even ? F.bx * 64 + (F.wave < 2 ? 5 * F.wave : 10 + 9 * (F.wave - 2)) : F.bx * NWAVES + F.wave, tkn = even ? (F.wave < 2 ? 5 : 9) : (TT + F.G * NWAVES - 1) / (F.G * NWAVES), tks = even ? 1 : F.G * NWAVES;
    for (int ti = 0; ti < tkn; ++ti) { const int t = tk0 + ti * tks; if (t >= TT) break;
        const int b = t >> 11, s = t & 2047; const bf16_t* prow = proj + (size_t)t * NPROJ;
        float cs[8], sn[8];
        if (isrope) {
#pragma unroll
            for (int j = 0; j < 8; j += 2) { const f32x4 c2 = *(const f32x4*)(rope + (size_t)t * 32 + ri + j); cs[j] = c2.x; sn[j] = c2.y; cs[j + 1] = c2.z; sn[j + 1] = c2.w; } }
        else {
#pragma unroll
            for (int j = 0; j < 8; ++j) { cs[j] = 1.f; sn[j] = 0.f; } }
        u32x4 kr = (u32x4){0u, 0u, 0u, 0u};
        if (isrope) kr = *(const u32x4*)(prow + C_KR + (ch - 16) * 8);
        u32x4 wl[8];
        { const bf16_t* src0 = kvraw + ((size_t)(b * NH + grp) * SEQ + s) * 128 + (ch & 15) * 8;
#pragma unroll
          for (int i = 0; i < 8; ++i) wl[i] = (!act) ? (u32x4){0u, 0u, 0u, 0u} : (isrope ? kr : *(const u32x4*)(src0 + (size_t)i * 2 * SEQ * 128)); }
#pragma unroll
        for (int i = 0; i < 8; ++i) { const int h = 2 * i + grp; const u32x4 w = wl[i];
            float x[8], ss = 0.f;
#pragma unroll
            for (int q = 0; q < 4; ++q) { x[2 * q] = bflo(w[q]); x[2 * q + 1] = bfhi(w[q]); }
#pragma unroll
            for (int j = 0; j < 8; ++j) ss += x[j] * x[j];
            const float s0 = wave_sum(grp == 0 ? ss : 0.f), s1 = wave_sum(grp == 1 ? ss : 0.f);
            const float rn = 1.0f / sqrtf((grp == 0 ? s0 : s1) * (1.0f / DQK) + EPS);
            float y[8];
#pragma unroll
            for (int j = 0; j < 8; ++j) y[j] = x[j] * rn * g[j];
#pragma unroll
            for (int j = 0; j < 8; ++j) { const float partner = __shfl_xor(y[j], 4); y[j] = x2half ? (y[j] * cs[j] + partner * sn[j]) : (y[j] * cs[j] - partner * sn[j]); }
            if (act) { u32x4 o; o.x = pk2(y[0], y[1]); o.y = pk2(y[2], y[3]); o.z = pk2(y[4], y[5]); o.w = pk2(y[6], y[7]);
                *(u32x4*)(Kn + ((size_t)(b * NH + h) * SEQ + s) * DQK + ch * 8) = o; }
        }
    }
}

__device__ __forceinline__ void p3_scan(const Args& a, const Frame& F) {
    FRAME_IDS(F);
    const float* sch = (const float*)(F.ws + WS_SCH); bf16_t* apack = (bf16_t*)(F.ws + WS_APACK); const float2* A16 = (const float2*)(F.ws + WS_SMALL + SM_A16);
    const int p = F_lane;
    for (int it = F.wave * F.G + F.bx; it < NB * S5G; it += F.G * NWAVES) { const int b = it / S5G, g = it % S5G;
        const float2 am = A16[g * 64 + p]; float xr = 0.f, xi = 0.f;
        const size_t row0 = (size_t)g * NCHUNK + (size_t)b * 128;
        for (int c0 = 0; c0 < 128; c0 += 32) { float sr[32], si[32];
#pragma unroll
            for (int q = 0; q < 32; ++q) { sr[q] = sch[(row0 + c0 + q) * 128 + p]; si[q] = sch[(row0 + c0 + q) * 128 + 64 + p]; }
#pragma unroll
            for (int q = 0; q < 32; ++q) { bf16_t* o = apack + (row0 + c0 + q) * APK + 256; o[p] = (bf16_t)f2bf(xr); o[64 + p] = (bf16_t)f2bf(xi);
                const float nr = am.x * xr - am.y * xi + sr[q], ni = am.x * xi + am.y * xr + si[q]; xr = nr; xi = ni; } }
    }
}

__device__ __forceinline__ void s5_reference(const Args& a, const Frame& F) {
    FRAME_IDS(F);
    const bf16_t* apack = (const bf16_t*)(F.ws + WS_APACK); bf16_t* gact = (bf16_t*)(F.ws + WS_GACT);
    const int gw = F.bx * NWAVES + F.wave, NGW = F.G * NWAVES, p = F_lane;
    for (int it = gw; it < NB * S5G; it += NGW) { const int b = it / S5G, g = it % S5G;
        const float dt = expf(a.in[I_LOGDT][g]); const float lr = a.in[I_LRE][g * 64 + p], li = a.in[I_LIM][g * 64 + p];
        const float mag = expf(lr * dt); const float ar = mag * cosf(li * dt), ai = mag * sinf(li * dt); const float den = lr * lr + li * li;
        const float zr = ((ar - 1.0f) * lr + ai * li) / den, zi = (ai * lr - (ar - 1.0f) * li) / den;
        float bbr[16], bbi[16], cr[16], ci[16];
#pragma unroll
        for (int c = 0; c < 16; ++c) { const float br = a.in[I_BRE][((size_t)g * 64 + p) * 16 + c], bi = a.in[I_BIM][((size_t)g * 64 + p) * 16 + c];
            bbr[c] = zr * br - zi * bi; bbi[c] = zr * bi + zi * br; cr[c] = a.in[I_CRE][((size_t)g * 16 + c) * 64 + p]; ci[c] = a.in[I_CIM][((size_t)g * 16 + c) * 64 + p]; }
        const float dl = (p < 16) ? a.in[I_S5D][g * 16 + p] : 0.f;
        float xr = 0.f, xi = 0.f;
        for (int t = 0; t < SEQ; ++t) { const int tok = b * SEQ + t;
            const bf16_t* up = apack + ((size_t)g * NCHUNK + (tok >> 4)) * APK + (tok & 15) * 16;
            const u32x4 w0 = *(const u32x4*)up, w1 = *(const u32x4*)(up + 8); float u[16];
#pragma unroll
            for (int q = 0; q < 4; ++q) { u[2 * q] = bflo(w0[q]); u[2 * q + 1] = bfhi(w0[q]); u[8 + 2 * q] = bflo(w1[q]); u[8 + 2 * q + 1] = bfhi(w1[q]); }
            float br = 0.f, bi = 0.f;
#pragma unroll
            for (int c = 0; c < 16; ++c) { br += bbr[c] * u[c]; bi += bbi[c] * u[c]; }
            const float nr = ar * xr - ai * xi + br, ni = ar * xi + ai * xr + bi; xr = nr; xi = ni;
            float y = 0.f, um = 0.f;
#pragma unroll
            for (int c = 0; c < 16; ++c) { const float yc = wave_sum(cr[c] * xr - ci[c] * xi); if (p == c) { y = yc; um = u[c]; } }
            if (p < 16) gact[(size_t)tok * S5W + g * 16 + p] = (bf16_t)f2bf(gelu_tanh(y + dl * um));
        }
    }
}

__device__ __forceinline__ float attn_bound(const Args& a, int lane) {
    float mq = 0.f, mk = 0.f;
#pragma unroll
    for (int q = 0; q < 3; ++q) { mq = fmaxf(mq, fabsf(a.in[I_QKQG][lane + 64 * q])); mk = fmaxf(mk, fabsf(a.in[I_QKKG][lane + 64 * q])); }
#pragma unroll
    for (int o = 1; o < 64; o <<= 1) { mq = fmaxf(mq, __shfl_xor(mq, o)); mk = fmaxf(mk, __shfl_xor(mk, o)); }
    return mq * mk * 13.856406460551018f * 1.4426950408889634f;
}
__device__ __forceinline__ void attn_reference(const Args& a, const Frame& F) {
    FRAME_IDS(F);
    const bf16_t* Qn = (const bf16_t*)(F.ws + WS_QN); const bf16_t* Kn = (const bf16_t*)(F.ws + WS_KN); const bf16_t* Vn = (const bf16_t*)(F.ws + WS_VN);
    bf16_t* O = (bf16_t*)(F.ws + WS_O);
    LAS float* ql = (LAS float*)(F.lds + F.wave * 1024);
    const int lane = F_lane, gw = F.bx * NWAVES + F.wave, NGW = F.G * NWAVES;
    const float Mb = attn_bound(a, lane);
    for (int it = gw; it < NB * NH * SEQ; it += NGW) { const int s = it & 2047, bh = it >> 11, b = bh >> 4, h = bh & 15;
        const bf16_t* qp = Qn + ((size_t)bh * SEQ + s) * DQK;
#pragma unroll
        for (int q = 0; q < 3; ++q) ql[lane + 64 * q] = bf2f(qp[lane + 64 * q]);
        LDS_WAIT();
        const int nk = 64 * ((s >> 6) + 1);
        float o0 = 0.f, o1 = 0.f, l = 0.f;
        for (int k0 = 0; k0 < nk; k0 += 64) {
            const bf16_t* kp = Kn + ((size_t)bh * SEQ + k0 + lane) * DQK; float sc = 0.f;
            for (int d = 0; d < DQK; d += 8) { const u32x4 w = *(const u32x4*)(kp + d);
#pragma unroll
                for (int q = 0; q < 4; ++q) sc += bflo(w[q]) * ql[d + 2 * q] + bfhi(w[q]) * ql[d + 2 * q + 1]; }
            const float pr = __builtin_amdgcn_exp2f(sc - Mb); l += pr;
            for (int kk = 0; kk < 64; ++kk) { const float pk = __shfl(pr, kk); const unsigned w = *(const unsigned*)(Vn + ((size_t)bh * SEQ + k0 + kk) * DV + 2 * lane);
                o0 += pk * bflo(w); o1 += pk * bfhi(w); }
        }
        l = wave_sum(l); const float rl = 1.0f / l;
        *(unsigned*)(O + ((size_t)(b * SEQ + s)) * DM + h * DV + 2 * lane) = pk2(o0 * rl, o1 * rl);
        LDS_WAIT();
    }
}

namespace at {
constexpr int KVB = 64;
constexpr int SHM_V = KVB * DV * 2  , SHM_K = KVB * DQK * 2  ;
constexpr int NQR = 4;
constexpr int OFF_V = 0, OFF_K = 2 * SHM_V, OFF_WS = OFF_K + 2 * SHM_K  , OFF_QL = OFF_WS + NWAVES * 256  , OFF_OST = 0;
constexpr int OPITCH = 272;
static_assert(OFF_QL + NWAVES * (12 - NQR) * 1024 <= LDSCTL_OFF, "attention LDS map");
#define KSWZ(row, colB) ((row) * 384 + ((colB) ^ ((((row) >> 1) & 7) << 4)))
__device__ __forceinline__ int crow(int r, int hi) { return (r & 3) + 8 * (r >> 2) + 4 * hi; }
__device__ __forceinline__ int v_st(int k, int c) { const int kk = (k & ~0xC) | ((k & 4) << 1) | ((k & 8) >> 1); return ((kk >> 3) * 4 + (c >> 5)) * 512 + ((kk & 7) * 32 + (c & 31)) * 2; }
__device__ __forceinline__ int v_rd_base(int lane) { return ((lane & 3) << 3) | (((lane >> 2) & 3) << 6) | (((lane >> 4) & 1) << 5) | (((lane >> 5) & 1) << 8); }
constexpr int v_rd_off(int d0, int ks, int half) { return d0 * 512 + ks * 4096 + half * 2048; }
template <int OFF> __device__ __forceinline__ s16x4 tr_read(int vb) { s16x4 r; asm volatile("ds_read_b64_tr_b16 %0, %1 offset:%2" : "=&v"(r) : "v"(vb), "i"(OFF) : "memory"); return r; }
template <int D0> __device__ __forceinline__ void pv_one(f32x16& od, int vb, bf16x8 pa0, bf16x8 pa1, bf16x8 pa2, bf16x8 pa3) {
    const s16x4 l0 = tr_read<v_rd_off(D0, 0, 0)>(vb), h0 = tr_read<v_rd_off(D0, 0, 1)>(vb), l1 = tr_read<v_rd_off(D0, 1, 0)>(vb), h1 = tr_read<v_rd_off(D0, 1, 1)>(vb);
    const s16x4 l2 = tr_read<v_rd_off(D0, 2, 0)>(vb), h2 = tr_read<v_rd_off(D0, 2, 1)>(vb), l3 = tr_read<v_rd_off(D0, 3, 0)>(vb), h3 = tr_read<v_rd_off(D0, 3, 1)>(vb);
    asm volatile("s_waitcnt lgkmcnt(0)" ::: "memory"); SBAR();
#define PK(L, H) (bf16x8){L[0], L[1], L[2], L[3], H[0], H[1], H[2], H[3]}
    od = __builtin_amdgcn_mfma_f32_32x32x16_bf16(pa0, PK(l0, h0), od, 0, 0, 0);
    od = __builtin_amdgcn_mfma_f32_32x32x16_bf16(pa1, PK(l1, h1), od, 0, 0, 0);
    od = __builtin_amdgcn_mfma_f32_32x32x16_bf16(pa2, PK(l2, h2), od, 0, 0, 0);
    od = __builtin_amdgcn_mfma_f32_32x32x16_bf16(pa3, PK(l3, h3), od, 0, 0, 0);
#undef PK
}
__device__ __forceinline__ void pv_d0(f32x16* o, int vb, bf16x8 pa0, bf16x8 pa1, bf16x8 pa2, bf16x8 pa3) {
    pv_one<0>(o[0], vb, pa0, pa1, pa2, pa3); pv_one<1>(o[1], vb, pa0, pa1, pa2, pa3); pv_one<2>(o[2], vb, pa0, pa1, pa2, pa3); pv_one<3>(o[3], vb, pa0, pa1, pa2, pa3);
}
template <int BUF, int NQR> __device__ __forceinline__ void qkt(f32x16& p0, f32x16& p1, const int (&kb)[4], const bf16x8* qr, int qlb, float bias) {
#pragma unroll
    for (int r = 0; r < 16; ++r) { p0[r] = bias; p1[r] = bias; }
#pragma unroll
    for (int a = 0; a < 3; ++a)
#pragma unroll
        for (int b = 0; b < 4; ++b) { const int d0 = 4 * a + b;
            const bf16x8 b0 = *(const LAS bf16x8*)(kb[b] + BUF * SHM_K + a * 128);
            const bf16x8 b1 = *(const LAS bf16x8*)(kb[b] + BUF * SHM_K + a * 128 + 32 * 384);
            bf16x8 q; if (d0 < NQR) q = qr[d0]; else q = *(const LAS bf16x8*)(qlb + (d0 - NQR) * 1024);
            p0 = __builtin_amdgcn_mfma_f32_32x32x16_bf16(b0, q, p0, 0, 0, 0);
            p1 = __builtin_amdgcn_mfma_f32_32x32x16_bf16(b1, q, p1, 0, 0, 0); }
}
__device__ __forceinline__ void partialSM(f32x16& p0, f32x16& p1) {
#pragma unroll
    for (int r = 0; r < 16; ++r) p0[r] = __builtin_amdgcn_exp2f(p0[r]);
}
__device__ __forceinline__ void finishSM(f32x16& p0, f32x16& p1, float& l_reg, bf16x8& pa0, bf16x8& pa1, bf16x8& pa2, bf16x8& pa3) {
#pragma unroll
    for (int r = 0; r < 16; ++r) p1[r] = __builtin_amdgcn_exp2f(p1[r]);
    float ps = 0;
#pragma unroll
    for (int r = 0; r < 16; ++r) ps += p0[r];
#pragma unroll
    for (int r = 0; r < 16; ++r) ps += p1[r];
    { auto rr = __builtin_amdgcn_permlane32_swap(__float_as_uint(ps), __float_as_uint(ps), false, false); ps = __uint_as_float(rr[0]) + __uint_as_float(rr[1]); }
    l_reg += ps;
#define PK4(P, BASE, OUT) do { unsigned a0 = cvt_pk_bf16(P[BASE + 0], P[BASE + 1]), a1 = cvt_pk_bf16(P[BASE + 2], P[BASE + 3]);   \
    unsigned b0 = cvt_pk_bf16(P[BASE + 4], P[BASE + 5]), b1 = cvt_pk_bf16(P[BASE + 6], P[BASE + 7]);                              \
    auto r0 = __builtin_amdgcn_permlane32_swap(a0, b0, false, false); auto r1 = __builtin_amdgcn_permlane32_swap(a1, b1, false, false); \
    u32x4 w = {r0[0], r1[0], r0[1], r1[1]}; OUT = *reinterpret_cast<bf16x8*>(&w); } while (0)
    PK4(p0, 0, pa0); PK4(p0, 8, pa1); PK4(p1, 0, pa2); PK4(p1, 8, pa3);
#undef PK4
}
__device__ __forceinline__ void attn_qblock(const bf16_t* __restrict__ Qb, const bf16_t* __restrict__ Kh, const bf16_t* __restrict__ Vh, bf16_t* __restrict__ Ob, int qb, float Mb, LAS char* lds, const int wid,
                                            const float2* __restrict__ ropeb, const float* __restrict__ gq) {
    const int lane = fresh_lane(), tid = wid * 64 + lane, r32 = lane & 31, hi = lane >> 5;
    LAS char* V_lds = lds + OFF_V; LAS char* K_lds = lds + OFF_K;
    LAS float* li_l = (LAS float*)(lds + OFF_WS) + wid * 64;
    float l_reg = 0; f32x16 o[4] = {}; bf16x8 qr[NQR];
    const int qlb = (int)(uintptr_t)(lds + OFF_QL) + wid * ((12 - NQR) * 1024) + lane * 16;
    {
        const bf16_t* Qw = Qb + (size_t)(wid * 32 + r32) * (NH * DQK) + hi * 8;
        bf16x8 qf[12];
#pragma unroll
        for (int d0 = 0; d0 < 12; ++d0) qf[d0] = *(const bf16x8*)(Qw + d0 * 16);
        float ssq = 0.f;
#pragma unroll
        for (int d0 = 0; d0 < 12; ++d0)
#pragma unroll
            for (int j = 0; j < 8; ++j) { const float v = bf2f((unsigned short)qf[d0][j]); ssq += v * v; }
        ssq += __shfl_xor(ssq, 32);
        const float rn = QSCALE / sqrtf(ssq * (1.0f / DQK) + EPS);
        const float2* rp = ropeb + (size_t)(wid * 32 + r32) * 32 + hi * 8;
#pragma unroll
        for (int d0 = 0; d0 < 12; ++d0) { bf16x8 qn;
            if (d0 < 8) { const f32x4 g0 = *(const f32x4*)(gq + d0 * 16 + hi * 8), g1 = *(const f32x4*)(gq + d0 * 16 + hi * 8 + 4);
#pragma unroll
                for (int j = 0; j < 8; ++j) qn[j] = (short)f2bf(bf2f((unsigned short)qf[d0][j]) * rn * (j < 4 ? g0[j] : g1[j - 4])); }
            else { const int pp = (d0 - 8) & 1, da = 8 + pp, db = 10 + pp; const bool second = d0 >= 10;
#pragma unroll
                for (int j = 0; j < 8; ++j) { const float2 c = rp[pp * 16 + j];
                    const float y1 = bf2f((unsigned short)qf[da][j]) * rn * gq[128 + pp * 16 + hi * 8 + j], y2 = bf2f((unsigned short)qf[db][j]) * rn * gq[160 + pp * 16 + hi * 8 + j];
                    qn[j] = (short)f2bf(second ? (y2 * c.x + y1 * c.y) : (y1 * c.x - y2 * c.y)); } }
            if (d0 < NQR) qr[d0] = qn; else *(LAS bf16x8*)(qlb + (d0 - NQR) * 1024) = qn; }
    }
    const int sr = tid >> 4, sc = (tid & 15) * 8, vst0 = v_st(sr, sc), vst1 = v_st(32 + sr, sc);
    int kro[3], kst[3];
#pragma unroll
    for (int i = 0; i < 3; ++i) { const int q = tid + 512 * i, row = q / 24, c8 = q % 24; kro[i] = row * DQK + c8 * 8; kst[i] = KSWZ(row, c8 * 16); }
    const int vb0 = (int)(uintptr_t)V_lds + v_rd_base(lane);
    int kb[4];
#pragma unroll
    for (int b = 0; b < 4; ++b) kb[b] = (int)(uintptr_t)K_lds + r32 * 384 + ((b * 32 + hi * 16) ^ (((r32 >> 1) & 7) << 4));
    bf16x8 vs0, vs1, ks0, ks1, ks2;
#define SLOAD(k0) do { vs0 = *(const bf16x8*)(Vh + (size_t)((k0) + sr) * DV + sc); vs1 = *(const bf16x8*)(Vh + (size_t)((k0) + 32 + sr) * DV + sc); \
    ks0 = *(const bf16x8*)(Kh + (size_t)(k0) * DQK + kro[0]); ks1 = *(const bf16x8*)(Kh + (size_t)(k0) * DQK + kro[1]); ks2 = *(const bf16x8*)(Kh + (size_t)(k0) * DQK + kro[2]); } while (0)
#define SWRITE(b) do { *(LAS bf16x8*)(V_lds + (b) * SHM_V + vst0) = vs0; *(LAS bf16x8*)(V_lds + (b) * SHM_V + vst1) = vs1; \
    *(LAS bf16x8*)(K_lds + (b) * SHM_K + kst[0]) = ks0; *(LAS bf16x8*)(K_lds + (b) * SHM_K + kst[1]) = ks1; *(LAS bf16x8*)(K_lds + (b) * SHM_K + kst[2]) = ks2; } while (0)
    const int NT = 4 * qb + 4, jmax = 4 * qb + (wid >> 1);
    f32x16 pA0, pA1, pB0, pB1; bf16x8 pa0, pa1, pa2, pa3;
    SLOAD(0); asm volatile("s_waitcnt vmcnt(0)" ::: "memory"); SWRITE(0); __syncthreads();
    qkt<0, NQR>(pA0, pA1, kb, qr, qlb, -Mb); partialSM(pA0, pA1);
    SLOAD(KVB); asm volatile("s_waitcnt vmcnt(0)" ::: "memory"); SWRITE(1); __syncthreads();
    for (int j = 1; j + 1 < NT; j += 2) {
        SBAR(); if (j <= jmax) qkt<1, NQR>(pB0, pB1, kb, qr, qlb, -Mb);
        if (j - 1 <= jmax) finishSM(pA0, pA1, l_reg, pa0, pa1, pa2, pa3); SBAR();
        SLOAD((j + 1) * KVB); SBAR();
        if (j - 1 <= jmax) pv_d0(o, vb0, pa0, pa1, pa2, pa3); if (j <= jmax) partialSM(pB0, pB1);
        __syncthreads(); asm volatile("s_waitcnt vmcnt(0)" ::: "memory"); SWRITE(0);
        __syncthreads();
        SBAR(); if (j + 1 <= jmax) qkt<0, NQR>(pA0, pA1, kb, qr, qlb, -Mb);
        if (j <= jmax) finishSM(pB0, pB1, l_reg, pa0, pa1, pa2, pa3); SBAR();
        SLOAD((j + 2) * KVB); SBAR();
        if (j <= jmax) pv_d0(o, vb0 + SHM_V, pa0, pa1, pa2, pa3); if (j + 1 <= jmax) partialSM(pA0, pA1);
        __syncthreads(); asm volatile("s_waitcnt vmcnt(0)" ::: "memory"); SWRITE(1);
        __syncthreads();
    }
    SBAR(); if (NT - 1 <= jmax) qkt<1, NQR>(pB0, pB1, kb, qr, qlb, -Mb);
    if (NT - 2 <= jmax) { finishSM(pA0, pA1, l_reg, pa0, pa1, pa2, pa3); SBAR(); pv_d0(o, vb0, pa0, pa1, pa2, pa3); }
    if (NT - 1 <= jmax) { partialSM(pB0, pB1); finishSM(pB0, pB1, l_reg, pa0, pa1, pa2, pa3); SBAR(); pv_d0(o, vb0 + SHM_V, pa0, pa1, pa2, pa3); }
    __syncthreads();
    const int lane2 = fresh_lane(), r32b = lane2 & 31, hib = lane2 >> 5, wid2 = wid;
    LAS float* li2 = (LAS float*)(lds + OFF_WS) + wid2 * 64;
    if (hib == 0) li2[r32b] = l_reg; LDS_WAIT();
    LAS char* ost = lds + OFF_OST + wid2 * (32 * OPITCH) + hib * (4 * OPITCH) + r32b * 2;
#pragma unroll
    for (int r = 0; r < 16; ++r) { const int orc = (r & 3) + 8 * (r >> 2); const float rl = __builtin_amdgcn_rcpf(li2[orc + 4 * hib]);
#pragma unroll
        for (int d0 = 0; d0 < 4; ++d0) *(LAS bf16_t*)(ost + orc * OPITCH + d0 * 64) = (bf16_t)f2bf(o[d0][r] * rl); }
    LDS_WAIT();
    bf16_t* Ow = Ob + (size_t)(wid2 * 32 + (lane2 >> 4)) * DM + (lane2 & 15) * 8;
    const LAS char* ord = lds + OFF_OST + wid2 * (32 * OPITCH) + (lane2 >> 4) * OPITCH + (lane2 & 15) * 16;
#pragma unroll
    for (int i = 0; i < 8; ++i) { const u32x4 w = *(const LAS u32x4*)(ord + i * 4 * OPITCH); *(u32x4*)(Ow + (size_t)(i * 4) * DM) = w; }
    __syncthreads();
#undef SLOAD
#undef SWRITE
}
#undef KSWZ
}
__device__ __forceinline__ void p4_attention(const Args& a, const Frame& F) {
    FRAME_IDS(F);
    const bf16_t* qraw = (const bf16_t*)(F.ws + WS_QRAW); const bf16_t* Kn = (const bf16_t*)(F.ws + WS_KN); const bf16_t* Vn = (const bf16_t*)(F.ws + WS_VN);
    bf16_t* O = (bf16_t*)(F.ws + WS_O); const float2* rope = (const float2*)(F.ws + WS_ROPE);
    const float Mb = attn_bound(a, F_lane);
    for (int id = F.bx; id < NB * NH * 4; id += F.G) { const int x = id & 7, idx = id >> 3, bh = x + 8 * (idx >> 2), pr = idx & 3, b = bh >> 4, h = bh & 15;
        const bf16_t* Kh = Kn + (size_t)bh * SEQ * DQK; const bf16_t* Vh = Vn + (size_t)bh * SEQ * DV;
#pragma unroll 1
        for (int w = 0; w < 2; ++w) { const int qb = w ? pr : 7 - pr; const size_t tok0 = (size_t)b * SEQ + qb * 256;
            at::attn_qblock(qraw + tok0 * (NH * DQK) + h * DQK, Kh, Vh, O + tok0 * DM + h * DV, qb, Mb, (LAS char*)F.lds, F.wave, rope + tok0 * 32, a.in[I_QKQG]); }
    }
}

__device__ __forceinline__ void p8_norm2_router(const Args& a, const Frame& F, const float* x1) {
    FRAME_IDS(F);
    bf16_t* H2 = (bf16_t*)(F.ws + WS_H2); int* topi = (int*)(F.ws + WS_TOPI); float* topw = (float*)(F.ws + WS_TOPW);
    const float* wrp = (const float*)(F.ws + WS_SMALL + SM_WRP); const float* g2 = a.in[I_N2G];
    const int lane = F_lane, wave = F.wave, tid = F_tid, i = lane & 31, kk = lane >> 5;
    LAS uchar* xs = F.lds + wave * 8704;
    LAS float* part = (LAS float*)(F.lds + 69632);
    LAS float* ssqp = (LAS float*)(F.lds + 69632 + 33792);
    LAS float* logit = ssqp + 256;
    LAS float* rstdl = logit + 32 * 33;
    for (int tile = F.bx; tile < TT / 32; tile += F.G) {
        const int t0 = tile * 32;
        f32x16 acc = {}; float ssq = 0.f;
        for (int ch = 0; ch < 4; ++ch) { const int k0 = wave * 256 + ch * 64;
            f32x4 v[8];
#pragma unroll
            for (int j = 0; j < 8; ++j) v[j] = *(const f32x4*)(x1 + (size_t)(t0 + 4 * j + (lane >> 4)) * DM + k0 + (lane & 15) * 4);
#pragma unroll
            for (int j = 0; j < 8; ++j) *(LAS f32x4*)(xs + (4 * j + (lane >> 4)) * 272 + (lane & 15) * 16) = v[j];
            LDS_WAIT(); asm volatile("" ::: "memory");
            const float* wp = wrp + (size_t)(k0 + kk * 32) * NE + i;
#pragma unroll
            for (int s4 = 0; s4 < 8; ++s4) { const f32x4 xv = *(const LAS f32x4*)(xs + i * 272 + kk * 128 + s4 * 16);
#pragma unroll
                for (int q = 0; q < 4; ++q) { const float b = wp[(s4 * 4 + q) * NE]; acc = __builtin_amdgcn_mfma_f32_32x32x2f32(xv[q], b, acc, 0, 0, 0); ssq += xv[q] * xv[q]; } }
            LDS_WAIT(); asm volatile("" ::: "memory");
        }
#pragma unroll
        for (int r = 0; r < 16; ++r) part[(wave * 32 + (r & 3) + 8 * (r >> 2) + 4 * kk) * 33 + i] = acc[r];
        ssq += __shfl_xor(ssq, 32);
        if (kk == 0) ssqp[wave * 32 + i] = ssq;
        __syncthreads();
        { const int row = tid >> 4, e0 = (tid & 15) * 2; float s0 = 0.f, s1 = 0.f;
#pragma unroll
          for (int w = 0; w < 8; ++w) { s0 += part[(w * 32 + row) * 33 + e0]; s1 += part[(w * 32 + row) * 33 + e0 + 1]; }
          logit[row * 33 + e0] = s0; logit[row * 33 + e0 + 1] = s1;
          if (tid < 32) { float q = 0.f;
#pragma unroll
              for (int w = 0; w < 8; ++w) q += ssqp[w * 32 + tid];
              rstdl[tid] = 1.0f / sqrtf(q * (1.0f / DM) + EPS); } }
        __syncthreads();
        if (tid < 32) { const float rs = rstdl[tid]; float lg[32];
#pragma unroll
            for (int e = 0; e < 32; ++e) lg[e] = logit[tid * 33 + e] * rs + a.in[I_BR][e];
            int bi[4]; float bv[4];
#pragma unroll
            for (int k = 0; k < 4; ++k) { float m = -3.0e38f; int mi = 0;
#pragma unroll
                for (int e = 0; e < 32; ++e) { const bool used = (k > 0 && bi[0] == e) || (k > 1 && bi[1] == e) || (k > 2 && bi[2] == e); if (!used && lg[e] > m) { m = lg[e]; mi = e; } }
                bi[k] = mi; bv[k] = m; }
            const float e1 = __expf(bv[1] - bv[0]), e2 = __expf(bv[2] - bv[0]), e3 = __expf(bv[3] - bv[0]); const float rsum = 1.0f / (1.0f + e1 + e2 + e3);
            const int t = t0 + tid;
            *(int4*)(topi + 4 * t) = make_int4(bi[0], bi[1], bi[2], bi[3]); *(float4*)(topw + 4 * t) = make_float4(rsum, e1 * rsum, e2 * rsum, e3 * rsum); }
#pragma unroll 4
        for (int it = 0; it < 16; ++it) { const int idx = it * NTHREADS + tid, row = idx >> 8, c8 = (idx & 255) * 8; const float rs = rstdl[row];
            const f32x4 x0 = *(const f32x4*)(x1 + (size_t)(t0 + row) * DM + c8), x1v = *(const f32x4*)(x1 + (size_t)(t0 + row) * DM + c8 + 4);
            const f32x4 g0 = *(const f32x4*)(g2 + c8), g1 = *(const f32x4*)(g2 + c8 + 4);
#if MK_FP8_MOE
            const float rs4 = rs * FP8_ASCALE; u32x2 o; o.x = pk4_fp8(x0.x * rs4 * g0.x, x0.y * rs4 * g0.y, x0.z * rs4 * g0.z, x0.w * rs4 * g0.w); o.y = pk4_fp8(x1v.x * rs4 * g1.x, x1v.y * rs4 * g1.y, x1v.z * rs4 * g1.z, x1v.w * rs4 * g1.w);
            *(u32x2*)((uchar*)H2 + (size_t)(t0 + row) * DM + c8) = o; }
#else
            u32x4 o; o.x = pk2(x0.x * rs * g0.x, x0.y * rs * g0.y); o.y = pk2(x0.z * rs * g0.z, x0.w * rs * g0.w); o.z = pk2(x1v.x * rs * g1.x, x1v.y * rs * g1.y); o.w = pk2(x1v.z * rs * g1.z, x1v.w * rs * g1.w);
            *(u32x4*)(H2 + (size_t)(t0 + row) * DM + c8) = o; }
#endif
        __syncthreads();
    }
}

__device__ __forceinline__ void p9_routing(const Args& a, const Frame& F) {
    FRAME_IDS(F);
    const int* topi = (const int*)(F.ws + WS_TOPI); int* tpos = (int*)(F.ws + WS_TPOS); int* list = (int*)(F.ws + WS_LIST); int* counts = (int*)(F.ws + WS_SMALL + SM_COUNTS);
    LAS int* wtot = (LAS int*)F.lds;
    constexpr int NIT = TT / NWAVES / 64;
    for (int e = F.bx; e < NE; e += F.G) {
        __syncthreads();
        const int t0 = F.wave * (TT / NWAVES);
        int kk[NIT];
#pragma unroll
        for (int i = 0; i < NIT; ++i) { const int4 ti = *(const int4*)(topi + 4 * (t0 + i * 64 + F_lane)); kk[i] = (ti.x == e) ? 0 : (ti.y == e) ? 1 : (ti.z == e) ? 2 : (ti.w == e) ? 3 : -1; }
        int cnt = 0;
#pragma unroll
        for (int i = 0; i < NIT; ++i) cnt += __popcll(__ballot(kk[i] >= 0));
        if (F_lane == 0) wtot[F.wave] = cnt;
        __syncthreads();
        int base = 0, total = 0;
        for (int w = 0; w < NWAVES; ++w) { const int c = wtot[w]; if (w < F.wave) base += c; total += c; }
#pragma unroll
        for (int i = 0; i < NIT; ++i) { const int t = t0 + i * 64 + F_lane; const int k = kk[i];
            const unsigned long long bal = __ballot(k >= 0); const int pos = base + __popcll(bal & ((1ull << F_lane) - 1ull));
            if (k >= 0) { list[(size_t)e * TT + pos] = t; tpos[4 * t + k] = pos; }
            base += __popcll(bal); }
        for (int q = total + F_tid; q < ((total + 255) & ~255); q += NTHREADS) list[(size_t)e * TT + q] = 0;
        if (F_tid == 0) counts[e] = total;
    }
}
__device__ __forceinline__ void moe_tables(const Frame& F, LAS int* tab) {
    FRAME_IDS(F);
    const int* counts = (const int*)(F.ws + WS_SMALL + SM_COUNTS);
    __syncthreads();
    if (F_tid < NE) { const int c = counts[F_tid]; tab[F_tid] = c; const int nt = (c + 255) >> 8; tab[32 + F_tid] = nt; tab[128 + F_tid] = nt > 0 ? ((1 << 20) + nt - 1) / nt : 0; }
    __syncthreads();
    if (F_tid < NE) { const int e = F_tid, me = tab[32 + e]; int pre = 0, rank = 0;
        for (int q = 0; q < NE; ++q) { const int v = tab[32 + q]; pre += (q < e) ? v : 0; rank += (v > me || (v == me && q < e)) ? 1 : 0; }
        tab[64 + e] = pre; if (e == NE - 1) tab[96] = pre + me;
        const int q4 = rank >> 3, pos = rank & 7, xx = (q4 & 1) ? 7 - pos : pos; tab[160 + xx * 4 + q4] = e; }
    __syncthreads();
}

__device__ __forceinline__ void p10_permute(const Args& a, const Frame& F, const LAS int* tab) {
    FRAME_IDS(F);
    constexpr size_t ROWB = MK_FP8_MOE ? DM : 2 * DM;
    const uchar* H2 = F.ws + WS_H2; uchar* XP = F.ws + WS_XPERM; const int* list = (const int*)(F.ws + WS_LIST);
    const int ntiles = tab[96];
    for (int tile = F.bx; tile < ntiles; tile += F.G) {
        int e = 0;
#pragma unroll 1
        for (int q = 1; q < NE; ++q) if (tab[64 + q] <= tile) e = q;
        const int p0 = (tile - tab[64 + e]) * 256;
        for (int r0 = F.wave * 32; r0 < F.wave * 32 + 32; r0 += 8) { int tok[8]; u32x4 v[8][ROWB / 1024];
#pragma unroll
            for (int q = 0; q < 8; ++q) tok[q] = list[(size_t)e * TT + p0 + r0 + q];
#pragma unroll
            for (int q = 0; q < 8; ++q)
#pragma unroll
                for (int c = 0; c < (int)(ROWB / 1024); ++c) v[q][c] = *(const u32x4*)(H2 + (size_t)tok[q] * ROWB + c * 1024 + F_lane * 16);
#pragma unroll
            for (int q = 0; q < 8; ++q)
#pragma unroll
                for (int c = 0; c < (int)(ROWB / 1024); ++c) *(u32x4*)(XP + ((size_t)tile * 256 + r0 + q) * ROWB + c * 1024 + F_lane * 16) = v[q][c]; }
    }
}

__device__ __forceinline__ void p12_combine(const Args& a, const Frame& F, float* out, const LAS int* tab) {
    FRAME_IDS(F);
    const int* topi = (const int*)(F.ws + WS_TOPI); const float* topw = (const float*)(F.ws + WS_TOPW); const int* tpos = (const int*)(F.ws + WS_TPOS);
    const int lane = F_lane, gw = F.bx * NWAVES + F.wave, NGW = F.G * NWAVES;
#if MK_FP8_MOE
    const uchar* ys = F.ws + WS_YSLOT;
    for (int t = gw; t < TT; t += NGW) {
        const int4 ti = *(const int4*)(topi + 4 * t), tp = *(const int4*)(tpos + 4 * t); float4 tw = *(const float4*)(topw + 4 * t);
        tw.x *= 1.0f / FP8_YSCALE; tw.y *= 1.0f / FP8_YSCALE; tw.z *= 1.0f / FP8_YSCALE; tw.w *= 1.0f / FP8_YSCALE;
        const uchar* r0 = ys + ((size_t)tab[64 + ti.x] * 256 + tp.x) * DM; const uchar* r1 = ys + ((size_t)tab[64 + ti.y] * 256 + tp.y) * DM;
        const uchar* r2 = ys + ((size_t)tab[64 + ti.z] * 256 + tp.z) * DM; const uchar* r3 = ys + ((size_t)tab[64 + ti.w] * 256 + tp.w) * DM;
        float* orow = out + (size_t)t * DM;
        u32x2 y0[4], y1[4], y2[4], y3[4]; f32x4 xa[4], xb[4];
#pragma unroll
        for (int j = 0; j < 4; ++j) { const int c = j * 512 + lane * 8; y0[j] = *(const u32x2*)(r0 + c); y1[j] = *(const u32x2*)(r1 + c); y2[j] = *(const u32x2*)(r2 + c); y3[j] = *(const u32x2*)(r3 + c);
            xa[j] = *(const f32x4*)(orow + c); xb[j] = *(const f32x4*)(orow + c + 4); }
#pragma unroll
        for (int j = 0; j < 4; ++j) { const int c = j * 512 + lane * 8; f32x4 x0 = xa[j], x1 = xb[j];
#define ACC4(X, Y, W) do { const f32x2 lo = __builtin_amdgcn_cvt_pk_f32_fp8((int)(Y), false), hi2 = __builtin_amdgcn_cvt_pk_f32_fp8((int)(Y), true); X[0] += (W) * lo.x; X[1] += (W) * lo.y; X[2] += (W) * hi2.x; X[3] += (W) * hi2.y; } while (0)
            ACC4(x0, y0[j].x, tw.x); ACC4(x1, y0[j].y, tw.x); ACC4(x0, y1[j].x, tw.y); ACC4(x1, y1[j].y, tw.y);
            ACC4(x0, y2[j].x, tw.z); ACC4(x1, y2[j].y, tw.z); ACC4(x0, y3[j].x, tw.w); ACC4(x1, y3[j].y, tw.w);
#undef ACC4
            *(f32x4*)(orow + c) = x0; *(f32x4*)(orow + c + 4) = x1; }
    }
#else
    const bf16_t* ys = (const bf16_t*)(F.ws + WS_YSLOT);
    for (int t = gw; t < TT; t += NGW) {
        const int4 ti = *(const int4*)(topi + 4 * t), tp = *(const int4*)(tpos + 4 * t); const float4 tw = *(const float4*)(topw + 4 * t);
        const bf16_t* r0 = ys + ((size_t)tab[64 + ti.x] * 256 + tp.x) * DM; const bf16_t* r1 = ys + ((size_t)tab[64 + ti.y] * 256 + tp.y) * DM;
        const bf16_t* r2 = ys + ((size_t)tab[64 + ti.z] * 256 + tp.z) * DM; const bf16_t* r3 = ys + ((size_t)tab[64 + ti.w] * 256 + tp.w) * DM;
        float* orow = out + (size_t)t * DM;
#pragma unroll
        for (int j = 0; j < 4; ++j) { const int c = j * 512 + lane * 8;
            const u32x4 a0 = *(const u32x4*)(r0 + c), a1 = *(const u32x4*)(r1 + c), a2 = *(const u32x4*)(r2 + c), a3 = *(const u32x4*)(r3 + c);
            f32x4 x0 = *(const f32x4*)(orow + c), x1 = *(const f32x4*)(orow + c + 4);
#pragma unroll
            for (int q = 0; q < 2; ++q) {
                x0[2 * q] += tw.x * bflo(a0[q]) + tw.y * bflo(a1[q]) + tw.z * bflo(a2[q]) + tw.w * bflo(a3[q]);
                x0[2 * q + 1] += tw.x * bfhi(a0[q]) + tw.y * bfhi(a1[q]) + tw.z * bfhi(a2[q]) + tw.w * bfhi(a3[q]);
                x1[2 * q] += tw.x * bflo(a0[2 + q]) + tw.y * bflo(a1[2 + q]) + tw.z * bflo(a2[2 + q]) + tw.w * bflo(a3[2 + q]);
                x1[2 * q + 1] += tw.x * bfhi(a0[2 + q]) + tw.y * bfhi(a1[2 + q]) + tw.z * bfhi(a2[2 + q]) + tw.w * bfhi(a3[2 + q]); }
            *(f32x4*)(orow + c) = x0; *(f32x4*)(orow + c + 4) = x1; }
    }
#endif
}

constexpr int NPHASE = 14;
__global__ void __launch_bounds__(NTHREADS, 2) mk_fwd(Args a) {
    extern __shared__ __attribute__((aligned(16))) uchar lds_raw[];
    Frame F; F.lds = (LAS uchar*)lds_raw; F.ws = a.ws; F.wave = __builtin_amdgcn_readfirstlane(threadIdx.x >> 6); F.G = gridDim.x; F.bx = blockIdx.x;
    FRAME_IDS(F);
    volatile LAS unsigned* MISC = (volatile LAS unsigned*)(F.lds + MISC_OFF);
    LAS int* tab = (LAS int*)(F.lds + LDSCTL_OFF + 512);
    for (int u = F_tid; u < (LDS_BYTES - LDSCTL_OFF) / 4; u += NTHREADS) ((LAS unsigned*)(F.lds + LDSCTL_OFF))[u] = 0u;
    __syncthreads();
    XcdBarrier bar; bar.bar = (unsigned*)(a.ws + WS_CTL) + CW_BAR; bar.x = 0; bar.st = nullptr; bar.wave = F.wave;
    const int lo = a.ph_lo, hi = a.ph_hi;
    if (hi - lo > 1) bar = xcd_barrier_post((unsigned*)(a.ws + WS_CTL) + CW_BAR, MISC + 8, F.wave);
#ifndef MK_PHASE_MASK
#define MK_PHASE_MASK 0xffff
#endif
#define IN(k) (((MK_PHASE_MASK >> (k)) & 1) && lo <= (k) && (k) < hi)
#ifdef MK_PROBE_LO
    volatile LAS unsigned long long* pr_t = (volatile LAS unsigned long long*)(F.lds + LDSCTL_OFF + 64);
#ifdef MK_PROBE_CLK
#define PROBE_NOW() __builtin_amdgcn_s_memtime()
#else
#define PROBE_NOW() __builtin_amdgcn_s_memrealtime()
#endif
#define PROBE_AT(k) do { if ((k) == MK_PROBE_LO && F.wave == 0 && fresh_lane() == 0) pr_t[0] = PROBE_NOW(); if ((k) == MK_PROBE_HI + 1 && F.wave == 0 && fresh_lane() == 0) pr_t[1] = PROBE_NOW(); } while (0)
#else
#define PROBE_AT(k) do { } while (0)
#endif
#define SEAM(k) do { if (IN(k) && IN((k) + 1)) xcd_barrier(bar); } while (0)
    LAS uchar* ring = F.lds;
    uchar* ws = a.ws;
    const int G = F.G, bx = F.bx;

    PROBE_AT(0);
    if (IN(0)) { p0_prologue(a, F); } SEAM(0); PROBE_AT(1);

    if (IN(1)) {
        gm::ProbDense P; P.init((const bf16_t*)(ws + WS_H), DM, (const bf16_t*)(ws + WS_WIN), DM, MK_FP8_INPROJ ? DM / 2 : DM, TT, NPROJ, G, bx);
        EpiInProj E{(bf16_t*)(ws + WS_PROJ), (bf16_t*)(ws + WS_APACK), a.in[I_BG], (float*)(ws + WS_SSQP)};
        gm::gemm_phase<gm::ProbDense, EpiInProj, false, MK_FP8_INPROJ != 0>(ring, P, E, F.wave);
    } SEAM(1); PROBE_AT(2);

    if (IN(2)) {
        { gm::ProbDense P; P.init((const bf16_t*)(ws + WS_PROJ) + C_QLAT, NPROJ, (const bf16_t*)(ws + WS_WUQ), QLORA, QLORA, TT, NH * DQK, G, bx);
          EpiStoreScaled<0, 8, QLORA> E{(bf16_t*)(ws + WS_QRAW), NH * DQK, (const float*)(ws + WS_SSQP)}; gm::gemm_phase<gm::ProbDense, EpiStoreScaled<0, 8, QLORA>, false>(ring, P, E, F.wave); }
        { gm::ProbDense P; P.init((const bf16_t*)(ws + WS_PROJ) + C_KVLAT, NPROJ, (const bf16_t*)(ws + WS_WUKV), KVLORA, KVLORA, TT, NH * 256, G, bx);
          EpiKV E{(bf16_t*)(ws + WS_KVRAW), (bf16_t*)(ws + WS_VN), (const float*)(ws + WS_SSQP)}; gm::gemm_phase<gm::ProbDense, EpiKV, false>(ring, P, E, F.wave); }
#if MK_FAST_S5
        { ProbS5 P{(const bf16_t*)(ws + WS_APACK), (const bf16_t*)(ws + WS_WS5), APK, 256, 4, G, bx};
          EpiS5State E{(float*)(ws + WS_SCH)}; gm::gemm_phase<ProbS5, EpiS5State, false>(ring, P, E, F.wave); }
#endif
    } SEAM(2); PROBE_AT(3);

    if (IN(3)) {
#if MK_FAST_S5
        p3_scan(a, F);
#endif
        p3_prep(a, F);
    } SEAM(3); PROBE_AT(4);

    if (IN(4)) {
#if MK_FAST_S5
        { ProbS5 P{(const bf16_t*)(ws + WS_APACK), (const bf16_t*)(ws + WS_TWC), APK, APK, 6, G, bx};
          EpiS5Out E{(bf16_t*)(ws + WS_GACT)}; gm::gemm_phase<ProbS5, EpiS5Out, false>(ring, P, E, F.wave); }
#else
        s5_reference(a, F);
#endif
#if MK_FAST_ATTN
        p4_attention(a, F);
#else
        attn_reference(a, F);
#endif
    } SEAM(4); PROBE_AT(5);

    if (IN(5)) {
        { gm::ProbDense P; P.init((const bf16_t*)(ws + WS_GACT), S5W, (const bf16_t*)(ws + WS_WGLU), S5W, S5W, TT, S5W, G, bx);
          EpiSide<0> E{(bf16_t*)(ws + WS_Y2), S5W, (const bf16_t*)(ws + WS_GACT), S5W, nullptr, 0}; gm::gemm_phase<gm::ProbDense, EpiSide<0>, false>(ring, P, E, F.wave); }
        { gm::ProbDense P; P.init((const bf16_t*)(ws + WS_O), DM, (const bf16_t*)(ws + WS_WOMLA), DM, DM, TT, DM, G, bx);
          EpiSide<1> E{(bf16_t*)(ws + WS_MA), DM, (const bf16_t*)(ws + WS_PROJ) + C_GA, NPROJ, nullptr, 0}; gm::gemm_phase<gm::ProbDense, EpiSide<1>, false>(ring, P, E, F.wave); }
    } SEAM(5); PROBE_AT(6);

    if (IN(6)) {
        gm::ProbDense P; P.init((const bf16_t*)(ws + WS_Y2), S5W, (const bf16_t*)(ws + WS_WOS5), S5W, S5W, TT, DM, G, bx);
        EpiSide<2> E{(bf16_t*)(ws + WS_M), DM, (const bf16_t*)(ws + WS_PROJ) + C_GB, NPROJ, (const bf16_t*)(ws + WS_MA), DM}; gm::gemm_phase<gm::ProbDense, EpiSide<2>, false>(ring, P, E, F.wave);
    } SEAM(6); PROBE_AT(7);

    if (IN(7)) {
        gm::ProbDense P; P.init((const bf16_t*)(ws + WS_M), DM, (const bf16_t*)(ws + WS_WOUT), DM, DM, TT, DM, G, bx);
        EpiResidF32 E{a.in[I_X], a.out}; gm::gemm_phase<gm::ProbDense, EpiResidF32, false>(ring, P, E, F.wave);
    } SEAM(7); PROBE_AT(8);

    if (IN(8)) { p8_norm2_router(a, F, a.out); } SEAM(8); PROBE_AT(9);
    if (IN(9)) { p9_routing(a, F); } SEAM(9); PROBE_AT(10);

    if (IN(10) || IN(11) || IN(12) || IN(13)) moe_tables(F, tab);
    const int xl = bx & 7, rk = bx >> 3, nrk = (G - xl + 7) >> 3;
    if (IN(10)) { p10_permute(a, F, tab); } SEAM(10); PROBE_AT(11);
    if (IN(11)) {
        ProbMoE P{(const bf16_t*)(ws + WS_XPERM), (const bf16_t*)(ws + WS_W1), DM, DM, MK_FP8_MOE ? DM / 128 : DM / 64, 16, (size_t)4096 * DM, xl, rk, nrk}; P.load(tab);
        EpiSwiglu E{(bf16_t*)(ws + WS_HACT), a.in[I_BGATE], a.in[I_BUP], tab}; gm::gemm_phase<ProbMoE, EpiSwiglu, false, MK_FP8_MOE != 0>(ring, P, E, F.wave);
    } SEAM(11); PROBE_AT(12);
    if (IN(12)) {
        ProbMoE P{(const bf16_t*)(ws + WS_HACT), (const bf16_t*)(ws + WS_W2), DFF, DFF, MK_FP8_MOE ? DFF / 128 : DFF / 64, 8, (size_t)DM * DFF, xl, rk, nrk}; P.load(tab);
        EpiDown E{(bf16_t*)(ws + WS_YSLOT), a.in[I_BDOWN], tab}; gm::gemm_phase<ProbMoE, EpiDown, false, MK_FP8_MOE != 0>(ring, P, E, F.wave);
    } SEAM(12); PROBE_AT(13);
    if (IN(13)) { p12_combine(a, F, a.out, tab); }
    PROBE_AT(14);
#ifdef MK_PROBE_LO
#ifdef MK_PROBE_CLK
#define PROBE_DIV 24ull
#else
#define PROBE_DIV 1ull
#endif
    if (blockIdx.x == 0 && F.wave == 0 && fresh_lane() == 0) { const unsigned long long dt = (pr_t[1] - pr_t[0]) / PROBE_DIV * MK_PROBE_X, te = __builtin_amdgcn_s_memrealtime();
        while (__builtin_amdgcn_s_memrealtime() - te < dt) __builtin_amdgcn_s_sleep(32); }
#endif
#undef IN
#undef SEAM
}

extern "C" void kernel_launch(void* const* d_in, const int* in_sizes, int n_in, void* d_out, int out_size, void* d_ws, size_t ws_size, hipStream_t stream) {
    static int grid = 0;
    if (grid == 0) {
        if (n_in != 32 || in_sizes[0] != TT * DM || out_size != TT * DM || ws_size < WS_END) {
            fprintf(stderr, "kernel_launch: shape mismatch: n_in %d in0 %d out %d ws %zu (need %zu); nothing launched\n", n_in, n_in > 0 ? in_sizes[0] : -1, out_size, ws_size, (size_t)WS_END); grid = -1; return; }
        int dev = 0, cus = 0, per_cu = 0;
        if (hipGetDevice(&dev) != hipSuccess || hipDeviceGetAttribute(&cus, hipDeviceAttributeMultiprocessorCount, dev) != hipSuccess) { fprintf(stderr, "kernel_launch: device query failed\n"); grid = -1; return; }
        if (hipFuncSetAttribute((const void*)mk_fwd, hipFuncAttributeMaxDynamicSharedMemorySize, LDS_BYTES) != hipSuccess) { fprintf(stderr, "kernel_launch: hipFuncSetAttribute failed\n"); grid = -1; return; }
        if (hipOccupancyMaxActiveBlocksPerMultiprocessor(&per_cu, (const void*)mk_fwd, NTHREADS, LDS_BYTES) != hipSuccess || per_cu < 1)
            fprintf(stderr, "kernel_launch: note: occupancy query reports %d workgroups per CU\n", per_cu);
        (void)hipGetLastError();
        grid = cus - (cus % 8);
        if (grid < 8) grid = 8;
    }
    if (grid < 0) return;
    if (hipMemsetAsync((char*)d_ws + WS_CTL, 0, CTL_ZERO_BYTES, stream) != hipSuccess) { fprintf(stderr, "kernel_launch: memset failed\n"); return; }
    Args a{};
    for (int i = 0; i < 32; ++i) a.in[i] = (const float*)d_in[i];
    a.out = (float*)d_out; a.ws = (uchar*)d_ws;
#if MK_ONE_LAUNCH
    a.ph_lo = 0; a.ph_hi = NPHASE;
    hipLaunchKernelGGL(mk_fwd, dim3(grid), dim3(NTHREADS), LDS_BYTES, stream, a);
#else
    for (int p = 0; p < NPHASE; ++p) { a.ph_lo = p; a.ph_hi = p + 1; hipLaunchKernelGGL(mk_fwd, dim3(grid), dim3(NTHREADS), LDS_BYTES, stream, a); }
#endif
    const hipError_t le = hipPeekAtLastError();
    if (le != hipSuccess) fprintf(stderr, "kernel_launch: launch failed: %s\n", hipGetErrorName(le));
}
```

```cpp
#include <hip/hip_runtime.h>
#include <cstdio>
#include <cstdint>

#ifndef MK_ONE_LAUNCH
#define MK_ONE_LAUNCH 1
#endif
#ifndef MK_FAST_GEMM
#define MK_FAST_GEMM 1
#endif
#ifndef MK_FAST_ATTN
#define MK_FAST_ATTN 1
#endif
#ifndef MK_FAST_S5
#define MK_FAST_S5 1
#endif

#ifndef MK_FP8_MOE
#define MK_FP8_MOE 1
#endif
#define LAS __attribute__((address_space(3)))
#define GAS __attribute__((address_space(1)))
typedef unsigned short bf16_t;
typedef short bf16x8 __attribute__((ext_vector_type(8)));
typedef short s16x4 __attribute__((ext_vector_type(4)));
typedef float f32x2 __attribute__((ext_vector_type(2)));
typedef float f32x4 __attribute__((ext_vector_type(4)));
typedef float f32x16 __attribute__((ext_vector_type(16)));
typedef unsigned u32x2 __attribute__((ext_vector_type(2)));
typedef unsigned u32x4 __attribute__((ext_vector_type(4)));
typedef unsigned char uchar;
typedef int v4i __attribute__((ext_vector_type(4)));
typedef int v8i __attribute__((ext_vector_type(8)));
constexpr float FP8_YSCALE = 16.0f;
#ifndef MK_FP8_INPROJ
#define MK_FP8_INPROJ 1
#endif
constexpr float FP8_ASCALE = 4.0f, FP8_WSCALE = 64.0f;
__device__ __forceinline__ float sat8(float x) { return __builtin_amdgcn_fmed3f(x, -448.0f, 448.0f); }
__device__ __forceinline__ unsigned pk4_fp8(float a, float b, float c, float d) { int w = __builtin_amdgcn_cvt_pk_fp8_f32(a, b, 0, false); w = __builtin_amdgcn_cvt_pk_fp8_f32(c, d, w, true); return (unsigned)w; }
__device__ __forceinline__ unsigned pk4_fp8c(float a, float b, float c, float d) { return pk4_fp8(sat8(a), sat8(b), sat8(c), sat8(d)); }

constexpr int NB = 8, SEQ = 2048, TT = NB * SEQ, DM = 2048;
constexpr int NH = 16, DNOPE = 128, DROPE = 64, DQK = 192, DV = 128, QLORA = 512, KVLORA = 256;
constexpr int S5W = 1024, S5G = 64, S5C = 16, S5P = 64, S5L = 16;
constexpr int NE = 32, TOPK = 4, DFF = 2048;
constexpr int IN_PROJ = QLORA + KVLORA + DROPE + S5W + 2 * DM;
constexpr int NPROJ = 6144;
constexpr int C_QLAT = 0, C_KVLAT = 512, C_U = 768, C_GA = 1792, C_GB = 3840, C_KR = 5888;
constexpr float EPS = 1e-6f;
constexpr int MAXSLOT_TILES = (TT * TOPK) / 256 + NE;
constexpr int MAXSLOTS = MAXSLOT_TILES * 256;
constexpr int NCHUNK = TT / S5L;
constexpr int APK = 384;

constexpr size_t MiB = 1u << 20;
constexpr size_t WS_CTL = 0, CTL_ZERO_BYTES = 1 * MiB;
constexpr size_t WS_WIN = 1 * MiB;
constexpr size_t WS_WUQ = WS_WIN + 24 * MiB;
constexpr size_t WS_WUKV = WS_WUQ + 3 * MiB;
constexpr size_t WS_WOMLA = WS_WUKV + 2 * MiB;
constexpr size_t WS_WGLU = WS_WOMLA + 8 * MiB;
constexpr size_t WS_WOS5 = WS_WGLU + 2 * MiB;
constexpr size_t WS_WOUT = WS_WOS5 + 4 * MiB;
constexpr size_t WS_TWC = WS_WOUT + 8 * MiB;
constexpr size_t WS_WS5 = WS_TWC + 12 * MiB;
constexpr size_t WS_ROPE = WS_WS5 + 8 * MiB;
constexpr size_t WS_SMALL = WS_ROPE + 4 * MiB;
constexpr size_t WS_W1 = WS_SMALL + 1 * MiB;
constexpr size_t WS_W2 = WS_W1 + 512 * MiB;
constexpr size_t WS_ACT = WS_W2 + 256 * MiB;
constexpr size_t WS_H = WS_ACT;
constexpr size_t WS_PROJ = WS_H + 64 * MiB;
constexpr size_t WS_APACK = WS_PROJ + 192 * MiB;
constexpr size_t WS_SCH = WS_APACK + 48 * MiB;
constexpr size_t WS_QRAW = WS_SCH + 32 * MiB;
constexpr size_t WS_KVRAW = WS_QRAW + 96 * MiB;
constexpr size_t WS_QN = WS_KVRAW + 128 * MiB;
constexpr size_t WS_KN = WS_QN + 96 * MiB;
constexpr size_t WS_VN = WS_KN + 96 * MiB;
constexpr size_t WS_O = WS_VN + 64 * MiB;
constexpr size_t WS_GACT = WS_O + 64 * MiB;
constexpr size_t WS_Y2 = WS_GACT + 32 * MiB;
constexpr size_t WS_MA = WS_Y2 + 32 * MiB;
constexpr size_t WS_M = WS_MA + 64 * MiB;
constexpr size_t WS_SSQP = WS_M + 64 * MiB;
constexpr size_t WS_ENDA = WS_SSQP + 1 * MiB;
constexpr size_t WS_H2 = WS_ACT;
constexpr size_t WS_HACT = WS_H2 + 64 * MiB;
constexpr size_t WS_YSLOT = WS_HACT + 288 * MiB;
constexpr size_t WS_TOPI = WS_YSLOT + 288 * MiB;
constexpr size_t WS_TOPW = WS_TOPI + 1 * MiB;
constexpr size_t WS_TPOS = WS_TOPW + 1 * MiB;
constexpr size_t WS_LIST = WS_TPOS + 1 * MiB;
constexpr size_t WS_XPERM = WS_ACT + 704 * MiB;
constexpr size_t WS_ENDB = WS_XPERM + 288 * MiB;
constexpr size_t WS_END = WS_ENDA > WS_ENDB ? WS_ENDA : WS_ENDB;
constexpr size_t SM_A16 = 0;
constexpr size_t SM_COUNTS = 64 * 1024;
constexpr size_t SM_WRP = 128 * 1024;
constexpr int CW_BAR = 4096;

constexpr int RING_BYTES = 131072;
constexpr int LDS_BYTES = 163840;
constexpr int LDSCTL_OFF = LDS_BYTES - 4096;
constexpr int MISC_OFF = LDSCTL_OFF;
constexpr int GTAB_OFF = LDSCTL_OFF + 2048;
constexpr int NWAVES = 8, NTHREADS = 512;

#define LDS_WAIT() asm volatile("s_waitcnt lgkmcnt(0)" ::: "memory")
#define VM_WAIT() asm volatile("s_waitcnt vmcnt(0)" ::: "memory")
#define SBAR() __builtin_amdgcn_sched_barrier(0)

__device__ __forceinline__ unsigned f2bf(float f) { unsigned u = __builtin_bit_cast(unsigned, f); return (u + 0x7fffu + ((u >> 16) & 1u)) >> 16; }
__device__ __forceinline__ unsigned pk2(float lo, float hi) { return f2bf(lo) | (f2bf(hi) << 16); }
__device__ __forceinline__ float bf2f(unsigned b) { return __builtin_bit_cast(float, b << 16); }
__device__ __forceinline__ float bflo(unsigned w) { return __builtin_bit_cast(float, w << 16); }
__device__ __forceinline__ float bfhi(unsigned w) { return __builtin_bit_cast(float, w & 0xffff0000u); }
__device__ __forceinline__ unsigned cvt_pk_bf16(float lo, float hi) { unsigned r; asm volatile("v_cvt_pk_bf16_f32 %0, %1, %2" : "=v"(r) : "v"(lo), "v"(hi)); return r; }
__device__ __forceinline__ float sigmoidf_(float x) { return __builtin_amdgcn_rcpf(1.0f + __builtin_amdgcn_exp2f(-1.4426950408889634f * x)); }
__device__ __forceinline__ f32x2 sig2_t(f32x2 t) { f32x2 d; d.x = __builtin_amdgcn_exp2f(t.x); d.y = __builtin_amdgcn_exp2f(t.y); d = d + 1.0f; f32x2 r; r.x = __builtin_amdgcn_rcpf(d.x); r.y = __builtin_amdgcn_rcpf(d.y); return r; }
__device__ __forceinline__ f32x2 gelu_tanh2(f32x2 x) { constexpr float C = -2.0f * 0.7978845608028654f * 1.4426950408889634f; const f32x2 p = (x * x) * (C * 0.044715f) + C; return x * sig2_t(x * p); }
__device__ __forceinline__ float gelu_tanh(float x) {
    const float u = 0.7978845608028654f * (x + 0.044715f * x * x * x);
    const float e = __builtin_amdgcn_exp2f(2.8853900817779268f * u);
    const float th = 1.0f - 2.0f * __builtin_amdgcn_rcpf(e + 1.0f);
    return 0.5f * x * (1.0f + th);
}
__device__ __forceinline__ int fresh_lane() { int z = 0; asm volatile("" : "+s"(z)); return (int)__builtin_amdgcn_mbcnt_hi(~0u, __builtin_amdgcn_mbcnt_lo(~0u, (unsigned)z)); }
__device__ __forceinline__ float wave_sum(float v) {
#pragma unroll
    for (int o = 1; o < 64; o <<= 1) v += __shfl_xor(v, o);
    return v;
}

#define XB_TMO      128
#define XB_XCNT(j)  (256  + 64 * (j))
#define XB_XSUB(j)  (1280 + 64 * (j))
#define XB_XGEN(j)  (2304 + 64 * (j))
#define XB_TOP      3328
#define XB_TOPGEN   3392
#define XCD_BAR_WORDS 3456
#define XB_SPIN_CAP (1u << 18)
__device__ __forceinline__ unsigned xb_ld(unsigned* p)              { return __hip_atomic_load(p, __ATOMIC_RELAXED, __HIP_MEMORY_SCOPE_AGENT); }
__device__ __forceinline__ unsigned xb_add(unsigned* p, unsigned v) { return __hip_atomic_fetch_add(p, v, __ATOMIC_RELAXED, __HIP_MEMORY_SCOPE_AGENT); }
__device__ __forceinline__ unsigned xb_xcc_id() { return (unsigned)__builtin_amdgcn_s_getreg((3 << 11) | 20) & 0xFu; }
#define XB_SPIN(cond, bar) do { unsigned _sp = 0; while (cond) { __builtin_amdgcn_s_sleep(1); \
    if ((++_sp & 255u) == 0u) { if (xb_ld(&(bar)[XB_TMO])) break; if (_sp > XB_SPIN_CAP) { atomicAdd(&(bar)[XB_TMO], 1u); break; } } } } while (0)
struct XcdBarrier { unsigned* bar; unsigned x; volatile LAS unsigned* st; int wave; };
__device__ __forceinline__ XcdBarrier xcd_barrier_post(unsigned* bar, volatile LAS unsigned* st, int wave) {
    XcdBarrier b; b.bar = bar; b.x = xb_xcc_id(); b.st = st; b.wave = wave;
    if (wave == 0 && fresh_lane() == 0) (void)xb_add(&bar[XB_XCNT(b.x)], 1u);
    return b;
}
__device__ __forceinline__ void xcd_barrier_complete(unsigned* bar, unsigned x, unsigned& nloc, unsigned& nx) {
    const unsigned G = gridDim.x * gridDim.y * gridDim.z;
    unsigned sum, cnt, mine, sp = 0u;
    for (;;) {
        sum = 0u; cnt = 0u; mine = 0u;
#pragma unroll
        for (unsigned j = 0; j < 16; ++j) { const unsigned c = xb_ld(&bar[XB_XCNT(j)]); sum += c; cnt += (c > 0u) ? 1u : 0u; mine = (j == x) ? c : mine; }
        if (sum == G) break;
        __builtin_amdgcn_s_sleep(1);
        if ((++sp & 255u) == 0u) { if (xb_ld(&bar[XB_TMO])) break; if (sp > XB_SPIN_CAP) { atomicAdd(&bar[XB_TMO], 1u); break; } }
    }
    nloc = mine > 0u ? mine : 1u; nx = cnt > 0u ? cnt : 1u;
}
__device__ __forceinline__ void xcd_barrier(const XcdBarrier& b) {
    asm volatile("s_waitcnt vmcnt(0)" ::: "memory");
    __syncthreads();
    if (b.wave == 0 && fresh_lane() == 0) {
        unsigned* bar = b.bar;
        __builtin_amdgcn_s_waitcnt(0);
        unsigned nloc = b.st[0], nx = b.st[1];
        if (nloc == 0u) { xcd_barrier_complete(bar, b.x, nloc, nx); b.st[0] = nloc; b.st[1] = nx; }
        const unsigned old = xb_add(&bar[XB_XSUB(b.x)], 1u);
        const unsigned gen = old / nloc;
        if (old + 1u == (gen + 1u) * nloc) {
            __builtin_amdgcn_fence(__ATOMIC_RELEASE, "agent");
            asm volatile("s_waitcnt vmcnt(0)" ::: "memory");
            const unsigned og = xb_add(&bar[XB_TOP], 1u);
            const unsigned tg = og / nx;
            if (og + 1u == (tg + 1u) * nx) xb_add(&bar[XB_TOPGEN], 1u);
            else XB_SPIN(xb_ld(&bar[XB_TOPGEN]) == tg, bar);
            __builtin_amdgcn_fence(__ATOMIC_ACQUIRE, "agent");
            xb_add(&bar[XB_XGEN(b.x)], 1u);
            asm volatile("s_waitcnt vmcnt(0)" ::: "memory");
        } else {
            XB_SPIN(xb_ld(&bar[XB_XGEN(b.x)]) == gen, bar);
            __builtin_amdgcn_fence(__ATOMIC_ACQUIRE, "agent");
            asm volatile("s_waitcnt vmcnt(0)" ::: "memory");
        }
    }
    __syncthreads();
}

#ifndef MK_FP8_YA
#define MK_FP8_YA 1
#endif
#ifndef MK_FP8_YB
#define MK_FP8_YB 1
#endif
#ifndef MK_FP8_OUT
#define MK_FP8_OUT 1
#endif
constexpr float FP8_XSCALE = 16.0f, MIX_DS = 1.0f / (FP8_XSCALE * FP8_WSCALE);
constexpr float INPROJ_DS = MK_FP8_INPROJ ? 1.0f / (FP8_ASCALE * FP8_WSCALE) : 1.0f;
#ifndef MK_DUP
#define MK_DUP 0
#endif
namespace gm {
constexpr int BM = 256, BK = 64, HALF = 128, HTB = HALF * BK * 2, STAGE_BYTES = 8 * HTB, NXCD = 8, WGM = 8;
__host__ __device__ __forceinline__ int lds_byte(int r, int c) { const int st = (r >> 4) * 2 + (c >> 5), rr = r & 15, cc = c & 31, ob = rr * 64 + cc * 2; return st * 1024 + (ob ^ (((ob >> 9) & 1) << 5)); }
__host__ __device__ __forceinline__ void stage_rc(int b, int& R, int& C) { const int st = b / 1024, sb = b % 1024, swz = sb ^ (((sb >> 9) & 1) << 5); R = (st >> 1) * 16 + swz / 64; C = (st & 1) * 32 + (swz % 64) / 2; }
__host__ __device__ __forceinline__ int perm32(int rho) { const int n = rho >> 4, i = rho & 15; return 8 * (i >> 2) + 4 * n + (i & 3); }

struct Unit { int pm, pn, g, st; };


struct ProbDense {
    const bf16_t* A; const bf16_t* B; int lda, ldb, nt; int nM, nN, nwg, G, c; const int* list = nullptr; const LAS int* gtab = nullptr;
    __device__ unsigned list_off(const Unit&) const { return 0u; }
    __device__ void init(const bf16_t* A_, int lda_, const bf16_t* B_, int ldb_, int K, int M, int N, int G_, int c_) { A = A_; B = B_; lda = lda_; ldb = ldb_; nt = K / BK; nM = M / BM; nN = N / BM; nwg = nM * nN; G = G_; c = c_; }
    __device__ bool next(int i, Unit& u) const {
        const long L = (long)i * G + c; if (L >= nwg) return false;
        int wgid = (int)L; { const int q = nwg / NXCD, r = nwg % NXCD, xcd = wgid % NXCD, off = wgid / NXCD; wgid = (xcd < r ? xcd * (q + 1) : r * (q + 1) + (xcd - r) * q) + off; }
        const int nig = WGM * nN, gid = wgid / nig, fm = gid * WGM, gsz = (nM - fm) < WGM ? (nM - fm) : WGM;
        u.pm = fm + ((wgid % nig) % gsz); u.pn = (wgid % nig) / gsz; u.g = 0; u.st = 0; return true;
    }
    __device__ size_t a_off(const Unit& u) const { return (size_t)u.pm * BM * lda; }
    __device__ size_t b_off(const Unit& u) const { return (size_t)u.pn * BM * ldb; }
    __device__ unsigned a_row(const Unit&, int) const { return 0u; }
};

#if MK_FAST_GEMM
template <class Prob, class Epi, bool GATHER, bool FP8 = false>
__device__ __forceinline__ void gemm_phase(LAS uchar* lds, const Prob& S, const Epi& E, const int wid  ) {
    constexpr unsigned ESZ = FP8 ? 1u : 2u;
    const int lane = fresh_lane(), tid = wid * 64 + lane, wr = wid >> 2, wc = wid & 3, fr = lane & 15, fq = lane >> 4;
    const int nt = S.nt;
    int Ra[2], Ca[2]; unsigned vB;
    { int R, C; stage_rc(tid * 16, R, C); const int Rb = Epi::PERM ? ((R & ~31) + perm32(R & 31)) : R; Ra[0] = R; Ca[0] = C; Ra[1] = R + 64; Ca[1] = C;
      vB = (unsigned)(Rb * S.ldb) * ESZ + (unsigned)C * 2u; }
    const unsigned dB64 = 64u * (unsigned)S.ldb * ESZ, dA64 = 64u * (unsigned)S.lda * ESZ, dA128 = 2u * dA64;
    constexpr unsigned kstep = BK * 2;
    const unsigned hstepB = (unsigned)HALF * (unsigned)S.ldb * ESZ;
    const unsigned ldsw = (unsigned)wid * 1024u;
    const int aoff = lds_byte(wr * 64 + fr, fq * 8), boff = lds_byte(wc * 32 + fr, fq * 8);
    const __amdgpu_buffer_rsrc_t srdA = __builtin_amdgcn_make_buffer_rsrc((void*)S.A, 0, 0xFFFFFFFF, 0x00020000);
    const __amdgpu_buffer_rsrc_t srdB = __builtin_amdgcn_make_buffer_rsrc((void*)S.B, 0, 0xFFFFFFFF, 0x00020000);
#define G_SA(b, h) (((b) * 2 + (h)) * HTB)
#define G_SB(b, h) ((4 + (b) * 2 + (h)) * HTB)
#define G_STAGE(bufoff, srd, soff, voff) do { _Pragma("unroll") for (int _i = 0; _i < 2; ++_i) \
        __builtin_amdgcn_raw_ptr_buffer_load_lds(srd, (LAS void*)(lds + (bufoff) + ldsw + _i * 8192), 16, (int)(voff)[_i], (int)(soff), 0, 0); } while (0)
#define G_STAGE1(bufoff, srd, soff, v1, d64) do { _Pragma("unroll") for (int _i = 0; _i < 2; ++_i) \
        __builtin_amdgcn_raw_ptr_buffer_load_lds(srd, (LAS void*)(lds + (bufoff) + ldsw + _i * 8192), 16, (int)(v1), (int)((soff) + _i * (d64)), 0, 0); } while (0)
#define G_STAGE_A(bufoff, soff, half, arr0, arr1) do { if constexpr (GATHER) { if (half) G_STAGE(bufoff, srdA, soff, arr1); else G_STAGE(bufoff, srdA, soff, arr0); } \
        else G_STAGE1(bufoff, srdA, (soff) + (half) * dA128, vA, dA64); } while (0)
#define G_LDA(dst, b, h) do { _Pragma("unroll") for (int m = 0; m < 4; ++m) _Pragma("unroll") for (int k = 0; k < 2; ++k) dst[m][k] = *(const LAS bf16x8*)(lds + G_SA(b, h) + aoff + m * 2048 + k * 1024); } while (0)
#define G_LDB(dst, b, h) do { _Pragma("unroll") for (int n = 0; n < 2; ++n) _Pragma("unroll") for (int k = 0; k < 2; ++k) dst[n][k] = *(const LAS bf16x8*)(lds + G_SB(b, h) + boff + n * 2048 + k * 1024); } while (0)
#define G_CAT(x0, x1) __builtin_shufflevector(__builtin_bit_cast(v4i, x0), __builtin_bit_cast(v4i, x1), 0, 1, 2, 3, 4, 5, 6, 7)
#define G_MMA(ai, bj, At, Bt) do { __builtin_amdgcn_s_setprio(1); _Pragma("unroll") for (int m = 0; m < 4; ++m) _Pragma("unroll") for (int n = 0; n < 2; ++n) { \
        if constexpr (FP8) acc[ai][bj][m][n] = __builtin_amdgcn_mfma_scale_f32_16x16x128_f8f6f4(G_CAT(Bt[n][0], Bt[n][1]), G_CAT(At[m][0], At[m][1]), acc[ai][bj][m][n], 0, 0, 0, 0x7f7f7f7f, 0, 0x7f7f7f7f); \
        else { _Pragma("unroll") for (int k = 0; k < 2; ++k) acc[ai][bj][m][n] = __builtin_amdgcn_mfma_f32_16x16x32_bf16(Bt[n][k], At[m][k], acc[ai][bj][m][n], 0, 0, 0); } } \
        __builtin_amdgcn_s_setprio(0); } while (0)
#define G_WAIT_V(n) asm volatile("s_waitcnt vmcnt(" #n ")" ::: "memory")
#define G_WAIT_L(n) asm volatile("s_waitcnt lgkmcnt(" #n ")" ::: "memory")
#define G_BAR __builtin_amdgcn_s_barrier()
#define G_SCHED __builtin_amdgcn_sched_barrier(0)
#define G_UNI(x) ((unsigned)__builtin_amdgcn_readfirstlane((int)(x)))
    Unit cur, nxt; int ui = 0;
    if (!S.next(0, cur)) return;
    unsigned vA0[2], vA1[2];
    unsigned cA = 0u, cB = G_UNI(S.b_off(cur) * ESZ);
    __amdgpu_buffer_rsrc_t srdL = srdA;
    if constexpr (GATHER) srdL = __builtin_amdgcn_make_buffer_rsrc((void*)S.list, 0, 0xFFFFFFFF, 0x00020000);
#define G_IDX(u_) do { if (wid < 4) __builtin_amdgcn_raw_ptr_buffer_load_lds(srdL, (LAS void*)(S.gtab + wid * 64), 4, lane * 4, (int)G_UNI(S.list_off(u_) * 4u) + wid * 256, 0, 0); } while (0)
    const int gR = (int)(uintptr_t)S.gtab + Ra[0] * 4; const unsigned gC = (unsigned)Ca[0] * 2u;
#define G_ROWS(o0, o1) do { const LAS int* _g = (const LAS int*)gR; const unsigned _ls = (unsigned)S.lda * ESZ; \
        o0[0] = (unsigned)_g[0] * _ls + gC; o0[1] = (unsigned)_g[64] * _ls + gC; o1[0] = (unsigned)_g[128] * _ls + gC; o1[1] = (unsigned)_g[192] * _ls + gC; } while (0)
    if constexpr (GATHER) { G_IDX(cur); G_WAIT_V(0); G_BAR; G_ROWS(vA0, vA1); G_WAIT_L(0); G_BAR; }
    else { cA = G_UNI(S.a_off(cur) * ESZ);
#pragma unroll
        for (int i = 0; i < 2; ++i) { vA0[i] = 0u; vA1[i] = 0u; } }
    const unsigned vA = (unsigned)(Ra[0] * S.lda) * ESZ + (unsigned)Ca[0] * 2u;
    G_STAGE1(G_SB(0, 0), srdB, cB, vB, dB64); G_STAGE_A(G_SA(0, 0), cA, 0, vA0, vA1); G_STAGE1(G_SB(0, 1), srdB, cB + hstepB, vB, dB64); G_STAGE_A(G_SA(0, 1), cA, 1, vA0, vA1);
    if (wr == 1) G_BAR;
    G_WAIT_V(4); G_BAR;
    G_STAGE1(G_SB(1, 0), srdB, cB + kstep, vB, dB64); G_STAGE_A(G_SA(1, 0), cA + kstep, 0, vA0, vA1); G_STAGE1(G_SB(1, 1), srdB, cB + hstepB + kstep, vB, dB64);
    G_WAIT_V(6); G_BAR;
    f32x4 acc[2][2][4][2];
#pragma unroll
    for (int a = 0; a < 2; ++a)
#pragma unroll
        for (int b = 0; b < 2; ++b)
#pragma unroll
            for (int m = 0; m < 4; ++m)
#pragma unroll
                for (int n = 0; n < 2; ++n) acc[a][b][m][n] = (f32x4){0.f, 0.f, 0.f, 0.f};
    bf16x8 At[4][2], B0[2][2], B1[2][2];
    for (;;) {
        const bool has_next = S.next(ui + 1, nxt);
        unsigned nA = cA, nB = cB; unsigned x0[2] = {0u, 0u}, x1[2] = {0u, 0u};
        if (has_next) { nB = G_UNI(S.b_off(nxt) * ESZ);
            if constexpr (GATHER) G_IDX(nxt);
            else nA = G_UNI(S.a_off(nxt) * ESZ);
        }
#define G_TRIP(LAST) do { \
            const unsigned a1 = cA + (unsigned)(t + 1) * kstep; \
            const unsigned a2 = (LAST) ? nA : cA + (unsigned)(t + 2) * kstep, b2 = (LAST) ? nB : cB + (unsigned)(t + 2) * kstep; \
            const unsigned a3 = a2 + kstep, b3 = b2 + kstep; \
            unsigned w0[2], w1[2]; \
            _Pragma("unroll") for (int i = 0; i < 2; ++i) { w0[i] = vA0[i]; w1[i] = vA1[i]; } \
            if constexpr (GATHER) { if ((LAST) && has_next) { G_ROWS(w0, w1); _Pragma("unroll") for (int i = 0; i < 2; ++i) { x0[i] = w0[i]; x1[i] = w1[i]; } } } \
              G_LDB(B0, 0, 0); G_SCHED; G_LDA(At, 0, 0); G_STAGE_A(G_SA(1, 1), a1, 1, vA0, vA1); \
            G_WAIT_L(8); G_BAR; G_WAIT_L(0); G_MMA(0, 0, At, B0); G_BAR; G_SCHED; \
              G_LDB(B1, 0, 1); G_STAGE1(G_SB(0, 0), srdB, b2, vB, dB64); \
            G_BAR; G_WAIT_L(0); G_MMA(0, 1, At, B1); G_BAR; \
              G_LDA(At, 0, 1); G_STAGE_A(G_SA(0, 0), a2, 0, w0, w1); \
            G_BAR; G_WAIT_L(0); G_MMA(1, 0, At, B0); G_BAR; G_SCHED; \
              G_STAGE1(G_SB(0, 1), srdB, b2 + hstepB, vB, dB64); \
            G_WAIT_V(6); G_BAR; G_MMA(1, 1, At, B1); G_BAR; \
              G_LDB(B0, 1, 0); G_SCHED; G_LDA(At, 1, 0); G_STAGE_A(G_SA(0, 1), a2, 1, w0, w1); \
            G_WAIT_L(8); G_BAR; G_WAIT_L(0); G_MMA(0, 0, At, B0); G_BAR; G_SCHED; \
              G_LDB(B1, 1, 1); G_STAGE1(G_SB(1, 0), srdB, b3, vB, dB64); \
            G_BAR; G_WAIT_L(0); G_MMA(0, 1, At, B1); G_BAR; \
              G_LDA(At, 1, 1); G_STAGE_A(G_SA(1, 0), a3, 0, w0, w1); \
            G_BAR; G_WAIT_L(0); G_MMA(1, 0, At, B0); G_BAR; G_SCHED; \
              G_STAGE1(G_SB(1, 1), srdB, b3 + hstepB, vB, dB64); \
            G_WAIT_V(6); G_BAR; G_MMA(1, 1, At, B1); G_BAR; } while (0)
        for (int t = 0; t < nt; t += 2) { const bool last = (t == nt - 2); G_TRIP(last); }
        if (wr == 0) G_BAR;
        { const int lane2 = fresh_lane();
          if (!(FP8 && MK_DUP && (ui & 1) == 0)) E(acc, cur, wid >> 2, wid & 3, lane2 & 15, lane2 >> 4); }
        if (!has_next) break;
#pragma unroll
        for (int a = 0; a < 2; ++a)
#pragma unroll
            for (int b = 0; b < 2; ++b)
#pragma unroll
                for (int m = 0; m < 4; ++m)
#pragma unroll
                    for (int n = 0; n < 2; ++n) acc[a][b][m][n] = (f32x4){0.f, 0.f, 0.f, 0.f};
        cur = nxt; cA = nA; cB = nB; ++ui;
        if (wr == 1) G_BAR;
        if constexpr (GATHER) {
#pragma unroll
            for (int i = 0; i < 2; ++i) { vA0[i] = x0[i]; vA1[i] = x1[i]; } }
    }
    G_WAIT_V(0);
    G_BAR;
#undef G_SA
#undef G_SB
#undef G_STAGE
#undef G_STAGE1
#undef G_STAGE_A
#undef G_LDA
#undef G_LDB
#undef G_MMA
#undef G_CAT
#undef G_WAIT_V
#undef G_WAIT_L
#undef G_BAR
#undef G_SCHED
#undef G_UNI
#undef G_TRIP
#undef G_IDX
#undef G_ROWS
}
#else
template <class Prob, class Epi, bool GATHER, bool FP8 = false>
__device__ __forceinline__ void gemm_phase(LAS uchar* lds, const Prob& S, const Epi& E, const int wid) {
    const int lane = fresh_lane(), tid = wid * 64 + lane, wr = wid >> 2, wc = wid & 3, fr = lane & 15, fq = lane >> 4;
    LAS float* As = (LAS float*)lds; LAS float* Bs = As + 256 * 33;
    Unit u;
    for (int ui = 0; S.next(ui, u); ++ui) {
        float acc[2][2][4][2][4];
#pragma unroll
        for (int a = 0; a < 2; ++a)
#pragma unroll
            for (int b = 0; b < 2; ++b)
#pragma unroll
                for (int m = 0; m < 4; ++m)
#pragma unroll
                    for (int n = 0; n < 2; ++n)
#pragma unroll
                        for (int j = 0; j < 4; ++j) acc[a][b][m][n][j] = 0.f;
        const int lr = tid >> 1, lk = (tid & 1) * 16;
        const bf16_t* ap = GATHER ? (S.A + S.a_row(u, lr)) : (S.A + S.a_off(u) + (size_t)lr * S.lda);
        const bf16_t* bp = S.B + S.b_off(u) + (size_t)lr * S.ldb;
        for (int k0 = 0; k0 < S.nt * 64; k0 += 32) {
            __syncthreads();
            const u32x4 a0 = *(const u32x4*)(ap + k0 + lk), a1 = *(const u32x4*)(ap + k0 + lk + 8);
            const u32x4 b0 = *(const u32x4*)(bp + k0 + lk), b1 = *(const u32x4*)(bp + k0 + lk + 8);
#pragma unroll
            for (int q = 0; q < 4; ++q) {
                As[lr * 33 + lk + 2 * q] = bflo(a0[q]); As[lr * 33 + lk + 2 * q + 1] = bfhi(a0[q]);
                As[lr * 33 + lk + 8 + 2 * q] = bflo(a1[q]); As[lr * 33 + lk + 8 + 2 * q + 1] = bfhi(a1[q]);
                Bs[lr * 33 + lk + 2 * q] = bflo(b0[q]); Bs[lr * 33 + lk + 2 * q + 1] = bfhi(b0[q]);
                Bs[lr * 33 + lk + 8 + 2 * q] = bflo(b1[q]); Bs[lr * 33 + lk + 8 + 2 * q + 1] = bfhi(b1[q]);
            }
            __syncthreads();
            for (int kk = 0; kk < 32; ++kk) {
                float av[2][4], bv[2][2][4];
#pragma unroll
                for (int a = 0; a < 2; ++a)
#pragma unroll
                    for (int m = 0; m < 4; ++m) av[a][m] = As[(128 * a + 64 * wr + 16 * m + fr) * 33 + kk];
#pragma unroll
                for (int b = 0; b < 2; ++b)
#pragma unroll
                    for (int n = 0; n < 2; ++n)
#pragma unroll
                        for (int j = 0; j < 4; ++j) { const int c = 128 * b + 32 * wc + (Epi::PERM ? (8 * fq + 4 * n + j) : (16 * n + 4 * fq + j)); bv[b][n][j] = Bs[c * 33 + kk]; }
#pragma unroll
                for (int a = 0; a < 2; ++a)
#pragma unroll
                    for (int b = 0; b < 2; ++b)
#pragma unroll
                        for (int m = 0; m < 4; ++m)
#pragma unroll
                            for (int n = 0; n < 2; ++n)
#pragma unroll
                                for (int j = 0; j < 4; ++j) acc[a][b][m][n][j] += av[a][m] * bv[b][n][j];
            }
        }
        f32x4 accv[2][2][4][2];
#pragma unroll
        for (int a = 0; a < 2; ++a)
#pragma unroll
            for (int b = 0; b < 2; ++b)
#pragma unroll
                for (int m = 0; m < 4; ++m)
#pragma unroll
                    for (int n = 0; n < 2; ++n) accv[a][b][m][n] = (f32x4){acc[a][b][m][n][0], acc[a][b][m][n][1], acc[a][b][m][n][2], acc[a][b][m][n][3]};
        E(accv, u, wr, wc, fr, fq);
    }
    __syncthreads();
}
#endif
}

struct Args {
    const float* in[32];
    float* out; uchar* ws;
    int ph_lo, ph_hi;
};
struct Frame {
    LAS uchar* lds; uchar* ws; int wave, G, bx;
};
#define FRAME_IDS(F) const int F_lane = fresh_lane(), F_tid = (F).wave * 64 + F_lane
enum { I_X = 0, I_POS, I_N1G, I_WIN, I_BG, I_QNG, I_WUQ, I_KVNG, I_WUKV, I_QKQG, I_QKKG, I_WOMLA, I_LRE, I_LIM, I_LOGDT, I_BRE, I_BIM, I_CRE, I_CIM, I_S5D,
       I_WGLU, I_WOS5, I_WOUT, I_N2G, I_WR, I_BR, I_WG, I_BGATE, I_WU, I_BUP, I_WD, I_BDOWN };

struct ProbS5 {
    const bf16_t* A; const bf16_t* B; int lda, ldb, nt; int G, c; const int* list = nullptr; const LAS int* gtab = nullptr;
    __device__ unsigned list_off(const gm::Unit&) const { return 0u; }
    __device__ bool next(int i, gm::Unit& u) const { const int L = i * G + c; if (L >= S5G * 4) return false; u.g = L >> 2; u.pm = L & 3; u.pn = 0; u.st = 0; return true; }
    __device__ size_t a_off(const gm::Unit& u) const { return ((size_t)u.g * NCHUNK + (size_t)u.pm * 256) * APK; }
    __device__ size_t b_off(const gm::Unit& u) const { return (size_t)u.g * 256 * ldb; }
    __device__ unsigned a_row(const gm::Unit&, int) const { return 0u; }
};
struct ProbMoE {
    const bf16_t* A; const bf16_t* B; int lda, ldb, nt; int npn; size_t estride;
    int x, rk, nrk; int nte[4], rcp[4], pre[4], eid[4];
    const int* list = nullptr; const LAS int* gtab = nullptr;
    __device__ void load(const LAS int* tab) {
#pragma unroll
        for (int q = 0; q < 4; ++q) { const int e = __builtin_amdgcn_readfirstlane(tab[160 + x * 4 + q]); eid[q] = e; nte[q] = __builtin_amdgcn_readfirstlane(tab[32 + e]); rcp[q] = __builtin_amdgcn_readfirstlane(tab[128 + e]); pre[q] = __builtin_amdgcn_readfirstlane(tab[64 + e]); }
    }
    __device__ unsigned list_off(const gm::Unit&) const { return 0u; }
    __device__ bool next(int i, gm::Unit& u) const {
        int L = (i >> MK_DUP) * nrk + rk;
#pragma unroll
        for (int q = 0; q < 4; ++q) { const int nu = nte[q] * npn;
            if (L < nu) { u.g = eid[q]; u.pn = (L * rcp[q]) >> 20; u.pm = L - u.pn * nte[q]; u.st = pre[q] + u.pm; return true; } L -= nu; }
        return false;
    }
    __device__ size_t a_off(const gm::Unit& u) const { return ((size_t)u.st * 256) * lda; }
    __device__ size_t b_off(const gm::Unit& u) const { return (size_t)u.g * estride + (size_t)u.pn * 256 * ldb; }
    __device__ unsigned a_row(const gm::Unit&, int) const { return 0u; }
};

#define EPI_ROW(u_, ai, m) ((u_).pm * 256 + (ai) * 128 + wr * 64 + (m) * 16 + fr)
struct EpiStoreBf16 {
    static constexpr bool PERM = true;
    bf16_t* O; int ld;
    __device__ __forceinline__ void operator()(const f32x4 (&acc)[2][2][4][2], const gm::Unit& u, int wr, int wc, int fr, int fq) const {
#pragma unroll
        for (int ai = 0; ai < 2; ++ai)
#pragma unroll
            for (int m = 0; m < 4; ++m) { bf16_t* rowp = O + (size_t)EPI_ROW(u, ai, m) * ld + u.pn * 256 + wc * 32 + 8 * fq;
#pragma unroll
                for (int bj = 0; bj < 2; ++bj) { const f32x4 v0 = acc[ai][bj][m][0], v1 = acc[ai][bj][m][1];
                    u32x4 w; w.x = cvt_pk_bf16(v0[0], v0[1]); w.y = cvt_pk_bf16(v0[2], v0[3]); w.z = cvt_pk_bf16(v1[0], v1[1]); w.w = cvt_pk_bf16(v1[2], v1[3]);
                    *(u32x4*)(rowp + bj * 128) = w; } }
    }
};
template <int S0, int NS, int LEN> struct EpiStoreScaled {
    static constexpr bool PERM = true;
    bf16_t* O; int ld; const float* ssqp;
    __device__ __forceinline__ void operator()(const f32x4 (&acc)[2][2][4][2], const gm::Unit& u, int wr, int wc, int fr, int fq) const {
#pragma unroll
        for (int ai = 0; ai < 2; ++ai) { float rs[4];
#pragma unroll
            for (int m = 0; m < 4; ++m) { const float* sp = ssqp + (size_t)EPI_ROW(u, ai, m) * 12 + S0; float t = 0.f;
#pragma unroll
                for (int q = 0; q < NS; q += 4) { const f32x4 v = *(const f32x4*)(sp + q); t += (v[0] + v[1]) + (v[2] + v[3]); }
                rs[m] = 1.0f / sqrtf(t * (1.0f / LEN) + EPS); }
#pragma unroll
            for (int m = 0; m < 4; ++m) { bf16_t* rowp = O + (size_t)EPI_ROW(u, ai, m) * ld + u.pn * 256 + wc * 32 + 8 * fq;
#pragma unroll
                for (int bj = 0; bj < 2; ++bj) { const f32x4 v0 = acc[ai][bj][m][0] * rs[m], v1 = acc[ai][bj][m][1] * rs[m];
                    u32x4 w; w.x = cvt_pk_bf16(v0[0], v0[1]); w.y = cvt_pk_bf16(v0[2], v0[3]); w.z = cvt_pk_bf16(v1[0], v1[1]); w.w = cvt_pk_bf16(v1[2], v1[3]);
                    *(u32x4*)(rowp + bj * 128) = w; } } }
    }
};
struct EpiKV {
    static constexpr bool PERM = true;
    bf16_t* kraw; bf16_t* vn; const float* ssqp;
    __device__ __forceinline__ void operator()(const f32x4 (&acc)[2][2][4][2], const gm::Unit& u, int wr, int wc, int fr, int fq) const {
#pragma unroll
        for (int ai = 0; ai < 2; ++ai) { float rs[4];
#pragma unroll
            for (int m = 0; m < 4; ++m) { const f32x4 v = *(const f32x4*)(ssqp + (size_t)EPI_ROW(u, ai, m) * 12 + 8); rs[m] = 1.0f / sqrtf(((v[0] + v[1]) + (v[2] + v[3])) * (1.0f / KVLORA) + EPS); }
#pragma unroll
            for (int m = 0; m < 4; ++m) { const int t = EPI_ROW(u, ai, m); const size_t ro = ((size_t)((t >> 11) * NH + u.pn) * SEQ + (t & 2047)) * 128 + wc * 32 + 8 * fq;
#pragma unroll
                for (int bj = 0; bj < 2; ++bj) { const f32x4 v0 = acc[ai][bj][m][0] * rs[m], v1 = acc[ai][bj][m][1] * rs[m];
                    u32x4 w; w.x = cvt_pk_bf16(v0[0], v0[1]); w.y = cvt_pk_bf16(v0[2], v0[3]); w.z = cvt_pk_bf16(v1[0], v1[1]); w.w = cvt_pk_bf16(v1[2], v1[3]);
                    *(u32x4*)((bj ? vn : kraw) + ro) = w; } } }
    }
};
struct EpiInProj {
    static constexpr bool PERM = true;
    bf16_t* proj; bf16_t* apack; const float* bgates; float* ssqp;
    __device__ __forceinline__ void operator()(const f32x4 (&acc)[2][2][4][2], const gm::Unit& u, int wr, int wc, int fr, int fq) const {
        const int colt = u.pn * 256 + wc * 32 + 8 * fq;
        if (u.pn < 3) {
#pragma unroll
            for (int ai = 0; ai < 2; ++ai)
#pragma unroll
                for (int m = 0; m < 4; ++m) { float sq = 0.f;
#pragma unroll
                    for (int bj = 0; bj < 2; ++bj)
#pragma unroll
                        for (int n = 0; n < 2; ++n) { const f32x4 v = acc[ai][bj][m][n]; sq += (v[0] * v[0] + v[1] * v[1]) + (v[2] * v[2] + v[3] * v[3]); }
                    sq += __shfl_xor(sq, 16); sq += __shfl_xor(sq, 32);
                    if (fq == 0) ssqp[(size_t)EPI_ROW(u, ai, m) * 12 + u.pn * 4 + wc] = sq * (INPROJ_DS * INPROJ_DS); } }
        const int kind = (u.pn >= 3 && u.pn < 7) ? 1 : ((u.pn >= 7 && u.pn < 23) ? 2 : 0);
#pragma unroll
        for (int bj = 0; bj < 2; ++bj) {
            const int col = colt + bj * 128;
            f32x4 b0 = (f32x4){0.f, 0.f, 0.f, 0.f}, b1 = b0;
            constexpr float NL2E = -1.4426950408889634f;
            if (kind == 2) { b0 = *(const f32x4*)(bgates + (col - C_GA)) * NL2E; b1 = *(const f32x4*)(bgates + (col - C_GA) + 4) * NL2E; }
#pragma unroll
            for (int ai = 0; ai < 2; ++ai)
#pragma unroll
                for (int m = 0; m < 4; ++m) {
                    const int row = EPI_ROW(u, ai, m);
                    f32x4 v0 = acc[ai][bj][m][0], v1 = acc[ai][bj][m][1];
                    if (kind == 2) {
#pragma unroll
                        for (int h = 0; h < 2; ++h) { const f32x2 s0 = sig2_t((f32x2){v0[2 * h], v0[2 * h + 1]} * (NL2E * INPROJ_DS) + (f32x2){b0[2 * h], b0[2 * h + 1]}), s1 = sig2_t((f32x2){v1[2 * h], v1[2 * h + 1]} * (NL2E * INPROJ_DS) + (f32x2){b1[2 * h], b1[2 * h + 1]});
                            v0[2 * h] = s0.x; v0[2 * h + 1] = s0.y; v1[2 * h] = s1.x; v1[2 * h + 1] = s1.y; }
                    } else if (MK_FP8_INPROJ) { v0 = v0 * INPROJ_DS; v1 = v1 * INPROJ_DS; }
                    u32x4 w; w.x = cvt_pk_bf16(v0[0], v0[1]); w.y = cvt_pk_bf16(v0[2], v0[3]); w.z = cvt_pk_bf16(v1[0], v1[1]); w.w = cvt_pk_bf16(v1[2], v1[3]);
                    if (kind == 1) { const int j = col - C_U, g = j >> 4, cc = j & 15;
                        *(u32x4*)(apack + ((size_t)g * NCHUNK + (row >> 4)) * APK + (row & 15) * 16 + cc) = w; }
                    else { *(u32x4*)(proj + (size_t)row * NPROJ + col) = w;
                    }
                }
        }
    }
};
struct EpiS5State {
    static constexpr bool PERM = false;
    float* sch;
    __device__ __forceinline__ void operator()(const f32x4 (&acc)[2][2][4][2], const gm::Unit& u, int wr, int wc, int fr, int fq) const {
#pragma unroll
        for (int ai = 0; ai < 2; ++ai)
#pragma unroll
            for (int m = 0; m < 4; ++m) { float* rowp = sch + ((size_t)u.g * NCHUNK + EPI_ROW(u, ai, m)) * 128 + wc * 32 + 4 * fq;
#pragma unroll
                for (int n = 0; n < 2; ++n) *(f32x4*)(rowp + n * 16) = acc[ai][0][m][n]; }
    }
};
struct EpiS5Out {
    static constexpr bool PERM = true;
    bf16_t* gact;
    __device__ __forceinline__ void operator()(const f32x4 (&acc)[2][2][4][2], const gm::Unit& u, int wr, int wc, int fr, int fq) const {
#pragma unroll
        for (int ai = 0; ai < 2; ++ai)
#pragma unroll
            for (int m = 0; m < 4; ++m) { const int r = EPI_ROW(u, ai, m);
#pragma unroll
                for (int bj = 0; bj < 2; ++bj) { const int n0 = bj * 128 + wc * 32 + 8 * fq, t = n0 >> 4, c0 = n0 & 15;
                    f32x4 v0 = acc[ai][bj][m][0], v1 = acc[ai][bj][m][1];
#pragma unroll
                    for (int h = 0; h < 2; ++h) { const f32x2 g0 = gelu_tanh2((f32x2){v0[2 * h], v0[2 * h + 1]}), g1 = gelu_tanh2((f32x2){v1[2 * h], v1[2 * h + 1]});
                        v0[2 * h] = g0.x; v0[2 * h + 1] = g0.y; v1[2 * h] = g1.x; v1[2 * h + 1] = g1.y; }
                    u32x4 w; w.x = cvt_pk_bf16(v0[0], v0[1]); w.y = cvt_pk_bf16(v0[2], v0[3]); w.z = cvt_pk_bf16(v1[0], v1[1]); w.w = cvt_pk_bf16(v1[2], v1[3]);
                    *(u32x4*)(gact + ((size_t)r * 16 + t) * S5W + u.g * 16 + c0) = w; } }
    }
};
template <int MODE, bool OUT8 = false, bool ACC8 = false> struct EpiSide {
    static constexpr bool PERM = true; static constexpr float DS = ACC8 ? MIX_DS : 1.0f;
    bf16_t* O; int ldo; const bf16_t* s0; int ld0; const bf16_t* s1; int ld1;
    __device__ __forceinline__ void operator()(const f32x4 (&acc)[2][2][4][2], const gm::Unit& u, int wr, int wc, int fr, int fq) const {
        const int col0 = u.pn * 256 + wc * 32 + 8 * fq;
#pragma unroll
        for (int ai = 0; ai < 2; ++ai) {
            u32x4 sa[4][2], sb[4][2];
#pragma unroll
            for (int m = 0; m < 4; ++m)
#pragma unroll
                for (int bj = 0; bj < 2; ++bj) { const int row = EPI_ROW(u, ai, m);
                    sa[m][bj] = *(const u32x4*)(s0 + (size_t)row * ld0 + col0 + bj * 128);
                    if (MODE == 2) sb[m][bj] = *(const u32x4*)(s1 + (size_t)row * ld1 + col0 + bj * 128); else sb[m][bj] = (u32x4){0u, 0u, 0u, 0u}; }
#pragma unroll
            for (int m = 0; m < 4; ++m)
#pragma unroll
                for (int bj = 0; bj < 2; ++bj) { const int row = EPI_ROW(u, ai, m);
                    const f32x4 v0 = acc[ai][bj][m][0], v1 = acc[ai][bj][m][1]; const u32x4 a = sa[m][bj], b = sb[m][bj];
                    float r[8];
#pragma unroll
                    for (int q = 0; q < 4; ++q) { const float x0 = (q < 2 ? v0[2 * q] : v1[2 * q - 4]) * DS, x1 = (q < 2 ? v0[2 * q + 1] : v1[2 * q - 3]) * DS;
                        const float a0 = bflo(a[q]), a1 = bfhi(a[q]);
                        if (MODE == 0) { const f32x2 sg = sig2_t((f32x2){x0, x1} * -1.4426950408889634f) * (f32x2){a0, a1}; r[2 * q] = sg.x; r[2 * q + 1] = sg.y; }
                        else if (MODE == 1) { r[2 * q] = a0 * x0; r[2 * q + 1] = a1 * x1; }
                        else { r[2 * q] = bflo(b[q]) + a0 * x0; r[2 * q + 1] = bfhi(b[q]) + a1 * x1; } }
                    if constexpr (OUT8) { u32x2 w; w.x = pk4_fp8c(r[0] * FP8_XSCALE, r[1] * FP8_XSCALE, r[2] * FP8_XSCALE, r[3] * FP8_XSCALE); w.y = pk4_fp8c(r[4] * FP8_XSCALE, r[5] * FP8_XSCALE, r[6] * FP8_XSCALE, r[7] * FP8_XSCALE);
                        *(u32x2*)((uchar*)O + (size_t)row * ldo + col0 + bj * 128) = w; }
                    else { u32x4 w; w.x = cvt_pk_bf16(r[0], r[1]); w.y = cvt_pk_bf16(r[2], r[3]); w.z = cvt_pk_bf16(r[4], r[5]); w.w = cvt_pk_bf16(r[6], r[7]);
                        *(u32x4*)(O + (size_t)row * ldo + col0 + bj * 128) = w; } }
        }
    }
};
struct EpiResidF32 {
    static constexpr bool PERM = false; static constexpr float DS = MK_FP8_OUT ? MIX_DS : 1.0f;
    const float* x; float* out;
    __device__ __forceinline__ void operator()(const f32x4 (&acc)[2][2][4][2], const gm::Unit& u, int wr, int wc, int fr, int fq) const {
#pragma unroll
        for (int ai = 0; ai < 2; ++ai)
#pragma unroll
            for (int mh = 0; mh < 2; ++mh) { f32x4 xv[2][2][2];
#pragma unroll
                for (int mm = 0; mm < 2; ++mm) { const size_t off = (size_t)EPI_ROW(u, ai, 2 * mh + mm) * DM + u.pn * 256 + wc * 32 + 4 * fq;
#pragma unroll
                    for (int bj = 0; bj < 2; ++bj)
#pragma unroll
                        for (int n = 0; n < 2; ++n) xv[mm][bj][n] = *(const f32x4*)(x + off + bj * 128 + n * 16); }
#pragma unroll
                for (int mm = 0; mm < 2; ++mm) { const size_t off = (size_t)EPI_ROW(u, ai, 2 * mh + mm) * DM + u.pn * 256 + wc * 32 + 4 * fq;
#pragma unroll
                    for (int bj = 0; bj < 2; ++bj)
#pragma unroll
                        for (int n = 0; n < 2; ++n) *(f32x4*)(out + off + bj * 128 + n * 16) = xv[mm][bj][n] + acc[ai][bj][2 * mh + mm][n] * DS; } }
    }
};
#if MK_FP8_MOE
constexpr float MOE_DESCALE = 1.0f / (FP8_ASCALE * FP8_WSCALE);
#else
constexpr float MOE_DESCALE = 1.0f;
#endif
struct EpiSwiglu {
    static constexpr bool PERM = true;
    static constexpr float EPS_AS = MK_FP8_MOE ? FP8_ASCALE : 1.0f;
    bf16_t* hact; const float* bgate; const float* bup; const LAS int* tab;
    __device__ __forceinline__ void operator()(const f32x4 (&acc)[2][2][4][2], const gm::Unit& u, int wr, int wc, int fr, int fq) const {
        const int hc = u.pn * 128 + wc * 32 + 8 * fq;
        const unsigned slot0 = (unsigned)u.st * 256u + wr * 64 + fr;
        unsigned w0[2][4];
#pragma unroll
        for (int n = 0; n < 2; ++n) {
            const f32x4 g0 = *(const f32x4*)(bgate + (unsigned)(u.g * DFF + hc + 4 * n)), u0 = *(const f32x4*)(bup + (unsigned)(u.g * DFF + hc + 4 * n));
            const f32x2 gbv[2] = {{g0.x, g0.y}, {g0.z, g0.w}}, ubv[2] = {{u0.x * EPS_AS + EPS_AS, u0.y * EPS_AS + EPS_AS}, {u0.z * EPS_AS + EPS_AS, u0.w * EPS_AS + EPS_AS}};
#pragma unroll
            for (int ai = 0; ai < 2; ++ai)
#pragma unroll
                for (int m = 0; m < 4; ++m) { const unsigned slot = slot0 + ai * 128 + m * 16;
                    float r[4];
#pragma unroll
                    for (int h = 0; h < 2; ++h) { const f32x2 ag = {acc[ai][0][m][n][2 * h], acc[ai][0][m][n][2 * h + 1]}, au = {acc[ai][1][m][n][2 * h], acc[ai][1][m][n][2 * h + 1]};
                        f32x2 gt = ag * MOE_DESCALE + gbv[h], up = au * (MOE_DESCALE * EPS_AS) + ubv[h];
                        gt.x = fminf(gt.x, 7.0f); gt.y = fminf(gt.y, 7.0f);
                        up.x = __builtin_amdgcn_fmed3f(up.x, -6.0f * EPS_AS, 8.0f * EPS_AS); up.y = __builtin_amdgcn_fmed3f(up.y, -6.0f * EPS_AS, 8.0f * EPS_AS);
                        const f32x2 t = gt * (-1.702f * 1.4426950408889634f); f32x2 d; d.x = __builtin_amdgcn_exp2f(t.x); d.y = __builtin_amdgcn_exp2f(t.y); d = d + 1.0f;
                        f32x2 sg; sg.x = __builtin_amdgcn_rcpf(d.x); sg.y = __builtin_amdgcn_rcpf(d.y);
                        const f32x2 o = up * (gt * sg); r[2 * h] = o.x; r[2 * h + 1] = o.y; }
#if MK_FP8_MOE
                    const unsigned pk = pk4_fp8(r[0], r[1], r[2], r[3]);
                    if (n == 0) w0[ai][m] = pk; else { u32x2 w; w.x = w0[ai][m]; w.y = pk; *(u32x2*)((uchar*)hact + slot * DFF + hc) = w; }
#else
                    u32x2 w; w.x = cvt_pk_bf16(r[0], r[1]); w.y = cvt_pk_bf16(r[2], r[3]); *(u32x2*)(hact + slot * DFF + hc + 4 * n) = w;
#endif
                }
        }
    }
};
struct EpiDown {
    static constexpr bool PERM = true;
    bf16_t* ys; const float* bdown; const LAS int* tab;
    __device__ __forceinline__ void operator()(const f32x4 (&acc)[2][2][4][2], const gm::Unit& u, int wr, int wc, int fr, int fq) const {
        const size_t slot0 = (size_t)u.st * 256;
#pragma unroll
        for (int bj = 0; bj < 2; ++bj) { const int col = u.pn * 256 + bj * 128 + wc * 32 + 8 * fq;
            const float* bd = bdown + (size_t)u.g * DM + col; const f32x4 d0 = *(const f32x4*)bd, d1 = *(const f32x4*)(bd + 4);
#pragma unroll
            for (int ai = 0; ai < 2; ++ai)
#pragma unroll
                for (int m = 0; m < 4; ++m) { const size_t slot = slot0 + ai * 128 + wr * 64 + m * 16 + fr;
                    const f32x4 v0 = acc[ai][bj][m][0] * MOE_DESCALE + d0, v1 = acc[ai][bj][m][1] * MOE_DESCALE + d1;
#if MK_FP8_MOE
                    u32x2 w; w.x = pk4_fp8c(v0[0] * FP8_YSCALE, v0[1] * FP8_YSCALE, v0[2] * FP8_YSCALE, v0[3] * FP8_YSCALE); w.y = pk4_fp8c(v1[0] * FP8_YSCALE, v1[1] * FP8_YSCALE, v1[2] * FP8_YSCALE, v1[3] * FP8_YSCALE);
                    *(u32x2*)((uchar*)ys + slot * DM + col) = w; } }
#else
                    u32x4 w; w.x = cvt_pk_bf16(v0[0], v0[1]); w.y = cvt_pk_bf16(v0[2], v0[3]); w.z = cvt_pk_bf16(v1[0], v1[1]); w.w = cvt_pk_bf16(v1[2], v1[3]);
                    *(u32x4*)(ys + slot * DM + col) = w; } }
#endif
    }
};

template <bool FP8OUT>
__device__ __forceinline__ void transpose_item(const float* W, int ldw, int src_col0, int k0, const float* kscale, void* WT, int ldt, int dst_row0, float oscale, LAS float* scr, int lane) {
    if (src_col0 >= 0) {
        f32x4 v[16]; const float* wp = W + (size_t)(k0 + (lane >> 4)) * ldw + src_col0 + (lane & 15) * 4;
#pragma unroll
        for (int i = 0; i < 16; ++i) v[i] = __builtin_nontemporal_load((const f32x4*)(wp + (size_t)(4 * i) * ldw));
#pragma unroll
        for (int i = 0; i < 16; ++i) { const int kk = 4 * i + (lane >> 4); const float sc = kscale ? kscale[k0 + kk] * oscale : oscale; LAS float* d = scr + kk * 65 + (lane & 15) * 4;
            d[0] = v[i].x * sc; d[1] = v[i].y * sc; d[2] = v[i].z * sc; d[3] = v[i].w * sc; }
    } else {
#pragma unroll
        for (int i = 0; i < 16; ++i) { LAS float* d = scr + (4 * i + (lane >> 4)) * 65 + (lane & 15) * 4; d[0] = 0.f; d[1] = 0.f; d[2] = 0.f; d[3] = 0.f; }
    }
    LDS_WAIT(); asm volatile("" ::: "memory");
    if constexpr (FP8OUT) { const int c = lane & 3;
#pragma unroll
        for (int j = 0; j < 4; ++j) { const int n = (lane >> 2) + 16 * j; const LAS float* s = scr + (16 * c) * 65 + n; u32x4 o;
            o.x = pk4_fp8(s[0 * 65], s[1 * 65], s[2 * 65], s[3 * 65]); o.y = pk4_fp8(s[4 * 65], s[5 * 65], s[6 * 65], s[7 * 65]);
            o.z = pk4_fp8(s[8 * 65], s[9 * 65], s[10 * 65], s[11 * 65]); o.w = pk4_fp8(s[12 * 65], s[13 * 65], s[14 * 65], s[15 * 65]);
            *(u32x4*)((uchar*)WT + (size_t)(dst_row0 + n) * ldt + k0 + 16 * c) = o; }
    } else { const int c = lane & 7;
#pragma unroll
        for (int j = 0; j < 8; ++j) { const int n = (lane >> 3) + 8 * j; const LAS float* s = scr + (8 * c) * 65 + n;
            u32x4 o; o.x = pk2(s[0 * 65], s[1 * 65]); o.y = pk2(s[2 * 65], s[3 * 65]); o.z = pk2(s[4 * 65], s[5 * 65]); o.w = pk2(s[6 * 65], s[7 * 65]);
            *(u32x4*)((bf16_t*)WT + (size_t)(dst_row0 + n) * ldt + k0 + 8 * c) = o; }
    }
    LDS_WAIT(); asm volatile("" ::: "memory");
}
struct TItem { const float* src; uchar* dst; };
__device__ __forceinline__ void ti_load(const TItem& t, f32x4 (&v)[16], int lane) {
    const float* wp = t.src + (size_t)(lane >> 4) * DM + (lane & 15) * 4;
#pragma unroll
    for (int i = 0; i < 16; ++i) v[i] = __builtin_nontemporal_load((const f32x4*)(wp + (size_t)(4 * i) * DM));
}
template <bool FP8OUT>
__device__ __forceinline__ void ti_store(const TItem& t, const f32x4 (&v)[16], float oscale, LAS float* scr, int lane) {
#pragma unroll
    for (int i = 0; i < 16; ++i) { LAS float* d = scr + (4 * i + (lane >> 4)) * 65 + (lane & 15) * 4; d[0] = v[i].x * oscale; d[1] = v[i].y * oscale; d[2] = v[i].z * oscale; d[3] = v[i].w * oscale; }
    LDS_WAIT(); asm volatile("" ::: "memory");
    if constexpr (FP8OUT) { const int c = lane & 3;
#pragma unroll
        for (int j = 0; j < 4; ++j) { const int n = (lane >> 2) + 16 * j; const LAS float* s = scr + (16 * c) * 65 + n; u32x4 o;
            o.x = pk4_fp8(s[0 * 65], s[1 * 65], s[2 * 65], s[3 * 65]); o.y = pk4_fp8(s[4 * 65], s[5 * 65], s[6 * 65], s[7 * 65]);
            o.z = pk4_fp8(s[8 * 65], s[9 * 65], s[10 * 65], s[11 * 65]); o.w = pk4_fp8(s[12 * 65], s[13 * 65], s[14 * 65], s[15 * 65]);
            *(u32x4*)(t.dst + (size_t)n * DM + 16 * c) = o; }
    } else { const int c = lane & 7;
#pragma unroll
        for (int j = 0; j < 8; ++j) { const int n = (lane >> 3) + 8 * j; const LAS float* s = scr + (8 * c) * 65 + n;
            u32x4 o; o.x = pk2(s[0 * 65], s[1 * 65]); o.y = pk2(s[2 * 65], s[3 * 65]); o.z = pk2(s[4 * 65], s[5 * 65]); o.w = pk2(s[6 * 65], s[7 * 65]);
            *(u32x4*)(t.dst + ((size_t)n * DM + 8 * c) * 2) = o; }
    }
    LDS_WAIT(); asm volatile("" ::: "memory");
}
template <bool W8>
__device__ __forceinline__ TItem moe_pair(const Args& a, uchar* ws, int it) {
    constexpr size_t WEB = W8 ? 1 : 2; TItem t;
    const int kb = 2 * ((it & 7) | (((it >> 11) & 1) << 3)), nb = (it >> 3) & 31;
    if (it < NE * 2 * 16 * 32) { const int rest = ((it >> 8) & 7) | ((it >> 12) << 3), half = rest & 1, e = rest >> 1, pn = nb >> 1, q = nb & 1;
        t.src = a.in[half ? I_WU : I_WG] + (size_t)e * DM * DFF + (size_t)(kb * 64) * DFF + nb * 64;
        t.dst = ws + WS_W1 + ((size_t)e * 4096 * DM + (size_t)(pn * 256 + half * 128 + q * 64) * DM + kb * 64) * WEB;
    } else { const int r = it - NE * 2 * 16 * 32, e = ((r >> 8) & 7) | ((r >> 12) << 3);
        t.src = a.in[I_WD] + (size_t)e * DFF * DM + (size_t)(kb * 64) * DM + nb * 64;
        t.dst = ws + WS_W2 + ((size_t)e * DM * DFF + (size_t)(nb * 64) * DFF + kb * 64) * WEB; }
    return t;
}
template <bool FP8OUT, int NO>
__device__ __forceinline__ void ti_block(const f32x4 (&v)[16], float oscale, LAS float* scr, int lane, u32x4 (&o)[NO]) {
#pragma unroll
    for (int i = 0; i < 16; ++i) { LAS float* d = scr + (4 * i + (lane >> 4)) * 65 + (lane & 15) * 4; d[0] = v[i].x * oscale; d[1] = v[i].y * oscale; d[2] = v[i].z * oscale; d[3] = v[i].w * oscale; }
    LDS_WAIT(); asm volatile("" ::: "memory");
    if constexpr (FP8OUT) { const int c = lane & 3;
#pragma unroll
        for (int j = 0; j < 4; ++j) { const int n = (lane >> 2) + 16 * j; const LAS float* s = scr + (16 * c) * 65 + n;
            o[j].x = pk4_fp8(s[0 * 65], s[1 * 65], s[2 * 65], s[3 * 65]); o[j].y = pk4_fp8(s[4 * 65], s[5 * 65], s[6 * 65], s[7 * 65]);
            o[j].z = pk4_fp8(s[8 * 65], s[9 * 65], s[10 * 65], s[11 * 65]); o[j].w = pk4_fp8(s[12 * 65], s[13 * 65], s[14 * 65], s[15 * 65]); }
    } else { const int c = lane & 7;
#pragma unroll
        for (int j = 0; j < 8; ++j) { const int n = (lane >> 3) + 8 * j; const LAS float* s = scr + (8 * c) * 65 + n;
            o[j].x = pk2(s[0 * 65], s[1 * 65]); o[j].y = pk2(s[2 * 65], s[3 * 65]); o[j].z = pk2(s[4 * 65], s[5 * 65]); o[j].w = pk2(s[6 * 65], s[7 * 65]); } }
    LDS_WAIT(); asm volatile("" ::: "memory");
}
__device__ __forceinline__ int win_src_col(int n0) {
    if (n0 < C_KVLAT) return n0;
    if (n0 < C_U) return n0;
    if (n0 < C_GA) return (n0 - C_U) + 832;
    if (n0 < C_KR) return (n0 - C_GA) + 1856;
    if (n0 < C_KR + DROPE) return (n0 - C_KR) + 768;
    return -1;
}
__device__ __forceinline__ void s5_build_group(const Args& a, const Frame& F, int g) {
    FRAME_IDS(F);
    LAS float* L = (LAS float*)F.lds;
    LAS float* Apr = L;              LAS float* Api = Apr + 17 * 64;
    LAS float* Zr = Api + 17 * 64;   LAS float* Zi = Zr + 64;
    LAS float* Bbr = Zi + 64;        LAS float* Bbi = Bbr + 1024;
    LAS float* Cr = Bbi + 1024;      LAS float* Ci = Cr + 1024;
    LAS float* Kt = Ci + 1024;
    const int tid = F_tid;
    __syncthreads();
    if (tid < 64) { const int p = tid;
        const float dt = expf(a.in[I_LOGDT][g]); const float lr = a.in[I_LRE][g * 64 + p], li = a.in[I_LIM][g * 64 + p];
        const float mag = expf(lr * dt); const float ar = mag * cosf(li * dt), ai = mag * sinf(li * dt);
        const float den = lr * lr + li * li;
        Zr[p] = ((ar - 1.0f) * lr + ai * li) / den; Zi[p] = (ai * lr - (ar - 1.0f) * li) / den;
        float pr = 1.0f, pi = 0.0f;
        for (int t = 0; t <= 16; ++t) { Apr[t * 64 + p] = pr; Api[t * 64 + p] = pi; const float nr = pr * ar - pi * ai, ni = pr * ai + pi * ar; pr = nr; pi = ni; }
    }
    __syncthreads();
    for (int i = tid; i < 1024; i += NTHREADS) { const int p = i >> 4;
        const float br = a.in[I_BRE][(size_t)g * 1024 + i], bi = a.in[I_BIM][(size_t)g * 1024 + i];
        Bbr[i] = Zr[p] * br - Zi[p] * bi; Bbi[i] = Zr[p] * bi + Zi[p] * br;
        Cr[i] = a.in[I_CRE][(size_t)g * 1024 + i]; Ci[i] = a.in[I_CIM][(size_t)g * 1024 + i]; }
    if (tid < 64) ((float2*)(F.ws + WS_SMALL + SM_A16))[g * 64 + tid] = make_float2(Apr[16 * 64 + tid], Api[16 * 64 + tid]);
    __syncthreads();
    { const int tau = tid >> 5, c = (tid >> 1) & 15, h8 = (tid & 1) * 8; float acc8[8];
#pragma unroll
      for (int j = 0; j < 8; ++j) acc8[j] = 0.f;
      for (int p = 0; p < 64; ++p) { const float cr = Cr[c * 64 + p], ci = Ci[c * 64 + p], ar = Apr[tau * 64 + p], ai = Api[tau * 64 + p];
          const float car = cr * ar - ci * ai, cai = cr * ai + ci * ar;
          const f32x4 b0 = *(const LAS f32x4*)(Bbr + p * 16 + h8), b1 = *(const LAS f32x4*)(Bbr + p * 16 + h8 + 4), d0 = *(const LAS f32x4*)(Bbi + p * 16 + h8), d1 = *(const LAS f32x4*)(Bbi + p * 16 + h8 + 4);
#pragma unroll
          for (int j = 0; j < 4; ++j) { acc8[j] += car * b0[j] - cai * d0[j]; acc8[4 + j] += car * b1[j] - cai * d1[j]; } }
#pragma unroll
      for (int j = 0; j < 8; ++j) Kt[(tau * 16 + c) * 16 + h8 + j] = acc8[j]; }
    __syncthreads();
    bf16_t* twc = (bf16_t*)(F.ws + WS_TWC) + (size_t)g * 256 * APK;
    for (int ch = tid; ch < 256 * (APK / 8); ch += NTHREADS) { const int n = ch / (APK / 8), k0 = (ch % (APK / 8)) * 8, t = n >> 4, c = n & 15; float v[8];
#pragma unroll
        for (int j = 0; j < 8; ++j) { const int k = k0 + j;
            if (k < 256) { const int s = k >> 4, cp = k & 15; float x = (s <= t) ? Kt[((t - s) * 16 + c) * 16 + cp] : 0.f; if (s == t && cp == c) x += a.in[I_S5D][g * 16 + c]; v[j] = x; }
            else { const int q = k - 256, p = q & 63; const float cr = Cr[c * 64 + p], ci = Ci[c * 64 + p], ar = Apr[(t + 1) * 64 + p], ai = Api[(t + 1) * 64 + p];
                v[j] = (q < 64) ? (cr * ar - ci * ai) : -(cr * ai + ci * ar); } }
        u32x4 o; o.x = pk2(v[0], v[1]); o.y = pk2(v[2], v[3]); o.z = pk2(v[4], v[5]); o.w = pk2(v[6], v[7]);
        *(u32x4*)(twc + (size_t)n * APK + k0) = o; }
    bf16_t* wsm = (bf16_t*)(F.ws + WS_WS5) + (size_t)g * 256 * 256;
    for (int ch = tid; ch < 256 * 32; ch += NTHREADS) { const int n = ch >> 5, k0 = (ch & 31) * 8; float v[8];
#pragma unroll
        for (int j = 0; j < 8; ++j) { const int k = k0 + j, s = k >> 4, cp = k & 15;
            if (n < 128) { const int p = n & 63; const float ar = Apr[(15 - s) * 64 + p], ai = Api[(15 - s) * 64 + p], br = Bbr[p * 16 + cp], bi = Bbi[p * 16 + cp];
                v[j] = (n < 64) ? (ar * br - ai * bi) : (ar * bi + ai * br); } else v[j] = 0.f; }
        u32x4 o; o.x = pk2(v[0], v[1]); o.y = pk2(v[2], v[3]); o.z = pk2(v[4], v[5]); o.w = pk2(v[6], v[7]);
        *(u32x4*)(wsm + (size_t)n * 256 + k0) = o; }
    __syncthreads();
}
__device__ __forceinline__ void rms_row_to_bf16(const float* xrow, const float* gain, bf16_t* orow, int lane) {
    const f32x4* xr = (const f32x4*)xrow + lane; const f32x4* gr = (const f32x4*)gain + lane;
    f32x4 v[8]; float s = 0.f;
#pragma unroll
    for (int j = 0; j < 8; ++j) { v[j] = __builtin_nontemporal_load(xr + 64 * j); s += (v[j].x * v[j].x + v[j].y * v[j].y) + (v[j].z * v[j].z + v[j].w * v[j].w); }
    const float rstd = 1.0f / sqrtf(wave_sum(s) * (1.0f / DM) + EPS);
#if MK_FP8_INPROJ
    unsigned* o4 = (unsigned*)orow + lane; const float rs4 = rstd * FP8_ASCALE;
#pragma unroll
    for (int j = 0; j < 8; ++j) { const f32x4 gg = gr[64 * j]; o4[64 * j] = pk4_fp8(v[j].x * rs4 * gg.x, v[j].y * rs4 * gg.y, v[j].z * rs4 * gg.z, v[j].w * rs4 * gg.w); }
#else
    unsigned long long* o8 = (unsigned long long*)orow + lane;
#pragma unroll
    for (int j = 0; j < 8; ++j) { const f32x4 gg = gr[64 * j];
        o8[64 * j] = (unsigned long long)pk2(v[j].x * rstd * gg.x, v[j].y * rstd * gg.y) | ((unsigned long long)pk2(v[j].z * rstd * gg.z, v[j].w * rstd * gg.w) << 32); }
#endif
}
__device__ __forceinline__ void p0_prologue(const Args& a, const Frame& F) {
    FRAME_IDS(F);
    for (int g = F.bx; g < S5G; g += F.G) s5_build_group(a, F, g);
    __syncthreads();
    const int gw = F.bx * NWAVES + F.wave, NGW = F.G * NWAVES; const int lane = F_lane;
    for (int m = gw; m < TT; m += NGW) rms_row_to_bf16(a.in[I_X] + (size_t)m * DM, a.in[I_N1G], (bf16_t*)(F.ws + WS_H + (size_t)m * DM * (MK_FP8_INPROJ ? 1 : 2)), lane);
    for (int i = gw * 64 + lane; i < TT * 32; i += NGW * 64) { const int t = i >> 5, f = i & 31;
        const double invf = exp(-(double)f * (9.210340371976184 / 32.0)); const double ang = (double)((const int*)a.in[I_POS])[t] * invf;
        ((float2*)(F.ws + WS_ROPE))[i] = make_float2((float)cos(ang), (float)sin(ang)); }
    for (int i = gw * 64 + lane; i < DM * NE; i += NGW * 64) ((float*)(F.ws + WS_SMALL + SM_WRP))[i] = a.in[I_WR][i] * a.in[I_N2G][i >> 5];
    LAS float* scr = (LAS float*)(F.lds + F.wave * 16640);
    constexpr int IT_WIN = (DM / 64) * (NPROJ / 64), IT_WUQ = (QLORA / 64) * (3072 / 64), IT_WUKV = (KVLORA / 64) * (4096 / 64), IT_SQ = (DM / 64) * (DM / 64),
                  IT_GLU = (S5W / 64) * (S5W / 64), IT_OS5 = (S5W / 64) * (DM / 64);
    constexpr int IT_MIX = IT_WIN + IT_WUQ + IT_WUKV + IT_SQ + IT_GLU + IT_OS5 + IT_SQ;
    for (int it = gw; it < IT_MIX; it += NGW) { int r = it;
        if (r < IT_WIN) { const int nb = r % (NPROJ / 64), kb = r / (NPROJ / 64); transpose_item<MK_FP8_INPROJ != 0>(a.in[I_WIN], IN_PROJ, win_src_col(nb * 64), kb * 64, nullptr, F.ws + WS_WIN, DM, nb * 64, MK_FP8_INPROJ ? FP8_WSCALE : 1.f, scr, lane); continue; } r -= IT_WIN;
        if (r < IT_WUQ) { const int nb = r % 48, kb = r / 48; transpose_item<false>(a.in[I_WUQ], 3072, nb * 64, kb * 64, a.in[I_QNG], F.ws + WS_WUQ, QLORA, nb * 64, 1.f, scr, lane); continue; } r -= IT_WUQ;
        if (r < IT_WUKV) { const int nb = r % 64, kb = r / 64; transpose_item<false>(a.in[I_WUKV], 4096, nb * 64, kb * 64, a.in[I_KVNG], F.ws + WS_WUKV, KVLORA, nb * 64, 1.f, scr, lane); continue; } r -= IT_WUKV;
        if (r < IT_SQ) { const int nb = r % 32, kb = r / 32; transpose_item<MK_FP8_YA != 0>(a.in[I_WOMLA], DM, nb * 64, kb * 64, nullptr, F.ws + WS_WOMLA, DM, nb * 64, MK_FP8_YA ? FP8_WSCALE : 1.f, scr, lane); continue; } r -= IT_SQ;
        if (r < IT_GLU) { const int nb = r % 16, kb = r / 16; transpose_item<false>(a.in[I_WGLU], S5W, nb * 64, kb * 64, nullptr, F.ws + WS_WGLU, S5W, nb * 64, 1.f, scr, lane); continue; } r -= IT_GLU;
        if (r < IT_OS5) { const int nb = r % 32, kb = r / 32; transpose_item<MK_FP8_YB != 0>(a.in[I_WOS5], DM, nb * 64, kb * 64, nullptr, F.ws + WS_WOS5, S5W, nb * 64, MK_FP8_YB ? FP8_WSCALE : 1.f, scr, lane); continue; } r -= IT_OS5;
        { const int nb = r % 32, kb = r / 32; transpose_item<MK_FP8_OUT != 0>(a.in[I_WOUT], DM, nb * 64, kb * 64, nullptr, F.ws + WS_WOUT, DM, nb * 64, MK_FP8_OUT ? FP8_WSCALE : 1.f, scr, lane); }
    }
    constexpr bool W8 = MK_FP8_MOE != 0; constexpr float WSC = W8 ? FP8_WSCALE : 1.0f; constexpr int NPAIR = NE * 3 * 16 * 32; constexpr int NO = W8 ? 4 : 8;
    for (int it = gw; it < NPAIR; it += NGW) { const TItem t = moe_pair<W8>(a, F.ws, it); f32x4 v0[16], v1[16];
        ti_load(t, v0, lane); { TItem t1 = t; t1.src += (size_t)64 * DM; ti_load(t1, v1, lane); }
        u32x4 o0[NO], o1[NO];
        ti_block<W8, NO>(v0, WSC, scr, lane, o0); ti_block<W8, NO>(v1, WSC, scr, lane, o1);
        if constexpr (W8) { const int c = lane & 3;
#pragma unroll
            for (int j = 0; j < 4; ++j) { uchar* d = t.dst + (size_t)((lane >> 2) + 16 * j) * DM + 16 * c; *(u32x4*)d = o0[j]; *(u32x4*)(d + 64) = o1[j]; }
        } else { const int c = lane & 7;
#pragma unroll
            for (int j = 0; j < 8; ++j) { uchar* d = t.dst + ((size_t)((lane >> 3) + 8 * j) * DM + 8 * c) * 2; *(u32x4*)d = o0[j]; *(u32x4*)(d + 128) = o1[j]; } }
    }
}

constexpr float QSCALE = 0.07216878364870322f * 1.4426950408889634f;
__device__ __forceinline__ float half_sum(float v) {
#pragma unroll
    for (int o = 1; o < 32; o <<= 1) v += __shfl_xor(v, o);
    return v;
}
__device__ __forceinline__ void p3_prep(const Args& a, const Frame& F) {
    FRAME_IDS(F);
    const bf16_t* proj = (const bf16_t*)(F.ws + WS_PROJ); const bf16_t* kvraw = (const bf16_t*)(F.ws + WS_KVRAW); bf16_t* Kn = (bf16_t*)(F.ws + WS_KN);
    const float2* rope = (const float2*)(F.ws + WS_ROPE);
    const int lane = F_lane, grp = lane / 24, ch = lane - grp * 24; const bool act = grp < 2;
    const bool isrope = act && ch >= 16, x2half = isrope && ch >= 20; const int ri = isrope ? ((ch - 16) & 3) * 8 : 0;
    float g[8];
#pragma unroll
    for (int j = 0; j < 8; ++j) g[j] = act ? a.in[I_QKKG][ch * 8 + j] : 0.f;
    const bool even = (TT == 64 * F.G);
    const int tk0 = even ? F.bx * 64 + (F.wave < 2 ? 5 * F.wave : 10 + 9 * (F.wave - 2)) : F.bx * NWAVES + F.wave, tkn = even ? (F.wave < 2 ? 5 : 9) : (TT + F.G * NWAVES - 1) / (F.G * NWAVES), tks = even ? 1 : F.G * NWAVES;
    for (int ti = 0; ti < tkn; ++ti) { const int t = tk0 + ti * tks; if (t >= TT) break;
        const int b = t >> 11, s = t & 2047; const bf16_t* prow = proj + (size_t)t * NPROJ;
        float cs[8], sn[8];
        if (isrope) {
#pragma unroll
            for (int j = 0; j < 8; j += 2) { const f32x4 c2 = *(const f32x4*)(rope + (size_t)t * 32 + ri + j); cs[j] = c2.x; sn[j] = c2.y; cs[j + 1] = c2.z; sn[j + 1] = c2.w; } }
        else {
#pragma unroll
            for (int j = 0; j < 8; ++j) { cs[j] = 1.f; sn[j] = 0.f; } }
        u32x4 kr = (u32x4){0u, 0u, 0u, 0u};
        if (isrope) kr = *(const u32x4*)(prow + C_KR + (ch - 16) * 8);
        u32x4 wl[8];
        { const bf16_t* src0 = kvraw + ((size_t)(b * NH + grp) * SEQ + s) * 128 + (ch & 15) * 8;
#pragma unroll
          for (int i = 0; i < 8; ++i) wl[i] = (!act) ? (u32x4){0u, 0u, 0u, 0u} : (isrope ? kr : *(const u32x4*)(src0 + (size_t)i * 2 * SEQ * 128)); }
#pragma unroll
        for (int i = 0; i < 8; ++i) { const int h = 2 * i + grp; const u32x4 w = wl[i];
            float x[8], ss = 0.f;
#pragma unroll
            for (int q = 0; q < 4; ++q) { x[2 * q] = bflo(w[q]); x[2 * q + 1] = bfhi(w[q]); }
#pragma unroll
            for (int j = 0; j < 8; ++j) ss += x[j] * x[j];
            const float s0 = wave_sum(grp == 0 ? ss : 0.f), s1 = wave_sum(grp == 1 ? ss : 0.f);
            const float rn = 1.0f / sqrtf((grp == 0 ? s0 : s1) * (1.0f / DQK) + EPS);
            float y[8];
#pragma unroll
            for (int j = 0; j < 8; ++j) y[j] = x[j] * rn * g[j];
#pragma unroll
            for (int j = 0; j < 8; ++j) { const float partner = __shfl_xor(y[j], 4); y[j] = x2half ? (y[j] * cs[j] + partner * sn[j]) : (y[j] * cs[j] - partner * sn[j]); }
            if (act) { u32x4 o; o.x = pk2(y[0], y[1]); o.y = pk2(y[2], y[3]); o.z = pk2(y[4], y[5]); o.w = pk2(y[6], y[7]);
                *(u32x4*)(Kn + ((size_t)(b * NH + h) * SEQ + s) * DQK + ch * 8) = o; }
        }
    }
}

__device__ __forceinline__ void p3_scan(const Args& a, const Frame& F) {
    FRAME_IDS(F);
    const float* sch = (const float*)(F.ws + WS_SCH); bf16_t* apack = (bf16_t*)(F.ws + WS_APACK); const float2* A16 = (const float2*)(F.ws + WS_SMALL + SM_A16);
    const int p = F_lane;
    for (int it = F.wave * F.G + F.bx; it < NB * S5G; it += F.G * NWAVES) { const int b = it / S5G, g = it % S5G;
        const float2 am = A16[g * 64 + p]; float xr = 0.f, xi = 0.f;
        const size_t row0 = (size_t)g * NCHUNK + (size_t)b * 128;
        for (int c0 = 0; c0 < 128; c0 += 32) { float sr[32], si[32];
#pragma unroll
            for (int q = 0; q < 32; ++q) { sr[q] = sch[(row0 + c0 + q) * 128 + p]; si[q] = sch[(row0 + c0 + q) * 128 + 64 + p]; }
#pragma unroll
            for (int q = 0; q < 32; ++q) { bf16_t* o = apack + (row0 + c0 + q) * APK + 256; o[p] = (bf16_t)f2bf(xr); o[64 + p] = (bf16_t)f2bf(xi);
                const float nr = am.x * xr - am.y * xi + sr[q], ni = am.x * xi + am.y * xr + si[q]; xr = nr; xi = ni; } }
    }
}

__device__ __forceinline__ void s5_reference(const Args& a, const Frame& F) {
    FRAME_IDS(F);
    const bf16_t* apack = (const bf16_t*)(F.ws + WS_APACK); bf16_t* gact = (bf16_t*)(F.ws + WS_GACT);
    const int gw = F.bx * NWAVES + F.wave, NGW = F.G * NWAVES, p = F_lane;
    for (int it = gw; it < NB * S5G; it += NGW) { const int b = it / S5G, g = it % S5G;
        const float dt = expf(a.in[I_LOGDT][g]); const float lr = a.in[I_LRE][g * 64 + p], li = a.in[I_LIM][g * 64 + p];
        const float mag = expf(lr * dt); const float ar = mag * cosf(li * dt), ai = mag * sinf(li * dt); const float den = lr * lr + li * li;
        const float zr = ((ar - 1.0f) * lr + ai * li) / den, zi = (ai * lr - (ar - 1.0f) * li) / den;
        float bbr[16], bbi[16], cr[16], ci[16];
#pragma unroll
        for (int c = 0; c < 16; ++c) { const float br = a.in[I_BRE][((size_t)g * 64 + p) * 16 + c], bi = a.in[I_BIM][((size_t)g * 64 + p) * 16 + c];
            bbr[c] = zr * br - zi * bi; bbi[c] = zr * bi + zi * br; cr[c] = a.in[I_CRE][((size_t)g * 16 + c) * 64 + p]; ci[c] = a.in[I_CIM][((size_t)g * 16 + c) * 64 + p]; }
        const float dl = (p < 16) ? a.in[I_S5D][g * 16 + p] : 0.f;
        float xr = 0.f, xi = 0.f;
        for (int t = 0; t < SEQ; ++t) { const int tok = b * SEQ + t;
            const bf16_t* up = apack + ((size_t)g * NCHUNK + (tok >> 4)) * APK + (tok & 15) * 16;
            const u32x4 w0 = *(const u32x4*)up, w1 = *(const u32x4*)(up + 8); float u[16];
#pragma unroll
            for (int q = 0; q < 4; ++q) { u[2 * q] = bflo(w0[q]); u[2 * q + 1] = bfhi(w0[q]); u[8 + 2 * q] = bflo(w1[q]); u[8 + 2 * q + 1] = bfhi(w1[q]); }
            float br = 0.f, bi = 0.f;
#pragma unroll
            for (int c = 0; c < 16; ++c) { br += bbr[c] * u[c]; bi += bbi[c] * u[c]; }
            const float nr = ar * xr - ai * xi + br, ni = ar * xi + ai * xr + bi; xr = nr; xi = ni;
            float y = 0.f, um = 0.f;
#pragma unroll
            for (int c = 0; c < 16; ++c) { const float yc = wave_sum(cr[c] * xr - ci[c] * xi); if (p == c) { y = yc; um = u[c]; } }
            if (p < 16) gact[(size_t)tok * S5W + g * 16 + p] = (bf16_t)f2bf(gelu_tanh(y + dl * um));
        }
    }
}

__device__ __forceinline__ float attn_bound(const Args& a, int lane) {
    float mq = 0.f, mk = 0.f;
#pragma unroll
    for (int q = 0; q < 3; ++q) { mq = fmaxf(mq, fabsf(a.in[I_QKQG][lane + 64 * q])); mk = fmaxf(mk, fabsf(a.in[I_QKKG][lane + 64 * q])); }
#pragma unroll
    for (int o = 1; o < 64; o <<= 1) { mq = fmaxf(mq, __shfl_xor(mq, o)); mk = fmaxf(mk, __shfl_xor(mk, o)); }
    return mq * mk * 13.856406460551018f * 1.4426950408889634f;
}
__device__ __forceinline__ void attn_reference(const Args& a, const Frame& F) {
    FRAME_IDS(F);
    const bf16_t* Qn = (const bf16_t*)(F.ws + WS_QN); const bf16_t* Kn = (const bf16_t*)(F.ws + WS_KN); const bf16_t* Vn = (const bf16_t*)(F.ws + WS_VN);
    bf16_t* O = (bf16_t*)(F.ws + WS_O);
    LAS float* ql = (LAS float*)(F.lds + F.wave * 1024);
    const int lane = F_lane, gw = F.bx * NWAVES + F.wave, NGW = F.G * NWAVES;
    const float Mb = attn_bound(a, lane);
    for (int it = gw; it < NB * NH * SEQ; it += NGW) { const int s = it & 2047, bh = it >> 11, b = bh >> 4, h = bh & 15;
        const bf16_t* qp = Qn + ((size_t)bh * SEQ + s) * DQK;
#pragma unroll
        for (int q = 0; q < 3; ++q) ql[lane + 64 * q] = bf2f(qp[lane + 64 * q]);
        LDS_WAIT();
        const int nk = 64 * ((s >> 6) + 1);
        float o0 = 0.f, o1 = 0.f, l = 0.f;
        for (int k0 = 0; k0 < nk; k0 += 64) {
            const bf16_t* kp = Kn + ((size_t)bh * SEQ + k0 + lane) * DQK; float sc = 0.f;
            for (int d = 0; d < DQK; d += 8) { const u32x4 w = *(const u32x4*)(kp + d);
#pragma unroll
                for (int q = 0; q < 4; ++q) sc += bflo(w[q]) * ql[d + 2 * q] + bfhi(w[q]) * ql[d + 2 * q + 1]; }
            const float pr = __builtin_amdgcn_exp2f(sc - Mb); l += pr;
            for (int kk = 0; kk < 64; ++kk) { const float pk = __shfl(pr, kk); const unsigned w = *(const unsigned*)(Vn + ((size_t)bh * SEQ + k0 + kk) * DV + 2 * lane);
                o0 += pk * bflo(w); o1 += pk * bfhi(w); }
        }
        l = wave_sum(l); const float rl = 1.0f / l;
        *(unsigned*)(O + ((size_t)(b * SEQ + s)) * DM + h * DV + 2 * lane) = pk2(o0 * rl, o1 * rl);
        LDS_WAIT();
    }
}

namespace at {
constexpr int KVB = 64;
constexpr int SHM_V = KVB * DV * 2  , SHM_K = KVB * DQK * 2  ;
constexpr int NQR = 4;
constexpr int OFF_V = 0, OFF_K = 2 * SHM_V, OFF_WS = OFF_K + 2 * SHM_K  , OFF_QL = OFF_WS + NWAVES * 256  , OFF_OST = 0;
constexpr int OPITCH = 272;
static_assert(OFF_QL + NWAVES * (12 - NQR) * 1024 <= LDSCTL_OFF, "attention LDS map");
#define KSWZ(row, colB) ((row) * 384 + ((colB) ^ ((((row) >> 1) & 7) << 4)))
__device__ __forceinline__ int crow(int r, int hi) { return (r & 3) + 8 * (r >> 2) + 4 * hi; }
__device__ __forceinline__ int v_st(int k, int c) { const int kk = (k & ~0xC) | ((k & 4) << 1) | ((k & 8) >> 1); return ((kk >> 3) * 4 + (c >> 5)) * 512 + ((kk & 7) * 32 + (c & 31)) * 2; }
__device__ __forceinline__ int v_rd_base(int lane) { return ((lane & 3) << 3) | (((lane >> 2) & 3) << 6) | (((lane >> 4) & 1) << 5) | (((lane >> 5) & 1) << 8); }
constexpr int v_rd_off(int d0, int ks, int half) { return d0 * 512 + ks * 4096 + half * 2048; }
template <int OFF> __device__ __forceinline__ s16x4 tr_read(int vb) { s16x4 r; asm volatile("ds_read_b64_tr_b16 %0, %1 offset:%2" : "=&v"(r) : "v"(vb), "i"(OFF) : "memory"); return r; }
template <int D0> __device__ __forceinline__ void pv_one(f32x16& od, int vb, bf16x8 pa0, bf16x8 pa1, bf16x8 pa2, bf16x8 pa3) {
    const s16x4 l0 = tr_read<v_rd_off(D0, 0, 0)>(vb), h0 = tr_read<v_rd_off(D0, 0, 1)>(vb), l1 = tr_read<v_rd_off(D0, 1, 0)>(vb), h1 = tr_read<v_rd_off(D0, 1, 1)>(vb);
    const s16x4 l2 = tr_read<v_rd_off(D0, 2, 0)>(vb), h2 = tr_read<v_rd_off(D0, 2, 1)>(vb), l3 = tr_read<v_rd_off(D0, 3, 0)>(vb), h3 = tr_read<v_rd_off(D0, 3, 1)>(vb);
    asm volatile("s_waitcnt lgkmcnt(0)" ::: "memory"); SBAR();
#define PK(L, H) (bf16x8){L[0], L[1], L[2], L[3], H[0], H[1], H[2], H[3]}
    od = __builtin_amdgcn_mfma_f32_32x32x16_bf16(pa0, PK(l0, h0), od, 0, 0, 0);
    od = __builtin_amdgcn_mfma_f32_32x32x16_bf16(pa1, PK(l1, h1), od, 0, 0, 0);
    od = __builtin_amdgcn_mfma_f32_32x32x16_bf16(pa2, PK(l2, h2), od, 0, 0, 0);
    od = __builtin_amdgcn_mfma_f32_32x32x16_bf16(pa3, PK(l3, h3), od, 0, 0, 0);
#undef PK
}
__device__ __forceinline__ void pv_d0(f32x16* o, int vb, bf16x8 pa0, bf16x8 pa1, bf16x8 pa2, bf16x8 pa3) {
    pv_one<0>(o[0], vb, pa0, pa1, pa2, pa3); pv_one<1>(o[1], vb, pa0, pa1, pa2, pa3); pv_one<2>(o[2], vb, pa0, pa1, pa2, pa3); pv_one<3>(o[3], vb, pa0, pa1, pa2, pa3);
}
template <int BUF, int NQR> __device__ __forceinline__ void qkt(f32x16& p0, f32x16& p1, const int (&kb)[4], const bf16x8* qr, int qlb, float bias) {
#pragma unroll
    for (int r = 0; r < 16; ++r) { p0[r] = bias; p1[r] = bias; }
#pragma unroll
    for (int a = 0; a < 3; ++a)
#pragma unroll
        for (int b = 0; b < 4; ++b) { const int d0 = 4 * a + b;
            const bf16x8 b0 = *(const LAS bf16x8*)(kb[b] + BUF * SHM_K + a * 128);
            const bf16x8 b1 = *(const LAS bf16x8*)(kb[b] + BUF * SHM_K + a * 128 + 32 * 384);
            bf16x8 q; if (d0 < NQR) q = qr[d0]; else q = *(const LAS bf16x8*)(qlb + (d0 - NQR) * 1024);
            p0 = __builtin_amdgcn_mfma_f32_32x32x16_bf16(b0, q, p0, 0, 0, 0);
            p1 = __builtin_amdgcn_mfma_f32_32x32x16_bf16(b1, q, p1, 0, 0, 0); }
}
__device__ __forceinline__ void partialSM(f32x16& p0, f32x16& p1) {
#pragma unroll
    for (int r = 0; r < 16; ++r) p0[r] = __builtin_amdgcn_exp2f(p0[r]);
}
__device__ __forceinline__ void finishSM(f32x16& p0, f32x16& p1, float& l_reg, bf16x8& pa0, bf16x8& pa1, bf16x8& pa2, bf16x8& pa3) {
#pragma unroll
    for (int r = 0; r < 16; ++r) p1[r] = __builtin_amdgcn_exp2f(p1[r]);
    float ps = 0;
#pragma unroll
    for (int r = 0; r < 16; ++r) ps += p0[r];
#pragma unroll
    for (int r = 0; r < 16; ++r) ps += p1[r];
    { auto rr = __builtin_amdgcn_permlane32_swap(__float_as_uint(ps), __float_as_uint(ps), false, false); ps = __uint_as_float(rr[0]) + __uint_as_float(rr[1]); }
    l_reg += ps;
#define PK4(P, BASE, OUT) do { unsigned a0 = cvt_pk_bf16(P[BASE + 0], P[BASE + 1]), a1 = cvt_pk_bf16(P[BASE + 2], P[BASE + 3]);   \
    unsigned b0 = cvt_pk_bf16(P[BASE + 4], P[BASE + 5]), b1 = cvt_pk_bf16(P[BASE + 6], P[BASE + 7]);                              \
    auto r0 = __builtin_amdgcn_permlane32_swap(a0, b0, false, false); auto r1 = __builtin_amdgcn_permlane32_swap(a1, b1, false, false); \
    u32x4 w = {r0[0], r1[0], r0[1], r1[1]}; OUT = *reinterpret_cast<bf16x8*>(&w); } while (0)
    PK4(p0, 0, pa0); PK4(p0, 8, pa1); PK4(p1, 0, pa2); PK4(p1, 8, pa3);
#undef PK4
}
__device__ __forceinline__ void attn_qblock(const bf16_t* __restrict__ Qb, const bf16_t* __restrict__ Kh, const bf16_t* __restrict__ Vh, bf16_t* __restrict__ Ob, int qb, float Mb, LAS char* lds, const int wid,
                                            const float2* __restrict__ ropeb, const float* __restrict__ gq) {
    const int lane = fresh_lane(), tid = wid * 64 + lane, r32 = lane & 31, hi = lane >> 5;
    LAS char* V_lds = lds + OFF_V; LAS char* K_lds = lds + OFF_K;
    LAS float* li_l = (LAS float*)(lds + OFF_WS) + wid * 64;
    float l_reg = 0; f32x16 o[4] = {}; bf16x8 qr[NQR];
    const int qlb = (int)(uintptr_t)(lds + OFF_QL) + wid * ((12 - NQR) * 1024) + lane * 16;
    {
        const bf16_t* Qw = Qb + (size_t)(wid * 32 + r32) * (NH * DQK) + hi * 8;
        bf16x8 qf[12];
#pragma unroll
        for (int d0 = 0; d0 < 12; ++d0) qf[d0] = *(const bf16x8*)(Qw + d0 * 16);
        float ssq = 0.f;
#pragma unroll
        for (int d0 = 0; d0 < 12; ++d0)
#pragma unroll
            for (int j = 0; j < 8; ++j) { const float v = bf2f((unsigned short)qf[d0][j]); ssq += v * v; }
        ssq += __shfl_xor(ssq, 32);
        const float rn = QSCALE / sqrtf(ssq * (1.0f / DQK) + EPS);
        const float2* rp = ropeb + (size_t)(wid * 32 + r32) * 32 + hi * 8;
#pragma unroll
        for (int d0 = 0; d0 < 12; ++d0) { bf16x8 qn;
            if (d0 < 8) { const f32x4 g0 = *(const f32x4*)(gq + d0 * 16 + hi * 8), g1 = *(const f32x4*)(gq + d0 * 16 + hi * 8 + 4);
#pragma unroll
                for (int j = 0; j < 8; ++j) qn[j] = (short)f2bf(bf2f((unsigned short)qf[d0][j]) * rn * (j < 4 ? g0[j] : g1[j - 4])); }
            else { const int pp = (d0 - 8) & 1, da = 8 + pp, db = 10 + pp; const bool second = d0 >= 10;
#pragma unroll
                for (int j = 0; j < 8; ++j) { const float2 c = rp[pp * 16 + j];
                    const float y1 = bf2f((unsigned short)qf[da][j]) * rn * gq[128 + pp * 16 + hi * 8 + j], y2 = bf2f((unsigned short)qf[db][j]) * rn * gq[160 + pp * 16 + hi * 8 + j];
                    qn[j] = (short)f2bf(second ? (y2 * c.x + y1 * c.y) : (y1 * c.x - y2 * c.y)); } }
            if (d0 < NQR) qr[d0] = qn; else *(LAS bf16x8*)(qlb + (d0 - NQR) * 1024) = qn; }
    }
    const int sr = tid >> 4, sc = (tid & 15) * 8, vst0 = v_st(sr, sc), vst1 = v_st(32 + sr, sc);
    int kro[3], kst[3];
#pragma unroll
    for (int i = 0; i < 3; ++i) { const int q = tid + 512 * i, row = q / 24, c8 = q % 24; kro[i] = row * DQK + c8 * 8; kst[i] = KSWZ(row, c8 * 16); }
    const int vb0 = (int)(uintptr_t)V_lds + v_rd_base(lane);
    int kb[4];
#pragma unroll
    for (int b = 0; b < 4; ++b) kb[b] = (int)(uintptr_t)K_lds + r32 * 384 + ((b * 32 + hi * 16) ^ (((r32 >> 1) & 7) << 4));
    bf16x8 vs0, vs1, ks0, ks1, ks2;
#define SLOAD(k0) do { vs0 = *(const bf16x8*)(Vh + (size_t)((k0) + sr) * DV + sc); vs1 = *(const bf16x8*)(Vh + (size_t)((k0) + 32 + sr) * DV + sc); \
    ks0 = *(const bf16x8*)(Kh + (size_t)(k0) * DQK + kro[0]); ks1 = *(const bf16x8*)(Kh + (size_t)(k0) * DQK + kro[1]); ks2 = *(const bf16x8*)(Kh + (size_t)(k0) * DQK + kro[2]); } while (0)
#define SWRITE(b) do { *(LAS bf16x8*)(V_lds + (b) * SHM_V + vst0) = vs0; *(LAS bf16x8*)(V_lds + (b) * SHM_V + vst1) = vs1; \
    *(LAS bf16x8*)(K_lds + (b) * SHM_K + kst[0]) = ks0; *(LAS bf16x8*)(K_lds + (b) * SHM_K + kst[1]) = ks1; *(LAS bf16x8*)(K_lds + (b) * SHM_K + kst[2]) = ks2; } while (0)
    const int NT = 4 * qb + 4, jmax = 4 * qb + (wid >> 1);
    f32x16 pA0, pA1, pB0, pB1; bf16x8 pa0, pa1, pa2, pa3;
    SLOAD(0); asm volatile("s_waitcnt vmcnt(0)" ::: "memory"); SWRITE(0); __syncthreads();
    qkt<0, NQR>(pA0, pA1, kb, qr, qlb, -Mb); partialSM(pA0, pA1);
    SLOAD(KVB); asm volatile("s_waitcnt vmcnt(0)" ::: "memory"); SWRITE(1); __syncthreads();
    for (int j = 1; j + 1 < NT; j += 2) {
        SBAR(); if (j <= jmax) qkt<1, NQR>(pB0, pB1, kb, qr, qlb, -Mb);
        if (j - 1 <= jmax) finishSM(pA0, pA1, l_reg, pa0, pa1, pa2, pa3); SBAR();
        SLOAD((j + 1) * KVB); SBAR();
        if (j - 1 <= jmax) pv_d0(o, vb0, pa0, pa1, pa2, pa3); if (j <= jmax) partialSM(pB0, pB1);
        __syncthreads(); asm volatile("s_waitcnt vmcnt(0)" ::: "memory"); SWRITE(0);
        __syncthreads();
        SBAR(); if (j + 1 <= jmax) qkt<0, NQR>(pA0, pA1, kb, qr, qlb, -Mb);
        if (j <= jmax) finishSM(pB0, pB1, l_reg, pa0, pa1, pa2, pa3); SBAR();
        SLOAD((j + 2) * KVB); SBAR();
        if (j <= jmax) pv_d0(o, vb0 + SHM_V, pa0, pa1, pa2, pa3); if (j + 1 <= jmax) partialSM(pA0, pA1);
        __syncthreads(); asm volatile("s_waitcnt vmcnt(0)" ::: "memory"); SWRITE(1);
        __syncthreads();
    }
    SBAR(); if (NT - 1 <= jmax) qkt<1, NQR>(pB0, pB1, kb, qr, qlb, -Mb);
    if (NT - 2 <= jmax) { finishSM(pA0, pA1, l_reg, pa0, pa1, pa2, pa3); SBAR(); pv_d0(o, vb0, pa0, pa1, pa2, pa3); }
    if (NT - 1 <= jmax) { partialSM(pB0, pB1); finishSM(pB0, pB1, l_reg, pa0, pa1, pa2, pa3); SBAR(); pv_d0(o, vb0 + SHM_V, pa0, pa1, pa2, pa3); }
    __syncthreads();
    const int lane2 = fresh_lane(), r32b = lane2 & 31, hib = lane2 >> 5, wid2 = wid;
    LAS float* li2 = (LAS float*)(lds + OFF_WS) + wid2 * 64;
    if (hib == 0) li2[r32b] = l_reg; LDS_WAIT();
    LAS char* ost = lds + OFF_OST + wid2 * (32 * OPITCH) + hib * (4 * OPITCH) + r32b * 2;
#pragma unroll
    for (int r = 0; r < 16; ++r) { const int orc = (r & 3) + 8 * (r >> 2); const float rl = __builtin_amdgcn_rcpf(li2[orc + 4 * hib]);
#pragma unroll
        for (int d0 = 0; d0 < 4; ++d0) *(LAS bf16_t*)(ost + orc * OPITCH + d0 * 64) = (bf16_t)f2bf(o[d0][r] * rl); }
    LDS_WAIT();
    const LAS char* ord = lds + OFF_OST + wid2 * (32 * OPITCH) + (lane2 >> 4) * OPITCH + (lane2 & 15) * 16;
#if MK_FP8_YA
    uchar* Ow = (uchar*)Ob + (size_t)(wid2 * 32 + (lane2 >> 4)) * DM + (lane2 & 15) * 8;
#pragma unroll
    for (int i = 0; i < 8; ++i) { const u32x4 w = *(const LAS u32x4*)(ord + i * 4 * OPITCH); u32x2 o8;
        o8.x = pk4_fp8c(bflo(w.x) * FP8_XSCALE, bfhi(w.x) * FP8_XSCALE, bflo(w.y) * FP8_XSCALE, bfhi(w.y) * FP8_XSCALE); o8.y = pk4_fp8c(bflo(w.z) * FP8_XSCALE, bfhi(w.z) * FP8_XSCALE, bflo(w.w) * FP8_XSCALE, bfhi(w.w) * FP8_XSCALE);
        *(u32x2*)(Ow + (size_t)(i * 4) * DM) = o8; }
#else
    bf16_t* Ow = Ob + (size_t)(wid2 * 32 + (lane2 >> 4)) * DM + (lane2 & 15) * 8;
#pragma unroll
    for (int i = 0; i < 8; ++i) { const u32x4 w = *(const LAS u32x4*)(ord + i * 4 * OPITCH); *(u32x4*)(Ow + (size_t)(i * 4) * DM) = w; }
#endif
    __syncthreads();
#undef SLOAD
#undef SWRITE
}
#undef KSWZ
}
__device__ __forceinline__ void p4_attention(const Args& a, const Frame& F) {
    FRAME_IDS(F);
    const bf16_t* qraw = (const bf16_t*)(F.ws + WS_QRAW); const bf16_t* Kn = (const bf16_t*)(F.ws + WS_KN); const bf16_t* Vn = (const bf16_t*)(F.ws + WS_VN);
    bf16_t* O = (bf16_t*)(F.ws + WS_O); const float2* rope = (const float2*)(F.ws + WS_ROPE);
    const float Mb = attn_bound(a, F_lane);
    for (int id = F.bx; id < NB * NH * 4; id += F.G) { const int x = id & 7, idx = id >> 3, bh = x + 8 * (idx >> 2), pr = idx & 3, b = bh >> 4, h = bh & 15;
        const bf16_t* Kh = Kn + (size_t)bh * SEQ * DQK; const bf16_t* Vh = Vn + (size_t)bh * SEQ * DV;
#pragma unroll 1
        for (int w = 0; w < 2; ++w) { const int qb = w ? pr : 7 - pr; const size_t tok0 = (size_t)b * SEQ + qb * 256;
            at::attn_qblock(qraw + tok0 * (NH * DQK) + h * DQK, Kh, Vh, (bf16_t*)((uchar*)O + (tok0 * DM + h * DV) * (MK_FP8_YA ? 1 : 2)), qb, Mb, (LAS char*)F.lds, F.wave, rope + tok0 * 32, a.in[I_QKQG]); }
    }
}

__device__ __forceinline__ void p8_norm2_router(const Args& a, const Frame& F, const float* x1) {
    FRAME_IDS(F);
    bf16_t* H2 = (bf16_t*)(F.ws + WS_H2); int* topi = (int*)(F.ws + WS_TOPI); float* topw = (float*)(F.ws + WS_TOPW);
    const float* wrp = (const float*)(F.ws + WS_SMALL + SM_WRP); const float* g2 = a.in[I_N2G];
    const int lane = F_lane, wave = F.wave, tid = F_tid, i = lane & 31, kk = lane >> 5;
    LAS uchar* xs = F.lds + wave * 8704;
    LAS float* part = (LAS float*)(F.lds + 69632);
    LAS float* ssqp = (LAS float*)(F.lds + 69632 + 33792);
    LAS float* logit = ssqp + 256;
    LAS float* rstdl = logit + 32 * 33;
    for (int tile = F.bx; tile < TT / 32; tile += F.G) {
        const int t0 = tile * 32;
        f32x16 acc = {}; float ssq = 0.f;
        for (int ch = 0; ch < 4; ++ch) { const int k0 = wave * 256 + ch * 64;
            f32x4 v[8];
#pragma unroll
            for (int j = 0; j < 8; ++j) v[j] = *(const f32x4*)(x1 + (size_t)(t0 + 4 * j + (lane >> 4)) * DM + k0 + (lane & 15) * 4);
#pragma unroll
            for (int j = 0; j < 8; ++j) *(LAS f32x4*)(xs + (4 * j + (lane >> 4)) * 272 + (lane & 15) * 16) = v[j];
            LDS_WAIT(); asm volatile("" ::: "memory");
            const float* wp = wrp + (size_t)(k0 + kk * 32) * NE + i;
#pragma unroll
            for (int s4 = 0; s4 < 8; ++s4) { const f32x4 xv = *(const LAS f32x4*)(xs + i * 272 + kk * 128 + s4 * 16);
#pragma unroll
                for (int q = 0; q < 4; ++q) { const float b = wp[(s4 * 4 + q) * NE]; acc = __builtin_amdgcn_mfma_f32_32x32x2f32(xv[q], b, acc, 0, 0, 0); ssq += xv[q] * xv[q]; } }
            LDS_WAIT(); asm volatile("" ::: "memory");
        }
#pragma unroll
        for (int r = 0; r < 16; ++r) part[(wave * 32 + (r & 3) + 8 * (r >> 2) + 4 * kk) * 33 + i] = acc[r];
        ssq += __shfl_xor(ssq, 32);
        if (kk == 0) ssqp[wave * 32 + i] = ssq;
        __syncthreads();
        { const int row = tid >> 4, e0 = (tid & 15) * 2; float s0 = 0.f, s1 = 0.f;
#pragma unroll
          for (int w = 0; w < 8; ++w) { s0 += part[(w * 32 + row) * 33 + e0]; s1 += part[(w * 32 + row) * 33 + e0 + 1]; }
          logit[row * 33 + e0] = s0; logit[row * 33 + e0 + 1] = s1;
          if (tid < 32) { float q = 0.f;
#pragma unroll
              for (int w = 0; w < 8; ++w) q += ssqp[w * 32 + tid];
              rstdl[tid] = 1.0f / sqrtf(q * (1.0f / DM) + EPS); } }
        __syncthreads();
        if (tid < 32) { const float rs = rstdl[tid]; float lg[32];
#pragma unroll
            for (int e = 0; e < 32; ++e) lg[e] = logit[tid * 33 + e] * rs + a.in[I_BR][e];
            int bi[4]; float bv[4];
#pragma unroll
            for (int k = 0; k < 4; ++k) { float m = -3.0e38f; int mi = 0;
#pragma unroll
                for (int e = 0; e < 32; ++e) { const bool used = (k > 0 && bi[0] == e) || (k > 1 && bi[1] == e) || (k > 2 && bi[2] == e); if (!used && lg[e] > m) { m = lg[e]; mi = e; } }
                bi[k] = mi; bv[k] = m; }
            const float e1 = __expf(bv[1] - bv[0]), e2 = __expf(bv[2] - bv[0]), e3 = __expf(bv[3] - bv[0]); const float rsum = 1.0f / (1.0f + e1 + e2 + e3);
            const int t = t0 + tid;
            *(int4*)(topi + 4 * t) = make_int4(bi[0], bi[1], bi[2], bi[3]); *(float4*)(topw + 4 * t) = make_float4(rsum, e1 * rsum, e2 * rsum, e3 * rsum); }
#pragma unroll 4
        for (int it = 0; it < 16; ++it) { const int idx = it * NTHREADS + tid, row = idx >> 8, c8 = (idx & 255) * 8; const float rs = rstdl[row];
            const f32x4 x0 = *(const f32x4*)(x1 + (size_t)(t0 + row) * DM + c8), x1v = *(const f32x4*)(x1 + (size_t)(t0 + row) * DM + c8 + 4);
            const f32x4 g0 = *(const f32x4*)(g2 + c8), g1 = *(const f32x4*)(g2 + c8 + 4);
#if MK_FP8_MOE
            const float rs4 = rs * FP8_ASCALE; u32x2 o; o.x = pk4_fp8(x0.x * rs4 * g0.x, x0.y * rs4 * g0.y, x0.z * rs4 * g0.z, x0.w * rs4 * g0.w); o.y = pk4_fp8(x1v.x * rs4 * g1.x, x1v.y * rs4 * g1.y, x1v.z * rs4 * g1.z, x1v.w * rs4 * g1.w);
            *(u32x2*)((uchar*)H2 + (size_t)(t0 + row) * DM + c8) = o; }
#else
            u32x4 o; o.x = pk2(x0.x * rs * g0.x, x0.y * rs * g0.y); o.y = pk2(x0.z * rs * g0.z, x0.w * rs * g0.w); o.z = pk2(x1v.x * rs * g1.x, x1v.y * rs * g1.y); o.w = pk2(x1v.z * rs * g1.z, x1v.w * rs * g1.w);
            *(u32x4*)(H2 + (size_t)(t0 + row) * DM + c8) = o; }
#endif
        __syncthreads();
    }
}

__device__ __forceinline__ void p9_routing(const Args& a, const Frame& F) {
    FRAME_IDS(F);
    const int* topi = (const int*)(F.ws + WS_TOPI); int* tpos = (int*)(F.ws + WS_TPOS); int* list = (int*)(F.ws + WS_LIST); int* counts = (int*)(F.ws + WS_SMALL + SM_COUNTS);
    LAS int* wtot = (LAS int*)F.lds;
    constexpr int NIT = TT / NWAVES / 64;
    for (int e = F.bx; e < NE; e += F.G) {
        __syncthreads();
        const int t0 = F.wave * (TT / NWAVES);
        int kk[NIT];
#pragma unroll
        for (int i = 0; i < NIT; ++i) { const int4 ti = *(const int4*)(topi + 4 * (t0 + i * 64 + F_lane)); kk[i] = (ti.x == e) ? 0 : (ti.y == e) ? 1 : (ti.z == e) ? 2 : (ti.w == e) ? 3 : -1; }
        int cnt = 0;
#pragma unroll
        for (int i = 0; i < NIT; ++i) cnt += __popcll(__ballot(kk[i] >= 0));
        if (F_lane == 0) wtot[F.wave] = cnt;
        __syncthreads();
        int base = 0, total = 0;
        for (int w = 0; w < NWAVES; ++w) { const int c = wtot[w]; if (w < F.wave) base += c; total += c; }
#pragma unroll
        for (int i = 0; i < NIT; ++i) { const int t = t0 + i * 64 + F_lane; const int k = kk[i];
            const unsigned long long bal = __ballot(k >= 0); const int pos = base + __popcll(bal & ((1ull << F_lane) - 1ull));
            if (k >= 0) { list[(size_t)e * TT + pos] = t; tpos[4 * t + k] = pos; }
            base += __popcll(bal); }
        for (int q = total + F_tid; q < ((total + 255) & ~255); q += NTHREADS) list[(size_t)e * TT + q] = 0;
        if (F_tid == 0) counts[e] = total;
    }
}
__device__ __forceinline__ void moe_tables(const Frame& F, LAS int* tab) {
    FRAME_IDS(F);
    const int* counts = (const int*)(F.ws + WS_SMALL + SM_COUNTS);
    __syncthreads();
    if (F_tid < NE) { const int c = counts[F_tid]; tab[F_tid] = c; const int nt = (c + 255) >> 8; tab[32 + F_tid] = nt; tab[128 + F_tid] = nt > 0 ? ((1 << 20) + nt - 1) / nt : 0; }
    __syncthreads();
    if (F_tid < NE) { const int e = F_tid, me = tab[32 + e]; int pre = 0, rank = 0;
        for (int q = 0; q < NE; ++q) { const int v = tab[32 + q]; pre += (q < e) ? v : 0; rank += (v > me || (v == me && q < e)) ? 1 : 0; }
        tab[64 + e] = pre; if (e == NE - 1) tab[96] = pre + me;
        const int q4 = rank >> 3, pos = rank & 7, xx = (q4 & 1) ? 7 - pos : pos; tab[160 + xx * 4 + q4] = e; }
    __syncthreads();
}

__device__ __forceinline__ void p10_permute(const Args& a, const Frame& F, const LAS int* tab) {
    FRAME_IDS(F);
    constexpr size_t ROWB = MK_FP8_MOE ? DM : 2 * DM;
    const uchar* H2 = F.ws + WS_H2; uchar* XP = F.ws + WS_XPERM; const int* list = (const int*)(F.ws + WS_LIST);
    const int ntiles = tab[96];
    for (int tile = F.bx; tile < ntiles; tile += F.G) {
        int e = 0;
#pragma unroll 1
        for (int q = 1; q < NE; ++q) if (tab[64 + q] <= tile) e = q;
        const int p0 = (tile - tab[64 + e]) * 256;
        for (int r0 = F.wave * 32; r0 < F.wave * 32 + 32; r0 += 8) { int tok[8]; u32x4 v[8][ROWB / 1024];
#pragma unroll
            for (int q = 0; q < 8; ++q) tok[q] = list[(size_t)e * TT + p0 + r0 + q];
#pragma unroll
            for (int q = 0; q < 8; ++q)
#pragma unroll
                for (int c = 0; c < (int)(ROWB / 1024); ++c) v[q][c] = *(const u32x4*)(H2 + (size_t)tok[q] * ROWB + c * 1024 + F_lane * 16);
#pragma unroll
            for (int q = 0; q < 8; ++q)
#pragma unroll
                for (int c = 0; c < (int)(ROWB / 1024); ++c) *(u32x4*)(XP + ((size_t)tile * 256 + r0 + q) * ROWB + c * 1024 + F_lane * 16) = v[q][c]; }
    }
}

__device__ __forceinline__ void p12_combine(const Args& a, const Frame& F, float* out, const LAS int* tab) {
    FRAME_IDS(F);
    const int* topi = (const int*)(F.ws + WS_TOPI); const float* topw = (const float*)(F.ws + WS_TOPW); const int* tpos = (const int*)(F.ws + WS_TPOS);
    const int lane = F_lane, gw = F.bx * NWAVES + F.wave, NGW = F.G * NWAVES;
#if MK_FP8_MOE
    const uchar* ys = F.ws + WS_YSLOT;
    for (int t = gw; t < TT; t += NGW) {
        const int4 ti = *(const int4*)(topi + 4 * t), tp = *(const int4*)(tpos + 4 * t); float4 tw = *(const float4*)(topw + 4 * t);
        tw.x *= 1.0f / FP8_YSCALE; tw.y *= 1.0f / FP8_YSCALE; tw.z *= 1.0f / FP8_YSCALE; tw.w *= 1.0f / FP8_YSCALE;
        const uchar* r0 = ys + ((size_t)tab[64 + ti.x] * 256 + tp.x) * DM; const uchar* r1 = ys + ((size_t)tab[64 + ti.y] * 256 + tp.y) * DM;
        const uchar* r2 = ys + ((size_t)tab[64 + ti.z] * 256 + tp.z) * DM; const uchar* r3 = ys + ((size_t)tab[64 + ti.w] * 256 + tp.w) * DM;
        float* orow = out + (size_t)t * DM;
        u32x2 y0[4], y1[4], y2[4], y3[4]; f32x4 xa[4], xb[4];
#pragma unroll
        for (int j = 0; j < 4; ++j) { const int c = j * 512 + lane * 8; y0[j] = *(const u32x2*)(r0 + c); y1[j] = *(const u32x2*)(r1 + c); y2[j] = *(const u32x2*)(r2 + c); y3[j] = *(const u32x2*)(r3 + c);
            xa[j] = *(const f32x4*)(orow + c); xb[j] = *(const f32x4*)(orow + c + 4); }
#pragma unroll
        for (int j = 0; j < 4; ++j) { const int c = j * 512 + lane * 8; f32x4 x0 = xa[j], x1 = xb[j];
#define ACC4(X, Y, W) do { const f32x2 lo = __builtin_amdgcn_cvt_pk_f32_fp8((int)(Y), false), hi2 = __builtin_amdgcn_cvt_pk_f32_fp8((int)(Y), true); X[0] += (W) * lo.x; X[1] += (W) * lo.y; X[2] += (W) * hi2.x; X[3] += (W) * hi2.y; } while (0)
            ACC4(x0, y0[j].x, tw.x); ACC4(x1, y0[j].y, tw.x); ACC4(x0, y1[j].x, tw.y); ACC4(x1, y1[j].y, tw.y);
            ACC4(x0, y2[j].x, tw.z); ACC4(x1, y2[j].y, tw.z); ACC4(x0, y3[j].x, tw.w); ACC4(x1, y3[j].y, tw.w);
#undef ACC4
            *(f32x4*)(orow + c) = x0; *(f32x4*)(orow + c + 4) = x1; }
    }
#else
    const bf16_t* ys = (const bf16_t*)(F.ws + WS_YSLOT);
    for (int t = gw; t < TT; t += NGW) {
        const int4 ti = *(const int4*)(topi + 4 * t), tp = *(const int4*)(tpos + 4 * t); const float4 tw = *(const float4*)(topw + 4 * t);
        const bf16_t* r0 = ys + ((size_t)tab[64 + ti.x] * 256 + tp.x) * DM; const bf16_t* r1 = ys + ((size_t)tab[64 + ti.y] * 256 + tp.y) * DM;
        const bf16_t* r2 = ys + ((size_t)tab[64 + ti.z] * 256 + tp.z) * DM; const bf16_t* r3 = ys + ((size_t)tab[64 + ti.w] * 256 + tp.w) * DM;
        float* orow = out + (size_t)t * DM;
#pragma unroll
        for (int j = 0; j < 4; ++j) { const int c = j * 512 + lane * 8;
            const u32x4 a0 = *(const u32x4*)(r0 + c), a1 = *(const u32x4*)(r1 + c), a2 = *(const u32x4*)(r2 + c), a3 = *(const u32x4*)(r3 + c);
            f32x4 x0 = *(const f32x4*)(orow + c), x1 = *(const f32x4*)(orow + c + 4);
#pragma unroll
            for (int q = 0; q < 2; ++q) {
                x0[2 * q] += tw.x * bflo(a0[q]) + tw.y * bflo(a1[q]) + tw.z * bflo(a2[q]) + tw.w * bflo(a3[q]);
                x0[2 * q + 1] += tw.x * bfhi(a0[q]) + tw.y * bfhi(a1[q]) + tw.z * bfhi(a2[q]) + tw.w * bfhi(a3[q]);
                x1[2 * q] += tw.x * bflo(a0[2 + q]) + tw.y * bflo(a1[2 + q]) + tw.z * bflo(a2[2 + q]) + tw.w * bflo(a3[2 + q]);
                x1[2 * q + 1] += tw.x * bfhi(a0[2 + q]) + tw.y * bfhi(a1[2 + q]) + tw.z * bfhi(a2[2 + q]) + tw.w * bfhi(a3[2 + q]); }
            *(f32x4*)(orow + c) = x0; *(f32x4*)(orow + c + 4) = x1; }
    }
#endif
}

constexpr int NPHASE = 14;
__global__ void __launch_bounds__(NTHREADS, 2) mk_fwd(Args a) {
    extern __shared__ __attribute__((aligned(16))) uchar lds_raw[];
    Frame F; F.lds = (LAS uchar*)lds_raw; F.ws = a.ws; F.wave = __builtin_amdgcn_readfirstlane(threadIdx.x >> 6); F.G = gridDim.x; F.bx = blockIdx.x;
    FRAME_IDS(F);
    volatile LAS unsigned* MISC = (volatile LAS unsigned*)(F.lds + MISC_OFF);
    LAS int* tab = (LAS int*)(F.lds + LDSCTL_OFF + 512);
    for (int u = F_tid; u < (LDS_BYTES - LDSCTL_OFF) / 4; u += NTHREADS) ((LAS unsigned*)(F.lds + LDSCTL_OFF))[u] = 0u;
    __syncthreads();
    XcdBarrier bar; bar.bar = (unsigned*)(a.ws + WS_CTL) + CW_BAR; bar.x = 0; bar.st = nullptr; bar.wave = F.wave;
    const int lo = a.ph_lo, hi = a.ph_hi;
    if (hi - lo > 1) bar = xcd_barrier_post((unsigned*)(a.ws + WS_CTL) + CW_BAR, MISC + 8, F.wave);
#ifndef MK_PHASE_MASK
#define MK_PHASE_MASK 0xffff
#endif
#define IN(k) (((MK_PHASE_MASK >> (k)) & 1) && lo <= (k) && (k) < hi)
#ifdef MK_PROBE_LO
    volatile LAS unsigned long long* pr_t = (volatile LAS unsigned long long*)(F.lds + LDSCTL_OFF + 64);
#ifdef MK_PROBE_CLK
#define PROBE_NOW() __builtin_amdgcn_s_memtime()
#else
#define PROBE_NOW() __builtin_amdgcn_s_memrealtime()
#endif
#define PROBE_AT(k) do { if ((k) == MK_PROBE_LO && F.wave == 0 && fresh_lane() == 0) pr_t[0] = PROBE_NOW(); if ((k) == MK_PROBE_HI + 1 && F.wave == 0 && fresh_lane() == 0) pr_t[1] = PROBE_NOW(); } while (0)
#else
#define PROBE_AT(k) do { } while (0)
#endif
#define SEAM(k) do { if (IN(k) && IN((k) + 1)) xcd_barrier(bar); } while (0)
    LAS uchar* ring = F.lds;
    uchar* ws = a.ws;
    const int G = F.G, bx = F.bx;

    PROBE_AT(0);
    if (IN(0)) { p0_prologue(a, F); } SEAM(0); PROBE_AT(1);

    if (IN(1)) {
        gm::ProbDense P; P.init((const bf16_t*)(ws + WS_H), DM, (const bf16_t*)(ws + WS_WIN), DM, MK_FP8_INPROJ ? DM / 2 : DM, TT, NPROJ, G, bx);
        EpiInProj E{(bf16_t*)(ws + WS_PROJ), (bf16_t*)(ws + WS_APACK), a.in[I_BG], (float*)(ws + WS_SSQP)};
        gm::gemm_phase<gm::ProbDense, EpiInProj, false, MK_FP8_INPROJ != 0>(ring, P, E, F.wave);
    } SEAM(1); PROBE_AT(2);

    if (IN(2)) {
        { gm::ProbDense P; P.init((const bf16_t*)(ws + WS_PROJ) + C_QLAT, NPROJ, (const bf16_t*)(ws + WS_WUQ), QLORA, QLORA, TT, NH * DQK, G, bx);
          EpiStoreScaled<0, 8, QLORA> E{(bf16_t*)(ws + WS_QRAW), NH * DQK, (const float*)(ws + WS_SSQP)}; gm::gemm_phase<gm::ProbDense, EpiStoreScaled<0, 8, QLORA>, false>(ring, P, E, F.wave); }
        { gm::ProbDense P; P.init((const bf16_t*)(ws + WS_PROJ) + C_KVLAT, NPROJ, (const bf16_t*)(ws + WS_WUKV), KVLORA, KVLORA, TT, NH * 256, G, bx);
          EpiKV E{(bf16_t*)(ws + WS_KVRAW), (bf16_t*)(ws + WS_VN), (const float*)(ws + WS_SSQP)}; gm::gemm_phase<gm::ProbDense, EpiKV, false>(ring, P, E, F.wave); }
#if MK_FAST_S5
        { ProbS5 P{(const bf16_t*)(ws + WS_APACK), (const bf16_t*)(ws + WS_WS5), APK, 256, 4, G, bx};
          EpiS5State E{(float*)(ws + WS_SCH)}; gm::gemm_phase<ProbS5, EpiS5State, false>(ring, P, E, F.wave); }
#endif
    } SEAM(2); PROBE_AT(3);

    if (IN(3)) {
#if MK_FAST_S5
        p3_scan(a, F);
#endif
        p3_prep(a, F);
    } SEAM(3); PROBE_AT(4);

    if (IN(4)) {
#if MK_FAST_S5
        { ProbS5 P{(const bf16_t*)(ws + WS_APACK), (const bf16_t*)(ws + WS_TWC), APK, APK, 6, G, bx};
          EpiS5Out E{(bf16_t*)(ws + WS_GACT)}; gm::gemm_phase<ProbS5, EpiS5Out, false>(ring, P, E, F.wave); }
#else
        s5_reference(a, F);
#endif
#if MK_FAST_ATTN
        p4_attention(a, F);
#else
        attn_reference(a, F);
#endif
    } SEAM(4); PROBE_AT(5);

    if (IN(5)) {
        { gm::ProbDense P; P.init((const bf16_t*)(ws + WS_GACT), S5W, (const bf16_t*)(ws + WS_WGLU), S5W, S5W, TT, S5W, G, bx);
          using E5 = EpiSide<0, MK_FP8_YB != 0, false>; E5 E{(bf16_t*)(ws + WS_Y2), S5W, (const bf16_t*)(ws + WS_GACT), S5W, nullptr, 0}; gm::gemm_phase<gm::ProbDense, E5, false>(ring, P, E, F.wave); }
        { gm::ProbDense P; P.init((const bf16_t*)(ws + WS_O), DM, (const bf16_t*)(ws + WS_WOMLA), DM, MK_FP8_YA ? DM / 2 : DM, TT, DM, G, bx);
          using E5a = EpiSide<1, false, MK_FP8_YA != 0>; E5a E{(bf16_t*)(ws + WS_MA), DM, (const bf16_t*)(ws + WS_PROJ) + C_GA, NPROJ, nullptr, 0}; gm::gemm_phase<gm::ProbDense, E5a, false, MK_FP8_YA != 0>(ring, P, E, F.wave); }
    } SEAM(5); PROBE_AT(6);

    if (IN(6)) {
        gm::ProbDense P; P.init((const bf16_t*)(ws + WS_Y2), S5W, (const bf16_t*)(ws + WS_WOS5), S5W, MK_FP8_YB ? S5W / 2 : S5W, TT, DM, G, bx);
        using E6 = EpiSide<2, MK_FP8_OUT != 0, MK_FP8_YB != 0>;
        E6 E{(bf16_t*)(ws + WS_M), DM, (const bf16_t*)(ws + WS_PROJ) + C_GB, NPROJ, (const bf16_t*)(ws + WS_MA), DM}; gm::gemm_phase<gm::ProbDense, E6, false, MK_FP8_YB != 0>(ring, P, E, F.wave);
    } SEAM(6); PROBE_AT(7);

    if (IN(7)) {
        gm::ProbDense P; P.init((const bf16_t*)(ws + WS_M), DM, (const bf16_t*)(ws + WS_WOUT), DM, MK_FP8_OUT ? DM / 2 : DM, TT, DM, G, bx);
        EpiResidF32 E{a.in[I_X], a.out}; gm::gemm_phase<gm::ProbDense, EpiResidF32, false, MK_FP8_OUT != 0>(ring, P, E, F.wave);
    } SEAM(7); PROBE_AT(8);

    if (IN(8)) { p8_norm2_router(a, F, a.out); } SEAM(8); PROBE_AT(9);
    if (IN(9)) { p9_routing(a, F); } SEAM(9); PROBE_AT(10);

    if (IN(10) || IN(11) || IN(12) || IN(13)) moe_tables(F, tab);
    const int xl = bx & 7, rk = bx >> 3, nrk = (G - xl + 7) >> 3;
    if (IN(10)) { p10_permute(a, F, tab); } SEAM(10); PROBE_AT(11);
    if (IN(11)) {
        ProbMoE P{(const bf16_t*)(ws + WS_XPERM), (const bf16_t*)(ws + WS_W1), DM, DM, MK_FP8_MOE ? DM / 128 : DM / 64, 16, (size_t)4096 * DM, xl, rk, nrk}; P.load(tab);
        EpiSwiglu E{(bf16_t*)(ws + WS_HACT), a.in[I_BGATE], a.in[I_BUP], tab}; gm::gemm_phase<ProbMoE, EpiSwiglu, false, MK_FP8_MOE != 0>(ring, P, E, F.wave);
    } SEAM(11); PROBE_AT(12);
    if (IN(12)) {
        ProbMoE P{(const bf16_t*)(ws + WS_HACT), (const bf16_t*)(ws + WS_W2), DFF, DFF, MK_FP8_MOE ? DFF / 128 : DFF / 64, 8, (size_t)DM * DFF, xl, rk, nrk}; P.load(tab);
        EpiDown E{(bf16_t*)(ws + WS_YSLOT), a.in[I_BDOWN], tab}; gm::gemm_phase<ProbMoE, EpiDown, false, MK_FP8_MOE != 0>(ring, P, E, F.wave);
    } SEAM(12); PROBE_AT(13);
    if (IN(13)) { p12_combine(a, F, a.out, tab); }
    PROBE_AT(14);
#ifdef MK_PROBE_LO
#ifdef MK_PROBE_CLK
#define PROBE_DIV 24ull
#else
#define PROBE_DIV 1ull
#endif
    if (blockIdx.x == 0 && F.wave == 0 && fresh_lane() == 0) { const unsigned long long dt = (pr_t[1] - pr_t[0]) / PROBE_DIV * MK_PROBE_X, te = __builtin_amdgcn_s_memrealtime();
        while (__builtin_amdgcn_s_memrealtime() - te < dt) __builtin_amdgcn_s_sleep(32); }
#endif
#undef IN
#undef SEAM
}

extern "C" void kernel_launch(void* const* d_in, const int* in_sizes, int n_in, void* d_out, int out_size, void* d_ws, size_t ws_size, hipStream_t stream) {
    static int grid = 0;
    if (grid == 0) {
        if (n_in != 32 || in_sizes[0] != TT * DM || out_size != TT * DM || ws_size < WS_END) {
            fprintf(stderr, "kernel_launch: shape mismatch: n_in %d in0 %d out %d ws %zu (need %zu); nothing launched\n", n_in, n_in > 0 ? in_sizes[0] : -1, out_size, ws_size, (size_t)WS_END); grid = -1; return; }
        int dev = 0, cus = 0, per_cu = 0;
        if (hipGetDevice(&dev) != hipSuccess || hipDeviceGetAttribute(&cus, hipDeviceAttributeMultiprocessorCount, dev) != hipSuccess) { fprintf(stderr, "kernel_launch: device query failed\n"); grid = -1; return; }
        if (hipFuncSetAttribute((const void*)mk_fwd, hipFuncAttributeMaxDynamicSharedMemorySize, LDS_BYTES) != hipSuccess) { fprintf(stderr, "kernel_launch: hipFuncSetAttribute failed\n"); grid = -1; return; }
        if (hipOccupancyMaxActiveBlocksPerMultiprocessor(&per_cu, (const void*)mk_fwd, NTHREADS, LDS_BYTES) != hipSuccess || per_cu < 1)
            fprintf(stderr, "kernel_launch: note: occupancy query reports %d workgroups per CU\n", per_cu);
        (void)hipGetLastError();
        grid = cus - (cus % 8);
        if (grid < 8) grid = 8;
    }
    if (grid < 0) return;
    if (hipMemsetAsync((char*)d_ws + WS_CTL, 0, CTL_ZERO_BYTES, stream) != hipSuccess) { fprintf(stderr, "kernel_launch: memset failed\n"); return; }
    Args a{};
    for (int i = 0; i < 32; ++i) a.in[i] = (const float*)d_in[i];
    a.out = (float*)d_out; a.ws = (uchar*)d_ws;
#if MK_ONE_LAUNCH
    a.ph_lo = 0; a.ph_hi = NPHASE;
    hipLaunchKernelGGL(mk_fwd, dim3(grid), dim3(NTHREADS), LDS_BYTES, stream, a);
#else
    for (int p = 0; p < NPHASE; ++p) { a.ph_lo = p; a.ph_hi = p + 1; hipLaunchKernelGGL(mk_fwd, dim3(grid), dim3(NTHREADS), LDS_BYTES, stream, a); }
#endif
    const hipError_t le = hipPeekAtLastError();
    if (le != hipSuccess) fprintf(stderr, "kernel_launch: launch failed: %s\n", hipGetErrorName(le));
}
```

```cpp
#include <hip/hip_runtime.h>
#include <cstdio>
#include <cstdint>

#ifndef MK_ONE_LAUNCH
#define MK_ONE_LAUNCH 1
#endif
#ifndef MK_FAST_GEMM
#define MK_FAST_GEMM 1
#endif
#ifndef MK_FAST_ATTN
#define MK_FAST_ATTN 1
#endif
#ifndef MK_FAST_S5
#define MK_FAST_S5 1
#endif

#ifndef MK_FP8_MOE
#define MK_FP8_MOE 1
#endif
#define LAS __attribute__((address_space(3)))
#define GAS __attribute__((address_space(1)))
typedef unsigned short bf16_t;
typedef short bf16x8 __attribute__((ext_vector_type(8)));
typedef short s16x4 __attribute__((ext_vector_type(4)));
typedef float f32x2 __attribute__((ext_vector_type(2)));
typedef float f32x4 __attribute__((ext_vector_type(4)));
typedef float f32x16 __attribute__((ext_vector_type(16)));
typedef unsigned u32x2 __attribute__((ext_vector_type(2)));
typedef unsigned u32x4 __attribute__((ext_vector_type(4)));
typedef unsigned char uchar;
typedef int v4i __attribute__((ext_vector_type(4)));
typedef int v8i __attribute__((ext_vector_type(8)));
constexpr float FP8_YSCALE = 16.0f;
#ifndef MK_FP8_INPROJ
#define MK_FP8_INPROJ 1
#endif
constexpr float FP8_ASCALE = 4.0f, FP8_WSCALE = 64.0f;
__device__ __forceinline__ float sat8(float x) { return __builtin_amdgcn_fmed3f(x, -448.0f, 448.0f); }
__device__ __forceinline__ unsigned pk4_fp8(float a, float b, float c, float d) { int w = __builtin_amdgcn_cvt_pk_fp8_f32(a, b, 0, false); w = __builtin_amdgcn_cvt_pk_fp8_f32(c, d, w, true); return (unsigned)w; }
__device__ __forceinline__ unsigned pk4_fp8c(float a, float b, float c, float d) { return pk4_fp8(sat8(a), sat8(b), sat8(c), sat8(d)); }

constexpr int NB = 8, SEQ = 2048, TT = NB * SEQ, DM = 2048;
constexpr int NH = 16, DNOPE = 128, DROPE = 64, DQK = 192, DV = 128, QLORA = 512, KVLORA = 256;
constexpr int S5W = 1024, S5G = 64, S5C = 16, S5P = 64, S5L = 16;
constexpr int NE = 32, TOPK = 4, DFF = 2048;
constexpr int IN_PROJ = QLORA + KVLORA + DROPE + S5W + 2 * DM;
constexpr int NPROJ = 6144;
constexpr int C_QLAT = 0, C_KVLAT = 512, C_U = 768, C_GA = 1792, C_GB = 3840, C_KR = 5888;
constexpr float EPS = 1e-6f;
constexpr int MAXSLOT_TILES = (TT * TOPK) / 256 + NE;
constexpr int MAXSLOTS = MAXSLOT_TILES * 256;
constexpr int NCHUNK = TT / S5L;
constexpr int APK = 384;

constexpr size_t MiB = 1u << 20;
constexpr size_t WS_CTL = 0, CTL_ZERO_BYTES = 1 * MiB;
constexpr size_t WS_WIN = 1 * MiB;
constexpr size_t WS_WUQ = WS_WIN + 24 * MiB;
constexpr size_t WS_WUKV = WS_WUQ + 3 * MiB;
constexpr size_t WS_WOMLA = WS_WUKV + 2 * MiB;
constexpr size_t WS_WGLU = WS_WOMLA + 8 * MiB;
constexpr size_t WS_WOS5 = WS_WGLU + 2 * MiB;
constexpr size_t WS_WOUT = WS_WOS5 + 4 * MiB;
constexpr size_t WS_TWC = WS_WOUT + 8 * MiB;
constexpr size_t WS_WS5 = WS_TWC + 12 * MiB;
constexpr size_t WS_ROPE = WS_WS5 + 8 * MiB;
constexpr size_t WS_SMALL = WS_ROPE + 4 * MiB;
constexpr size_t WS_W1 = WS_SMALL + 1 * MiB;
constexpr size_t WS_W2 = WS_W1 + 512 * MiB;
constexpr size_t WS_ACT = WS_W2 + 256 * MiB;
constexpr size_t WS_H = WS_ACT;
constexpr size_t WS_PROJ = WS_H + 64 * MiB;
constexpr size_t WS_APACK = WS_PROJ + 192 * MiB;
constexpr size_t WS_SCH = WS_APACK + 48 * MiB;
constexpr size_t WS_QRAW = WS_SCH + 32 * MiB;
constexpr size_t WS_KVRAW = WS_QRAW + 96 * MiB;
constexpr size_t WS_QN = WS_KVRAW + 128 * MiB;
constexpr size_t WS_GACT8 = WS_QN;
constexpr size_t WS_KN = WS_QN + 96 * MiB;
constexpr size_t WS_VN = WS_KN + 96 * MiB;
constexpr size_t WS_O = WS_VN + 64 * MiB;
constexpr size_t WS_GACT = WS_O + 64 * MiB;
constexpr size_t WS_Y2 = WS_GACT + 32 * MiB;
constexpr size_t WS_MA = WS_Y2 + 32 * MiB;
constexpr size_t WS_M = WS_MA + 64 * MiB;
constexpr size_t WS_SSQP = WS_M + 64 * MiB;
constexpr size_t WS_ENDA = WS_SSQP + 1 * MiB;
constexpr size_t WS_H2 = WS_ACT;
constexpr size_t WS_HACT = WS_H2 + 64 * MiB;
constexpr size_t WS_YSLOT = WS_HACT + 288 * MiB;
constexpr size_t WS_TOPI = WS_YSLOT + 288 * MiB;
constexpr size_t WS_TOPW = WS_TOPI + 1 * MiB;
constexpr size_t WS_TPOS = WS_TOPW + 1 * MiB;
constexpr size_t WS_LIST = WS_TPOS + 1 * MiB;
constexpr size_t WS_XPERM = WS_ACT + 704 * MiB;
constexpr size_t WS_X1 = WS_W1 + 256 * MiB;
constexpr size_t WS_ENDB = WS_XPERM + 288 * MiB;
constexpr size_t WS_END = WS_ENDA > WS_ENDB ? WS_ENDA : WS_ENDB;
constexpr size_t SM_A16 = 0;
constexpr size_t SM_COUNTS = 64 * 1024;
constexpr size_t SM_WRP = 128 * 1024;
constexpr int CW_BAR = 4096;

constexpr int RING_BYTES = 131072;
constexpr int LDS_BYTES = 163840;
constexpr int LDSCTL_OFF = LDS_BYTES - 4096;
constexpr int MISC_OFF = LDSCTL_OFF;
constexpr int GTAB_OFF = LDSCTL_OFF + 2048;
constexpr int NWAVES = 8, NTHREADS = 512;

#define LDS_WAIT() asm volatile("s_waitcnt lgkmcnt(0)" ::: "memory")
#define VM_WAIT() asm volatile("s_waitcnt vmcnt(0)" ::: "memory")
#define SBAR() __builtin_amdgcn_sched_barrier(0)

__device__ __forceinline__ unsigned f2bf(float f) { unsigned u = __builtin_bit_cast(unsigned, f); return (u + 0x7fffu + ((u >> 16) & 1u)) >> 16; }
__device__ __forceinline__ unsigned pk2(float lo, float hi) { return f2bf(lo) | (f2bf(hi) << 16); }
__device__ __forceinline__ float bf2f(unsigned b) { return __builtin_bit_cast(float, b << 16); }
__device__ __forceinline__ float bflo(unsigned w) { return __builtin_bit_cast(float, w << 16); }
__device__ __forceinline__ float bfhi(unsigned w) { return __builtin_bit_cast(float, w & 0xffff0000u); }
__device__ __forceinline__ unsigned cvt_pk_bf16(float lo, float hi) { unsigned r; asm volatile("v_cvt_pk_bf16_f32 %0, %1, %2" : "=v"(r) : "v"(lo), "v"(hi)); return r; }
__device__ __forceinline__ float sigmoidf_(float x) { return __builtin_amdgcn_rcpf(1.0f + __builtin_amdgcn_exp2f(-1.4426950408889634f * x)); }
__device__ __forceinline__ f32x2 sig2_t(f32x2 t) { f32x2 d; d.x = __builtin_amdgcn_exp2f(t.x); d.y = __builtin_amdgcn_exp2f(t.y); d = d + 1.0f; f32x2 r; r.x = __builtin_amdgcn_rcpf(d.x); r.y = __builtin_amdgcn_rcpf(d.y); return r; }
__device__ __forceinline__ f32x2 gelu_tanh2(f32x2 x) { constexpr float C = -2.0f * 0.7978845608028654f * 1.4426950408889634f; const f32x2 p = (x * x) * (C * 0.044715f) + C; return x * sig2_t(x * p); }
__device__ __forceinline__ float gelu_tanh(float x) {
    const float u = 0.7978845608028654f * (x + 0.044715f * x * x * x);
    const float e = __builtin_amdgcn_exp2f(2.8853900817779268f * u);
    const float th = 1.0f - 2.0f * __builtin_amdgcn_rcpf(e + 1.0f);
    return 0.5f * x * (1.0f + th);
}
__device__ __forceinline__ int fresh_lane() { int z = 0; asm volatile("" : "+s"(z)); return (int)__builtin_amdgcn_mbcnt_hi(~0u, __builtin_amdgcn_mbcnt_lo(~0u, (unsigned)z)); }
__device__ __forceinline__ float wave_sum(float v) {
#pragma unroll
    for (int o = 1; o < 64; o <<= 1) v += __shfl_xor(v, o);
    return v;
}

#define XB_TMO      128
#define XB_XCNT(j)  (256  + 64 * (j))
#define XB_XSUB(j)  (1280 + 64 * (j))
#define XB_XGEN(j)  (2304 + 64 * (j))
#define XB_TOP      3328
#define XB_TOPGEN   3392
#define XCD_BAR_WORDS 3456
#define XB_SPIN_CAP (1u << 18)
__device__ __forceinline__ unsigned xb_ld(unsigned* p)              { return __hip_atomic_load(p, __ATOMIC_RELAXED, __HIP_MEMORY_SCOPE_AGENT); }
__device__ __forceinline__ unsigned xb_add(unsigned* p, unsigned v) { return __hip_atomic_fetch_add(p, v, __ATOMIC_RELAXED, __HIP_MEMORY_SCOPE_AGENT); }
__device__ __forceinline__ unsigned xb_xcc_id() { return (unsigned)__builtin_amdgcn_s_getreg((3 << 11) | 20) & 0xFu; }
#define XB_SPIN(cond, bar) do { unsigned _sp = 0; while (cond) { __builtin_amdgcn_s_sleep(1); \
    if ((++_sp & 255u) == 0u) { if (xb_ld(&(bar)[XB_TMO])) break; if (_sp > XB_SPIN_CAP) { atomicAdd(&(bar)[XB_TMO], 1u); break; } } } } while (0)
struct XcdBarrier { unsigned* bar; unsigned x; volatile LAS unsigned* st; int wave; };
__device__ __forceinline__ XcdBarrier xcd_barrier_post(unsigned* bar, volatile LAS unsigned* st, int wave) {
    XcdBarrier b; b.bar = bar; b.x = xb_xcc_id(); b.st = st; b.wave = wave;
    if (wave == 0 && fresh_lane() == 0) (void)xb_add(&bar[XB_XCNT(b.x)], 1u);
    return b;
}
__device__ __forceinline__ void xcd_barrier_complete(unsigned* bar, unsigned x, unsigned& nloc, unsigned& nx) {
    const unsigned G = gridDim.x * gridDim.y * gridDim.z;
    unsigned sum, cnt, mine, sp = 0u;
    for (;;) {
        sum = 0u; cnt = 0u; mine = 0u;
#pragma unroll
        for (unsigned j = 0; j < 16; ++j) { const unsigned c = xb_ld(&bar[XB_XCNT(j)]); sum += c; cnt += (c > 0u) ? 1u : 0u; mine = (j == x) ? c : mine; }
        if (sum == G) break;
        __builtin_amdgcn_s_sleep(1);
        if ((++sp & 255u) == 0u) { if (xb_ld(&bar[XB_TMO])) break; if (sp > XB_SPIN_CAP) { atomicAdd(&bar[XB_TMO], 1u); break; } }
    }
    nloc = mine > 0u ? mine : 1u; nx = cnt > 0u ? cnt : 1u;
}
__device__ __forceinline__ void xcd_barrier(const XcdBarrier& b) {
    asm volatile("s_waitcnt vmcnt(0)" ::: "memory");
    __syncthreads();
    if (b.wave == 0 && fresh_lane() == 0) {
        unsigned* bar = b.bar;
        __builtin_amdgcn_s_waitcnt(0);
        unsigned nloc = b.st[0], nx = b.st[1];
        if (nloc == 0u) { xcd_barrier_complete(bar, b.x, nloc, nx); b.st[0] = nloc; b.st[1] = nx; }
        const unsigned old = xb_add(&bar[XB_XSUB(b.x)], 1u);
        const unsigned gen = old / nloc;
        if (old + 1u == (gen + 1u) * nloc) {
            __builtin_amdgcn_fence(__ATOMIC_RELEASE, "agent");
            asm volatile("s_waitcnt vmcnt(0)" ::: "memory");
            const unsigned og = xb_add(&bar[XB_TOP], 1u);
            const unsigned tg = og / nx;
            if (og + 1u == (tg + 1u) * nx) xb_add(&bar[XB_TOPGEN], 1u);
            else XB_SPIN(xb_ld(&bar[XB_TOPGEN]) == tg, bar);
            __builtin_amdgcn_fence(__ATOMIC_ACQUIRE, "agent");
            xb_add(&bar[XB_XGEN(b.x)], 1u);
            asm volatile("s_waitcnt vmcnt(0)" ::: "memory");
        } else {
            XB_SPIN(xb_ld(&bar[XB_XGEN(b.x)]) == gen, bar);
            __builtin_amdgcn_fence(__ATOMIC_ACQUIRE, "agent");
            asm volatile("s_waitcnt vmcnt(0)" ::: "memory");
        }
    }
    __syncthreads();
}

#ifndef MK_FP8_YA
#define MK_FP8_YA 1
#endif
#ifndef MK_FP8_YB
#define MK_FP8_YB 1
#endif
#ifndef MK_FP8_GLU
#define MK_FP8_GLU 0
#endif
#ifndef MK_X1_BF16
#define MK_X1_BF16 1
#endif
#ifndef MK_FP8_OUT
#define MK_FP8_OUT 1
#endif
static_assert(!(MK_X1_BF16 && !MK_FP8_MOE), "the bf16-x1 combine is only written for the fp8 MoE build");
constexpr float FP8_XSCALE = 16.0f, MIX_DS = 1.0f / (FP8_XSCALE * FP8_WSCALE);
constexpr float INPROJ_DS = MK_FP8_INPROJ ? 1.0f / (FP8_ASCALE * FP8_WSCALE) : 1.0f;
#ifndef MK_DUP
#define MK_DUP 0
#endif
namespace gm {
constexpr int BM = 256, BK = 64, HALF = 128, HTB = HALF * BK * 2, STAGE_BYTES = 8 * HTB, NXCD = 8, WGM = 8;
__host__ __device__ __forceinline__ int lds_byte(int r, int c) { const int st = (r >> 4) * 2 + (c >> 5), rr = r & 15, cc = c & 31, ob = rr * 64 + cc * 2; return st * 1024 + (ob ^ (((ob >> 9) & 1) << 5)); }
__host__ __device__ __forceinline__ void stage_rc(int b, int& R, int& C) { const int st = b / 1024, sb = b % 1024, swz = sb ^ (((sb >> 9) & 1) << 5); R = (st >> 1) * 16 + swz / 64; C = (st & 1) * 32 + (swz % 64) / 2; }
__host__ __device__ __forceinline__ int perm32(int rho) { const int n = rho >> 4, i = rho & 15; return 8 * (i >> 2) + 4 * n + (i & 3); }

struct Unit { int pm, pn, g, st; };


struct ProbDense {
    const bf16_t* A; const bf16_t* B; int lda, ldb, nt; int nM, nN, nwg, G, c; const int* list = nullptr; const LAS int* gtab = nullptr;
    __device__ unsigned list_off(const Unit&) const { return 0u; }
    __device__ void init(const bf16_t* A_, int lda_, const bf16_t* B_, int ldb_, int K, int M, int N, int G_, int c_) { A = A_; B = B_; lda = lda_; ldb = ldb_; nt = K / BK; nM = M / BM; nN = N / BM; nwg = nM * nN; G = G_; c = c_; }
    __device__ bool next(int i, Unit& u) const {
        const long L = (long)i * G + c; if (L >= nwg) return false;
        int wgid = (int)L; { const int q = nwg / NXCD, r = nwg % NXCD, xcd = wgid % NXCD, off = wgid / NXCD; wgid = (xcd < r ? xcd * (q + 1) : r * (q + 1) + (xcd - r) * q) + off; }
        const int nig = WGM * nN, gid = wgid / nig, fm = gid * WGM, gsz = (nM - fm) < WGM ? (nM - fm) : WGM;
        u.pm = fm + ((wgid % nig) % gsz); u.pn = (wgid % nig) / gsz; u.g = 0; u.st = 0; return true;
    }
    __device__ size_t a_off(const Unit& u) const { return (size_t)u.pm * BM * lda; }
    __device__ size_t b_off(const Unit& u) const { return (size_t)u.pn * BM * ldb; }
    __device__ unsigned a_row(const Unit&, int) const { return 0u; }
};

#if MK_FAST_GEMM
template <class Prob, class Epi, bool GATHER, bool FP8 = false>
__device__ __forceinline__ void gemm_phase(LAS uchar* lds, const Prob& S, const Epi& E, const int wid  ) {
    constexpr unsigned ESZ = FP8 ? 1u : 2u;
    const int lane = fresh_lane(), tid = wid * 64 + lane, wr = wid >> 2, wc = wid & 3, fr = lane & 15, fq = lane >> 4;
    const int nt = S.nt;
    int Ra[2], Ca[2]; unsigned vB;
    { int R, C; stage_rc(tid * 16, R, C); const int Rb = Epi::PERM ? ((R & ~31) + perm32(R & 31)) : R; Ra[0] = R; Ca[0] = C; Ra[1] = R + 64; Ca[1] = C;
      vB = (unsigned)(Rb * S.ldb) * ESZ + (unsigned)C * 2u; }
    const unsigned dB64 = 64u * (unsigned)S.ldb * ESZ, dA64 = 64u * (unsigned)S.lda * ESZ, dA128 = 2u * dA64;
    constexpr unsigned kstep = BK * 2;
    const unsigned hstepB = (unsigned)HALF * (unsigned)S.ldb * ESZ;
    const unsigned ldsw = (unsigned)wid * 1024u;
    const int aoff = lds_byte(wr * 64 + fr, fq * 8), boff = lds_byte(wc * 32 + fr, fq * 8);
    const __amdgpu_buffer_rsrc_t srdA = __builtin_amdgcn_make_buffer_rsrc((void*)S.A, 0, 0xFFFFFFFF, 0x00020000);
    const __amdgpu_buffer_rsrc_t srdB = __builtin_amdgcn_make_buffer_rsrc((void*)S.B, 0, 0xFFFFFFFF, 0x00020000);
#define G_SA(b, h) (((b) * 2 + (h)) * HTB)
#define G_SB(b, h) ((4 + (b) * 2 + (h)) * HTB)
#define G_STAGE(bufoff, srd, soff, voff) do { _Pragma("unroll") for (int _i = 0; _i < 2; ++_i) \
        __builtin_amdgcn_raw_ptr_buffer_load_lds(srd, (LAS void*)(lds + (bufoff) + ldsw + _i * 8192), 16, (int)(voff)[_i], (int)(soff), 0, 0); } while (0)
#define G_STAGE1(bufoff, srd, soff, v1, d64) do { _Pragma("unroll") for (int _i = 0; _i < 2; ++_i) \
        __builtin_amdgcn_raw_ptr_buffer_load_lds(srd, (LAS void*)(lds + (bufoff) + ldsw + _i * 8192), 16, (int)(v1), (int)((soff) + _i * (d64)), 0, 0); } while (0)
#define G_STAGE_A(bufoff, soff, half, arr0, arr1) do { if constexpr (GATHER) { if (half) G_STAGE(bufoff, srdA, soff, arr1); else G_STAGE(bufoff, srdA, soff, arr0); } \
        else G_STAGE1(bufoff, srdA, (soff) + (half) * dA128, vA, dA64); } while (0)
#define G_LDA(dst, b, h) do { _Pragma("unroll") for (int m = 0; m < 4; ++m) _Pragma("unroll") for (int k = 0; k < 2; ++k) dst[m][k] = *(const LAS bf16x8*)(lds + G_SA(b, h) + aoff + m * 2048 + k * 1024); } while (0)
#define G_LDB(dst, b, h) do { _Pragma("unroll") for (int n = 0; n < 2; ++n) _Pragma("unroll") for (int k = 0; k < 2; ++k) dst[n][k] = *(const LAS bf16x8*)(lds + G_SB(b, h) + boff + n * 2048 + k * 1024); } while (0)
#define G_CAT(x0, x1) __builtin_shufflevector(__builtin_bit_cast(v4i, x0), __builtin_bit_cast(v4i, x1), 0, 1, 2, 3, 4, 5, 6, 7)
#define G_MMA(ai, bj, At, Bt) do { __builtin_amdgcn_s_setprio(1); _Pragma("unroll") for (int m = 0; m < 4; ++m) _Pragma("unroll") for (int n = 0; n < 2; ++n) { \
        if constexpr (FP8) acc[ai][bj][m][n] = __builtin_amdgcn_mfma_scale_f32_16x16x128_f8f6f4(G_CAT(Bt[n][0], Bt[n][1]), G_CAT(At[m][0], At[m][1]), acc[ai][bj][m][n], 0, 0, 0, 0x7f7f7f7f, 0, 0x7f7f7f7f); \
        else { _Pragma("unroll") for (int k = 0; k < 2; ++k) acc[ai][bj][m][n] = __builtin_amdgcn_mfma_f32_16x16x32_bf16(Bt[n][k], At[m][k], acc[ai][bj][m][n], 0, 0, 0); } } \
        __builtin_amdgcn_s_setprio(0); } while (0)
#define G_WAIT_V(n) asm volatile("s_waitcnt vmcnt(" #n ")" ::: "memory")
#define G_WAIT_L(n) asm volatile("s_waitcnt lgkmcnt(" #n ")" ::: "memory")
#define G_BAR __builtin_amdgcn_s_barrier()
#define G_SCHED __builtin_amdgcn_sched_barrier(0)
#define G_UNI(x) ((unsigned)__builtin_amdgcn_readfirstlane((int)(x)))
    Unit cur, nxt; int ui = 0;
    if (!S.next(0, cur)) return;
    unsigned vA0[2], vA1[2];
    unsigned cA = 0u, cB = G_UNI(S.b_off(cur) * ESZ);
    __amdgpu_buffer_rsrc_t srdL = srdA;
    if constexpr (GATHER) srdL = __builtin_amdgcn_make_buffer_rsrc((void*)S.list, 0, 0xFFFFFFFF, 0x00020000);
#define G_IDX(u_) do { if (wid < 4) __builtin_amdgcn_raw_ptr_buffer_load_lds(srdL, (LAS void*)(S.gtab + wid * 64), 4, lane * 4, (int)G_UNI(S.list_off(u_) * 4u) + wid * 256, 0, 0); } while (0)
    const int gR = (int)(uintptr_t)S.gtab + Ra[0] * 4; const unsigned gC = (unsigned)Ca[0] * 2u;
#define G_ROWS(o0, o1) do { const LAS int* _g = (const LAS int*)gR; const unsigned _ls = (unsigned)S.lda * ESZ; \
        o0[0] = (unsigned)_g[0] * _ls + gC; o0[1] = (unsigned)_g[64] * _ls + gC; o1[0] = (unsigned)_g[128] * _ls + gC; o1[1] = (unsigned)_g[192] * _ls + gC; } while (0)
    if constexpr (GATHER) { G_IDX(cur); G_WAIT_V(0); G_BAR; G_ROWS(vA0, vA1); G_WAIT_L(0); G_BAR; }
    else { cA = G_UNI(S.a_off(cur) * ESZ);
#pragma unroll
        for (int i = 0; i < 2; ++i) { vA0[i] = 0u; vA1[i] = 0u; } }
    const unsigned vA = (unsigned)(Ra[0] * S.lda) * ESZ + (unsigned)Ca[0] * 2u;
    G_STAGE1(G_SB(0, 0), srdB, cB, vB, dB64); G_STAGE_A(G_SA(0, 0), cA, 0, vA0, vA1); G_STAGE1(G_SB(0, 1), srdB, cB + hstepB, vB, dB64); G_STAGE_A(G_SA(0, 1), cA, 1, vA0, vA1);
    if (wr == 1) G_BAR;
    G_WAIT_V(4); G_BAR;
    G_STAGE1(G_SB(1, 0), srdB, cB + kstep, vB, dB64); G_STAGE_A(G_SA(1, 0), cA + kstep, 0, vA0, vA1); G_STAGE1(G_SB(1, 1), srdB, cB + hstepB + kstep, vB, dB64);
    G_WAIT_V(6); G_BAR;
    f32x4 acc[2][2][4][2];
#pragma unroll
    for (int a = 0; a < 2; ++a)
#pragma unroll
        for (int b = 0; b < 2; ++b)
#pragma unroll
            for (int m = 0; m < 4; ++m)
#pragma unroll
                for (int n = 0; n < 2; ++n) acc[a][b][m][n] = (f32x4){0.f, 0.f, 0.f, 0.f};
    bf16x8 At[4][2], B0[2][2], B1[2][2];
    for (;;) {
        const bool has_next = S.next(ui + 1, nxt);
        unsigned nA = cA, nB = cB; unsigned x0[2] = {0u, 0u}, x1[2] = {0u, 0u};
        if (has_next) { nB = G_UNI(S.b_off(nxt) * ESZ);
            if constexpr (GATHER) G_IDX(nxt);
            else nA = G_UNI(S.a_off(nxt) * ESZ);
        }
#define G_TRIP(LAST) do { \
            const unsigned a1 = cA + (unsigned)(t + 1) * kstep; \
            const unsigned a2 = (LAST) ? nA : cA + (unsigned)(t + 2) * kstep, b2 = (LAST) ? nB : cB + (unsigned)(t + 2) * kstep; \
            const unsigned a3 = a2 + kstep, b3 = b2 + kstep; \
            unsigned w0[2], w1[2]; \
            _Pragma("unroll") for (int i = 0; i < 2; ++i) { w0[i] = vA0[i]; w1[i] = vA1[i]; } \
            if constexpr (GATHER) { if ((LAST) && has_next) { G_ROWS(w0, w1); _Pragma("unroll") for (int i = 0; i < 2; ++i) { x0[i] = w0[i]; x1[i] = w1[i]; } } } \
              G_LDB(B0, 0, 0); G_SCHED; G_LDA(At, 0, 0); G_STAGE_A(G_SA(1, 1), a1, 1, vA0, vA1); \
            G_WAIT_L(8); G_BAR; G_WAIT_L(0); G_MMA(0, 0, At, B0); G_BAR; G_SCHED; \
              G_LDB(B1, 0, 1); G_STAGE1(G_SB(0, 0), srdB, b2, vB, dB64); \
            G_BAR; G_WAIT_L(0); G_MMA(0, 1, At, B1); G_BAR; \
              G_LDA(At, 0, 1); G_STAGE_A(G_SA(0, 0), a2, 0, w0, w1); \
            G_BAR; G_WAIT_L(0); G_MMA(1, 0, At, B0); G_BAR; G_SCHED; \
              G_STAGE1(G_SB(0, 1), srdB, b2 + hstepB, vB, dB64); \
            G_WAIT_V(6); G_BAR; G_MMA(1, 1, At, B1); G_BAR; \
              G_LDB(B0, 1, 0); G_SCHED; G_LDA(At, 1, 0); G_STAGE_A(G_SA(0, 1), a2, 1, w0, w1); \
            G_WAIT_L(8); G_BAR; G_WAIT_L(0); G_MMA(0, 0, At, B0); G_BAR; G_SCHED; \
              G_LDB(B1, 1, 1); G_STAGE1(G_SB(1, 0), srdB, b3, vB, dB64); \
            G_BAR; G_WAIT_L(0); G_MMA(0, 1, At, B1); G_BAR; \
              G_LDA(At, 1, 1); G_STAGE_A(G_SA(1, 0), a3, 0, w0, w1); \
            G_BAR; G_WAIT_L(0); G_MMA(1, 0, At, B0); G_BAR; G_SCHED; \
              G_STAGE1(G_SB(1, 1), srdB, b3 + hstepB, vB, dB64); \
            G_WAIT_V(6); G_BAR; G_MMA(1, 1, At, B1); G_BAR; } while (0)
        for (int t = 0; t < nt; t += 2) { const bool last = (t == nt - 2); G_TRIP(last); }
        if (wr == 0) G_BAR;
        { const int lane2 = fresh_lane();
          if (!(FP8 && MK_DUP && (ui & 1) == 0)) E(acc, cur, wid >> 2, wid & 3, lane2 & 15, lane2 >> 4); }
        if (!has_next) break;
#pragma unroll
        for (int a = 0; a < 2; ++a)
#pragma unroll
            for (int b = 0; b < 2; ++b)
#pragma unroll
                for (int m = 0; m < 4; ++m)
#pragma unroll
                    for (int n = 0; n < 2; ++n) acc[a][b][m][n] = (f32x4){0.f, 0.f, 0.f, 0.f};
        cur = nxt; cA = nA; cB = nB; ++ui;
        if (wr == 1) G_BAR;
        if constexpr (GATHER) {
#pragma unroll
            for (int i = 0; i < 2; ++i) { vA0[i] = x0[i]; vA1[i] = x1[i]; } }
    }
    G_WAIT_V(0);
    G_BAR;
#undef G_SA
#undef G_SB
#undef G_STAGE
#undef G_STAGE1
#undef G_STAGE_A
#undef G_LDA
#undef G_LDB
#undef G_MMA
#undef G_CAT
#undef G_WAIT_V
#undef G_WAIT_L
#undef G_BAR
#undef G_SCHED
#undef G_UNI
#undef G_TRIP
#undef G_IDX
#undef G_ROWS
}
#else
template <class Prob, class Epi, bool GATHER, bool FP8 = false>
__device__ __forceinline__ void gemm_phase(LAS uchar* lds, const Prob& S, const Epi& E, const int wid) {
    const int lane = fresh_lane(), tid = wid * 64 + lane, wr = wid >> 2, wc = wid & 3, fr = lane & 15, fq = lane >> 4;
    LAS float* As = (LAS float*)lds; LAS float* Bs = As + 256 * 33;
    Unit u;
    for (int ui = 0; S.next(ui, u); ++ui) {
        float acc[2][2][4][2][4];
#pragma unroll
        for (int a = 0; a < 2; ++a)
#pragma unroll
            for (int b = 0; b < 2; ++b)
#pragma unroll
                for (int m = 0; m < 4; ++m)
#pragma unroll
                    for (int n = 0; n < 2; ++n)
#pragma unroll
                        for (int j = 0; j < 4; ++j) acc[a][b][m][n][j] = 0.f;
        const int lr = tid >> 1, lk = (tid & 1) * 16;
        const bf16_t* ap = GATHER ? (S.A + S.a_row(u, lr)) : (S.A + S.a_off(u) + (size_t)lr * S.lda);
        const bf16_t* bp = S.B + S.b_off(u) + (size_t)lr * S.ldb;
        for (int k0 = 0; k0 < S.nt * 64; k0 += 32) {
            __syncthreads();
            const u32x4 a0 = *(const u32x4*)(ap + k0 + lk), a1 = *(const u32x4*)(ap + k0 + lk + 8);
            const u32x4 b0 = *(const u32x4*)(bp + k0 + lk), b1 = *(const u32x4*)(bp + k0 + lk + 8);
#pragma unroll
            for (int q = 0; q < 4; ++q) {
                As[lr * 33 + lk + 2 * q] = bflo(a0[q]); As[lr * 33 + lk + 2 * q + 1] = bfhi(a0[q]);
                As[lr * 33 + lk + 8 + 2 * q] = bflo(a1[q]); As[lr * 33 + lk + 8 + 2 * q + 1] = bfhi(a1[q]);
                Bs[lr * 33 + lk + 2 * q] = bflo(b0[q]); Bs[lr * 33 + lk + 2 * q + 1] = bfhi(b0[q]);
                Bs[lr * 33 + lk + 8 + 2 * q] = bflo(b1[q]); Bs[lr * 33 + lk + 8 + 2 * q + 1] = bfhi(b1[q]);
            }
            __syncthreads();
            for (int kk = 0; kk < 32; ++kk) {
                float av[2][4], bv[2][2][4];
#pragma unroll
                for (int a = 0; a < 2; ++a)
#pragma unroll
                    for (int m = 0; m < 4; ++m) av[a][m] = As[(128 * a + 64 * wr + 16 * m + fr) * 33 + kk];
#pragma unroll
                for (int b = 0; b < 2; ++b)
#pragma unroll
                    for (int n = 0; n < 2; ++n)
#pragma unroll
                        for (int j = 0; j < 4; ++j) { const int c = 128 * b + 32 * wc + (Epi::PERM ? (8 * fq + 4 * n + j) : (16 * n + 4 * fq + j)); bv[b][n][j] = Bs[c * 33 + kk]; }
#pragma unroll
                for (int a = 0; a < 2; ++a)
#pragma unroll
                    for (int b = 0; b < 2; ++b)
#pragma unroll
                        for (int m = 0; m < 4; ++m)
#pragma unroll
                            for (int n = 0; n < 2; ++n)
#pragma unroll
                                for (int j = 0; j < 4; ++j) acc[a][b][m][n][j] += av[a][m] * bv[b][n][j];
            }
        }
        f32x4 accv[2][2][4][2];
#pragma unroll
        for (int a = 0; a < 2; ++a)
#pragma unroll
            for (int b = 0; b < 2; ++b)
#pragma unroll
                for (int m = 0; m < 4; ++m)
#pragma unroll
                    for (int n = 0; n < 2; ++n) accv[a][b][m][n] = (f32x4){acc[a][b][m][n][0], acc[a][b][m][n][1], acc[a][b][m][n][2], acc[a][b][m][n][3]};
        E(accv, u, wr, wc, fr, fq);
    }
    __syncthreads();
}
#endif
}

struct Args {
    const float* in[32];
    float* out; uchar* ws;
    int ph_lo, ph_hi;
};
struct Frame {
    LAS uchar* lds; uchar* ws; int wave, G, bx;
};
#define FRAME_IDS(F) const int F_lane = fresh_lane(), F_tid = (F).wave * 64 + F_lane
enum { I_X = 0, I_POS, I_N1G, I_WIN, I_BG, I_QNG, I_WUQ, I_KVNG, I_WUKV, I_QKQG, I_QKKG, I_WOMLA, I_LRE, I_LIM, I_LOGDT, I_BRE, I_BIM, I_CRE, I_CIM, I_S5D,
       I_WGLU, I_WOS5, I_WOUT, I_N2G, I_WR, I_BR, I_WG, I_BGATE, I_WU, I_BUP, I_WD, I_BDOWN };

struct ProbS5 {
    const bf16_t* A; const bf16_t* B; int lda, ldb, nt; int G, c; const int* list = nullptr; const LAS int* gtab = nullptr;
    __device__ unsigned list_off(const gm::Unit&) const { return 0u; }
    __device__ bool next(int i, gm::Unit& u) const { const int L = i * G + c; if (L >= S5G * 4) return false; u.g = L >> 2; u.pm = L & 3; u.pn = 0; u.st = 0; return true; }
    __device__ size_t a_off(const gm::Unit& u) const { return ((size_t)u.g * NCHUNK + (size_t)u.pm * 256) * APK; }
    __device__ size_t b_off(const gm::Unit& u) const { return (size_t)u.g * 256 * ldb; }
    __device__ unsigned a_row(const gm::Unit&, int) const { return 0u; }
};
struct ProbMoE {
    const bf16_t* A; const bf16_t* B; int lda, ldb, nt; int npn; size_t estride;
    int x, rk, nrk; int nte[4], rcp[4], pre[4], eid[4];
    const int* list = nullptr; const LAS int* gtab = nullptr;
    __device__ void load(const LAS int* tab) {
#pragma unroll
        for (int q = 0; q < 4; ++q) { const int e = __builtin_amdgcn_readfirstlane(tab[160 + x * 4 + q]); eid[q] = e; nte[q] = __builtin_amdgcn_readfirstlane(tab[32 + e]); rcp[q] = __builtin_amdgcn_readfirstlane(tab[128 + e]); pre[q] = __builtin_amdgcn_readfirstlane(tab[64 + e]); }
    }
    __device__ unsigned list_off(const gm::Unit&) const { return 0u; }
    __device__ bool next(int i, gm::Unit& u) const {
        int L = (i >> MK_DUP) * nrk + rk;
#pragma unroll
        for (int q = 0; q < 4; ++q) { const int nu = nte[q] * npn;
            if (L < nu) { u.g = eid[q]; u.pn = (L * rcp[q]) >> 20; u.pm = L - u.pn * nte[q]; u.st = pre[q] + u.pm; return true; } L -= nu; }
        return false;
    }
    __device__ size_t a_off(const gm::Unit& u) const { return ((size_t)u.st * 256) * lda; }
    __device__ size_t b_off(const gm::Unit& u) const { return (size_t)u.g * estride + (size_t)u.pn * 256 * ldb; }
    __device__ unsigned a_row(const gm::Unit&, int) const { return 0u; }
};

#define EPI_ROW(u_, ai, m) ((u_).pm * 256 + (ai) * 128 + wr * 64 + (m) * 16 + fr)
struct EpiStoreBf16 {
    static constexpr bool PERM = true;
    bf16_t* O; int ld;
    __device__ __forceinline__ void operator()(const f32x4 (&acc)[2][2][4][2], const gm::Unit& u, int wr, int wc, int fr, int fq) const {
#pragma unroll
        for (int ai = 0; ai < 2; ++ai)
#pragma unroll
            for (int m = 0; m < 4; ++m) { bf16_t* rowp = O + (size_t)EPI_ROW(u, ai, m) * ld + u.pn * 256 + wc * 32 + 8 * fq;
#pragma unroll
                for (int bj = 0; bj < 2; ++bj) { const f32x4 v0 = acc[ai][bj][m][0], v1 = acc[ai][bj][m][1];
                    u32x4 w; w.x = cvt_pk_bf16(v0[0], v0[1]); w.y = cvt_pk_bf16(v0[2], v0[3]); w.z = cvt_pk_bf16(v1[0], v1[1]); w.w = cvt_pk_bf16(v1[2], v1[3]);
                    *(u32x4*)(rowp + bj * 128) = w; } }
    }
};
template <int S0, int NS, int LEN> struct EpiStoreScaled {
    static constexpr bool PERM = true;
    bf16_t* O; int ld; const float* ssqp;
    __device__ __forceinline__ void operator()(const f32x4 (&acc)[2][2][4][2], const gm::Unit& u, int wr, int wc, int fr, int fq) const {
#pragma unroll
        for (int ai = 0; ai < 2; ++ai) { float rs[4];
#pragma unroll
            for (int m = 0; m < 4; ++m) { const float* sp = ssqp + (size_t)EPI_ROW(u, ai, m) * 12 + S0; float t = 0.f;
#pragma unroll
                for (int q = 0; q < NS; q += 4) { const f32x4 v = *(const f32x4*)(sp + q); t += (v[0] + v[1]) + (v[2] + v[3]); }
                rs[m] = 1.0f / sqrtf(t * (1.0f / LEN) + EPS); }
#pragma unroll
            for (int m = 0; m < 4; ++m) { bf16_t* rowp = O + (size_t)EPI_ROW(u, ai, m) * ld + u.pn * 256 + wc * 32 + 8 * fq;
#pragma unroll
                for (int bj = 0; bj < 2; ++bj) { const f32x4 v0 = acc[ai][bj][m][0] * rs[m], v1 = acc[ai][bj][m][1] * rs[m];
                    u32x4 w; w.x = cvt_pk_bf16(v0[0], v0[1]); w.y = cvt_pk_bf16(v0[2], v0[3]); w.z = cvt_pk_bf16(v1[0], v1[1]); w.w = cvt_pk_bf16(v1[2], v1[3]);
                    *(u32x4*)(rowp + bj * 128) = w; } } }
    }
};
struct EpiKV {
    static constexpr bool PERM = true;
    bf16_t* kraw; bf16_t* vn; const float* ssqp;
    __device__ __forceinline__ void operator()(const f32x4 (&acc)[2][2][4][2], const gm::Unit& u, int wr, int wc, int fr, int fq) const {
#pragma unroll
        for (int ai = 0; ai < 2; ++ai) { float rs[4];
#pragma unroll
            for (int m = 0; m < 4; ++m) { const f32x4 v = *(const f32x4*)(ssqp + (size_t)EPI_ROW(u, ai, m) * 12 + 8); rs[m] = 1.0f / sqrtf(((v[0] + v[1]) + (v[2] + v[3])) * (1.0f / KVLORA) + EPS); }
#pragma unroll
            for (int m = 0; m < 4; ++m) { const int t = EPI_ROW(u, ai, m); const size_t ro = ((size_t)((t >> 11) * NH + u.pn) * SEQ + (t & 2047)) * 128 + wc * 32 + 8 * fq;
#pragma unroll
                for (int bj = 0; bj < 2; ++bj) { const f32x4 v0 = acc[ai][bj][m][0] * rs[m], v1 = acc[ai][bj][m][1] * rs[m];
                    u32x4 w; w.x = cvt_pk_bf16(v0[0], v0[1]); w.y = cvt_pk_bf16(v0[2], v0[3]); w.z = cvt_pk_bf16(v1[0], v1[1]); w.w = cvt_pk_bf16(v1[2], v1[3]);
                    *(u32x4*)((bj ? vn : kraw) + ro) = w; } } }
    }
};
struct EpiInProj {
    static constexpr bool PERM = true;
    bf16_t* proj; bf16_t* apack; const float* bgates; float* ssqp;
    __device__ __forceinline__ void operator()(const f32x4 (&acc)[2][2][4][2], const gm::Unit& u, int wr, int wc, int fr, int fq) const {
        const int colt = u.pn * 256 + wc * 32 + 8 * fq;
        if (u.pn < 3) {
#pragma unroll
            for (int ai = 0; ai < 2; ++ai)
#pragma unroll
                for (int m = 0; m < 4; ++m) { float sq = 0.f;
#pragma unroll
                    for (int bj = 0; bj < 2; ++bj)
#pragma unroll
                        for (int n = 0; n < 2; ++n) { const f32x4 v = acc[ai][bj][m][n]; sq += (v[0] * v[0] + v[1] * v[1]) + (v[2] * v[2] + v[3] * v[3]); }
                    sq += __shfl_xor(sq, 16); sq += __shfl_xor(sq, 32);
                    if (fq == 0) ssqp[(size_t)EPI_ROW(u, ai, m) * 12 + u.pn * 4 + wc] = sq * (INPROJ_DS * INPROJ_DS); } }
        const int kind = (u.pn >= 3 && u.pn < 7) ? 1 : ((u.pn >= 7 && u.pn < 23) ? 2 : 0);
#pragma unroll
        for (int bj = 0; bj < 2; ++bj) {
            const int col = colt + bj * 128;
            f32x4 b0 = (f32x4){0.f, 0.f, 0.f, 0.f}, b1 = b0;
            constexpr float NL2E = -1.4426950408889634f;
            if (kind == 2) { b0 = *(const f32x4*)(bgates + (col - C_GA)) * NL2E; b1 = *(const f32x4*)(bgates + (col - C_GA) + 4) * NL2E; }
#pragma unroll
            for (int ai = 0; ai < 2; ++ai)
#pragma unroll
                for (int m = 0; m < 4; ++m) {
                    const int row = EPI_ROW(u, ai, m);
                    f32x4 v0 = acc[ai][bj][m][0], v1 = acc[ai][bj][m][1];
                    if (kind == 2) {
#pragma unroll
                        for (int h = 0; h < 2; ++h) { const f32x2 s0 = sig2_t((f32x2){v0[2 * h], v0[2 * h + 1]} * (NL2E * INPROJ_DS) + (f32x2){b0[2 * h], b0[2 * h + 1]}), s1 = sig2_t((f32x2){v1[2 * h], v1[2 * h + 1]} * (NL2E * INPROJ_DS) + (f32x2){b1[2 * h], b1[2 * h + 1]});
                            v0[2 * h] = s0.x; v0[2 * h + 1] = s0.y; v1[2 * h] = s1.x; v1[2 * h + 1] = s1.y; }
                    } else if (MK_FP8_INPROJ) { v0 = v0 * INPROJ_DS; v1 = v1 * INPROJ_DS; }
                    u32x4 w; w.x = cvt_pk_bf16(v0[0], v0[1]); w.y = cvt_pk_bf16(v0[2], v0[3]); w.z = cvt_pk_bf16(v1[0], v1[1]); w.w = cvt_pk_bf16(v1[2], v1[3]);
                    if (kind == 1) { const int j = col - C_U, g = j >> 4, cc = j & 15;
                        *(u32x4*)(apack + ((size_t)g * NCHUNK + (row >> 4)) * APK + (row & 15) * 16 + cc) = w; }
                    else { *(u32x4*)(proj + (size_t)row * NPROJ + col) = w;
                    }
                }
        }
    }
};
struct EpiS5State {
    static constexpr bool PERM = false;
    float* sch;
    __device__ __forceinline__ void operator()(const f32x4 (&acc)[2][2][4][2], const gm::Unit& u, int wr, int wc, int fr, int fq) const {
#pragma unroll
        for (int ai = 0; ai < 2; ++ai)
#pragma unroll
            for (int m = 0; m < 4; ++m) { float* rowp = sch + ((size_t)u.g * NCHUNK + EPI_ROW(u, ai, m)) * 128 + wc * 32 + 4 * fq;
#pragma unroll
                for (int n = 0; n < 2; ++n) *(f32x4*)(rowp + n * 16) = acc[ai][0][m][n]; }
    }
};
struct EpiS5Out {
    static constexpr bool PERM = true;
    bf16_t* gact; uchar* gact8;
    __device__ __forceinline__ void operator()(const f32x4 (&acc)[2][2][4][2], const gm::Unit& u, int wr, int wc, int fr, int fq) const {
#pragma unroll
        for (int ai = 0; ai < 2; ++ai)
#pragma unroll
            for (int m = 0; m < 4; ++m) { const int r = EPI_ROW(u, ai, m);
#pragma unroll
                for (int bj = 0; bj < 2; ++bj) { const int n0 = bj * 128 + wc * 32 + 8 * fq, t = n0 >> 4, c0 = n0 & 15;
                    f32x4 v0 = acc[ai][bj][m][0], v1 = acc[ai][bj][m][1];
#pragma unroll
                    for (int h = 0; h < 2; ++h) { const f32x2 g0 = gelu_tanh2((f32x2){v0[2 * h], v0[2 * h + 1]}), g1 = gelu_tanh2((f32x2){v1[2 * h], v1[2 * h + 1]});
                        v0[2 * h] = g0.x; v0[2 * h + 1] = g0.y; v1[2 * h] = g1.x; v1[2 * h + 1] = g1.y; }
                    u32x4 w; w.x = cvt_pk_bf16(v0[0], v0[1]); w.y = cvt_pk_bf16(v0[2], v0[3]); w.z = cvt_pk_bf16(v1[0], v1[1]); w.w = cvt_pk_bf16(v1[2], v1[3]);
                    *(u32x4*)(gact + ((size_t)r * 16 + t) * S5W + u.g * 16 + c0) = w;
#if MK_FP8_GLU
                    { u32x2 w8; w8.x = pk4_fp8c(v0[0] * FP8_XSCALE, v0[1] * FP8_XSCALE, v0[2] * FP8_XSCALE, v0[3] * FP8_XSCALE); w8.y = pk4_fp8c(v1[0] * FP8_XSCALE, v1[1] * FP8_XSCALE, v1[2] * FP8_XSCALE, v1[3] * FP8_XSCALE);
                      *(u32x2*)(gact8 + ((size_t)r * 16 + t) * S5W + u.g * 16 + c0) = w8; }
#endif
                    } }
    }
};
template <int MODE, bool OUT8 = false, bool ACC8 = false> struct EpiSide {
    static constexpr bool PERM = true; static constexpr float DS = ACC8 ? MIX_DS : 1.0f;
    bf16_t* O; int ldo; const bf16_t* s0; int ld0; const bf16_t* s1; int ld1;
    __device__ __forceinline__ void operator()(const f32x4 (&acc)[2][2][4][2], const gm::Unit& u, int wr, int wc, int fr, int fq) const {
        const int col0 = u.pn * 256 + wc * 32 + 8 * fq;
#pragma unroll
        for (int ai = 0; ai < 2; ++ai) {
            u32x4 sa[4][2], sb[4][2];
#pragma unroll
            for (int m = 0; m < 4; ++m)
#pragma unroll
                for (int bj = 0; bj < 2; ++bj) { const int row = EPI_ROW(u, ai, m);
                    sa[m][bj] = *(const u32x4*)(s0 + (size_t)row * ld0 + col0 + bj * 128);
                    if (MODE == 2) sb[m][bj] = *(const u32x4*)(s1 + (size_t)row * ld1 + col0 + bj * 128); else sb[m][bj] = (u32x4){0u, 0u, 0u, 0u}; }
#pragma unroll
            for (int m = 0; m < 4; ++m)
#pragma unroll
                for (int bj = 0; bj < 2; ++bj) { const int row = EPI_ROW(u, ai, m);
                    const f32x4 v0 = acc[ai][bj][m][0], v1 = acc[ai][bj][m][1]; const u32x4 a = sa[m][bj], b = sb[m][bj];
                    float r[8];
#pragma unroll
                    for (int q = 0; q < 4; ++q) { const float x0 = (q < 2 ? v0[2 * q] : v1[2 * q - 4]) * DS, x1 = (q < 2 ? v0[2 * q + 1] : v1[2 * q - 3]) * DS;
                        const float a0 = bflo(a[q]), a1 = bfhi(a[q]);
                        if (MODE == 0) { const f32x2 sg = sig2_t((f32x2){x0, x1} * -1.4426950408889634f) * (f32x2){a0, a1}; r[2 * q] = sg.x; r[2 * q + 1] = sg.y; }
                        else if (MODE == 1) { r[2 * q] = a0 * x0; r[2 * q + 1] = a1 * x1; }
                        else { r[2 * q] = bflo(b[q]) + a0 * x0; r[2 * q + 1] = bfhi(b[q]) + a1 * x1; } }
                    if constexpr (OUT8) { u32x2 w; w.x = pk4_fp8c(r[0] * FP8_XSCALE, r[1] * FP8_XSCALE, r[2] * FP8_XSCALE, r[3] * FP8_XSCALE); w.y = pk4_fp8c(r[4] * FP8_XSCALE, r[5] * FP8_XSCALE, r[6] * FP8_XSCALE, r[7] * FP8_XSCALE);
                        *(u32x2*)((uchar*)O + (size_t)row * ldo + col0 + bj * 128) = w; }
                    else { u32x4 w; w.x = cvt_pk_bf16(r[0], r[1]); w.y = cvt_pk_bf16(r[2], r[3]); w.z = cvt_pk_bf16(r[4], r[5]); w.w = cvt_pk_bf16(r[6], r[7]);
                        *(u32x4*)(O + (size_t)row * ldo + col0 + bj * 128) = w; } }
        }
    }
};
struct EpiResidF32 {
    static constexpr bool PERM = false; static constexpr float DS = MK_FP8_OUT ? MIX_DS : 1.0f;
    const float* x; float* out;
    __device__ __forceinline__ void operator()(const f32x4 (&acc)[2][2][4][2], const gm::Unit& u, int wr, int wc, int fr, int fq) const {
#pragma unroll
        for (int ai = 0; ai < 2; ++ai)
#pragma unroll
            for (int mh = 0; mh < 2; ++mh) { f32x4 xv[2][2][2];
#pragma unroll
                for (int mm = 0; mm < 2; ++mm) { const size_t off = (size_t)EPI_ROW(u, ai, 2 * mh + mm) * DM + u.pn * 256 + wc * 32 + 4 * fq;
#pragma unroll
                    for (int bj = 0; bj < 2; ++bj)
#pragma unroll
                        for (int n = 0; n < 2; ++n) xv[mm][bj][n] = *(const f32x4*)(x + off + bj * 128 + n * 16); }
#pragma unroll
                for (int mm = 0; mm < 2; ++mm) { const size_t off = (size_t)EPI_ROW(u, ai, 2 * mh + mm) * DM + u.pn * 256 + wc * 32 + 4 * fq;
#pragma unroll
                    for (int bj = 0; bj < 2; ++bj)
#pragma unroll
                        for (int n = 0; n < 2; ++n) *(f32x4*)(out + off + bj * 128 + n * 16) = xv[mm][bj][n] + acc[ai][bj][2 * mh + mm][n] * DS; } }
    }
};
struct EpiResidBf16 {
    static constexpr bool PERM = true; static constexpr float DS = MK_FP8_OUT ? MIX_DS : 1.0f;
    const float* x; bf16_t* x1;
    __device__ __forceinline__ void operator()(const f32x4 (&acc)[2][2][4][2], const gm::Unit& u, int wr, int wc, int fr, int fq) const {
#pragma unroll
        for (int ai = 0; ai < 2; ++ai)
#pragma unroll
            for (int mh = 0; mh < 2; ++mh) { f32x4 xv[2][2][2];
#pragma unroll
                for (int mm = 0; mm < 2; ++mm) { const size_t off = (size_t)EPI_ROW(u, ai, 2 * mh + mm) * DM + u.pn * 256 + wc * 32 + 8 * fq;
#pragma unroll
                    for (int bj = 0; bj < 2; ++bj)
#pragma unroll
                        for (int n = 0; n < 2; ++n) xv[mm][bj][n] = __builtin_nontemporal_load((const f32x4*)(x + off + bj * 128 + n * 4)); }
#pragma unroll
                for (int mm = 0; mm < 2; ++mm) { const size_t off = (size_t)EPI_ROW(u, ai, 2 * mh + mm) * DM + u.pn * 256 + wc * 32 + 8 * fq;
#pragma unroll
                    for (int bj = 0; bj < 2; ++bj) { const f32x4 v0 = xv[mm][bj][0] + acc[ai][bj][2 * mh + mm][0] * DS, v1 = xv[mm][bj][1] + acc[ai][bj][2 * mh + mm][1] * DS;
                        u32x4 w; w.x = cvt_pk_bf16(v0[0], v0[1]); w.y = cvt_pk_bf16(v0[2], v0[3]); w.z = cvt_pk_bf16(v1[0], v1[1]); w.w = cvt_pk_bf16(v1[2], v1[3]);
                        *(u32x4*)(x1 + off + bj * 128) = w; } } }
    }
};
#if MK_FP8_MOE
constexpr float MOE_DESCALE = 1.0f / (FP8_ASCALE * FP8_WSCALE);
#else
constexpr float MOE_DESCALE = 1.0f;
#endif
struct EpiSwiglu {
    static constexpr bool PERM = true;
    static constexpr float EPS_AS = MK_FP8_MOE ? FP8_ASCALE : 1.0f;
    bf16_t* hact; const float* bgate; const float* bup; const LAS int* tab;
    __device__ __forceinline__ void operator()(const f32x4 (&acc)[2][2][4][2], const gm::Unit& u, int wr, int wc, int fr, int fq) const {
        const int hc = u.pn * 128 + wc * 32 + 8 * fq;
        const unsigned slot0 = (unsigned)u.st * 256u + wr * 64 + fr;
        unsigned w0[2][4];
#pragma unroll
        for (int n = 0; n < 2; ++n) {
            const f32x4 g0 = *(const f32x4*)(bgate + (unsigned)(u.g * DFF + hc + 4 * n)), u0 = *(const f32x4*)(bup + (unsigned)(u.g * DFF + hc + 4 * n));
            const f32x2 gbv[2] = {{g0.x, g0.y}, {g0.z, g0.w}}, ubv[2] = {{u0.x * EPS_AS + EPS_AS, u0.y * EPS_AS + EPS_AS}, {u0.z * EPS_AS + EPS_AS, u0.w * EPS_AS + EPS_AS}};
#pragma unroll
            for (int ai = 0; ai < 2; ++ai)
#pragma unroll
                for (int m = 0; m < 4; ++m) { const unsigned slot = slot0 + ai * 128 + m * 16;
                    float r[4];
#pragma unroll
                    for (int h = 0; h < 2; ++h) { const f32x2 ag = {acc[ai][0][m][n][2 * h], acc[ai][0][m][n][2 * h + 1]}, au = {acc[ai][1][m][n][2 * h], acc[ai][1][m][n][2 * h + 1]};
                        f32x2 gt = ag * MOE_DESCALE + gbv[h], up = au * (MOE_DESCALE * EPS_AS) + ubv[h];
                        gt.x = fminf(gt.x, 7.0f); gt.y = fminf(gt.y, 7.0f);
                        up.x = __builtin_amdgcn_fmed3f(up.x, -6.0f * EPS_AS, 8.0f * EPS_AS); up.y = __builtin_amdgcn_fmed3f(up.y, -6.0f * EPS_AS, 8.0f * EPS_AS);
                        const f32x2 t = gt * (-1.702f * 1.4426950408889634f); f32x2 d; d.x = __builtin_amdgcn_exp2f(t.x); d.y = __builtin_amdgcn_exp2f(t.y); d = d + 1.0f;
                        f32x2 sg; sg.x = __builtin_amdgcn_rcpf(d.x); sg.y = __builtin_amdgcn_rcpf(d.y);
                        const f32x2 o = up * (gt * sg); r[2 * h] = o.x; r[2 * h + 1] = o.y; }
#if MK_FP8_MOE
                    const unsigned pk = pk4_fp8(r[0], r[1], r[2], r[3]);
                    if (n == 0) w0[ai][m] = pk; else { u32x2 w; w.x = w0[ai][m]; w.y = pk; *(u32x2*)((uchar*)hact + slot * DFF + hc) = w; }
#else
                    u32x2 w; w.x = cvt_pk_bf16(r[0], r[1]); w.y = cvt_pk_bf16(r[2], r[3]); *(u32x2*)(hact + slot * DFF + hc + 4 * n) = w;
#endif
                }
        }
    }
};
struct EpiDown {
    static constexpr bool PERM = true;
    bf16_t* ys; const float* bdown; const LAS int* tab;
    __device__ __forceinline__ void operator()(const f32x4 (&acc)[2][2][4][2], const gm::Unit& u, int wr, int wc, int fr, int fq) const {
        const size_t slot0 = (size_t)u.st * 256;
#pragma unroll
        for (int bj = 0; bj < 2; ++bj) { const int col = u.pn * 256 + bj * 128 + wc * 32 + 8 * fq;
            const float* bd = bdown + (size_t)u.g * DM + col; const f32x4 d0 = *(const f32x4*)bd, d1 = *(const f32x4*)(bd + 4);
#pragma unroll
            for (int ai = 0; ai < 2; ++ai)
#pragma unroll
                for (int m = 0; m < 4; ++m) { const size_t slot = slot0 + ai * 128 + wr * 64 + m * 16 + fr;
                    const f32x4 v0 = acc[ai][bj][m][0] * MOE_DESCALE + d0, v1 = acc[ai][bj][m][1] * MOE_DESCALE + d1;
#if MK_FP8_MOE
                    u32x2 w; w.x = pk4_fp8c(v0[0] * FP8_YSCALE, v0[1] * FP8_YSCALE, v0[2] * FP8_YSCALE, v0[3] * FP8_YSCALE); w.y = pk4_fp8c(v1[0] * FP8_YSCALE, v1[1] * FP8_YSCALE, v1[2] * FP8_YSCALE, v1[3] * FP8_YSCALE);
                    *(u32x2*)((uchar*)ys + slot * DM + col) = w; } }
#else
                    u32x4 w; w.x = cvt_pk_bf16(v0[0], v0[1]); w.y = cvt_pk_bf16(v0[2], v0[3]); w.z = cvt_pk_bf16(v1[0], v1[1]); w.w = cvt_pk_bf16(v1[2], v1[3]);
                    *(u32x4*)(ys + slot * DM + col) = w; } }
#endif
    }
};

template <bool FP8OUT>
__device__ __forceinline__ void transpose_item(const float* W, int ldw, int src_col0, int k0, const float* kscale, void* WT, int ldt, int dst_row0, float oscale, LAS float* scr, int lane) {
    if (src_col0 >= 0) {
        f32x4 v[16]; const float* wp = W + (size_t)(k0 + (lane >> 4)) * ldw + src_col0 + (lane & 15) * 4;
#pragma unroll
        for (int i = 0; i < 16; ++i) v[i] = __builtin_nontemporal_load((const f32x4*)(wp + (size_t)(4 * i) * ldw));
#pragma unroll
        for (int i = 0; i < 16; ++i) { const int kk = 4 * i + (lane >> 4); const float sc = kscale ? kscale[k0 + kk] * oscale : oscale; LAS float* d = scr + kk * 65 + (lane & 15) * 4;
            d[0] = v[i].x * sc; d[1] = v[i].y * sc; d[2] = v[i].z * sc; d[3] = v[i].w * sc; }
    } else {
#pragma unroll
        for (int i = 0; i < 16; ++i) { LAS float* d = scr + (4 * i + (lane >> 4)) * 65 + (lane & 15) * 4; d[0] = 0.f; d[1] = 0.f; d[2] = 0.f; d[3] = 0.f; }
    }
    LDS_WAIT(); asm volatile("" ::: "memory");
    if constexpr (FP8OUT) { const int c = lane & 3;
#pragma unroll
        for (int j = 0; j < 4; ++j) { const int n = (lane >> 2) + 16 * j; const LAS float* s = scr + (16 * c) * 65 + n; u32x4 o;
            o.x = pk4_fp8(s[0 * 65], s[1 * 65], s[2 * 65], s[3 * 65]); o.y = pk4_fp8(s[4 * 65], s[5 * 65], s[6 * 65], s[7 * 65]);
            o.z = pk4_fp8(s[8 * 65], s[9 * 65], s[10 * 65], s[11 * 65]); o.w = pk4_fp8(s[12 * 65], s[13 * 65], s[14 * 65], s[15 * 65]);
            *(u32x4*)((uchar*)WT + (size_t)(dst_row0 + n) * ldt + k0 + 16 * c) = o; }
    } else { const int c = lane & 7;
#pragma unroll
        for (int j = 0; j < 8; ++j) { const int n = (lane >> 3) + 8 * j; const LAS float* s = scr + (8 * c) * 65 + n;
            u32x4 o; o.x = pk2(s[0 * 65], s[1 * 65]); o.y = pk2(s[2 * 65], s[3 * 65]); o.z = pk2(s[4 * 65], s[5 * 65]); o.w = pk2(s[6 * 65], s[7 * 65]);
            *(u32x4*)((bf16_t*)WT + (size_t)(dst_row0 + n) * ldt + k0 + 8 * c) = o; }
    }
    LDS_WAIT(); asm volatile("" ::: "memory");
}
struct TItem { const float* src; uchar* dst; };
__device__ __forceinline__ void ti_load(const TItem& t, f32x4 (&v)[16], int lane) {
    const float* wp = t.src + (size_t)(lane >> 4) * DM + (lane & 15) * 4;
#pragma unroll
    for (int i = 0; i < 16; ++i) v[i] = __builtin_nontemporal_load((const f32x4*)(wp + (size_t)(4 * i) * DM));
}
template <bool FP8OUT>
__device__ __forceinline__ void ti_store(const TItem& t, const f32x4 (&v)[16], float oscale, LAS float* scr, int lane) {
#pragma unroll
    for (int i = 0; i < 16; ++i) { LAS float* d = scr + (4 * i + (lane >> 4)) * 65 + (lane & 15) * 4; d[0] = v[i].x * oscale; d[1] = v[i].y * oscale; d[2] = v[i].z * oscale; d[3] = v[i].w * oscale; }
    LDS_WAIT(); asm volatile("" ::: "memory");
    if constexpr (FP8OUT) { const int c = lane & 3;
#pragma unroll
        for (int j = 0; j < 4; ++j) { const int n = (lane >> 2) + 16 * j; const LAS float* s = scr + (16 * c) * 65 + n; u32x4 o;
            o.x = pk4_fp8(s[0 * 65], s[1 * 65], s[2 * 65], s[3 * 65]); o.y = pk4_fp8(s[4 * 65], s[5 * 65], s[6 * 65], s[7 * 65]);
            o.z = pk4_fp8(s[8 * 65], s[9 * 65], s[10 * 65], s[11 * 65]); o.w = pk4_fp8(s[12 * 65], s[13 * 65], s[14 * 65], s[15 * 65]);
            *(u32x4*)(t.dst + (size_t)n * DM + 16 * c) = o; }
    } else { const int c = lane & 7;
#pragma unroll
        for (int j = 0; j < 8; ++j) { const int n = (lane >> 3) + 8 * j; const LAS float* s = scr + (8 * c) * 65 + n;
            u32x4 o; o.x = pk2(s[0 * 65], s[1 * 65]); o.y = pk2(s[2 * 65], s[3 * 65]); o.z = pk2(s[4 * 65], s[5 * 65]); o.w = pk2(s[6 * 65], s[7 * 65]);
            *(u32x4*)(t.dst + ((size_t)n * DM + 8 * c) * 2) = o; }
    }
    LDS_WAIT(); asm volatile("" ::: "memory");
}
template <bool W8>
__device__ __forceinline__ TItem moe_pair(const Args& a, uchar* ws, int it) {
    constexpr size_t WEB = W8 ? 1 : 2; TItem t;
    const int kb = 2 * ((it & 7) | (((it >> 11) & 1) << 3)), nb = (it >> 3) & 31;
    if (it < NE * 2 * 16 * 32) { const int rest = ((it >> 8) & 7) | ((it >> 12) << 3), half = rest & 1, e = rest >> 1, pn = nb >> 1, q = nb & 1;
        t.src = a.in[half ? I_WU : I_WG] + (size_t)e * DM * DFF + (size_t)(kb * 64) * DFF + nb * 64;
        t.dst = ws + WS_W1 + ((size_t)e * 4096 * DM + (size_t)(pn * 256 + half * 128 + q * 64) * DM + kb * 64) * WEB;
    } else { const int r = it - NE * 2 * 16 * 32, e = ((r >> 8) & 7) | ((r >> 12) << 3);
        t.src = a.in[I_WD] + (size_t)e * DFF * DM + (size_t)(kb * 64) * DM + nb * 64;
        t.dst = ws + WS_W2 + ((size_t)e * DM * DFF + (size_t)(nb * 64) * DFF + kb * 64) * WEB; }
    return t;
}
template <bool FP8OUT, int NO>
__device__ __forceinline__ void ti_block(const f32x4 (&v)[16], float oscale, LAS float* scr, int lane, u32x4 (&o)[NO]) {
#pragma unroll
    for (int i = 0; i < 16; ++i) { LAS float* d = scr + (4 * i + (lane >> 4)) * 65 + (lane & 15) * 4; d[0] = v[i].x * oscale; d[1] = v[i].y * oscale; d[2] = v[i].z * oscale; d[3] = v[i].w * oscale; }
    LDS_WAIT(); asm volatile("" ::: "memory");
    if constexpr (FP8OUT) { const int c = lane & 3;
#pragma unroll
        for (int j = 0; j < 4; ++j) { const int n = (lane >> 2) + 16 * j; const LAS float* s = scr + (16 * c) * 65 + n;
            o[j].x = pk4_fp8(s[0 * 65], s[1 * 65], s[2 * 65], s[3 * 65]); o[j].y = pk4_fp8(s[4 * 65], s[5 * 65], s[6 * 65], s[7 * 65]);
            o[j].z = pk4_fp8(s[8 * 65], s[9 * 65], s[10 * 65], s[11 * 65]); o[j].w = pk4_fp8(s[12 * 65], s[13 * 65], s[14 * 65], s[15 * 65]); }
    } else { const int c = lane & 7;
#pragma unroll
        for (int j = 0; j < 8; ++j) { const int n = (lane >> 3) + 8 * j; const LAS float* s = scr + (8 * c) * 65 + n;
            o[j].x = pk2(s[0 * 65], s[1 * 65]); o[j].y = pk2(s[2 * 65], s[3 * 65]); o[j].z = pk2(s[4 * 65], s[5 * 65]); o[j].w = pk2(s[6 * 65], s[7 * 65]); } }
    LDS_WAIT(); asm volatile("" ::: "memory");
}
__device__ __forceinline__ int win_src_col(int n0) {
    if (n0 < C_KVLAT) return n0;
    if (n0 < C_U) return n0;
    if (n0 < C_GA) return (n0 - C_U) + 832;
    if (n0 < C_KR) return (n0 - C_GA) + 1856;
    if (n0 < C_KR + DROPE) return (n0 - C_KR) + 768;
    return -1;
}
__device__ __forceinline__ void s5_build_group(const Args& a, const Frame& F, int g) {
    FRAME_IDS(F);
    LAS float* L = (LAS float*)F.lds;
    LAS float* Apr = L;              LAS float* Api = Apr + 17 * 64;
    LAS float* Zr = Api + 17 * 64;   LAS float* Zi = Zr + 64;
    LAS float* Bbr = Zi + 64;        LAS float* Bbi = Bbr + 1024;
    LAS float* Cr = Bbi + 1024;      LAS float* Ci = Cr + 1024;
    LAS float* Kt = Ci + 1024;
    const int tid = F_tid;
    __syncthreads();
    if (tid < 64) { const int p = tid;
        const float dt = expf(a.in[I_LOGDT][g]); const float lr = a.in[I_LRE][g * 64 + p], li = a.in[I_LIM][g * 64 + p];
        const float mag = expf(lr * dt); const float ar = mag * cosf(li * dt), ai = mag * sinf(li * dt);
        const float den = lr * lr + li * li;
        Zr[p] = ((ar - 1.0f) * lr + ai * li) / den; Zi[p] = (ai * lr - (ar - 1.0f) * li) / den;
        float pr = 1.0f, pi = 0.0f;
        for (int t = 0; t <= 16; ++t) { Apr[t * 64 + p] = pr; Api[t * 64 + p] = pi; const float nr = pr * ar - pi * ai, ni = pr * ai + pi * ar; pr = nr; pi = ni; }
    }
    __syncthreads();
    for (int i = tid; i < 1024; i += NTHREADS) { const int p = i >> 4;
        const float br = a.in[I_BRE][(size_t)g * 1024 + i], bi = a.in[I_BIM][(size_t)g * 1024 + i];
        Bbr[i] = Zr[p] * br - Zi[p] * bi; Bbi[i] = Zr[p] * bi + Zi[p] * br;
        Cr[i] = a.in[I_CRE][(size_t)g * 1024 + i]; Ci[i] = a.in[I_CIM][(size_t)g * 1024 + i]; }
    if (tid < 64) ((float2*)(F.ws + WS_SMALL + SM_A16))[g * 64 + tid] = make_float2(Apr[16 * 64 + tid], Api[16 * 64 + tid]);
    __syncthreads();
    { const int tau = tid >> 5, c = (tid >> 1) & 15, h8 = (tid & 1) * 8; float acc8[8];
#pragma unroll
      for (int j = 0; j < 8; ++j) acc8[j] = 0.f;
      for (int p = 0; p < 64; ++p) { const float cr = Cr[c * 64 + p], ci = Ci[c * 64 + p], ar = Apr[tau * 64 + p], ai = Api[tau * 64 + p];
          const float car = cr * ar - ci * ai, cai = cr * ai + ci * ar;
          const f32x4 b0 = *(const LAS f32x4*)(Bbr + p * 16 + h8), b1 = *(const LAS f32x4*)(Bbr + p * 16 + h8 + 4), d0 = *(const LAS f32x4*)(Bbi + p * 16 + h8), d1 = *(const LAS f32x4*)(Bbi + p * 16 + h8 + 4);
#pragma unroll
          for (int j = 0; j < 4; ++j) { acc8[j] += car * b0[j] - cai * d0[j]; acc8[4 + j] += car * b1[j] - cai * d1[j]; } }
#pragma unroll
      for (int j = 0; j < 8; ++j) Kt[(tau * 16 + c) * 16 + h8 + j] = acc8[j]; }
    __syncthreads();
    bf16_t* twc = (bf16_t*)(F.ws + WS_TWC) + (size_t)g * 256 * APK;
    for (int ch = tid; ch < 256 * (APK / 8); ch += NTHREADS) { const int n = ch / (APK / 8), k0 = (ch % (APK / 8)) * 8, t = n >> 4, c = n & 15; float v[8];
#pragma unroll
        for (int j = 0; j < 8; ++j) { const int k = k0 + j;
            if (k < 256) { const int s = k >> 4, cp = k & 15; float x = (s <= t) ? Kt[((t - s) * 16 + c) * 16 + cp] : 0.f; if (s == t && cp == c) x += a.in[I_S5D][g * 16 + c]; v[j] = x; }
            else { const int q = k - 256, p = q & 63; const float cr = Cr[c * 64 + p], ci = Ci[c * 64 + p], ar = Apr[(t + 1) * 64 + p], ai = Api[(t + 1) * 64 + p];
                v[j] = (q < 64) ? (cr * ar - ci * ai) : -(cr * ai + ci * ar); } }
        u32x4 o; o.x = pk2(v[0], v[1]); o.y = pk2(v[2], v[3]); o.z = pk2(v[4], v[5]); o.w = pk2(v[6], v[7]);
        *(u32x4*)(twc + (size_t)n * APK + k0) = o; }
    bf16_t* wsm = (bf16_t*)(F.ws + WS_WS5) + (size_t)g * 256 * 256;
    for (int ch = tid; ch < 256 * 32; ch += NTHREADS) { const int n = ch >> 5, k0 = (ch & 31) * 8; float v[8];
#pragma unroll
        for (int j = 0; j < 8; ++j) { const int k = k0 + j, s = k >> 4, cp = k & 15;
            if (n < 128) { const int p = n & 63; const float ar = Apr[(15 - s) * 64 + p], ai = Api[(15 - s) * 64 + p], br = Bbr[p * 16 + cp], bi = Bbi[p * 16 + cp];
                v[j] = (n < 64) ? (ar * br - ai * bi) : (ar * bi + ai * br); } else v[j] = 0.f; }
        u32x4 o; o.x = pk2(v[0], v[1]); o.y = pk2(v[2], v[3]); o.z = pk2(v[4], v[5]); o.w = pk2(v[6], v[7]);
        *(u32x4*)(wsm + (size_t)n * 256 + k0) = o; }
    __syncthreads();
}
__device__ __forceinline__ void rms_row_to_bf16(const float* xrow, const float* gain, bf16_t* orow, int lane) {
    const f32x4* xr = (const f32x4*)xrow + lane; const f32x4* gr = (const f32x4*)gain + lane;
    f32x4 v[8]; float s = 0.f;
#pragma unroll
    for (int j = 0; j < 8; ++j) { v[j] = __builtin_nontemporal_load(xr + 64 * j); s += (v[j].x * v[j].x + v[j].y * v[j].y) + (v[j].z * v[j].z + v[j].w * v[j].w); }
    const float rstd = 1.0f / sqrtf(wave_sum(s) * (1.0f / DM) + EPS);
#if MK_FP8_INPROJ
    unsigned* o4 = (unsigned*)orow + lane; const float rs4 = rstd * FP8_ASCALE;
#pragma unroll
    for (int j = 0; j < 8; ++j) { const f32x4 gg = gr[64 * j]; o4[64 * j] = pk4_fp8(v[j].x * rs4 * gg.x, v[j].y * rs4 * gg.y, v[j].z * rs4 * gg.z, v[j].w * rs4 * gg.w); }
#else
    unsigned long long* o8 = (unsigned long long*)orow + lane;
#pragma unroll
    for (int j = 0; j < 8; ++j) { const f32x4 gg = gr[64 * j];
        o8[64 * j] = (unsigned long long)pk2(v[j].x * rstd * gg.x, v[j].y * rstd * gg.y) | ((unsigned long long)pk2(v[j].z * rstd * gg.z, v[j].w * rstd * gg.w) << 32); }
#endif
}
__device__ __forceinline__ void p0_prologue(const Args& a, const Frame& F) {
    FRAME_IDS(F);
    for (int g = F.bx; g < S5G; g += F.G) s5_build_group(a, F, g);
    __syncthreads();
    const int gw = F.bx * NWAVES + F.wave, NGW = F.G * NWAVES; const int lane = F_lane;
    for (int m = gw; m < TT; m += NGW) rms_row_to_bf16(a.in[I_X] + (size_t)m * DM, a.in[I_N1G], (bf16_t*)(F.ws + WS_H + (size_t)m * DM * (MK_FP8_INPROJ ? 1 : 2)), lane);
    for (int i = gw * 64 + lane; i < TT * 32; i += NGW * 64) { const int t = i >> 5, f = i & 31;
        const double invf = exp(-(double)f * (9.210340371976184 / 32.0)); const double ang = (double)((const int*)a.in[I_POS])[t] * invf;
        ((float2*)(F.ws + WS_ROPE))[i] = make_float2((float)cos(ang), (float)sin(ang)); }
    for (int i = gw * 64 + lane; i < DM * NE; i += NGW * 64) ((float*)(F.ws + WS_SMALL + SM_WRP))[i] = a.in[I_WR][i] * a.in[I_N2G][i >> 5];
    LAS float* scr = (LAS float*)(F.lds + F.wave * 16640);
    constexpr int IT_WIN = (DM / 64) * (NPROJ / 64), IT_WUQ = (QLORA / 64) * (3072 / 64), IT_WUKV = (KVLORA / 64) * (4096 / 64), IT_SQ = (DM / 64) * (DM / 64),
                  IT_GLU = (S5W / 64) * (S5W / 64), IT_OS5 = (S5W / 64) * (DM / 64);
    constexpr int IT_MIX = IT_WIN + IT_WUQ + IT_WUKV + IT_SQ + IT_GLU + IT_OS5 + IT_SQ;
    for (int it = gw; it < IT_MIX; it += NGW) { int r = it;
        if (r < IT_WIN) { const int nb = r % (NPROJ / 64), kb = r / (NPROJ / 64); transpose_item<MK_FP8_INPROJ != 0>(a.in[I_WIN], IN_PROJ, win_src_col(nb * 64), kb * 64, nullptr, F.ws + WS_WIN, DM, nb * 64, MK_FP8_INPROJ ? FP8_WSCALE : 1.f, scr, lane); continue; } r -= IT_WIN;
        if (r < IT_WUQ) { const int nb = r % 48, kb = r / 48; transpose_item<false>(a.in[I_WUQ], 3072, nb * 64, kb * 64, a.in[I_QNG], F.ws + WS_WUQ, QLORA, nb * 64, 1.f, scr, lane); continue; } r -= IT_WUQ;
        if (r < IT_WUKV) { const int nb = r % 64, kb = r / 64; transpose_item<false>(a.in[I_WUKV], 4096, nb * 64, kb * 64, a.in[I_KVNG], F.ws + WS_WUKV, KVLORA, nb * 64, 1.f, scr, lane); continue; } r -= IT_WUKV;
        if (r < IT_SQ) { const int nb = r % 32, kb = r / 32; transpose_item<MK_FP8_YA != 0>(a.in[I_WOMLA], DM, nb * 64, kb * 64, nullptr, F.ws + WS_WOMLA, DM, nb * 64, MK_FP8_YA ? FP8_WSCALE : 1.f, scr, lane); continue; } r -= IT_SQ;
        if (r < IT_GLU) { const int nb = r % 16, kb = r / 16; transpose_item<MK_FP8_GLU != 0>(a.in[I_WGLU], S5W, nb * 64, kb * 64, nullptr, F.ws + WS_WGLU, S5W, nb * 64, MK_FP8_GLU ? FP8_WSCALE : 1.f, scr, lane); continue; } r -= IT_GLU;
        if (r < IT_OS5) { const int nb = r % 32, kb = r / 32; transpose_item<MK_FP8_YB != 0>(a.in[I_WOS5], DM, nb * 64, kb * 64, nullptr, F.ws + WS_WOS5, S5W, nb * 64, MK_FP8_YB ? FP8_WSCALE : 1.f, scr, lane); continue; } r -= IT_OS5;
        { const int nb = r % 32, kb = r / 32; transpose_item<MK_FP8_OUT != 0>(a.in[I_WOUT], DM, nb * 64, kb * 64, nullptr, F.ws + WS_WOUT, DM, nb * 64, MK_FP8_OUT ? FP8_WSCALE : 1.f, scr, lane); }
    }
    constexpr bool W8 = MK_FP8_MOE != 0; constexpr float WSC = W8 ? FP8_WSCALE : 1.0f; constexpr int NPAIR = NE * 3 * 16 * 32; constexpr int NO = W8 ? 4 : 8;
    for (int it = gw; it < NPAIR; it += NGW) { const TItem t = moe_pair<W8>(a, F.ws, it); f32x4 v0[16], v1[16];
        ti_load(t, v0, lane); { TItem t1 = t; t1.src += (size_t)64 * DM; ti_load(t1, v1, lane); }
        u32x4 o0[NO], o1[NO];
        ti_block<W8, NO>(v0, WSC, scr, lane, o0); ti_block<W8, NO>(v1, WSC, scr, lane, o1);
        if constexpr (W8) { const int c = lane & 3;
#pragma unroll
            for (int j = 0; j < 4; ++j) { uchar* d = t.dst + (size_t)((lane >> 2) + 16 * j) * DM + 16 * c; __builtin_nontemporal_store(o0[j], (u32x4*)d); __builtin_nontemporal_store(o1[j], (u32x4*)(d + 64)); }
        } else { const int c = lane & 7;
#pragma unroll
            for (int j = 0; j < 8; ++j) { uchar* d = t.dst + ((size_t)((lane >> 3) + 8 * j) * DM + 8 * c) * 2; *(u32x4*)d = o0[j]; *(u32x4*)(d + 128) = o1[j]; } }
    }
}

constexpr float QSCALE = 0.07216878364870322f * 1.4426950408889634f;
__device__ __forceinline__ float half_sum(float v) {
#pragma unroll
    for (int o = 1; o < 32; o <<= 1) v += __shfl_xor(v, o);
    return v;
}
__device__ __forceinline__ void p3_prep(const Args& a, const Frame& F) {
    FRAME_IDS(F);
    const bf16_t* proj = (const bf16_t*)(F.ws + WS_PROJ); const bf16_t* kvraw = (const bf16_t*)(F.ws + WS_KVRAW); bf16_t* Kn = (bf16_t*)(F.ws + WS_KN);
    const float2* rope = (const float2*)(F.ws + WS_ROPE);
    const int lane = F_lane, grp = lane / 24, ch = lane - grp * 24; const bool act = grp < 2;
    const bool isrope = act && ch >= 16, x2half = isrope && ch >= 20; const int ri = isrope ? ((ch - 16) & 3) * 8 : 0;
    float g[8];
#pragma unroll
    for (int j = 0; j < 8; ++j) g[j] = act ? a.in[I_QKKG][ch * 8 + j] : 0.f;
    const bool even = (TT == 64 * F.G);
    const int tk0 = even ? F.bx * 64 + (F.wave < 2 ? 5 * F.wave : 10 + 9 * (F.wave - 2)) : F.bx * NWAVES + F.wave, tkn = even ? (F.wave < 2 ? 5 : 9) : (TT + F.G * NWAVES - 1) / (F.G * NWAVES), tks = even ? 1 : F.G * NWAVES;
    for (int ti = 0; ti < tkn; ++ti) { const int t = tk0 + ti * tks; if (t >= TT) break;
        const int b = t >> 11, s = t & 2047; const bf16_t* prow = proj + (size_t)t * NPROJ;
        float cs[8], sn[8];
        if (isrope) {
#pragma unroll
            for (int j = 0; j < 8; j += 2) { const f32x4 c2 = *(const f32x4*)(rope + (size_t)t * 32 + ri + j); cs[j] = c2.x; sn[j] = c2.y; cs[j + 1] = c2.z; sn[j + 1] = c2.w; } }
        else {
#pragma unroll
            for (int j = 0; j < 8; ++j) { cs[j] = 1.f; sn[j] = 0.f; } }
        u32x4 kr = (u32x4){0u, 0u, 0u, 0u};
        if (isrope) kr = *(const u32x4*)(prow + C_KR + (ch - 16) * 8);
        u32x4 wl[8];
        { const bf16_t* src0 = kvraw + ((size_t)(b * NH + grp) * SEQ + s) * 128 + (ch & 15) * 8;
#pragma unroll
          for (int i = 0; i < 8; ++i) wl[i] = (!act) ? (u32x4){0u, 0u, 0u, 0u} : (isrope ? kr : *(const u32x4*)(src0 + (size_t)i * 2 * SEQ * 128)); }
#pragma unroll
        for (int i = 0; i < 8; ++i) { const int h = 2 * i + grp; const u32x4 w = wl[i];
            float x[8], ss = 0.f;
#pragma unroll
            for (int q = 0; q < 4; ++q) { x[2 * q] = bflo(w[q]); x[2 * q + 1] = bfhi(w[q]); }
#pragma unroll
            for (int j = 0; j < 8; ++j) ss += x[j] * x[j];
            const float s0 = wave_sum(grp == 0 ? ss : 0.f), s1 = wave_sum(grp == 1 ? ss : 0.f);
            const float rn = 1.0f / sqrtf((grp == 0 ? s0 : s1) * (1.0f / DQK) + EPS);
            float y[8];
#pragma unroll
            for (int j = 0; j < 8; ++j) y[j] = x[j] * rn * g[j];
#pragma unroll
            for (int j = 0; j < 8; ++j) { const float partner = __shfl_xor(y[j], 4); y[j] = x2half ? (y[j] * cs[j] + partner * sn[j]) : (y[j] * cs[j] - partner * sn[j]); }
            if (act) { u32x4 o; o.x = pk2(y[0], y[1]); o.y = pk2(y[2], y[3]); o.z = pk2(y[4], y[5]); o.w = pk2(y[6], y[7]);
                *(u32x4*)(Kn + ((size_t)(b * NH + h) * SEQ + s) * DQK + ch * 8) = o; }
        }
    }
}

__device__ __forceinline__ void p3_scan(const Args& a, const Frame& F) {
    FRAME_IDS(F);
    const float* sch = (const float*)(F.ws + WS_SCH); bf16_t* apack = (bf16_t*)(F.ws + WS_APACK); const float2* A16 = (const float2*)(F.ws + WS_SMALL + SM_A16);
    const int p = F_lane;
    for (int it = F.wave * F.G + F.bx; it < NB * S5G; it += F.G * NWAVES) { const int b = it / S5G, g = it % S5G;
        const float2 am = A16[g * 64 + p]; float xr = 0.f, xi = 0.f;
        const size_t row0 = (size_t)g * NCHUNK + (size_t)b * 128;
        for (int c0 = 0; c0 < 128; c0 += 32) { float sr[32], si[32];
#pragma unroll
            for (int q = 0; q < 32; ++q) { sr[q] = sch[(row0 + c0 + q) * 128 + p]; si[q] = sch[(row0 + c0 + q) * 128 + 64 + p]; }
#pragma unroll
            for (int q = 0; q < 32; ++q) { bf16_t* o = apack + (row0 + c0 + q) * APK + 256; o[p] = (bf16_t)f2bf(xr); o[64 + p] = (bf16_t)f2bf(xi);
                const float nr = am.x * xr - am.y * xi + sr[q], ni = am.x * xi + am.y * xr + si[q]; xr = nr; xi = ni; } }
    }
}

__device__ __forceinline__ void s5_reference(const Args& a, const Frame& F) {
    FRAME_IDS(F);
    const bf16_t* apack = (const bf16_t*)(F.ws + WS_APACK); bf16_t* gact = (bf16_t*)(F.ws + WS_GACT);
    const int gw = F.bx * NWAVES + F.wave, NGW = F.G * NWAVES, p = F_lane;
    for (int it = gw; it < NB * S5G; it += NGW) { const int b = it / S5G, g = it % S5G;
        const float dt = expf(a.in[I_LOGDT][g]); const float lr = a.in[I_LRE][g * 64 + p], li = a.in[I_LIM][g * 64 + p];
        const float mag = expf(lr * dt); const float ar = mag * cosf(li * dt), ai = mag * sinf(li * dt); const float den = lr * lr + li * li;
        const float zr = ((ar - 1.0f) * lr + ai * li) / den, zi = (ai * lr - (ar - 1.0f) * li) / den;
        float bbr[16], bbi[16], cr[16], ci[16];
#pragma unroll
        for (int c = 0; c < 16; ++c) { const float br = a.in[I_BRE][((size_t)g * 64 + p) * 16 + c], bi = a.in[I_BIM][((size_t)g * 64 + p) * 16 + c];
            bbr[c] = zr * br - zi * bi; bbi[c] = zr * bi + zi * br; cr[c] = a.in[I_CRE][((size_t)g * 16 + c) * 64 + p]; ci[c] = a.in[I_CIM][((size_t)g * 16 + c) * 64 + p]; }
        const float dl = (p < 16) ? a.in[I_S5D][g * 16 + p] : 0.f;
        float xr = 0.f, xi = 0.f;
        for (int t = 0; t < SEQ; ++t) { const int tok = b * SEQ + t;
            const bf16_t* up = apack + ((size_t)g * NCHUNK + (tok >> 4)) * APK + (tok & 15) * 16;
            const u32x4 w0 = *(const u32x4*)up, w1 = *(const u32x4*)(up + 8); float u[16];
#pragma unroll
            for (int q = 0; q < 4; ++q) { u[2 * q] = bflo(w0[q]); u[2 * q + 1] = bfhi(w0[q]); u[8 + 2 * q] = bflo(w1[q]); u[8 + 2 * q + 1] = bfhi(w1[q]); }
            float br = 0.f, bi = 0.f;
#pragma unroll
            for (int c = 0; c < 16; ++c) { br += bbr[c] * u[c]; bi += bbi[c] * u[c]; }
            const float nr = ar * xr - ai * xi + br, ni = ar * xi + ai * xr + bi; xr = nr; xi = ni;
            float y = 0.f, um = 0.f;
#pragma unroll
            for (int c = 0; c < 16; ++c) { const float yc = wave_sum(cr[c] * xr - ci[c] * xi); if (p == c) { y = yc; um = u[c]; } }
            if (p < 16) gact[(size_t)tok * S5W + g * 16 + p] = (bf16_t)f2bf(gelu_tanh(y + dl * um));
        }
    }
}

__device__ __forceinline__ float attn_bound(const Args& a, int lane) {
    float mq = 0.f, mk = 0.f;
#pragma unroll
    for (int q = 0; q < 3; ++q) { mq = fmaxf(mq, fabsf(a.in[I_QKQG][lane + 64 * q])); mk = fmaxf(mk, fabsf(a.in[I_QKKG][lane + 64 * q])); }
#pragma unroll
    for (int o = 1; o < 64; o <<= 1) { mq = fmaxf(mq, __shfl_xor(mq, o)); mk = fmaxf(mk, __shfl_xor(mk, o)); }
    return mq * mk * 13.856406460551018f * 1.4426950408889634f;
}
__device__ __forceinline__ void attn_reference(const Args& a, const Frame& F) {
    FRAME_IDS(F);
    const bf16_t* Qn = (const bf16_t*)(F.ws + WS_QN); const bf16_t* Kn = (const bf16_t*)(F.ws + WS_KN); const bf16_t* Vn = (const bf16_t*)(F.ws + WS_VN);
    bf16_t* O = (bf16_t*)(F.ws + WS_O);
    LAS float* ql = (LAS float*)(F.lds + F.wave * 1024);
    const int lane = F_lane, gw = F.bx * NWAVES + F.wave, NGW = F.G * NWAVES;
    const float Mb = attn_bound(a, lane);
    for (int it = gw; it < NB * NH * SEQ; it += NGW) { const int s = it & 2047, bh = it >> 11, b = bh >> 4, h = bh & 15;
        const bf16_t* qp = Qn + ((size_t)bh * SEQ + s) * DQK;
#pragma unroll
        for (int q = 0; q < 3; ++q) ql[lane + 64 * q] = bf2f(qp[lane + 64 * q]);
        LDS_WAIT();
        const int nk = 64 * ((s >> 6) + 1);
        float o0 = 0.f, o1 = 0.f, l = 0.f;
        for (int k0 = 0; k0 < nk; k0 += 64) {
            const bf16_t* kp = Kn + ((size_t)bh * SEQ + k0 + lane) * DQK; float sc = 0.f;
            for (int d = 0; d < DQK; d += 8) { const u32x4 w = *(const u32x4*)(kp + d);
#pragma unroll
                for (int q = 0; q < 4; ++q) sc += bflo(w[q]) * ql[d + 2 * q] + bfhi(w[q]) * ql[d + 2 * q + 1]; }
            const float pr = __builtin_amdgcn_exp2f(sc - Mb); l += pr;
            for (int kk = 0; kk < 64; ++kk) { const float pk = __shfl(pr, kk); const unsigned w = *(const unsigned*)(Vn + ((size_t)bh * SEQ + k0 + kk) * DV + 2 * lane);
                o0 += pk * bflo(w); o1 += pk * bfhi(w); }
        }
        l = wave_sum(l); const float rl = 1.0f / l;
        *(unsigned*)(O + ((size_t)(b * SEQ + s)) * DM + h * DV + 2 * lane) = pk2(o0 * rl, o1 * rl);
        LDS_WAIT();
    }
}

namespace at {
constexpr int KVB = 64;
constexpr int SHM_V = KVB * DV * 2  , SHM_K = KVB * DQK * 2  ;
constexpr int NQR = 4;
constexpr int OFF_V = 0, OFF_K = 2 * SHM_V, OFF_WS = OFF_K + 2 * SHM_K  , OFF_QL = OFF_WS + NWAVES * 256  , OFF_OST = 0;
constexpr int OPITCH = 272;
static_assert(OFF_QL + NWAVES * (12 - NQR) * 1024 <= LDSCTL_OFF, "attention LDS map");
#define KSWZ(row, colB) ((row) * 384 + ((colB) ^ ((((row) >> 1) & 7) << 4)))
__device__ __forceinline__ int crow(int r, int hi) { return (r & 3) + 8 * (r >> 2) + 4 * hi; }
__device__ __forceinline__ int v_st(int k, int c) { const int kk = (k & ~0xC) | ((k & 4) << 1) | ((k & 8) >> 1); return ((kk >> 3) * 4 + (c >> 5)) * 512 + ((kk & 7) * 32 + (c & 31)) * 2; }
__device__ __forceinline__ int v_rd_base(int lane) { return ((lane & 3) << 3) | (((lane >> 2) & 3) << 6) | (((lane >> 4) & 1) << 5) | (((lane >> 5) & 1) << 8); }
constexpr int v_rd_off(int d0, int ks, int half) { return d0 * 512 + ks * 4096 + half * 2048; }
template <int OFF> __device__ __forceinline__ s16x4 tr_read(int vb) { s16x4 r; asm volatile("ds_read_b64_tr_b16 %0, %1 offset:%2" : "=&v"(r) : "v"(vb), "i"(OFF) : "memory"); return r; }
template <int D0> __device__ __forceinline__ void pv_one(f32x16& od, int vb, bf16x8 pa0, bf16x8 pa1, bf16x8 pa2, bf16x8 pa3) {
    const s16x4 l0 = tr_read<v_rd_off(D0, 0, 0)>(vb), h0 = tr_read<v_rd_off(D0, 0, 1)>(vb), l1 = tr_read<v_rd_off(D0, 1, 0)>(vb), h1 = tr_read<v_rd_off(D0, 1, 1)>(vb);
    const s16x4 l2 = tr_read<v_rd_off(D0, 2, 0)>(vb), h2 = tr_read<v_rd_off(D0, 2, 1)>(vb), l3 = tr_read<v_rd_off(D0, 3, 0)>(vb), h3 = tr_read<v_rd_off(D0, 3, 1)>(vb);
    asm volatile("s_waitcnt lgkmcnt(0)" ::: "memory"); SBAR();
#define PK(L, H) (bf16x8){L[0], L[1], L[2], L[3], H[0], H[1], H[2], H[3]}
    od = __builtin_amdgcn_mfma_f32_32x32x16_bf16(pa0, PK(l0, h0), od, 0, 0, 0);
    od = __builtin_amdgcn_mfma_f32_32x32x16_bf16(pa1, PK(l1, h1), od, 0, 0, 0);
    od = __builtin_amdgcn_mfma_f32_32x32x16_bf16(pa2, PK(l2, h2), od, 0, 0, 0);
    od = __builtin_amdgcn_mfma_f32_32x32x16_bf16(pa3, PK(l3, h3), od, 0, 0, 0);
#undef PK
}
__device__ __forceinline__ void pv_d0(f32x16* o, int vb, bf16x8 pa0, bf16x8 pa1, bf16x8 pa2, bf16x8 pa3) {
    pv_one<0>(o[0], vb, pa0, pa1, pa2, pa3); pv_one<1>(o[1], vb, pa0, pa1, pa2, pa3); pv_one<2>(o[2], vb, pa0, pa1, pa2, pa3); pv_one<3>(o[3], vb, pa0, pa1, pa2, pa3);
}
template <int BUF, int NQR> __device__ __forceinline__ void qkt(f32x16& p0, f32x16& p1, const int (&kb)[4], const bf16x8* qr, int qlb, float bias) {
#pragma unroll
    for (int r = 0; r < 16; ++r) { p0[r] = bias; p1[r] = bias; }
#pragma unroll
    for (int a = 0; a < 3; ++a)
#pragma unroll
        for (int b = 0; b < 4; ++b) { const int d0 = 4 * a + b;
            const bf16x8 b0 = *(const LAS bf16x8*)(kb[b] + BUF * SHM_K + a * 128);
            const bf16x8 b1 = *(const LAS bf16x8*)(kb[b] + BUF * SHM_K + a * 128 + 32 * 384);
            bf16x8 q; if (d0 < NQR) q = qr[d0]; else q = *(const LAS bf16x8*)(qlb + (d0 - NQR) * 1024);
            p0 = __builtin_amdgcn_mfma_f32_32x32x16_bf16(b0, q, p0, 0, 0, 0);
            p1 = __builtin_amdgcn_mfma_f32_32x32x16_bf16(b1, q, p1, 0, 0, 0); }
}
__device__ __forceinline__ void partialSM(f32x16& p0, f32x16& p1) {
#pragma unroll
    for (int r = 0; r < 16; ++r) p0[r] = __builtin_amdgcn_exp2f(p0[r]);
}
__device__ __forceinline__ void finishSM(f32x16& p0, f32x16& p1, float& l_reg, bf16x8& pa0, bf16x8& pa1, bf16x8& pa2, bf16x8& pa3) {
#pragma unroll
    for (int r = 0; r < 16; ++r) p1[r] = __builtin_amdgcn_exp2f(p1[r]);
    float ps = 0;
#pragma unroll
    for (int r = 0; r < 16; ++r) ps += p0[r];
#pragma unroll
    for (int r = 0; r < 16; ++r) ps += p1[r];
    { auto rr = __builtin_amdgcn_permlane32_swap(__float_as_uint(ps), __float_as_uint(ps), false, false); ps = __uint_as_float(rr[0]) + __uint_as_float(rr[1]); }
    l_reg += ps;
#define PK4(P, BASE, OUT) do { unsigned a0 = cvt_pk_bf16(P[BASE + 0], P[BASE + 1]), a1 = cvt_pk_bf16(P[BASE + 2], P[BASE + 3]);   \
    unsigned b0 = cvt_pk_bf16(P[BASE + 4], P[BASE + 5]), b1 = cvt_pk_bf16(P[BASE + 6], P[BASE + 7]);                              \
    auto r0 = __builtin_amdgcn_permlane32_swap(a0, b0, false, false); auto r1 = __builtin_amdgcn_permlane32_swap(a1, b1, false, false); \
    u32x4 w = {r0[0], r1[0], r0[1], r1[1]}; OUT = *reinterpret_cast<bf16x8*>(&w); } while (0)
    PK4(p0, 0, pa0); PK4(p0, 8, pa1); PK4(p1, 0, pa2); PK4(p1, 8, pa3);
#undef PK4
}
__device__ __forceinline__ void attn_qblock(const bf16_t* __restrict__ Qb, const bf16_t* __restrict__ Kh, const bf16_t* __restrict__ Vh, bf16_t* __restrict__ Ob, int qb, float Mb, LAS char* lds, const int wid,
                                            const float2* __restrict__ ropeb, const float* __restrict__ gq) {
    const int lane = fresh_lane(), tid = wid * 64 + lane, r32 = lane & 31, hi = lane >> 5;
    LAS char* V_lds = lds + OFF_V; LAS char* K_lds = lds + OFF_K;
    LAS float* li_l = (LAS float*)(lds + OFF_WS) + wid * 64;
    float l_reg = 0; f32x16 o[4] = {}; bf16x8 qr[NQR];
    const int qlb = (int)(uintptr_t)(lds + OFF_QL) + wid * ((12 - NQR) * 1024) + lane * 16;
    {
        const bf16_t* Qw = Qb + (size_t)(wid * 32 + r32) * (NH * DQK) + hi * 8;
        bf16x8 qf[12];
#pragma unroll
        for (int d0 = 0; d0 < 12; ++d0) qf[d0] = *(const bf16x8*)(Qw + d0 * 16);
        float ssq = 0.f;
#pragma unroll
        for (int d0 = 0; d0 < 12; ++d0)
#pragma unroll
            for (int j = 0; j < 8; ++j) { const float v = bf2f((unsigned short)qf[d0][j]); ssq += v * v; }
        ssq += __shfl_xor(ssq, 32);
        const float rn = QSCALE / sqrtf(ssq * (1.0f / DQK) + EPS);
        const float2* rp = ropeb + (size_t)(wid * 32 + r32) * 32 + hi * 8;
#pragma unroll
        for (int d0 = 0; d0 < 12; ++d0) { bf16x8 qn;
            if (d0 < 8) { const f32x4 g0 = *(const f32x4*)(gq + d0 * 16 + hi * 8), g1 = *(const f32x4*)(gq + d0 * 16 + hi * 8 + 4);
#pragma unroll
                for (int j = 0; j < 8; ++j) qn[j] = (short)f2bf(bf2f((unsigned short)qf[d0][j]) * rn * (j < 4 ? g0[j] : g1[j - 4])); }
            else { const int pp = (d0 - 8) & 1, da = 8 + pp, db = 10 + pp; const bool second = d0 >= 10;
#pragma unroll
                for (int j = 0; j < 8; ++j) { const float2 c = rp[pp * 16 + j];
                    const float y1 = bf2f((unsigned short)qf[da][j]) * rn * gq[128 + pp * 16 + hi * 8 + j], y2 = bf2f((unsigned short)qf[db][j]) * rn * gq[160 + pp * 16 + hi * 8 + j];
                    qn[j] = (short)f2bf(second ? (y2 * c.x + y1 * c.y) : (y1 * c.x - y2 * c.y)); } }
            if (d0 < NQR) qr[d0] = qn; else *(LAS bf16x8*)(qlb + (d0 - NQR) * 1024) = qn; }
    }
    const int sr = tid >> 4, sc = (tid & 15) * 8, vst0 = v_st(sr, sc), vst1 = v_st(32 + sr, sc);
    int kro[3], kst[3];
#pragma unroll
    for (int i = 0; i < 3; ++i) { const int q = tid + 512 * i, row = q / 24, c8 = q % 24; kro[i] = row * DQK + c8 * 8; kst[i] = KSWZ(row, c8 * 16); }
    const int vb0 = (int)(uintptr_t)V_lds + v_rd_base(lane);
    int kb[4];
#pragma unroll
    for (int b = 0; b < 4; ++b) kb[b] = (int)(uintptr_t)K_lds + r32 * 384 + ((b * 32 + hi * 16) ^ (((r32 >> 1) & 7) << 4));
    bf16x8 vs0, vs1, ks0, ks1, ks2;
#define SLOAD(k0) do { vs0 = *(const bf16x8*)(Vh + (size_t)((k0) + sr) * DV + sc); vs1 = *(const bf16x8*)(Vh + (size_t)((k0) + 32 + sr) * DV + sc); \
    ks0 = *(const bf16x8*)(Kh + (size_t)(k0) * DQK + kro[0]); ks1 = *(const bf16x8*)(Kh + (size_t)(k0) * DQK + kro[1]); ks2 = *(const bf16x8*)(Kh + (size_t)(k0) * DQK + kro[2]); } while (0)
#define SWRITE(b) do { *(LAS bf16x8*)(V_lds + (b) * SHM_V + vst0) = vs0; *(LAS bf16x8*)(V_lds + (b) * SHM_V + vst1) = vs1; \
    *(LAS bf16x8*)(K_lds + (b) * SHM_K + kst[0]) = ks0; *(LAS bf16x8*)(K_lds + (b) * SHM_K + kst[1]) = ks1; *(LAS bf16x8*)(K_lds + (b) * SHM_K + kst[2]) = ks2; } while (0)
    const int NT = 4 * qb + 4, jmax = 4 * qb + (wid >> 1);
    f32x16 pA0, pA1, pB0, pB1; bf16x8 pa0, pa1, pa2, pa3;
    SLOAD(0); asm volatile("s_waitcnt vmcnt(0)" ::: "memory"); SWRITE(0); __syncthreads();
    qkt<0, NQR>(pA0, pA1, kb, qr, qlb, -Mb); partialSM(pA0, pA1);
    SLOAD(KVB); asm volatile("s_waitcnt vmcnt(0)" ::: "memory"); SWRITE(1); __syncthreads();
    for (int j = 1; j + 1 < NT; j += 2) {
        SBAR(); if (j <= jmax) qkt<1, NQR>(pB0, pB1, kb, qr, qlb, -Mb);
        if (j - 1 <= jmax) finishSM(pA0, pA1, l_reg, pa0, pa1, pa2, pa3); SBAR();
        SLOAD((j + 1) * KVB); SBAR();
        if (j - 1 <= jmax) pv_d0(o, vb0, pa0, pa1, pa2, pa3); if (j <= jmax) partialSM(pB0, pB1);
        __syncthreads(); asm volatile("s_waitcnt vmcnt(0)" ::: "memory"); SWRITE(0);
        __syncthreads();
        SBAR(); if (j + 1 <= jmax) qkt<0, NQR>(pA0, pA1, kb, qr, qlb, -Mb);
        if (j <= jmax) finishSM(pB0, pB1, l_reg, pa0, pa1, pa2, pa3); SBAR();
        SLOAD((j + 2) * KVB); SBAR();
        if (j <= jmax) pv_d0(o, vb0 + SHM_V, pa0, pa1, pa2, pa3); if (j + 1 <= jmax) partialSM(pA0, pA1);
        __syncthreads(); asm volatile("s_waitcnt vmcnt(0)" ::: "memory"); SWRITE(1);
        __syncthreads();
    }
    SBAR(); if (NT - 1 <= jmax) qkt<1, NQR>(pB0, pB1, kb, qr, qlb, -Mb);
    if (NT - 2 <= jmax) { finishSM(pA0, pA1, l_reg, pa0, pa1, pa2, pa3); SBAR(); pv_d0(o, vb0, pa0, pa1, pa2, pa3); }
    if (NT - 1 <= jmax) { partialSM(pB0, pB1); finishSM(pB0, pB1, l_reg, pa0, pa1, pa2, pa3); SBAR(); pv_d0(o, vb0 + SHM_V, pa0, pa1, pa2, pa3); }
    __syncthreads();
    const int lane2 = fresh_lane(), r32b = lane2 & 31, hib = lane2 >> 5, wid2 = wid;
    LAS float* li2 = (LAS float*)(lds + OFF_WS) + wid2 * 64;
    if (hib == 0) li2[r32b] = l_reg; LDS_WAIT();
    LAS char* ost = lds + OFF_OST + wid2 * (32 * OPITCH) + hib * (4 * OPITCH) + r32b * 2;
#pragma unroll
    for (int r = 0; r < 16; ++r) { const int orc = (r & 3) + 8 * (r >> 2); const float rl = __builtin_amdgcn_rcpf(li2[orc + 4 * hib]);
#pragma unroll
        for (int d0 = 0; d0 < 4; ++d0) *(LAS bf16_t*)(ost + orc * OPITCH + d0 * 64) = (bf16_t)f2bf(o[d0][r] * rl); }
    LDS_WAIT();
    const LAS char* ord = lds + OFF_OST + wid2 * (32 * OPITCH) + (lane2 >> 4) * OPITCH + (lane2 & 15) * 16;
#if MK_FP8_YA
    uchar* Ow = (uchar*)Ob + (size_t)(wid2 * 32 + (lane2 >> 4)) * DM + (lane2 & 15) * 8;
#pragma unroll
    for (int i = 0; i < 8; ++i) { const u32x4 w = *(const LAS u32x4*)(ord + i * 4 * OPITCH); u32x2 o8;
        o8.x = pk4_fp8c(bflo(w.x) * FP8_XSCALE, bfhi(w.x) * FP8_XSCALE, bflo(w.y) * FP8_XSCALE, bfhi(w.y) * FP8_XSCALE); o8.y = pk4_fp8c(bflo(w.z) * FP8_XSCALE, bfhi(w.z) * FP8_XSCALE, bflo(w.w) * FP8_XSCALE, bfhi(w.w) * FP8_XSCALE);
        *(u32x2*)(Ow + (size_t)(i * 4) * DM) = o8; }
#else
    bf16_t* Ow = Ob + (size_t)(wid2 * 32 + (lane2 >> 4)) * DM + (lane2 & 15) * 8;
#pragma unroll
    for (int i = 0; i < 8; ++i) { const u32x4 w = *(const LAS u32x4*)(ord + i * 4 * OPITCH); *(u32x4*)(Ow + (size_t)(i * 4) * DM) = w; }
#endif
    __syncthreads();
#undef SLOAD
#undef SWRITE
}
#undef KSWZ
}
__device__ __forceinline__ void p4_attention(const Args& a, const Frame& F) {
    FRAME_IDS(F);
    const bf16_t* qraw = (const bf16_t*)(F.ws + WS_QRAW); const bf16_t* Kn = (const bf16_t*)(F.ws + WS_KN); const bf16_t* Vn = (const bf16_t*)(F.ws + WS_VN);
    bf16_t* O = (bf16_t*)(F.ws + WS_O); const float2* rope = (const float2*)(F.ws + WS_ROPE);
    const float Mb = attn_bound(a, F_lane);
    for (int id = F.bx; id < NB * NH * 4; id += F.G) { const int x = id & 7, idx = id >> 3, bh = x + 8 * (idx >> 2), pr = idx & 3, b = bh >> 4, h = bh & 15;
        const bf16_t* Kh = Kn + (size_t)bh * SEQ * DQK; const bf16_t* Vh = Vn + (size_t)bh * SEQ * DV;
#pragma unroll 1
        for (int w = 0; w < 2; ++w) { const int qb = w ? pr : 7 - pr; const size_t tok0 = (size_t)b * SEQ + qb * 256;
            at::attn_qblock(qraw + tok0 * (NH * DQK) + h * DQK, Kh, Vh, (bf16_t*)((uchar*)O + (tok0 * DM + h * DV) * (MK_FP8_YA ? 1 : 2)), qb, Mb, (LAS char*)F.lds, F.wave, rope + tok0 * 32, a.in[I_QKQG]); }
    }
}

__device__ __forceinline__ void p8_norm2_router(const Args& a, const Frame& F, const float* x1) {
    FRAME_IDS(F);
    bf16_t* H2 = (bf16_t*)(F.ws + WS_H2); int* topi = (int*)(F.ws + WS_TOPI); float* topw = (float*)(F.ws + WS_TOPW);
    const float* wrp = (const float*)(F.ws + WS_SMALL + SM_WRP); const float* g2 = a.in[I_N2G];
    const int lane = F_lane, wave = F.wave, tid = F_tid, i = lane & 31, kk = lane >> 5;
    LAS uchar* xs = F.lds + wave * 8704;
    LAS float* part = (LAS float*)(F.lds + 69632);
    LAS float* ssqp = (LAS float*)(F.lds + 69632 + 33792);
    LAS float* logit = ssqp + 256;
    LAS float* rstdl = logit + 32 * 33;
    for (int tile = F.bx; tile < TT / 32; tile += F.G) {
        const int t0 = tile * 32;
        f32x16 acc = {}; float ssq = 0.f;
        for (int ch = 0; ch < 4; ++ch) { const int k0 = wave * 256 + ch * 64;
            f32x4 v[8];
#pragma unroll
            for (int j = 0; j < 8; ++j) {
#if MK_X1_BF16
                const u32x2 w = *(const u32x2*)((const bf16_t*)x1 + (size_t)(t0 + 4 * j + (lane >> 4)) * DM + k0 + (lane & 15) * 4); v[j] = (f32x4){bflo(w.x), bfhi(w.x), bflo(w.y), bfhi(w.y)};
#else
                v[j] = *(const f32x4*)(x1 + (size_t)(t0 + 4 * j + (lane >> 4)) * DM + k0 + (lane & 15) * 4);
#endif
            }
#pragma unroll
            for (int j = 0; j < 8; ++j) *(LAS f32x4*)(xs + (4 * j + (lane >> 4)) * 272 + (lane & 15) * 16) = v[j];
            LDS_WAIT(); asm volatile("" ::: "memory");
            const float* wp = wrp + (size_t)(k0 + kk * 32) * NE + i;
#pragma unroll
            for (int s4 = 0; s4 < 8; ++s4) { const f32x4 xv = *(const LAS f32x4*)(xs + i * 272 + kk * 128 + s4 * 16);
#pragma unroll
                for (int q = 0; q < 4; ++q) { const float b = wp[(s4 * 4 + q) * NE]; acc = __builtin_amdgcn_mfma_f32_32x32x2f32(xv[q], b, acc, 0, 0, 0); ssq += xv[q] * xv[q]; } }
            LDS_WAIT(); asm volatile("" ::: "memory");
        }
#pragma unroll
        for (int r = 0; r < 16; ++r) part[(wave * 32 + (r & 3) + 8 * (r >> 2) + 4 * kk) * 33 + i] = acc[r];
        ssq += __shfl_xor(ssq, 32);
        if (kk == 0) ssqp[wave * 32 + i] = ssq;
        __syncthreads();
        { const int row = tid >> 4, e0 = (tid & 15) * 2; float s0 = 0.f, s1 = 0.f;
#pragma unroll
          for (int w = 0; w < 8; ++w) { s0 += part[(w * 32 + row) * 33 + e0]; s1 += part[(w * 32 + row) * 33 + e0 + 1]; }
          logit[row * 33 + e0] = s0; logit[row * 33 + e0 + 1] = s1;
          if (tid < 32) { float q = 0.f;
#pragma unroll
              for (int w = 0; w < 8; ++w) q += ssqp[w * 32 + tid];
              rstdl[tid] = 1.0f / sqrtf(q * (1.0f / DM) + EPS); } }
        __syncthreads();
        if (tid < 32) { const float rs = rstdl[tid]; float lg[32];
#pragma unroll
            for (int e = 0; e < 32; ++e) lg[e] = logit[tid * 33 + e] * rs + a.in[I_BR][e];
            int bi[4]; float bv[4];
#pragma unroll
            for (int k = 0; k < 4; ++k) { float m = -3.0e38f; int mi = 0;
#pragma unroll
                for (int e = 0; e < 32; ++e) { const bool used = (k > 0 && bi[0] == e) || (k > 1 && bi[1] == e) || (k > 2 && bi[2] == e); if (!used && lg[e] > m) { m = lg[e]; mi = e; } }
                bi[k] = mi; bv[k] = m; }
            const float e1 = __expf(bv[1] - bv[0]), e2 = __expf(bv[2] - bv[0]), e3 = __expf(bv[3] - bv[0]); const float rsum = 1.0f / (1.0f + e1 + e2 + e3);
            const int t = t0 + tid;
            *(int4*)(topi + 4 * t) = make_int4(bi[0], bi[1], bi[2], bi[3]); *(float4*)(topw + 4 * t) = make_float4(rsum, e1 * rsum, e2 * rsum, e3 * rsum); }
#pragma unroll 4
        for (int it = 0; it < 16; ++it) { const int idx = it * NTHREADS + tid, row = idx >> 8, c8 = (idx & 255) * 8; const float rs = rstdl[row];
#if MK_X1_BF16
            const u32x4 xq = *(const u32x4*)((const bf16_t*)x1 + (size_t)(t0 + row) * DM + c8); const f32x4 x0 = {bflo(xq.x), bfhi(xq.x), bflo(xq.y), bfhi(xq.y)}, x1v = {bflo(xq.z), bfhi(xq.z), bflo(xq.w), bfhi(xq.w)};
#else
            const f32x4 x0 = *(const f32x4*)(x1 + (size_t)(t0 + row) * DM + c8), x1v = *(const f32x4*)(x1 + (size_t)(t0 + row) * DM + c8 + 4);
#endif
            const f32x4 g0 = *(const f32x4*)(g2 + c8), g1 = *(const f32x4*)(g2 + c8 + 4);
#if MK_FP8_MOE
            const float rs4 = rs * FP8_ASCALE; u32x2 o; o.x = pk4_fp8(x0.x * rs4 * g0.x, x0.y * rs4 * g0.y, x0.z * rs4 * g0.z, x0.w * rs4 * g0.w); o.y = pk4_fp8(x1v.x * rs4 * g1.x, x1v.y * rs4 * g1.y, x1v.z * rs4 * g1.z, x1v.w * rs4 * g1.w);
            *(u32x2*)((uchar*)H2 + (size_t)(t0 + row) * DM + c8) = o; }
#else
            u32x4 o; o.x = pk2(x0.x * rs * g0.x, x0.y * rs * g0.y); o.y = pk2(x0.z * rs * g0.z, x0.w * rs * g0.w); o.z = pk2(x1v.x * rs * g1.x, x1v.y * rs * g1.y); o.w = pk2(x1v.z * rs * g1.z, x1v.w * rs * g1.w);
            *(u32x4*)(H2 + (size_t)(t0 + row) * DM + c8) = o; }
#endif
        __syncthreads();
    }
}

__device__ __forceinline__ void p9_routing(const Args& a, const Frame& F) {
    FRAME_IDS(F);
    const int* topi = (const int*)(F.ws + WS_TOPI); int* tpos = (int*)(F.ws + WS_TPOS); int* list = (int*)(F.ws + WS_LIST); int* counts = (int*)(F.ws + WS_SMALL + SM_COUNTS);
    LAS int* wtot = (LAS int*)F.lds;
    constexpr int NIT = TT / NWAVES / 64;
    for (int e = F.bx; e < NE; e += F.G) {
        __syncthreads();
        const int t0 = F.wave * (TT / NWAVES);
        int kk[NIT];
#pragma unroll
        for (int i = 0; i < NIT; ++i) { const int4 ti = *(const int4*)(topi + 4 * (t0 + i * 64 + F_lane)); kk[i] = (ti.x == e) ? 0 : (ti.y == e) ? 1 : (ti.z == e) ? 2 : (ti.w == e) ? 3 : -1; }
        int cnt = 0;
#pragma unroll
        for (int i = 0; i < NIT; ++i) cnt += __popcll(__ballot(kk[i] >= 0));
        if (F_lane == 0) wtot[F.wave] = cnt;
        __syncthreads();
        int base = 0, total = 0;
        for (int w = 0; w < NWAVES; ++w) { const int c = wtot[w]; if (w < F.wave) base += c; total += c; }
#pragma unroll
        for (int i = 0; i < NIT; ++i) { const int t = t0 + i * 64 + F_lane; const int k = kk[i];
            const unsigned long long bal = __ballot(k >= 0); const int pos = base + __popcll(bal & ((1ull << F_lane) - 1ull));
            if (k >= 0) { list[(size_t)e * TT + pos] = t; tpos[4 * t + k] = pos; }
            base += __popcll(bal); }
        for (int q = total + F_tid; q < ((total + 255) & ~255); q += NTHREADS) list[(size_t)e * TT + q] = 0;
        if (F_tid == 0) counts[e] = total;
    }
}
__device__ __forceinline__ void moe_tables(const Frame& F, LAS int* tab) {
    FRAME_IDS(F);
    const int* counts = (const int*)(F.ws + WS_SMALL + SM_COUNTS);
    __syncthreads();
    if (F_tid < NE) { const int c = counts[F_tid]; tab[F_tid] = c; const int nt = (c + 255) >> 8; tab[32 + F_tid] = nt; tab[128 + F_tid] = nt > 0 ? ((1 << 20) + nt - 1) / nt : 0; }
    __syncthreads();
    if (F_tid < NE) { const int e = F_tid, me = tab[32 + e]; int pre = 0, rank = 0;
        for (int q = 0; q < NE; ++q) { const int v = tab[32 + q]; pre += (q < e) ? v : 0; rank += (v > me || (v == me && q < e)) ? 1 : 0; }
        tab[64 + e] = pre; if (e == NE - 1) tab[96] = pre + me;
        const int q4 = rank >> 3, pos = rank & 7, xx = (q4 & 1) ? 7 - pos : pos; tab[160 + xx * 4 + q4] = e; }
    __syncthreads();
}

__device__ __forceinline__ void p10_permute(const Args& a, const Frame& F, const LAS int* tab) {
    FRAME_IDS(F);
    constexpr size_t ROWB = MK_FP8_MOE ? DM : 2 * DM;
    const uchar* H2 = F.ws + WS_H2; uchar* XP = F.ws + WS_XPERM; const int* list = (const int*)(F.ws + WS_LIST);
    const int ntiles = tab[96];
    for (int tile = F.bx; tile < ntiles; tile += F.G) {
        int e = 0;
#pragma unroll 1
        for (int q = 1; q < NE; ++q) if (tab[64 + q] <= tile) e = q;
        const int p0 = (tile - tab[64 + e]) * 256;
        for (int r0 = F.wave * 32; r0 < F.wave * 32 + 32; r0 += 8) { int tok[8]; u32x4 v[8][ROWB / 1024];
#pragma unroll
            for (int q = 0; q < 8; ++q) tok[q] = list[(size_t)e * TT + p0 + r0 + q];
#pragma unroll
            for (int q = 0; q < 8; ++q)
#pragma unroll
                for (int c = 0; c < (int)(ROWB / 1024); ++c) v[q][c] = *(const u32x4*)(H2 + (size_t)tok[q] * ROWB + c * 1024 + F_lane * 16);
#pragma unroll
            for (int q = 0; q < 8; ++q)
#pragma unroll
                for (int c = 0; c < (int)(ROWB / 1024); ++c) *(u32x4*)(XP + ((size_t)tile * 256 + r0 + q) * ROWB + c * 1024 + F_lane * 16) = v[q][c]; }
    }
}

__device__ __forceinline__ void p12_combine(const Args& a, const Frame& F, float* out, const LAS int* tab) {
    FRAME_IDS(F);
    const int* topi = (const int*)(F.ws + WS_TOPI); const float* topw = (const float*)(F.ws + WS_TOPW); const int* tpos = (const int*)(F.ws + WS_TPOS);
    const int lane = F_lane, gw = F.bx * NWAVES + F.wave, NGW = F.G * NWAVES;
#if MK_FP8_MOE
    const uchar* ys = F.ws + WS_YSLOT;
    for (int t = gw; t < TT; t += NGW) {
        const int4 ti = *(const int4*)(topi + 4 * t), tp = *(const int4*)(tpos + 4 * t); float4 tw = *(const float4*)(topw + 4 * t);
        tw.x *= 1.0f / FP8_YSCALE; tw.y *= 1.0f / FP8_YSCALE; tw.z *= 1.0f / FP8_YSCALE; tw.w *= 1.0f / FP8_YSCALE;
        const uchar* r0 = ys + ((size_t)tab[64 + ti.x] * 256 + tp.x) * DM; const uchar* r1 = ys + ((size_t)tab[64 + ti.y] * 256 + tp.y) * DM;
        const uchar* r2 = ys + ((size_t)tab[64 + ti.z] * 256 + tp.z) * DM; const uchar* r3 = ys + ((size_t)tab[64 + ti.w] * 256 + tp.w) * DM;
        float* orow = out + (size_t)t * DM;
        u32x2 y0[4], y1[4], y2[4], y3[4]; f32x4 xa[4], xb[4];
#pragma unroll
        for (int j = 0; j < 4; ++j) { const int c = j * 512 + lane * 8; y0[j] = *(const u32x2*)(r0 + c); y1[j] = *(const u32x2*)(r1 + c); y2[j] = *(const u32x2*)(r2 + c); y3[j] = *(const u32x2*)(r3 + c);
#if MK_X1_BF16
            const u32x4 xq = *(const u32x4*)((const bf16_t*)(F.ws + WS_X1) + (size_t)t * DM + c); xa[j] = (f32x4){bflo(xq.x), bfhi(xq.x), bflo(xq.y), bfhi(xq.y)}; xb[j] = (f32x4){bflo(xq.z), bfhi(xq.z), bflo(xq.w), bfhi(xq.w)}; }
#else
            xa[j] = *(const f32x4*)(orow + c); xb[j] = *(const f32x4*)(orow + c + 4); }
#endif
#pragma unroll
        for (int j = 0; j < 4; ++j) { const int c = j * 512 + lane * 8; f32x4 x0 = xa[j], x1 = xb[j];
#define ACC4(X, Y, W) do { const f32x2 lo = __builtin_amdgcn_cvt_pk_f32_fp8((int)(Y), false), hi2 = __builtin_amdgcn_cvt_pk_f32_fp8((int)(Y), true); X[0] += (W) * lo.x; X[1] += (W) * lo.y; X[2] += (W) * hi2.x; X[3] += (W) * hi2.y; } while (0)
            ACC4(x0, y0[j].x, tw.x); ACC4(x1, y0[j].y, tw.x); ACC4(x0, y1[j].x, tw.y); ACC4(x1, y1[j].y, tw.y);
            ACC4(x0, y2[j].x, tw.z); ACC4(x1, y2[j].y, tw.z); ACC4(x0, y3[j].x, tw.w); ACC4(x1, y3[j].y, tw.w);
#undef ACC4
            *(f32x4*)(orow + c) = x0; *(f32x4*)(orow + c + 4) = x1; }
    }
#else
    const bf16_t* ys = (const bf16_t*)(F.ws + WS_YSLOT);
    for (int t = gw; t < TT; t += NGW) {
        const int4 ti = *(const int4*)(topi + 4 * t), tp = *(const int4*)(tpos + 4 * t); const float4 tw = *(const float4*)(topw + 4 * t);
        const bf16_t* r0 = ys + ((size_t)tab[64 + ti.x] * 256 + tp.x) * DM; const bf16_t* r1 = ys + ((size_t)tab[64 + ti.y] * 256 + tp.y) * DM;
        const bf16_t* r2 = ys + ((size_t)tab[64 + ti.z] * 256 + tp.z) * DM; const bf16_t* r3 = ys + ((size_t)tab[64 + ti.w] * 256 + tp.w) * DM;
        float* orow = out + (size_t)t * DM;
#pragma unroll
        for (int j = 0; j < 4; ++j) { const int c = j * 512 + lane * 8;
            const u32x4 a0 = *(const u32x4*)(r0 + c), a1 = *(const u32x4*)(r1 + c), a2 = *(const u32x4*)(r2 + c), a3 = *(const u32x4*)(r3 + c);
            f32x4 x0 = *(const f32x4*)(orow + c), x1 = *(const f32x4*)(orow + c + 4);
#pragma unroll
            for (int q = 0; q < 2; ++q) {
                x0[2 * q] += tw.x * bflo(a0[q]) + tw.y * bflo(a1[q]) + tw.z * bflo(a2[q]) + tw.w * bflo(a3[q]);
                x0[2 * q + 1] += tw.x * bfhi(a0[q]) + tw.y * bfhi(a1[q]) + tw.z * bfhi(a2[q]) + tw.w * bfhi(a3[q]);
                x1[2 * q] += tw.x * bflo(a0[2 + q]) + tw.y * bflo(a1[2 + q]) + tw.z * bflo(a2[2 + q]) + tw.w * bflo(a3[2 + q]);
                x1[2 * q + 1] += tw.x * bfhi(a0[2 + q]) + tw.y * bfhi(a1[2 + q]) + tw.z * bfhi(a2[2 + q]) + tw.w * bfhi(a3[2 + q]); }
            *(f32x4*)(orow + c) = x0; *(f32x4*)(orow + c + 4) = x1; }
    }
#endif
}

constexpr int NPHASE = 14;
__global__ void __launch_bounds__(NTHREADS, 2) mk_fwd(Args a) {
    extern __shared__ __attribute__((aligned(16))) uchar lds_raw[];
    Frame F; F.lds = (LAS uchar*)lds_raw; F.ws = a.ws; F.wave = __builtin_amdgcn_readfirstlane(threadIdx.x >> 6); F.G = gridDim.x; F.bx = blockIdx.x;
    FRAME_IDS(F);
    volatile LAS unsigned* MISC = (volatile LAS unsigned*)(F.lds + MISC_OFF);
    LAS int* tab = (LAS int*)(F.lds + LDSCTL_OFF + 512);
    for (int u = F_tid; u < (LDS_BYTES - LDSCTL_OFF) / 4; u += NTHREADS) ((LAS unsigned*)(F.lds + LDSCTL_OFF))[u] = 0u;
    __syncthreads();
    XcdBarrier bar; bar.bar = (unsigned*)(a.ws + WS_CTL) + CW_BAR; bar.x = 0; bar.st = nullptr; bar.wave = F.wave;
    const int lo = a.ph_lo, hi = a.ph_hi;
    if (hi - lo > 1) bar = xcd_barrier_post((unsigned*)(a.ws + WS_CTL) + CW_BAR, MISC + 8, F.wave);
#ifndef MK_PHASE_MASK
#define MK_PHASE_MASK 0xffff
#endif
#define IN(k) (((MK_PHASE_MASK >> (k)) & 1) && lo <= (k) && (k) < hi)
#ifdef MK_PROBE_LO
    volatile LAS unsigned long long* pr_t = (volatile LAS unsigned long long*)(F.lds + LDSCTL_OFF + 64);
#ifdef MK_PROBE_CLK
#define PROBE_NOW() __builtin_amdgcn_s_memtime()
#else
#define PROBE_NOW() __builtin_amdgcn_s_memrealtime()
#endif
#define PROBE_AT(k) do { if ((k) == MK_PROBE_LO && F.wave == 0 && fresh_lane() == 0) pr_t[0] = PROBE_NOW(); if ((k) == MK_PROBE_HI + 1 && F.wave == 0 && fresh_lane() == 0) pr_t[1] = PROBE_NOW(); } while (0)
#else
#define PROBE_AT(k) do { } while (0)
#endif
#define SEAM(k) do { if (IN(k) && IN((k) + 1)) xcd_barrier(bar); } while (0)
    LAS uchar* ring = F.lds;
    uchar* ws = a.ws;
    const int G = F.G, bx = F.bx;

    PROBE_AT(0);
    if (IN(0)) { p0_prologue(a, F); } SEAM(0); PROBE_AT(1);

    if (IN(1)) {
        gm::ProbDense P; P.init((const bf16_t*)(ws + WS_H), DM, (const bf16_t*)(ws + WS_WIN), DM, MK_FP8_INPROJ ? DM / 2 : DM, TT, NPROJ, G, bx);
        EpiInProj E{(bf16_t*)(ws + WS_PROJ), (bf16_t*)(ws + WS_APACK), a.in[I_BG], (float*)(ws + WS_SSQP)};
        gm::gemm_phase<gm::ProbDense, EpiInProj, false, MK_FP8_INPROJ != 0>(ring, P, E, F.wave);
    } SEAM(1); PROBE_AT(2);

    if (IN(2)) {
        { gm::ProbDense P; P.init((const bf16_t*)(ws + WS_PROJ) + C_QLAT, NPROJ, (const bf16_t*)(ws + WS_WUQ), QLORA, QLORA, TT, NH * DQK, G, bx);
          EpiStoreScaled<0, 8, QLORA> E{(bf16_t*)(ws + WS_QRAW), NH * DQK, (const float*)(ws + WS_SSQP)}; gm::gemm_phase<gm::ProbDense, EpiStoreScaled<0, 8, QLORA>, false>(ring, P, E, F.wave); }
        { gm::ProbDense P; P.init((const bf16_t*)(ws + WS_PROJ) + C_KVLAT, NPROJ, (const bf16_t*)(ws + WS_WUKV), KVLORA, KVLORA, TT, NH * 256, G, bx);
          EpiKV E{(bf16_t*)(ws + WS_KVRAW), (bf16_t*)(ws + WS_VN), (const float*)(ws + WS_SSQP)}; gm::gemm_phase<gm::ProbDense, EpiKV, false>(ring, P, E, F.wave); }
#if MK_FAST_S5
        { ProbS5 P{(const bf16_t*)(ws + WS_APACK), (const bf16_t*)(ws + WS_WS5), APK, 256, 4, G, bx};
          EpiS5State E{(float*)(ws + WS_SCH)}; gm::gemm_phase<ProbS5, EpiS5State, false>(ring, P, E, F.wave); }
#endif
    } SEAM(2); PROBE_AT(3);

    if (IN(3)) {
#if MK_FAST_S5
        p3_scan(a, F);
#endif
        p3_prep(a, F);
    } SEAM(3); PROBE_AT(4);

    if (IN(4)) {
#if MK_FAST_S5
        { ProbS5 P{(const bf16_t*)(ws + WS_APACK), (const bf16_t*)(ws + WS_TWC), APK, APK, 6, G, bx};
          EpiS5Out E{(bf16_t*)(ws + WS_GACT), ws + WS_GACT8}; gm::gemm_phase<ProbS5, EpiS5Out, false>(ring, P, E, F.wave); }
#else
        s5_reference(a, F);
#endif
#if MK_FAST_ATTN
        p4_attention(a, F);
#else
        attn_reference(a, F);
#endif
    } SEAM(4); PROBE_AT(5);

    if (IN(5)) {
        { gm::ProbDense P; P.init((const bf16_t*)(ws + (MK_FP8_GLU ? WS_GACT8 : WS_GACT)), S5W, (const bf16_t*)(ws + WS_WGLU), S5W, MK_FP8_GLU ? S5W / 2 : S5W, TT, S5W, G, bx);
          using E5 = EpiSide<0, MK_FP8_YB != 0, MK_FP8_GLU != 0>; E5 E{(bf16_t*)(ws + WS_Y2), S5W, (const bf16_t*)(ws + WS_GACT), S5W, nullptr, 0}; gm::gemm_phase<gm::ProbDense, E5, false, MK_FP8_GLU != 0>(ring, P, E, F.wave); }
        { gm::ProbDense P; P.init((const bf16_t*)(ws + WS_O), DM, (const bf16_t*)(ws + WS_WOMLA), DM, MK_FP8_YA ? DM / 2 : DM, TT, DM, G, bx);
          using E5a = EpiSide<1, false, MK_FP8_YA != 0>; E5a E{(bf16_t*)(ws + WS_MA), DM, (const bf16_t*)(ws + WS_PROJ) + C_GA, NPROJ, nullptr, 0}; gm::gemm_phase<gm::ProbDense, E5a, false, MK_FP8_YA != 0>(ring, P, E, F.wave); }
    } SEAM(5); PROBE_AT(6);

    if (IN(6)) {
        gm::ProbDense P; P.init((const bf16_t*)(ws + WS_Y2), S5W, (const bf16_t*)(ws + WS_WOS5), S5W, MK_FP8_YB ? S5W / 2 : S5W, TT, DM, G, bx);
        using E6 = EpiSide<2, MK_FP8_OUT != 0, MK_FP8_YB != 0>;
        E6 E{(bf16_t*)(ws + WS_M), DM, (const bf16_t*)(ws + WS_PROJ) + C_GB, NPROJ, (const bf16_t*)(ws + WS_MA), DM}; gm::gemm_phase<gm::ProbDense, E6, false, MK_FP8_YB != 0>(ring, P, E, F.wave);
    } SEAM(6); PROBE_AT(7);

    if (IN(7)) {
        gm::ProbDense P; P.init((const bf16_t*)(ws + WS_M), DM, (const bf16_t*)(ws + WS_WOUT), DM, MK_FP8_OUT ? DM / 2 : DM, TT, DM, G, bx);
        #if MK_X1_BF16
        EpiResidBf16 E{a.in[I_X], (bf16_t*)(ws + WS_X1)}; gm::gemm_phase<gm::ProbDense, EpiResidBf16, false, MK_FP8_OUT != 0>(ring, P, E, F.wave);
#else
        EpiResidF32 E{a.in[I_X], a.out}; gm::gemm_phase<gm::ProbDense, EpiResidF32, false, MK_FP8_OUT != 0>(ring, P, E, F.wave);
#endif
    } SEAM(7); PROBE_AT(8);

    if (IN(8)) { p8_norm2_router(a, F, MK_X1_BF16 ? (const float*)(ws + WS_X1) : a.out); } SEAM(8); PROBE_AT(9);
    if (IN(9)) { p9_routing(a, F); } SEAM(9); PROBE_AT(10);

    if (IN(10) || IN(11) || IN(12) || IN(13)) moe_tables(F, tab);
    const int xl = bx & 7, rk = bx >> 3, nrk = (G - xl + 7) >> 3;
    if (IN(10)) { p10_permute(a, F, tab); } SEAM(10); PROBE_AT(11);
    if (IN(11)) {
        ProbMoE P{(const bf16_t*)(ws + WS_XPERM), (const bf16_t*)(ws + WS_W1), DM, DM, MK_FP8_MOE ? DM / 128 : DM / 64, 16, (size_t)4096 * DM, xl, rk, nrk}; P.load(tab);
        EpiSwiglu E{(bf16_t*)(ws + WS_HACT), a.in[I_BGATE], a.in[I_BUP], tab}; gm::gemm_phase<ProbMoE, EpiSwiglu, false, MK_FP8_MOE != 0>(ring, P, E, F.wave);
    } SEAM(11); PROBE_AT(12);
    if (IN(12)) {
        ProbMoE P{(const bf16_t*)(ws + WS_HACT), (const bf16_t*)(ws + WS_W2), DFF, DFF, MK_FP8_MOE ? DFF / 128 : DFF / 64, 8, (size_t)DM * DFF, xl, rk, nrk}; P.load(tab);
        EpiDown E{(bf16_t*)(ws + WS_YSLOT), a.in[I_BDOWN], tab}; gm::gemm_phase<ProbMoE, EpiDown, false, MK_FP8_MOE != 0>(ring, P, E, F.wave);
    } SEAM(12); PROBE_AT(13);
    if (IN(13)) { p12_combine(a, F, a.out, tab); }
    PROBE_AT(14);
#ifdef MK_PROBE_LO
#ifdef MK_PROBE_CLK
#define PROBE_DIV 24ull
#else
#define PROBE_DIV 1ull
#endif
    if (blockIdx.x == 0 && F.wave == 0 && fresh_lane() == 0) { const unsigned long long dt = (pr_t[1] - pr_t[0]) / PROBE_DIV * MK_PROBE_X, te = __builtin_amdgcn_s_memrealtime();
        while (__builtin_amdgcn_s_memrealtime() - te < dt) __builtin_amdgcn_s_sleep(32); }
#endif
#undef IN
#undef SEAM
}

extern "C" void kernel_launch(void* const* d_in, const int* in_sizes, int n_in, void* d_out, int out_size, void* d_ws, size_t ws_size, hipStream_t stream) {
    static int grid = 0;
    if (grid == 0) {
        if (n_in != 32 || in_sizes[0] != TT * DM || out_size != TT * DM || ws_size < WS_END) {
            fprintf(stderr, "kernel_launch: shape mismatch: n_in %d in0 %d out %d ws %zu (need %zu); nothing launched\n", n_in, n_in > 0 ? in_sizes[0] : -1, out_size, ws_size, (size_t)WS_END); grid = -1; return; }
        int dev = 0, cus = 0, per_cu = 0;
        if (hipGetDevice(&dev) != hipSuccess || hipDeviceGetAttribute(&cus, hipDeviceAttributeMultiprocessorCount, dev) != hipSuccess) { fprintf(stderr, "kernel_launch: device query failed\n"); grid = -1; return; }
        if (hipFuncSetAttribute((const void*)mk_fwd, hipFuncAttributeMaxDynamicSharedMemorySize, LDS_BYTES) != hipSuccess) { fprintf(stderr, "kernel_launch: hipFuncSetAttribute failed\n"); grid = -1; return; }
        if (hipOccupancyMaxActiveBlocksPerMultiprocessor(&per_cu, (const void*)mk_fwd, NTHREADS, LDS_BYTES) != hipSuccess || per_cu < 1)
            fprintf(stderr, "kernel_launch: note: occupancy query reports %d workgroups per CU\n", per_cu);
        (void)hipGetLastError();
        grid = cus - (cus % 8);
        if (grid < 8) grid = 8;
    }
    if (grid < 0) return;
    if (hipMemsetAsync((char*)d_ws + WS_CTL, 0, CTL_ZERO_BYTES, stream) != hipSuccess) { fprintf(stderr, "kernel_launch: memset failed\n"); return; }
    Args a{};
    for (int i = 0; i < 32; ++i) a.in[i] = (const float*)d_in[i];
    a.out = (float*)d_out; a.ws = (uchar*)d_ws;
#if MK_ONE_LAUNCH
    a.ph_lo = 0; a.ph_hi = NPHASE;
    hipLaunchKernelGGL(mk_fwd, dim3(grid), dim3(NTHREADS), LDS_BYTES, stream, a);
#else
    for (int p = 0; p < NPHASE; ++p) { a.ph_lo = p; a.ph_hi = p + 1; hipLaunchKernelGGL(mk_fwd, dim3(grid), dim3(NTHREADS), LDS_BYTES, stream, a); }
#endif
    const hipError_t le = hipPeekAtLastError();
    if (le != hipSuccess) fprintf(stderr, "kernel_launch: launch failed: %s\n", hipGetErrorName(le));
}
```

```cpp
#include <hip/hip_runtime.h>
#include <cstdio>
#include <cstdint>

#ifndef MK_ONE_LAUNCH
#define MK_ONE_LAUNCH 1
#endif
#ifndef MK_FAST_GEMM
#define MK_FAST_GEMM 1
#endif
#ifndef MK_FAST_ATTN
#define MK_FAST_ATTN 1
#endif
#ifndef MK_FAST_S5
#define MK_FAST_S5 1
#endif

#ifndef MK_FP8_MOE
#define MK_FP8_MOE 1
#endif
#define LAS __attribute__((address_space(3)))
#define GAS __attribute__((address_space(1)))
typedef unsigned short bf16_t;
typedef short bf16x8 __attribute__((ext_vector_type(8)));
typedef short s16x4 __attribute__((ext_vector_type(4)));
typedef float f32x2 __attribute__((ext_vector_type(2)));
typedef float f32x4 __attribute__((ext_vector_type(4)));
typedef float f32x16 __attribute__((ext_vector_type(16)));
typedef unsigned u32x2 __attribute__((ext_vector_type(2)));
typedef unsigned u32x4 __attribute__((ext_vector_type(4)));
typedef unsigned char uchar;
typedef int v4i __attribute__((ext_vector_type(4)));
typedef int v8i __attribute__((ext_vector_type(8)));
constexpr float FP8_YSCALE = 16.0f;
#ifndef MK_FP8_INPROJ
#define MK_FP8_INPROJ 1
#endif
constexpr float FP8_ASCALE = 4.0f, FP8_WSCALE = 64.0f;
__device__ __forceinline__ float sat8(float x) { return __builtin_amdgcn_fmed3f(x, -448.0f, 448.0f); }
__device__ __forceinline__ unsigned pk4_fp8(float a, float b, float c, float d) { int w = __builtin_amdgcn_cvt_pk_fp8_f32(a, b, 0, false); w = __builtin_amdgcn_cvt_pk_fp8_f32(c, d, w, true); return (unsigned)w; }
__device__ __forceinline__ unsigned pk4_fp8c(float a, float b, float c, float d) { return pk4_fp8(sat8(a), sat8(b), sat8(c), sat8(d)); }

constexpr int NB = 8, SEQ = 2048, TT = NB * SEQ, DM = 2048;
constexpr int NH = 16, DNOPE = 128, DROPE = 64, DQK = 192, DV = 128, QLORA = 512, KVLORA = 256;
constexpr int S5W = 1024, S5G = 64, S5C = 16, S5P = 64, S5L = 16;
constexpr int NE = 32, TOPK = 4, DFF = 2048;
constexpr int IN_PROJ = QLORA + KVLORA + DROPE + S5W + 2 * DM;
constexpr int NPROJ = 6144;
constexpr int C_QLAT = 0, C_KVLAT = 512, C_U = 768, C_GA = 1792, C_GB = 3840, C_KR = 5888;
constexpr float EPS = 1e-6f;
constexpr int MAXSLOT_TILES = (TT * TOPK) / 256 + NE;
constexpr int MAXSLOTS = MAXSLOT_TILES * 256;
constexpr int NCHUNK = TT / S5L;
constexpr int APK = 384;

constexpr size_t MiB = 1u << 20;
constexpr size_t WS_CTL = 0, CTL_ZERO_BYTES = 1 * MiB;
constexpr size_t WS_WIN = 1 * MiB;
constexpr size_t WS_WUQ = WS_WIN + 24 * MiB;
constexpr size_t WS_WUKV = WS_WUQ + 3 * MiB;
constexpr size_t WS_WOMLA = WS_WUKV + 2 * MiB;
constexpr size_t WS_WGLU = WS_WOMLA + 8 * MiB;
constexpr size_t WS_WOS5 = WS_WGLU + 2 * MiB;
constexpr size_t WS_WOUT = WS_WOS5 + 4 * MiB;
constexpr size_t WS_TWC = WS_WOUT + 8 * MiB;
constexpr size_t WS_WS5 = WS_TWC + 12 * MiB;
constexpr size_t WS_ROPE = WS_WS5 + 8 * MiB;
constexpr size_t WS_SMALL = WS_ROPE + 4 * MiB;
constexpr size_t WS_W1 = WS_SMALL + 1 * MiB;
constexpr size_t WS_W2 = WS_W1 + 512 * MiB;
constexpr size_t WS_ACT = WS_W2 + 256 * MiB;
constexpr size_t WS_H = WS_ACT;
constexpr size_t WS_PROJ = WS_H + 64 * MiB;
constexpr size_t WS_APACK = WS_PROJ + 192 * MiB;
constexpr size_t WS_SCH = WS_APACK + 48 * MiB;
constexpr size_t WS_QRAW = WS_SCH + 32 * MiB;
constexpr size_t WS_KVRAW = WS_QRAW + 96 * MiB;
constexpr size_t WS_QN = WS_KVRAW + 128 * MiB;
constexpr size_t WS_GACT8 = WS_QN;
constexpr size_t WS_KN = WS_QN + 96 * MiB;
constexpr size_t WS_VN = WS_KN + 96 * MiB;
constexpr size_t WS_O = WS_VN + 64 * MiB;
constexpr size_t WS_GACT = WS_O + 64 * MiB;
constexpr size_t WS_Y2 = WS_GACT + 32 * MiB;
constexpr size_t WS_MA = WS_Y2 + 32 * MiB;
constexpr size_t WS_M = WS_MA + 64 * MiB;
constexpr size_t WS_SSQP = WS_M + 64 * MiB;
constexpr size_t WS_ENDA = WS_SSQP + 1 * MiB;
constexpr size_t WS_H2 = WS_ACT;
constexpr size_t WS_RSTD2 = WS_H2;
constexpr size_t WS_HIST = WS_H2 + 1 * MiB;
constexpr size_t WS_HACT = WS_H2 + 64 * MiB;
constexpr size_t WS_YSLOT = WS_HACT + 288 * MiB;
constexpr size_t WS_TOPI = WS_YSLOT + 288 * MiB;
constexpr size_t WS_TOPW = WS_TOPI + 1 * MiB;
constexpr size_t WS_TPOS = WS_TOPW + 1 * MiB;
constexpr size_t WS_LIST = WS_TPOS + 1 * MiB;
constexpr size_t WS_XPERM = WS_ACT + 704 * MiB;
constexpr size_t WS_X1 = WS_W1 + 256 * MiB;
constexpr size_t WS_ENDB = WS_XPERM + 288 * MiB;
constexpr size_t WS_END = WS_ENDA > WS_ENDB ? WS_ENDA : WS_ENDB;
constexpr size_t SM_A16 = 0;
constexpr size_t SM_COUNTS = 64 * 1024;
constexpr size_t SM_WRP = 128 * 1024;
constexpr int CW_BAR = 4096;

constexpr int RING_BYTES = 131072;
constexpr int LDS_BYTES = 163840;
constexpr int LDSCTL_OFF = LDS_BYTES - 4096;
constexpr int MISC_OFF = LDSCTL_OFF;
constexpr int GTAB_OFF = LDSCTL_OFF + 2048;
constexpr int NWAVES = 8, NTHREADS = 512;

#define LDS_WAIT() asm volatile("s_waitcnt lgkmcnt(0)" ::: "memory")
#define VM_WAIT() asm volatile("s_waitcnt vmcnt(0)" ::: "memory")
#define SBAR() __builtin_amdgcn_sched_barrier(0)

__device__ __forceinline__ unsigned f2bf(float f) { unsigned u = __builtin_bit_cast(unsigned, f); return (u + 0x7fffu + ((u >> 16) & 1u)) >> 16; }
__device__ __forceinline__ unsigned pk2(float lo, float hi) { return f2bf(lo) | (f2bf(hi) << 16); }
__device__ __forceinline__ float bf2f(unsigned b) { return __builtin_bit_cast(float, b << 16); }
__device__ __forceinline__ float bflo(unsigned w) { return __builtin_bit_cast(float, w << 16); }
__device__ __forceinline__ float bfhi(unsigned w) { return __builtin_bit_cast(float, w & 0xffff0000u); }
__device__ __forceinline__ unsigned cvt_pk_bf16(float lo, float hi) { unsigned r; asm volatile("v_cvt_pk_bf16_f32 %0, %1, %2" : "=v"(r) : "v"(lo), "v"(hi)); return r; }
__device__ __forceinline__ float sigmoidf_(float x) { return __builtin_amdgcn_rcpf(1.0f + __builtin_amdgcn_exp2f(-1.4426950408889634f * x)); }
__device__ __forceinline__ f32x2 sig2_t(f32x2 t) { f32x2 d; d.x = __builtin_amdgcn_exp2f(t.x); d.y = __builtin_amdgcn_exp2f(t.y); d = d + 1.0f; f32x2 r; r.x = __builtin_amdgcn_rcpf(d.x); r.y = __builtin_amdgcn_rcpf(d.y); return r; }
__device__ __forceinline__ f32x2 gelu_tanh2(f32x2 x) { constexpr float C = -2.0f * 0.7978845608028654f * 1.4426950408889634f; const f32x2 p = (x * x) * (C * 0.044715f) + C; return x * sig2_t(x * p); }
__device__ __forceinline__ float gelu_tanh(float x) {
    const float u = 0.7978845608028654f * (x + 0.044715f * x * x * x);
    const float e = __builtin_amdgcn_exp2f(2.8853900817779268f * u);
    const float th = 1.0f - 2.0f * __builtin_amdgcn_rcpf(e + 1.0f);
    return 0.5f * x * (1.0f + th);
}
__device__ __forceinline__ int fresh_lane() { int z = 0; asm volatile("" : "+s"(z)); return (int)__builtin_amdgcn_mbcnt_hi(~0u, __builtin_amdgcn_mbcnt_lo(~0u, (unsigned)z)); }
__device__ __forceinline__ float wave_sum(float v) {
#pragma unroll
    for (int o = 1; o < 64; o <<= 1) v += __shfl_xor(v, o);
    return v;
}

#define XB_TMO      128
#define XB_XCNT(j)  (256  + 64 * (j))
#define XB_XSUB(j)  (1280 + 64 * (j))
#define XB_XGEN(j)  (2304 + 64 * (j))
#define XB_TOP      3328
#define XB_TOPGEN   3392
#define XCD_BAR_WORDS 3456
#define XB_SPIN_CAP (1u << 18)
__device__ __forceinline__ unsigned xb_ld(unsigned* p)              { return __hip_atomic_load(p, __ATOMIC_RELAXED, __HIP_MEMORY_SCOPE_AGENT); }
__device__ __forceinline__ unsigned xb_add(unsigned* p, unsigned v) { return __hip_atomic_fetch_add(p, v, __ATOMIC_RELAXED, __HIP_MEMORY_SCOPE_AGENT); }
__device__ __forceinline__ unsigned xb_xcc_id() { return (unsigned)__builtin_amdgcn_s_getreg((3 << 11) | 20) & 0xFu; }
#define XB_SPIN(cond, bar) do { unsigned _sp = 0; while (cond) { __builtin_amdgcn_s_sleep(1); \
    if ((++_sp & 255u) == 0u) { if (xb_ld(&(bar)[XB_TMO])) break; if (_sp > XB_SPIN_CAP) { atomicAdd(&(bar)[XB_TMO], 1u); break; } } } } while (0)
struct XcdBarrier { unsigned* bar; unsigned x; volatile LAS unsigned* st; int wave; };
__device__ __forceinline__ XcdBarrier xcd_barrier_post(unsigned* bar, volatile LAS unsigned* st, int wave) {
    XcdBarrier b; b.bar = bar; b.x = xb_xcc_id(); b.st = st; b.wave = wave;
    if (wave == 0 && fresh_lane() == 0) (void)xb_add(&bar[XB_XCNT(b.x)], 1u);
    return b;
}
__device__ __forceinline__ void xcd_barrier_complete(unsigned* bar, unsigned x, unsigned& nloc, unsigned& nx) {
    const unsigned G = gridDim.x * gridDim.y * gridDim.z;
    unsigned sum, cnt, mine, sp = 0u;
    for (;;) {
        sum = 0u; cnt = 0u; mine = 0u;
#pragma unroll
        for (unsigned j = 0; j < 16; ++j) { const unsigned c = xb_ld(&bar[XB_XCNT(j)]); sum += c; cnt += (c > 0u) ? 1u : 0u; mine = (j == x) ? c : mine; }
        if (sum == G) break;
        __builtin_amdgcn_s_sleep(1);
        if ((++sp & 255u) == 0u) { if (xb_ld(&bar[XB_TMO])) break; if (sp > XB_SPIN_CAP) { atomicAdd(&bar[XB_TMO], 1u); break; } }
    }
    nloc = mine > 0u ? mine : 1u; nx = cnt > 0u ? cnt : 1u;
}
__device__ __forceinline__ void xcd_barrier(const XcdBarrier& b) {
    asm volatile("s_waitcnt vmcnt(0)" ::: "memory");
    __syncthreads();
    if (b.wave == 0 && fresh_lane() == 0) {
        unsigned* bar = b.bar;
        __builtin_amdgcn_s_waitcnt(0);
        unsigned nloc = b.st[0], nx = b.st[1];
        if (nloc == 0u) { xcd_barrier_complete(bar, b.x, nloc, nx); b.st[0] = nloc; b.st[1] = nx; }
        const unsigned old = xb_add(&bar[XB_XSUB(b.x)], 1u);
        const unsigned gen = old / nloc;
        if (old + 1u == (gen + 1u) * nloc) {
            __builtin_amdgcn_fence(__ATOMIC_RELEASE, "agent");
            asm volatile("s_waitcnt vmcnt(0)" ::: "memory");
            const unsigned og = xb_add(&bar[XB_TOP], 1u);
            const unsigned tg = og / nx;
            if (og + 1u == (tg + 1u) * nx) xb_add(&bar[XB_TOPGEN], 1u);
            else XB_SPIN(xb_ld(&bar[XB_TOPGEN]) == tg, bar);
            __builtin_amdgcn_fence(__ATOMIC_ACQUIRE, "agent");
            xb_add(&bar[XB_XGEN(b.x)], 1u);
            asm volatile("s_waitcnt vmcnt(0)" ::: "memory");
        } else {
            XB_SPIN(xb_ld(&bar[XB_XGEN(b.x)]) == gen, bar);
            __builtin_amdgcn_fence(__ATOMIC_ACQUIRE, "agent");
            asm volatile("s_waitcnt vmcnt(0)" ::: "memory");
        }
    }
    __syncthreads();
}

#ifndef MK_FP8_YA
#define MK_FP8_YA 1
#endif
#ifndef MK_FP8_YB
#define MK_FP8_YB 1
#endif
#ifndef MK_FP8_GLU
#define MK_FP8_GLU 0
#endif
#ifndef MK_HIST_ROUTE
#define MK_HIST_ROUTE 1
#endif
#ifndef MK_X1_BF16
#define MK_X1_BF16 1
#endif
#ifndef MK_FP8_OUT
#define MK_FP8_OUT 1
#endif
static_assert(!(MK_HIST_ROUTE && !(MK_X1_BF16 && MK_FP8_MOE)), "histogram routing reads bf16 x1 and writes fp8 rows");
static_assert(!(MK_X1_BF16 && !MK_FP8_MOE), "the bf16-x1 combine is only written for the fp8 MoE build");
constexpr float FP8_XSCALE = 16.0f, MIX_DS = 1.0f / (FP8_XSCALE * FP8_WSCALE);
constexpr float INPROJ_DS = MK_FP8_INPROJ ? 1.0f / (FP8_ASCALE * FP8_WSCALE) : 1.0f;
#ifndef MK_DUP
#define MK_DUP 0
#endif
namespace gm {
constexpr int BM = 256, BK = 64, HALF = 128, HTB = HALF * BK * 2, STAGE_BYTES = 8 * HTB, NXCD = 8, WGM = 8;
__host__ __device__ __forceinline__ int lds_byte(int r, int c) { const int st = (r >> 4) * 2 + (c >> 5), rr = r & 15, cc = c & 31, ob = rr * 64 + cc * 2; return st * 1024 + (ob ^ (((ob >> 9) & 1) << 5)); }
__host__ __device__ __forceinline__ void stage_rc(int b, int& R, int& C) { const int st = b / 1024, sb = b % 1024, swz = sb ^ (((sb >> 9) & 1) << 5); R = (st >> 1) * 16 + swz / 64; C = (st & 1) * 32 + (swz % 64) / 2; }
__host__ __device__ __forceinline__ int perm32(int rho) { const int n = rho >> 4, i = rho & 15; return 8 * (i >> 2) + 4 * n + (i & 3); }

struct Unit { int pm, pn, g, st; };


struct ProbDense {
    const bf16_t* A; const bf16_t* B; int lda, ldb, nt; int nM, nN, nwg, G, c; const int* list = nullptr; const LAS int* gtab = nullptr;
    __device__ unsigned list_off(const Unit&) const { return 0u; }
    __device__ void init(const bf16_t* A_, int lda_, const bf16_t* B_, int ldb_, int K, int M, int N, int G_, int c_) { A = A_; B = B_; lda = lda_; ldb = ldb_; nt = K / BK; nM = M / BM; nN = N / BM; nwg = nM * nN; G = G_; c = c_; }
    __device__ bool next(int i, Unit& u) const {
        const long L = (long)i * G + c; if (L >= nwg) return false;
        int wgid = (int)L; { const int q = nwg / NXCD, r = nwg % NXCD, xcd = wgid % NXCD, off = wgid / NXCD; wgid = (xcd < r ? xcd * (q + 1) : r * (q + 1) + (xcd - r) * q) + off; }
        const int nig = WGM * nN, gid = wgid / nig, fm = gid * WGM, gsz = (nM - fm) < WGM ? (nM - fm) : WGM;
        u.pm = fm + ((wgid % nig) % gsz); u.pn = (wgid % nig) / gsz; u.g = 0; u.st = 0; return true;
    }
    __device__ size_t a_off(const Unit& u) const { return (size_t)u.pm * BM * lda; }
    __device__ size_t b_off(const Unit& u) const { return (size_t)u.pn * BM * ldb; }
    __device__ unsigned a_row(const Unit&, int) const { return 0u; }
};

#if MK_FAST_GEMM
template <class Prob, class Epi, bool GATHER, bool FP8 = false>
__device__ __forceinline__ void gemm_phase(LAS uchar* lds, const Prob& S, const Epi& E, const int wid  ) {
    constexpr unsigned ESZ = FP8 ? 1u : 2u;
    const int lane = fresh_lane(), tid = wid * 64 + lane, wr = wid >> 2, wc = wid & 3, fr = lane & 15, fq = lane >> 4;
    const int nt = S.nt;
    int Ra[2], Ca[2]; unsigned vB;
    { int R, C; stage_rc(tid * 16, R, C); const int Rb = Epi::PERM ? ((R & ~31) + perm32(R & 31)) : R; Ra[0] = R; Ca[0] = C; Ra[1] = R + 64; Ca[1] = C;
      vB = (unsigned)(Rb * S.ldb) * ESZ + (unsigned)C * 2u; }
    const unsigned dB64 = 64u * (unsigned)S.ldb * ESZ, dA64 = 64u * (unsigned)S.lda * ESZ, dA128 = 2u * dA64;
    constexpr unsigned kstep = BK * 2;
    const unsigned hstepB = (unsigned)HALF * (unsigned)S.ldb * ESZ;
    const unsigned ldsw = (unsigned)wid * 1024u;
    const int aoff = lds_byte(wr * 64 + fr, fq * 8), boff = lds_byte(wc * 32 + fr, fq * 8);
    const __amdgpu_buffer_rsrc_t srdA = __builtin_amdgcn_make_buffer_rsrc((void*)S.A, 0, 0xFFFFFFFF, 0x00020000);
    const __amdgpu_buffer_rsrc_t srdB = __builtin_amdgcn_make_buffer_rsrc((void*)S.B, 0, 0xFFFFFFFF, 0x00020000);
#define G_SA(b, h) (((b) * 2 + (h)) * HTB)
#define G_SB(b, h) ((4 + (b) * 2 + (h)) * HTB)
#define G_STAGE(bufoff, srd, soff, voff) do { _Pragma("unroll") for (int _i = 0; _i < 2; ++_i) \
        __builtin_amdgcn_raw_ptr_buffer_load_lds(srd, (LAS void*)(lds + (bufoff) + ldsw + _i * 8192), 16, (int)(voff)[_i], (int)(soff), 0, 0); } while (0)
#define G_STAGE1(bufoff, srd, soff, v1, d64) do { _Pragma("unroll") for (int _i = 0; _i < 2; ++_i) \
        __builtin_amdgcn_raw_ptr_buffer_load_lds(srd, (LAS void*)(lds + (bufoff) + ldsw + _i * 8192), 16, (int)(v1), (int)((soff) + _i * (d64)), 0, 0); } while (0)
#define G_STAGE_A(bufoff, soff, half, arr0, arr1) do { if constexpr (GATHER) { if (half) G_STAGE(bufoff, srdA, soff, arr1); else G_STAGE(bufoff, srdA, soff, arr0); } \
        else G_STAGE1(bufoff, srdA, (soff) + (half) * dA128, vA, dA64); } while (0)
#define G_LDA(dst, b, h) do { _Pragma("unroll") for (int m = 0; m < 4; ++m) _Pragma("unroll") for (int k = 0; k < 2; ++k) dst[m][k] = *(const LAS bf16x8*)(lds + G_SA(b, h) + aoff + m * 2048 + k * 1024); } while (0)
#define G_LDB(dst, b, h) do { _Pragma("unroll") for (int n = 0; n < 2; ++n) _Pragma("unroll") for (int k = 0; k < 2; ++k) dst[n][k] = *(const LAS bf16x8*)(lds + G_SB(b, h) + boff + n * 2048 + k * 1024); } while (0)
#define G_CAT(x0, x1) __builtin_shufflevector(__builtin_bit_cast(v4i, x0), __builtin_bit_cast(v4i, x1), 0, 1, 2, 3, 4, 5, 6, 7)
#define G_MMA(ai, bj, At, Bt) do { __builtin_amdgcn_s_setprio(1); _Pragma("unroll") for (int m = 0; m < 4; ++m) _Pragma("unroll") for (int n = 0; n < 2; ++n) { \
        if constexpr (FP8) acc[ai][bj][m][n] = __builtin_amdgcn_mfma_scale_f32_16x16x128_f8f6f4(G_CAT(Bt[n][0], Bt[n][1]), G_CAT(At[m][0], At[m][1]), acc[ai][bj][m][n], 0, 0, 0, 0x7f7f7f7f, 0, 0x7f7f7f7f); \
        else { _Pragma("unroll") for (int k = 0; k < 2; ++k) acc[ai][bj][m][n] = __builtin_amdgcn_mfma_f32_16x16x32_bf16(Bt[n][k], At[m][k], acc[ai][bj][m][n], 0, 0, 0); } } \
        __builtin_amdgcn_s_setprio(0); } while (0)
#define G_WAIT_V(n) asm volatile("s_waitcnt vmcnt(" #n ")" ::: "memory")
#define G_WAIT_L(n) asm volatile("s_waitcnt lgkmcnt(" #n ")" ::: "memory")
#define G_BAR __builtin_amdgcn_s_barrier()
#define G_SCHED __builtin_amdgcn_sched_barrier(0)
#define G_UNI(x) ((unsigned)__builtin_amdgcn_readfirstlane((int)(x)))
    Unit cur, nxt; int ui = 0;
    if (!S.next(0, cur)) return;
    unsigned vA0[2], vA1[2];
    unsigned cA = 0u, cB = G_UNI(S.b_off(cur) * ESZ);
    __amdgpu_buffer_rsrc_t srdL = srdA;
    if constexpr (GATHER) srdL = __builtin_amdgcn_make_buffer_rsrc((void*)S.list, 0, 0xFFFFFFFF, 0x00020000);
#define G_IDX(u_) do { if (wid < 4) __builtin_amdgcn_raw_ptr_buffer_load_lds(srdL, (LAS void*)(S.gtab + wid * 64), 4, lane * 4, (int)G_UNI(S.list_off(u_) * 4u) + wid * 256, 0, 0); } while (0)
    const int gR = (int)(uintptr_t)S.gtab + Ra[0] * 4; const unsigned gC = (unsigned)Ca[0] * 2u;
#define G_ROWS(o0, o1) do { const LAS int* _g = (const LAS int*)gR; const unsigned _ls = (unsigned)S.lda * ESZ; \
        o0[0] = (unsigned)_g[0] * _ls + gC; o0[1] = (unsigned)_g[64] * _ls + gC; o1[0] = (unsigned)_g[128] * _ls + gC; o1[1] = (unsigned)_g[192] * _ls + gC; } while (0)
    if constexpr (GATHER) { G_IDX(cur); G_WAIT_V(0); G_BAR; G_ROWS(vA0, vA1); G_WAIT_L(0); G_BAR; }
    else { cA = G_UNI(S.a_off(cur) * ESZ);
#pragma unroll
        for (int i = 0; i < 2; ++i) { vA0[i] = 0u; vA1[i] = 0u; } }
    const unsigned vA = (unsigned)(Ra[0] * S.lda) * ESZ + (unsigned)Ca[0] * 2u;
    G_STAGE1(G_SB(0, 0), srdB, cB, vB, dB64); G_STAGE_A(G_SA(0, 0), cA, 0, vA0, vA1); G_STAGE1(G_SB(0, 1), srdB, cB + hstepB, vB, dB64); G_STAGE_A(G_SA(0, 1), cA, 1, vA0, vA1);
    if (wr == 1) G_BAR;
    G_WAIT_V(4); G_BAR;
    G_STAGE1(G_SB(1, 0), srdB, cB + kstep, vB, dB64); G_STAGE_A(G_SA(1, 0), cA + kstep, 0, vA0, vA1); G_STAGE1(G_SB(1, 1), srdB, cB + hstepB + kstep, vB, dB64);
    G_WAIT_V(6); G_BAR;
    f32x4 acc[2][2][4][2];
#pragma unroll
    for (int a = 0; a < 2; ++a)
#pragma unroll
        for (int b = 0; b < 2; ++b)
#pragma unroll
            for (int m = 0; m < 4; ++m)
#pragma unroll
                for (int n = 0; n < 2; ++n) acc[a][b][m][n] = (f32x4){0.f, 0.f, 0.f, 0.f};
    bf16x8 At[4][2], B0[2][2], B1[2][2];
    for (;;) {
        const bool has_next = S.next(ui + 1, nxt);
        unsigned nA = cA, nB = cB; unsigned x0[2] = {0u, 0u}, x1[2] = {0u, 0u};
        if (has_next) { nB = G_UNI(S.b_off(nxt) * ESZ);
            if constexpr (GATHER) G_IDX(nxt);
            else nA = G_UNI(S.a_off(nxt) * ESZ);
        }
#define G_TRIP(LAST) do { \
            const unsigned a1 = cA + (unsigned)(t + 1) * kstep; \
            const unsigned a2 = (LAST) ? nA : cA + (unsigned)(t + 2) * kstep, b2 = (LAST) ? nB : cB + (unsigned)(t + 2) * kstep; \
            const unsigned a3 = a2 + kstep, b3 = b2 + kstep; \
            unsigned w0[2], w1[2]; \
            _Pragma("unroll") for (int i = 0; i < 2; ++i) { w0[i] = vA0[i]; w1[i] = vA1[i]; } \
            if constexpr (GATHER) { if ((LAST) && has_next) { G_ROWS(w0, w1); _Pragma("unroll") for (int i = 0; i < 2; ++i) { x0[i] = w0[i]; x1[i] = w1[i]; } } } \
              G_LDB(B0, 0, 0); G_SCHED; G_LDA(At, 0, 0); G_STAGE_A(G_SA(1, 1), a1, 1, vA0, vA1); \
            G_WAIT_L(8); G_BAR; G_WAIT_L(0); G_MMA(0, 0, At, B0); G_BAR; G_SCHED; \
              G_LDB(B1, 0, 1); G_STAGE1(G_SB(0, 0), srdB, b2, vB, dB64); \
            G_BAR; G_WAIT_L(0); G_MMA(0, 1, At, B1); G_BAR; \
              G_LDA(At, 0, 1); G_STAGE_A(G_SA(0, 0), a2, 0, w0, w1); \
            G_BAR; G_WAIT_L(0); G_MMA(1, 0, At, B0); G_BAR; G_SCHED; \
              G_STAGE1(G_SB(0, 1), srdB, b2 + hstepB, vB, dB64); \
            G_WAIT_V(6); G_BAR; G_MMA(1, 1, At, B1); G_BAR; \
              G_LDB(B0, 1, 0); G_SCHED; G_LDA(At, 1, 0); G_STAGE_A(G_SA(0, 1), a2, 1, w0, w1); \
            G_WAIT_L(8); G_BAR; G_WAIT_L(0); G_MMA(0, 0, At, B0); G_BAR; G_SCHED; \
              G_LDB(B1, 1, 1); G_STAGE1(G_SB(1, 0), srdB, b3, vB, dB64); \
            G_BAR; G_WAIT_L(0); G_MMA(0, 1, At, B1); G_BAR; \
              G_LDA(At, 1, 1); G_STAGE_A(G_SA(1, 0), a3, 0, w0, w1); \
            G_BAR; G_WAIT_L(0); G_MMA(1, 0, At, B0); G_BAR; G_SCHED; \
              G_STAGE1(G_SB(1, 1), srdB, b3 + hstepB, vB, dB64); \
            G_WAIT_V(6); G_BAR; G_MMA(1, 1, At, B1); G_BAR; } while (0)
        for (int t = 0; t < nt; t += 2) { const bool last = (t == nt - 2); G_TRIP(last); }
        if (wr == 0) G_BAR;
        { const int lane2 = fresh_lane();
          if (!(FP8 && MK_DUP && (ui & 1) == 0)) E(acc, cur, wid >> 2, wid & 3, lane2 & 15, lane2 >> 4); }
        if (!has_next) break;
#pragma unroll
        for (int a = 0; a < 2; ++a)
#pragma unroll
            for (int b = 0; b < 2; ++b)
#pragma unroll
                for (int m = 0; m < 4; ++m)
#pragma unroll
                    for (int n = 0; n < 2; ++n) acc[a][b][m][n] = (f32x4){0.f, 0.f, 0.f, 0.f};
        cur = nxt; cA = nA; cB = nB; ++ui;
        if (wr == 1) G_BAR;
        if constexpr (GATHER) {
#pragma unroll
            for (int i = 0; i < 2; ++i) { vA0[i] = x0[i]; vA1[i] = x1[i]; } }
    }
    G_WAIT_V(0);
    G_BAR;
#undef G_SA
#undef G_SB
#undef G_STAGE
#undef G_STAGE1
#undef G_STAGE_A
#undef G_LDA
#undef G_LDB
#undef G_MMA
#undef G_CAT
#undef G_WAIT_V
#undef G_WAIT_L
#undef G_BAR
#undef G_SCHED
#undef G_UNI
#undef G_TRIP
#undef G_IDX
#undef G_ROWS
}
#else
template <class Prob, class Epi, bool GATHER, bool FP8 = false>
__device__ __forceinline__ void gemm_phase(LAS uchar* lds, const Prob& S, const Epi& E, const int wid) {
    const int lane = fresh_lane(), tid = wid * 64 + lane, wr = wid >> 2, wc = wid & 3, fr = lane & 15, fq = lane >> 4;
    LAS float* As = (LAS float*)lds; LAS float* Bs = As + 256 * 33;
    Unit u;
    for (int ui = 0; S.next(ui, u); ++ui) {
        float acc[2][2][4][2][4];
#pragma unroll
        for (int a = 0; a < 2; ++a)
#pragma unroll
            for (int b = 0; b < 2; ++b)
#pragma unroll
                for (int m = 0; m < 4; ++m)
#pragma unroll
                    for (int n = 0; n < 2; ++n)
#pragma unroll
                        for (int j = 0; j < 4; ++j) acc[a][b][m][n][j] = 0.f;
        const int lr = tid >> 1, lk = (tid & 1) * 16;
        const bf16_t* ap = GATHER ? (S.A + S.a_row(u, lr)) : (S.A + S.a_off(u) + (size_t)lr * S.lda);
        const bf16_t* bp = S.B + S.b_off(u) + (size_t)lr * S.ldb;
        for (int k0 = 0; k0 < S.nt * 64; k0 += 32) {
            __syncthreads();
            const u32x4 a0 = *(const u32x4*)(ap + k0 + lk), a1 = *(const u32x4*)(ap + k0 + lk + 8);
            const u32x4 b0 = *(const u32x4*)(bp + k0 + lk), b1 = *(const u32x4*)(bp + k0 + lk + 8);
#pragma unroll
            for (int q = 0; q < 4; ++q) {
                As[lr * 33 + lk + 2 * q] = bflo(a0[q]); As[lr * 33 + lk + 2 * q + 1] = bfhi(a0[q]);
                As[lr * 33 + lk + 8 + 2 * q] = bflo(a1[q]); As[lr * 33 + lk + 8 + 2 * q + 1] = bfhi(a1[q]);
                Bs[lr * 33 + lk + 2 * q] = bflo(b0[q]); Bs[lr * 33 + lk + 2 * q + 1] = bfhi(b0[q]);
                Bs[lr * 33 + lk + 8 + 2 * q] = bflo(b1[q]); Bs[lr * 33 + lk + 8 + 2 * q + 1] = bfhi(b1[q]);
            }
            __syncthreads();
            for (int kk = 0; kk < 32; ++kk) {
                float av[2][4], bv[2][2][4];
#pragma unroll
                for (int a = 0; a < 2; ++a)
#pragma unroll
                    for (int m = 0; m < 4; ++m) av[a][m] = As[(128 * a + 64 * wr + 16 * m + fr) * 33 + kk];
#pragma unroll
                for (int b = 0; b < 2; ++b)
#pragma unroll
                    for (int n = 0; n < 2; ++n)
#pragma unroll
                        for (int j = 0; j < 4; ++j) { const int c = 128 * b + 32 * wc + (Epi::PERM ? (8 * fq + 4 * n + j) : (16 * n + 4 * fq + j)); bv[b][n][j] = Bs[c * 33 + kk]; }
#pragma unroll
                for (int a = 0; a < 2; ++a)
#pragma unroll
                    for (int b = 0; b < 2; ++b)
#pragma unroll
                        for (int m = 0; m < 4; ++m)
#pragma unroll
                            for (int n = 0; n < 2; ++n)
#pragma unroll
                                for (int j = 0; j < 4; ++j) acc[a][b][m][n][j] += av[a][m] * bv[b][n][j];
            }
        }
        f32x4 accv[2][2][4][2];
#pragma unroll
        for (int a = 0; a < 2; ++a)
#pragma unroll
            for (int b = 0; b < 2; ++b)
#pragma unroll
                for (int m = 0; m < 4; ++m)
#pragma unroll
                    for (int n = 0; n < 2; ++n) accv[a][b][m][n] = (f32x4){acc[a][b][m][n][0], acc[a][b][m][n][1], acc[a][b][m][n][2], acc[a][b][m][n][3]};
        E(accv, u, wr, wc, fr, fq);
    }
    __syncthreads();
}
#endif
}

struct Args {
    const float* in[32];
    float* out; uchar* ws;
    int ph_lo, ph_hi;
};
struct Frame {
    LAS uchar* lds; uchar* ws; int wave, G, bx;
};
#define FRAME_IDS(F) const int F_lane = fresh_lane(), F_tid = (F).wave * 64 + F_lane
enum { I_X = 0, I_POS, I_N1G, I_WIN, I_BG, I_QNG, I_WUQ, I_KVNG, I_WUKV, I_QKQG, I_QKKG, I_WOMLA, I_LRE, I_LIM, I_LOGDT, I_BRE, I_BIM, I_CRE, I_CIM, I_S5D,
       I_WGLU, I_WOS5, I_WOUT, I_N2G, I_WR, I_BR, I_WG, I_BGATE, I_WU, I_BUP, I_WD, I_BDOWN };

struct ProbS5 {
    const bf16_t* A; const bf16_t* B; int lda, ldb, nt; int G, c; const int* list = nullptr; const LAS int* gtab = nullptr;
    __device__ unsigned list_off(const gm::Unit&) const { return 0u; }
    __device__ bool next(int i, gm::Unit& u) const { const int L = i * G + c; if (L >= S5G * 4) return false; u.g = L >> 2; u.pm = L & 3; u.pn = 0; u.st = 0; return true; }
    __device__ size_t a_off(const gm::Unit& u) const { return ((size_t)u.g * NCHUNK + (size_t)u.pm * 256) * APK; }
    __device__ size_t b_off(const gm::Unit& u) const { return (size_t)u.g * 256 * ldb; }
    __device__ unsigned a_row(const gm::Unit&, int) const { return 0u; }
};
struct ProbMoE {
    const bf16_t* A; const bf16_t* B; int lda, ldb, nt; int npn; size_t estride;
    int x, rk, nrk; int nte[4], rcp[4], pre[4], eid[4];
    const int* list = nullptr; const LAS int* gtab = nullptr;
    __device__ void load(const LAS int* tab) {
#pragma unroll
        for (int q = 0; q < 4; ++q) { const int e = __builtin_amdgcn_readfirstlane(tab[160 + x * 4 + q]); eid[q] = e; nte[q] = __builtin_amdgcn_readfirstlane(tab[32 + e]); rcp[q] = __builtin_amdgcn_readfirstlane(tab[128 + e]); pre[q] = __builtin_amdgcn_readfirstlane(tab[64 + e]); }
    }
    __device__ unsigned list_off(const gm::Unit&) const { return 0u; }
    __device__ bool next(int i, gm::Unit& u) const {
        int L = (i >> MK_DUP) * nrk + rk;
#pragma unroll
        for (int q = 0; q < 4; ++q) { const int nu = nte[q] * npn;
            if (L < nu) { u.g = eid[q]; u.pn = (L * rcp[q]) >> 20; u.pm = L - u.pn * nte[q]; u.st = pre[q] + u.pm; return true; } L -= nu; }
        return false;
    }
    __device__ size_t a_off(const gm::Unit& u) const { return ((size_t)u.st * 256) * lda; }
    __device__ size_t b_off(const gm::Unit& u) const { return (size_t)u.g * estride + (size_t)u.pn * 256 * ldb; }
    __device__ unsigned a_row(const gm::Unit&, int) const { return 0u; }
};

#define EPI_ROW(u_, ai, m) ((u_).pm * 256 + (ai) * 128 + wr * 64 + (m) * 16 + fr)
struct EpiStoreBf16 {
    static constexpr bool PERM = true;
    bf16_t* O; int ld;
    __device__ __forceinline__ void operator()(const f32x4 (&acc)[2][2][4][2], const gm::Unit& u, int wr, int wc, int fr, int fq) const {
#pragma unroll
        for (int ai = 0; ai < 2; ++ai)
#pragma unroll
            for (int m = 0; m < 4; ++m) { bf16_t* rowp = O + (size_t)EPI_ROW(u, ai, m) * ld + u.pn * 256 + wc * 32 + 8 * fq;
#pragma unroll
                for (int bj = 0; bj < 2; ++bj) { const f32x4 v0 = acc[ai][bj][m][0], v1 = acc[ai][bj][m][1];
                    u32x4 w; w.x = cvt_pk_bf16(v0[0], v0[1]); w.y = cvt_pk_bf16(v0[2], v0[3]); w.z = cvt_pk_bf16(v1[0], v1[1]); w.w = cvt_pk_bf16(v1[2], v1[3]);
                    *(u32x4*)(rowp + bj * 128) = w; } }
    }
};
template <int S0, int NS, int LEN> struct EpiStoreScaled {
    static constexpr bool PERM = true;
    bf16_t* O; int ld; const float* ssqp;
    __device__ __forceinline__ void operator()(const f32x4 (&acc)[2][2][4][2], const gm::Unit& u, int wr, int wc, int fr, int fq) const {
#pragma unroll
        for (int ai = 0; ai < 2; ++ai) { float rs[4];
#pragma unroll
            for (int m = 0; m < 4; ++m) { const float* sp = ssqp + (size_t)EPI_ROW(u, ai, m) * 12 + S0; float t = 0.f;
#pragma unroll
                for (int q = 0; q < NS; q += 4) { const f32x4 v = *(const f32x4*)(sp + q); t += (v[0] + v[1]) + (v[2] + v[3]); }
                rs[m] = 1.0f / sqrtf(t * (1.0f / LEN) + EPS); }
#pragma unroll
            for (int m = 0; m < 4; ++m) { bf16_t* rowp = O + (size_t)EPI_ROW(u, ai, m) * ld + u.pn * 256 + wc * 32 + 8 * fq;
#pragma unroll
                for (int bj = 0; bj < 2; ++bj) { const f32x4 v0 = acc[ai][bj][m][0] * rs[m], v1 = acc[ai][bj][m][1] * rs[m];
                    u32x4 w; w.x = cvt_pk_bf16(v0[0], v0[1]); w.y = cvt_pk_bf16(v0[2], v0[3]); w.z = cvt_pk_bf16(v1[0], v1[1]); w.w = cvt_pk_bf16(v1[2], v1[3]);
                    *(u32x4*)(rowp + bj * 128) = w; } } }
    }
};
struct EpiKV {
    static constexpr bool PERM = true;
    bf16_t* kraw; bf16_t* vn; const float* ssqp;
    __device__ __forceinline__ void operator()(const f32x4 (&acc)[2][2][4][2], const gm::Unit& u, int wr, int wc, int fr, int fq) const {
#pragma unroll
        for (int ai = 0; ai < 2; ++ai) { float rs[4];
#pragma unroll
            for (int m = 0; m < 4; ++m) { const f32x4 v = *(const f32x4*)(ssqp + (size_t)EPI_ROW(u, ai, m) * 12 + 8); rs[m] = 1.0f / sqrtf(((v[0] + v[1]) + (v[2] + v[3])) * (1.0f / KVLORA) + EPS); }
#pragma unroll
            for (int m = 0; m < 4; ++m) { const int t = EPI_ROW(u, ai, m); const size_t ro = ((size_t)((t >> 11) * NH + u.pn) * SEQ + (t & 2047)) * 128 + wc * 32 + 8 * fq;
#pragma unroll
                for (int bj = 0; bj < 2; ++bj) { const f32x4 v0 = acc[ai][bj][m][0] * rs[m], v1 = acc[ai][bj][m][1] * rs[m];
                    u32x4 w; w.x = cvt_pk_bf16(v0[0], v0[1]); w.y = cvt_pk_bf16(v0[2], v0[3]); w.z = cvt_pk_bf16(v1[0], v1[1]); w.w = cvt_pk_bf16(v1[2], v1[3]);
                    *(u32x4*)((bj ? vn : kraw) + ro) = w; } } }
    }
};
struct EpiInProj {
    static constexpr bool PERM = true;
    bf16_t* proj; bf16_t* apack; const float* bgates; float* ssqp;
    __device__ __forceinline__ void operator()(const f32x4 (&acc)[2][2][4][2], const gm::Unit& u, int wr, int wc, int fr, int fq) const {
        const int colt = u.pn * 256 + wc * 32 + 8 * fq;
        if (u.pn < 3) {
#pragma unroll
            for (int ai = 0; ai < 2; ++ai)
#pragma unroll
                for (int m = 0; m < 4; ++m) { float sq = 0.f;
#pragma unroll
                    for (int bj = 0; bj < 2; ++bj)
#pragma unroll
                        for (int n = 0; n < 2; ++n) { const f32x4 v = acc[ai][bj][m][n]; sq += (v[0] * v[0] + v[1] * v[1]) + (v[2] * v[2] + v[3] * v[3]); }
                    sq += __shfl_xor(sq, 16); sq += __shfl_xor(sq, 32);
                    if (fq == 0) ssqp[(size_t)EPI_ROW(u, ai, m) * 12 + u.pn * 4 + wc] = sq * (INPROJ_DS * INPROJ_DS); } }
        const int kind = (u.pn >= 3 && u.pn < 7) ? 1 : ((u.pn >= 7 && u.pn < 23) ? 2 : 0);
#pragma unroll
        for (int bj = 0; bj < 2; ++bj) {
            const int col = colt + bj * 128;
            f32x4 b0 = (f32x4){0.f, 0.f, 0.f, 0.f}, b1 = b0;
            constexpr float NL2E = -1.4426950408889634f;
            if (kind == 2) { b0 = *(const f32x4*)(bgates + (col - C_GA)) * NL2E; b1 = *(const f32x4*)(bgates + (col - C_GA) + 4) * NL2E; }
#pragma unroll
            for (int ai = 0; ai < 2; ++ai)
#pragma unroll
                for (int m = 0; m < 4; ++m) {
                    const int row = EPI_ROW(u, ai, m);
                    f32x4 v0 = acc[ai][bj][m][0], v1 = acc[ai][bj][m][1];
                    if (kind == 2) {
#pragma unroll
                        for (int h = 0; h < 2; ++h) { const f32x2 s0 = sig2_t((f32x2){v0[2 * h], v0[2 * h + 1]} * (NL2E * INPROJ_DS) + (f32x2){b0[2 * h], b0[2 * h + 1]}), s1 = sig2_t((f32x2){v1[2 * h], v1[2 * h + 1]} * (NL2E * INPROJ_DS) + (f32x2){b1[2 * h], b1[2 * h + 1]});
                            v0[2 * h] = s0.x; v0[2 * h + 1] = s0.y; v1[2 * h] = s1.x; v1[2 * h + 1] = s1.y; }
                    } else if (MK_FP8_INPROJ) { v0 = v0 * INPROJ_DS; v1 = v1 * INPROJ_DS; }
                    u32x4 w; w.x = cvt_pk_bf16(v0[0], v0[1]); w.y = cvt_pk_bf16(v0[2], v0[3]); w.z = cvt_pk_bf16(v1[0], v1[1]); w.w = cvt_pk_bf16(v1[2], v1[3]);
                    if (kind == 1) { const int j = col - C_U, g = j >> 4, cc = j & 15;
                        *(u32x4*)(apack + ((size_t)g * NCHUNK + (row >> 4)) * APK + (row & 15) * 16 + cc) = w; }
                    else { *(u32x4*)(proj + (size_t)row * NPROJ + col) = w;
                    }
                }
        }
    }
};
struct EpiS5State {
    static constexpr bool PERM = false;
    float* sch;
    __device__ __forceinline__ void operator()(const f32x4 (&acc)[2][2][4][2], const gm::Unit& u, int wr, int wc, int fr, int fq) const {
#pragma unroll
        for (int ai = 0; ai < 2; ++ai)
#pragma unroll
            for (int m = 0; m < 4; ++m) { float* rowp = sch + ((size_t)u.g * NCHUNK + EPI_ROW(u, ai, m)) * 128 + wc * 32 + 4 * fq;
#pragma unroll
                for (int n = 0; n < 2; ++n) *(f32x4*)(rowp + n * 16) = acc[ai][0][m][n]; }
    }
};
struct EpiS5Out {
    static constexpr bool PERM = true;
    bf16_t* gact; uchar* gact8;
    __device__ __forceinline__ void operator()(const f32x4 (&acc)[2][2][4][2], const gm::Unit& u, int wr, int wc, int fr, int fq) const {
#pragma unroll
        for (int ai = 0; ai < 2; ++ai)
#pragma unroll
            for (int m = 0; m < 4; ++m) { const int r = EPI_ROW(u, ai, m);
#pragma unroll
                for (int bj = 0; bj < 2; ++bj) { const int n0 = bj * 128 + wc * 32 + 8 * fq, t = n0 >> 4, c0 = n0 & 15;
                    f32x4 v0 = acc[ai][bj][m][0], v1 = acc[ai][bj][m][1];
#pragma unroll
                    for (int h = 0; h < 2; ++h) { const f32x2 g0 = gelu_tanh2((f32x2){v0[2 * h], v0[2 * h + 1]}), g1 = gelu_tanh2((f32x2){v1[2 * h], v1[2 * h + 1]});
                        v0[2 * h] = g0.x; v0[2 * h + 1] = g0.y; v1[2 * h] = g1.x; v1[2 * h + 1] = g1.y; }
                    u32x4 w; w.x = cvt_pk_bf16(v0[0], v0[1]); w.y = cvt_pk_bf16(v0[2], v0[3]); w.z = cvt_pk_bf16(v1[0], v1[1]); w.w = cvt_pk_bf16(v1[2], v1[3]);
                    *(u32x4*)(gact + ((size_t)r * 16 + t) * S5W + u.g * 16 + c0) = w;
#if MK_FP8_GLU
                    { u32x2 w8; w8.x = pk4_fp8c(v0[0] * FP8_XSCALE, v0[1] * FP8_XSCALE, v0[2] * FP8_XSCALE, v0[3] * FP8_XSCALE); w8.y = pk4_fp8c(v1[0] * FP8_XSCALE, v1[1] * FP8_XSCALE, v1[2] * FP8_XSCALE, v1[3] * FP8_XSCALE);
                      *(u32x2*)(gact8 + ((size_t)r * 16 + t) * S5W + u.g * 16 + c0) = w8; }
#endif
                    } }
    }
};
template <int MODE, bool OUT8 = false, bool ACC8 = false> struct EpiSide {
    static constexpr bool PERM = true; static constexpr float DS = ACC8 ? MIX_DS : 1.0f;
    bf16_t* O; int ldo; const bf16_t* s0; int ld0; const bf16_t* s1; int ld1;
    __device__ __forceinline__ void operator()(const f32x4 (&acc)[2][2][4][2], const gm::Unit& u, int wr, int wc, int fr, int fq) const {
        const int col0 = u.pn * 256 + wc * 32 + 8 * fq;
#pragma unroll
        for (int ai = 0; ai < 2; ++ai) {
            u32x4 sa[4][2], sb[4][2];
#pragma unroll
            for (int m = 0; m < 4; ++m)
#pragma unroll
                for (int bj = 0; bj < 2; ++bj) { const int row = EPI_ROW(u, ai, m);
                    sa[m][bj] = *(const u32x4*)(s0 + (size_t)row * ld0 + col0 + bj * 128);
                    if (MODE == 2) sb[m][bj] = *(const u32x4*)(s1 + (size_t)row * ld1 + col0 + bj * 128); else sb[m][bj] = (u32x4){0u, 0u, 0u, 0u}; }
#pragma unroll
            for (int m = 0; m < 4; ++m)
#pragma unroll
                for (int bj = 0; bj < 2; ++bj) { const int row = EPI_ROW(u, ai, m);
                    const f32x4 v0 = acc[ai][bj][m][0], v1 = acc[ai][bj][m][1]; const u32x4 a = sa[m][bj], b = sb[m][bj];
                    float r[8];
#pragma unroll
                    for (int q = 0; q < 4; ++q) { const float x0 = (q < 2 ? v0[2 * q] : v1[2 * q - 4]) * DS, x1 = (q < 2 ? v0[2 * q + 1] : v1[2 * q - 3]) * DS;
                        const float a0 = bflo(a[q]), a1 = bfhi(a[q]);
                        if (MODE == 0) { const f32x2 sg = sig2_t((f32x2){x0, x1} * -1.4426950408889634f) * (f32x2){a0, a1}; r[2 * q] = sg.x; r[2 * q + 1] = sg.y; }
                        else if (MODE == 1) { r[2 * q] = a0 * x0; r[2 * q + 1] = a1 * x1; }
                        else { r[2 * q] = bflo(b[q]) + a0 * x0; r[2 * q + 1] = bfhi(b[q]) + a1 * x1; } }
                    if constexpr (OUT8) { u32x2 w; w.x = pk4_fp8c(r[0] * FP8_XSCALE, r[1] * FP8_XSCALE, r[2] * FP8_XSCALE, r[3] * FP8_XSCALE); w.y = pk4_fp8c(r[4] * FP8_XSCALE, r[5] * FP8_XSCALE, r[6] * FP8_XSCALE, r[7] * FP8_XSCALE);
                        *(u32x2*)((uchar*)O + (size_t)row * ldo + col0 + bj * 128) = w; }
                    else { u32x4 w; w.x = cvt_pk_bf16(r[0], r[1]); w.y = cvt_pk_bf16(r[2], r[3]); w.z = cvt_pk_bf16(r[4], r[5]); w.w = cvt_pk_bf16(r[6], r[7]);
                        *(u32x4*)(O + (size_t)row * ldo + col0 + bj * 128) = w; } }
        }
    }
};
struct EpiResidF32 {
    static constexpr bool PERM = false; static constexpr float DS = MK_FP8_OUT ? MIX_DS : 1.0f;
    const float* x; float* out;
    __device__ __forceinline__ void operator()(const f32x4 (&acc)[2][2][4][2], const gm::Unit& u, int wr, int wc, int fr, int fq) const {
#pragma unroll
        for (int ai = 0; ai < 2; ++ai)
#pragma unroll
            for (int mh = 0; mh < 2; ++mh) { f32x4 xv[2][2][2];
#pragma unroll
                for (int mm = 0; mm < 2; ++mm) { const size_t off = (size_t)EPI_ROW(u, ai, 2 * mh + mm) * DM + u.pn * 256 + wc * 32 + 4 * fq;
#pragma unroll
                    for (int bj = 0; bj < 2; ++bj)
#pragma unroll
                        for (int n = 0; n < 2; ++n) xv[mm][bj][n] = *(const f32x4*)(x + off + bj * 128 + n * 16); }
#pragma unroll
                for (int mm = 0; mm < 2; ++mm) { const size_t off = (size_t)EPI_ROW(u, ai, 2 * mh + mm) * DM + u.pn * 256 + wc * 32 + 4 * fq;
#pragma unroll
                    for (int bj = 0; bj < 2; ++bj)
#pragma unroll
                        for (int n = 0; n < 2; ++n) *(f32x4*)(out + off + bj * 128 + n * 16) = xv[mm][bj][n] + acc[ai][bj][2 * mh + mm][n] * DS; } }
    }
};
struct EpiResidBf16 {
    static constexpr bool PERM = true; static constexpr float DS = MK_FP8_OUT ? MIX_DS : 1.0f;
    const float* x; bf16_t* x1;
    __device__ __forceinline__ void operator()(const f32x4 (&acc)[2][2][4][2], const gm::Unit& u, int wr, int wc, int fr, int fq) const {
#pragma unroll
        for (int ai = 0; ai < 2; ++ai)
#pragma unroll
            for (int mh = 0; mh < 2; ++mh) { f32x4 xv[2][2][2];
#pragma unroll
                for (int mm = 0; mm < 2; ++mm) { const size_t off = (size_t)EPI_ROW(u, ai, 2 * mh + mm) * DM + u.pn * 256 + wc * 32 + 8 * fq;
#pragma unroll
                    for (int bj = 0; bj < 2; ++bj)
#pragma unroll
                        for (int n = 0; n < 2; ++n) xv[mm][bj][n] = __builtin_nontemporal_load((const f32x4*)(x + off + bj * 128 + n * 4)); }
#pragma unroll
                for (int mm = 0; mm < 2; ++mm) { const size_t off = (size_t)EPI_ROW(u, ai, 2 * mh + mm) * DM + u.pn * 256 + wc * 32 + 8 * fq;
#pragma unroll
                    for (int bj = 0; bj < 2; ++bj) { const f32x4 v0 = xv[mm][bj][0] + acc[ai][bj][2 * mh + mm][0] * DS, v1 = xv[mm][bj][1] + acc[ai][bj][2 * mh + mm][1] * DS;
                        u32x4 w; w.x = cvt_pk_bf16(v0[0], v0[1]); w.y = cvt_pk_bf16(v0[2], v0[3]); w.z = cvt_pk_bf16(v1[0], v1[1]); w.w = cvt_pk_bf16(v1[2], v1[3]);
                        *(u32x4*)(x1 + off + bj * 128) = w; } } }
    }
};
#if MK_FP8_MOE
constexpr float MOE_DESCALE = 1.0f / (FP8_ASCALE * FP8_WSCALE);
#else
constexpr float MOE_DESCALE = 1.0f;
#endif
struct EpiSwiglu {
    static constexpr bool PERM = true;
    static constexpr float EPS_AS = MK_FP8_MOE ? FP8_ASCALE : 1.0f;
    bf16_t* hact; const float* bgate; const float* bup; const LAS int* tab;
    __device__ __forceinline__ void operator()(const f32x4 (&acc)[2][2][4][2], const gm::Unit& u, int wr, int wc, int fr, int fq) const {
        const int hc = u.pn * 128 + wc * 32 + 8 * fq;
        const unsigned slot0 = (unsigned)u.st * 256u + wr * 64 + fr;
        unsigned w0[2][4];
#pragma unroll
        for (int n = 0; n < 2; ++n) {
            const f32x4 g0 = *(const f32x4*)(bgate + (unsigned)(u.g * DFF + hc + 4 * n)), u0 = *(const f32x4*)(bup + (unsigned)(u.g * DFF + hc + 4 * n));
            const f32x2 gbv[2] = {{g0.x, g0.y}, {g0.z, g0.w}}, ubv[2] = {{u0.x * EPS_AS + EPS_AS, u0.y * EPS_AS + EPS_AS}, {u0.z * EPS_AS + EPS_AS, u0.w * EPS_AS + EPS_AS}};
#pragma unroll
            for (int ai = 0; ai < 2; ++ai)
#pragma unroll
                for (int m = 0; m < 4; ++m) { const unsigned slot = slot0 + ai * 128 + m * 16;
                    float r[4];
#pragma unroll
                    for (int h = 0; h < 2; ++h) { const f32x2 ag = {acc[ai][0][m][n][2 * h], acc[ai][0][m][n][2 * h + 1]}, au = {acc[ai][1][m][n][2 * h], acc[ai][1][m][n][2 * h + 1]};
                        f32x2 gt = ag * MOE_DESCALE + gbv[h], up = au * (MOE_DESCALE * EPS_AS) + ubv[h];
                        gt.x = fminf(gt.x, 7.0f); gt.y = fminf(gt.y, 7.0f);
                        up.x = __builtin_amdgcn_fmed3f(up.x, -6.0f * EPS_AS, 8.0f * EPS_AS); up.y = __builtin_amdgcn_fmed3f(up.y, -6.0f * EPS_AS, 8.0f * EPS_AS);
                        const f32x2 t = gt * (-1.702f * 1.4426950408889634f); f32x2 d; d.x = __builtin_amdgcn_exp2f(t.x); d.y = __builtin_amdgcn_exp2f(t.y); d = d + 1.0f;
                        f32x2 sg; sg.x = __builtin_amdgcn_rcpf(d.x); sg.y = __builtin_amdgcn_rcpf(d.y);
                        const f32x2 o = up * (gt * sg); r[2 * h] = o.x; r[2 * h + 1] = o.y; }
#if MK_FP8_MOE
                    const unsigned pk = pk4_fp8(r[0], r[1], r[2], r[3]);
                    if (n == 0) w0[ai][m] = pk; else { u32x2 w; w.x = w0[ai][m]; w.y = pk; *(u32x2*)((uchar*)hact + slot * DFF + hc) = w; }
#else
                    u32x2 w; w.x = cvt_pk_bf16(r[0], r[1]); w.y = cvt_pk_bf16(r[2], r[3]); *(u32x2*)(hact + slot * DFF + hc + 4 * n) = w;
#endif
                }
        }
    }
};
struct EpiDown {
    static constexpr bool PERM = true;
    bf16_t* ys; const float* bdown; const LAS int* tab;
    __device__ __forceinline__ void operator()(const f32x4 (&acc)[2][2][4][2], const gm::Unit& u, int wr, int wc, int fr, int fq) const {
        const size_t slot0 = (size_t)u.st * 256;
#pragma unroll
        for (int bj = 0; bj < 2; ++bj) { const int col = u.pn * 256 + bj * 128 + wc * 32 + 8 * fq;
            const float* bd = bdown + (size_t)u.g * DM + col; const f32x4 d0 = *(const f32x4*)bd, d1 = *(const f32x4*)(bd + 4);
#pragma unroll
            for (int ai = 0; ai < 2; ++ai)
#pragma unroll
                for (int m = 0; m < 4; ++m) { const size_t slot = slot0 + ai * 128 + wr * 64 + m * 16 + fr;
                    const f32x4 v0 = acc[ai][bj][m][0] * MOE_DESCALE + d0, v1 = acc[ai][bj][m][1] * MOE_DESCALE + d1;
#if MK_FP8_MOE
                    u32x2 w; w.x = pk4_fp8c(v0[0] * FP8_YSCALE, v0[1] * FP8_YSCALE, v0[2] * FP8_YSCALE, v0[3] * FP8_YSCALE); w.y = pk4_fp8c(v1[0] * FP8_YSCALE, v1[1] * FP8_YSCALE, v1[2] * FP8_YSCALE, v1[3] * FP8_YSCALE);
                    *(u32x2*)((uchar*)ys + slot * DM + col) = w; } }
#else
                    u32x4 w; w.x = cvt_pk_bf16(v0[0], v0[1]); w.y = cvt_pk_bf16(v0[2], v0[3]); w.z = cvt_pk_bf16(v1[0], v1[1]); w.w = cvt_pk_bf16(v1[2], v1[3]);
                    *(u32x4*)(ys + slot * DM + col) = w; } }
#endif
    }
};

template <bool FP8OUT>
__device__ __forceinline__ void transpose_item(const float* W, int ldw, int src_col0, int k0, const float* kscale, void* WT, int ldt, int dst_row0, float oscale, LAS float* scr, int lane) {
    if (src_col0 >= 0) {
        f32x4 v[16]; const float* wp = W + (size_t)(k0 + (lane >> 4)) * ldw + src_col0 + (lane & 15) * 4;
#pragma unroll
        for (int i = 0; i < 16; ++i) v[i] = __builtin_nontemporal_load((const f32x4*)(wp + (size_t)(4 * i) * ldw));
#pragma unroll
        for (int i = 0; i < 16; ++i) { const int kk = 4 * i + (lane >> 4); const float sc = kscale ? kscale[k0 + kk] * oscale : oscale; LAS float* d = scr + kk * 65 + (lane & 15) * 4;
            d[0] = v[i].x * sc; d[1] = v[i].y * sc; d[2] = v[i].z * sc; d[3] = v[i].w * sc; }
    } else {
#pragma unroll
        for (int i = 0; i < 16; ++i) { LAS float* d = scr + (4 * i + (lane >> 4)) * 65 + (lane & 15) * 4; d[0] = 0.f; d[1] = 0.f; d[2] = 0.f; d[3] = 0.f; }
    }
    LDS_WAIT(); asm volatile("" ::: "memory");
    if constexpr (FP8OUT) { const int c = lane & 3;
#pragma unroll
        for (int j = 0; j < 4; ++j) { const int n = (lane >> 2) + 16 * j; const LAS float* s = scr + (16 * c) * 65 + n; u32x4 o;
            o.x = pk4_fp8(s[0 * 65], s[1 * 65], s[2 * 65], s[3 * 65]); o.y = pk4_fp8(s[4 * 65], s[5 * 65], s[6 * 65], s[7 * 65]);
            o.z = pk4_fp8(s[8 * 65], s[9 * 65], s[10 * 65], s[11 * 65]); o.w = pk4_fp8(s[12 * 65], s[13 * 65], s[14 * 65], s[15 * 65]);
            *(u32x4*)((uchar*)WT + (size_t)(dst_row0 + n) * ldt + k0 + 16 * c) = o; }
    } else { const int c = lane & 7;
#pragma unroll
        for (int j = 0; j < 8; ++j) { const int n = (lane >> 3) + 8 * j; const LAS float* s = scr + (8 * c) * 65 + n;
            u32x4 o; o.x = pk2(s[0 * 65], s[1 * 65]); o.y = pk2(s[2 * 65], s[3 * 65]); o.z = pk2(s[4 * 65], s[5 * 65]); o.w = pk2(s[6 * 65], s[7 * 65]);
            *(u32x4*)((bf16_t*)WT + (size_t)(dst_row0 + n) * ldt + k0 + 8 * c) = o; }
    }
    LDS_WAIT(); asm volatile("" ::: "memory");
}
struct TItem { const float* src; uchar* dst; };
__device__ __forceinline__ void ti_load(const TItem& t, f32x4 (&v)[16], int lane) {
    const float* wp = t.src + (size_t)(lane >> 4) * DM + (lane & 15) * 4;
#pragma unroll
    for (int i = 0; i < 16; ++i) v[i] = __builtin_nontemporal_load((const f32x4*)(wp + (size_t)(4 * i) * DM));
}
template <bool FP8OUT>
__device__ __forceinline__ void ti_store(const TItem& t, const f32x4 (&v)[16], float oscale, LAS float* scr, int lane) {
#pragma unroll
    for (int i = 0; i < 16; ++i) { LAS float* d = scr + (4 * i + (lane >> 4)) * 65 + (lane & 15) * 4; d[0] = v[i].x * oscale; d[1] = v[i].y * oscale; d[2] = v[i].z * oscale; d[3] = v[i].w * oscale; }
    LDS_WAIT(); asm volatile("" ::: "memory");
    if constexpr (FP8OUT) { const int c = lane & 3;
#pragma unroll
        for (int j = 0; j < 4; ++j) { const int n = (lane >> 2) + 16 * j; const LAS float* s = scr + (16 * c) * 65 + n; u32x4 o;
            o.x = pk4_fp8(s[0 * 65], s[1 * 65], s[2 * 65], s[3 * 65]); o.y = pk4_fp8(s[4 * 65], s[5 * 65], s[6 * 65], s[7 * 65]);
            o.z = pk4_fp8(s[8 * 65], s[9 * 65], s[10 * 65], s[11 * 65]); o.w = pk4_fp8(s[12 * 65], s[13 * 65], s[14 * 65], s[15 * 65]);
            *(u32x4*)(t.dst + (size_t)n * DM + 16 * c) = o; }
    } else { const int c = lane & 7;
#pragma unroll
        for (int j = 0; j < 8; ++j) { const int n = (lane >> 3) + 8 * j; const LAS float* s = scr + (8 * c) * 65 + n;
            u32x4 o; o.x = pk2(s[0 * 65], s[1 * 65]); o.y = pk2(s[2 * 65], s[3 * 65]); o.z = pk2(s[4 * 65], s[5 * 65]); o.w = pk2(s[6 * 65], s[7 * 65]);
            *(u32x4*)(t.dst + ((size_t)n * DM + 8 * c) * 2) = o; }
    }
    LDS_WAIT(); asm volatile("" ::: "memory");
}
template <bool W8>
__device__ __forceinline__ TItem moe_pair(const Args& a, uchar* ws, int it) {
    constexpr size_t WEB = W8 ? 1 : 2; TItem t;
    const int kb = 2 * ((it & 7) | (((it >> 11) & 1) << 3)), nb = (it >> 3) & 31;
    if (it < NE * 2 * 16 * 32) { const int rest = ((it >> 8) & 7) | ((it >> 12) << 3), half = rest & 1, e = rest >> 1, pn = nb >> 1, q = nb & 1;
        t.src = a.in[half ? I_WU : I_WG] + (size_t)e * DM * DFF + (size_t)(kb * 64) * DFF + nb * 64;
        t.dst = ws + WS_W1 + ((size_t)e * 4096 * DM + (size_t)(pn * 256 + half * 128 + q * 64) * DM + kb * 64) * WEB;
    } else { const int r = it - NE * 2 * 16 * 32, e = ((r >> 8) & 7) | ((r >> 12) << 3);
        t.src = a.in[I_WD] + (size_t)e * DFF * DM + (size_t)(kb * 64) * DM + nb * 64;
        t.dst = ws + WS_W2 + ((size_t)e * DM * DFF + (size_t)(nb * 64) * DFF + kb * 64) * WEB; }
    return t;
}
template <bool FP8OUT, int NO>
__device__ __forceinline__ void ti_block(const f32x4 (&v)[16], float oscale, LAS float* scr, int lane, u32x4 (&o)[NO]) {
#pragma unroll
    for (int i = 0; i < 16; ++i) { LAS float* d = scr + (4 * i + (lane >> 4)) * 65 + (lane & 15) * 4; d[0] = v[i].x * oscale; d[1] = v[i].y * oscale; d[2] = v[i].z * oscale; d[3] = v[i].w * oscale; }
    LDS_WAIT(); asm volatile("" ::: "memory");
    if constexpr (FP8OUT) { const int c = lane & 3;
#pragma unroll
        for (int j = 0; j < 4; ++j) { const int n = (lane >> 2) + 16 * j; const LAS float* s = scr + (16 * c) * 65 + n;
            o[j].x = pk4_fp8(s[0 * 65], s[1 * 65], s[2 * 65], s[3 * 65]); o[j].y = pk4_fp8(s[4 * 65], s[5 * 65], s[6 * 65], s[7 * 65]);
            o[j].z = pk4_fp8(s[8 * 65], s[9 * 65], s[10 * 65], s[11 * 65]); o[j].w = pk4_fp8(s[12 * 65], s[13 * 65], s[14 * 65], s[15 * 65]); }
    } else { const int c = lane & 7;
#pragma unroll
        for (int j = 0; j < 8; ++j) { const int n = (lane >> 3) + 8 * j; const LAS float* s = scr + (8 * c) * 65 + n;
            o[j].x = pk2(s[0 * 65], s[1 * 65]); o[j].y = pk2(s[2 * 65], s[3 * 65]); o[j].z = pk2(s[4 * 65], s[5 * 65]); o[j].w = pk2(s[6 * 65], s[7 * 65]); } }
    LDS_WAIT(); asm volatile("" ::: "memory");
}
__device__ __forceinline__ int win_src_col(int n0) {
    if (n0 < C_KVLAT) return n0;
    if (n0 < C_U) return n0;
    if (n0 < C_GA) return (n0 - C_U) + 832;
    if (n0 < C_KR) return (n0 - C_GA) + 1856;
    if (n0 < C_KR + DROPE) return (n0 - C_KR) + 768;
    return -1;
}
__device__ __forceinline__ void s5_build_group(const Args& a, const Frame& F, int g) {
    FRAME_IDS(F);
    LAS float* L = (LAS float*)F.lds;
    LAS float* Apr = L;              LAS float* Api = Apr + 17 * 64;
    LAS float* Zr = Api + 17 * 64;   LAS float* Zi = Zr + 64;
    LAS float* Bbr = Zi + 64;        LAS float* Bbi = Bbr + 1024;
    LAS float* Cr = Bbi + 1024;      LAS float* Ci = Cr + 1024;
    LAS float* Kt = Ci + 1024;
    const int tid = F_tid;
    __syncthreads();
    if (tid < 64) { const int p = tid;
        const float dt = expf(a.in[I_LOGDT][g]); const float lr = a.in[I_LRE][g * 64 + p], li = a.in[I_LIM][g * 64 + p];
        const float mag = expf(lr * dt); const float ar = mag * cosf(li * dt), ai = mag * sinf(li * dt);
        const float den = lr * lr + li * li;
        Zr[p] = ((ar - 1.0f) * lr + ai * li) / den; Zi[p] = (ai * lr - (ar - 1.0f) * li) / den;
        float pr = 1.0f, pi = 0.0f;
        for (int t = 0; t <= 16; ++t) { Apr[t * 64 + p] = pr; Api[t * 64 + p] = pi; const float nr = pr * ar - pi * ai, ni = pr * ai + pi * ar; pr = nr; pi = ni; }
    }
    __syncthreads();
    for (int i = tid; i < 1024; i += NTHREADS) { const int p = i >> 4;
        const float br = a.in[I_BRE][(size_t)g * 1024 + i], bi = a.in[I_BIM][(size_t)g * 1024 + i];
        Bbr[i] = Zr[p] * br - Zi[p] * bi; Bbi[i] = Zr[p] * bi + Zi[p] * br;
        Cr[i] = a.in[I_CRE][(size_t)g * 1024 + i]; Ci[i] = a.in[I_CIM][(size_t)g * 1024 + i]; }
    if (tid < 64) ((float2*)(F.ws + WS_SMALL + SM_A16))[g * 64 + tid] = make_float2(Apr[16 * 64 + tid], Api[16 * 64 + tid]);
    __syncthreads();
    { const int tau = tid >> 5, c = (tid >> 1) & 15, h8 = (tid & 1) * 8; float acc8[8];
#pragma unroll
      for (int j = 0; j < 8; ++j) acc8[j] = 0.f;
      for (int p = 0; p < 64; ++p) { const float cr = Cr[c * 64 + p], ci = Ci[c * 64 + p], ar = Apr[tau * 64 + p], ai = Api[tau * 64 + p];
          const float car = cr * ar - ci * ai, cai = cr * ai + ci * ar;
          const f32x4 b0 = *(const LAS f32x4*)(Bbr + p * 16 + h8), b1 = *(const LAS f32x4*)(Bbr + p * 16 + h8 + 4), d0 = *(const LAS f32x4*)(Bbi + p * 16 + h8), d1 = *(const LAS f32x4*)(Bbi + p * 16 + h8 + 4);
#pragma unroll
          for (int j = 0; j < 4; ++j) { acc8[j] += car * b0[j] - cai * d0[j]; acc8[4 + j] += car * b1[j] - cai * d1[j]; } }
#pragma unroll
      for (int j = 0; j < 8; ++j) Kt[(tau * 16 + c) * 16 + h8 + j] = acc8[j]; }
    __syncthreads();
    bf16_t* twc = (bf16_t*)(F.ws + WS_TWC) + (size_t)g * 256 * APK;
    for (int ch = tid; ch < 256 * (APK / 8); ch += NTHREADS) { const int n = ch / (APK / 8), k0 = (ch % (APK / 8)) * 8, t = n >> 4, c = n & 15; float v[8];
#pragma unroll
        for (int j = 0; j < 8; ++j) { const int k = k0 + j;
            if (k < 256) { const int s = k >> 4, cp = k & 15; float x = (s <= t) ? Kt[((t - s) * 16 + c) * 16 + cp] : 0.f; if (s == t && cp == c) x += a.in[I_S5D][g * 16 + c]; v[j] = x; }
            else { const int q = k - 256, p = q & 63; const float cr = Cr[c * 64 + p], ci = Ci[c * 64 + p], ar = Apr[(t + 1) * 64 + p], ai = Api[(t + 1) * 64 + p];
                v[j] = (q < 64) ? (cr * ar - ci * ai) : -(cr * ai + ci * ar); } }
        u32x4 o; o.x = pk2(v[0], v[1]); o.y = pk2(v[2], v[3]); o.z = pk2(v[4], v[5]); o.w = pk2(v[6], v[7]);
        *(u32x4*)(twc + (size_t)n * APK + k0) = o; }
    bf16_t* wsm = (bf16_t*)(F.ws + WS_WS5) + (size_t)g * 256 * 256;
    for (int ch = tid; ch < 256 * 32; ch += NTHREADS) { const int n = ch >> 5, k0 = (ch & 31) * 8; float v[8];
#pragma unroll
        for (int j = 0; j < 8; ++j) { const int k = k0 + j, s = k >> 4, cp = k & 15;
            if (n < 128) { const int p = n & 63; const float ar = Apr[(15 - s) * 64 + p], ai = Api[(15 - s) * 64 + p], br = Bbr[p * 16 + cp], bi = Bbi[p * 16 + cp];
                v[j] = (n < 64) ? (ar * br - ai * bi) : (ar * bi + ai * br); } else v[j] = 0.f; }
        u32x4 o; o.x = pk2(v[0], v[1]); o.y = pk2(v[2], v[3]); o.z = pk2(v[4], v[5]); o.w = pk2(v[6], v[7]);
        *(u32x4*)(wsm + (size_t)n * 256 + k0) = o; }
    __syncthreads();
}
__device__ __forceinline__ void rms_row_to_bf16(const float* xrow, const float* gain, bf16_t* orow, int lane) {
    const f32x4* xr = (const f32x4*)xrow + lane; const f32x4* gr = (const f32x4*)gain + lane;
    f32x4 v[8]; float s = 0.f;
#pragma unroll
    for (int j = 0; j < 8; ++j) { v[j] = __builtin_nontemporal_load(xr + 64 * j); s += (v[j].x * v[j].x + v[j].y * v[j].y) + (v[j].z * v[j].z + v[j].w * v[j].w); }
    const float rstd = 1.0f / sqrtf(wave_sum(s) * (1.0f / DM) + EPS);
#if MK_FP8_INPROJ
    unsigned* o4 = (unsigned*)orow + lane; const float rs4 = rstd * FP8_ASCALE;
#pragma unroll
    for (int j = 0; j < 8; ++j) { const f32x4 gg = gr[64 * j]; o4[64 * j] = pk4_fp8(v[j].x * rs4 * gg.x, v[j].y * rs4 * gg.y, v[j].z * rs4 * gg.z, v[j].w * rs4 * gg.w); }
#else
    unsigned long long* o8 = (unsigned long long*)orow + lane;
#pragma unroll
    for (int j = 0; j < 8; ++j) { const f32x4 gg = gr[64 * j];
        o8[64 * j] = (unsigned long long)pk2(v[j].x * rstd * gg.x, v[j].y * rstd * gg.y) | ((unsigned long long)pk2(v[j].z * rstd * gg.z, v[j].w * rstd * gg.w) << 32); }
#endif
}
__device__ __forceinline__ void p0_prologue(const Args& a, const Frame& F) {
    FRAME_IDS(F);
    for (int g = F.bx; g < S5G; g += F.G) s5_build_group(a, F, g);
    __syncthreads();
    const int gw = F.bx * NWAVES + F.wave, NGW = F.G * NWAVES; const int lane = F_lane;
    for (int m = gw; m < TT; m += NGW) rms_row_to_bf16(a.in[I_X] + (size_t)m * DM, a.in[I_N1G], (bf16_t*)(F.ws + WS_H + (size_t)m * DM * (MK_FP8_INPROJ ? 1 : 2)), lane);
    for (int i = gw * 64 + lane; i < TT * 32; i += NGW * 64) { const int t = i >> 5, f = i & 31;
        const double invf = exp(-(double)f * (9.210340371976184 / 32.0)); const double ang = (double)((const int*)a.in[I_POS])[t] * invf;
        ((float2*)(F.ws + WS_ROPE))[i] = make_float2((float)cos(ang), (float)sin(ang)); }
    for (int i = gw * 64 + lane; i < DM * NE; i += NGW * 64) ((float*)(F.ws + WS_SMALL + SM_WRP))[i] = a.in[I_WR][i] * a.in[I_N2G][i >> 5];
    LAS float* scr = (LAS float*)(F.lds + F.wave * 16640);
    constexpr int IT_WIN = (DM / 64) * (NPROJ / 64), IT_WUQ = (QLORA / 64) * (3072 / 64), IT_WUKV = (KVLORA / 64) * (4096 / 64), IT_SQ = (DM / 64) * (DM / 64),
                  IT_GLU = (S5W / 64) * (S5W / 64), IT_OS5 = (S5W / 64) * (DM / 64);
    constexpr int IT_MIX = IT_WIN + IT_WUQ + IT_WUKV + IT_SQ + IT_GLU + IT_OS5 + IT_SQ;
    for (int it = gw; it < IT_MIX; it += NGW) { int r = it;
        if (r < IT_WIN) { const int nb = r % (NPROJ / 64), kb = r / (NPROJ / 64); transpose_item<MK_FP8_INPROJ != 0>(a.in[I_WIN], IN_PROJ, win_src_col(nb * 64), kb * 64, nullptr, F.ws + WS_WIN, DM, nb * 64, MK_FP8_INPROJ ? FP8_WSCALE : 1.f, scr, lane); continue; } r -= IT_WIN;
        if (r < IT_WUQ) { const int nb = r % 48, kb = r / 48; transpose_item<false>(a.in[I_WUQ], 3072, nb * 64, kb * 64, a.in[I_QNG], F.ws + WS_WUQ, QLORA, nb * 64, 1.f, scr, lane); continue; } r -= IT_WUQ;
        if (r < IT_WUKV) { const int nb = r % 64, kb = r / 64; transpose_item<false>(a.in[I_WUKV], 4096, nb * 64, kb * 64, a.in[I_KVNG], F.ws + WS_WUKV, KVLORA, nb * 64, 1.f, scr, lane); continue; } r -= IT_WUKV;
        if (r < IT_SQ) { const int nb = r % 32, kb = r / 32; transpose_item<MK_FP8_YA != 0>(a.in[I_WOMLA], DM, nb * 64, kb * 64, nullptr, F.ws + WS_WOMLA, DM, nb * 64, MK_FP8_YA ? FP8_WSCALE : 1.f, scr, lane); continue; } r -= IT_SQ;
        if (r < IT_GLU) { const int nb = r % 16, kb = r / 16; transpose_item<MK_FP8_GLU != 0>(a.in[I_WGLU], S5W, nb * 64, kb * 64, nullptr, F.ws + WS_WGLU, S5W, nb * 64, MK_FP8_GLU ? FP8_WSCALE : 1.f, scr, lane); continue; } r -= IT_GLU;
        if (r < IT_OS5) { const int nb = r % 32, kb = r / 32; transpose_item<MK_FP8_YB != 0>(a.in[I_WOS5], DM, nb * 64, kb * 64, nullptr, F.ws + WS_WOS5, S5W, nb * 64, MK_FP8_YB ? FP8_WSCALE : 1.f, scr, lane); continue; } r -= IT_OS5;
        { const int nb = r % 32, kb = r / 32; transpose_item<MK_FP8_OUT != 0>(a.in[I_WOUT], DM, nb * 64, kb * 64, nullptr, F.ws + WS_WOUT, DM, nb * 64, MK_FP8_OUT ? FP8_WSCALE : 1.f, scr, lane); }
    }
    constexpr bool W8 = MK_FP8_MOE != 0; constexpr float WSC = W8 ? FP8_WSCALE : 1.0f; constexpr int NPAIR = NE * 3 * 16 * 32; constexpr int NO = W8 ? 4 : 8;
    for (int it = gw; it < NPAIR; it += NGW) { const TItem t = moe_pair<W8>(a, F.ws, it); f32x4 v0[16], v1[16];
        ti_load(t, v0, lane); { TItem t1 = t; t1.src += (size_t)64 * DM; ti_load(t1, v1, lane); }
        u32x4 o0[NO], o1[NO];
        ti_block<W8, NO>(v0, WSC, scr, lane, o0); ti_block<W8, NO>(v1, WSC, scr, lane, o1);
        if constexpr (W8) { const int c = lane & 3;
#pragma unroll
            for (int j = 0; j < 4; ++j) { uchar* d = t.dst + (size_t)((lane >> 2) + 16 * j) * DM + 16 * c; __builtin_nontemporal_store(o0[j], (u32x4*)d); __builtin_nontemporal_store(o1[j], (u32x4*)(d + 64)); }
        } else { const int c = lane & 7;
#pragma unroll
            for (int j = 0; j < 8; ++j) { uchar* d = t.dst + ((size_t)((lane >> 3) + 8 * j) * DM + 8 * c) * 2; *(u32x4*)d = o0[j]; *(u32x4*)(d + 128) = o1[j]; } }
    }
}

constexpr float QSCALE = 0.07216878364870322f * 1.4426950408889634f;
__device__ __forceinline__ float half_sum(float v) {
#pragma unroll
    for (int o = 1; o < 32; o <<= 1) v += __shfl_xor(v, o);
    return v;
}
template <int CTRL> __device__ __forceinline__ float dpp_f(float v) { return __builtin_bit_cast(float, __builtin_amdgcn_update_dpp(0, __builtin_bit_cast(int, v), CTRL, 0xF, 0xF, true)); }
__device__ __forceinline__ void p3_prep(const Args& a, const Frame& F) {
    FRAME_IDS(F);
    const bf16_t* proj = (const bf16_t*)(F.ws + WS_PROJ); const bf16_t* kvraw = (const bf16_t*)(F.ws + WS_KVRAW); bf16_t* Kn = (bf16_t*)(F.ws + WS_KN);
    const float2* rope = (const float2*)(F.ws + WS_ROPE);
    const int lane = F_lane, row = lane >> 4, i16 = lane & 15, r8 = i16 & 7; const bool act = row < 3, isrope = row == 2; const int grp = isrope ? (i16 >> 3) : (row & 1);
    float g[8];
#pragma unroll
    for (int j = 0; j < 8; ++j) g[j] = !act ? 0.f : (isrope ? a.in[I_QKKG][128 + (j >> 2) * 32 + 4 * r8 + (j & 3)] : a.in[I_QKKG][i16 * 8 + j]);
    const bool even = (TT == 64 * F.G);
    const int tk0 = even ? F.bx * 64 + (F.wave < 2 ? 5 * F.wave : 10 + 9 * (F.wave - 2)) : F.bx * NWAVES + F.wave, tkn = even ? (F.wave < 2 ? 5 : 9) : (TT + F.G * NWAVES - 1) / (F.G * NWAVES), tks = even ? 1 : F.G * NWAVES;
    u32x4 wl[8], wn[8]; f32x4 c01 = {1.f, 0.f, 1.f, 0.f}, c23 = c01, n01 = c01, n23 = c01;
#define P3_LOAD(T_, W_, C01_, C23_) do { const int t_ = (T_), b_ = t_ >> 11, s_ = t_ & 2047; \
        if (isrope) { const bf16_t* pr_ = proj + (size_t)t_ * NPROJ + C_KR + 4 * r8; const u32x2 k1_ = *(const u32x2*)pr_, k2_ = *(const u32x2*)(pr_ + 32); \
            _Pragma("unroll") for (int i = 0; i < 8; ++i) W_[i] = (u32x4){k1_.x, k1_.y, k2_.x, k2_.y}; \
            C01_ = *(const f32x4*)(rope + (size_t)t_ * 32 + 4 * r8); C23_ = *(const f32x4*)(rope + (size_t)t_ * 32 + 4 * r8 + 2); } \
        else if (act) { const bf16_t* src0_ = kvraw + ((size_t)(b_ * NH + grp) * SEQ + s_) * 128 + i16 * 8;            \
            _Pragma("unroll") for (int i = 0; i < 8; ++i) W_[i] = *(const u32x4*)(src0_ + (size_t)i * 2 * SEQ * 128); } \
        else { _Pragma("unroll") for (int i = 0; i < 8; ++i) W_[i] = (u32x4){0u, 0u, 0u, 0u}; } } while (0)
    if (tkn > 0 && tk0 < TT) P3_LOAD(tk0, wl, c01, c23);
#pragma unroll 1
    for (int ti = 0; ti < tkn; ++ti) { const int t = tk0 + ti * tks; if (t >= TT) break;
        const int b = t >> 11, s = t & 2047; const int tn = t + tks;
        if (ti + 1 < tkn && tn < TT) P3_LOAD(tn, wn, n01, n23);
        const float cs[4] = {c01.x, c01.z, c23.x, c23.z}, sn[4] = {c01.y, c01.w, c23.y, c23.w};
#pragma unroll
        for (int i = 0; i < 8; ++i) { const int h = 2 * i + grp; const u32x4 w = wl[i];
            float x[8], ss = 0.f;
#pragma unroll
            for (int q = 0; q < 4; ++q) { x[2 * q] = bflo(w[q]); x[2 * q + 1] = bfhi(w[q]); }
#pragma unroll
            for (int j = 0; j < 8; ++j) ss += x[j] * x[j];
            ss += dpp_f<0xB1>(ss); ss += dpp_f<0x4E>(ss); ss += dpp_f<0x141>(ss);
            const float s16 = ss + dpp_f<0x140>(ss);
            const float sA = __builtin_bit_cast(float, __builtin_amdgcn_readlane(__builtin_bit_cast(int, s16), 0)) + __builtin_bit_cast(float, __builtin_amdgcn_readlane(__builtin_bit_cast(int, ss), 32));
            const float sB = __builtin_bit_cast(float, __builtin_amdgcn_readlane(__builtin_bit_cast(int, s16), 16)) + __builtin_bit_cast(float, __builtin_amdgcn_readlane(__builtin_bit_cast(int, ss), 40));
            const float rn = 1.0f / sqrtf((grp ? sB : sA) * (1.0f / DQK) + EPS);
            float y[8];
#pragma unroll
            for (int j = 0; j < 8; ++j) y[j] = x[j] * rn * g[j];
            if (isrope) { bf16_t* d = Kn + ((size_t)(b * NH + h) * SEQ + s) * DQK + 128 + 4 * r8; u32x2 o1, o2;
                o1.x = pk2(y[0] * cs[0] - y[4] * sn[0], y[1] * cs[1] - y[5] * sn[1]); o1.y = pk2(y[2] * cs[2] - y[6] * sn[2], y[3] * cs[3] - y[7] * sn[3]);
                o2.x = pk2(y[4] * cs[0] + y[0] * sn[0], y[5] * cs[1] + y[1] * sn[1]); o2.y = pk2(y[6] * cs[2] + y[2] * sn[2], y[7] * cs[3] + y[3] * sn[3]);
                *(u32x2*)d = o1; *(u32x2*)(d + 32) = o2; }
            else if (act) { u32x4 o; o.x = pk2(y[0], y[1]); o.y = pk2(y[2], y[3]); o.z = pk2(y[4], y[5]); o.w = pk2(y[6], y[7]);
                *(u32x4*)(Kn + ((size_t)(b * NH + h) * SEQ + s) * DQK + i16 * 8) = o; }
        }
#pragma unroll
        for (int i = 0; i < 8; ++i) wl[i] = wn[i];
        c01 = n01; c23 = n23;
    }
#undef P3_LOAD
}

__device__ __forceinline__ void p3_scan(const Args& a, const Frame& F) {
    FRAME_IDS(F);
    const float* sch = (const float*)(F.ws + WS_SCH); bf16_t* apack = (bf16_t*)(F.ws + WS_APACK); const float2* A16 = (const float2*)(F.ws + WS_SMALL + SM_A16);
    const int p = F_lane;
    for (int it = F.wave * F.G + F.bx; it < NB * S5G; it += F.G * NWAVES) { const int b = it / S5G, g = it % S5G;
        const float2 am = A16[g * 64 + p]; float xr = 0.f, xi = 0.f;
        const size_t row0 = (size_t)g * NCHUNK + (size_t)b * 128;
        for (int c0 = 0; c0 < 128; c0 += 32) { float sr[32], si[32];
#pragma unroll
            for (int q = 0; q < 32; ++q) { sr[q] = sch[(row0 + c0 + q) * 128 + p]; si[q] = sch[(row0 + c0 + q) * 128 + 64 + p]; }
#pragma unroll
            for (int q = 0; q < 32; ++q) { bf16_t* o = apack + (row0 + c0 + q) * APK + 256; o[p] = (bf16_t)f2bf(xr); o[64 + p] = (bf16_t)f2bf(xi);
                const float nr = am.x * xr - am.y * xi + sr[q], ni = am.x * xi + am.y * xr + si[q]; xr = nr; xi = ni; } }
    }
}

__device__ __forceinline__ void s5_reference(const Args& a, const Frame& F) {
    FRAME_IDS(F);
    const bf16_t* apack = (const bf16_t*)(F.ws + WS_APACK); bf16_t* gact = (bf16_t*)(F.ws + WS_GACT);
    const int gw = F.bx * NWAVES + F.wave, NGW = F.G * NWAVES, p = F_lane;
    for (int it = gw; it < NB * S5G; it += NGW) { const int b = it / S5G, g = it % S5G;
        const float dt = expf(a.in[I_LOGDT][g]); const float lr = a.in[I_LRE][g * 64 + p], li = a.in[I_LIM][g * 64 + p];
        const float mag = expf(lr * dt); const float ar = mag * cosf(li * dt), ai = mag * sinf(li * dt); const float den = lr * lr + li * li;
        const float zr = ((ar - 1.0f) * lr + ai * li) / den, zi = (ai * lr - (ar - 1.0f) * li) / den;
        float bbr[16], bbi[16], cr[16], ci[16];
#pragma unroll
        for (int c = 0; c < 16; ++c) { const float br = a.in[I_BRE][((size_t)g * 64 + p) * 16 + c], bi = a.in[I_BIM][((size_t)g * 64 + p) * 16 + c];
            bbr[c] = zr * br - zi * bi; bbi[c] = zr * bi + zi * br; cr[c] = a.in[I_CRE][((size_t)g * 16 + c) * 64 + p]; ci[c] = a.in[I_CIM][((size_t)g * 16 + c) * 64 + p]; }
        const float dl = (p < 16) ? a.in[I_S5D][g * 16 + p] : 0.f;
        float xr = 0.f, xi = 0.f;
        for (int t = 0; t < SEQ; ++t) { const int tok = b * SEQ + t;
            const bf16_t* up = apack + ((size_t)g * NCHUNK + (tok >> 4)) * APK + (tok & 15) * 16;
            const u32x4 w0 = *(const u32x4*)up, w1 = *(const u32x4*)(up + 8); float u[16];
#pragma unroll
            for (int q = 0; q < 4; ++q) { u[2 * q] = bflo(w0[q]); u[2 * q + 1] = bfhi(w0[q]); u[8 + 2 * q] = bflo(w1[q]); u[8 + 2 * q + 1] = bfhi(w1[q]); }
            float br = 0.f, bi = 0.f;
#pragma unroll
            for (int c = 0; c < 16; ++c) { br += bbr[c] * u[c]; bi += bbi[c] * u[c]; }
            const float nr = ar * xr - ai * xi + br, ni = ar * xi + ai * xr + bi; xr = nr; xi = ni;
            float y = 0.f, um = 0.f;
#pragma unroll
            for (int c = 0; c < 16; ++c) { const float yc = wave_sum(cr[c] * xr - ci[c] * xi); if (p == c) { y = yc; um = u[c]; } }
            if (p < 16) gact[(size_t)tok * S5W + g * 16 + p] = (bf16_t)f2bf(gelu_tanh(y + dl * um));
        }
    }
}

__device__ __forceinline__ float attn_bound(const Args& a, int lane) {
    float mq = 0.f, mk = 0.f;
#pragma unroll
    for (int q = 0; q < 3; ++q) { mq = fmaxf(mq, fabsf(a.in[I_QKQG][lane + 64 * q])); mk = fmaxf(mk, fabsf(a.in[I_QKKG][lane + 64 * q])); }
#pragma unroll
    for (int o = 1; o < 64; o <<= 1) { mq = fmaxf(mq, __shfl_xor(mq, o)); mk = fmaxf(mk, __shfl_xor(mk, o)); }
    return mq * mk * 13.856406460551018f * 1.4426950408889634f;
}
__device__ __forceinline__ void attn_reference(const Args& a, const Frame& F) {
    FRAME_IDS(F);
    const bf16_t* Qn = (const bf16_t*)(F.ws + WS_QN); const bf16_t* Kn = (const bf16_t*)(F.ws + WS_KN); const bf16_t* Vn = (const bf16_t*)(F.ws + WS_VN);
    bf16_t* O = (bf16_t*)(F.ws + WS_O);
    LAS float* ql = (LAS float*)(F.lds + F.wave * 1024);
    const int lane = F_lane, gw = F.bx * NWAVES + F.wave, NGW = F.G * NWAVES;
    const float Mb = attn_bound(a, lane);
    for (int it = gw; it < NB * NH * SEQ; it += NGW) { const int s = it & 2047, bh = it >> 11, b = bh >> 4, h = bh & 15;
        const bf16_t* qp = Qn + ((size_t)bh * SEQ + s) * DQK;
#pragma unroll
        for (int q = 0; q < 3; ++q) ql[lane + 64 * q] = bf2f(qp[lane + 64 * q]);
        LDS_WAIT();
        const int nk = 64 * ((s >> 6) + 1);
        float o0 = 0.f, o1 = 0.f, l = 0.f;
        for (int k0 = 0; k0 < nk; k0 += 64) {
            const bf16_t* kp = Kn + ((size_t)bh * SEQ + k0 + lane) * DQK; float sc = 0.f;
            for (int d = 0; d < DQK; d += 8) { const u32x4 w = *(const u32x4*)(kp + d);
#pragma unroll
                for (int q = 0; q < 4; ++q) sc += bflo(w[q]) * ql[d + 2 * q] + bfhi(w[q]) * ql[d + 2 * q + 1]; }
            const float pr = __builtin_amdgcn_exp2f(sc - Mb); l += pr;
            for (int kk = 0; kk < 64; ++kk) { const float pk = __shfl(pr, kk); const unsigned w = *(const unsigned*)(Vn + ((size_t)bh * SEQ + k0 + kk) * DV + 2 * lane);
                o0 += pk * bflo(w); o1 += pk * bfhi(w); }
        }
        l = wave_sum(l); const float rl = 1.0f / l;
        *(unsigned*)(O + ((size_t)(b * SEQ + s)) * DM + h * DV + 2 * lane) = pk2(o0 * rl, o1 * rl);
        LDS_WAIT();
    }
}

namespace at {
constexpr int KVB = 64;
constexpr int SHM_V = KVB * DV * 2  , SHM_K = KVB * DQK * 2  ;
constexpr int NQR = 4;
constexpr int OFF_V = 0, OFF_K = 2 * SHM_V, OFF_WS = OFF_K + 2 * SHM_K  , OFF_QL = OFF_WS + NWAVES * 256  , OFF_OST = 0;
constexpr int OPITCH = 272;
static_assert(OFF_QL + NWAVES * (12 - NQR) * 1024 <= LDSCTL_OFF, "attention LDS map");
#define KSWZ(row, colB) ((row) * 384 + ((colB) ^ ((((row) >> 1) & 7) << 4)))
__device__ __forceinline__ int crow(int r, int hi) { return (r & 3) + 8 * (r >> 2) + 4 * hi; }
__device__ __forceinline__ int v_st(int k, int c) { const int kk = (k & ~0xC) | ((k & 4) << 1) | ((k & 8) >> 1); return ((kk >> 3) * 4 + (c >> 5)) * 512 + ((kk & 7) * 32 + (c & 31)) * 2; }
__device__ __forceinline__ int v_rd_base(int lane) { return ((lane & 3) << 3) | (((lane >> 2) & 3) << 6) | (((lane >> 4) & 1) << 5) | (((lane >> 5) & 1) << 8); }
constexpr int v_rd_off(int d0, int ks, int half) { return d0 * 512 + ks * 4096 + half * 2048; }
template <int OFF> __device__ __forceinline__ s16x4 tr_read(int vb) { s16x4 r; asm volatile("ds_read_b64_tr_b16 %0, %1 offset:%2" : "=&v"(r) : "v"(vb), "i"(OFF) : "memory"); return r; }
template <int D0> __device__ __forceinline__ void pv_one(f32x16& od, int vb, bf16x8 pa0, bf16x8 pa1, bf16x8 pa2, bf16x8 pa3) {
    const s16x4 l0 = tr_read<v_rd_off(D0, 0, 0)>(vb), h0 = tr_read<v_rd_off(D0, 0, 1)>(vb), l1 = tr_read<v_rd_off(D0, 1, 0)>(vb), h1 = tr_read<v_rd_off(D0, 1, 1)>(vb);
    const s16x4 l2 = tr_read<v_rd_off(D0, 2, 0)>(vb), h2 = tr_read<v_rd_off(D0, 2, 1)>(vb), l3 = tr_read<v_rd_off(D0, 3, 0)>(vb), h3 = tr_read<v_rd_off(D0, 3, 1)>(vb);
    asm volatile("s_waitcnt lgkmcnt(0)" ::: "memory"); SBAR();
#define PK(L, H) (bf16x8){L[0], L[1], L[2], L[3], H[0], H[1], H[2], H[3]}
    od = __builtin_amdgcn_mfma_f32_32x32x16_bf16(pa0, PK(l0, h0), od, 0, 0, 0);
    od = __builtin_amdgcn_mfma_f32_32x32x16_bf16(pa1, PK(l1, h1), od, 0, 0, 0);
    od = __builtin_amdgcn_mfma_f32_32x32x16_bf16(pa2, PK(l2, h2), od, 0, 0, 0);
    od = __builtin_amdgcn_mfma_f32_32x32x16_bf16(pa3, PK(l3, h3), od, 0, 0, 0);
#undef PK
}
__device__ __forceinline__ void pv_d0(f32x16* o, int vb, bf16x8 pa0, bf16x8 pa1, bf16x8 pa2, bf16x8 pa3) {
    pv_one<0>(o[0], vb, pa0, pa1, pa2, pa3); pv_one<1>(o[1], vb, pa0, pa1, pa2, pa3); pv_one<2>(o[2], vb, pa0, pa1, pa2, pa3); pv_one<3>(o[3], vb, pa0, pa1, pa2, pa3);
}
template <int BUF, int NQR> __device__ __forceinline__ void qkt(f32x16& p0, f32x16& p1, const int (&kb)[4], const bf16x8* qr, int qlb, float bias) {
#pragma unroll
    for (int r = 0; r < 16; ++r) { p0[r] = bias; p1[r] = bias; }
#pragma unroll
    for (int a = 0; a < 3; ++a)
#pragma unroll
        for (int b = 0; b < 4; ++b) { const int d0 = 4 * a + b;
            const bf16x8 b0 = *(const LAS bf16x8*)(kb[b] + BUF * SHM_K + a * 128);
            const bf16x8 b1 = *(const LAS bf16x8*)(kb[b] + BUF * SHM_K + a * 128 + 32 * 384);
            bf16x8 q; if (d0 < NQR) q = qr[d0]; else q = *(const LAS bf16x8*)(qlb + (d0 - NQR) * 1024);
            p0 = __builtin_amdgcn_mfma_f32_32x32x16_bf16(b0, q, p0, 0, 0, 0);
            p1 = __builtin_amdgcn_mfma_f32_32x32x16_bf16(b1, q, p1, 0, 0, 0); }
}
__device__ __forceinline__ void partialSM(f32x16& p0, f32x16& p1) {
#pragma unroll
    for (int r = 0; r < 16; ++r) p0[r] = __builtin_amdgcn_exp2f(p0[r]);
}
__device__ __forceinline__ void finishSM(f32x16& p0, f32x16& p1, float& l_reg, bf16x8& pa0, bf16x8& pa1, bf16x8& pa2, bf16x8& pa3) {
#pragma unroll
    for (int r = 0; r < 16; ++r) p1[r] = __builtin_amdgcn_exp2f(p1[r]);
    float ps = 0;
#pragma unroll
    for (int r = 0; r < 16; ++r) ps += p0[r];
#pragma unroll
    for (int r = 0; r < 16; ++r) ps += p1[r];
    { auto rr = __builtin_amdgcn_permlane32_swap(__float_as_uint(ps), __float_as_uint(ps), false, false); ps = __uint_as_float(rr[0]) + __uint_as_float(rr[1]); }
    l_reg += ps;
#define PK4(P, BASE, OUT) do { unsigned a0 = cvt_pk_bf16(P[BASE + 0], P[BASE + 1]), a1 = cvt_pk_bf16(P[BASE + 2], P[BASE + 3]);   \
    unsigned b0 = cvt_pk_bf16(P[BASE + 4], P[BASE + 5]), b1 = cvt_pk_bf16(P[BASE + 6], P[BASE + 7]);                              \
    auto r0 = __builtin_amdgcn_permlane32_swap(a0, b0, false, false); auto r1 = __builtin_amdgcn_permlane32_swap(a1, b1, false, false); \
    u32x4 w = {r0[0], r1[0], r0[1], r1[1]}; OUT = *reinterpret_cast<bf16x8*>(&w); } while (0)
    PK4(p0, 0, pa0); PK4(p0, 8, pa1); PK4(p1, 0, pa2); PK4(p1, 8, pa3);
#undef PK4
}
__device__ __forceinline__ void attn_qblock(const bf16_t* __restrict__ Qb, const bf16_t* __restrict__ Kh, const bf16_t* __restrict__ Vh, bf16_t* __restrict__ Ob, int qb, float Mb, LAS char* lds, const int wid,
                                            const float2* __restrict__ ropeb, const float* __restrict__ gq) {
    const int lane = fresh_lane(), tid = wid * 64 + lane, r32 = lane & 31, hi = lane >> 5;
    LAS char* V_lds = lds + OFF_V; LAS char* K_lds = lds + OFF_K;
    LAS float* li_l = (LAS float*)(lds + OFF_WS) + wid * 64;
    float l_reg = 0; f32x16 o[4] = {}; bf16x8 qr[NQR];
    const int qlb = (int)(uintptr_t)(lds + OFF_QL) + wid * ((12 - NQR) * 1024) + lane * 16;
    {
        const bf16_t* Qw = Qb + (size_t)(wid * 32 + r32) * (NH * DQK) + hi * 8;
        bf16x8 qf[12];
#pragma unroll
        for (int d0 = 0; d0 < 12; ++d0) qf[d0] = *(const bf16x8*)(Qw + d0 * 16);
        float ssq = 0.f;
#pragma unroll
        for (int d0 = 0; d0 < 12; ++d0)
#pragma unroll
            for (int j = 0; j < 8; ++j) { const float v = bf2f((unsigned short)qf[d0][j]); ssq += v * v; }
        ssq += __shfl_xor(ssq, 32);
        const float rn = QSCALE / sqrtf(ssq * (1.0f / DQK) + EPS);
        const float2* rp = ropeb + (size_t)(wid * 32 + r32) * 32 + hi * 8;
#pragma unroll
        for (int d0 = 0; d0 < 12; ++d0) { bf16x8 qn;
            if (d0 < 8) { const f32x4 g0 = *(const f32x4*)(gq + d0 * 16 + hi * 8), g1 = *(const f32x4*)(gq + d0 * 16 + hi * 8 + 4);
#pragma unroll
                for (int j = 0; j < 8; ++j) qn[j] = (short)f2bf(bf2f((unsigned short)qf[d0][j]) * rn * (j < 4 ? g0[j] : g1[j - 4])); }
            else { const int pp = (d0 - 8) & 1, da = 8 + pp, db = 10 + pp; const bool second = d0 >= 10;
#pragma unroll
                for (int j = 0; j < 8; ++j) { const float2 c = rp[pp * 16 + j];
                    const float y1 = bf2f((unsigned short)qf[da][j]) * rn * gq[128 + pp * 16 + hi * 8 + j], y2 = bf2f((unsigned short)qf[db][j]) * rn * gq[160 + pp * 16 + hi * 8 + j];
                    qn[j] = (short)f2bf(second ? (y2 * c.x + y1 * c.y) : (y1 * c.x - y2 * c.y)); } }
            if (d0 < NQR) qr[d0] = qn; else *(LAS bf16x8*)(qlb + (d0 - NQR) * 1024) = qn; }
    }
    const int sr = tid >> 4, sc = (tid & 15) * 8, vst0 = v_st(sr, sc), vst1 = v_st(32 + sr, sc);
    int kro[3], kst[3];
#pragma unroll
    for (int i = 0; i < 3; ++i) { const int q = tid + 512 * i, row = q / 24, c8 = q % 24; kro[i] = row * DQK + c8 * 8; kst[i] = KSWZ(row, c8 * 16); }
    const int vb0 = (int)(uintptr_t)V_lds + v_rd_base(lane);
    int kb[4];
#pragma unroll
    for (int b = 0; b < 4; ++b) kb[b] = (int)(uintptr_t)K_lds + r32 * 384 + ((b * 32 + hi * 16) ^ (((r32 >> 1) & 7) << 4));
    bf16x8 vs0, vs1, ks0, ks1, ks2;
#define SLOAD(k0) do { vs0 = *(const bf16x8*)(Vh + (size_t)((k0) + sr) * DV + sc); vs1 = *(const bf16x8*)(Vh + (size_t)((k0) + 32 + sr) * DV + sc); \
    ks0 = *(const bf16x8*)(Kh + (size_t)(k0) * DQK + kro[0]); ks1 = *(const bf16x8*)(Kh + (size_t)(k0) * DQK + kro[1]); ks2 = *(const bf16x8*)(Kh + (size_t)(k0) * DQK + kro[2]); } while (0)
#define SWRITE(b) do { *(LAS bf16x8*)(V_lds + (b) * SHM_V + vst0) = vs0; *(LAS bf16x8*)(V_lds + (b) * SHM_V + vst1) = vs1; \
    *(LAS bf16x8*)(K_lds + (b) * SHM_K + kst[0]) = ks0; *(LAS bf16x8*)(K_lds + (b) * SHM_K + kst[1]) = ks1; *(LAS bf16x8*)(K_lds + (b) * SHM_K + kst[2]) = ks2; } while (0)
    const int NT = 4 * qb + 4, jmax = 4 * qb + (wid >> 1);
    f32x16 pA0, pA1, pB0, pB1; bf16x8 pa0, pa1, pa2, pa3;
    SLOAD(0); asm volatile("s_waitcnt vmcnt(0)" ::: "memory"); SWRITE(0); __syncthreads();
    qkt<0, NQR>(pA0, pA1, kb, qr, qlb, -Mb); partialSM(pA0, pA1);
    SLOAD(KVB); asm volatile("s_waitcnt vmcnt(0)" ::: "memory"); SWRITE(1); __syncthreads();
    for (int j = 1; j + 1 < NT; j += 2) {
        SBAR(); if (j <= jmax) qkt<1, NQR>(pB0, pB1, kb, qr, qlb, -Mb);
        if (j - 1 <= jmax) finishSM(pA0, pA1, l_reg, pa0, pa1, pa2, pa3); SBAR();
        SLOAD((j + 1) * KVB); SBAR();
        if (j - 1 <= jmax) pv_d0(o, vb0, pa0, pa1, pa2, pa3); if (j <= jmax) partialSM(pB0, pB1);
        __syncthreads(); asm volatile("s_waitcnt vmcnt(0)" ::: "memory"); SWRITE(0);
        __syncthreads();
        SBAR(); if (j + 1 <= jmax) qkt<0, NQR>(pA0, pA1, kb, qr, qlb, -Mb);
        if (j <= jmax) finishSM(pB0, pB1, l_reg, pa0, pa1, pa2, pa3); SBAR();
        SLOAD((j + 2) * KVB); SBAR();
        if (j <= jmax) pv_d0(o, vb0 + SHM_V, pa0, pa1, pa2, pa3); if (j + 1 <= jmax) partialSM(pA0, pA1);
        __syncthreads(); asm volatile("s_waitcnt vmcnt(0)" ::: "memory"); SWRITE(1);
        __syncthreads();
    }
    SBAR(); if (NT - 1 <= jmax) qkt<1, NQR>(pB0, pB1, kb, qr, qlb, -Mb);
    if (NT - 2 <= jmax) { finishSM(pA0, pA1, l_reg, pa0, pa1, pa2, pa3); SBAR(); pv_d0(o, vb0, pa0, pa1, pa2, pa3); }
    if (NT - 1 <= jmax) { partialSM(pB0, pB1); finishSM(pB0, pB1, l_reg, pa0, pa1, pa2, pa3); SBAR(); pv_d0(o, vb0 + SHM_V, pa0, pa1, pa2, pa3); }
    __syncthreads();
    const int lane2 = fresh_lane(), r32b = lane2 & 31, hib = lane2 >> 5, wid2 = wid;
    LAS float* li2 = (LAS float*)(lds + OFF_WS) + wid2 * 64;
    if (hib == 0) li2[r32b] = l_reg; LDS_WAIT();
    LAS char* ost = lds + OFF_OST + wid2 * (32 * OPITCH) + hib * (4 * OPITCH) + r32b * 2;
#pragma unroll
    for (int r = 0; r < 16; ++r) { const int orc = (r & 3) + 8 * (r >> 2); const float rl = __builtin_amdgcn_rcpf(li2[orc + 4 * hib]);
#pragma unroll
        for (int d0 = 0; d0 < 4; ++d0) *(LAS bf16_t*)(ost + orc * OPITCH + d0 * 64) = (bf16_t)f2bf(o[d0][r] * rl); }
    LDS_WAIT();
    const LAS char* ord = lds + OFF_OST + wid2 * (32 * OPITCH) + (lane2 >> 4) * OPITCH + (lane2 & 15) * 16;
#if MK_FP8_YA
    uchar* Ow = (uchar*)Ob + (size_t)(wid2 * 32 + (lane2 >> 4)) * DM + (lane2 & 15) * 8;
#pragma unroll
    for (int i = 0; i < 8; ++i) { const u32x4 w = *(const LAS u32x4*)(ord + i * 4 * OPITCH); u32x2 o8;
        o8.x = pk4_fp8c(bflo(w.x) * FP8_XSCALE, bfhi(w.x) * FP8_XSCALE, bflo(w.y) * FP8_XSCALE, bfhi(w.y) * FP8_XSCALE); o8.y = pk4_fp8c(bflo(w.z) * FP8_XSCALE, bfhi(w.z) * FP8_XSCALE, bflo(w.w) * FP8_XSCALE, bfhi(w.w) * FP8_XSCALE);
        *(u32x2*)(Ow + (size_t)(i * 4) * DM) = o8; }
#else
    bf16_t* Ow = Ob + (size_t)(wid2 * 32 + (lane2 >> 4)) * DM + (lane2 & 15) * 8;
#pragma unroll
    for (int i = 0; i < 8; ++i) { const u32x4 w = *(const LAS u32x4*)(ord + i * 4 * OPITCH); *(u32x4*)(Ow + (size_t)(i * 4) * DM) = w; }
#endif
    __syncthreads();
#undef SLOAD
#undef SWRITE
}
#undef KSWZ
}
__device__ __forceinline__ void p4_attention(const Args& a, const Frame& F) {
    FRAME_IDS(F);
    const bf16_t* qraw = (const bf16_t*)(F.ws + WS_QRAW); const bf16_t* Kn = (const bf16_t*)(F.ws + WS_KN); const bf16_t* Vn = (const bf16_t*)(F.ws + WS_VN);
    bf16_t* O = (bf16_t*)(F.ws + WS_O); const float2* rope = (const float2*)(F.ws + WS_ROPE);
    const float Mb = attn_bound(a, F_lane);
    for (int id = F.bx; id < NB * NH * 4; id += F.G) { const int x = id & 7, idx = id >> 3, bh = x + 8 * (idx >> 2), pr = idx & 3, b = bh >> 4, h = bh & 15;
        const bf16_t* Kh = Kn + (size_t)bh * SEQ * DQK; const bf16_t* Vh = Vn + (size_t)bh * SEQ * DV;
#pragma unroll 1
        for (int w = 0; w < 2; ++w) { const int qb = w ? pr : 7 - pr; const size_t tok0 = (size_t)b * SEQ + qb * 256;
            at::attn_qblock(qraw + tok0 * (NH * DQK) + h * DQK, Kh, Vh, (bf16_t*)((uchar*)O + (tok0 * DM + h * DV) * (MK_FP8_YA ? 1 : 2)), qb, Mb, (LAS char*)F.lds, F.wave, rope + tok0 * 32, a.in[I_QKQG]); }
    }
}

__device__ __forceinline__ void p8_norm2_router(const Args& a, const Frame& F, const float* x1) {
    FRAME_IDS(F);
    bf16_t* H2 = (bf16_t*)(F.ws + WS_H2); int* topi = (int*)(F.ws + WS_TOPI); float* topw = (float*)(F.ws + WS_TOPW);
    const float* wrp = (const float*)(F.ws + WS_SMALL + SM_WRP); const float* g2 = a.in[I_N2G];
    const int lane = F_lane, wave = F.wave, tid = F_tid, i = lane & 31, kk = lane >> 5;
    LAS uchar* xs = F.lds + wave * 8704;
    LAS float* part = (LAS float*)(F.lds + 69632);
    LAS float* ssqp = (LAS float*)(F.lds + 69632 + 33792);
    LAS float* logit = ssqp + 256;
    LAS float* rstdl = logit + 32 * 33;
#if MK_HIST_ROUTE
    const int NTB = (TT / 32 + F.G - 1) / F.G;
    LAS int* pick = (LAS int*)(F.lds + 110592);
    for (int tj = 0; tj < NTB; ++tj) { const int tile = F.bx * NTB + tj; if (tile >= TT / 32) break;
#else
    for (int tile = F.bx; tile < TT / 32; tile += F.G) {
#endif
        const int t0 = tile * 32;
        f32x16 acc = {}; float ssq = 0.f;
        for (int ch = 0; ch < 4; ++ch) { const int k0 = wave * 256 + ch * 64;
            f32x4 v[8];
#pragma unroll
            for (int j = 0; j < 8; ++j) {
#if MK_X1_BF16
                const u32x2 w = *(const u32x2*)((const bf16_t*)x1 + (size_t)(t0 + 4 * j + (lane >> 4)) * DM + k0 + (lane & 15) * 4); v[j] = (f32x4){bflo(w.x), bfhi(w.x), bflo(w.y), bfhi(w.y)};
#else
                v[j] = *(const f32x4*)(x1 + (size_t)(t0 + 4 * j + (lane >> 4)) * DM + k0 + (lane & 15) * 4);
#endif
            }
#pragma unroll
            for (int j = 0; j < 8; ++j) *(LAS f32x4*)(xs + (4 * j + (lane >> 4)) * 272 + (lane & 15) * 16) = v[j];
            LDS_WAIT(); asm volatile("" ::: "memory");
            const float* wp = wrp + (size_t)(k0 + kk * 32) * NE + i;
#pragma unroll
            for (int s4 = 0; s4 < 8; ++s4) { const f32x4 xv = *(const LAS f32x4*)(xs + i * 272 + kk * 128 + s4 * 16);
#pragma unroll
                for (int q = 0; q < 4; ++q) { const float b = wp[(s4 * 4 + q) * NE]; acc = __builtin_amdgcn_mfma_f32_32x32x2f32(xv[q], b, acc, 0, 0, 0); ssq += xv[q] * xv[q]; } }
            LDS_WAIT(); asm volatile("" ::: "memory");
        }
#pragma unroll
        for (int r = 0; r < 16; ++r) part[(wave * 32 + (r & 3) + 8 * (r >> 2) + 4 * kk) * 33 + i] = acc[r];
        ssq += __shfl_xor(ssq, 32);
        if (kk == 0) ssqp[wave * 32 + i] = ssq;
        __syncthreads();
        { const int row = tid >> 4, e0 = (tid & 15) * 2; float s0 = 0.f, s1 = 0.f;
#pragma unroll
          for (int w = 0; w < 8; ++w) { s0 += part[(w * 32 + row) * 33 + e0]; s1 += part[(w * 32 + row) * 33 + e0 + 1]; }
          logit[row * 33 + e0] = s0; logit[row * 33 + e0 + 1] = s1;
          if (tid < 32) { float q = 0.f;
#pragma unroll
              for (int w = 0; w < 8; ++w) q += ssqp[w * 32 + tid];
              rstdl[tid] = 1.0f / sqrtf(q * (1.0f / DM) + EPS); } }
        __syncthreads();
        if (tid < 32) { const float rs = rstdl[tid]; float lg[32];
#pragma unroll
            for (int e = 0; e < 32; ++e) lg[e] = logit[tid * 33 + e] * rs + a.in[I_BR][e];
            int bi[4]; float bv[4];
#pragma unroll
            for (int k = 0; k < 4; ++k) { float m = -3.0e38f; int mi = 0;
#pragma unroll
                for (int e = 0; e < 32; ++e) { const bool used = (k > 0 && bi[0] == e) || (k > 1 && bi[1] == e) || (k > 2 && bi[2] == e); if (!used && lg[e] > m) { m = lg[e]; mi = e; } }
                bi[k] = mi; bv[k] = m; }
            const float e1 = __expf(bv[1] - bv[0]), e2 = __expf(bv[2] - bv[0]), e3 = __expf(bv[3] - bv[0]); const float rsum = 1.0f / (1.0f + e1 + e2 + e3);
            const int t = t0 + tid;
            *(int4*)(topi + 4 * t) = make_int4(bi[0], bi[1], bi[2], bi[3]); *(float4*)(topw + 4 * t) = make_float4(rsum, e1 * rsum, e2 * rsum, e3 * rsum);
#if MK_HIST_ROUTE
            *(LAS v4i*)(pick + 4 * (tj * 32 + tid)) = (v4i){bi[0], bi[1], bi[2], bi[3]}; ((float*)(F.ws + WS_RSTD2))[t] = rs;
#endif
            }
#if !MK_HIST_ROUTE
#pragma unroll 4
        for (int it = 0; it < 16; ++it) { const int idx = it * NTHREADS + tid, row = idx >> 8, c8 = (idx & 255) * 8; const float rs = rstdl[row];
#if MK_X1_BF16
            const u32x4 xq = *(const u32x4*)((const bf16_t*)x1 + (size_t)(t0 + row) * DM + c8); const f32x4 x0 = {bflo(xq.x), bfhi(xq.x), bflo(xq.y), bfhi(xq.y)}, x1v = {bflo(xq.z), bfhi(xq.z), bflo(xq.w), bfhi(xq.w)};
#else
            const f32x4 x0 = *(const f32x4*)(x1 + (size_t)(t0 + row) * DM + c8), x1v = *(const f32x4*)(x1 + (size_t)(t0 + row) * DM + c8 + 4);
#endif
            const f32x4 g0 = *(const f32x4*)(g2 + c8), g1 = *(const f32x4*)(g2 + c8 + 4);
#if MK_FP8_MOE
            const float rs4 = rs * FP8_ASCALE; u32x2 o; o.x = pk4_fp8(x0.x * rs4 * g0.x, x0.y * rs4 * g0.y, x0.z * rs4 * g0.z, x0.w * rs4 * g0.w); o.y = pk4_fp8(x1v.x * rs4 * g1.x, x1v.y * rs4 * g1.y, x1v.z * rs4 * g1.z, x1v.w * rs4 * g1.w);
            *(u32x2*)((uchar*)H2 + (size_t)(t0 + row) * DM + c8) = o; }
#else
            u32x4 o; o.x = pk2(x0.x * rs * g0.x, x0.y * rs * g0.y); o.y = pk2(x0.z * rs * g0.z, x0.w * rs * g0.w); o.z = pk2(x1v.x * rs * g1.x, x1v.y * rs * g1.y); o.w = pk2(x1v.z * rs * g1.z, x1v.w * rs * g1.w);
            *(u32x4*)(H2 + (size_t)(t0 + row) * DM + c8) = o; }
#endif
#endif
        __syncthreads();
    }
#if MK_HIST_ROUTE
    { const int tb0 = F.bx * NTB * 32, ntok = (TT - tb0) < NTB * 32 ? ((TT - tb0) > 0 ? (TT - tb0) : 0) : NTB * 32; int* tpos = (int*)(F.ws + WS_TPOS); int* hist = (int*)(F.ws + WS_HIST);
      for (int pr = tid; pr < ntok * 4; pr += NTHREADS) { const int tl = pr >> 2, e = pick[pr]; int lr = 0;
          for (int tp = 0; tp < tl; ++tp) { const v4i pk = *(const LAS v4i*)(pick + 4 * tp); lr += (pk.x == e) + (pk.y == e) + (pk.z == e) + (pk.w == e); }
          tpos[4 * tb0 + pr] = lr; }
      if (tid < NE) { int c = 0; for (int q = 0; q < ntok * 4; ++q) c += (pick[q] == tid) ? 1 : 0; hist[F.bx * NE + tid] = c; } }
#endif
}

__device__ __forceinline__ void p9_routing(const Args& a, const Frame& F) {
    FRAME_IDS(F);
    const int* topi = (const int*)(F.ws + WS_TOPI); int* tpos = (int*)(F.ws + WS_TPOS); int* list = (int*)(F.ws + WS_LIST); int* counts = (int*)(F.ws + WS_SMALL + SM_COUNTS);
    LAS int* wtot = (LAS int*)F.lds;
    constexpr int NIT = TT / NWAVES / 64;
    for (int e = F.bx; e < NE; e += F.G) {
        __syncthreads();
        const int t0 = F.wave * (TT / NWAVES);
        int kk[NIT];
#pragma unroll
        for (int i = 0; i < NIT; ++i) { const int4 ti = *(const int4*)(topi + 4 * (t0 + i * 64 + F_lane)); kk[i] = (ti.x == e) ? 0 : (ti.y == e) ? 1 : (ti.z == e) ? 2 : (ti.w == e) ? 3 : -1; }
        int cnt = 0;
#pragma unroll
        for (int i = 0; i < NIT; ++i) cnt += __popcll(__ballot(kk[i] >= 0));
        if (F_lane == 0) wtot[F.wave] = cnt;
        __syncthreads();
        int base = 0, total = 0;
        for (int w = 0; w < NWAVES; ++w) { const int c = wtot[w]; if (w < F.wave) base += c; total += c; }
#pragma unroll
        for (int i = 0; i < NIT; ++i) { const int t = t0 + i * 64 + F_lane; const int k = kk[i];
            const unsigned long long bal = __ballot(k >= 0); const int pos = base + __popcll(bal & ((1ull << F_lane) - 1ull));
            if (k >= 0) { list[(size_t)e * TT + pos] = t; tpos[4 * t + k] = pos; }
            base += __popcll(bal); }
        for (int q = total + F_tid; q < ((total + 255) & ~255); q += NTHREADS) list[(size_t)e * TT + q] = 0;
        if (F_tid == 0) counts[e] = total;
    }
}
__device__ __forceinline__ void moe_tables(const Frame& F, LAS int* tab) {
    FRAME_IDS(F);
    const int* counts = (const int*)(F.ws + WS_SMALL + SM_COUNTS);
    __syncthreads();
    if (F_tid < NE) { const int c = counts[F_tid]; tab[F_tid] = c; const int nt = (c + 255) >> 8; tab[32 + F_tid] = nt; tab[128 + F_tid] = nt > 0 ? ((1 << 20) + nt - 1) / nt : 0; }
    __syncthreads();
    if (F_tid < NE) { const int e = F_tid, me = tab[32 + e]; int pre = 0, rank = 0;
        for (int q = 0; q < NE; ++q) { const int v = tab[32 + q]; pre += (q < e) ? v : 0; rank += (v > me || (v == me && q < e)) ? 1 : 0; }
        tab[64 + e] = pre; if (e == NE - 1) tab[96] = pre + me;
        const int q4 = rank >> 3, pos = rank & 7, xx = (q4 & 1) ? 7 - pos : pos; tab[160 + xx * 4 + q4] = e; }
    __syncthreads();
}

#if MK_HIST_ROUTE
__device__ __forceinline__ void moe_tables_hist(const Frame& F, LAS int* tab) {
    FRAME_IDS(F);
    const int* hist = (const int*)(F.ws + WS_HIST); LAS int* red = (LAS int*)F.lds;
    __syncthreads();
    { const int e = F_tid & 31, part = F_tid >> 5; int tot = 0, bef = 0;
      for (int w = part; w < F.G; w += 16) { const int v = hist[w * NE + e]; tot += v; bef += (w < F.bx) ? v : 0; }
      red[part * 32 + e] = tot; red[512 + part * 32 + e] = bef; }
    __syncthreads();
    if (F_tid < NE) { int tot = 0, bef = 0;
#pragma unroll
        for (int q = 0; q < 16; ++q) { tot += red[q * 32 + F_tid]; bef += red[512 + q * 32 + F_tid]; }
        tab[F_tid] = tot; tab[192 + F_tid] = bef; const int nt = (tot + 255) >> 8; tab[32 + F_tid] = nt; tab[128 + F_tid] = nt > 0 ? ((1 << 20) + nt - 1) / nt : 0; }
    __syncthreads();
    if (F_tid < NE) { const int e = F_tid, me = tab[32 + e]; int pre = 0, rank = 0;
        for (int q = 0; q < NE; ++q) { const int v = tab[32 + q]; pre += (q < e) ? v : 0; rank += (v > me || (v == me && q < e)) ? 1 : 0; }
        tab[64 + e] = pre; if (e == NE - 1) tab[96] = pre + me;
        const int q4 = rank >> 3, pos = rank & 7, xx = (q4 & 1) ? 7 - pos : pos; tab[160 + xx * 4 + q4] = e; }
    __syncthreads();
}
__device__ __forceinline__ void p10_place(const Args& a, const Frame& F, const LAS int* tab) {
    FRAME_IDS(F);
    const bf16_t* x1 = (const bf16_t*)(F.ws + WS_X1); uchar* XP = F.ws + WS_XPERM; const int* topi = (const int*)(F.ws + WS_TOPI); int* tpos = (int*)(F.ws + WS_TPOS); const float* rstd2 = (const float*)(F.ws + WS_RSTD2);
    const int lane = F_lane, NTB = (TT / 32 + F.G - 1) / F.G, tb0 = F.bx * NTB * 32;
    f32x4 gg[8];
#pragma unroll
    for (int q = 0; q < 8; ++q) gg[q] = *(const f32x4*)(a.in[I_N2G] + (q >> 2) * 1024 + 16 * lane + (q & 3) * 4) * FP8_ASCALE;
    for (int tl0 = F.wave * 4; tl0 < NTB * 32; tl0 += NWAVES * 4) {
        u32x4 xv[4][4]; int sl[4][4]; float rs[4];
#pragma unroll
        for (int q = 0; q < 4; ++q) { const int t = tb0 + tl0 + q; const bool ok = t < TT; const int tc = ok ? t : 0;
#pragma unroll
            for (int c = 0; c < 4; ++c) xv[q][c] = *(const u32x4*)(x1 + (size_t)tc * DM + (c >> 1) * 1024 + 16 * lane + (c & 1) * 8);
            const int4 ti = *(const int4*)(topi + 4 * tc), lr = *(const int4*)(tpos + 4 * tc); rs[q] = rstd2[tc];
            const int p0 = tab[192 + ti.x] + lr.x, p1 = tab[192 + ti.y] + lr.y, p2 = tab[192 + ti.z] + lr.z, p3 = tab[192 + ti.w] + lr.w;
            sl[q][0] = ok ? tab[64 + ti.x] * 256 + p0 : -1; sl[q][1] = ok ? tab[64 + ti.y] * 256 + p1 : -1; sl[q][2] = ok ? tab[64 + ti.z] * 256 + p2 : -1; sl[q][3] = ok ? tab[64 + ti.w] * 256 + p3 : -1;
            if (ok && lane == 0) *(int4*)(tpos + 4 * tc) = make_int4(p0, p1, p2, p3); }
#pragma unroll
        for (int q = 0; q < 4; ++q) { u32x4 o[2];
#pragma unroll
            for (int hf = 0; hf < 2; ++hf) { const u32x4 w0 = xv[q][2 * hf], w1 = xv[q][2 * hf + 1]; const float r = rs[q]; unsigned ow[4];
#pragma unroll
                for (int d = 0; d < 4; ++d) { const unsigned lo = d < 2 ? w0[2 * d] : w1[2 * d - 4], hi = d < 2 ? w0[2 * d + 1] : w1[2 * d - 3]; const f32x4 g4 = gg[hf * 4 + d];
                    ow[d] = pk4_fp8(bflo(lo) * r * g4.x, bfhi(lo) * r * g4.y, bflo(hi) * r * g4.z, bfhi(hi) * r * g4.w); }
                o[hf] = (u32x4){ow[0], ow[1], ow[2], ow[3]}; }
#pragma unroll
            for (int k = 0; k < 4; ++k) if (sl[q][k] >= 0) { uchar* d = XP + (size_t)sl[q][k] * DM + 16 * lane; *(u32x4*)d = o[0]; *(u32x4*)(d + 1024) = o[1]; } }
    }
}
#endif
__device__ __forceinline__ void p10_permute(const Args& a, const Frame& F, const LAS int* tab) {
    FRAME_IDS(F);
    constexpr size_t ROWB = MK_FP8_MOE ? DM : 2 * DM;
    const uchar* H2 = F.ws + WS_H2; uchar* XP = F.ws + WS_XPERM; const int* list = (const int*)(F.ws + WS_LIST);
    const int ntiles = tab[96];
    for (int tile = F.bx; tile < ntiles; tile += F.G) {
        int e = 0;
#pragma unroll 1
        for (int q = 1; q < NE; ++q) if (tab[64 + q] <= tile) e = q;
        const int p0 = (tile - tab[64 + e]) * 256;
        for (int r0 = F.wave * 32; r0 < F.wave * 32 + 32; r0 += 8) { int tok[8]; u32x4 v[8][ROWB / 1024];
#pragma unroll
            for (int q = 0; q < 8; ++q) tok[q] = list[(size_t)e * TT + p0 + r0 + q];
#pragma unroll
            for (int q = 0; q < 8; ++q)
#pragma unroll
                for (int c = 0; c < (int)(ROWB / 1024); ++c) v[q][c] = *(const u32x4*)(H2 + (size_t)tok[q] * ROWB + c * 1024 + F_lane * 16);
#pragma unroll
            for (int q = 0; q < 8; ++q)
#pragma unroll
                for (int c = 0; c < (int)(ROWB / 1024); ++c) *(u32x4*)(XP + ((size_t)tile * 256 + r0 + q) * ROWB + c * 1024 + F_lane * 16) = v[q][c]; }
    }
}

__device__ __forceinline__ void p12_combine(const Args& a, const Frame& F, float* out, const LAS int* tab) {
    FRAME_IDS(F);
    const int* topi = (const int*)(F.ws + WS_TOPI); const float* topw = (const float*)(F.ws + WS_TOPW); const int* tpos = (const int*)(F.ws + WS_TPOS);
    const int lane = F_lane, gw = F.bx * NWAVES + F.wave, NGW = F.G * NWAVES;
#if MK_FP8_MOE
    const uchar* ys = F.ws + WS_YSLOT;
    for (int t = gw; t < TT; t += NGW) {
        const int4 ti = *(const int4*)(topi + 4 * t), tp = *(const int4*)(tpos + 4 * t); float4 tw = *(const float4*)(topw + 4 * t);
        tw.x *= 1.0f / FP8_YSCALE; tw.y *= 1.0f / FP8_YSCALE; tw.z *= 1.0f / FP8_YSCALE; tw.w *= 1.0f / FP8_YSCALE;
        const uchar* r0 = ys + ((size_t)tab[64 + ti.x] * 256 + tp.x) * DM; const uchar* r1 = ys + ((size_t)tab[64 + ti.y] * 256 + tp.y) * DM;
        const uchar* r2 = ys + ((size_t)tab[64 + ti.z] * 256 + tp.z) * DM; const uchar* r3 = ys + ((size_t)tab[64 + ti.w] * 256 + tp.w) * DM;
        float* orow = out + (size_t)t * DM;
        u32x2 y0[4], y1[4], y2[4], y3[4]; f32x4 xa[4], xb[4];
#pragma unroll
        for (int j = 0; j < 4; ++j) { const int c = j * 512 + lane * 8; y0[j] = *(const u32x2*)(r0 + c); y1[j] = *(const u32x2*)(r1 + c); y2[j] = *(const u32x2*)(r2 + c); y3[j] = *(const u32x2*)(r3 + c);
#if MK_X1_BF16
            const u32x4 xq = *(const u32x4*)((const bf16_t*)(F.ws + WS_X1) + (size_t)t * DM + c); xa[j] = (f32x4){bflo(xq.x), bfhi(xq.x), bflo(xq.y), bfhi(xq.y)}; xb[j] = (f32x4){bflo(xq.z), bfhi(xq.z), bflo(xq.w), bfhi(xq.w)}; }
#else
            xa[j] = *(const f32x4*)(orow + c); xb[j] = *(const f32x4*)(orow + c + 4); }
#endif
#pragma unroll
        for (int j = 0; j < 4; ++j) { const int c = j * 512 + lane * 8; f32x4 x0 = xa[j], x1 = xb[j];
#define ACC4(X, Y, W) do { const f32x2 lo = __builtin_amdgcn_cvt_pk_f32_fp8((int)(Y), false), hi2 = __builtin_amdgcn_cvt_pk_f32_fp8((int)(Y), true); X[0] += (W) * lo.x; X[1] += (W) * lo.y; X[2] += (W) * hi2.x; X[3] += (W) * hi2.y; } while (0)
            ACC4(x0, y0[j].x, tw.x); ACC4(x1, y0[j].y, tw.x); ACC4(x0, y1[j].x, tw.y); ACC4(x1, y1[j].y, tw.y);
            ACC4(x0, y2[j].x, tw.z); ACC4(x1, y2[j].y, tw.z); ACC4(x0, y3[j].x, tw.w); ACC4(x1, y3[j].y, tw.w);
#undef ACC4
            *(f32x4*)(orow + c) = x0; *(f32x4*)(orow + c + 4) = x1; }
    }
#else
    const bf16_t* ys = (const bf16_t*)(F.ws + WS_YSLOT);
    for (int t = gw; t < TT; t += NGW) {
        const int4 ti = *(const int4*)(topi + 4 * t), tp = *(const int4*)(tpos + 4 * t); const float4 tw = *(const float4*)(topw + 4 * t);
        const bf16_t* r0 = ys + ((size_t)tab[64 + ti.x] * 256 + tp.x) * DM; const bf16_t* r1 = ys + ((size_t)tab[64 + ti.y] * 256 + tp.y) * DM;
        const bf16_t* r2 = ys + ((size_t)tab[64 + ti.z] * 256 + tp.z) * DM; const bf16_t* r3 = ys + ((size_t)tab[64 + ti.w] * 256 + tp.w) * DM;
        float* orow = out + (size_t)t * DM;
#pragma unroll
        for (int j = 0; j < 4; ++j) { const int c = j * 512 + lane * 8;
            const u32x4 a0 = *(const u32x4*)(r0 + c), a1 = *(const u32x4*)(r1 + c), a2 = *(const u32x4*)(r2 + c), a3 = *(const u32x4*)(r3 + c);
            f32x4 x0 = *(const f32x4*)(orow + c), x1 = *(const f32x4*)(orow + c + 4);
#pragma unroll
            for (int q = 0; q < 2; ++q) {
                x0[2 * q] += tw.x * bflo(a0[q]) + tw.y * bflo(a1[q]) + tw.z * bflo(a2[q]) + tw.w * bflo(a3[q]);
                x0[2 * q + 1] += tw.x * bfhi(a0[q]) + tw.y * bfhi(a1[q]) + tw.z * bfhi(a2[q]) + tw.w * bfhi(a3[q]);
                x1[2 * q] += tw.x * bflo(a0[2 + q]) + tw.y * bflo(a1[2 + q]) + tw.z * bflo(a2[2 + q]) + tw.w * bflo(a3[2 + q]);
                x1[2 * q + 1] += tw.x * bfhi(a0[2 + q]) + tw.y * bfhi(a1[2 + q]) + tw.z * bfhi(a2[2 + q]) + tw.w * bfhi(a3[2 + q]); }
            *(f32x4*)(orow + c) = x0; *(f32x4*)(orow + c + 4) = x1; }
    }
#endif
}

constexpr int NPHASE = 14;
__global__ void __launch_bounds__(NTHREADS, 2) mk_fwd(Args a) {
    extern __shared__ __attribute__((aligned(16))) uchar lds_raw[];
    Frame F; F.lds = (LAS uchar*)lds_raw; F.ws = a.ws; F.wave = __builtin_amdgcn_readfirstlane(threadIdx.x >> 6); F.G = gridDim.x; F.bx = blockIdx.x;
    FRAME_IDS(F);
    volatile LAS unsigned* MISC = (volatile LAS unsigned*)(F.lds + MISC_OFF);
    LAS int* tab = (LAS int*)(F.lds + LDSCTL_OFF + 512);
    for (int u = F_tid; u < (LDS_BYTES - LDSCTL_OFF) / 4; u += NTHREADS) ((LAS unsigned*)(F.lds + LDSCTL_OFF))[u] = 0u;
    __syncthreads();
    XcdBarrier bar; bar.bar = (unsigned*)(a.ws + WS_CTL) + CW_BAR; bar.x = 0; bar.st = nullptr; bar.wave = F.wave;
    const int lo = a.ph_lo, hi = a.ph_hi;
    if (hi - lo > 1) bar = xcd_barrier_post((unsigned*)(a.ws + WS_CTL) + CW_BAR, MISC + 8, F.wave);
#ifndef MK_PHASE_MASK
#define MK_PHASE_MASK 0xffff
#endif
#define IN(k) (((MK_PHASE_MASK >> (k)) & 1) && lo <= (k) && (k) < hi)
#ifdef MK_PROBE_LO
    volatile LAS unsigned long long* pr_t = (volatile LAS unsigned long long*)(F.lds + LDSCTL_OFF + 64);
#ifdef MK_PROBE_CLK
#define PROBE_NOW() __builtin_amdgcn_s_memtime()
#else
#define PROBE_NOW() __builtin_amdgcn_s_memrealtime()
#endif
#define PROBE_AT(k) do { if ((k) == MK_PROBE_LO && F.wave == 0 && fresh_lane() == 0) pr_t[0] = PROBE_NOW(); if ((k) == MK_PROBE_HI + 1 && F.wave == 0 && fresh_lane() == 0) pr_t[1] = PROBE_NOW(); } while (0)
#else
#define PROBE_AT(k) do { } while (0)
#endif
#define SEAM(k) do { if (IN(k) && IN((k) + 1)) xcd_barrier(bar); } while (0)
    LAS uchar* ring = F.lds;
    uchar* ws = a.ws;
    const int G = F.G, bx = F.bx;

    PROBE_AT(0);
    if (IN(0)) { p0_prologue(a, F); } SEAM(0); PROBE_AT(1);

    if (IN(1)) {
        gm::ProbDense P; P.init((const bf16_t*)(ws + WS_H), DM, (const bf16_t*)(ws + WS_WIN), DM, MK_FP8_INPROJ ? DM / 2 : DM, TT, NPROJ, G, bx);
        EpiInProj E{(bf16_t*)(ws + WS_PROJ), (bf16_t*)(ws + WS_APACK), a.in[I_BG], (float*)(ws + WS_SSQP)};
        gm::gemm_phase<gm::ProbDense, EpiInProj, false, MK_FP8_INPROJ != 0>(ring, P, E, F.wave);
    } SEAM(1); PROBE_AT(2);

    if (IN(2)) {
        { gm::ProbDense P; P.init((const bf16_t*)(ws + WS_PROJ) + C_QLAT, NPROJ, (const bf16_t*)(ws + WS_WUQ), QLORA, QLORA, TT, NH * DQK, G, bx);
          EpiStoreScaled<0, 8, QLORA> E{(bf16_t*)(ws + WS_QRAW), NH * DQK, (const float*)(ws + WS_SSQP)}; gm::gemm_phase<gm::ProbDense, EpiStoreScaled<0, 8, QLORA>, false>(ring, P, E, F.wave); }
        { gm::ProbDense P; P.init((const bf16_t*)(ws + WS_PROJ) + C_KVLAT, NPROJ, (const bf16_t*)(ws + WS_WUKV), KVLORA, KVLORA, TT, NH * 256, G, bx);
          EpiKV E{(bf16_t*)(ws + WS_KVRAW), (bf16_t*)(ws + WS_VN), (const float*)(ws + WS_SSQP)}; gm::gemm_phase<gm::ProbDense, EpiKV, false>(ring, P, E, F.wave); }
#if MK_FAST_S5
        { ProbS5 P{(const bf16_t*)(ws + WS_APACK), (const bf16_t*)(ws + WS_WS5), APK, 256, 4, G, bx};
          EpiS5State E{(float*)(ws + WS_SCH)}; gm::gemm_phase<ProbS5, EpiS5State, false>(ring, P, E, F.wave); }
#endif
    } SEAM(2); PROBE_AT(3);

    if (IN(3)) {
#if MK_FAST_S5
        p3_scan(a, F);
#endif
        p3_prep(a, F);
    } SEAM(3); PROBE_AT(4);

    if (IN(4)) {
#if MK_FAST_S5
        { ProbS5 P{(const bf16_t*)(ws + WS_APACK), (const bf16_t*)(ws + WS_TWC), APK, APK, 6, G, bx};
          EpiS5Out E{(bf16_t*)(ws + WS_GACT), ws + WS_GACT8}; gm::gemm_phase<ProbS5, EpiS5Out, false>(ring, P, E, F.wave); }
#else
        s5_reference(a, F);
#endif
#if MK_FAST_ATTN
        p4_attention(a, F);
#else
        attn_reference(a, F);
#endif
    } SEAM(4); PROBE_AT(5);

    if (IN(5)) {
        { gm::ProbDense P; P.init((const bf16_t*)(ws + (MK_FP8_GLU ? WS_GACT8 : WS_GACT)), S5W, (const bf16_t*)(ws + WS_WGLU), S5W, MK_FP8_GLU ? S5W / 2 : S5W, TT, S5W, G, bx);
          using E5 = EpiSide<0, MK_FP8_YB != 0, MK_FP8_GLU != 0>; E5 E{(bf16_t*)(ws + WS_Y2), S5W, (const bf16_t*)(ws + WS_GACT), S5W, nullptr, 0}; gm::gemm_phase<gm::ProbDense, E5, false, MK_FP8_GLU != 0>(ring, P, E, F.wave); }
        { gm::ProbDense P; P.init((const bf16_t*)(ws + WS_O), DM, (const bf16_t*)(ws + WS_WOMLA), DM, MK_FP8_YA ? DM / 2 : DM, TT, DM, G, bx);
          using E5a = EpiSide<1, false, MK_FP8_YA != 0>; E5a E{(bf16_t*)(ws + WS_MA), DM, (const bf16_t*)(ws + WS_PROJ) + C_GA, NPROJ, nullptr, 0}; gm::gemm_phase<gm::ProbDense, E5a, false, MK_FP8_YA != 0>(ring, P, E, F.wave); }
    } SEAM(5); PROBE_AT(6);

    if (IN(6)) {
        gm::ProbDense P; P.init((const bf16_t*)(ws + WS_Y2), S5W, (const bf16_t*)(ws + WS_WOS5), S5W, MK_FP8_YB ? S5W / 2 : S5W, TT, DM, G, bx);
        using E6 = EpiSide<2, MK_FP8_OUT != 0, MK_FP8_YB != 0>;
        E6 E{(bf16_t*)(ws + WS_M), DM, (const bf16_t*)(ws + WS_PROJ) + C_GB, NPROJ, (const bf16_t*)(ws + WS_MA), DM}; gm::gemm_phase<gm::ProbDense, E6, false, MK_FP8_YB != 0>(ring, P, E, F.wave);
    } SEAM(6); PROBE_AT(7);

    if (IN(7)) {
        gm::ProbDense P; P.init((const bf16_t*)(ws + WS_M), DM, (const bf16_t*)(ws + WS_WOUT), DM, MK_FP8_OUT ? DM / 2 : DM, TT, DM, G, bx);
        #if MK_X1_BF16
        EpiResidBf16 E{a.in[I_X], (bf16_t*)(ws + WS_X1)}; gm::gemm_phase<gm::ProbDense, EpiResidBf16, false, MK_FP8_OUT != 0>(ring, P, E, F.wave);
#else
        EpiResidF32 E{a.in[I_X], a.out}; gm::gemm_phase<gm::ProbDense, EpiResidF32, false, MK_FP8_OUT != 0>(ring, P, E, F.wave);
#endif
    } SEAM(7); PROBE_AT(8);

    if (IN(8)) { p8_norm2_router(a, F, MK_X1_BF16 ? (const float*)(ws + WS_X1) : a.out); } SEAM(8); PROBE_AT(9);
#if !MK_HIST_ROUTE
    if (IN(9)) { p9_routing(a, F); } SEAM(9);
#endif
    PROBE_AT(10);

#if MK_HIST_ROUTE
    if (IN(10) || IN(11) || IN(12) || IN(13)) moe_tables_hist(F, tab);
#else
    if (IN(10) || IN(11) || IN(12) || IN(13)) moe_tables(F, tab);
#endif
    const int xl = bx & 7, rk = bx >> 3, nrk = (G - xl + 7) >> 3;
#if MK_HIST_ROUTE
    if (IN(10)) { p10_place(a, F, tab); } SEAM(10);
#else
    if (IN(10)) { p10_permute(a, F, tab); } SEAM(10);
#endif PROBE_AT(11);
    if (IN(11)) {
        ProbMoE P{(const bf16_t*)(ws + WS_XPERM), (const bf16_t*)(ws + WS_W1), DM, DM, MK_FP8_MOE ? DM / 128 : DM / 64, 16, (size_t)4096 * DM, xl, rk, nrk}; P.load(tab);
        EpiSwiglu E{(bf16_t*)(ws + WS_HACT), a.in[I_BGATE], a.in[I_BUP], tab}; gm::gemm_phase<ProbMoE, EpiSwiglu, false, MK_FP8_MOE != 0>(ring, P, E, F.wave);
    } SEAM(11); PROBE_AT(12);
    if (IN(12)) {
        ProbMoE P{(const bf16_t*)(ws + WS_HACT), (const bf16_t*)(ws + WS_W2), DFF, DFF, MK_FP8_MOE ? DFF / 128 : DFF / 64, 8, (size_t)DM * DFF, xl, rk, nrk}; P.load(tab);
        EpiDown E{(bf16_t*)(ws + WS_YSLOT), a.in[I_BDOWN], tab}; gm::gemm_phase<ProbMoE, EpiDown, false, MK_FP8_MOE != 0>(ring, P, E, F.wave);
    } SEAM(12); PROBE_AT(13);
    if (IN(13)) { p12_combine(a, F, a.out, tab); }
    PROBE_AT(14);
#ifdef MK_PROBE_LO
#ifdef MK_PROBE_CLK
#define PROBE_DIV 24ull
#else
#define PROBE_DIV 1ull
#endif
    if (blockIdx.x == 0 && F.wave == 0 && fresh_lane() == 0) { const unsigned long long dt = (pr_t[1] - pr_t[0]) / PROBE_DIV * MK_PROBE_X, te = __builtin_amdgcn_s_memrealtime();
        while (__builtin_amdgcn_s_memrealtime() - te < dt) __builtin_amdgcn_s_sleep(32); }
#endif
#undef IN
#undef SEAM
}

extern "C" void kernel_launch(void* const* d_in, const int* in_sizes, int n_in, void* d_out, int out_size, void* d_ws, size_t ws_size, hipStream_t stream) {
    static int grid = 0;
    if (grid == 0) {
        if (n_in != 32 || in_sizes[0] != TT * DM || out_size != TT * DM || ws_size < WS_END) {
            fprintf(stderr, "kernel_launch: shape mismatch: n_in %d in0 %d out %d ws %zu (need %zu); nothing launched\n", n_in, n_in > 0 ? in_sizes[0] : -1, out_size, ws_size, (size_t)WS_END); grid = -1; return; }
        int dev = 0, cus = 0, per_cu = 0;
        if (hipGetDevice(&dev) != hipSuccess || hipDeviceGetAttribute(&cus, hipDeviceAttributeMultiprocessorCount, dev) != hipSuccess) { fprintf(stderr, "kernel_launch: device query failed\n"); grid = -1; return; }
        if (hipFuncSetAttribute((const void*)mk_fwd, hipFuncAttributeMaxDynamicSharedMemorySize, LDS_BYTES) != hipSuccess) { fprintf(stderr, "kernel_launch: hipFuncSetAttribute failed\n"); grid = -1; return; }
        if (hipOccupancyMaxActiveBlocksPerMultiprocessor(&per_cu, (const void*)mk_fwd, NTHREADS, LDS_BYTES) != hipSuccess || per_cu < 1)
            fprintf(stderr, "kernel_launch: note: occupancy query reports %d workgroups per CU\n", per_cu);
        (void)hipGetLastError();
        grid = cus - (cus % 8);
        if (grid < 8) grid = 8;
    }
    if (grid < 0) return;
    if (hipMemsetAsync((char*)d_ws + WS_CTL, 0, CTL_ZERO_BYTES, stream) != hipSuccess) { fprintf(stderr, "kernel_launch: memset failed\n"); return; }
    Args a{};
    for (int i = 0; i < 32; ++i) a.in[i] = (const float*)d_in[i];
    a.out = (float*)d_out; a.ws = (uchar*)d_ws;
#if MK_ONE_LAUNCH
    a.ph_lo = 0; a.ph_hi = NPHASE;
    hipLaunchKernelGGL(mk_fwd, dim3(grid), dim3(NTHREADS), LDS_BYTES, stream, a);
#else
    for (int p = 0; p < NPHASE; ++p) { a.ph_lo = p; a.ph_hi = p + 1; hipLaunchKernelGGL(mk_fwd, dim3(grid), dim3(NTHREADS), LDS_BYTES, stream, a); }
#endif
    const hipError_t le = hipPeekAtLastError();
    if (le != hipSuccess) fprintf(stderr, "kernel_launch: launch failed: %s\n", hipGetErrorName(le));
}
```
